# Optimizing an MI355X kernel written in HIP

```python
import math
import jax, jax.numpy as jnp
from jax import lax
import numpy as np

D_MODEL = 1024
BATCH = 16
SEQ = 4096
DEPTH = 1

PLE_DIM = 256
N_DIFF_HEADS = 4
DIFF_HEAD_DIM = 64
ATTN_WIDTH = N_DIFF_HEADS * 2 * DIFF_HEAD_DIM
POOL_WINDOWS = (2, 4, 8, 16)
N_POOL_GROUPS = len(POOL_WINDOWS)
POOL_GROUP_DIM = 128
POOL_WIDTH = N_POOL_GROUPS * POOL_GROUP_DIM
N_BRANCHES = 2
IN_WIDTH = 3 * ATTN_WIDTH + POOL_WIDTH + N_BRANCHES * D_MODEL
N_EXPERTS = 32
TOP_K = 4
D_FF = D_MODEL
SWIGLU_LIMIT = 7.0
SWIGLU_ALPHA = 1.702
Q_BLOCK = 128
MOE_BLOCK = 128
LN_EPS = 1e-5
DEEPNORM_ALPHA = (2 * DEPTH) ** 0.25
DEEPNORM_BETA = (8 * DEPTH) ** -0.25

kernel_name = 'hybrid_diffattn_pool_moe_deepnorm'

F32 = jnp.float32


def layer_norm(x, g, b):
    xf = x.astype(F32)
    mu = jnp.mean(xf, axis=-1, keepdims=True)
    var = jnp.mean(jnp.square(xf - mu), axis=-1, keepdims=True)
    return ((xf - mu) * lax.rsqrt(var + LN_EPS) * g + b).astype(x.dtype)


def rms_norm(x, g):
    xf = x.astype(F32)
    return (xf * lax.rsqrt(jnp.mean(jnp.square(xf), axis=-1, keepdims=True) + LN_EPS) * g).astype(x.dtype)


def alibi_slopes(n_heads):
    return jnp.asarray(np.array([2.0 ** (-8.0 * (h + 1) / n_heads) for h in range(n_heads)], dtype=np.float32))


def diff_attention(q, k, v, lam):
    Bb, Ss, H = q.shape[0], q.shape[1], q.shape[2]
    nq = Ss // Q_BLOCK
    qb = (q * (DIFF_HEAD_DIM ** -0.5)).reshape(Bb, nq, Q_BLOCK, H, 2, DIFF_HEAD_DIM).transpose(1, 0, 3, 4, 2, 5)
    kt = k.transpose(0, 2, 3, 1, 4)
    vt = v.transpose(0, 2, 1, 3)
    slopes = alibi_slopes(H)
    k_pos = jnp.arange(Ss)

    def block(args):
        q_blk, q_start = args
        s = jnp.einsum('bhmqd,bhmkd->bhmqk', q_blk, kt, preferred_element_type=F32)
        dist = (q_start + jnp.arange(Q_BLOCK))[:, None] - k_pos[None, :]
        bias = jnp.where(dist >= 0, -slopes[:, None, None] * dist.astype(F32), -jnp.inf)
        probs = jax.nn.softmax(s + bias[None, :, None], axis=-1)
        w = probs[:, :, 0] - lam * probs[:, :, 1]
        return jnp.einsum('bhqk,bhkv->bhqv', w.astype(vt.dtype), vt)

    starts = jnp.arange(nq) * Q_BLOCK
    o = lax.map(block, (qb, starts))
    return o.transpose(1, 0, 3, 2, 4).reshape(Bb, Ss, H, 2 * DIFF_HEAD_DIM)


def multiscale_pool(u, w_mix, scale):
    Bb, Ss, _ = u.shape
    ug = u.reshape(Bb, Ss, N_POOL_GROUPS, POOL_GROUP_DIM)
    cs = jnp.cumsum(ug.astype(F32), axis=1)
    pos = jnp.arange(Ss)
    means = []
    for gi, w in enumerate(POOL_WINDOWS):
        c = cs[:, :, gi]
        lagged = jnp.pad(c, ((0, 0), (w, 0), (0, 0)))[:, :Ss]
        count = jnp.minimum(pos + 1, w).astype(F32)[None, :, None]
        means.append((c - lagged) / count)
    pooled = (jnp.stack(means, axis=2) - ug.astype(F32)).astype(u.dtype)
    mixed = jnp.einsum('bsgc,gcd->bsgd', pooled, w_mix).reshape(Bb, Ss, POOL_WIDTH)
    return mixed * scale


def clamped_swiglu(h):
    glu, lin = jnp.split(h, 2, axis=-1)
    glu = jnp.minimum(glu, SWIGLU_LIMIT)
    lin = jnp.clip(lin, -SWIGLU_LIMIT, SWIGLU_LIMIT)
    return glu * jax.nn.sigmoid(SWIGLU_ALPHA * glu) * (lin + 1.0)


def moe(h, w_router, b_router, w_up, b_up, w_down, b_down):
    Bb, Ss, D = h.shape
    T = Bb * Ss
    A = T * TOP_K
    t = h.reshape(T, D)
    logits = (t @ w_router + b_router).astype(F32)
    top_val, top_idx = lax.top_k(logits, TOP_K)
    gate = jax.nn.softmax(top_val, axis=-1).reshape(A)
    flat_e = top_idx.reshape(A)
    flat_tok = jnp.arange(A) // TOP_K
    order = jnp.argsort(flat_e)
    sorted_e = flat_e[order]
    counts = jnp.bincount(flat_e, length=N_EXPERTS)
    padded = ((counts + MOE_BLOCK - 1) // MOE_BLOCK) * MOE_BLOCK
    cum_padded = jnp.cumsum(padded)
    pad_start = cum_padded - padded
    start = jnp.cumsum(counts) - counts
    dest = pad_start[sorted_e] + (jnp.arange(A) - start[sorted_e])
    n_slots = A + N_EXPERTS * MOE_BLOCK
    n_blocks = n_slots // MOE_BLOCK
    slot_tok = jnp.full((n_slots,), T, jnp.int32).at[dest].set(flat_tok[order])
    slot_gate = jnp.zeros((n_slots,), F32).at[dest].set(gate[order])
    block_expert = jnp.minimum(jnp.searchsorted(cum_padded, jnp.arange(n_blocks) * MOE_BLOCK, side='right'), N_EXPERTS - 1)
    t_pad = jnp.concatenate([t, jnp.zeros((1, D), t.dtype)], axis=0)
    xs = t_pad[slot_tok].reshape(n_blocks, MOE_BLOCK, D)

    def expert_block(args):
        xb, e = args
        hb = clamped_swiglu(xb @ w_up[e] + b_up[e])
        return hb @ w_down[e] + b_down[e]

    ys = lax.map(expert_block, (xs, block_expert)).reshape(n_slots, D)
    out = jnp.zeros((T + 1, D), ys.dtype).at[slot_tok].add(ys * slot_gate[:, None].astype(ys.dtype))
    return out[:T].reshape(Bb, Ss, D)


def setup_inputs(seed: int = 0) -> dict:
    key = jax.random.key(seed)
    ks = jax.random.split(key, 32)
    L = DEPTH

    def nrm(k, shape, scale):
        return jax.random.normal(k, shape, F32) * scale

    s_in = D_MODEL ** -0.5
    w_qk = nrm(ks[2], (L, D_MODEL, 2 * ATTN_WIDTH), s_in)
    w_v = nrm(ks[3], (L, D_MODEL, ATTN_WIDTH), s_in * DEEPNORM_BETA)
    w_pool_in = nrm(ks[4], (L, D_MODEL, POOL_WIDTH), s_in)
    w_gate = nrm(ks[5], (L, D_MODEL, N_BRANCHES * D_MODEL), s_in)
    return {
        'x': nrm(ks[0], (BATCH, SEQ, D_MODEL), 1.0),
        'p': nrm(ks[1], (DEPTH, BATCH, SEQ, PLE_DIM), 1.0),
        'w_in': jnp.concatenate([w_qk, w_v, w_pool_in, w_gate], axis=-1),
        'b_gate': nrm(ks[6], (L, N_BRANCHES * D_MODEL), 0.02),
        'lambda_q1': nrm(ks[7], (L, DIFF_HEAD_DIM), 0.1),
        'lambda_k1': nrm(ks[8], (L, DIFF_HEAD_DIM), 0.1),
        'lambda_q2': nrm(ks[9], (L, DIFF_HEAD_DIM), 0.1),
        'lambda_k2': nrm(ks[10], (L, DIFF_HEAD_DIM), 0.1),
        'subln_g': 1.0 + nrm(ks[11], (L, 2 * DIFF_HEAD_DIM), 0.02),
        'w_attn_br': nrm(ks[12], (L, ATTN_WIDTH, D_MODEL), ATTN_WIDTH ** -0.5),
        'w_pool_mix': nrm(ks[13], (L, N_POOL_GROUPS, POOL_GROUP_DIM, POOL_GROUP_DIM), POOL_GROUP_DIM ** -0.5),
        'pool_scale': 1.0 + nrm(ks[14], (L, POOL_WIDTH), 0.02),
        'w_pool_br': nrm(ks[15], (L, POOL_WIDTH, D_MODEL), POOL_WIDTH ** -0.5),
        'w_out': nrm(ks[16], (L, D_MODEL, D_MODEL), s_in * DEEPNORM_BETA),
        'ln1_g': 1.0 + nrm(ks[17], (L, D_MODEL), 0.02),
        'ln1_b': nrm(ks[18], (L, D_MODEL), 0.02),
        'w_router': nrm(ks[19], (L, D_MODEL, N_EXPERTS), s_in),
        'b_router': nrm(ks[20], (L, N_EXPERTS), 0.01),
        'w_up': nrm(ks[21], (L, N_EXPERTS, D_MODEL, 2 * D_FF), s_in),
        'b_up': nrm(ks[22], (L, N_EXPERTS, 2 * D_FF), 0.02),
        'w_down': nrm(ks[23], (L, N_EXPERTS, D_FF, D_MODEL), D_FF ** -0.5 * DEEPNORM_BETA),
        'b_down': nrm(ks[24], (L, N_EXPERTS, D_MODEL), 0.02),
        'w_ple_gate': nrm(ks[25], (L, D_MODEL, D_MODEL), s_in),
        'w_ple_proj': nrm(ks[26], (L, PLE_DIM, D_MODEL), PLE_DIM ** -0.5 * DEEPNORM_BETA),
        'ln2_g': 1.0 + nrm(ks[27], (L, D_MODEL), 0.02),
        'ln2_b': nrm(ks[28], (L, D_MODEL), 0.02),
    }


def reference(x, p, w_in, b_gate, lambda_q1, lambda_k1, lambda_q2, lambda_k2, subln_g, w_attn_br,
              w_pool_mix, pool_scale, w_pool_br, w_out, ln1_g, ln1_b, w_router, b_router, w_up, b_up,
              w_down, b_down, w_ple_gate, w_ple_proj, ln2_g, ln2_b):
    Bb, Ss, _ = x.shape
    splits = [ATTN_WIDTH, 2 * ATTN_WIDTH, 3 * ATTN_WIDTH, 3 * ATTN_WIDTH + POOL_WIDTH]
    for i in range(DEPTH):
        proj = x @ w_in[i]
        q, k, v, u, g = jnp.split(proj, splits, axis=-1)
        q = q.reshape(Bb, Ss, N_DIFF_HEADS, 2, DIFF_HEAD_DIM)
        k = k.reshape(Bb, Ss, N_DIFF_HEADS, 2, DIFF_HEAD_DIM)
        v = v.reshape(Bb, Ss, N_DIFF_HEADS, 2 * DIFF_HEAD_DIM)
        lam_init = 0.8 - 0.6 * math.exp(-0.3 * i)
        lam = (jnp.exp(jnp.sum(lambda_q1[i].astype(F32) * lambda_k1[i].astype(F32)))
               - jnp.exp(jnp.sum(lambda_q2[i].astype(F32) * lambda_k2[i].astype(F32))) + lam_init)
        o = diff_attention(q, k, v, lam)
        o = rms_norm(o, subln_g[i]) * (1.0 - lam_init)
        a_branch = o.reshape(Bb, Ss, ATTN_WIDTH) @ w_attn_br[i]
        p_branch = multiscale_pool(u, w_pool_mix[i], pool_scale[i]) @ w_pool_br[i]
        g_a, g_p = jnp.split(jax.nn.sigmoid(g + b_gate[i]), 2, axis=-1)
        mixed = g_a * a_branch + g_p * p_branch
        x = layer_norm(DEEPNORM_ALPHA * x + mixed @ w_out[i], ln1_g[i], ln1_b[i])
        ffn = moe(x, w_router[i], b_router[i], w_up[i], b_up[i], w_down[i], b_down[i])
        ple = jax.nn.sigmoid(x @ w_ple_gate[i]) * (p[i] @ w_ple_proj[i])
        x = layer_norm(DEEPNORM_ALPHA * x + ffn + ple, ln2_g[i], ln2_b[i])
    return x
```

```cpp
#include <hip/hip_runtime.h>
#include <hip/hip_bf16.h>
#include <cstdio>
#include <cstdint>
#include <cmath>

#define GAS __attribute__((address_space(1)))
#define LAS __attribute__((address_space(3)))
typedef unsigned short bf16;
typedef unsigned v4u __attribute__((ext_vector_type(4)));
typedef float f32x4 __attribute__((ext_vector_type(4)));
typedef short bf16x8 __attribute__((ext_vector_type(8)));
typedef GAS unsigned gu32;
typedef GAS unsigned long long gu64;
#define RLX_AGENT __ATOMIC_RELAXED, __HIP_MEMORY_SCOPE_AGENT
#define LDS_WAIT() asm volatile("s_waitcnt lgkmcnt(0)" ::: "memory")
#define VM_WAIT() asm volatile("s_waitcnt vmcnt(0)" ::: "memory")
__device__ __forceinline__ unsigned f2bf(float f) { unsigned u = __builtin_bit_cast(unsigned, f); return (u + 0x7fffu + ((u >> 16) & 1u)) >> 16; }
__device__ __forceinline__ unsigned pk2(float lo, float hi) { return f2bf(lo) | (f2bf(hi) << 16); }

constexpr int BATCH = 16, SEQ = 4096, D = 1024, M = BATCH * SEQ;
constexpr int NEXP = 32, TOPK = 4, NASSIGN = M * TOPK, FF = 1024, PLE = 256;
constexpr float LN_EPS = 1e-5f;
constexpr float ALPHA = 1.189207115002721f;
constexpr float C2Q = 0.125f * 1.4426950408889634f;

constexpr size_t MiB = 1u << 20;
constexpr size_t WS_CTL = 0, CTL_ZERO_BYTES = 1 * MiB;
constexpr size_t WS_LIST = 1 * MiB;
constexpr size_t WS_GATE = 9 * MiB;
constexpr size_t WS_WPCF = 10 * MiB;
constexpr size_t WS_WIN = 16 * MiB, WS_WA = 24 * MiB, WS_WPC = 25 * MiB, WS_WOUT = 26 * MiB, WS_WPG = 28 * MiB, WS_WPP = 30 * MiB;
constexpr size_t WS_WDN = 32 * MiB, WS_WUP = 96 * MiB;
constexpr size_t WS_XB = 224 * MiB;
constexpr size_t WS_OA = 224 * MiB, WS_PO = 288 * MiB;
constexpr size_t WS_X1B = 224 * MiB;
constexpr size_t WS_Q = 352 * MiB, WS_K = 416 * MiB, WS_V = 480 * MiB, WS_U = 544 * MiB;
constexpr size_t WS_G = 608 * MiB;
constexpr size_t WS_O16 = 864 * MiB;
constexpr size_t WS_PB = 992 * MiB;
constexpr size_t WS_MIX = 352 * MiB;
constexpr size_t WS_T = 352 * MiB;
constexpr size_t WS_HB = 352 * MiB;
constexpr size_t WS_YS1 = 96 * MiB, WS_YS2 = 224 * MiB, WS_YS3 = 864 * MiB;
constexpr size_t WS_END = 1024 * MiB;
constexpr int CW_TMO = 0, CW_CODE = 1;
constexpr int CW_CNT = 64;
constexpr int CW_BAR = 4096;
namespace nv {
__device__ __forceinline__ float bf2f(bf16 b) { return __builtin_bit_cast(float, (unsigned)b << 16); }
__device__ __forceinline__ bf16 f2b(float f) { return (bf16)f2bf(f); }
__device__ __forceinline__ float sigm(float v) { return 1.f / (1.f + __expf(-v)); }

__global__ void k_zero_ctl(unsigned* p, int n) { int i = blockIdx.x * blockDim.x + threadIdx.x; if (i < n) p[i] = 0u; }
__global__ void k_cvt_bf16(const float* in, bf16* out, size_t n4) {
    size_t i = (size_t)blockIdx.x * blockDim.x + threadIdx.x; const size_t st = (size_t)gridDim.x * blockDim.x;
    for (; i < n4; i += st) { const f32x4 v = ((const f32x4*)in)[i]; unsigned long long o = (unsigned long long)pk2(v.x, v.y) | ((unsigned long long)pk2(v.z, v.w) << 32); ((unsigned long long*)out)[i] = o; }
}
__global__ void k_fold_pool(const float* wmix, const float* scale, const float* wpb, float* Wpc) {
    const int row = blockIdx.x, g = row >> 7, c = row & 127;
    __shared__ float wm[128];
    if (threadIdx.x < 128) wm[threadIdx.x] = wmix[(g * 128 + c) * 128 + threadIdx.x] * scale[g * 128 + threadIdx.x];
    __syncthreads();
    for (int n = threadIdx.x; n < 1024; n += 256) { float s = 0.f; for (int d = 0; d < 128; ++d) s += wm[d] * wpb[(size_t)(g * 128 + d) * 1024 + n]; Wpc[(size_t)row * 1024 + n] = s; }
}

template <bool DUAL, class RowF, class Epi>
__global__ void __launch_bounds__(256) k_gemm(RowF rf, Epi epi, const float* W, size_t wz, int ldw, int K, int dualoff, int pad_) {
    __shared__ float As[16][68]; __shared__ float Bs[16][64]; __shared__ float Bs2[DUAL ? 16 : 1][64];
    const int tid = threadIdx.x, ty = tid >> 4, tx = tid & 15, z = blockIdx.z;
    const int row0 = blockIdx.y * 64, col0 = blockIdx.x * 64;
    if (!rf.active(z, row0)) return;
    const float* Wz = W + (size_t)z * wz;
    float acc[4][4] = {}, acc2[4][4] = {};
    const int ar = tid >> 2, ak = (tid & 3) * 4; const bf16* arow = rf.row(z, row0 + ar);
    const int bk = tid >> 4, bc = (tid & 15) * 4;
    for (int k0 = 0; k0 < K; k0 += 16) {
        { const unsigned long long v = arow ? *(const unsigned long long*)(arow + k0 + ak) : 0ull;
          As[ak + 0][ar] = bf2f((bf16)(v & 0xffff)); As[ak + 1][ar] = bf2f((bf16)((v >> 16) & 0xffff)); As[ak + 2][ar] = bf2f((bf16)((v >> 32) & 0xffff)); As[ak + 3][ar] = bf2f((bf16)(v >> 48)); }
        { const f32x4 v = *(const f32x4*)(Wz + (size_t)(k0 + bk) * ldw + col0 + bc); Bs[bk][bc] = v.x; Bs[bk][bc + 1] = v.y; Bs[bk][bc + 2] = v.z; Bs[bk][bc + 3] = v.w;
          if (DUAL) { const f32x4 w = *(const f32x4*)(Wz + (size_t)(k0 + bk) * ldw + dualoff + col0 + bc); Bs2[bk][bc] = w.x; Bs2[bk][bc + 1] = w.y; Bs2[bk][bc + 2] = w.z; Bs2[bk][bc + 3] = w.w; } }
        __syncthreads();
#pragma unroll
        for (int k = 0; k < 16; ++k) { float a[4], b[4], b2[4];
#pragma unroll
            for (int i = 0; i < 4; ++i) { a[i] = As[k][ty * 4 + i]; b[i] = Bs[k][tx * 4 + i]; b2[i] = DUAL ? Bs2[k][tx * 4 + i] : 0.f; }
#pragma unroll
            for (int i = 0; i < 4; ++i)
#pragma unroll
                for (int j = 0; j < 4; ++j) { acc[i][j] += a[i] * b[j]; if (DUAL) acc2[i][j] += a[i] * b2[j]; } }
        __syncthreads();
    }
#pragma unroll
    for (int i = 0; i < 4; ++i)
#pragma unroll
        for (int j = 0; j < 4; ++j) epi(z, row0 + ty * 4 + i, col0 + tx * 4 + j, acc[i][j], acc2[i][j]);
}
struct RowDense { const bf16* A; int lda; int pad; __device__ bool active(int, int) const { return true; } __device__ const bf16* row(int, int r) const { return A + (size_t)r * lda; } };

struct EpiProj { bf16 *Q, *K, *V, *U, *G; const float* bg; float c2; int pad;
    __device__ void operator()(int, int r, int c, float v, float) const {
        if (c < 512) Q[(size_t)r * 512 + c] = f2b(v * c2); else if (c < 1024) K[(size_t)r * 512 + c - 512] = f2b(v); else if (c < 1536) V[(size_t)r * 512 + c - 1024] = f2b(v);
        else if (c < 2048) U[(size_t)r * 512 + c - 1536] = f2b(v); else G[(size_t)r * 2048 + c - 2048] = f2b(sigm(v + bg[c - 2048])); } };
struct EpiMixA { bf16* MIX; const bf16* G; __device__ void operator()(int, int r, int c, float v, float) const { MIX[(size_t)r * 1024 + c] = f2b(bf2f(G[(size_t)r * 2048 + c]) * v); } };
struct EpiMixB { bf16* MIX; const bf16* G; __device__ void operator()(int, int r, int c, float v, float) const { MIX[(size_t)r * 1024 + c] = f2b(bf2f(MIX[(size_t)r * 1024 + c]) + bf2f(G[(size_t)r * 2048 + 1024 + c]) * v); } };
struct EpiPre1 { float* out; const float* x; float alpha; int pad; __device__ void operator()(int, int r, int c, float v, float) const { out[(size_t)r * 1024 + c] = alpha * x[(size_t)r * 1024 + c] + v; } };
struct EpiStoreF32 { float* T; __device__ void operator()(int, int r, int c, float v, float) const { T[(size_t)r * 1024 + c] = v; } };
struct EpiBase { float* base; const float* T; float alpha; int pad; __device__ void operator()(int, int r, int c, float v, float) const { const size_t i = (size_t)r * 1024 + c; base[i] = alpha * base[i] + sigm(v) * T[i]; } };

__global__ void __launch_bounds__(256) k_attn(const bf16* Q, const bf16* K, const bf16* V, bf16* O16) {
    __shared__ float Ks[64][64]; __shared__ float Vs[64][64];
    const int qb = blockIdx.x, vh = blockIdx.y, b = blockIdx.z, tid = threadIdx.x;
    const int hm = vh >> 1, half = vh & 1, h = hm >> 1;
    const float c2 = exp2f(-2.f * (h + 1)) * 1.4426950408889634f;
    const int i = qb * 256 + tid; const size_t rowb = (size_t)b * SEQ;
    float q[64], acc[64];
    { const bf16* qp = Q + (rowb + i) * 512 + hm * 64;
#pragma unroll
      for (int d = 0; d < 64; ++d) { q[d] = bf2f(qp[d]); acc[d] = 0.f; } }
    float m = -INFINITY, l = 0.f;
    const int ntile = (qb * 256 + 256) / 64;
    for (int t = 0; t < ntile; ++t) {
        __syncthreads();
        for (int e = tid; e < 64 * 64; e += 256) { const int j = e >> 6, d = e & 63; const size_t r = rowb + t * 64 + j;
            Ks[j][d] = bf2f(K[r * 512 + hm * 64 + d]); Vs[j][d] = bf2f(V[r * 512 + h * 128 + half * 64 + d]); }
        __syncthreads();
        for (int j = 0; j < 64; ++j) { const int jj = t * 64 + j; if (jj > i) break;
            float s = 0.f;
#pragma unroll
            for (int d = 0; d < 64; ++d) s += q[d] * Ks[j][d];
            s -= c2 * (float)(i - jj);
            if (s > m) { const float f = exp2f(m - s); l *= f;
#pragma unroll
                for (int d = 0; d < 64; ++d) acc[d] *= f;
                m = s; }
            const float p = exp2f(s - m); l += p;
#pragma unroll
            for (int d = 0; d < 64; ++d) acc[d] += p * Vs[j][d]; }
    }
    const float rl = 1.f / l; bf16* op = O16 + (rowb + i) * 1024 + h * 256 + (hm & 1) * 128 + half * 64;
#pragma unroll
    for (int d = 0; d < 64; ++d) op[d] = f2b(acc[d] * rl);
}
__device__ __forceinline__ float lam_value(const float* lq1, const float* lk1, const float* lq2, const float* lk2) {
    float a = 0.f, b = 0.f; for (int d = 0; d < 64; ++d) { a += lq1[d] * lk1[d]; b += lq2[d] * lk2[d]; } return __expf(a) - __expf(b) + 0.2f; }
__global__ void __launch_bounds__(256) k_combine(const bf16* O16, bf16* OA, const float* lq1, const float* lk1, const float* lq2, const float* lk2, const float* sg) {
    const float lam = lam_value(lq1, lk1, lq2, lk2);
    const int row = blockIdx.x * 4 + (threadIdx.x >> 6), lane = threadIdx.x & 63, h = lane >> 4, e0 = (lane & 15) * 8;
    const bf16* a = O16 + (size_t)row * 1024 + h * 256 + e0; const bf16* bb = a + 128;
    float o[8], ss = 0.f;
#pragma unroll
    for (int j = 0; j < 8; ++j) { o[j] = bf2f(a[j]) - lam * bf2f(bb[j]); ss += o[j] * o[j]; }
    ss += __shfl_xor(ss, 1); ss += __shfl_xor(ss, 2); ss += __shfl_xor(ss, 4); ss += __shfl_xor(ss, 8);
    const float r = rsqrtf(ss * (1.f / 128.f) + LN_EPS) * 0.8f;
#pragma unroll
    for (int j = 0; j < 8; ++j) OA[(size_t)row * 512 + h * 128 + e0 + j] = f2b(o[j] * r * sg[e0 + j]);
}
__global__ void __launch_bounds__(256) k_pool(const bf16* U, bf16* PO) {
    const size_t idx = (size_t)blockIdx.x * 256 + threadIdx.x; const int c = (int)(idx & 511); const size_t row = idx >> 9; const int pos = (int)(row & (SEQ - 1));
    const int w = 2 << (c >> 7); const int n = pos + 1 < w ? pos + 1 : w; float s = 0.f;
    for (int k = 0; k < n; ++k) s += bf2f(U[(row - k) * 512 + c]);
    PO[row * 512 + c] = f2b(s / (float)n - bf2f(U[row * 512 + c]));
}
__global__ void __launch_bounds__(256) k_ln1_route(float* X1, bf16* X1B, const float* g, const float* bta, const float* wr, const float* br, unsigned* CNT, int* LIST, float* GATE) {
    __shared__ float xs[1024]; __shared__ float red[8]; __shared__ float part[8][32]; __shared__ float lg[32];
    const int row = blockIdx.x, tid = threadIdx.x, lane = tid & 63, wv = tid >> 6;
    f32x4 v = ((const f32x4*)(X1 + (size_t)row * 1024))[tid];
    float s = (v.x + v.y) + (v.z + v.w); for (int o = 1; o < 64; o <<= 1) s += __shfl_xor(s, o);
    if (lane == 0) red[wv] = s; __syncthreads(); const float mean = (red[0] + red[1] + red[2] + red[3]) * (1.f / 1024.f); __syncthreads();
    v = v - mean; float q = (v.x * v.x + v.y * v.y) + (v.z * v.z + v.w * v.w); for (int o = 1; o < 64; o <<= 1) q += __shfl_xor(q, o);
    if (lane == 0) red[wv] = q; __syncthreads(); const float rstd = rsqrtf((red[0] + red[1] + red[2] + red[3]) * (1.f / 1024.f) + LN_EPS);
    const f32x4 gg = ((const f32x4*)g)[tid], bb = ((const f32x4*)bta)[tid]; v = v * rstd * gg + bb;
    ((f32x4*)(X1 + (size_t)row * 1024))[tid] = v; ((unsigned long long*)(X1B + (size_t)row * 1024))[tid] = (unsigned long long)pk2(v.x, v.y) | ((unsigned long long)pk2(v.z, v.w) << 32);
    xs[tid * 4] = v.x; xs[tid * 4 + 1] = v.y; xs[tid * 4 + 2] = v.z; xs[tid * 4 + 3] = v.w; __syncthreads();
    { const int e = tid & 31, pt = tid >> 5; float a = 0.f; for (int k = pt * 128; k < pt * 128 + 128; ++k) a += xs[k] * wr[k * 32 + e]; part[pt][e] = a; }
    __syncthreads();
    if (tid < 32) { float a = br[tid]; for (int pt = 0; pt < 8; ++pt) a += part[pt][tid]; lg[tid] = a; }
    __syncthreads();
    if (tid == 0) { int id[4]; float vv[4]; unsigned used = 0u;
        for (int k = 0; k < 4; ++k) { int bi = 0; float bv = -INFINITY; for (int e = 0; e < 32; ++e) if (!((used >> e) & 1u) && lg[e] > bv) { bv = lg[e]; bi = e; } used |= 1u << bi; id[k] = bi; vv[k] = bv; }
        float es[4], sum = 0.f; for (int k = 0; k < 4; ++k) { es[k] = __expf(vv[k] - vv[0]); sum += es[k]; }
        for (int k = 0; k < 4; ++k) { const unsigned pos = atomicAdd(&CNT[id[k]], 1u); LIST[(size_t)id[k] * 65536 + pos] = row * 4 + k; GATE[row * 4 + k] = es[k] / sum; } }
}
struct RowGather { const bf16* X1B; const int* LIST; const unsigned* CNT;
    __device__ bool active(int e, int row0) const { return (unsigned)row0 < CNT[e]; }
    __device__ const bf16* row(int e, int r) const { return (unsigned)r < CNT[e] ? X1B + (size_t)(LIST[(size_t)e * 65536 + r] >> 2) * 1024 : nullptr; } };
__device__ __forceinline__ unsigned slot_off(const unsigned* CNT, int e) { unsigned o = 0; for (int i = 0; i < e; ++i) o += CNT[i]; return o; }
struct EpiUp { bf16* HB; const float* bup; const unsigned* CNT;
    __device__ void operator()(int e, int r, int c, float glu, float lin) const { if ((unsigned)r >= CNT[e]) return;
        glu += bup[e * 2048 + c]; lin += bup[e * 2048 + 1024 + c]; glu = fminf(glu, 7.f); lin = fminf(fmaxf(lin, -7.f), 7.f);
        HB[(size_t)(slot_off(CNT, e) + r) * 1024 + c] = f2b(glu * sigm(1.702f * glu) * (lin + 1.f)); } };
struct RowSlots { const bf16* HB; const unsigned* CNT;
    __device__ bool active(int e, int row0) const { return (unsigned)row0 < CNT[e]; }
    __device__ const bf16* row(int e, int r) const { return (unsigned)r < CNT[e] ? HB + (size_t)(slot_off(CNT, e) + r) * 1024 : nullptr; } };
struct EpiDown { float* base; bf16* YS1; bf16* YS2; bf16* YS3; const float* bdn; const int* LIST; const float* GATE; const unsigned* CNT;
    __device__ void operator()(int e, int r, int c, float v, float) const { if ((unsigned)r >= CNT[e]) return;
        const int a = LIST[(size_t)e * 65536 + r], tok = a >> 2, k = a & 3; const float y = (v + bdn[e * 1024 + c]) * GATE[a]; const size_t i = (size_t)tok * 1024 + c;
        if (k == 0) base[i] += y; else if (k == 1) YS1[i] = f2b(y); else if (k == 2) YS2[i] = f2b(y); else YS3[i] = f2b(y); } };
__global__ void __launch_bounds__(256) k_final(float* out, const bf16* YS1, const bf16* YS2, const bf16* YS3, const float* g, const float* bta) {
    __shared__ float red[8]; const int row = blockIdx.x, tid = threadIdx.x, lane = tid & 63, wv = tid >> 6; const size_t i0 = (size_t)row * 1024 + tid * 4;
    f32x4 v = *(const f32x4*)(out + i0);
    const bf16* ys[3] = {YS1, YS2, YS3};
    for (int k = 0; k < 3; ++k) { const unsigned long long w = *(const unsigned long long*)(ys[k] + i0); v.x += bf2f((bf16)(w & 0xffff)); v.y += bf2f((bf16)((w >> 16) & 0xffff)); v.z += bf2f((bf16)((w >> 32) & 0xffff)); v.w += bf2f((bf16)(w >> 48)); }
    float s = (v.x + v.y) + (v.z + v.w); for (int o = 1; o < 64; o <<= 1) s += __shfl_xor(s, o);
    if (lane == 0) red[wv] = s; __syncthreads(); const float mean = (red[0] + red[1] + red[2] + red[3]) * (1.f / 1024.f); __syncthreads();
    v = v - mean; float q = (v.x * v.x + v.y * v.y) + (v.z * v.z + v.w * v.w); for (int o = 1; o < 64; o <<= 1) q += __shfl_xor(q, o);
    if (lane == 0) red[wv] = q; __syncthreads(); const float rstd = rsqrtf((red[0] + red[1] + red[2] + red[3]) * (1.f / 1024.f) + LN_EPS);
    const f32x4 gg = ((const f32x4*)g)[tid], bb = ((const f32x4*)bta)[tid]; *(f32x4*)(out + i0) = v * rstd * gg + bb;
}
}
extern "C" void kernel_launch(void* const* d_in, const int* in_sizes, int n_in, void* d_out, int out_size, void* d_ws, size_t ws_size, hipStream_t stream) {
    if (n_in != 26 || ws_size < WS_END || out_size != M * D) { fprintf(stderr, "kernel_launch: unexpected shapes (n_in %d, ws %zu, out %d)\n", n_in, ws_size, out_size); return; }
    const float* x = (const float*)d_in[0]; const float* p = (const float*)d_in[1]; const float* w_in = (const float*)d_in[2]; const float* b_gate = (const float*)d_in[3];
    const float *lq1 = (const float*)d_in[4], *lk1 = (const float*)d_in[5], *lq2 = (const float*)d_in[6], *lk2 = (const float*)d_in[7], *subln = (const float*)d_in[8];
    const float *w_abr = (const float*)d_in[9], *w_pmix = (const float*)d_in[10], *pscale = (const float*)d_in[11], *w_pbr = (const float*)d_in[12], *w_out = (const float*)d_in[13];
    const float *ln1g = (const float*)d_in[14], *ln1b = (const float*)d_in[15], *w_router = (const float*)d_in[16], *b_router = (const float*)d_in[17];
    const float *w_up = (const float*)d_in[18], *b_up = (const float*)d_in[19], *w_down = (const float*)d_in[20], *b_down = (const float*)d_in[21];
    const float *w_pg = (const float*)d_in[22], *w_pp = (const float*)d_in[23], *ln2g = (const float*)d_in[24], *ln2b = (const float*)d_in[25];
    unsigned char* ws = (unsigned char*)d_ws; float* out = (float*)d_out;
    unsigned* CTL = (unsigned*)(ws + WS_CTL); unsigned* CNT = CTL + CW_CNT; int* LIST = (int*)(ws + WS_LIST); float* GATE = (float*)(ws + WS_GATE); float* WPCF = (float*)(ws + WS_WPCF);
    bf16 *XB = (bf16*)(ws + WS_XB), *PB = (bf16*)(ws + WS_PB), *Q = (bf16*)(ws + WS_Q), *K = (bf16*)(ws + WS_K), *V = (bf16*)(ws + WS_V), *U = (bf16*)(ws + WS_U), *G = (bf16*)(ws + WS_G);
    bf16 *O16 = (bf16*)(ws + WS_O16), *OA = (bf16*)(ws + WS_OA), *PO = (bf16*)(ws + WS_PO), *MIX = (bf16*)(ws + WS_MIX), *X1B = (bf16*)(ws + WS_X1B), *HB = (bf16*)(ws + WS_HB);
    bf16 *YS1 = (bf16*)(ws + WS_YS1), *YS2 = (bf16*)(ws + WS_YS2), *YS3 = (bf16*)(ws + WS_YS3); float* T = (float*)(ws + WS_T);
    (void)hipMemsetAsync(ws + WS_CTL, 0, CTL_ZERO_BYTES, stream);
    nv::k_cvt_bf16<<<2048, 256, 0, stream>>>(x, XB, (size_t)M * D / 4);
    nv::k_cvt_bf16<<<2048, 256, 0, stream>>>(p, PB, (size_t)M * PLE / 4);
    nv::k_fold_pool<<<512, 256, 0, stream>>>(w_pmix, pscale, w_pbr, WPCF);
    nv::k_gemm<false><<<dim3(4096 / 64, M / 64, 1), 256, 0, stream>>>(nv::RowDense{XB, 1024, 0}, nv::EpiProj{Q, K, V, U, G, b_gate, C2Q, 0}, w_in, 0, 4096, 1024, 0, 0);
    nv::k_attn<<<dim3(SEQ / 256, 16, BATCH), 256, 0, stream>>>(Q, K, V, O16);
    nv::k_combine<<<M / 4, 256, 0, stream>>>(O16, OA, lq1, lk1, lq2, lk2, subln);
    nv::k_pool<<<(unsigned)((size_t)M * 512 / 256), 256, 0, stream>>>(U, PO);
    nv::k_gemm<false><<<dim3(1024 / 64, M / 64, 1), 256, 0, stream>>>(nv::RowDense{OA, 512, 0}, nv::EpiMixA{MIX, G}, w_abr, 0, 1024, 512, 0, 0);
    nv::k_gemm<false><<<dim3(1024 / 64, M / 64, 1), 256, 0, stream>>>(nv::RowDense{PO, 512, 0}, nv::EpiMixB{MIX, G}, WPCF, 0, 1024, 512, 0, 0);
    nv::k_gemm<false><<<dim3(1024 / 64, M / 64, 1), 256, 0, stream>>>(nv::RowDense{MIX, 1024, 0}, nv::EpiPre1{out, x, ALPHA, 0}, w_out, 0, 1024, 1024, 0, 0);
    nv::k_ln1_route<<<M, 256, 0, stream>>>(out, X1B, ln1g, ln1b, w_router, b_router, CNT, LIST, GATE);
    nv::k_gemm<false><<<dim3(1024 / 64, M / 64, 1), 256, 0, stream>>>(nv::RowDense{PB, 256, 0}, nv::EpiStoreF32{T}, w_pp, 0, 1024, 256, 0, 0);
    nv::k_gemm<false><<<dim3(1024 / 64, M / 64, 1), 256, 0, stream>>>(nv::RowDense{X1B, 1024, 0}, nv::EpiBase{out, T, ALPHA, 0}, w_pg, 0, 1024, 1024, 0, 0);
    nv::k_gemm<true><<<dim3(1024 / 64, M / 64, NEXP), 256, 0, stream>>>(nv::RowGather{X1B, LIST, CNT}, nv::EpiUp{HB, b_up, CNT}, w_up, (size_t)1024 * 2048, 2048, 1024, 1024, 0);
    nv::k_gemm<false><<<dim3(1024 / 64, M / 64, NEXP), 256, 0, stream>>>(nv::RowSlots{HB, CNT}, nv::EpiDown{out, YS1, YS2, YS3, b_down, LIST, GATE, CNT}, w_down, (size_t)1024 * 1024, 1024, 1024, 0, 0);
    nv::k_final<<<M, 256, 0, stream>>>(out, YS1, YS2, YS3, ln2g, ln2b);
}
```

```cpp
#define FAST_MASK 0x7ff
#include <hip/hip_runtime.h>
#include <hip/hip_bf16.h>
#include <cstdio>
#include <cstdint>
#include <cmath>

#define GAS __attribute__((address_space(1)))
#define LAS __attribute__((address_space(3)))
typedef unsigned short bf16;
typedef unsigned v4u __attribute__((ext_vector_type(4)));
typedef float f32x4 __attribute__((ext_vector_type(4)));
typedef short bf16x8 __attribute__((ext_vector_type(8)));
typedef GAS unsigned gu32;
typedef GAS unsigned long long gu64;
#define RLX_AGENT __ATOMIC_RELAXED, __HIP_MEMORY_SCOPE_AGENT
#define LDS_WAIT() asm volatile("s_waitcnt lgkmcnt(0)" ::: "memory")
#define VM_WAIT() asm volatile("s_waitcnt vmcnt(0)" ::: "memory")
__device__ __forceinline__ unsigned f2bf(float f) { unsigned u = __builtin_bit_cast(unsigned, f); return (u + 0x7fffu + ((u >> 16) & 1u)) >> 16; }
__device__ __forceinline__ unsigned pk2(float lo, float hi) { return f2bf(lo) | (f2bf(hi) << 16); }

constexpr int BATCH = 16, SEQ = 4096, D = 1024, M = BATCH * SEQ;
constexpr int NEXP = 32, TOPK = 4, NASSIGN = M * TOPK, FF = 1024, PLE = 256;
constexpr float LN_EPS = 1e-5f;
constexpr float ALPHA = 1.189207115002721f;
constexpr float C2Q = 0.125f * 1.4426950408889634f;

constexpr size_t MiB = 1u << 20;
constexpr size_t WS_CTL = 0, CTL_ZERO_BYTES = 1 * MiB;
constexpr size_t WS_LIST = 1 * MiB;
constexpr size_t WS_GATEL = 9 * MiB;
constexpr size_t WS_GATE = 17 * MiB;
constexpr size_t WS_WPCF = 18 * MiB;
constexpr size_t WS_WIN = 20 * MiB, WS_WA = 28 * MiB, WS_WPC = 29 * MiB, WS_WOUT = 30 * MiB, WS_WPG = 32 * MiB, WS_WPP = 34 * MiB;
constexpr size_t WS_WDN = 36 * MiB, WS_WUP = 100 * MiB;
constexpr size_t WS_XB = 228 * MiB;
constexpr size_t WS_OA = 228 * MiB, WS_PO = 292 * MiB;
constexpr size_t WS_X1B = 228 * MiB;
constexpr size_t WS_Q = 356 * MiB, WS_K = 420 * MiB, WS_V = 484 * MiB, WS_U = 548 * MiB;
constexpr size_t WS_G = 612 * MiB;
constexpr size_t WS_O16 = 868 * MiB;
constexpr size_t WS_PB = 868 * MiB;
constexpr size_t WS_MIX = 356 * MiB;
constexpr size_t WS_T = 356 * MiB;
constexpr size_t WS_HB = 356 * MiB;
constexpr size_t WS_YS1 = 100 * MiB, WS_YS2 = 228 * MiB, WS_YS3 = 868 * MiB;
constexpr size_t WS_END = 1024 * MiB;
constexpr int CW_TMO = 0, CW_CODE = 1;
constexpr int CW_CNT = 64;
constexpr int CW_BAR = 4096;
namespace nv {
__device__ __forceinline__ float bf2f(bf16 b) { return __builtin_bit_cast(float, (unsigned)b << 16); }
__device__ __forceinline__ bf16 f2b(float f) { return (bf16)f2bf(f); }
__device__ __forceinline__ float sigm(float v) { return 1.f / (1.f + __expf(-v)); }

__global__ void k_zero_ctl(unsigned* p, int n) { int i = blockIdx.x * blockDim.x + threadIdx.x; if (i < n) p[i] = 0u; }
__global__ void k_cvt_bf16(const float* in, bf16* out, size_t n4) {
    size_t i = (size_t)blockIdx.x * blockDim.x + threadIdx.x; const size_t st = (size_t)gridDim.x * blockDim.x;
    for (; i < n4; i += st) { const f32x4 v = ((const f32x4*)in)[i]; unsigned long long o = (unsigned long long)pk2(v.x, v.y) | ((unsigned long long)pk2(v.z, v.w) << 32); ((unsigned long long*)out)[i] = o; }
}
__global__ void k_fold_pool(const float* wmix, const float* scale, const float* wpb, float* Wpc) {
    const int row = blockIdx.x, g = row >> 7, c = row & 127;
    __shared__ float wm[128];
    if (threadIdx.x < 128) wm[threadIdx.x] = wmix[(g * 128 + c) * 128 + threadIdx.x] * scale[g * 128 + threadIdx.x];
    __syncthreads();
    for (int n = threadIdx.x; n < 1024; n += 256) { float s = 0.f; for (int d = 0; d < 128; ++d) s += wm[d] * wpb[(size_t)(g * 128 + d) * 1024 + n]; Wpc[(size_t)row * 1024 + n] = s; }
}

template <bool DUAL, class RowF, class Epi>
__global__ void __launch_bounds__(256) k_gemm(RowF rf, Epi epi, const float* W, size_t wz, int ldw, int K, int dualoff, int pad_) {
    __shared__ float As[16][68]; __shared__ float Bs[16][64]; __shared__ float Bs2[DUAL ? 16 : 1][64];
    const int tid = threadIdx.x, ty = tid >> 4, tx = tid & 15, z = blockIdx.z;
    const int row0 = blockIdx.y * 64, col0 = blockIdx.x * 64;
    if (!rf.active(z, row0)) return;
    const float* Wz = W + (size_t)z * wz;
    float acc[4][4] = {}, acc2[4][4] = {};
    const int ar = tid >> 2, ak = (tid & 3) * 4; const bf16* arow = rf.row(z, row0 + ar);
    const int bk = tid >> 4, bc = (tid & 15) * 4;
    for (int k0 = 0; k0 < K; k0 += 16) {
        { const unsigned long long v = arow ? *(const unsigned long long*)(arow + k0 + ak) : 0ull;
          As[ak + 0][ar] = bf2f((bf16)(v & 0xffff)); As[ak + 1][ar] = bf2f((bf16)((v >> 16) & 0xffff)); As[ak + 2][ar] = bf2f((bf16)((v >> 32) & 0xffff)); As[ak + 3][ar] = bf2f((bf16)(v >> 48)); }
        { const f32x4 v = *(const f32x4*)(Wz + (size_t)(k0 + bk) * ldw + col0 + bc); Bs[bk][bc] = v.x; Bs[bk][bc + 1] = v.y; Bs[bk][bc + 2] = v.z; Bs[bk][bc + 3] = v.w;
          if (DUAL) { const f32x4 w = *(const f32x4*)(Wz + (size_t)(k0 + bk) * ldw + dualoff + col0 + bc); Bs2[bk][bc] = w.x; Bs2[bk][bc + 1] = w.y; Bs2[bk][bc + 2] = w.z; Bs2[bk][bc + 3] = w.w; } }
        __syncthreads();
#pragma unroll
        for (int k = 0; k < 16; ++k) { float a[4], b[4], b2[4];
#pragma unroll
            for (int i = 0; i < 4; ++i) { a[i] = As[k][ty * 4 + i]; b[i] = Bs[k][tx * 4 + i]; b2[i] = DUAL ? Bs2[k][tx * 4 + i] : 0.f; }
#pragma unroll
            for (int i = 0; i < 4; ++i)
#pragma unroll
                for (int j = 0; j < 4; ++j) { acc[i][j] += a[i] * b[j]; if (DUAL) acc2[i][j] += a[i] * b2[j]; } }
        __syncthreads();
    }
#pragma unroll
    for (int i = 0; i < 4; ++i)
#pragma unroll
        for (int j = 0; j < 4; ++j) epi(z, row0 + ty * 4 + i, col0 + tx * 4 + j, acc[i][j], acc2[i][j]);
}
struct RowDense { const bf16* A; int lda; int pad; __device__ bool active(int, int) const { return true; } __device__ const bf16* row(int, int r) const { return A + (size_t)r * lda; } };

struct EpiProj { bf16 *Q, *K, *V, *U, *G; const float* bg; float c2; int pad;
    __device__ void operator()(int, int r, int c, float v, float) const {
        if (c < 512) Q[(size_t)r * 512 + c] = f2b(v * c2); else if (c < 1024) K[(size_t)r * 512 + c - 512] = f2b(v); else if (c < 1536) V[(size_t)r * 512 + c - 1024] = f2b(v);
        else if (c < 2048) U[(size_t)r * 512 + c - 1536] = f2b(v); else G[(size_t)r * 2048 + c - 2048] = f2b(sigm(v + bg[c - 2048])); } };
struct EpiMixA { bf16* MIX; const bf16* G; __device__ void operator()(int, int r, int c, float v, float) const { MIX[(size_t)r * 1024 + c] = f2b(bf2f(G[(size_t)r * 2048 + c]) * v); } };
struct EpiMixB { bf16* MIX; const bf16* G; __device__ void operator()(int, int r, int c, float v, float) const { MIX[(size_t)r * 1024 + c] = f2b(bf2f(MIX[(size_t)r * 1024 + c]) + bf2f(G[(size_t)r * 2048 + 1024 + c]) * v); } };
struct EpiPre1 { float* out; const float* x; float alpha; int pad; __device__ void operator()(int, int r, int c, float v, float) const { out[(size_t)r * 1024 + c] = alpha * x[(size_t)r * 1024 + c] + v; } };
struct EpiStoreF32 { float* T; __device__ void operator()(int, int r, int c, float v, float) const { T[(size_t)r * 1024 + c] = v; } };
struct EpiBase { float* base; const float* T; float alpha; int pad; __device__ void operator()(int, int r, int c, float v, float) const { const size_t i = (size_t)r * 1024 + c; base[i] = alpha * base[i] + sigm(v) * T[i]; } };

__global__ void __launch_bounds__(256) k_attn(const bf16* Q, const bf16* K, const bf16* V, bf16* O16) {
    __shared__ float Ks[64][64]; __shared__ float Vs[64][64];
    const int qb = blockIdx.x, vh = blockIdx.y, b = blockIdx.z, tid = threadIdx.x;
    const int hm = vh >> 1, half = vh & 1, h = hm >> 1;
    const float c2 = exp2f(-2.f * (h + 1)) * 1.4426950408889634f;
    const int i = qb * 256 + tid; const size_t rowb = (size_t)b * SEQ;
    float q[64], acc[64];
    { const bf16* qp = Q + (rowb + i) * 512 + hm * 64;
#pragma unroll
      for (int d = 0; d < 64; ++d) { q[d] = bf2f(qp[d]); acc[d] = 0.f; } }
    float m = -INFINITY, l = 0.f;
    const int ntile = (qb * 256 + 256) / 64;
    for (int t = 0; t < ntile; ++t) {
        __syncthreads();
        for (int e = tid; e < 64 * 64; e += 256) { const int j = e >> 6, d = e & 63; const size_t r = rowb + t * 64 + j;
            Ks[j][d] = bf2f(K[r * 512 + hm * 64 + d]); Vs[j][d] = bf2f(V[r * 512 + h * 128 + half * 64 + d]); }
        __syncthreads();
        for (int j = 0; j < 64; ++j) { const int jj = t * 64 + j; if (jj > i) break;
            float s = 0.f;
#pragma unroll
            for (int d = 0; d < 64; ++d) s += q[d] * Ks[j][d];
            s -= c2 * (float)(i - jj);
            if (s > m) { const float f = exp2f(m - s); l *= f;
#pragma unroll
                for (int d = 0; d < 64; ++d) acc[d] *= f;
                m = s; }
            const float p = exp2f(s - m); l += p;
#pragma unroll
            for (int d = 0; d < 64; ++d) acc[d] += p * Vs[j][d]; }
    }
    const float rl = 1.f / l; bf16* op = O16 + (rowb + i) * 1024 + h * 256 + (hm & 1) * 128 + half * 64;
#pragma unroll
    for (int d = 0; d < 64; ++d) op[d] = f2b(acc[d] * rl);
}
__device__ __forceinline__ float lam_value(const float* lq1, const float* lk1, const float* lq2, const float* lk2) {
    float a = 0.f, b = 0.f; for (int d = 0; d < 64; ++d) { a += lq1[d] * lk1[d]; b += lq2[d] * lk2[d]; } return __expf(a) - __expf(b) + 0.2f; }
__global__ void __launch_bounds__(256) k_combine(const bf16* O16, bf16* OA, const float* lq1, const float* lk1, const float* lq2, const float* lk2, const float* sg) {
    const float lam = lam_value(lq1, lk1, lq2, lk2);
    const int row = blockIdx.x * 4 + (threadIdx.x >> 6), lane = threadIdx.x & 63, h = lane >> 4, e0 = (lane & 15) * 8;
    const bf16* a = O16 + (size_t)row * 1024 + h * 256 + e0; const bf16* bb = a + 128;
    float o[8], ss = 0.f;
#pragma unroll
    for (int j = 0; j < 8; ++j) { o[j] = bf2f(a[j]) - lam * bf2f(bb[j]); ss += o[j] * o[j]; }
    ss += __shfl_xor(ss, 1); ss += __shfl_xor(ss, 2); ss += __shfl_xor(ss, 4); ss += __shfl_xor(ss, 8);
    const float r = rsqrtf(ss * (1.f / 128.f) + LN_EPS) * 0.8f;
#pragma unroll
    for (int j = 0; j < 8; ++j) OA[(size_t)row * 512 + h * 128 + e0 + j] = f2b(o[j] * r * sg[e0 + j]);
}
__global__ void __launch_bounds__(256) k_pool(const bf16* U, bf16* PO) {
    const size_t idx = (size_t)blockIdx.x * 256 + threadIdx.x; const int c = (int)(idx & 511); const size_t row = idx >> 9; const int pos = (int)(row & (SEQ - 1));
    const int w = 2 << (c >> 7); const int n = pos + 1 < w ? pos + 1 : w; float s = 0.f;
    for (int k = 0; k < n; ++k) s += bf2f(U[(row - k) * 512 + c]);
    PO[row * 512 + c] = f2b(s / (float)n - bf2f(U[row * 512 + c]));
}
__global__ void __launch_bounds__(256) k_ln1_route(float* X1, bf16* X1B, const float* g, const float* bta, const float* wr, const float* br, unsigned* CNT, int* LIST, float* GATE, float* GATEL) {
    __shared__ float xs[1024]; __shared__ float red[8]; __shared__ float part[8][32]; __shared__ float lg[32];
    const int row = blockIdx.x, tid = threadIdx.x, lane = tid & 63, wv = tid >> 6;
    f32x4 v = ((const f32x4*)(X1 + (size_t)row * 1024))[tid];
    float s = (v.x + v.y) + (v.z + v.w); for (int o = 1; o < 64; o <<= 1) s += __shfl_xor(s, o);
    if (lane == 0) red[wv] = s; __syncthreads(); const float mean = (red[0] + red[1] + red[2] + red[3]) * (1.f / 1024.f); __syncthreads();
    v = v - mean; float q = (v.x * v.x + v.y * v.y) + (v.z * v.z + v.w * v.w); for (int o = 1; o < 64; o <<= 1) q += __shfl_xor(q, o);
    if (lane == 0) red[wv] = q; __syncthreads(); const float rstd = rsqrtf((red[0] + red[1] + red[2] + red[3]) * (1.f / 1024.f) + LN_EPS);
    const f32x4 gg = ((const f32x4*)g)[tid], bb = ((const f32x4*)bta)[tid]; v = v * rstd * gg + bb;
    ((f32x4*)(X1 + (size_t)row * 1024))[tid] = v; ((unsigned long long*)(X1B + (size_t)row * 1024))[tid] = (unsigned long long)pk2(v.x, v.y) | ((unsigned long long)pk2(v.z, v.w) << 32);
    xs[tid * 4] = v.x; xs[tid * 4 + 1] = v.y; xs[tid * 4 + 2] = v.z; xs[tid * 4 + 3] = v.w; __syncthreads();
    { const int e = tid & 31, pt = tid >> 5; float a = 0.f; for (int k = pt * 128; k < pt * 128 + 128; ++k) a += xs[k] * wr[k * 32 + e]; part[pt][e] = a; }
    __syncthreads();
    if (tid < 32) { float a = br[tid]; for (int pt = 0; pt < 8; ++pt) a += part[pt][tid]; lg[tid] = a; }
    __syncthreads();
    if (tid == 0) { int id[4]; float vv[4]; unsigned used = 0u;
        for (int k = 0; k < 4; ++k) { int bi = 0; float bv = -INFINITY; for (int e = 0; e < 32; ++e) if (!((used >> e) & 1u) && lg[e] > bv) { bv = lg[e]; bi = e; } used |= 1u << bi; id[k] = bi; vv[k] = bv; }
        float es[4], sum = 0.f; for (int k = 0; k < 4; ++k) { es[k] = __expf(vv[k] - vv[0]); sum += es[k]; }
        for (int k = 0; k < 4; ++k) { const unsigned pos = atomicAdd(&CNT[id[k]], 1u); LIST[(size_t)id[k] * 65536 + pos] = row * 4 + k; GATEL[(size_t)id[k] * 65536 + pos] = es[k] / sum; GATE[row * 4 + k] = es[k] / sum; } }
}
struct RowGather { const bf16* X1B; const int* LIST; const unsigned* CNT;
    __device__ bool active(int e, int row0) const { return (unsigned)row0 < CNT[e]; }
    __device__ const bf16* row(int e, int r) const { return (unsigned)r < CNT[e] ? X1B + (size_t)(LIST[(size_t)e * 65536 + r] >> 2) * 1024 : nullptr; } };
__device__ __forceinline__ unsigned slot_off(const unsigned* CNT, int e) { unsigned o = 0; for (int i = 0; i < e; ++i) o += CNT[i]; return o; }
struct EpiUp { bf16* HB; const float* bup; const unsigned* CNT;
    __device__ void operator()(int e, int r, int c, float glu, float lin) const { if ((unsigned)r >= CNT[e]) return;
        glu += bup[e * 2048 + c]; lin += bup[e * 2048 + 1024 + c]; glu = fminf(glu, 7.f); lin = fminf(fmaxf(lin, -7.f), 7.f);
        HB[(size_t)(slot_off(CNT, e) + r) * 1024 + c] = f2b(glu * sigm(1.702f * glu) * (lin + 1.f)); } };
struct RowSlots { const bf16* HB; const unsigned* CNT;
    __device__ bool active(int e, int row0) const { return (unsigned)row0 < CNT[e]; }
    __device__ const bf16* row(int e, int r) const { return (unsigned)r < CNT[e] ? HB + (size_t)(slot_off(CNT, e) + r) * 1024 : nullptr; } };
struct EpiDown { float* base; bf16* YS1; bf16* YS2; bf16* YS3; const float* bdn; const int* LIST; const float* GATE; const unsigned* CNT;
    __device__ void operator()(int e, int r, int c, float v, float) const { if ((unsigned)r >= CNT[e]) return;
        const int a = LIST[(size_t)e * 65536 + r], tok = a >> 2, k = a & 3; const float y = (v + bdn[e * 1024 + c]) * GATE[a]; const size_t i = (size_t)tok * 1024 + c;
        if (k == 0) base[i] += y; else if (k == 1) YS1[i] = f2b(y); else if (k == 2) YS2[i] = f2b(y); else YS3[i] = f2b(y); } };
__global__ void __launch_bounds__(256) k_final(float* out, const bf16* YS1, const bf16* YS2, const bf16* YS3, const float* g, const float* bta) {
    __shared__ float red[8]; const int row = blockIdx.x, tid = threadIdx.x, lane = tid & 63, wv = tid >> 6; const size_t i0 = (size_t)row * 1024 + tid * 4;
    f32x4 v = *(const f32x4*)(out + i0);
    const bf16* ys[3] = {YS1, YS2, YS3};
    for (int k = 0; k < 3; ++k) { const unsigned long long w = *(const unsigned long long*)(ys[k] + i0); v.x += bf2f((bf16)(w & 0xffff)); v.y += bf2f((bf16)((w >> 16) & 0xffff)); v.z += bf2f((bf16)((w >> 32) & 0xffff)); v.w += bf2f((bf16)(w >> 48)); }
    float s = (v.x + v.y) + (v.z + v.w); for (int o = 1; o < 64; o <<= 1) s += __shfl_xor(s, o);
    if (lane == 0) red[wv] = s; __syncthreads(); const float mean = (red[0] + red[1] + red[2] + red[3]) * (1.f / 1024.f); __syncthreads();
    v = v - mean; float q = (v.x * v.x + v.y * v.y) + (v.z * v.z + v.w * v.w); for (int o = 1; o < 64; o <<= 1) q += __shfl_xor(q, o);
    if (lane == 0) red[wv] = q; __syncthreads(); const float rstd = rsqrtf((red[0] + red[1] + red[2] + red[3]) * (1.f / 1024.f) + LN_EPS);
    const f32x4 gg = ((const f32x4*)g)[tid], bb = ((const f32x4*)bta)[tid]; *(f32x4*)(out + i0) = v * rstd * gg + bb;
}
}
namespace pg8 {
#define PG8_LAS __attribute__((address_space(3)))
typedef unsigned short bf16_t;
typedef unsigned u32x4 __attribute__((ext_vector_type(4)));
typedef float f32x2 __attribute__((ext_vector_type(2)));
constexpr int BM = 256, BK = 64, HALF = 128, HTB = HALF * BK * 2  , STAGE_BYTES = 8 * HTB, NXCD = 8, WGM = 8;
constexpr int TAB_OFF = 131072 + 1024;
constexpr int TAB_CNT = TAB_OFF, TAB_BLK0 = TAB_OFF + 128, TAB_ROW0 = TAB_OFF + 384, TAB_IDS = TAB_OFF + 1024, TAB_GATES = TAB_OFF + 1024 + 2048;

__host__ __device__ __forceinline__ int lds_byte(int r, int c) { const int st = (r >> 4) * 2 + (c >> 5), rr = r & 15, cc = c & 31, ob = rr * 64 + cc * 2; return st * 1024 + (ob ^ (((ob >> 9) & 1) << 5)); }
__host__ __device__ __forceinline__ void stage_rc(int b, int& R, int& C) { const int st = b / 1024, sb = b % 1024, swz = sb ^ (((sb >> 9) & 1) << 5); R = (st >> 1) * 16 + swz / 64; C = (st & 1) * 32 + (swz % 64) / 2; }
__host__ __device__ __forceinline__ int perm32(int rho) { const int n = rho >> 4, i = rho & 15; return 8 * (i >> 2) + 4 * n + (i & 3); }

struct Unit { int pm, pn, e, nvalid; };
struct Gemm { const bf16_t* A; const bf16_t* Bt; int K; };

struct StaticOrder {
    static constexpr bool TABLES = false;
    int nM, nN, nwg, G, c;
    __host__ __device__ void init(int M, int N, int G_, int c_) { nM = M / BM; nN = N / BM; nwg = nM * nN; G = G_; c = c_; }
    __device__ __forceinline__ bool next(int i, Unit& u, PG8_LAS unsigned char*) const {
        const long L = (long)i * G + c; if (L >= nwg) return false;
        int wgid = (int)L; { const int q = nwg / NXCD, r = nwg % NXCD, xcd = wgid % NXCD, off = wgid / NXCD; wgid = (xcd < r ? xcd * (q + 1) : r * (q + 1) + (xcd - r) * q) + off; }
        const int nig = WGM * nN, gid = wgid / nig, fm = gid * WGM, gsz = (nM - fm) < WGM ? (nM - fm) : WGM;
        u.pm = fm + ((wgid % nig) % gsz); u.pn = (wgid % nig) / gsz; u.e = 0; u.nvalid = 256; return true;
    }
    __device__ __forceinline__ const char* b_tile(const Gemm& g, const Unit& u) const { return (const char*)g.Bt + (size_t)u.pn * (size_t)(BM * 2) * g.K; }
    __device__ __forceinline__ void a_offsets(const Gemm& g, const Unit& u, PG8_LAS unsigned char*, int, const int (&R)[2], const int (&C)[2], unsigned (&off)[2][2]) const {
#pragma unroll
        for (int h = 0; h < 2; ++h)
#pragma unroll
            for (int i = 0; i < 2; ++i) off[h][i] = (unsigned)(((u.pm * BM + h * HALF + R[i]) * g.K + C[i]) * 2);
    }
    __device__ __forceinline__ void issue_tables(const Unit&, PG8_LAS unsigned char*, int, int) const {}
};

template <bool GATHER_> struct MoeOrder {
    static constexpr bool TABLES = true; static constexpr bool GATHER = GATHER_;
    int NT, G, c; const int* LIST; const float* GATEL; size_t bstride;
    __device__ __forceinline__ bool next(int i, Unit& u, PG8_LAS unsigned char* lds) const {
        const PG8_LAS int* cnt = (const PG8_LAS int*)(lds + TAB_CNT); const PG8_LAS int* blk0 = (const PG8_LAS int*)(lds + TAB_BLK0);
        const int L = i * G + c; const int total = blk0[32] * NT; if (L >= total) return false;
        const int blk = L / NT; int e = 0;
#pragma unroll 1
        for (int j = 1; j < 32; ++j) e += (blk >= blk0[j]) ? 1 : 0;
        e = __builtin_amdgcn_readfirstlane(e);
        u.e = e; u.pm = __builtin_amdgcn_readfirstlane(blk - blk0[e]); u.pn = L % NT; const int left = __builtin_amdgcn_readfirstlane(cnt[e]) - 256 * u.pm; u.nvalid = left < 256 ? left : 256; return true;
    }
    __device__ __forceinline__ const char* b_tile(const Gemm& g, const Unit& u) const { return (const char*)g.Bt + (size_t)u.e * bstride + (size_t)u.pn * (size_t)(BM * 2) * g.K; }
    __device__ __forceinline__ void a_offsets(const Gemm& g, const Unit& u, PG8_LAS unsigned char* lds, int buf, const int (&R)[2], const int (&C)[2], unsigned (&off)[2][2]) const {
        const PG8_LAS int* ids = (const PG8_LAS int*)(lds + TAB_IDS) + buf * 256; const PG8_LAS int* row0 = (const PG8_LAS int*)(lds + TAB_ROW0);
#pragma unroll
        for (int h = 0; h < 2; ++h)
#pragma unroll
            for (int i = 0; i < 2; ++i) { const int r = h * HALF + R[i];
                if (GATHER) { const int tok = (r < u.nvalid) ? (ids[r] >> 2) : 0; off[h][i] = (unsigned)((tok * g.K + C[i]) * 2); }
                else off[h][i] = (unsigned)(((row0[u.e] + u.pm * BM + r) * g.K + C[i]) * 2); }
    }
    __device__ __forceinline__ void issue_tables(const Unit& u, PG8_LAS unsigned char* lds, int buf, int lane) const {
        const size_t o = (size_t)u.e * 65536 + (size_t)u.pm * 256 + lane * 4;
        __builtin_amdgcn_global_load_lds((const unsigned*)(LIST + o), (PG8_LAS unsigned*)(lds + TAB_IDS + buf * 1024), 16, 0, 0);
        if (!GATHER) __builtin_amdgcn_global_load_lds((const unsigned*)(GATEL + o), (PG8_LAS unsigned*)(lds + TAB_GATES + buf * 1024), 16, 0, 0);
    }
};

__device__ __forceinline__ unsigned cvt_pk_bf16(float lo, float hi) { unsigned r; asm volatile("v_cvt_pk_bf16_f32 %0, %1, %2" : "=v"(r) : "v"(lo), "v"(hi)); return r; }
__device__ __forceinline__ float bflo(unsigned w) { return __builtin_bit_cast(float, w << 16); }
__device__ __forceinline__ float bfhi(unsigned w) { return __builtin_bit_cast(float, w & 0xffff0000u); }
__device__ __forceinline__ float sigm(float v) { return __builtin_amdgcn_rcpf(1.f + __builtin_amdgcn_exp2f(-1.4426950408889634f * v)); }
__device__ __forceinline__ u32x4 pack8(const f32x4& v0, const f32x4& v1) { u32x4 w; w.x = cvt_pk_bf16(v0[0], v0[1]); w.y = cvt_pk_bf16(v0[2], v0[3]); w.z = cvt_pk_bf16(v1[0], v1[1]); w.w = cvt_pk_bf16(v1[2], v1[3]); return w; }
__device__ __forceinline__ void unpack8(const u32x4& w, f32x4& v0, f32x4& v1) { v0 = (f32x4){bflo(w.x), bfhi(w.x), bflo(w.y), bfhi(w.y)}; v1 = (f32x4){bflo(w.z), bfhi(w.z), bflo(w.w), bfhi(w.w)}; }
typedef f32x4 Acc[2][2][4][2];

struct EpiProj {
    static constexpr bool PERM = true;
    bf16_t *Q, *K, *V, *U, *G; const float* bg; float c2; int pad;
    __device__ __forceinline__ void operator()(const Acc& acc, const Unit& u, int wr, int wc, int fr, int fq, PG8_LAS unsigned char*, int) const {
        const int row0 = u.pm * BM + wr * 64 + fr; const bool isg = u.pn >= 8;
        bf16_t* base; int ldc, colt; float sc = 1.f;
        if (isg) { base = G; ldc = 2048; colt = (u.pn - 8) * BM; } else { const int t = u.pn >> 1; base = t == 0 ? Q : t == 1 ? K : t == 2 ? V : U; ldc = 512; colt = (u.pn & 1) * BM; if (t == 0) sc = c2; }
        const int col0 = colt + wc * 32 + 8 * fq;
        f32x4 bv[2][2];
#pragma unroll
        for (int bj = 0; bj < 2; ++bj)
#pragma unroll
            for (int n = 0; n < 2; ++n) bv[bj][n] = isg ? *(const f32x4*)(bg + col0 + bj * HALF + 4 * n) : (f32x4){0.f, 0.f, 0.f, 0.f};
#pragma unroll
        for (int ai = 0; ai < 2; ++ai)
#pragma unroll
            for (int m = 0; m < 4; ++m) { bf16_t* rowp = base + (size_t)(row0 + ai * HALF + m * 16) * ldc + col0;
#pragma unroll
                for (int bj = 0; bj < 2; ++bj) { f32x4 v0 = acc[ai][bj][m][0] + bv[bj][0], v1 = acc[ai][bj][m][1] + bv[bj][1];
                    if (isg) {
#pragma unroll
                        for (int i = 0; i < 4; ++i) { v0[i] = sigm(v0[i]); v1[i] = sigm(v1[i]); } }
                    v0 = v0 * sc; v1 = v1 * sc; *(u32x4*)(rowp + bj * HALF) = pack8(v0, v1); } }
    }
};
template <bool ADD> struct EpiMix {
    static constexpr bool PERM = true;
    bf16_t* MIX; const bf16_t* G;
    __device__ __forceinline__ void operator()(const Acc& acc, const Unit& u, int wr, int wc, int fr, int fq, PG8_LAS unsigned char*, int) const {
        const int row0 = u.pm * BM + wr * 64 + fr, col0 = u.pn * BM + wc * 32 + 8 * fq;
#pragma unroll
        for (int ai = 0; ai < 2; ++ai)
#pragma unroll
            for (int m = 0; m < 4; ++m) { const size_t r = (size_t)(row0 + ai * HALF + m * 16);
#pragma unroll
                for (int bj = 0; bj < 2; ++bj) { const int c = col0 + bj * HALF;
                    const u32x4 gw = *(const u32x4*)(G + r * 2048 + (ADD ? 1024 : 0) + c); f32x4 g0, g1; unpack8(gw, g0, g1);
                    f32x4 v0 = acc[ai][bj][m][0] * g0, v1 = acc[ai][bj][m][1] * g1;
                    if (ADD) { const u32x4 pw = *(const u32x4*)(MIX + r * 1024 + c); f32x4 p0, p1; unpack8(pw, p0, p1); v0 += p0; v1 += p1; }
                    *(u32x4*)(MIX + r * 1024 + c) = pack8(v0, v1); } }
    }
};
template <int MODE> struct EpiF32 {
    static constexpr bool PERM = false;
    float* out; const float* aux; float alpha; int pad;
    __device__ __forceinline__ void operator()(const Acc& acc, const Unit& u, int wr, int wc, int fr, int fq, PG8_LAS unsigned char*, int) const {
        const int col0 = u.pn * BM + wc * 32 + 4 * fq;
#pragma unroll
        for (int ai = 0; ai < 2; ++ai)
#pragma unroll
            for (int m = 0; m < 4; ++m) { const size_t off = (size_t)(u.pm * BM + ai * HALF + wr * 64 + m * 16 + fr) * 1024 + col0;
#pragma unroll
                for (int bj = 0; bj < 2; ++bj)
#pragma unroll
                    for (int n = 0; n < 2; ++n) { const size_t o = off + bj * HALF + n * 16; const f32x4 a = acc[ai][bj][m][n]; f32x4 r;
                        if (MODE == 0) r = *(const f32x4*)(aux + o) * alpha + a;
                        else if (MODE == 1) r = a;
                        else { const f32x4 t = *(const f32x4*)(aux + o), b = *(const f32x4*)(out + o); r = b * alpha;
#pragma unroll
                            for (int i = 0; i < 4; ++i) r[i] += sigm(a[i]) * t[i]; }
                        *(f32x4*)(out + o) = r; }
                if (MODE == 2 || (m & 1)) asm volatile("" ::: "memory"); }
    }
};
struct EpiUp {
    static constexpr bool PERM = true;
    bf16_t* HB; const float* bup;
    __device__ __forceinline__ void operator()(const Acc& acc, const Unit& u, int wr, int wc, int fr, int fq, PG8_LAS unsigned char* lds, int) const {
        const PG8_LAS int* row0t = (const PG8_LAS int*)(lds + TAB_ROW0); const int srow = row0t[u.e] + u.pm * BM;
        const int c0 = u.pn * HALF + wc * 32 + 8 * fq; const float* bp = bup + (size_t)u.e * 2048 + c0;
        const f32x4 bg0 = *(const f32x4*)(bp), bg1 = *(const f32x4*)(bp + 4), bl0 = *(const f32x4*)(bp + 1024), bl1 = *(const f32x4*)(bp + 1028);
#pragma unroll
        for (int ai = 0; ai < 2; ++ai)
#pragma unroll
            for (int m = 0; m < 4; ++m) { const int r = ai * HALF + wr * 64 + m * 16 + fr;
                f32x4 g0 = acc[ai][0][m][0] + bg0, g1 = acc[ai][0][m][1] + bg1, l0 = acc[ai][1][m][0] + bl0, l1 = acc[ai][1][m][1] + bl1;
#pragma unroll
                for (int i = 0; i < 4; ++i) { float a = fminf(g0[i], 7.f), b = fminf(fmaxf(l0[i], -7.f), 7.f); g0[i] = a * sigm(1.702f * a) * (b + 1.f);
                                              a = fminf(g1[i], 7.f); b = fminf(fmaxf(l1[i], -7.f), 7.f); g1[i] = a * sigm(1.702f * a) * (b + 1.f); }
                if (r < u.nvalid) *(u32x4*)(HB + (size_t)(srow + r) * 1024 + c0) = pack8(g0, g1); }
    }
};
struct EpiDown {
    static constexpr bool PERM = true;
    float* base; bf16_t* YS1; bf16_t* YS2; bf16_t* YS3; const float* bdn;
    __device__ __forceinline__ void operator()(const Acc& acc, const Unit& u, int wr, int wc, int fr, int fq, PG8_LAS unsigned char* lds, int buf) const {
        const PG8_LAS int* ids = (const PG8_LAS int*)(lds + TAB_IDS) + buf * 256; const PG8_LAS float* gates = (const PG8_LAS float*)(lds + TAB_GATES) + buf * 256;
        const int col0 = u.pn * BM + wc * 32 + 8 * fq; const float* bp = bdn + (size_t)u.e * 1024 + col0;
        f32x4 bv[2][2];
#pragma unroll
        for (int bj = 0; bj < 2; ++bj)
#pragma unroll
            for (int n = 0; n < 2; ++n) bv[bj][n] = *(const f32x4*)(bp + bj * HALF + 4 * n);
#pragma unroll
        for (int ai = 0; ai < 2; ++ai)
#pragma unroll
            for (int m = 0; m < 4; ++m) { const int r = ai * HALF + wr * 64 + m * 16 + fr;
                if (r < u.nvalid) { const int a = ids[r]; const float gt = gates[r]; const int k = a & 3; const size_t o = (size_t)(a >> 2) * 1024 + col0;
#pragma unroll
                    for (int bj = 0; bj < 2; ++bj) { const f32x4 v0 = (acc[ai][bj][m][0] + bv[bj][0]) * gt, v1 = (acc[ai][bj][m][1] + bv[bj][1]) * gt; const size_t oo = o + bj * HALF;
                        if (k == 0) { *(f32x4*)(base + oo) += v0; *(f32x4*)(base + oo + 4) += v1; }
                        else { bf16_t* yp = k == 1 ? YS1 : k == 2 ? YS2 : YS3; *(u32x4*)(yp + oo) = pack8(v0, v1); } } } }
    }
};

template <class Epi, class Sched>
__device__ __forceinline__ void gemm_phase(PG8_LAS unsigned char* lds, const Gemm g, const Sched& S, const Epi& E) {
    int tid = threadIdx.x; asm volatile("" : "+v"(tid));
    const int wid = __builtin_amdgcn_readfirstlane(tid >> 6), lane = tid & 63, wr = wid >> 2, wc = wid & 3, fr = lane & 15, fq = lane >> 4;
    const int K = g.K, nt = K / BK;
    int RA[2], CA[2]; unsigned voffA[2], voffB[2];
#pragma unroll
    for (int i = 0; i < 2; ++i) { int R, C; stage_rc(tid * 16 + i * 8192, R, C); const int Rb = Epi::PERM ? ((R & ~31) + perm32(R & 31)) : R; RA[i] = R; CA[i] = C; voffA[i] = (unsigned)(R * K + C) * 2u; voffB[i] = (unsigned)(Rb * K + C) * 2u; }
    const size_t tstep = (size_t)BM * K * 2;
    const size_t kstep = (size_t)(BK * 2);
    const size_t hstep = (size_t)HALF * K * 2;
    const unsigned ldsw = (unsigned)wid * 1024u;
    const int aoff = lds_byte(wr * 64 + fr, fq * 8), boff = lds_byte(wc * 32 + fr, fq * 8);
#define PG8_SA(b, h) (((b) * 2 + (h)) * HTB)
#define PG8_SB(b, h) ((4 + (b) * 2 + (h)) * HTB)
#define PG8_STAGE(bufoff, gbase, voff) do { _Pragma("unroll") for (int _i = 0; _i < 2; ++_i) \
        __builtin_amdgcn_global_load_lds((const unsigned*)((const char*)(gbase) + (voff)[_i]), (PG8_LAS unsigned*)(lds + (bufoff) + ldsw + _i * 8192), 16, 0, 0); } while (0)
#define PG8_STAGE_A(bufoff, ubase, h, OFF) do { if constexpr (Sched::TABLES) PG8_STAGE(bufoff, ubase, OFF[h]); else PG8_STAGE(bufoff, (ubase) + ((h) ? hstep : 0), voffA); } while (0)
#define PG8_LDA(dst, b, h) do { _Pragma("unroll") for (int m = 0; m < 4; ++m) _Pragma("unroll") for (int k = 0; k < 2; ++k) dst[m][k] = *(const PG8_LAS bf16x8*)(lds + PG8_SA(b, h) + aoff + m * 2048 + k * 1024); } while (0)
#define PG8_LDB(dst, b, h) do { _Pragma("unroll") for (int n = 0; n < 2; ++n) _Pragma("unroll") for (int k = 0; k < 2; ++k) dst[n][k] = *(const PG8_LAS bf16x8*)(lds + PG8_SB(b, h) + boff + n * 2048 + k * 1024); } while (0)
#define PG8_MMA(ai, bj, At, Bt) do { __builtin_amdgcn_s_setprio(1); _Pragma("unroll") for (int m = 0; m < 4; ++m) _Pragma("unroll") for (int n = 0; n < 2; ++n) _Pragma("unroll") for (int k = 0; k < 2; ++k) \
        acc[ai][bj][m][n] = __builtin_amdgcn_mfma_f32_16x16x32_bf16(Bt[n][k], At[m][k], acc[ai][bj][m][n], 0, 0, 0); __builtin_amdgcn_s_setprio(0); } while (0)
#define PG8_WAIT_V(n) asm volatile("s_waitcnt vmcnt(" #n ")" ::: "memory")
#define PG8_WAIT_L(n) asm volatile("s_waitcnt lgkmcnt(" #n ")" ::: "memory")
#define PG8_BAR __builtin_amdgcn_s_barrier()
#define PG8_SCHED __builtin_amdgcn_sched_barrier(0)
    Unit cur, nxt; int ui = 0;
    if (!S.next(0, cur, lds)) return;
    if constexpr (Sched::TABLES) {
        if (wid == 0) S.issue_tables(cur, lds, 0, lane);
        PG8_WAIT_V(0); PG8_BAR;
    }
    Acc acc;
#pragma unroll
    for (int a = 0; a < 2; ++a)
#pragma unroll
        for (int b = 0; b < 2; ++b)
#pragma unroll
            for (int m = 0; m < 4; ++m)
#pragma unroll
                for (int n = 0; n < 2; ++n) acc[a][b][m][n] = (f32x4){0.f, 0.f, 0.f, 0.f};
    bf16x8 At[4][2], B0[2][2], B1[2][2];
    unsigned offc[2][2], offn[2][2];
    if constexpr (Sched::TABLES) { S.a_offsets(g, cur, lds, 0, RA, CA, offc);
#pragma unroll
        for (int h = 0; h < 2; ++h)
#pragma unroll
            for (int i = 0; i < 2; ++i) offn[h][i] = offc[h][i]; }
    const char* const Ab = (const char*)g.A;
    const char* cA = Sched::TABLES ? Ab : Ab + (size_t)cur.pm * tstep;
    const char* cB = S.b_tile(g, cur);
    PG8_STAGE(PG8_SB(0, 0), cB, voffB); PG8_STAGE(PG8_SB(0, 1), cB + hstep, voffB); PG8_STAGE_A(PG8_SA(0, 0), cA, 0, offc); PG8_STAGE_A(PG8_SA(0, 1), cA, 1, offc);
    if (wr == 1) PG8_BAR;
    PG8_WAIT_V(2); PG8_BAR;
    PG8_STAGE(PG8_SB(1, 0), cB + kstep, voffB); PG8_STAGE_A(PG8_SA(1, 0), cA + kstep, 0, offc); PG8_STAGE(PG8_SB(1, 1), cB + hstep + kstep, voffB);
    PG8_WAIT_V(6); PG8_BAR;
    for (;;) {
        const bool has_next = S.next(ui + 1, nxt, lds);
        const char* nB = has_next ? S.b_tile(g, nxt) : cB;
        const char* nA = Sched::TABLES ? Ab : (has_next ? Ab + (size_t)nxt.pm * tstep : cA);
        for (int t = 0; t < nt; t += 2) {
            const bool last = (t == nt - 2);
            if constexpr (Sched::TABLES) {
                if (t == 2 && has_next && wid == 0) S.issue_tables(nxt, lds, (ui + 1) & 1, lane);
                if (t == nt - 6 && has_next) S.a_offsets(g, nxt, lds, (ui + 1) & 1, RA, CA, offn);
            }
            unsigned o2[2][2];
            if constexpr (Sched::TABLES) {
#pragma unroll
                for (int h = 0; h < 2; ++h)
#pragma unroll
                    for (int i = 0; i < 2; ++i) o2[h][i] = last ? offn[h][i] : offc[h][i]; }
            const char* a1 = cA + (size_t)(t + 1) * kstep;
            const char* a2 = last ? nA : cA + (size_t)(t + 2) * kstep; const char* b2 = last ? nB : cB + (size_t)(t + 2) * kstep;
            const char* a3 = a2 + kstep; const char* b3 = b2 + kstep;
            PG8_LDB(B0, 0, 0); PG8_LDB(B1, 0, 1); PG8_SCHED; PG8_LDA(At, 0, 0); PG8_STAGE_A(PG8_SA(1, 1), a1, 1, offc);
            PG8_WAIT_V(8); PG8_WAIT_L(0); PG8_BAR; PG8_MMA(0, 0, At, B0); PG8_MMA(0, 1, At, B1); PG8_BAR; PG8_SCHED;
            PG8_LDA(At, 0, 1); PG8_STAGE(PG8_SB(0, 0), b2, voffB); PG8_STAGE(PG8_SB(0, 1), b2 + hstep, voffB); PG8_STAGE_A(PG8_SA(0, 0), a2, 0, o2);
            PG8_WAIT_V(8); PG8_WAIT_L(0); PG8_BAR; PG8_MMA(1, 0, At, B0); PG8_MMA(1, 1, At, B1); PG8_BAR; PG8_SCHED;
            PG8_LDB(B0, 1, 0); PG8_LDB(B1, 1, 1); PG8_SCHED; PG8_LDA(At, 1, 0); PG8_STAGE_A(PG8_SA(0, 1), a2, 1, o2);
            PG8_WAIT_V(8); PG8_WAIT_L(0); PG8_BAR; PG8_MMA(0, 0, At, B0); PG8_MMA(0, 1, At, B1); PG8_BAR; PG8_SCHED;
            PG8_LDA(At, 1, 1); PG8_STAGE(PG8_SB(1, 0), b3, voffB); PG8_STAGE(PG8_SB(1, 1), b3 + hstep, voffB); PG8_STAGE_A(PG8_SA(1, 0), a3, 0, o2);
            PG8_WAIT_V(8); PG8_WAIT_L(0); PG8_BAR; PG8_MMA(1, 0, At, B0); PG8_MMA(1, 1, At, B1); PG8_BAR; PG8_SCHED;
        }
        if (wr == 0) PG8_BAR;
        E(acc, cur, wr, wc, fr, fq, lds, ui & 1);
        if (!has_next) break;
#pragma unroll
        for (int a = 0; a < 2; ++a)
#pragma unroll
            for (int b = 0; b < 2; ++b)
#pragma unroll
                for (int m = 0; m < 4; ++m)
#pragma unroll
                    for (int n = 0; n < 2; ++n) acc[a][b][m][n] = (f32x4){0.f, 0.f, 0.f, 0.f};
        cur = nxt; cB = nB; cA = nA; ++ui;
        if constexpr (Sched::TABLES) {
#pragma unroll
            for (int h = 0; h < 2; ++h)
#pragma unroll
                for (int i = 0; i < 2; ++i) offc[h][i] = offn[h][i]; }
        if (wr == 1) PG8_BAR;
    }
    PG8_WAIT_V(0);
    PG8_BAR;
#undef PG8_SA
#undef PG8_SB
#undef PG8_STAGE
#undef PG8_STAGE_A
#undef PG8_LDA
#undef PG8_LDB
#undef PG8_MMA
#undef PG8_WAIT_V
#undef PG8_WAIT_L
#undef PG8_BAR
#undef PG8_SCHED
}
}
namespace attn_body {
using bf16=__hip_bfloat16;
using bf16x8=__attribute__((ext_vector_type(8)))short;
using s16x4=__attribute__((ext_vector_type(4)))short;
using f32x16=__attribute__((ext_vector_type(16)))float;
using u32x4=__attribute__((ext_vector_type(4)))unsigned;
constexpr int BATCH=16,SEQ=4096,D=64,DM=512,DMO=1024;
constexpr int NW=8,QBLK=32,QB=QBLK*NW,KVBLK=64,NQB=SEQ/QB;
constexpr int ATTN_UNIT_ROWS=QB;
__device__ __forceinline__ int crow(int r,int hi){return (r&3)+8*(r>>2)+4*hi;}
#define SBAR() __builtin_amdgcn_sched_barrier(0)
__device__ __forceinline__ void cmask(f32x16&p0,f32x16&p1,int jb,int qrel,int hi){
  const float NEG=-INFINITY; int kb=64*jb+4*hi; asm volatile("":"+v"(kb));
  #pragma unroll
  for(int r=0;r<16;++r){int kv=kb+(r&3)+8*(r>>2); if(kv>qrel)p0[r]=NEG; if(kv+32>qrel)p1[r]=NEG;}
}

constexpr int NSLOT=3, SLOTB=8192;
constexpr int LDS_K=0, LDS_V=NSLOT*SLOTB, LDS_WS=2*NSLOT*SLOTB, LDS_OST=LDS_WS+NW*64*4, LDS_BYTES=LDS_OST+NW*4096;
constexpr float C2=0.125f*1.4426950408889634f;
__device__ __forceinline__ void glds16(const void*gsrc,unsigned lds_dst){unsigned keep;
  asm volatile("s_mov_b32 %0, m0\n\ts_mov_b32 m0, %2\n\ts_nop 0\n\tglobal_load_lds_dwordx4 %1, off\n\ts_mov_b32 m0, %0":"=&s"(keep):"v"(gsrc),"s"(lds_dst):"memory");}
__device__ __forceinline__ float max3f(float a,float b,float c){float r;asm("v_max3_f32 %0, %1, %2, %3":"=v"(r):"v"(a),"v"(b),"v"(c));return r;}
__device__ __forceinline__ float max2f(float a,float b){float r;asm("v_max_f32_e32 %0, %1, %2":"=v"(r):"v"(a),"v"(b));return r;}
__device__ __forceinline__ float fadd_s(float a,float b){float r;asm("v_add_f32_e32 %0, %1, %2":"=v"(r):"v"(a),"v"(b));return r;}
__device__ __forceinline__ float fsub_s(float a,float b){float r;asm("v_sub_f32_e32 %0, %1, %2":"=v"(r):"v"(a),"v"(b));return r;}
typedef float f32x2_t __attribute__((ext_vector_type(2))); typedef __bf16 bf16x2_t __attribute__((ext_vector_type(2)));
__device__ __forceinline__ unsigned cvtpk_s(float lo,float hi){f32x2_t v={lo,hi};bf16x2_t b=__builtin_convertvector(v,bf16x2_t);return __builtin_bit_cast(unsigned,b);}
#define WAIT_BAR(N) asm volatile("s_waitcnt vmcnt(" #N ") lgkmcnt(0)\n\ts_barrier":::"memory")

__device__ __forceinline__ void qkt(f32x16&p0,f32x16&p1,const char*Kslot,const bf16x8*qr,const f32x16&i0,const f32x16&i1,int r32,int hi){
  const char*kb=Kslot+hi*1024+r32*16;
  #pragma unroll
  for(int d0=0;d0<4;++d0){
    const bf16x8 b0=*reinterpret_cast<const bf16x8*>(kb+d0*2048);
    const bf16x8 b1=*reinterpret_cast<const bf16x8*>(kb+d0*2048+512);
    if(d0==0){p0=__builtin_amdgcn_mfma_f32_32x32x16_bf16(b0,qr[0],i0,0,0,0);p1=__builtin_amdgcn_mfma_f32_32x32x16_bf16(b1,qr[0],i1,0,0,0);}
    else{p0=__builtin_amdgcn_mfma_f32_32x32x16_bf16(b0,qr[d0],p0,0,0,0);p1=__builtin_amdgcn_mfma_f32_32x32x16_bf16(b1,qr[d0],p1,0,0,0);}}
}
typedef __attribute__((address_space(3))) const char* lds_cptr;
typedef short v4i16_t __attribute__((ext_vector_type(4)));
__device__ __forceinline__ void kload8(bf16x8*kf,lds_cptr kp){
  kf[0]=*(const __attribute__((address_space(3))) bf16x8*)(kp);      kf[1]=*(const __attribute__((address_space(3))) bf16x8*)(kp+512);
  kf[2]=*(const __attribute__((address_space(3))) bf16x8*)(kp+2048); kf[3]=*(const __attribute__((address_space(3))) bf16x8*)(kp+2560);
  kf[4]=*(const __attribute__((address_space(3))) bf16x8*)(kp+4096); kf[5]=*(const __attribute__((address_space(3))) bf16x8*)(kp+4608);
  kf[6]=*(const __attribute__((address_space(3))) bf16x8*)(kp+6144); kf[7]=*(const __attribute__((address_space(3))) bf16x8*)(kp+6656);
}
__device__ __forceinline__ void kload2(bf16x8*kf,lds_cptr kp,int j){ kf[2*j]=*(const __attribute__((address_space(3))) bf16x8*)(kp+j*2048); kf[2*j+1]=*(const __attribute__((address_space(3))) bf16x8*)(kp+j*2048+512); }
__device__ __forceinline__ s16x4 vtr(lds_cptr p){ return __builtin_bit_cast(s16x4,__builtin_amdgcn_ds_read_tr16_b64_v4i16((__attribute__((address_space(3))) v4i16_t*)p)); }
__device__ __forceinline__ float rowmax(const f32x16&p0,const f32x16&p1){
  float a=max3f(p0[0],p0[1],p1[0]),b=max3f(p0[2],p0[3],p1[1]);a=max3f(a,p1[2],p1[3]);
  #pragma unroll
  for(int r=4;r<16;r+=4){a=max3f(a,p0[r],p0[r+1]);b=max3f(b,p0[r+2],p0[r+3]);a=max3f(a,p1[r],p1[r+1]);b=max3f(b,p1[r+2],p1[r+3]);}
  const float m=max2f(a,b);
  auto rr=__builtin_amdgcn_permlane32_swap(__float_as_uint(m),__float_as_uint(m),false,false);
  return max2f(__uint_as_float(rr[0]),__uint_as_float(rr[1]));
}
__device__ __forceinline__ void pv(f32x16*o,int vb,bf16x8 pa0,bf16x8 pa1,bf16x8 pa2,bf16x8 pa3){
  #pragma unroll
  for(int d0=0;d0<2;++d0){s16x4 lo[4],hi[4];
    #pragma unroll
    for(int ks=0;ks<4;++ks){
      asm volatile("ds_read_b64_tr_b16 %0,%1 offset:%c2":"=&v"(lo[ks]):"v"(vb),"i"(d0*4096+ks*1024):"memory");
      asm volatile("ds_read_b64_tr_b16 %0,%1 offset:%c2":"=&v"(hi[ks]):"v"(vb),"i"(d0*4096+ks*1024+512):"memory");}
    asm volatile("s_waitcnt lgkmcnt(0)":::"memory");SBAR();
    #define PK(k) (bf16x8){lo[k][0],lo[k][1],lo[k][2],lo[k][3],hi[k][0],hi[k][1],hi[k][2],hi[k][3]}
    o[d0]=__builtin_amdgcn_mfma_f32_32x32x16_bf16(pa0,PK(0),o[d0],0,0,0);
    o[d0]=__builtin_amdgcn_mfma_f32_32x32x16_bf16(pa1,PK(1),o[d0],0,0,0);
    o[d0]=__builtin_amdgcn_mfma_f32_32x32x16_bf16(pa2,PK(2),o[d0],0,0,0);
    o[d0]=__builtin_amdgcn_mfma_f32_32x32x16_bf16(pa3,PK(3),o[d0],0,0,0);
    #undef PK
  }
}

#ifndef ATTN_STORE16
#define ATTN_STORE16(p,v) (*(u32x4*)(p)=(v))
#endif
template<int THRL> __device__ __forceinline__ void attn_unit(int b,int hm,int half,int qb,float cs,const bf16*Q,const bf16*__restrict__ K,const bf16*__restrict__ V,bf16*O,char*shm){
  const int tid=threadIdx.x; int lane=tid&63; asm volatile("":"+v"(lane));
  const int r32=lane&31,hi=lane>>5; const int wid=__builtin_amdgcn_readfirstlane(tid>>6);
  const long rowbase=(long)b*SEQ; const int q0=qb*QB;
  const bf16*Qw=Q+(rowbase+q0+wid*QBLK)*DM+hm*D;
  const bf16*Kh=K+rowbase*DM+hm*D,*Vh=V+rowbase*DM+(hm>>1)*128+half*64;
  const unsigned lds0=(unsigned)(uintptr_t)shm;
  float*wsf=(float*)(shm+LDS_WS)+wid*64;
  const bf16*ksrc=Kh+(long)lane*DM+wid*8;
  const bf16*vsrc=Vh+(long)(16*(wid&3)+(lane>>2))*DM+(wid>>2)*32+(lane&3)*8;
  const unsigned kdst=lds0+LDS_K+wid*1024, vdst=lds0+LDS_V+wid*1024;
  #define DMA_K(t,slot) glds16(ksrc+(long)(t)*KVBLK*DM,(unsigned)__builtin_amdgcn_readfirstlane(kdst+(slot)))
  #define DMA_V(t,slot) glds16(vsrc+(long)(t)*KVBLK*DM,(unsigned)__builtin_amdgcn_readfirstlane(vdst+(slot)))
  const int vb0=(int)(lds0+LDS_V)+((lane>>4)&1)*32+(lane&3)*8+(4*hi+((lane&15)>>2))*64;
  const char*Kbase=shm+LDS_K; bf16x8 kf[8];
  const lds_cptr shm3=(lds_cptr)shm; const lds_cptr kp0=shm3+LDS_K+hi*1024+r32*16; const lds_cptr vp0=shm3+LDS_V+((lane>>4)&1)*32+(lane&3)*8+(4*hi+((lane&15)>>2))*64;
  const int NT=(q0+QB)/KVBLK;
  DMA_K(0,0);DMA_V(0,0);DMA_K(1,SLOTB);
  bf16x8 qr[4];
  #pragma unroll
  for(int d0=0;d0<4;++d0)qr[d0]=*reinterpret_cast<const bf16x8*>(&Qw[(long)r32*DM+d0*16+hi*8]);
  float mhat=0.f,l_reg=0.f;f32x16 o[2];o[0]=f32x16{};o[1]=f32x16{};
  const int qrel=wid*QBLK+r32;
  float nb=-cs*(float)(q0+qrel-4*hi);
  const float cs8=__builtin_bit_cast(float,__builtin_amdgcn_readfirstlane(__builtin_bit_cast(int,8.f*cs)));
  #define CINIT1(C,t,X) do{ C[0]=nb+cs*(float)(64*(t)+(X)); C[1]=C[0]+cs; C[2]=C[1]+cs; C[3]=C[2]+cs; _Pragma("unroll") for(int r=4;r<16;++r) C[r]=C[r-4]+cs8; asm volatile("":"+v"(C)); }while(0)
  #define CINIT(C0,C1,t) do{ CINIT1(C0,t,0); CINIT1(C1,t,32); }while(0)
  #define CMASK(P0,P1,t) do{int jb_=(t)-(NT-4); if(jb_>=0)cmask(P0,P1,jb_,qrel,hi);}while(0)
  bool resc=false;
  #define START(P0,P1) do{ const float rm=rowmax(P0,P1); resc=false; \
    { const float dl=rm; mhat=fadd_s(mhat,dl); nb=fsub_s(nb,dl); \
      _Pragma("unroll") for(int r=0;r<16;++r){P0[r]=fsub_s(P0[r],dl);P1[r]=fsub_s(P1[r],dl);} } \
    _Pragma("unroll") for(int r=0;r<16;++r)P0[r]=__builtin_amdgcn_exp2f(P0[r]); }while(0)
  #define RESC() do{ if(resc){ asm volatile("s_waitcnt lgkmcnt(0)":::"memory"); \
      _Pragma("unroll") for(int d_=0;d_<2;++d_) _Pragma("unroll") for(int r=0;r<16;++r)o[d_][r]*=wsf[crow(r,hi)]; } }while(0)
  f32x16 pA0,pA1,pB0,pB1;
  int sl_prev=0,sl_cur=0,sl_next=SLOTB;
  #define ROT() do{sl_prev=sl_cur;sl_cur=sl_next;sl_next=(sl_next==(NSLOT-1)*SLOTB)?0:sl_next+SLOTB;}while(0)
  DMA_K(2,2*SLOTB);
  WAIT_BAR(3);
  { f32x16 i0_,i1_; CINIT(i0_,i1_,0); qkt(pA0,pA1,Kbase,qr,i0_,i1_,r32,hi); } asm volatile("s_nop 15\n\ts_nop 7":"+v"(pA0),"+v"(pA1));CMASK(pA0,pA1,0);
  START(pA0,pA1);
  _Pragma("unroll") for(int r=0;r<16;++r)pA1[r]=__builtin_amdgcn_exp2f(pA1[r]);
  WAIT_BAR(0);
  DMA_K(3,0);DMA_V(1,SLOTB);
  ROT();
  kload8(kf,kp0+sl_cur);
  WAIT_BAR(2);
  s16x4 vlo[8],vhi[8]; u32x4 pw0,pw1,pw2,pw3;
  #define PKW(P,B) cvtpk_s(P[B],P[B+1])
  #define PAF(k) __builtin_bit_cast(bf16x8,pw##k)
  #define VFR(i) (bf16x8){vlo[i][0],vlo[i][1],vlo[i][2],vlo[i][3],vhi[i][0],vhi[i][1],vhi[i][2],vhi[i][3]}
  #define PIN(x) asm volatile("":"+v"(x))
  #define MX3(a,b,c) __builtin_fmaxf(__builtin_fmaxf((a),(b)),(c))
  #define GAPA(MF,A0,A1,A2,A3,W0,W1,PW) do{ MF; sacc+=A0; sacc+=A1; sacc+=A2; sacc+=A3; PIN(sacc); W0; W1; PIN(PW); SBAR(); }while(0)
  #define EX(v) __builtin_amdgcn_exp2f(v)
  #define GAPB(MF,X,B) do{ MF; X[B]=EX(X[B]); X[B+1]=EX(X[B+1]); X[B+2]=EX(X[B+2]); X[B+3]=EX(X[B+3]); PIN(X); SBAR(); }while(0)
  #define VRD(i) do{ vlo[i]=vtr(vp_+(((i)>>2)*4096+((i)&3)*1024)); vhi[i]=vtr(vp_+(((i)>>2)*4096+((i)&3)*1024+512)); }while(0)
  #define KRD(G,j) do{ if(G){ kload2(kf,kp0+sl_next,j); SBAR(); } }while(0)
  #define STEP(C0,C1,P0,P1,t,GK,GV,GL) do{ SBAR(); \
    const lds_cptr vp_=vp0+sl_prev; \
    VRD(0); SBAR(); float sacc=(P0[0]+P0[1]); CINIT1(C0,t,0); SBAR(); \
    GAPA(C0=__builtin_amdgcn_mfma_f32_32x32x16_bf16(kf[0],qr[0],C0,0,0,0), P0[2],P0[3],P0[4],P0[5],     pw0[0]=PKW(P0,0), pw0[1]=PKW(P0,2), pw0); \
    VRD(4); SBAR(); CINIT1(C1,t,32); SBAR(); GAPA(C1=__builtin_amdgcn_mfma_f32_32x32x16_bf16(kf[1],qr[0],C1,0,0,0), P0[6],P0[7],P0[8],P0[9],     pw0[2]=PKW(P0,4), pw0[3]=PKW(P0,6), pw0); \
    VRD(1); SBAR(); GAPA(C0=__builtin_amdgcn_mfma_f32_32x32x16_bf16(kf[2],qr[1],C0,0,0,0),   P0[10],P0[11],P0[12],P0[13], pw1[0]=PKW(P0,8), pw1[1]=PKW(P0,10), pw1); \
    VRD(5); SBAR(); GAPA(C1=__builtin_amdgcn_mfma_f32_32x32x16_bf16(kf[3],qr[1],C1,0,0,0),   P0[14],P0[15],P1[0],P1[1],   pw1[2]=PKW(P0,12),pw1[3]=PKW(P0,14), pw1); \
    VRD(2); SBAR(); GAPA(C0=__builtin_amdgcn_mfma_f32_32x32x16_bf16(kf[4],qr[2],C0,0,0,0),   P1[2],P1[3],P1[4],P1[5],     pw2[0]=PKW(P1,0), pw2[1]=PKW(P1,2), pw2); \
    VRD(6); SBAR(); GAPA(C1=__builtin_amdgcn_mfma_f32_32x32x16_bf16(kf[5],qr[2],C1,0,0,0),   P1[6],P1[7],P1[8],P1[9],     pw2[2]=PKW(P1,4), pw2[3]=PKW(P1,6), pw2); \
    VRD(3); SBAR(); GAPA(C0=__builtin_amdgcn_mfma_f32_32x32x16_bf16(kf[6],qr[3],C0,0,0,0),   P1[10],P1[11],P1[12],P1[13], pw3[0]=PKW(P1,8), pw3[1]=PKW(P1,10), pw3); \
    VRD(7); SBAR(); GAPA(C1=__builtin_amdgcn_mfma_f32_32x32x16_bf16(kf[7],qr[3],C1,0,0,0),   P1[14],P1[15],0.f,0.f,       pw3[2]=PKW(P1,12),pw3[3]=PKW(P1,14), pw3); \
    l_reg+=sacc; \
    if(GK){DMA_K((t)+3,sl_cur);} if(GV){DMA_V((t)+1,sl_next);} \
    CMASK(C0,C1,t); \
    { float a=MX3(C0[0],C0[1],C1[0]),b=MX3(C0[2],C0[3],C1[1]); a=MX3(a,C1[2],C1[3]); \
      _Pragma("unroll") for(int r=4;r<16;r+=4){a=MX3(a,C0[r],C0[r+1]);b=MX3(b,C0[r+2],C0[r+3]);a=MX3(a,C1[r],C1[r+1]);b=MX3(b,C1[r+2],C1[r+3]);} \
      float rm=__builtin_fmaxf(a,b); { auto rr=__builtin_amdgcn_permlane32_swap(__float_as_uint(rm),__float_as_uint(rm),false,false); rm=__builtin_fmaxf(__uint_as_float(rr[0]),__uint_as_float(rr[1])); } \
      resc=false; \
      if(__builtin_expect(__any(rm>(float)THRL),0)){ const float dl=__builtin_fmaxf(rm,0.f); mhat+=dl; nb-=dl; \
        _Pragma("unroll") for(int r=0;r<16;++r){C0[r]-=dl;C1[r]-=dl;} \
        const float f=__builtin_amdgcn_exp2f(-dl); l_reg*=f; if(hi==0)wsf[r32]=f; resc=true; } } \
    SBAR(); \
    GAPB(o[0]=__builtin_amdgcn_mfma_f32_32x32x16_bf16(PAF(0),VFR(0),o[0],0,0,0), C0,0); \
    GAPB(o[1]=__builtin_amdgcn_mfma_f32_32x32x16_bf16(PAF(0),VFR(4),o[1],0,0,0), C0,4); \
    KRD(GL,0); GAPB(o[0]=__builtin_amdgcn_mfma_f32_32x32x16_bf16(PAF(1),VFR(1),o[0],0,0,0), C0,8); \
    KRD(GL,1); GAPB(o[1]=__builtin_amdgcn_mfma_f32_32x32x16_bf16(PAF(1),VFR(5),o[1],0,0,0), C0,12); \
    KRD(GL,2); GAPB(o[0]=__builtin_amdgcn_mfma_f32_32x32x16_bf16(PAF(2),VFR(2),o[0],0,0,0), C1,0); \
    KRD(GL,3); GAPB(o[1]=__builtin_amdgcn_mfma_f32_32x32x16_bf16(PAF(2),VFR(6),o[1],0,0,0), C1,4); \
    GAPB(o[0]=__builtin_amdgcn_mfma_f32_32x32x16_bf16(PAF(3),VFR(3),o[0],0,0,0), C1,8); \
    GAPB(o[1]=__builtin_amdgcn_mfma_f32_32x32x16_bf16(PAF(3),VFR(7),o[1],0,0,0), C1,12); \
    }while(0)
  int t=1;
  #undef CMASK
  #define CMASK(P0,P1,t) do{}while(0)
  for(;t+5<NT;t+=2){
    STEP(pB0,pB1,pA0,pA1,t,true,true,true);     WAIT_BAR(2); RESC(); ROT();
    STEP(pA0,pA1,pB0,pB1,t+1,true,true,true);   WAIT_BAR(2); RESC(); ROT();
  }
  #undef CMASK
  #define CMASK(P0,P1,t) do{int jb_=(t)-(NT-4); if(jb_>=0)cmask(P0,P1,jb_,qrel,hi);}while(0)
  #define ENDW(tt) do{ if((tt)+3<NT){WAIT_BAR(2);} else if((tt)+2<NT){WAIT_BAR(1);} else {WAIT_BAR(0);} }while(0)
  for(;t+1<NT;t+=2){
    STEP(pB0,pB1,pA0,pA1,t,(t+3<NT),(t+1<NT),(t+1<NT));       ENDW(t);   RESC(); ROT();
    STEP(pA0,pA1,pB0,pB1,t+1,(t+4<NT),(t+2<NT),(t+2<NT));     ENDW(t+1); RESC(); ROT();
  }
  STEP(pB0,pB1,pA0,pA1,NT-1,false,false,false); RESC();
  { float sacc=pB0[0]+pB0[1]; _Pragma("unroll") for(int r=2;r<16;++r)sacc+=pB0[r]; _Pragma("unroll") for(int r=0;r<16;++r)sacc+=pB1[r]; l_reg+=sacc;
    pw0=(u32x4){PKW(pB0,0),PKW(pB0,2),PKW(pB0,4),PKW(pB0,6)};pw1=(u32x4){PKW(pB0,8),PKW(pB0,10),PKW(pB0,12),PKW(pB0,14)};pw2=(u32x4){PKW(pB1,0),PKW(pB1,2),PKW(pB1,4),PKW(pB1,6)};pw3=(u32x4){PKW(pB1,8),PKW(pB1,10),PKW(pB1,12),PKW(pB1,14)};
    SBAR(); pv(o,vb0+sl_cur,PAF(0),PAF(1),PAF(2),PAF(3)); }
  #undef PKW
  #undef PAF
  #undef VFR
  #undef PIN
  #undef MX3
  #undef GAPA
  #undef GAPB
  #undef EX
  #undef VRD
  #undef KRD
  #undef STEP
  #undef ENDW
  {auto rr=__builtin_amdgcn_permlane32_swap(__float_as_uint(l_reg),__float_as_uint(l_reg),false,false);l_reg=__uint_as_float(rr[0])+__uint_as_float(rr[1]);}
  if(hi==0)wsf[32+r32]=l_reg;asm volatile("s_waitcnt lgkmcnt(0)":::"memory");
  float rli[16];
  #pragma unroll
  for(int r=0;r<16;++r)rli[r]=__builtin_amdgcn_rcpf(wsf[32+crow(r,hi)]);
  bf16*Ow=O+(rowbase+q0+wid*QBLK)*DMO+(hm>>1)*256+(hm&1)*128+half*64;
  { bf16*stg=(bf16*)(shm+LDS_OST)+wid*2048;
    int eoff=hi*256+r32; asm volatile("":"+v"(eoff));
    #pragma unroll
    for(int r=0;r<16;++r){const int orow=(r&3)+8*(r>>2);
      #pragma unroll
      for(int d0=0;d0<2;++d0)stg[eoff+orow*64+d0*32]=__float2bfloat16(o[d0][r]*rli[r]);}
    asm volatile("s_waitcnt lgkmcnt(0)":::"memory");
    #pragma unroll
    for(int i=0;i<4;++i){const int row=i*8+(lane>>3),ch=lane&7; const u32x4 v=*(const u32x4*)(stg+row*64+ch*8); ATTN_STORE16(Ow+(long)row*DMO+ch*8,v);} }
  asm volatile("s_waitcnt lgkmcnt(0)\n\ts_barrier":::"memory");
  #undef DMA_K
  #undef DMA_V
  #undef CMASK
  #undef START
  #undef RESC
  #undef ROT
  #undef CINIT
  #undef CINIT1
}
constexpr int ATTN_LDS_BYTES=LDS_BYTES;
struct AttnTensors { const bf16* Q; const bf16* K; const bf16* V; bf16* O; };
template<int THRL=8> __device__ __forceinline__ void attn_phase(char*lds,const AttnTensors&T,int vcu,int G){
  const int np=(BATCH*16-vcu+G-1)/G;
  for(int it=0;it<np*NQB;++it){ const int p=vcu+(it/NQB)*G,i=it%NQB; const int b=p>>4,vh=p&15,hm=vh>>1,half=vh&1;
    const float cs=__builtin_bit_cast(float,__builtin_amdgcn_readfirstlane(__builtin_bit_cast(int,__builtin_amdgcn_exp2f(-2.f*(float)((hm>>1)+1))*1.4426950408889634f)));
    attn_unit<THRL>(b,hm,half,NQB-1-i,cs,T.Q,T.K,T.V,T.O,lds); }
}
#undef SBAR
#undef WAIT_BAR
}
constexpr int NWAVES = 8;
constexpr int RING_OFF = 0, RING_BYTES = 131072;
constexpr int LDSCTL_OFF = RING_BYTES, MISC_OFF = LDSCTL_OFF + 320;
constexpr int LDS_BYTES = 163840;

#define XB_TMO      128
#define XB_XCNT(j)  (256  + 64 * (j))
#define XB_XSUB(j)  (1280 + 64 * (j))
#define XB_XGEN(j)  (2304 + 64 * (j))
#define XB_TOP      3328
#define XB_TOPGEN   3392
#define XCD_BAR_WORDS 3456
#define XB_SPIN_CAP (1u << 18)
__device__ __forceinline__ unsigned xb_ld(unsigned* p)              { return __hip_atomic_load(p, __ATOMIC_RELAXED, __HIP_MEMORY_SCOPE_AGENT); }
__device__ __forceinline__ unsigned xb_add(unsigned* p, unsigned v) { return __hip_atomic_fetch_add(p, v, __ATOMIC_RELAXED, __HIP_MEMORY_SCOPE_AGENT); }
__device__ __forceinline__ unsigned xb_xcc_id() { return (unsigned)__builtin_amdgcn_s_getreg((3 << 11) | 20) & 0xFu; }
#define XB_SPIN(cond, bar) do { unsigned _sp = 0; while (cond) { __builtin_amdgcn_s_sleep(1); \
    if ((++_sp & 255u) == 0u) { if (xb_ld(&(bar)[XB_TMO])) break; if (_sp > XB_SPIN_CAP) { atomicAdd(&(bar)[XB_TMO], 1u); break; } } } } while (0)
struct XcdBarrier { unsigned* bar; unsigned x; volatile LAS unsigned* st; };
__device__ __forceinline__ XcdBarrier xcd_barrier_post(unsigned* bar, volatile LAS unsigned* st) {
    XcdBarrier b; b.bar = bar; b.x = xb_xcc_id(); b.st = st;
    if (threadIdx.x == 0) (void)xb_add(&bar[XB_XCNT(b.x)], 1u);
    return b;
}
__device__ __forceinline__ void xcd_barrier_complete(unsigned* bar, unsigned x, unsigned& nloc, unsigned& nx) {
    const unsigned G = gridDim.x * gridDim.y * gridDim.z;
    unsigned sum, cnt, mine, sp = 0u;
    for (;;) {
        sum = 0u; cnt = 0u; mine = 0u;
#pragma unroll
        for (unsigned j = 0; j < 16; ++j) { const unsigned c = xb_ld(&bar[XB_XCNT(j)]); sum += c; cnt += (c > 0u) ? 1u : 0u; mine = (j == x) ? c : mine; }
        if (sum == G) break;
        __builtin_amdgcn_s_sleep(1);
        if ((++sp & 255u) == 0u) { if (xb_ld(&bar[XB_TMO])) break; if (sp > XB_SPIN_CAP) { atomicAdd(&bar[XB_TMO], 1u); break; } }
    }
    nloc = mine > 0u ? mine : 1u; nx = cnt > 0u ? cnt : 1u;
}
__device__ __forceinline__ void xcd_barrier(const XcdBarrier& b) {
    asm volatile("s_waitcnt vmcnt(0)" ::: "memory");
    __syncthreads();
    if (threadIdx.x == 0) {
        unsigned* bar = b.bar;
        __builtin_amdgcn_s_waitcnt(0);
        unsigned nloc = b.st[0], nx = b.st[1];
        if (nloc == 0u) { xcd_barrier_complete(bar, b.x, nloc, nx); b.st[0] = nloc; b.st[1] = nx; }
        const unsigned old = xb_add(&bar[XB_XSUB(b.x)], 1u);
        const unsigned gen = old / nloc;
        if (old + 1u == (gen + 1u) * nloc) {
            __builtin_amdgcn_fence(__ATOMIC_RELEASE, "agent");
            asm volatile("s_waitcnt vmcnt(0)" ::: "memory");
            const unsigned og = xb_add(&bar[XB_TOP], 1u);
            const unsigned tg = og / nx;
            if (og + 1u == (tg + 1u) * nx) xb_add(&bar[XB_TOPGEN], 1u);
            else XB_SPIN(xb_ld(&bar[XB_TOPGEN]) == tg, bar);
            __builtin_amdgcn_fence(__ATOMIC_ACQUIRE, "agent");
            xb_add(&bar[XB_XGEN(b.x)], 1u);
            asm volatile("s_waitcnt vmcnt(0)" ::: "memory");
        } else {
            XB_SPIN(xb_ld(&bar[XB_XGEN(b.x)]) == gen, bar);
            __builtin_amdgcn_fence(__ATOMIC_ACQUIRE, "agent");
            asm volatile("s_waitcnt vmcnt(0)" ::: "memory");
        }
    }
    __syncthreads();
}

struct Frame {
    LAS unsigned char* lds; volatile LAS unsigned* MISC; gu32* ctl;
    int tid, lane, wave, vcu, G;
};
__device__ __forceinline__ float bf2f_(unsigned short b) { return __builtin_bit_cast(float, (unsigned)b << 16); }
__device__ __forceinline__ float wave_sum(float v) {
#pragma unroll
    for (int o = 1; o < 64; o <<= 1) v += __shfl_xor(v, o);
    return v;
}
__device__ __forceinline__ void p0_transpose_item(const float* W, int ldw, int K, bf16* WT, int k0, int n0, int drow0, LAS float* scr, int lane) {
#pragma unroll 8
    for (int i = 0; i < 32; ++i) { const int kk = 2 * i + (lane >> 5); scr[kk * 33 + (lane & 31)] = W[(size_t)(k0 + kk) * ldw + n0 + (lane & 31)]; }
    LDS_WAIT(); asm volatile("" ::: "memory");
    const int c = lane & 7;
#pragma unroll
    for (int j = 0; j < 4; ++j) { const int n = (lane >> 3) + 8 * j; const LAS float* s = scr + (8 * c) * 33 + n;
        v4u o; o.x = pk2(s[0 * 33], s[1 * 33]); o.y = pk2(s[2 * 33], s[3 * 33]); o.z = pk2(s[4 * 33], s[5 * 33]); o.w = pk2(s[6 * 33], s[7 * 33]);
        *(GAS v4u*)(WT + (size_t)(drow0 + n) * K + k0 + 8 * c) = o; }
    LDS_WAIT(); asm volatile("" ::: "memory");
}
struct Ptrs {
    const float *x, *p, *w_in, *b_gate, *lq1, *lk1, *lq2, *lk2, *subln, *w_abr, *w_pmix, *pscale, *w_pbr, *w_out, *ln1g, *ln1b, *w_router, *b_router, *w_up, *b_up, *w_down, *b_down, *w_pg, *w_pp, *ln2g, *ln2b;
    float* out; unsigned char* ws;
};
__device__ __forceinline__ void ph0_prologue(Frame& F, const Ptrs& P) {
    unsigned char* ws = P.ws;
    LAS float* scr = (LAS float*)(F.lds + RING_OFF + F.wave * 16384);
    const int gw = F.vcu * NWAVES + F.wave, NGW = F.G * NWAVES;
    { const size_t n4 = (size_t)M * D / 4, st = (size_t)F.G * 512; const f32x4* src = (const f32x4*)P.x; unsigned long long* dst = (unsigned long long*)(ws + WS_XB);
      for (size_t i = (size_t)blockIdx.x * 512 + F.tid; i < n4; i += st) { const f32x4 v = src[i]; dst[i] = (unsigned long long)pk2(v.x, v.y) | ((unsigned long long)pk2(v.z, v.w) << 32); } }
    constexpr int I_IN = 16 * 128, I_A = 8 * 32, I_O = 16 * 32, I_PG = 16 * 32, I_PP = 4 * 32, I_UP1 = 16 * 64, I_DN1 = 16 * 32;
    constexpr int I_UP = NEXP * I_UP1, I_DN = NEXP * I_DN1, NITEMS = I_IN + I_A + I_O + I_PG + I_PP + I_UP + I_DN;
    for (int it = gw; it < NITEMS; it += NGW) {
        int r = it;
        if (r < I_IN) { const int nb = 128; p0_transpose_item(P.w_in, 4096, 1024, (bf16*)(ws + WS_WIN), 64 * (r / nb), 32 * (r % nb), 32 * (r % nb), scr, F.lane); continue; } r -= I_IN;
        if (r < I_A) { const int nb = 32; p0_transpose_item(P.w_abr, 1024, 512, (bf16*)(ws + WS_WA), 64 * (r / nb), 32 * (r % nb), 32 * (r % nb), scr, F.lane); continue; } r -= I_A;
        if (r < I_O) { const int nb = 32; p0_transpose_item(P.w_out, 1024, 1024, (bf16*)(ws + WS_WOUT), 64 * (r / nb), 32 * (r % nb), 32 * (r % nb), scr, F.lane); continue; } r -= I_O;
        if (r < I_PG) { const int nb = 32; p0_transpose_item(P.w_pg, 1024, 1024, (bf16*)(ws + WS_WPG), 64 * (r / nb), 32 * (r % nb), 32 * (r % nb), scr, F.lane); continue; } r -= I_PG;
        if (r < I_PP) { const int nb = 32; p0_transpose_item(P.w_pp, 1024, 256, (bf16*)(ws + WS_WPP), 64 * (r / nb), 32 * (r % nb), 32 * (r % nb), scr, F.lane); continue; } r -= I_PP;
        if (r < I_UP) { const int e = r / I_UP1, q = r % I_UP1, nb = 64, n0 = 32 * (q % nb);
            const int bj = n0 >> 10, pn = (n0 & 1023) >> 7, cp = n0 & 127;
            p0_transpose_item(P.w_up + (size_t)e * 1024 * 2048, 2048, 1024, (bf16*)(ws + WS_WUP) + (size_t)e * 2048 * 1024, 64 * (q / nb), n0, 256 * pn + 128 * bj + cp, scr, F.lane); continue; } r -= I_UP;
        { const int e = r / I_DN1, q = r % I_DN1, nb = 32;
            p0_transpose_item(P.w_down + (size_t)e * 1024 * 1024, 1024, 1024, (bf16*)(ws + WS_WDN) + (size_t)e * 1024 * 1024, 64 * (q / nb), 32 * (q % nb), 32 * (q % nb), scr, F.lane); }
    }
    { bf16* WPC = (bf16*)(ws + WS_WPC);
      for (int k = blockIdx.x; k < 512; k += F.G) { const int g = k >> 7;
          float a0 = 0.f, a1 = 0.f; const float* wm = P.w_pmix + (size_t)k * 128; const float* sc = P.pscale + g * 128; const float* wb = P.w_pbr + (size_t)(g * 128) * 1024;
          for (int d = 0; d < 128; ++d) { const float w = wm[d] * sc[d]; a0 += w * wb[(size_t)d * 1024 + F.tid]; a1 += w * wb[(size_t)d * 1024 + 512 + F.tid]; }
          WPC[(size_t)F.tid * 512 + k] = (bf16)f2bf(a0); WPC[(size_t)(F.tid + 512) * 512 + k] = (bf16)f2bf(a1); } }
}
__device__ __forceinline__ void ph_pool(Frame& F, const Ptrs& P) {
    const bf16* U = (const bf16*)(P.ws + WS_U); bf16* PO = (bf16*)(P.ws + WS_PO);
    const size_t nitem = (size_t)M * 64, st = (size_t)F.G * 512;
    for (size_t idx = (size_t)blockIdx.x * 512 + F.tid; idx < nitem; idx += st) {
        const size_t row = idx >> 6; const int cg = (int)(idx & 63), c0 = cg * 8, pos = (int)(row & (SEQ - 1)), w = 2 << (c0 >> 7), n = pos + 1 < w ? pos + 1 : w;
        float s[8] = {0.f, 0.f, 0.f, 0.f, 0.f, 0.f, 0.f, 0.f}; v4u cur = *(const v4u*)(U + row * 512 + c0);
        for (int k = 0; k < n; ++k) { const v4u v = k == 0 ? cur : *(const v4u*)(U + (row - k) * 512 + c0);
            s[0] += pg8::bflo(v.x); s[1] += pg8::bfhi(v.x); s[2] += pg8::bflo(v.y); s[3] += pg8::bfhi(v.y); s[4] += pg8::bflo(v.z); s[5] += pg8::bfhi(v.z); s[6] += pg8::bflo(v.w); s[7] += pg8::bfhi(v.w); }
        const float rn = 1.f / (float)n; v4u o;
        o.x = pk2(s[0] * rn - pg8::bflo(cur.x), s[1] * rn - pg8::bfhi(cur.x)); o.y = pk2(s[2] * rn - pg8::bflo(cur.y), s[3] * rn - pg8::bfhi(cur.y));
        o.z = pk2(s[4] * rn - pg8::bflo(cur.z), s[5] * rn - pg8::bfhi(cur.z)); o.w = pk2(s[6] * rn - pg8::bflo(cur.w), s[7] * rn - pg8::bfhi(cur.w));
        *(v4u*)(PO + row * 512 + c0) = o;
    }
}
__device__ __forceinline__ float lam_value(const Ptrs& P) { float a = 0.f, b = 0.f; for (int d = 0; d < 64; ++d) { a += P.lq1[d] * P.lk1[d]; b += P.lq2[d] * P.lk2[d]; } return __expf(a) - __expf(b) + 0.2f; }
__device__ __forceinline__ void ph_combine(Frame& F, const Ptrs& P) {
    const bf16* O16 = (const bf16*)(P.ws + WS_O16); bf16* OA = (bf16*)(P.ws + WS_OA); const float lam = lam_value(P);
    const int gw = F.vcu * NWAVES + F.wave, NGW = F.G * NWAVES, h = F.lane >> 4, e0 = (F.lane & 15) * 8;
    float sg[8];
#pragma unroll
    for (int j = 0; j < 8; ++j) sg[j] = P.subln[e0 + j] * 0.8f;
    for (int row = gw; row < M; row += NGW) {
        const v4u a = *(const v4u*)(O16 + (size_t)row * 1024 + h * 256 + e0), b = *(const v4u*)(O16 + (size_t)row * 1024 + h * 256 + 128 + e0);
        f32x4 a0, a1, b0, b1; pg8::unpack8(a, a0, a1); pg8::unpack8(b, b0, b1); a0 -= b0 * lam; a1 -= b1 * lam;
        float ss = (a0[0] * a0[0] + a0[1] * a0[1]) + (a0[2] * a0[2] + a0[3] * a0[3]) + (a1[0] * a1[0] + a1[1] * a1[1]) + (a1[2] * a1[2] + a1[3] * a1[3]);
        ss += __shfl_xor(ss, 1); ss += __shfl_xor(ss, 2); ss += __shfl_xor(ss, 4); ss += __shfl_xor(ss, 8);
        const float r = rsqrtf(ss * (1.f / 128.f) + LN_EPS);
#pragma unroll
        for (int j = 0; j < 4; ++j) { a0[j] *= r * sg[j]; a1[j] *= r * sg[4 + j]; }
        *(v4u*)(OA + (size_t)row * 512 + h * 128 + e0) = pg8::pack8(a0, a1);
    }
}
__device__ __forceinline__ void ph6_ln1_route(Frame& F, const Ptrs& P) {
    unsigned char* ws = P.ws;
    const unsigned keep0 = F.MISC[8], keep1 = F.MISC[9];
    __syncthreads();
    { LAS f32x4* img = (LAS f32x4*)F.lds; const f32x4* src = (const f32x4*)P.w_router;
      for (int i = F.tid; i < 1024 * 8; i += 512) { const int k = i >> 3, q = i & 7; img[(k ^ ((k >> 3) & 1)) * 8 + q] = src[i]; } }
    { const size_t n4 = (size_t)M * PLE / 4, st = (size_t)F.G * 512; const f32x4* src = (const f32x4*)P.p; unsigned long long* dst = (unsigned long long*)(ws + WS_PB);
      for (size_t i = (size_t)blockIdx.x * 512 + F.tid; i < n4; i += st) { const f32x4 v = src[i]; dst[i] = (unsigned long long)pk2(v.x, v.y) | ((unsigned long long)pk2(v.z, v.w) << 32); } }
    __syncthreads();
    float* X1 = P.out; bf16* X1B = (bf16*)(ws + WS_X1B);
    const int lane = F.lane, eg = lane & 7, ko = lane >> 3;
    LAS float* xrow = (LAS float*)(F.lds + 131072 + 4096 * F.wave);
    f32x4 gam[4], bet[4];
#pragma unroll
    for (int j = 0; j < 4; ++j) { gam[j] = ((const f32x4*)P.ln1g)[lane + 64 * j]; bet[j] = ((const f32x4*)P.ln1b)[lane + 64 * j]; }
    const f32x4 brt = ((const f32x4*)P.b_router)[eg];
    int my_e[4] = {0, 0, 0, 0}; float my_g[4] = {0.f, 0.f, 0.f, 0.f};
    for (int chunk = blockIdx.x; chunk < M / 256; chunk += F.G) {
        for (int i = 0; i < 32; ++i) {
            const int row = chunk * 256 + F.wave * 32 + i;
            f32x4 v[4]; float s = 0.f;
#pragma unroll
            for (int j = 0; j < 4; ++j) { v[j] = ((const f32x4*)(X1 + (size_t)row * 1024))[lane + 64 * j]; s += (v[j].x + v[j].y) + (v[j].z + v[j].w); }
            const float mean = wave_sum(s) * (1.f / 1024.f); float s2 = 0.f;
#pragma unroll
            for (int j = 0; j < 4; ++j) { v[j] = v[j] - mean; s2 += (v[j].x * v[j].x + v[j].y * v[j].y) + (v[j].z * v[j].z + v[j].w * v[j].w); }
            const float rstd = rsqrtf(wave_sum(s2) * (1.f / 1024.f) + LN_EPS);
#pragma unroll
            for (int j = 0; j < 4; ++j) { v[j] = v[j] * rstd * gam[j] + bet[j];
                ((f32x4*)(X1 + (size_t)row * 1024))[lane + 64 * j] = v[j];
                ((unsigned long long*)(X1B + (size_t)row * 1024))[lane + 64 * j] = (unsigned long long)pk2(v[j].x, v[j].y) | ((unsigned long long)pk2(v[j].z, v[j].w) << 32);
                ((LAS f32x4*)xrow)[lane + 64 * j] = v[j]; }
            LDS_WAIT(); asm volatile("" ::: "memory");
            f32x4 acc = {0.f, 0.f, 0.f, 0.f};
#pragma unroll 4
            for (int sidx = 0; sidx < 32; ++sidx) { const f32x4 xv = ((const LAS f32x4*)xrow)[sidx * 8 + ko];
#pragma unroll
                for (int q = 0; q < 4; ++q) { const int k = 32 * sidx + 4 * ko + q; const f32x4 w = ((const LAS f32x4*)F.lds)[(k ^ ((k >> 3) & 1)) * 8 + eg]; acc += w * xv[q]; } }
#pragma unroll
            for (int q = 0; q < 4; ++q) { acc[q] += __shfl_xor(acc[q], 8); acc[q] += __shfl_xor(acc[q], 16); acc[q] += __shfl_xor(acc[q], 32); }
            acc += brt;
            float tv[4]; int ti[4];
#pragma unroll
            for (int r = 0; r < 4; ++r) { float bv = acc[0]; int bi = 4 * eg;
#pragma unroll
                for (int q = 1; q < 4; ++q) if (acc[q] > bv) { bv = acc[q]; bi = 4 * eg + q; }
#pragma unroll
                for (int o = 1; o < 8; o <<= 1) { const float ov = __shfl_xor(bv, o); const int oi = __shfl_xor(bi, o); if (ov > bv || (ov == bv && oi < bi)) { bv = ov; bi = oi; } }
                tv[r] = bv; ti[r] = bi;
#pragma unroll
                for (int q = 0; q < 4; ++q) if (bi == 4 * eg + q) acc[q] = -INFINITY; }
            const float e1 = __expf(tv[1] - tv[0]), e2 = __expf(tv[2] - tv[0]), e3 = __expf(tv[3] - tv[0]), rs = 1.f / (1.f + e1 + e2 + e3);
            if (lane == i) { my_e[0] = ti[0]; my_e[1] = ti[1]; my_e[2] = ti[2]; my_e[3] = ti[3]; my_g[0] = rs; my_g[1] = e1 * rs; my_g[2] = e2 * rs; my_g[3] = e3 * rs; }
        }
        __syncthreads();
        LAS int* cntl = (LAS int*)(F.lds + 131072); LAS int* basel = cntl + 32;
        if (F.tid < 32) cntl[F.tid] = 0;
        __syncthreads();
        int rk[4] = {0, 0, 0, 0};
        if (lane < 32) {
#pragma unroll
            for (int k = 0; k < 4; ++k) rk[k] = __hip_atomic_fetch_add(&cntl[my_e[k]], 1, __ATOMIC_RELAXED, __HIP_MEMORY_SCOPE_WORKGROUP); }
        __syncthreads();
        if (F.tid < 32) basel[F.tid] = (int)__hip_atomic_fetch_add(F.ctl + CW_CNT + F.tid, (unsigned)cntl[F.tid], RLX_AGENT);
        __syncthreads();
        if (lane < 32) { const int row = chunk * 256 + F.wave * 32 + lane; int* LIST = (int*)(ws + WS_LIST); float* GATEL = (float*)(ws + WS_GATEL); float* GATE = (float*)(ws + WS_GATE);
#pragma unroll
            for (int k = 0; k < 4; ++k) { const size_t o = (size_t)my_e[k] * 65536 + (size_t)(basel[my_e[k]] + rk[k]); LIST[o] = row * 4 + k; GATEL[o] = my_g[k]; GATE[row * 4 + k] = my_g[k]; } }
        __syncthreads();
    }
    if (F.tid == 0) { F.MISC[8] = keep0; F.MISC[9] = keep1; }
    __syncthreads();
}
__device__ __forceinline__ void ph10_final(Frame& F, const Ptrs& P) {
    const bf16* YS1 = (const bf16*)(P.ws + WS_YS1); const bf16* YS2 = (const bf16*)(P.ws + WS_YS2); const bf16* YS3 = (const bf16*)(P.ws + WS_YS3);
    const int gw = F.vcu * NWAVES + F.wave, NGW = F.G * NWAVES, lane = F.lane;
    f32x4 gam[4], bet[4];
#pragma unroll
    for (int j = 0; j < 4; ++j) { gam[j] = ((const f32x4*)P.ln2g)[lane + 64 * j]; bet[j] = ((const f32x4*)P.ln2b)[lane + 64 * j]; }
    for (int row = gw; row < M; row += NGW) {
        f32x4 v[4]; float s = 0.f;
#pragma unroll
        for (int j = 0; j < 4; ++j) { const size_t o = (size_t)row * 256 + lane + 64 * j; v[j] = ((const f32x4*)P.out)[o];
            const unsigned long long a = ((const unsigned long long*)YS1)[o], b = ((const unsigned long long*)YS2)[o], c = ((const unsigned long long*)YS3)[o];
            const unsigned a0 = (unsigned)a, a1 = (unsigned)(a >> 32), b0 = (unsigned)b, b1 = (unsigned)(b >> 32), c0 = (unsigned)c, c1 = (unsigned)(c >> 32);
            v[j].x += (pg8::bflo(a0) + pg8::bflo(b0)) + pg8::bflo(c0); v[j].y += (pg8::bfhi(a0) + pg8::bfhi(b0)) + pg8::bfhi(c0);
            v[j].z += (pg8::bflo(a1) + pg8::bflo(b1)) + pg8::bflo(c1); v[j].w += (pg8::bfhi(a1) + pg8::bfhi(b1)) + pg8::bfhi(c1);
            s += (v[j].x + v[j].y) + (v[j].z + v[j].w); }
        const float mean = wave_sum(s) * (1.f / 1024.f); float s2 = 0.f;
#pragma unroll
        for (int j = 0; j < 4; ++j) { v[j] = v[j] - mean; s2 += (v[j].x * v[j].x + v[j].y * v[j].y) + (v[j].z * v[j].z + v[j].w * v[j].w); }
        const float rstd = rsqrtf(wave_sum(s2) * (1.f / 1024.f) + LN_EPS);
#pragma unroll
        for (int j = 0; j < 4; ++j) ((f32x4*)P.out)[(size_t)row * 256 + lane + 64 * j] = v[j] * rstd * gam[j] + bet[j];
    }
}
__device__ __forceinline__ void moe_tables(Frame& F) {
    LAS int* cnt = (LAS int*)(F.lds + pg8::TAB_CNT); LAS int* blk0 = (LAS int*)(F.lds + pg8::TAB_BLK0); LAS int* row0 = (LAS int*)(F.lds + pg8::TAB_ROW0);
    __syncthreads();
    if (F.tid < 32) cnt[F.tid] = (int)__hip_atomic_load(F.ctl + CW_CNT + F.tid, RLX_AGENT);
    __syncthreads();
    if (F.tid == 0) { int b = 0, r = 0; for (int e = 0; e < 32; ++e) { blk0[e] = b; row0[e] = r; b += (cnt[e] + 255) >> 8; r += cnt[e]; } blk0[32] = b; row0[32] = r; }
    __syncthreads();
}

constexpr int NPHASE = 11;
struct Args { Ptrs P; int ph_lo, ph_hi; };
__global__ void __launch_bounds__(NWAVES * 64, 2) mk_fwd(Args args) {
    extern __shared__ __attribute__((aligned(16))) unsigned char lds[];
    Frame F; const Ptrs& P = args.P;
    F.lds = (LAS unsigned char*)lds; F.MISC = (volatile LAS unsigned*)(F.lds + MISC_OFF);
    F.tid = threadIdx.x; F.lane = F.tid & 63; F.wave = __builtin_amdgcn_readfirstlane(F.tid >> 6);
    F.G = gridDim.x; { const int bx = blockIdx.x; F.vcu = (F.G % 8 == 0) ? (bx % 8) * (F.G / 8) + bx / 8 : bx; }
    unsigned char* ws = P.ws; F.ctl = (gu32*)(ws + WS_CTL);
    for (int u = F.tid; u < 1024 / 4; u += NWAVES * 64) ((LAS unsigned*)(F.lds + LDSCTL_OFF))[u] = 0u;
    __syncthreads();
    const int lo = args.ph_lo, hi = args.ph_hi;
    XcdBarrier bar = xcd_barrier_post((unsigned*)(F.ctl + CW_BAR) + lo * XCD_BAR_WORDS, F.MISC + 8);
#ifndef PH_COMPILE
#define PH_COMPILE 0x7ff
#endif
#define IN(k) ((((PH_COMPILE) >> (k)) & 1) && lo <= (k) && (k) < hi)
#define SEAM(k) do { if (IN(k) && IN((k) + 1)) xcd_barrier(bar); } while (0)
    bf16 *XB = (bf16*)(ws + WS_XB), *Q = (bf16*)(ws + WS_Q), *K = (bf16*)(ws + WS_K), *V = (bf16*)(ws + WS_V), *U = (bf16*)(ws + WS_U), *G = (bf16*)(ws + WS_G);
    bf16 *O16 = (bf16*)(ws + WS_O16), *OA = (bf16*)(ws + WS_OA), *PO = (bf16*)(ws + WS_PO), *MIX = (bf16*)(ws + WS_MIX), *X1B = (bf16*)(ws + WS_X1B), *HB = (bf16*)(ws + WS_HB), *PB = (bf16*)(ws + WS_PB);
    float* T = (float*)(ws + WS_T);

    if (IN(0)) { ph0_prologue(F, P); } SEAM(0);
    if (IN(1)) {
        pg8::Gemm g{XB, (const bf16*)(ws + WS_WIN), 1024}; pg8::StaticOrder S; S.init(M, 4096, F.G, (int)blockIdx.x);
        pg8::EpiProj E{Q, K, V, U, G, P.b_gate, C2Q, 0};
        pg8::gemm_phase(F.lds, g, S, E);
    } SEAM(1);
    if (IN(2)) {
        const attn_body::AttnTensors AT{(const attn_body::bf16*)Q, (const attn_body::bf16*)K, (const attn_body::bf16*)V, (attn_body::bf16*)O16};
        attn_body::attn_phase<8>((char*)lds + RING_OFF, AT, F.vcu, F.G);
#ifndef NO_POOL
        ph_pool(F, P);
#endif
    } SEAM(2);
    if (IN(3)) { ph_combine(F, P); } SEAM(3);
    if (IN(4)) {
        pg8::StaticOrder S; S.init(M, 1024, F.G, (int)blockIdx.x);
        { pg8::Gemm g{OA, (const bf16*)(ws + WS_WA), 512}; pg8::EpiMix<false> E{MIX, G}; pg8::gemm_phase(F.lds, g, S, E); }
        VM_WAIT(); __syncthreads();
        { pg8::Gemm g{PO, (const bf16*)(ws + WS_WPC), 512}; pg8::EpiMix<true> E{MIX, G}; pg8::gemm_phase(F.lds, g, S, E); }
    } SEAM(4);
    if (IN(5)) {
        pg8::Gemm g{MIX, (const bf16*)(ws + WS_WOUT), 1024}; pg8::StaticOrder S; S.init(M, 1024, F.G, (int)blockIdx.x);
        pg8::EpiF32<0> E{P.out, P.x, ALPHA, 0};
        pg8::gemm_phase(F.lds, g, S, E);
    } SEAM(5);
    if (IN(6)) { ph6_ln1_route(F, P); } SEAM(6);
    if (IN(7)) {
        pg8::StaticOrder S; S.init(M, 1024, F.G, (int)blockIdx.x);
#ifndef NO_PH7A
        { pg8::Gemm g{PB, (const bf16*)(ws + WS_WPP), 256}; pg8::EpiF32<1> E{T, nullptr, 0.f, 0}; pg8::gemm_phase(F.lds, g, S, E); }
#endif
        VM_WAIT(); __syncthreads();
#ifndef NO_PH7B
        { pg8::Gemm g{X1B, (const bf16*)(ws + WS_WPG), 1024}; pg8::EpiF32<2> E{P.out, T, ALPHA, 0}; pg8::gemm_phase(F.lds, g, S, E); }
#endif
    } SEAM(7);
    if (IN(8)) {
        moe_tables(F);
        pg8::Gemm g{X1B, (const bf16*)(ws + WS_WUP), 1024}; pg8::MoeOrder<true> S{8, F.G, (int)blockIdx.x, (const int*)(ws + WS_LIST), (const float*)(ws + WS_GATEL), (size_t)2048 * 1024 * 2};
        pg8::EpiUp E{HB, P.b_up};
        pg8::gemm_phase(F.lds, g, S, E);
    } SEAM(8);
    if (IN(9)) {
        moe_tables(F);
        pg8::Gemm g{HB, (const bf16*)(ws + WS_WDN), 1024}; pg8::MoeOrder<false> S{4, F.G, (int)blockIdx.x, (const int*)(ws + WS_LIST), (const float*)(ws + WS_GATEL), (size_t)1024 * 1024 * 2};
        pg8::EpiDown E{P.out, (bf16*)(ws + WS_YS1), (bf16*)(ws + WS_YS2), (bf16*)(ws + WS_YS3), P.b_down};
        pg8::gemm_phase(F.lds, g, S, E);
    } SEAM(9);
    if (IN(10)) { ph10_final(F, P); }
#undef IN
#undef SEAM
}
#ifndef FAST_MASK
#define FAST_MASK 0x7ff
#endif
#ifndef MERGE_FAST
#define MERGE_FAST 1
#endif
extern "C" void kernel_launch(void* const* d_in, const int* in_sizes, int n_in, void* d_out, int out_size, void* d_ws, size_t ws_size, hipStream_t stream) {
    static int grid = 0;
    if (grid == 0) {
        if (n_in != 26 || ws_size < WS_END || out_size != M * D) { fprintf(stderr, "kernel_launch: unexpected shapes (n_in %d, ws %zu, out %d)\n", n_in, ws_size, out_size); grid = -1; return; }
        int dev = 0, cus = 0, per_cu = 0;
        if (hipGetDevice(&dev) != hipSuccess || hipDeviceGetAttribute(&cus, hipDeviceAttributeMultiprocessorCount, dev) != hipSuccess) { grid = -1; return; }
        if (hipFuncSetAttribute((const void*)mk_fwd, hipFuncAttributeMaxDynamicSharedMemorySize, LDS_BYTES) != hipSuccess) { fprintf(stderr, "kernel_launch: hipFuncSetAttribute failed\n"); grid = -1; return; }
        if (hipOccupancyMaxActiveBlocksPerMultiprocessor(&per_cu, (const void*)mk_fwd, NWAVES * 64, LDS_BYTES) != hipSuccess || per_cu < 1) fprintf(stderr, "kernel_launch: occupancy query says %d\n", per_cu);
        (void)hipGetLastError();
        grid = cus;
    }
    if (grid < 0) return;
    Ptrs P{};
    { const float** pp = (const float**)&P; for (int i = 0; i < 26; ++i) pp[i] = (const float*)d_in[i]; }
    P.out = (float*)d_out; P.ws = (unsigned char*)d_ws;
    unsigned char* ws = (unsigned char*)d_ws; float* out = (float*)d_out;
    unsigned* CTL = (unsigned*)(ws + WS_CTL); unsigned* CNT = CTL + CW_CNT; int* LIST = (int*)(ws + WS_LIST); float* GATE = (float*)(ws + WS_GATE); float* GATEL = (float*)(ws + WS_GATEL); float* WPCF = (float*)(ws + WS_WPCF);
    bf16 *XB = (bf16*)(ws + WS_XB), *PB = (bf16*)(ws + WS_PB), *Q = (bf16*)(ws + WS_Q), *K = (bf16*)(ws + WS_K), *V = (bf16*)(ws + WS_V), *U = (bf16*)(ws + WS_U), *G = (bf16*)(ws + WS_G);
    bf16 *O16 = (bf16*)(ws + WS_O16), *OA = (bf16*)(ws + WS_OA), *PO = (bf16*)(ws + WS_PO), *MIX = (bf16*)(ws + WS_MIX), *X1B = (bf16*)(ws + WS_X1B), *HB = (bf16*)(ws + WS_HB);
    bf16 *YS1 = (bf16*)(ws + WS_YS1), *YS2 = (bf16*)(ws + WS_YS2), *YS3 = (bf16*)(ws + WS_YS3); float* T = (float*)(ws + WS_T);
    (void)hipMemsetAsync(ws + WS_CTL, 0, CTL_ZERO_BYTES, stream);
    const unsigned fm = FAST_MASK;
    for (int ph = 0; ph < NPHASE;) {
        if ((fm >> ph) & 1u) {
            int hi = ph + 1; if (MERGE_FAST) while (hi < NPHASE && ((fm >> hi) & 1u)) ++hi;
            Args a{}; a.P = P; a.ph_lo = ph; a.ph_hi = hi;
            hipLaunchKernelGGL(mk_fwd, dim3(grid), dim3(NWAVES * 64), LDS_BYTES, stream, a);
            if (fm != 0x7ffu && ph == 0) { nv::k_fold_pool<<<512, 256, 0, stream>>>(P.w_pmix, P.pscale, P.w_pbr, WPCF); }
            ph = hi; continue;
        }
        switch (ph) {
        case 0: nv::k_cvt_bf16<<<2048, 256, 0, stream>>>(P.x, XB, (size_t)M * D / 4); nv::k_fold_pool<<<512, 256, 0, stream>>>(P.w_pmix, P.pscale, P.w_pbr, WPCF); break;
        case 1: nv::k_gemm<false><<<dim3(4096 / 64, M / 64, 1), 256, 0, stream>>>(nv::RowDense{XB, 1024, 0}, nv::EpiProj{Q, K, V, U, G, P.b_gate, C2Q, 0}, P.w_in, 0, 4096, 1024, 0, 0); break;
        case 2: nv::k_attn<<<dim3(SEQ / 256, 16, BATCH), 256, 0, stream>>>(Q, K, V, O16); nv::k_pool<<<(unsigned)((size_t)M * 512 / 256), 256, 0, stream>>>(U, PO); break;
        case 3: nv::k_combine<<<M / 4, 256, 0, stream>>>(O16, OA, P.lq1, P.lk1, P.lq2, P.lk2, P.subln); break;
        case 4: nv::k_gemm<false><<<dim3(1024 / 64, M / 64, 1), 256, 0, stream>>>(nv::RowDense{OA, 512, 0}, nv::EpiMixA{MIX, G}, P.w_abr, 0, 1024, 512, 0, 0);
                nv::k_gemm<false><<<dim3(1024 / 64, M / 64, 1), 256, 0, stream>>>(nv::RowDense{PO, 512, 0}, nv::EpiMixB{MIX, G}, WPCF, 0, 1024, 512, 0, 0); break;
        case 5: nv::k_gemm<false><<<dim3(1024 / 64, M / 64, 1), 256, 0, stream>>>(nv::RowDense{MIX, 1024, 0}, nv::EpiPre1{out, P.x, ALPHA, 0}, P.w_out, 0, 1024, 1024, 0, 0); break;
        case 6: nv::k_ln1_route<<<M, 256, 0, stream>>>(out, X1B, P.ln1g, P.ln1b, P.w_router, P.b_router, CNT, LIST, GATE, GATEL);
                nv::k_cvt_bf16<<<2048, 256, 0, stream>>>(P.p, PB, (size_t)M * PLE / 4); break;
        case 7: nv::k_gemm<false><<<dim3(1024 / 64, M / 64, 1), 256, 0, stream>>>(nv::RowDense{PB, 256, 0}, nv::EpiStoreF32{T}, P.w_pp, 0, 1024, 256, 0, 0);
                nv::k_gemm<false><<<dim3(1024 / 64, M / 64, 1), 256, 0, stream>>>(nv::RowDense{X1B, 1024, 0}, nv::EpiBase{out, T, ALPHA, 0}, P.w_pg, 0, 1024, 1024, 0, 0); break;
        case 8: nv::k_gemm<true><<<dim3(1024 / 64, M / 64, NEXP), 256, 0, stream>>>(nv::RowGather{X1B, LIST, CNT}, nv::EpiUp{HB, P.b_up, CNT}, P.w_up, (size_t)1024 * 2048, 2048, 1024, 1024, 0); break;
        case 9: nv::k_gemm<false><<<dim3(1024 / 64, M / 64, NEXP), 256, 0, stream>>>(nv::RowSlots{HB, CNT}, nv::EpiDown{out, YS1, YS2, YS3, P.b_down, LIST, GATE, CNT}, P.w_down, (size_t)1024 * 1024, 1024, 1024, 0, 0); break;
        case 10: nv::k_final<<<M, 256, 0, stream>>>(out, YS1, YS2, YS3, P.ln2g, P.ln2b); break;
        }
        ++ph;
    }
}
```

```cpp
#define FAST_MASK 0x7ff
#include <hip/hip_runtime.h>
#include <hip/hip_bf16.h>
#include <cstdio>
#include <cstdint>
#include <cmath>

#define GAS __attribute__((address_space(1)))
#define LAS __attribute__((address_space(3)))
typedef unsigned short bf16;
typedef unsigned v4u __attribute__((ext_vector_type(4)));
typedef float f32x4 __attribute__((ext_vector_type(4)));
typedef short bf16x8 __attribute__((ext_vector_type(8)));
typedef GAS unsigned gu32;
typedef GAS unsigned long long gu64;
#define RLX_AGENT __ATOMIC_RELAXED, __HIP_MEMORY_SCOPE_AGENT
#define LDS_WAIT() asm volatile("s_waitcnt lgkmcnt(0)" ::: "memory")
#define VM_WAIT() asm volatile("s_waitcnt vmcnt(0)" ::: "memory")
__device__ __forceinline__ unsigned f2bf(float f) { unsigned u = __builtin_bit_cast(unsigned, f); return (u + 0x7fffu + ((u >> 16) & 1u)) >> 16; }
__device__ __forceinline__ unsigned pk2(float lo, float hi) { return f2bf(lo) | (f2bf(hi) << 16); }

__device__ __forceinline__ int lane_id() { return (int)__builtin_amdgcn_mbcnt_hi(~0u, __builtin_amdgcn_mbcnt_lo(~0u, 0u)); }

constexpr int BATCH = 16, SEQ = 4096, D = 1024, M = BATCH * SEQ;
constexpr int NEXP = 32, TOPK = 4, NASSIGN = M * TOPK, FF = 1024, PLE = 256;
constexpr float LN_EPS = 1e-5f;
constexpr float ALPHA = 1.189207115002721f;
constexpr float C2Q = 0.125f * 1.4426950408889634f;

constexpr size_t MiB = 1u << 20;
constexpr size_t WS_CTL = 0, CTL_ZERO_BYTES = 1 * MiB;
constexpr size_t WS_LIST = 1 * MiB;
constexpr size_t WS_GATEL = 9 * MiB;
constexpr size_t WS_GATE = 17 * MiB;
constexpr size_t WS_WPCF = 18 * MiB;
constexpr size_t WS_WIN = 20 * MiB, WS_WCAT = 28 * MiB, WS_WOUT = 30 * MiB, WS_WPG = 32 * MiB, WS_WPP = 34 * MiB;
constexpr size_t WS_WDN = 36 * MiB, WS_WUP = 100 * MiB;
constexpr size_t WS_XB = 228 * MiB;
constexpr size_t WS_APO = 228 * MiB;
constexpr size_t WS_X1B = 228 * MiB;
constexpr size_t WS_Q = 356 * MiB, WS_K = 420 * MiB, WS_V = 484 * MiB, WS_U = 548 * MiB;
constexpr size_t WS_G = 612 * MiB;
constexpr size_t WS_O16 = 868 * MiB;
constexpr size_t WS_PB = 868 * MiB;
constexpr size_t WS_MIX = 356 * MiB;
constexpr size_t WS_T = 356 * MiB;
constexpr size_t WS_HB = 356 * MiB;
constexpr size_t WS_YS1 = 100 * MiB, WS_YS2 = 228 * MiB, WS_YS3 = 868 * MiB;
constexpr size_t WS_X1F8 = 900 * MiB;
constexpr size_t WS_END = 1024 * MiB;
#ifndef MOE_FP8
#define MOE_FP8 1
#endif
constexpr float WUP_SCALE = 32.f, WDN_SCALE = 64.f;
constexpr int CW_TMO = 0, CW_CODE = 1;
constexpr int CW_CNT = 64;
constexpr int CW_BAR = 4096;
namespace nv {
__device__ __forceinline__ float bf2f(bf16 b) { return __builtin_bit_cast(float, (unsigned)b << 16); }
__device__ __forceinline__ bf16 f2b(float f) { return (bf16)f2bf(f); }
__device__ __forceinline__ float sigm(float v) { return 1.f / (1.f + __expf(-v)); }

__global__ void k_zero_ctl(unsigned* p, int n) { int i = blockIdx.x * blockDim.x + threadIdx.x; if (i < n) p[i] = 0u; }
__global__ void k_cvt_bf16(const float* in, bf16* out, size_t n4) {
    size_t i = (size_t)blockIdx.x * blockDim.x + threadIdx.x; const size_t st = (size_t)gridDim.x * blockDim.x;
    for (; i < n4; i += st) { const f32x4 v = ((const f32x4*)in)[i]; unsigned long long o = (unsigned long long)pk2(v.x, v.y) | ((unsigned long long)pk2(v.z, v.w) << 32); ((unsigned long long*)out)[i] = o; }
}
__global__ void k_fold_pool(const float* wmix, const float* scale, const float* wpb, float* Wpc) {
    const int row = blockIdx.x, g = row >> 7, c = row & 127;
    __shared__ float wm[128];
    if (threadIdx.x < 128) wm[threadIdx.x] = wmix[(g * 128 + c) * 128 + threadIdx.x] * scale[g * 128 + threadIdx.x];
    __syncthreads();
    for (int n = threadIdx.x; n < 1024; n += 256) { float s = 0.f; for (int d = 0; d < 128; ++d) s += wm[d] * wpb[(size_t)(g * 128 + d) * 1024 + n]; Wpc[(size_t)row * 1024 + n] = s; }
}

template <bool DUAL, class RowF, class Epi>
__global__ void __launch_bounds__(256) k_gemm(RowF rf, Epi epi, const float* W, size_t wz, int ldw, int K, int dualoff, int pad_) {
    __shared__ float As[16][68]; __shared__ float Bs[16][64]; __shared__ float Bs2[DUAL ? 16 : 1][64];
    const int tid = threadIdx.x, ty = tid >> 4, tx = tid & 15, z = blockIdx.z;
    const int row0 = blockIdx.y * 64, col0 = blockIdx.x * 64;
    if (!rf.active(z, row0)) return;
    const float* Wz = W + (size_t)z * wz;
    float acc[4][4] = {}, acc2[4][4] = {};
    const int ar = tid >> 2, ak = (tid & 3) * 4; const bf16* arow = rf.row(z, row0 + ar);
    const int bk = tid >> 4, bc = (tid & 15) * 4;
    for (int k0 = 0; k0 < K; k0 += 16) {
        { const unsigned long long v = arow ? *(const unsigned long long*)(arow + k0 + ak) : 0ull;
          As[ak + 0][ar] = bf2f((bf16)(v & 0xffff)); As[ak + 1][ar] = bf2f((bf16)((v >> 16) & 0xffff)); As[ak + 2][ar] = bf2f((bf16)((v >> 32) & 0xffff)); As[ak + 3][ar] = bf2f((bf16)(v >> 48)); }
        { const f32x4 v = *(const f32x4*)(Wz + (size_t)(k0 + bk) * ldw + col0 + bc); Bs[bk][bc] = v.x; Bs[bk][bc + 1] = v.y; Bs[bk][bc + 2] = v.z; Bs[bk][bc + 3] = v.w;
          if (DUAL) { const f32x4 w = *(const f32x4*)(Wz + (size_t)(k0 + bk) * ldw + dualoff + col0 + bc); Bs2[bk][bc] = w.x; Bs2[bk][bc + 1] = w.y; Bs2[bk][bc + 2] = w.z; Bs2[bk][bc + 3] = w.w; } }
        __syncthreads();
#pragma unroll
        for (int k = 0; k < 16; ++k) { float a[4], b[4], b2[4];
#pragma unroll
            for (int i = 0; i < 4; ++i) { a[i] = As[k][ty * 4 + i]; b[i] = Bs[k][tx * 4 + i]; b2[i] = DUAL ? Bs2[k][tx * 4 + i] : 0.f; }
#pragma unroll
            for (int i = 0; i < 4; ++i)
#pragma unroll
                for (int j = 0; j < 4; ++j) { acc[i][j] += a[i] * b[j]; if (DUAL) acc2[i][j] += a[i] * b2[j]; } }
        __syncthreads();
    }
#pragma unroll
    for (int i = 0; i < 4; ++i)
#pragma unroll
        for (int j = 0; j < 4; ++j) epi(z, row0 + ty * 4 + i, col0 + tx * 4 + j, acc[i][j], acc2[i][j]);
}
struct RowDense { const bf16* A; int lda; int pad; __device__ bool active(int, int) const { return true; } __device__ const bf16* row(int, int r) const { return A + (size_t)r * lda; } };

struct EpiProj { bf16 *Q, *K, *V, *U, *G; const float* bg; float c2; int pad;
    __device__ void operator()(int, int r, int c, float v, float) const {
        if (c < 512) Q[(size_t)r * 512 + c] = f2b(v * c2); else if (c < 1024) K[(size_t)r * 512 + c - 512] = f2b(v); else if (c < 1536) V[(size_t)r * 512 + c - 1024] = f2b(v);
        else if (c < 2048) U[(size_t)r * 512 + c - 1536] = f2b(v); else G[(size_t)r * 2048 + c - 2048] = f2b(sigm(v + bg[c - 2048])); } };
struct EpiMixA { bf16* MIX; const bf16* G; __device__ void operator()(int, int r, int c, float v, float) const { MIX[(size_t)r * 1024 + c] = f2b(bf2f(G[(size_t)r * 2048 + c]) * v); } };
struct EpiMixB { bf16* MIX; const bf16* G; __device__ void operator()(int, int r, int c, float v, float) const { MIX[(size_t)r * 1024 + c] = f2b(bf2f(MIX[(size_t)r * 1024 + c]) + bf2f(G[(size_t)r * 2048 + 1024 + c]) * v); } };
struct EpiPre1 { float* out; const float* x; float alpha; int pad; __device__ void operator()(int, int r, int c, float v, float) const { out[(size_t)r * 1024 + c] = alpha * x[(size_t)r * 1024 + c] + v; } };
struct EpiStoreF32 { bf16* T; __device__ void operator()(int, int r, int c, float v, float) const { T[(size_t)r * 1024 + c] = f2b(v); } };
struct EpiBase { float* base; const bf16* T; float alpha; int pad; __device__ void operator()(int, int r, int c, float v, float) const { const size_t i = (size_t)r * 1024 + c; base[i] = alpha * base[i] + sigm(v) * bf2f(T[i]); } };

__global__ void __launch_bounds__(256) k_attn(const bf16* Q, const bf16* K, const bf16* V, bf16* O16) {
    __shared__ float Ks[64][64]; __shared__ float Vs[64][64];
    const int qb = blockIdx.x, vh = blockIdx.y, b = blockIdx.z, tid = threadIdx.x;
    const int hm = vh >> 1, half = vh & 1, h = hm >> 1;
    const float c2 = exp2f(-2.f * (h + 1)) * 1.4426950408889634f;
    const int i = qb * 256 + tid; const size_t rowb = (size_t)b * SEQ;
    float q[64], acc[64];
    { const bf16* qp = Q + (rowb + i) * 512 + hm * 64;
#pragma unroll
      for (int d = 0; d < 64; ++d) { q[d] = bf2f(qp[d]); acc[d] = 0.f; } }
    float m = -INFINITY, l = 0.f;
    const int ntile = (qb * 256 + 256) / 64;
    for (int t = 0; t < ntile; ++t) {
        __syncthreads();
        for (int e = tid; e < 64 * 64; e += 256) { const int j = e >> 6, d = e & 63; const size_t r = rowb + t * 64 + j;
            Ks[j][d] = bf2f(K[r * 512 + hm * 64 + d]); Vs[j][d] = bf2f(V[r * 512 + h * 128 + half * 64 + d]); }
        __syncthreads();
        for (int j = 0; j < 64; ++j) { const int jj = t * 64 + j; if (jj > i) break;
            float s = 0.f;
#pragma unroll
            for (int d = 0; d < 64; ++d) s += q[d] * Ks[j][d];
            s -= c2 * (float)(i - jj);
            if (s > m) { const float f = exp2f(m - s); l *= f;
#pragma unroll
                for (int d = 0; d < 64; ++d) acc[d] *= f;
                m = s; }
            const float p = exp2f(s - m); l += p;
#pragma unroll
            for (int d = 0; d < 64; ++d) acc[d] += p * Vs[j][d]; }
    }
    const float rl = 1.f / l; bf16* op = O16 + (rowb + i) * 1024 + h * 256 + (hm & 1) * 128 + half * 64;
#pragma unroll
    for (int d = 0; d < 64; ++d) op[d] = f2b(acc[d] * rl);
}
__device__ __forceinline__ float lam_value(const float* lq1, const float* lk1, const float* lq2, const float* lk2) {
    float a = 0.f, b = 0.f; for (int d = 0; d < 64; ++d) { a += lq1[d] * lk1[d]; b += lq2[d] * lk2[d]; } return __expf(a) - __expf(b) + 0.2f; }
__global__ void __launch_bounds__(256) k_combine(const bf16* O16, bf16* OA, const float* lq1, const float* lk1, const float* lq2, const float* lk2, const float* sg) {
    const float lam = lam_value(lq1, lk1, lq2, lk2);
    const int row = blockIdx.x * 4 + (threadIdx.x >> 6), lane = threadIdx.x & 63, h = lane >> 4, e0 = (lane & 15) * 8;
    const bf16* a = O16 + (size_t)row * 1024 + h * 256 + e0; const bf16* bb = a + 128;
    float o[8], ss = 0.f;
#pragma unroll
    for (int j = 0; j < 8; ++j) { o[j] = bf2f(a[j]) - lam * bf2f(bb[j]); ss += o[j] * o[j]; }
    ss += __shfl_xor(ss, 1); ss += __shfl_xor(ss, 2); ss += __shfl_xor(ss, 4); ss += __shfl_xor(ss, 8);
    const float r = rsqrtf(ss * (1.f / 128.f) + LN_EPS) * 0.8f;
#pragma unroll
    for (int j = 0; j < 8; ++j) OA[(size_t)row * 1024 + h * 128 + e0 + j] = f2b(o[j] * r * sg[e0 + j]);
}
__global__ void __launch_bounds__(256) k_pool(const bf16* U, bf16* PO) {
    const size_t idx = (size_t)blockIdx.x * 256 + threadIdx.x; const int c = (int)(idx & 511); const size_t row = idx >> 9; const int pos = (int)(row & (SEQ - 1));
    const int w = 2 << (c >> 7); const int n = pos + 1 < w ? pos + 1 : w; float s = 0.f;
    for (int k = 0; k < n; ++k) s += bf2f(U[(row - k) * 512 + c]);
    PO[row * 1024 + c] = f2b(s / (float)n - bf2f(U[row * 512 + c]));
}
__global__ void __launch_bounds__(256) k_ln1_route(float* X1, bf16* X1B, const float* g, const float* bta, const float* wr, const float* br, unsigned* CNT, int* LIST, float* GATE, float* GATEL) {
    __shared__ float xs[1024]; __shared__ float red[8]; __shared__ float part[8][32]; __shared__ float lg[32];
    const int row = blockIdx.x, tid = threadIdx.x, lane = tid & 63, wv = tid >> 6;
    f32x4 v = ((const f32x4*)(X1 + (size_t)row * 1024))[tid];
    float s = (v.x + v.y) + (v.z + v.w); for (int o = 1; o < 64; o <<= 1) s += __shfl_xor(s, o);
    if (lane == 0) red[wv] = s; __syncthreads(); const float mean = (red[0] + red[1] + red[2] + red[3]) * (1.f / 1024.f); __syncthreads();
    v = v - mean; float q = (v.x * v.x + v.y * v.y) + (v.z * v.z + v.w * v.w); for (int o = 1; o < 64; o <<= 1) q += __shfl_xor(q, o);
    if (lane == 0) red[wv] = q; __syncthreads(); const float rstd = rsqrtf((red[0] + red[1] + red[2] + red[3]) * (1.f / 1024.f) + LN_EPS);
    const f32x4 gg = ((const f32x4*)g)[tid], bb = ((const f32x4*)bta)[tid]; v = v * rstd * gg + bb;
    ((f32x4*)(X1 + (size_t)row * 1024))[tid] = v; ((unsigned long long*)(X1B + (size_t)row * 1024))[tid] = (unsigned long long)pk2(v.x, v.y) | ((unsigned long long)pk2(v.z, v.w) << 32);
    xs[tid * 4] = v.x; xs[tid * 4 + 1] = v.y; xs[tid * 4 + 2] = v.z; xs[tid * 4 + 3] = v.w; __syncthreads();
    { const int e = tid & 31, pt = tid >> 5; float a = 0.f; for (int k = pt * 128; k < pt * 128 + 128; ++k) a += xs[k] * wr[k * 32 + e]; part[pt][e] = a; }
    __syncthreads();
    if (tid < 32) { float a = br[tid]; for (int pt = 0; pt < 8; ++pt) a += part[pt][tid]; lg[tid] = a; }
    __syncthreads();
    if (tid == 0) { int id[4]; float vv[4]; unsigned used = 0u;
        for (int k = 0; k < 4; ++k) { int bi = 0; float bv = -INFINITY; for (int e = 0; e < 32; ++e) if (!((used >> e) & 1u) && lg[e] > bv) { bv = lg[e]; bi = e; } used |= 1u << bi; id[k] = bi; vv[k] = bv; }
        float es[4], sum = 0.f; for (int k = 0; k < 4; ++k) { es[k] = __expf(vv[k] - vv[0]); sum += es[k]; }
        for (int k = 0; k < 4; ++k) { const unsigned pos = atomicAdd(&CNT[id[k]], 1u); LIST[(size_t)id[k] * 65536 + pos] = row * 4 + k; GATEL[(size_t)id[k] * 65536 + pos] = es[k] / sum; GATE[row * 4 + k] = es[k] / sum; } }
}
struct RowGather { const bf16* X1B; const int* LIST; const unsigned* CNT;
    __device__ bool active(int e, int row0) const { return (unsigned)row0 < CNT[e]; }
    __device__ const bf16* row(int e, int r) const { return (unsigned)r < CNT[e] ? X1B + (size_t)(LIST[(size_t)e * 65536 + r] >> 2) * 1024 : nullptr; } };
__device__ __forceinline__ unsigned slot_off(const unsigned* CNT, int e) { unsigned o = 0; for (int i = 0; i < e; ++i) o += CNT[i]; return o; }
struct EpiUp { bf16* HB; const float* bup; const unsigned* CNT;
    __device__ void operator()(int e, int r, int c, float glu, float lin) const { if ((unsigned)r >= CNT[e]) return;
        glu += bup[e * 2048 + c]; lin += bup[e * 2048 + 1024 + c]; glu = fminf(glu, 7.f); lin = fminf(fmaxf(lin, -7.f), 7.f);
        HB[(size_t)(slot_off(CNT, e) + r) * 1024 + c] = f2b(glu * sigm(1.702f * glu) * (lin + 1.f)); } };
struct RowSlots { const bf16* HB; const unsigned* CNT;
    __device__ bool active(int e, int row0) const { return (unsigned)row0 < CNT[e]; }
    __device__ const bf16* row(int e, int r) const { return (unsigned)r < CNT[e] ? HB + (size_t)(slot_off(CNT, e) + r) * 1024 : nullptr; } };
struct EpiDown { float* base; bf16* YS1; bf16* YS2; bf16* YS3; const float* bdn; const int* LIST; const float* GATE; const unsigned* CNT;
    __device__ void operator()(int e, int r, int c, float v, float) const { if ((unsigned)r >= CNT[e]) return;
        const int a = LIST[(size_t)e * 65536 + r], tok = a >> 2, k = a & 3; const float y = (v + bdn[e * 1024 + c]) * GATE[a]; const size_t i = (size_t)tok * 1024 + c;
        if (k == 0) base[i] += y; else if (k == 1) YS1[i] = f2b(y); else if (k == 2) YS2[i] = f2b(y); else YS3[i] = f2b(y); } };
__global__ void __launch_bounds__(256) k_final(float* out, const bf16* YS1, const bf16* YS2, const bf16* YS3, const float* g, const float* bta) {
    __shared__ float red[8]; const int row = blockIdx.x, tid = threadIdx.x, lane = tid & 63, wv = tid >> 6; const size_t i0 = (size_t)row * 1024 + tid * 4;
    f32x4 v = *(const f32x4*)(out + i0);
    const bf16* ys[3] = {YS1, YS2, YS3};
    for (int k = 0; k < 3; ++k) { const unsigned long long w = *(const unsigned long long*)(ys[k] + i0); v.x += bf2f((bf16)(w & 0xffff)); v.y += bf2f((bf16)((w >> 16) & 0xffff)); v.z += bf2f((bf16)((w >> 32) & 0xffff)); v.w += bf2f((bf16)(w >> 48)); }
    float s = (v.x + v.y) + (v.z + v.w); for (int o = 1; o < 64; o <<= 1) s += __shfl_xor(s, o);
    if (lane == 0) red[wv] = s; __syncthreads(); const float mean = (red[0] + red[1] + red[2] + red[3]) * (1.f / 1024.f); __syncthreads();
    v = v - mean; float q = (v.x * v.x + v.y * v.y) + (v.z * v.z + v.w * v.w); for (int o = 1; o < 64; o <<= 1) q += __shfl_xor(q, o);
    if (lane == 0) red[wv] = q; __syncthreads(); const float rstd = rsqrtf((red[0] + red[1] + red[2] + red[3]) * (1.f / 1024.f) + LN_EPS);
    const f32x4 gg = ((const f32x4*)g)[tid], bb = ((const f32x4*)bta)[tid]; *(f32x4*)(out + i0) = v * rstd * gg + bb;
}
}
namespace pg8 {
#define PG8_LAS __attribute__((address_space(3)))
typedef unsigned short bf16_t;
typedef unsigned u32x4 __attribute__((ext_vector_type(4)));
typedef float f32x2 __attribute__((ext_vector_type(2)));
constexpr int BM = 256, BK = 64, HALF = 128, HTB = HALF * BK * 2  , STAGE_BYTES = 8 * HTB, NXCD = 8, WGM = 8;
constexpr int TAB_OFF = 131072 + 1024;
constexpr int TAB_CNT = TAB_OFF, TAB_BLK0 = TAB_OFF + 128, TAB_ROW0 = TAB_OFF + 384, TAB_IDS = TAB_OFF + 1024, TAB_GATES = TAB_OFF + 1024 + 2048;

__host__ __device__ __forceinline__ int lds_byte(int r, int c) { const int st = (r >> 4) * 2 + (c >> 5), rr = r & 15, cc = c & 31, ob = rr * 64 + cc * 2; return st * 1024 + (ob ^ (((ob >> 9) & 1) << 5)); }
__host__ __device__ __forceinline__ void stage_rc(int b, int& R, int& C) { const int st = b / 1024, sb = b % 1024, swz = sb ^ (((sb >> 9) & 1) << 5); R = (st >> 1) * 16 + swz / 64; C = (st & 1) * 32 + (swz % 64) / 2; }
__host__ __device__ __forceinline__ int perm32(int rho) { const int n = rho >> 4, i = rho & 15; return 8 * (i >> 2) + 4 * n + (i & 3); }

struct Unit { int pm, pn, e, nvalid; };
struct Gemm { const bf16_t* A; const bf16_t* Bt; int K; };

struct StaticOrder {
    static constexpr bool TABLES = false, FP8 = false;
    int nM, nN, nwg, G, c;
    __host__ __device__ void init(int M, int N, int G_, int c_) { nM = M / BM; nN = N / BM; nwg = nM * nN; G = G_; c = c_; }
    __device__ __forceinline__ bool next(int i, Unit& u, PG8_LAS unsigned char*) const {
        const long L = (long)i * G + c; if (L >= nwg) return false;
        int wgid = (int)L; { const int q = nwg / NXCD, r = nwg % NXCD, xcd = wgid % NXCD, off = wgid / NXCD; wgid = (xcd < r ? xcd * (q + 1) : r * (q + 1) + (xcd - r) * q) + off; }
        const int nig = WGM * nN, gid = wgid / nig, fm = gid * WGM, gsz = (nM - fm) < WGM ? (nM - fm) : WGM;
        u.pm = fm + ((wgid % nig) % gsz); u.pn = (wgid % nig) / gsz; u.e = 0; u.nvalid = 256; return true;
    }
    __device__ __forceinline__ const char* b_tile(const Gemm& g, const Unit& u) const { return (const char*)g.Bt + (size_t)u.pn * (size_t)(BM * 2) * g.K; }
    __device__ __forceinline__ void a_offsets(const Gemm& g, const Unit& u, PG8_LAS unsigned char*, int, const int (&R)[2], const int (&C)[2], unsigned (&off)[2][2]) const {
#pragma unroll
        for (int h = 0; h < 2; ++h)
#pragma unroll
            for (int i = 0; i < 2; ++i) off[h][i] = (unsigned)(((u.pm * BM + h * HALF + R[i]) * g.K + C[i]) * 2);
    }
    __device__ __forceinline__ void issue_tables(const Unit&, PG8_LAS unsigned char*, int, int) const {}
};

template <bool GATHER_, bool FP8_> struct MoeOrder {
    static constexpr bool TABLES = true; static constexpr bool GATHER = GATHER_, FP8 = FP8_;
    int NT, G, c; const int* LIST; const float* GATEL; size_t bstride;
    __device__ __forceinline__ bool next(int i, Unit& u, PG8_LAS unsigned char* lds) const {
        const PG8_LAS int* cnt = (const PG8_LAS int*)(lds + TAB_CNT); const PG8_LAS int* blk0 = (const PG8_LAS int*)(lds + TAB_BLK0);
        const int L = i * G + c; const int total = blk0[32] * NT; if (L >= total) return false;
        const int blk = L / NT; int e = 0;
#pragma unroll 1
        for (int j = 1; j < 32; ++j) e += (blk >= blk0[j]) ? 1 : 0;
        e = __builtin_amdgcn_readfirstlane(e);
        u.e = e; u.pm = __builtin_amdgcn_readfirstlane(blk - blk0[e]); u.pn = L % NT; const int left = __builtin_amdgcn_readfirstlane(cnt[e]) - 256 * u.pm; u.nvalid = left < 256 ? left : 256; return true;
    }
    __device__ __forceinline__ const char* b_tile(const Gemm& g, const Unit& u) const { return (const char*)g.Bt + (size_t)u.e * bstride + (size_t)u.pn * (size_t)(BM * 2) * g.K; }
    __device__ __forceinline__ void a_offsets(const Gemm& g, const Unit& u, PG8_LAS unsigned char* lds, int buf, const int (&R)[2], const int (&C)[2], unsigned (&off)[2][2]) const {
        const PG8_LAS int* ids = (const PG8_LAS int*)(lds + TAB_IDS) + buf * 256; const PG8_LAS int* row0 = (const PG8_LAS int*)(lds + TAB_ROW0);
#pragma unroll
        for (int h = 0; h < 2; ++h)
#pragma unroll
            for (int i = 0; i < 2; ++i) { const int r = h * HALF + R[i];
                if (GATHER) { const int tok = (r < u.nvalid) ? (ids[r] >> 2) : 0; off[h][i] = (unsigned)((tok * g.K + C[i]) * 2); }
                else off[h][i] = (unsigned)(((row0[u.e] + u.pm * BM + r) * g.K + C[i]) * 2); }
    }
    __device__ __forceinline__ void issue_tables(const Unit& u, PG8_LAS unsigned char* lds, int buf, int lane) const {
        const size_t o = (size_t)u.e * 65536 + (size_t)u.pm * 256 + lane * 4;
        __builtin_amdgcn_global_load_lds((const unsigned*)(LIST + o), (PG8_LAS unsigned*)(lds + TAB_IDS + buf * 1024), 16, 0, 0);
        if (!GATHER) __builtin_amdgcn_global_load_lds((const unsigned*)(GATEL + o), (PG8_LAS unsigned*)(lds + TAB_GATES + buf * 1024), 16, 0, 0);
    }
};

__device__ __forceinline__ unsigned cvt_pk_bf16(float lo, float hi) { unsigned r; asm volatile("v_cvt_pk_bf16_f32 %0, %1, %2" : "=v"(r) : "v"(lo), "v"(hi)); return r; }
__device__ __forceinline__ float bflo(unsigned w) { return __builtin_bit_cast(float, w << 16); }
__device__ __forceinline__ float bfhi(unsigned w) { return __builtin_bit_cast(float, w & 0xffff0000u); }
__device__ __forceinline__ float sigm(float v) { return __builtin_amdgcn_rcpf(1.f + __builtin_amdgcn_exp2f(-1.4426950408889634f * v)); }
__device__ __forceinline__ u32x4 pack8(const f32x4& v0, const f32x4& v1) { u32x4 w; w.x = cvt_pk_bf16(v0[0], v0[1]); w.y = cvt_pk_bf16(v0[2], v0[3]); w.z = cvt_pk_bf16(v1[0], v1[1]); w.w = cvt_pk_bf16(v1[2], v1[3]); return w; }
__device__ __forceinline__ void unpack8(const u32x4& w, f32x4& v0, f32x4& v1) { v0 = (f32x4){bflo(w.x), bfhi(w.x), bflo(w.y), bfhi(w.y)}; v1 = (f32x4){bflo(w.z), bfhi(w.z), bflo(w.w), bfhi(w.w)}; }
typedef f32x4 Acc[2][2][4][2];
typedef int i32x4 __attribute__((ext_vector_type(4)));
typedef int i32x8 __attribute__((ext_vector_type(8)));
struct bf16x8p { bf16x8 k[2]; };
template <bool F8> struct Frag { typedef bf16x8p T; };
template <> struct Frag<true> { typedef i32x8 T; };
__device__ __forceinline__ void frag_set(i32x8& d, const i32x4& lo, const i32x4& hi) { d = __builtin_shufflevector(lo, hi, 0, 1, 2, 3, 4, 5, 6, 7); }
__device__ __forceinline__ void frag_set(bf16x8p& d, const bf16x8& lo, const bf16x8& hi) { d.k[0] = lo; d.k[1] = hi; }
__device__ __forceinline__ void frag_mma(f32x4& c, const i32x8& b, const i32x8& a) { c = __builtin_amdgcn_mfma_scale_f32_16x16x128_f8f6f4(b, a, c, 0, 0, 0, 0, 0, 0); }
__device__ __forceinline__ void frag_mma(f32x4& c, const bf16x8p& b, const bf16x8p& a) { c = __builtin_amdgcn_mfma_f32_16x16x32_bf16(b.k[0], a.k[0], c, 0, 0, 0); c = __builtin_amdgcn_mfma_f32_16x16x32_bf16(b.k[1], a.k[1], c, 0, 0, 0); }
__device__ __forceinline__ unsigned pk4_fp8(float a, float b, float c, float d) { unsigned w = __builtin_amdgcn_cvt_pk_fp8_f32(a, b, 0u, false); return __builtin_amdgcn_cvt_pk_fp8_f32(c, d, w, true); }
template <class E> struct has_mid { template <class T> static constexpr bool f(decltype(T::MID)*) { return T::MID; } template <class T> static constexpr bool f(...) { return false; } static constexpr bool value = f<E>(nullptr); };

struct EpiProj {
    static constexpr bool PERM = true;
    bf16_t *Q, *K, *V, *U, *G; const float* bg; float c2; int pad;
    __device__ __forceinline__ void operator()(const Acc& acc, const Unit& u, int wr, int wc, int fr_, int fq_, PG8_LAS unsigned char*, int) const {
        int fr = fr_, fq = fq_; asm volatile("" : "+v"(fr), "+v"(fq));
        const int row0 = u.pm * BM + wr * 64 + fr; const bool isg = u.pn >= 8;
        bf16_t* base; int ldc, colt; float sc = 1.f;
        if (isg) { base = G; ldc = 2048; colt = (u.pn - 8) * BM; } else { const int t = u.pn >> 1; base = t == 0 ? Q : t == 1 ? K : t == 2 ? V : U; ldc = 512; colt = (u.pn & 1) * BM; if (t == 0) sc = c2; }
        const int col0 = colt + wc * 32 + 8 * fq;
        f32x4 bv[2][2];
#pragma unroll
        for (int bj = 0; bj < 2; ++bj)
#pragma unroll
            for (int n = 0; n < 2; ++n) bv[bj][n] = isg ? *(const f32x4*)(bg + col0 + bj * HALF + 4 * n) : (f32x4){0.f, 0.f, 0.f, 0.f};
#pragma unroll
        for (int ai = 0; ai < 2; ++ai)
#pragma unroll
            for (int m = 0; m < 4; ++m) { bf16_t* rowp = base + (size_t)(row0 + ai * HALF + m * 16) * ldc + col0;
#pragma unroll
                for (int bj = 0; bj < 2; ++bj) { f32x4 v0 = acc[ai][bj][m][0] + bv[bj][0], v1 = acc[ai][bj][m][1] + bv[bj][1];
                    if (isg) {
#pragma unroll
                        for (int i = 0; i < 4; ++i) { v0[i] = sigm(v0[i]); v1[i] = sigm(v1[i]); } }
                    v0 = v0 * sc; v1 = v1 * sc; *(u32x4*)(rowp + bj * HALF) = pack8(v0, v1); } }
    }
};
struct EpiMixCat {
    static constexpr bool PERM = true, MID = true;
    bf16_t* MIX; const bf16_t* G;
    __device__ __forceinline__ void mid(Acc& acc, const Unit& u, int wr, int wc, int fr_, int fq_) const {
        int fr = fr_, fq = fq_; asm volatile("" : "+v"(fr), "+v"(fq));
        const int row0 = u.pm * BM + wr * 64 + fr, col0 = u.pn * BM + wc * 32 + 8 * fq;
#pragma unroll
        for (int ai = 0; ai < 2; ++ai)
#pragma unroll
            for (int m = 0; m < 4; ++m) { const size_t r = (size_t)(row0 + ai * HALF + m * 16);
#pragma unroll
                for (int bj = 0; bj < 2; ++bj) { const int c = col0 + bj * HALF;
                    const u32x4 aw = *(const u32x4*)(G + r * 2048 + c), pw = *(const u32x4*)(G + r * 2048 + 1024 + c); f32x4 a0, a1, p0, p1; unpack8(aw, a0, a1); unpack8(pw, p0, p1);
#pragma unroll
                    for (int i = 0; i < 4; ++i) { acc[ai][bj][m][0][i] *= a0[i] * __builtin_amdgcn_rcpf(fmaxf(p0[i], 8.67e-19f)); acc[ai][bj][m][1][i] *= a1[i] * __builtin_amdgcn_rcpf(fmaxf(p1[i], 8.67e-19f)); }
                    asm volatile("" : "+v"(acc[ai][bj][m][0]), "+v"(acc[ai][bj][m][1]) :: "memory"); } }
    }
    __device__ __forceinline__ void operator()(const Acc& acc, const Unit& u, int wr, int wc, int fr_, int fq_, PG8_LAS unsigned char*, int) const {
        int fr = fr_, fq = fq_; asm volatile("" : "+v"(fr), "+v"(fq));
        const int row0 = u.pm * BM + wr * 64 + fr, col0 = u.pn * BM + wc * 32 + 8 * fq;
#pragma unroll
        for (int ai = 0; ai < 2; ++ai)
#pragma unroll
            for (int m = 0; m < 4; ++m) { const size_t r = (size_t)(row0 + ai * HALF + m * 16);
#pragma unroll
                for (int bj = 0; bj < 2; ++bj) { const int c = col0 + bj * HALF;
                    const u32x4 pw = *(const u32x4*)(G + r * 2048 + 1024 + c); f32x4 p0, p1; unpack8(pw, p0, p1);
#pragma unroll
                    for (int i = 0; i < 4; ++i) { p0[i] = fmaxf(p0[i], 8.67e-19f); p1[i] = fmaxf(p1[i], 8.67e-19f); }
                    *(u32x4*)(MIX + r * 1024 + c) = pack8(acc[ai][bj][m][0] * p0, acc[ai][bj][m][1] * p1); }
                asm volatile("" ::: "memory"); }
    }
};
template <int MODE> struct EpiF32 {
    static constexpr bool PERM = false;
    float* out; const float* aux; float alpha; int pad;
    __device__ __forceinline__ void operator()(const Acc& acc, const Unit& u, int wr, int wc, int fr_, int fq_, PG8_LAS unsigned char*, int) const {
        int fr = fr_, fq = fq_; asm volatile("" : "+v"(fr), "+v"(fq));
        const int col0 = u.pn * BM + wc * 32 + 4 * fq;
#pragma unroll
        for (int ai = 0; ai < 2; ++ai)
#pragma unroll
            for (int m = 0; m < 4; ++m) { const size_t off = (size_t)(u.pm * BM + ai * HALF + wr * 64 + m * 16 + fr) * 1024 + col0;
#pragma unroll
                for (int bj = 0; bj < 2; ++bj) {
#pragma unroll
                    for (int n = 0; n < 2; ++n) { const size_t o = off + bj * HALF + n * 16; const f32x4 a = acc[ai][bj][m][n]; f32x4 r;
                        if (MODE == 1) { f32x2 w; unsigned* wp = (unsigned*)&w; wp[0] = cvt_pk_bf16(a[0], a[1]); wp[1] = cvt_pk_bf16(a[2], a[3]); *(f32x2*)((bf16_t*)out + o) = w; continue; }
                        if (MODE == 0) r = *(const f32x4*)(aux + o) * alpha + a;
                        else { const f32x2 tw = *(const f32x2*)((const bf16_t*)aux + o); const unsigned* tp = (const unsigned*)&tw; const f32x4 t = {bflo(tp[0]), bfhi(tp[0]), bflo(tp[1]), bfhi(tp[1])}; const f32x4 b = *(const f32x4*)(out + o); r = b * alpha;
#pragma unroll
                            for (int i = 0; i < 4; ++i) r[i] += sigm(a[i]) * t[i]; }
                        *(f32x4*)(out + o) = r; }
                  if (MODE == 2) asm volatile("" ::: "memory"); }
                if (m & 1) asm volatile("" ::: "memory"); }
    }
};
template <bool F8> struct EpiUp {
    static constexpr bool PERM = true;
    void* HB; const float* bup; float dsc; int pad;
    __device__ __forceinline__ void operator()(const Acc& acc, const Unit& u, int wr, int wc, int fr_, int fq_, PG8_LAS unsigned char* lds, int) const {
        int fr = fr_, fq = fq_; asm volatile("" : "+v"(fr), "+v"(fq));
        const PG8_LAS int* row0t = (const PG8_LAS int*)(lds + TAB_ROW0); const int srow = row0t[u.e] + u.pm * BM;
        const int c0 = u.pn * HALF + wc * 32 + 8 * fq; const float* bp = bup + (size_t)u.e * 2048 + c0;
        const f32x4 bg0 = *(const f32x4*)(bp), bg1 = *(const f32x4*)(bp + 4), bl0 = *(const f32x4*)(bp + 1024), bl1 = *(const f32x4*)(bp + 1028);
#pragma unroll
        for (int ai = 0; ai < 2; ++ai)
#pragma unroll
            for (int m = 0; m < 4; ++m) { const int r = ai * HALF + wr * 64 + m * 16 + fr;
                f32x4 g0 = acc[ai][0][m][0] * dsc + bg0, g1 = acc[ai][0][m][1] * dsc + bg1, l0 = acc[ai][1][m][0] * dsc + bl0, l1 = acc[ai][1][m][1] * dsc + bl1;
#pragma unroll
                for (int i = 0; i < 4; ++i) { float a = fminf(g0[i], 7.f), b = fminf(fmaxf(l0[i], -7.f), 7.f); g0[i] = a * sigm(1.702f * a) * (b + 1.f);
                                              a = fminf(g1[i], 7.f); b = fminf(fmaxf(l1[i], -7.f), 7.f); g1[i] = a * sigm(1.702f * a) * (b + 1.f); }
                if (r < u.nvalid) {
                    if (F8) { f32x2 w; unsigned* wp = (unsigned*)&w; wp[0] = pk4_fp8(g0[0], g0[1], g0[2], g0[3]); wp[1] = pk4_fp8(g1[0], g1[1], g1[2], g1[3]); *(f32x2*)((unsigned char*)HB + (size_t)(srow + r) * 1024 + c0) = w; }
                    else *(u32x4*)((bf16_t*)HB + (size_t)(srow + r) * 1024 + c0) = pack8(g0, g1); } }
    }
};
struct EpiDown {
    static constexpr bool PERM = true;
    float* base; bf16_t* YS1; bf16_t* YS2; bf16_t* YS3; const float* bdn; float dsc; int pad;
    __device__ __forceinline__ void operator()(const Acc& acc, const Unit& u, int wr, int wc, int fr_, int fq_, PG8_LAS unsigned char* lds, int buf) const {
        int fr = fr_, fq = fq_; asm volatile("" : "+v"(fr), "+v"(fq));
        const PG8_LAS int* ids = (const PG8_LAS int*)(lds + TAB_IDS) + buf * 256; const PG8_LAS float* gates = (const PG8_LAS float*)(lds + TAB_GATES) + buf * 256;
        const int col0 = u.pn * BM + wc * 32 + 8 * fq; const float* bp = bdn + (size_t)u.e * 1024 + col0;
        f32x4 bv[2][2];
#pragma unroll
        for (int bj = 0; bj < 2; ++bj)
#pragma unroll
            for (int n = 0; n < 2; ++n) bv[bj][n] = *(const f32x4*)(bp + bj * HALF + 4 * n);
#pragma unroll
        for (int ai = 0; ai < 2; ++ai)
#pragma unroll
            for (int m = 0; m < 4; ++m) { const int r = ai * HALF + wr * 64 + m * 16 + fr;
                if (r < u.nvalid) { const int a = ids[r]; const float gt = gates[r]; const int k = a & 3; const size_t o = (size_t)(a >> 2) * 1024 + col0;
#pragma unroll
                    for (int bj = 0; bj < 2; ++bj) { const f32x4 v0 = (acc[ai][bj][m][0] * dsc + bv[bj][0]) * gt, v1 = (acc[ai][bj][m][1] * dsc + bv[bj][1]) * gt; const size_t oo = o + bj * HALF;
                        if (k == 0) { *(f32x4*)(base + oo) += v0; *(f32x4*)(base + oo + 4) += v1; }
                        else { bf16_t* yp = k == 1 ? YS1 : k == 2 ? YS2 : YS3; *(u32x4*)(yp + oo) = pack8(v0, v1); } } } }
    }
};

template <class Epi, class Sched>
__device__ __forceinline__ void gemm_phase(PG8_LAS unsigned char* lds, const int wid, const Gemm g, const Sched& S, const Epi& E) {
    int lane = lane_id(); asm volatile("" : "+v"(lane));
    const int tid = wid * 64 + lane, wr = wid >> 2, wc = wid & 3, fr = lane & 15, fq = lane >> 4;
    const int K = g.K, nt = K / BK;
    int RA[2], CA[2]; unsigned voffA[2], voffB[2];
#pragma unroll
    for (int i = 0; i < 2; ++i) { int R, C; stage_rc(tid * 16 + i * 8192, R, C); const int Rb = Epi::PERM ? ((R & ~31) + perm32(R & 31)) : R; RA[i] = R; CA[i] = C; voffA[i] = (unsigned)(R * K + C) * 2u; voffB[i] = (unsigned)(Rb * K + C) * 2u; }
    const size_t tstep = (size_t)BM * K * 2;
    const size_t kstep = (size_t)(BK * 2);
    const size_t hstep = (size_t)HALF * K * 2;
    const unsigned ldsw = (unsigned)wid * 1024u;
    const int aoff = lds_byte(wr * 64 + fr, fq * 8), boff = lds_byte(wc * 32 + fr, fq * 8);
#define PG8_SA(b, h) (((b) * 2 + (h)) * HTB)
#define PG8_SB(b, h) ((4 + (b) * 2 + (h)) * HTB)
#define PG8_STAGE(bufoff, gbase, voff) do { _Pragma("unroll") for (int _i = 0; _i < 2; ++_i) \
        __builtin_amdgcn_global_load_lds((const unsigned*)((const char*)(gbase) + (voff)[_i]), (PG8_LAS unsigned*)(lds + (bufoff) + ldsw + _i * 8192), 16, 0, 0); } while (0)
#define PG8_STAGE_A(bufoff, ubase, h, OFF) do { if constexpr (Sched::TABLES) PG8_STAGE(bufoff, ubase, OFF[h]); else PG8_STAGE(bufoff, (ubase) + ((h) ? hstep : 0), voffA); } while (0)
#define PG8_LDA(dst, b, h) do { _Pragma("unroll") for (int m = 0; m < 4; ++m) { if constexpr (Sched::FP8) dst##8[m] = __builtin_shufflevector(*(const PG8_LAS i32x4*)(lds + PG8_SA(b, h) + aoff + m * 2048), *(const PG8_LAS i32x4*)(lds + PG8_SA(b, h) + aoff + m * 2048 + 1024), 0, 1, 2, 3, 4, 5, 6, 7); \
        else { _Pragma("unroll") for (int k = 0; k < 2; ++k) dst[m][k] = *(const PG8_LAS bf16x8*)(lds + PG8_SA(b, h) + aoff + m * 2048 + k * 1024); } } } while (0)
#define PG8_LDB(dst, b, h) do { _Pragma("unroll") for (int n = 0; n < 2; ++n) { if constexpr (Sched::FP8) dst##8[n] = __builtin_shufflevector(*(const PG8_LAS i32x4*)(lds + PG8_SB(b, h) + boff + n * 2048), *(const PG8_LAS i32x4*)(lds + PG8_SB(b, h) + boff + n * 2048 + 1024), 0, 1, 2, 3, 4, 5, 6, 7); \
        else { _Pragma("unroll") for (int k = 0; k < 2; ++k) dst[n][k] = *(const PG8_LAS bf16x8*)(lds + PG8_SB(b, h) + boff + n * 2048 + k * 1024); } } } while (0)
#define PG8_MMA(ai, bj, At, Bt) do { __builtin_amdgcn_s_setprio(1); if constexpr (Sched::FP8) asm volatile("s_nop 1"); _Pragma("unroll") for (int m = 0; m < 4; ++m) _Pragma("unroll") for (int n = 0; n < 2; ++n) { \
        if constexpr (Sched::FP8) asm volatile("v_mfma_f32_16x16x128_f8f6f4 %0, %1, %2, %0" : "+v"(acc[ai][bj][m][n]) : "v"(Bt##8[n]), "v"(At##8[m]));   \
        else { _Pragma("unroll") for (int k = 0; k < 2; ++k) acc[ai][bj][m][n] = __builtin_amdgcn_mfma_f32_16x16x32_bf16(Bt[n][k], At[m][k], acc[ai][bj][m][n], 0, 0, 0); } } __builtin_amdgcn_s_setprio(0); } while (0)
#define PG8_WAIT_V(n) asm volatile("s_waitcnt vmcnt(" #n ")" ::: "memory")
#define PG8_WAIT_L(n) asm volatile("s_waitcnt lgkmcnt(" #n ")" ::: "memory")
#define PG8_BAR __builtin_amdgcn_s_barrier()
#define PG8_SCHED __builtin_amdgcn_sched_barrier(0)
    Unit cur, nxt; int ui = 0;
    if (!S.next(0, cur, lds)) return;
    if constexpr (Sched::TABLES) {
        if (wid == 0) S.issue_tables(cur, lds, 0, lane);
        PG8_WAIT_V(0); PG8_BAR;
    }
    Acc acc;
#pragma unroll
    for (int a = 0; a < 2; ++a)
#pragma unroll
        for (int b = 0; b < 2; ++b)
#pragma unroll
            for (int m = 0; m < 4; ++m)
#pragma unroll
                for (int n = 0; n < 2; ++n) acc[a][b][m][n] = (f32x4){0.f, 0.f, 0.f, 0.f};
    bf16x8 At[4][2], B0[2][2], B1[2][2];
    i32x8 At8[4], B08[2], B18[2];
    unsigned offc[2][2], offn[2][2];
    if constexpr (Sched::TABLES) { S.a_offsets(g, cur, lds, 0, RA, CA, offc);
#pragma unroll
        for (int h = 0; h < 2; ++h)
#pragma unroll
            for (int i = 0; i < 2; ++i) offn[h][i] = offc[h][i]; }
    const char* const Ab = (const char*)g.A;
    const char* cA = Sched::TABLES ? Ab : Ab + (size_t)cur.pm * tstep;
    const char* cB = S.b_tile(g, cur);
    PG8_STAGE(PG8_SB(0, 0), cB, voffB); PG8_STAGE(PG8_SB(0, 1), cB + hstep, voffB); PG8_STAGE_A(PG8_SA(0, 0), cA, 0, offc); PG8_STAGE_A(PG8_SA(0, 1), cA, 1, offc);
    if (wr == 1) PG8_BAR;
    PG8_WAIT_V(2); PG8_BAR;
    PG8_STAGE(PG8_SB(1, 0), cB + kstep, voffB); PG8_STAGE_A(PG8_SA(1, 0), cA + kstep, 0, offc); PG8_STAGE(PG8_SB(1, 1), cB + hstep + kstep, voffB);
    PG8_WAIT_V(6); PG8_BAR;
    for (;;) {
        const bool has_next = S.next(ui + 1, nxt, lds);
        const char* nB = has_next ? S.b_tile(g, nxt) : cB;
        const char* nA = Sched::TABLES ? Ab : (has_next ? Ab + (size_t)nxt.pm * tstep : cA);
#pragma nounroll
        for (int t = 0; t < nt; t += 2) {
            const bool last = (t == nt - 2);
            if constexpr (has_mid<Epi>::value) { if (t == nt / 2) E.mid(acc, cur, wr, wc, fr, fq); }
            if constexpr (Sched::TABLES) {
                if (t == 2 && has_next && wid == 0) S.issue_tables(nxt, lds, (ui + 1) & 1, lane);
                if (t == (nt >= 16 ? nt - 6 : nt - 2) && has_next) S.a_offsets(g, nxt, lds, (ui + 1) & 1, RA, CA, offn);
            }
            unsigned o2[2][2];
            if constexpr (Sched::TABLES) {
#pragma unroll
                for (int h = 0; h < 2; ++h)
#pragma unroll
                    for (int i = 0; i < 2; ++i) o2[h][i] = last ? offn[h][i] : offc[h][i]; }
            const char* a1 = cA + (size_t)(t + 1) * kstep;
            const char* a2 = last ? nA : cA + (size_t)(t + 2) * kstep; const char* b2 = last ? nB : cB + (size_t)(t + 2) * kstep;
            const char* a3 = a2 + kstep; const char* b3 = b2 + kstep;
            PG8_LDB(B0, 0, 0); PG8_LDB(B1, 0, 1); PG8_SCHED; PG8_LDA(At, 0, 0); PG8_STAGE_A(PG8_SA(1, 1), a1, 1, offc);
            PG8_WAIT_V(8); PG8_WAIT_L(0); PG8_BAR; PG8_MMA(0, 0, At, B0); PG8_MMA(0, 1, At, B1); PG8_BAR; PG8_SCHED;
            PG8_LDA(At, 0, 1); PG8_STAGE(PG8_SB(0, 0), b2, voffB); PG8_STAGE(PG8_SB(0, 1), b2 + hstep, voffB); PG8_STAGE_A(PG8_SA(0, 0), a2, 0, o2);
            PG8_WAIT_V(8); PG8_WAIT_L(0); PG8_BAR; PG8_MMA(1, 0, At, B0); PG8_MMA(1, 1, At, B1); PG8_BAR; PG8_SCHED;
            PG8_LDB(B0, 1, 0); PG8_LDB(B1, 1, 1); PG8_SCHED; PG8_LDA(At, 1, 0); PG8_STAGE_A(PG8_SA(0, 1), a2, 1, o2);
            PG8_WAIT_V(8); PG8_WAIT_L(0); PG8_BAR; PG8_MMA(0, 0, At, B0); PG8_MMA(0, 1, At, B1); PG8_BAR; PG8_SCHED;
            PG8_LDA(At, 1, 1); PG8_STAGE(PG8_SB(1, 0), b3, voffB); PG8_STAGE(PG8_SB(1, 1), b3 + hstep, voffB); PG8_STAGE_A(PG8_SA(1, 0), a3, 0, o2);
            PG8_WAIT_V(8); PG8_WAIT_L(0); PG8_BAR; PG8_MMA(1, 0, At, B0); PG8_MMA(1, 1, At, B1); PG8_BAR; PG8_SCHED;
        }
        if (wr == 0) PG8_BAR;
        E(acc, cur, wr, wc, fr, fq, lds, ui & 1);
        if (!has_next) break;
#pragma unroll
        for (int a = 0; a < 2; ++a)
#pragma unroll
            for (int b = 0; b < 2; ++b)
#pragma unroll
                for (int m = 0; m < 4; ++m)
#pragma unroll
                    for (int n = 0; n < 2; ++n) acc[a][b][m][n] = (f32x4){0.f, 0.f, 0.f, 0.f};
        cur = nxt; cB = nB; cA = nA; ++ui;
        if constexpr (Sched::TABLES) {
#pragma unroll
            for (int h = 0; h < 2; ++h)
#pragma unroll
                for (int i = 0; i < 2; ++i) offc[h][i] = offn[h][i]; }
        if (wr == 1) PG8_BAR;
    }
    PG8_WAIT_V(0);
    PG8_BAR;
#undef PG8_SA
#undef PG8_SB
#undef PG8_STAGE
#undef PG8_STAGE_A
#undef PG8_LDA
#undef PG8_LDB
#undef PG8_MMA
#undef PG8_WAIT_V
#undef PG8_WAIT_L
#undef PG8_BAR
#undef PG8_SCHED
}
}
namespace attn_body {
using bf16=__hip_bfloat16;
using bf16x8=__attribute__((ext_vector_type(8)))short;
using s16x4=__attribute__((ext_vector_type(4)))short;
using f32x16=__attribute__((ext_vector_type(16)))float;
using u32x4=__attribute__((ext_vector_type(4)))unsigned;
constexpr int BATCH=16,SEQ=4096,D=64,DM=512,DMO=1024;
constexpr int NW=8,QBLK=32,QB=QBLK*NW,KVBLK=64,NQB=SEQ/QB;
constexpr int ATTN_UNIT_ROWS=QB;
__device__ __forceinline__ int crow(int r,int hi){return (r&3)+8*(r>>2)+4*hi;}
#define SBAR() __builtin_amdgcn_sched_barrier(0)
__device__ __forceinline__ void cmask(f32x16&p0,f32x16&p1,int jb,int qrel,int hi){
  const float NEG=-INFINITY; int kb=64*jb+4*hi; asm volatile("":"+v"(kb));
  #pragma unroll
  for(int r=0;r<16;++r){int kv=kb+(r&3)+8*(r>>2); if(kv>qrel)p0[r]=NEG; if(kv+32>qrel)p1[r]=NEG;}
}

constexpr int NSLOT=3, SLOTB=8192;
constexpr int LDS_K=0, LDS_V=NSLOT*SLOTB, LDS_WS=2*NSLOT*SLOTB, LDS_OST=LDS_WS+NW*64*4, LDS_BYTES=LDS_OST+NW*4096;
constexpr float C2=0.125f*1.4426950408889634f;
__device__ __forceinline__ void glds16(const void*gsrc,unsigned lds_dst){unsigned keep;
  asm volatile("s_mov_b32 %0, m0\n\ts_mov_b32 m0, %2\n\ts_nop 0\n\tglobal_load_lds_dwordx4 %1, off\n\ts_mov_b32 m0, %0":"=&s"(keep):"v"(gsrc),"s"(lds_dst):"memory");}
__device__ __forceinline__ float max3f(float a,float b,float c){float r;asm("v_max3_f32 %0, %1, %2, %3":"=v"(r):"v"(a),"v"(b),"v"(c));return r;}
__device__ __forceinline__ float max2f(float a,float b){float r;asm("v_max_f32_e32 %0, %1, %2":"=v"(r):"v"(a),"v"(b));return r;}
__device__ __forceinline__ float fadd_s(float a,float b){float r;asm("v_add_f32_e32 %0, %1, %2":"=v"(r):"v"(a),"v"(b));return r;}
__device__ __forceinline__ float fsub_s(float a,float b){float r;asm("v_sub_f32_e32 %0, %1, %2":"=v"(r):"v"(a),"v"(b));return r;}
typedef float f32x2_t __attribute__((ext_vector_type(2))); typedef __bf16 bf16x2_t __attribute__((ext_vector_type(2)));
__device__ __forceinline__ unsigned cvtpk_s(float lo,float hi){f32x2_t v={lo,hi};bf16x2_t b=__builtin_convertvector(v,bf16x2_t);return __builtin_bit_cast(unsigned,b);}
#define WAIT_BAR(N) asm volatile("s_waitcnt vmcnt(" #N ") lgkmcnt(0)\n\ts_barrier":::"memory")

__device__ __forceinline__ void qkt(f32x16&p0,f32x16&p1,const char*Kslot,const bf16x8*qr,const f32x16&i0,const f32x16&i1,int r32,int hi){
  const char*kb=Kslot+hi*1024+r32*16;
  #pragma unroll
  for(int d0=0;d0<4;++d0){
    const bf16x8 b0=*reinterpret_cast<const bf16x8*>(kb+d0*2048);
    const bf16x8 b1=*reinterpret_cast<const bf16x8*>(kb+d0*2048+512);
    if(d0==0){p0=__builtin_amdgcn_mfma_f32_32x32x16_bf16(b0,qr[0],i0,0,0,0);p1=__builtin_amdgcn_mfma_f32_32x32x16_bf16(b1,qr[0],i1,0,0,0);}
    else{p0=__builtin_amdgcn_mfma_f32_32x32x16_bf16(b0,qr[d0],p0,0,0,0);p1=__builtin_amdgcn_mfma_f32_32x32x16_bf16(b1,qr[d0],p1,0,0,0);}}
}
typedef __attribute__((address_space(3))) const char* lds_cptr;
typedef short v4i16_t __attribute__((ext_vector_type(4)));
__device__ __forceinline__ void kload8(bf16x8*kf,lds_cptr kp){
  kf[0]=*(const __attribute__((address_space(3))) bf16x8*)(kp);      kf[1]=*(const __attribute__((address_space(3))) bf16x8*)(kp+512);
  kf[2]=*(const __attribute__((address_space(3))) bf16x8*)(kp+2048); kf[3]=*(const __attribute__((address_space(3))) bf16x8*)(kp+2560);
  kf[4]=*(const __attribute__((address_space(3))) bf16x8*)(kp+4096); kf[5]=*(const __attribute__((address_space(3))) bf16x8*)(kp+4608);
  kf[6]=*(const __attribute__((address_space(3))) bf16x8*)(kp+6144); kf[7]=*(const __attribute__((address_space(3))) bf16x8*)(kp+6656);
}
__device__ __forceinline__ void kload2(bf16x8*kf,lds_cptr kp,int j){ kf[2*j]=*(const __attribute__((address_space(3))) bf16x8*)(kp+j*2048); kf[2*j+1]=*(const __attribute__((address_space(3))) bf16x8*)(kp+j*2048+512); }
__device__ __forceinline__ s16x4 vtr(lds_cptr p){ return __builtin_bit_cast(s16x4,__builtin_amdgcn_ds_read_tr16_b64_v4i16((__attribute__((address_space(3))) v4i16_t*)p)); }
__device__ __forceinline__ float rowmax(const f32x16&p0,const f32x16&p1){
  float a=max3f(p0[0],p0[1],p1[0]),b=max3f(p0[2],p0[3],p1[1]);a=max3f(a,p1[2],p1[3]);
  #pragma unroll
  for(int r=4;r<16;r+=4){a=max3f(a,p0[r],p0[r+1]);b=max3f(b,p0[r+2],p0[r+3]);a=max3f(a,p1[r],p1[r+1]);b=max3f(b,p1[r+2],p1[r+3]);}
  const float m=max2f(a,b);
  auto rr=__builtin_amdgcn_permlane32_swap(__float_as_uint(m),__float_as_uint(m),false,false);
  return max2f(__uint_as_float(rr[0]),__uint_as_float(rr[1]));
}
__device__ __forceinline__ void pv(f32x16*o,int vb,bf16x8 pa0,bf16x8 pa1,bf16x8 pa2,bf16x8 pa3){
  #pragma unroll
  for(int d0=0;d0<2;++d0){s16x4 lo[4],hi[4];
    #pragma unroll
    for(int ks=0;ks<4;++ks){
      asm volatile("ds_read_b64_tr_b16 %0,%1 offset:%c2":"=&v"(lo[ks]):"v"(vb),"i"(d0*4096+ks*1024):"memory");
      asm volatile("ds_read_b64_tr_b16 %0,%1 offset:%c2":"=&v"(hi[ks]):"v"(vb),"i"(d0*4096+ks*1024+512):"memory");}
    asm volatile("s_waitcnt lgkmcnt(0)":::"memory");SBAR();
    #define PK(k) (bf16x8){lo[k][0],lo[k][1],lo[k][2],lo[k][3],hi[k][0],hi[k][1],hi[k][2],hi[k][3]}
    o[d0]=__builtin_amdgcn_mfma_f32_32x32x16_bf16(pa0,PK(0),o[d0],0,0,0);
    o[d0]=__builtin_amdgcn_mfma_f32_32x32x16_bf16(pa1,PK(1),o[d0],0,0,0);
    o[d0]=__builtin_amdgcn_mfma_f32_32x32x16_bf16(pa2,PK(2),o[d0],0,0,0);
    o[d0]=__builtin_amdgcn_mfma_f32_32x32x16_bf16(pa3,PK(3),o[d0],0,0,0);
    #undef PK
  }
}

#ifndef ATTN_STORE16
#define ATTN_STORE16(p,v) (*(u32x4*)(p)=(v))
#endif
template<int THRL> __device__ __forceinline__ void attn_unit(int b,int hm,int half,int qb,float cs,const int wid,const bf16*Q,const bf16*__restrict__ K,const bf16*__restrict__ V,bf16*O,char*shm){
  int lane=lane_id(); asm volatile("":"+v"(lane));
  const int r32=lane&31,hi=lane>>5;
  const long rowbase=(long)b*SEQ; const int q0=qb*QB;
  const bf16*Qw=Q+(rowbase+q0+wid*QBLK)*DM+hm*D;
  const bf16*Kh=K+rowbase*DM+hm*D,*Vh=V+rowbase*DM+(hm>>1)*128+half*64;
  const unsigned lds0=(unsigned)(uintptr_t)shm;
  float*wsf=(float*)(shm+LDS_WS)+wid*64;
  const bf16*ksrc=Kh+(long)lane*DM+wid*8;
  const bf16*vsrc=Vh+(long)(16*(wid&3)+(lane>>2))*DM+(wid>>2)*32+(lane&3)*8;
  const unsigned kdst=lds0+LDS_K+wid*1024, vdst=lds0+LDS_V+wid*1024;
  #define DMA_K(t,slot) glds16(ksrc+(long)(t)*KVBLK*DM,(unsigned)__builtin_amdgcn_readfirstlane(kdst+(slot)))
  #define DMA_V(t,slot) glds16(vsrc+(long)(t)*KVBLK*DM,(unsigned)__builtin_amdgcn_readfirstlane(vdst+(slot)))
  const int vb0=(int)(lds0+LDS_V)+((lane>>4)&1)*32+(lane&3)*8+(4*hi+((lane&15)>>2))*64;
  const char*Kbase=shm+LDS_K; bf16x8 kf[8];
  const lds_cptr shm3=(lds_cptr)shm; const lds_cptr kp0=shm3+LDS_K+hi*1024+r32*16; const lds_cptr vp0=shm3+LDS_V+((lane>>4)&1)*32+(lane&3)*8+(4*hi+((lane&15)>>2))*64;
  const int NT=(q0+QB)/KVBLK;
  DMA_K(0,0);DMA_V(0,0);DMA_K(1,SLOTB);
  bf16x8 qr[4];
  #pragma unroll
  for(int d0=0;d0<4;++d0)qr[d0]=*reinterpret_cast<const bf16x8*>(&Qw[(long)r32*DM+d0*16+hi*8]);
  float mhat=0.f,l_reg=0.f;f32x16 o[2];o[0]=f32x16{};o[1]=f32x16{};
  const int qrel=wid*QBLK+r32;
  float nb=-cs*(float)(q0+qrel-4*hi);
  const float cs8=__builtin_bit_cast(float,__builtin_amdgcn_readfirstlane(__builtin_bit_cast(int,8.f*cs)));
  #define CINIT1(C,t,X) do{ C[0]=nb+cs*(float)(64*(t)+(X)); C[1]=C[0]+cs; C[2]=C[1]+cs; C[3]=C[2]+cs; _Pragma("unroll") for(int r=4;r<16;++r) C[r]=C[r-4]+cs8; asm volatile("":"+v"(C)); }while(0)
  #define CINIT(C0,C1,t) do{ CINIT1(C0,t,0); CINIT1(C1,t,32); }while(0)
  #define CMASK(P0,P1,t) do{int jb_=(t)-(NT-4); if(jb_>=0)cmask(P0,P1,jb_,qrel,hi);}while(0)
  bool resc=false;
  #define START(P0,P1) do{ const float rm=rowmax(P0,P1); resc=false; \
    { const float dl=rm; mhat=fadd_s(mhat,dl); nb=fsub_s(nb,dl); \
      _Pragma("unroll") for(int r=0;r<16;++r){P0[r]=fsub_s(P0[r],dl);P1[r]=fsub_s(P1[r],dl);} } \
    _Pragma("unroll") for(int r=0;r<16;++r)P0[r]=__builtin_amdgcn_exp2f(P0[r]); }while(0)
  #define RESC() do{ if(resc){ asm volatile("s_waitcnt lgkmcnt(0)":::"memory"); \
      _Pragma("unroll") for(int d_=0;d_<2;++d_) _Pragma("unroll") for(int r=0;r<16;++r)o[d_][r]*=wsf[crow(r,hi)]; } }while(0)
  f32x16 pA0,pA1,pB0,pB1;
  int sl_prev=0,sl_cur=0,sl_next=SLOTB;
  #define ROT() do{sl_prev=sl_cur;sl_cur=sl_next;sl_next=(sl_next==(NSLOT-1)*SLOTB)?0:sl_next+SLOTB;}while(0)
  DMA_K(2,2*SLOTB);
  WAIT_BAR(3);
  { f32x16 i0_,i1_; CINIT(i0_,i1_,0); qkt(pA0,pA1,Kbase,qr,i0_,i1_,r32,hi); } asm volatile("s_nop 15\n\ts_nop 7":"+v"(pA0),"+v"(pA1));CMASK(pA0,pA1,0);
  START(pA0,pA1);
  _Pragma("unroll") for(int r=0;r<16;++r)pA1[r]=__builtin_amdgcn_exp2f(pA1[r]);
  WAIT_BAR(0);
  DMA_K(3,0);DMA_V(1,SLOTB);
  ROT();
  kload8(kf,kp0+sl_cur);
  WAIT_BAR(2);
  s16x4 vlo[8],vhi[8]; u32x4 pw0,pw1,pw2,pw3;
  #define PKW(P,B) cvtpk_s(P[B],P[B+1])
  #define PAF(k) __builtin_bit_cast(bf16x8,pw##k)
  #define VFR(i) (bf16x8){vlo[i][0],vlo[i][1],vlo[i][2],vlo[i][3],vhi[i][0],vhi[i][1],vhi[i][2],vhi[i][3]}
  #define PIN(x) asm volatile("":"+v"(x))
  #define MX3(a,b,c) __builtin_fmaxf(__builtin_fmaxf((a),(b)),(c))
  #define GAPA(MF,A0,A1,A2,A3,W0,W1,PW) do{ MF; sacc+=A0; sacc+=A1; sacc+=A2; sacc+=A3; PIN(sacc); W0; W1; PIN(PW); SBAR(); }while(0)
  #define EX(v) __builtin_amdgcn_exp2f(v)
  #define GAPB(MF,X,B) do{ MF; X[B]=EX(X[B]); X[B+1]=EX(X[B+1]); X[B+2]=EX(X[B+2]); X[B+3]=EX(X[B+3]); PIN(X); SBAR(); }while(0)
  #define VRD(i) do{ vlo[i]=vtr(vp_+(((i)>>2)*4096+((i)&3)*1024)); vhi[i]=vtr(vp_+(((i)>>2)*4096+((i)&3)*1024+512)); }while(0)
  #define KRD(G,j) do{ if(G){ kload2(kf,kp0+sl_next,j); SBAR(); } }while(0)
  #define STEP(C0,C1,P0,P1,t,GK,GV,GL) do{ SBAR(); \
    const lds_cptr vp_=vp0+sl_prev; \
    VRD(0); SBAR(); float sacc=(P0[0]+P0[1]); CINIT1(C0,t,0); SBAR(); \
    GAPA(C0=__builtin_amdgcn_mfma_f32_32x32x16_bf16(kf[0],qr[0],C0,0,0,0), P0[2],P0[3],P0[4],P0[5],     pw0[0]=PKW(P0,0), pw0[1]=PKW(P0,2), pw0); \
    VRD(4); SBAR(); CINIT1(C1,t,32); SBAR(); GAPA(C1=__builtin_amdgcn_mfma_f32_32x32x16_bf16(kf[1],qr[0],C1,0,0,0), P0[6],P0[7],P0[8],P0[9],     pw0[2]=PKW(P0,4), pw0[3]=PKW(P0,6), pw0); \
    VRD(1); SBAR(); GAPA(C0=__builtin_amdgcn_mfma_f32_32x32x16_bf16(kf[2],qr[1],C0,0,0,0),   P0[10],P0[11],P0[12],P0[13], pw1[0]=PKW(P0,8), pw1[1]=PKW(P0,10), pw1); \
    VRD(5); SBAR(); GAPA(C1=__builtin_amdgcn_mfma_f32_32x32x16_bf16(kf[3],qr[1],C1,0,0,0),   P0[14],P0[15],P1[0],P1[1],   pw1[2]=PKW(P0,12),pw1[3]=PKW(P0,14), pw1); \
    VRD(2); SBAR(); GAPA(C0=__builtin_amdgcn_mfma_f32_32x32x16_bf16(kf[4],qr[2],C0,0,0,0),   P1[2],P1[3],P1[4],P1[5],     pw2[0]=PKW(P1,0), pw2[1]=PKW(P1,2), pw2); \
    VRD(6); SBAR(); GAPA(C1=__builtin_amdgcn_mfma_f32_32x32x16_bf16(kf[5],qr[2],C1,0,0,0),   P1[6],P1[7],P1[8],P1[9],     pw2[2]=PKW(P1,4), pw2[3]=PKW(P1,6), pw2); \
    VRD(3); SBAR(); GAPA(C0=__builtin_amdgcn_mfma_f32_32x32x16_bf16(kf[6],qr[3],C0,0,0,0),   P1[10],P1[11],P1[12],P1[13], pw3[0]=PKW(P1,8), pw3[1]=PKW(P1,10), pw3); \
    VRD(7); SBAR(); GAPA(C1=__builtin_amdgcn_mfma_f32_32x32x16_bf16(kf[7],qr[3],C1,0,0,0),   P1[14],P1[15],0.f,0.f,       pw3[2]=PKW(P1,12),pw3[3]=PKW(P1,14), pw3); \
    l_reg+=sacc; \
    if(GK){DMA_K((t)+3,sl_cur);} if(GV){DMA_V((t)+1,sl_next);} \
    CMASK(C0,C1,t); \
    { float a=MX3(C0[0],C0[1],C1[0]),b=MX3(C0[2],C0[3],C1[1]); a=MX3(a,C1[2],C1[3]); \
      _Pragma("unroll") for(int r=4;r<16;r+=4){a=MX3(a,C0[r],C0[r+1]);b=MX3(b,C0[r+2],C0[r+3]);a=MX3(a,C1[r],C1[r+1]);b=MX3(b,C1[r+2],C1[r+3]);} \
      float rm=__builtin_fmaxf(a,b); { auto rr=__builtin_amdgcn_permlane32_swap(__float_as_uint(rm),__float_as_uint(rm),false,false); rm=__builtin_fmaxf(__uint_as_float(rr[0]),__uint_as_float(rr[1])); } \
      resc=false; \
      if(__builtin_expect(__any(rm>(float)THRL),0)){ const float dl=__builtin_fmaxf(rm,0.f); mhat+=dl; nb-=dl; \
        _Pragma("unroll") for(int r=0;r<16;++r){C0[r]-=dl;C1[r]-=dl;} \
        const float f=__builtin_amdgcn_exp2f(-dl); l_reg*=f; if(hi==0)wsf[r32]=f; resc=true; } } \
    SBAR(); \
    GAPB(o[0]=__builtin_amdgcn_mfma_f32_32x32x16_bf16(PAF(0),VFR(0),o[0],0,0,0), C0,0); \
    GAPB(o[1]=__builtin_amdgcn_mfma_f32_32x32x16_bf16(PAF(0),VFR(4),o[1],0,0,0), C0,4); \
    KRD(GL,0); GAPB(o[0]=__builtin_amdgcn_mfma_f32_32x32x16_bf16(PAF(1),VFR(1),o[0],0,0,0), C0,8); \
    KRD(GL,1); GAPB(o[1]=__builtin_amdgcn_mfma_f32_32x32x16_bf16(PAF(1),VFR(5),o[1],0,0,0), C0,12); \
    KRD(GL,2); GAPB(o[0]=__builtin_amdgcn_mfma_f32_32x32x16_bf16(PAF(2),VFR(2),o[0],0,0,0), C1,0); \
    KRD(GL,3); GAPB(o[1]=__builtin_amdgcn_mfma_f32_32x32x16_bf16(PAF(2),VFR(6),o[1],0,0,0), C1,4); \
    GAPB(o[0]=__builtin_amdgcn_mfma_f32_32x32x16_bf16(PAF(3),VFR(3),o[0],0,0,0), C1,8); \
    GAPB(o[1]=__builtin_amdgcn_mfma_f32_32x32x16_bf16(PAF(3),VFR(7),o[1],0,0,0), C1,12); \
    }while(0)
  int t=1;
  #undef CMASK
  #define CMASK(P0,P1,t) do{}while(0)
  for(;t+5<NT;t+=2){
    STEP(pB0,pB1,pA0,pA1,t,true,true,true);     WAIT_BAR(2); RESC(); ROT();
    STEP(pA0,pA1,pB0,pB1,t+1,true,true,true);   WAIT_BAR(2); RESC(); ROT();
  }
  #undef CMASK
  #define CMASK(P0,P1,t) do{int jb_=(t)-(NT-4); if(jb_>=0)cmask(P0,P1,jb_,qrel,hi);}while(0)
  #define ENDW(tt) do{ if((tt)+3<NT){WAIT_BAR(2);} else if((tt)+2<NT){WAIT_BAR(1);} else {WAIT_BAR(0);} }while(0)
  for(;t+1<NT;t+=2){
    STEP(pB0,pB1,pA0,pA1,t,(t+3<NT),(t+1<NT),(t+1<NT));       ENDW(t);   RESC(); ROT();
    STEP(pA0,pA1,pB0,pB1,t+1,(t+4<NT),(t+2<NT),(t+2<NT));     ENDW(t+1); RESC(); ROT();
  }
  STEP(pB0,pB1,pA0,pA1,NT-1,false,false,false); RESC();
  { float sacc=pB0[0]+pB0[1]; _Pragma("unroll") for(int r=2;r<16;++r)sacc+=pB0[r]; _Pragma("unroll") for(int r=0;r<16;++r)sacc+=pB1[r]; l_reg+=sacc;
    pw0=(u32x4){PKW(pB0,0),PKW(pB0,2),PKW(pB0,4),PKW(pB0,6)};pw1=(u32x4){PKW(pB0,8),PKW(pB0,10),PKW(pB0,12),PKW(pB0,14)};pw2=(u32x4){PKW(pB1,0),PKW(pB1,2),PKW(pB1,4),PKW(pB1,6)};pw3=(u32x4){PKW(pB1,8),PKW(pB1,10),PKW(pB1,12),PKW(pB1,14)};
    SBAR(); pv(o,vb0+sl_cur,PAF(0),PAF(1),PAF(2),PAF(3)); }
  #undef PKW
  #undef PAF
  #undef VFR
  #undef PIN
  #undef MX3
  #undef GAPA
  #undef GAPB
  #undef EX
  #undef VRD
  #undef KRD
  #undef STEP
  #undef ENDW
  {auto rr=__builtin_amdgcn_permlane32_swap(__float_as_uint(l_reg),__float_as_uint(l_reg),false,false);l_reg=__uint_as_float(rr[0])+__uint_as_float(rr[1]);}
  if(hi==0)wsf[32+r32]=l_reg;asm volatile("s_waitcnt lgkmcnt(0)":::"memory");
  float rli[16];
  #pragma unroll
  for(int r=0;r<16;++r)rli[r]=__builtin_amdgcn_rcpf(wsf[32+crow(r,hi)]);
  bf16*Ow=O+(rowbase+q0+wid*QBLK)*DMO+(hm>>1)*256+(hm&1)*128+half*64;
  { bf16*stg=(bf16*)(shm+LDS_OST)+wid*2048;
    int eoff=hi*256+r32; asm volatile("":"+v"(eoff));
    #pragma unroll
    for(int r=0;r<16;++r){const int orow=(r&3)+8*(r>>2);
      #pragma unroll
      for(int d0=0;d0<2;++d0)stg[eoff+orow*64+d0*32]=__float2bfloat16(o[d0][r]*rli[r]);}
    asm volatile("s_waitcnt lgkmcnt(0)":::"memory");
    #pragma unroll
    for(int i=0;i<4;++i){const int row=i*8+(lane>>3),ch=lane&7; const u32x4 v=*(const u32x4*)(stg+row*64+ch*8); ATTN_STORE16(Ow+(long)row*DMO+ch*8,v);} }
  asm volatile("s_waitcnt lgkmcnt(0)\n\ts_barrier":::"memory");
  #undef DMA_K
  #undef DMA_V
  #undef CMASK
  #undef START
  #undef RESC
  #undef ROT
  #undef CINIT
  #undef CINIT1
}
constexpr int ATTN_LDS_BYTES=LDS_BYTES;
struct AttnTensors { const bf16* Q; const bf16* K; const bf16* V; bf16* O; };
template<int THRL=8> __device__ __forceinline__ void attn_phase(char*lds,const AttnTensors&T,int vcu,int G,const int wid){
  const int np=(BATCH*16-vcu+G-1)/G;
  for(int it=0;it<np*NQB;++it){ const int p=vcu+(it/NQB)*G,i=it%NQB; const int b=p>>4,vh=p&15,hm=vh>>1,half=vh&1;
    const float cs=__builtin_bit_cast(float,__builtin_amdgcn_readfirstlane(__builtin_bit_cast(int,__builtin_amdgcn_exp2f(-2.f*(float)((hm>>1)+1))*1.4426950408889634f)));
    attn_unit<THRL>(b,hm,half,NQB-1-i,cs,wid,T.Q,T.K,T.V,T.O,lds); }
}
#undef SBAR
#undef WAIT_BAR
}
constexpr int NWAVES = 8;
constexpr int RING_OFF = 0, RING_BYTES = 131072;
constexpr int LDSCTL_OFF = RING_BYTES, MISC_OFF = LDSCTL_OFF + 320;
constexpr int LDS_BYTES = 163840;

#define XB_TMO      128
#define XB_XCNT(j)  (256  + 64 * (j))
#define XB_XSUB(j)  (1280 + 64 * (j))
#define XB_XGEN(j)  (2304 + 64 * (j))
#define XB_TOP      3328
#define XB_TOPGEN   3392
#define XCD_BAR_WORDS 3456
#define XB_SPIN_CAP (1u << 18)
__device__ __forceinline__ unsigned xb_ld(unsigned* p)              { return __hip_atomic_load(p, __ATOMIC_RELAXED, __HIP_MEMORY_SCOPE_AGENT); }
__device__ __forceinline__ unsigned xb_add(unsigned* p, unsigned v) { return __hip_atomic_fetch_add(p, v, __ATOMIC_RELAXED, __HIP_MEMORY_SCOPE_AGENT); }
__device__ __forceinline__ unsigned xb_xcc_id() { return (unsigned)__builtin_amdgcn_s_getreg((3 << 11) | 20) & 0xFu; }
#define XB_SPIN(cond, bar) do { unsigned _sp = 0; while (cond) { __builtin_amdgcn_s_sleep(1); \
    if ((++_sp & 255u) == 0u) { if (xb_ld(&(bar)[XB_TMO])) break; if (_sp > XB_SPIN_CAP) { atomicAdd(&(bar)[XB_TMO], 1u); break; } } } } while (0)
struct XcdBarrier { unsigned* bar; unsigned x; volatile LAS unsigned* st; bool wave0; };
__device__ __forceinline__ XcdBarrier xcd_barrier_post(unsigned* bar, volatile LAS unsigned* st) {
    XcdBarrier b; b.bar = bar; b.x = xb_xcc_id(); b.st = st; b.wave0 = __builtin_amdgcn_readfirstlane(threadIdx.x >> 6) == 0;
    if (threadIdx.x == 0) (void)xb_add(&bar[XB_XCNT(b.x)], 1u);
    return b;
}
__device__ __forceinline__ void xcd_barrier_complete(unsigned* bar, unsigned x, unsigned& nloc, unsigned& nx) {
    const unsigned G = gridDim.x * gridDim.y * gridDim.z;
    unsigned sum, cnt, mine, sp = 0u;
    for (;;) {
        sum = 0u; cnt = 0u; mine = 0u;
#pragma unroll
        for (unsigned j = 0; j < 16; ++j) { const unsigned c = xb_ld(&bar[XB_XCNT(j)]); sum += c; cnt += (c > 0u) ? 1u : 0u; mine = (j == x) ? c : mine; }
        if (sum == G) break;
        __builtin_amdgcn_s_sleep(1);
        if ((++sp & 255u) == 0u) { if (xb_ld(&bar[XB_TMO])) break; if (sp > XB_SPIN_CAP) { atomicAdd(&bar[XB_TMO], 1u); break; } }
    }
    nloc = mine > 0u ? mine : 1u; nx = cnt > 0u ? cnt : 1u;
}
__device__ __forceinline__ void xcd_barrier(const XcdBarrier& b) {
    asm volatile("s_waitcnt vmcnt(0)" ::: "memory");
    __syncthreads();
    if (b.wave0 && lane_id() == 0) {
        unsigned* bar = b.bar;
        __builtin_amdgcn_s_waitcnt(0);
        unsigned nloc = b.st[0], nx = b.st[1];
        if (nloc == 0u) { xcd_barrier_complete(bar, b.x, nloc, nx); b.st[0] = nloc; b.st[1] = nx; }
        const unsigned old = xb_add(&bar[XB_XSUB(b.x)], 1u);
        const unsigned gen = old / nloc;
        if (old + 1u == (gen + 1u) * nloc) {
            __builtin_amdgcn_fence(__ATOMIC_RELEASE, "agent");
            asm volatile("s_waitcnt vmcnt(0)" ::: "memory");
            const unsigned og = xb_add(&bar[XB_TOP], 1u);
            const unsigned tg = og / nx;
            if (og + 1u == (tg + 1u) * nx) xb_add(&bar[XB_TOPGEN], 1u);
            else XB_SPIN(xb_ld(&bar[XB_TOPGEN]) == tg, bar);
            __builtin_amdgcn_fence(__ATOMIC_ACQUIRE, "agent");
            xb_add(&bar[XB_XGEN(b.x)], 1u);
            asm volatile("s_waitcnt vmcnt(0)" ::: "memory");
        } else {
            XB_SPIN(xb_ld(&bar[XB_XGEN(b.x)]) == gen, bar);
            __builtin_amdgcn_fence(__ATOMIC_ACQUIRE, "agent");
            asm volatile("s_waitcnt vmcnt(0)" ::: "memory");
        }
    }
    __syncthreads();
}

struct Frame {
    LAS unsigned char* lds; volatile LAS unsigned* MISC; gu32* ctl;
    int tid, lane, wave, vcu, G;
};
__device__ __forceinline__ float bf2f_(unsigned short b) { return __builtin_bit_cast(float, (unsigned)b << 16); }
__device__ __forceinline__ float wave_sum(float v) {
#pragma unroll
    for (int o = 1; o < 64; o <<= 1) v += __shfl_xor(v, o);
    return v;
}
__device__ __forceinline__ void p0_transpose_item(const float* W, int ldw, int K, bf16* WT, int k0, int n0, int drow0, LAS float* scr, int lane) {
#pragma unroll 8
    for (int i = 0; i < 32; ++i) { const int kk = 2 * i + (lane >> 5); scr[kk * 33 + (lane & 31)] = W[(size_t)(k0 + kk) * ldw + n0 + (lane & 31)]; }
    LDS_WAIT(); asm volatile("" ::: "memory");
    const int c = lane & 7;
#pragma unroll
    for (int j = 0; j < 4; ++j) { const int n = (lane >> 3) + 8 * j; const LAS float* s = scr + (8 * c) * 33 + n;
        v4u o; o.x = pk2(s[0 * 33], s[1 * 33]); o.y = pk2(s[2 * 33], s[3 * 33]); o.z = pk2(s[4 * 33], s[5 * 33]); o.w = pk2(s[6 * 33], s[7 * 33]);
        *(GAS v4u*)(WT + (size_t)(drow0 + n) * K + k0 + 8 * c) = o; }
    LDS_WAIT(); asm volatile("" ::: "memory");
}
__device__ __forceinline__ void p0_transpose_item_f8(const float* W, int ldw, int K, unsigned char* WT, int k0, int n0, int drow0, float scale, LAS float* scr, int lane) {
#pragma unroll 8
    for (int i = 0; i < 32; ++i) { const int kk = 2 * i + (lane >> 5); scr[kk * 33 + (lane & 31)] = W[(size_t)(k0 + kk) * ldw + n0 + (lane & 31)] * scale; }
    LDS_WAIT(); asm volatile("" ::: "memory");
    const int c = lane & 3;
#pragma unroll
    for (int j = 0; j < 2; ++j) { const int n = (lane >> 2) + 16 * j; const LAS float* s = scr + (16 * c) * 33 + n;
        v4u o; o.x = pg8::pk4_fp8(s[0 * 33], s[1 * 33], s[2 * 33], s[3 * 33]); o.y = pg8::pk4_fp8(s[4 * 33], s[5 * 33], s[6 * 33], s[7 * 33]);
        o.z = pg8::pk4_fp8(s[8 * 33], s[9 * 33], s[10 * 33], s[11 * 33]); o.w = pg8::pk4_fp8(s[12 * 33], s[13 * 33], s[14 * 33], s[15 * 33]);
        *(GAS v4u*)(WT + (size_t)(drow0 + n) * K + k0 + 16 * c) = o; }
    LDS_WAIT(); asm volatile("" ::: "memory");
}
struct Ptrs {
    const float *x, *p, *w_in, *b_gate, *lq1, *lk1, *lq2, *lk2, *subln, *w_abr, *w_pmix, *pscale, *w_pbr, *w_out, *ln1g, *ln1b, *w_router, *b_router, *w_up, *b_up, *w_down, *b_down, *w_pg, *w_pp, *ln2g, *ln2b;
    float* out; unsigned char* ws;
};
__device__ __forceinline__ void ph0_prologue(Frame& F, const Ptrs& P) {
    unsigned char* ws = P.ws;
    LAS float* scr = (LAS float*)(F.lds + RING_OFF + F.wave * 16384);
    const int gw = F.vcu * NWAVES + F.wave, NGW = F.G * NWAVES;
    { const size_t n4 = (size_t)M * D / 4, st = (size_t)F.G * 512; const f32x4* src = (const f32x4*)P.x; unsigned long long* dst = (unsigned long long*)(ws + WS_XB);
      for (size_t i = (size_t)blockIdx.x * 512 + F.tid; i < n4; i += st) { const f32x4 v = src[i]; dst[i] = (unsigned long long)pk2(v.x, v.y) | ((unsigned long long)pk2(v.z, v.w) << 32); } }
    constexpr int I_IN = 16 * 128, I_A = 8 * 32, I_O = 16 * 32, I_PG = 16 * 32, I_PP = 4 * 32, I_UP1 = 16 * 64, I_DN1 = 16 * 32;
    constexpr int I_UP = NEXP * I_UP1, I_DN = NEXP * I_DN1, NITEMS = I_IN + I_A + I_O + I_PG + I_PP + I_UP + I_DN;
    for (int it = gw; it < NITEMS; it += NGW) {
        int r = it;
        if (r < I_IN) { const int nb = 128; p0_transpose_item(P.w_in, 4096, 1024, (bf16*)(ws + WS_WIN), 64 * (r / nb), 32 * (r % nb), 32 * (r % nb), scr, F.lane); continue; } r -= I_IN;
        if (r < I_A) { const int nb = 32; p0_transpose_item(P.w_abr, 1024, 1024, (bf16*)(ws + WS_WCAT), 64 * (r / nb), 32 * (r % nb), 32 * (r % nb), scr, F.lane); continue; } r -= I_A;
        if (r < I_O) { const int nb = 32; p0_transpose_item(P.w_out, 1024, 1024, (bf16*)(ws + WS_WOUT), 64 * (r / nb), 32 * (r % nb), 32 * (r % nb), scr, F.lane); continue; } r -= I_O;
        if (r < I_PG) { const int nb = 32; p0_transpose_item(P.w_pg, 1024, 1024, (bf16*)(ws + WS_WPG), 64 * (r / nb), 32 * (r % nb), 32 * (r % nb), scr, F.lane); continue; } r -= I_PG;
        if (r < I_PP) { const int nb = 32; p0_transpose_item(P.w_pp, 1024, 256, (bf16*)(ws + WS_WPP), 64 * (r / nb), 32 * (r % nb), 32 * (r % nb), scr, F.lane); continue; } r -= I_PP;
        if (r < I_UP) { const int e = r / I_UP1, q = r % I_UP1, nb = 64, n0 = 32 * (q % nb);
            const int bj = n0 >> 10, pn = (n0 & 1023) >> 7, cp = n0 & 127;
            if (MOE_FP8) p0_transpose_item_f8(P.w_up + (size_t)e * 1024 * 2048, 2048, 1024, ws + WS_WUP + (size_t)e * 2048 * 1024, 64 * (q / nb), n0, 256 * pn + 128 * bj + cp, WUP_SCALE, scr, F.lane);
            else p0_transpose_item(P.w_up + (size_t)e * 1024 * 2048, 2048, 1024, (bf16*)(ws + WS_WUP) + (size_t)e * 2048 * 1024, 64 * (q / nb), n0, 256 * pn + 128 * bj + cp, scr, F.lane);
            continue; } r -= I_UP;
        { const int e = r / I_DN1, q = r % I_DN1, nb = 32;
            if (MOE_FP8) p0_transpose_item_f8(P.w_down + (size_t)e * 1024 * 1024, 1024, 1024, ws + WS_WDN + (size_t)e * 1024 * 1024, 64 * (q / nb), 32 * (q % nb), 32 * (q % nb), WDN_SCALE, scr, F.lane);
            else p0_transpose_item(P.w_down + (size_t)e * 1024 * 1024, 1024, 1024, (bf16*)(ws + WS_WDN) + (size_t)e * 1024 * 1024, 64 * (q / nb), 32 * (q % nb), 32 * (q % nb), scr, F.lane); }
    }
    { bf16* WPC = (bf16*)(ws + WS_WCAT) + 512;
      for (int k = blockIdx.x; k < 512; k += F.G) { const int g = k >> 7;
          float a0 = 0.f, a1 = 0.f; const float* wm = P.w_pmix + (size_t)k * 128; const float* sc = P.pscale + g * 128; const float* wb = P.w_pbr + (size_t)(g * 128) * 1024;
          for (int d = 0; d < 128; ++d) { const float w = wm[d] * sc[d]; a0 += w * wb[(size_t)d * 1024 + F.tid]; a1 += w * wb[(size_t)d * 1024 + 512 + F.tid]; }
          WPC[(size_t)F.tid * 1024 + k] = (bf16)f2bf(a0); WPC[(size_t)(F.tid + 512) * 1024 + k] = (bf16)f2bf(a1); } }
}
__device__ __forceinline__ void ph_pool(Frame& F, const Ptrs& P) {
    const bf16* U = (const bf16*)(P.ws + WS_U); bf16* PO = (bf16*)(P.ws + WS_APO) + 512;
    const size_t nitem = (size_t)M * 64, st = (size_t)F.G * 512;
    for (size_t idx = (size_t)blockIdx.x * 512 + F.tid; idx < nitem; idx += st) {
        const size_t row = idx >> 6; const int cg = (int)(idx & 63), c0 = cg * 8, pos = (int)(row & (SEQ - 1)), w = 2 << (c0 >> 7), n = pos + 1 < w ? pos + 1 : w;
        float s[8] = {0.f, 0.f, 0.f, 0.f, 0.f, 0.f, 0.f, 0.f}; v4u cur = *(const v4u*)(U + row * 512 + c0);
        for (int k = 0; k < n; ++k) { const v4u v = k == 0 ? cur : *(const v4u*)(U + (row - k) * 512 + c0);
            s[0] += pg8::bflo(v.x); s[1] += pg8::bfhi(v.x); s[2] += pg8::bflo(v.y); s[3] += pg8::bfhi(v.y); s[4] += pg8::bflo(v.z); s[5] += pg8::bfhi(v.z); s[6] += pg8::bflo(v.w); s[7] += pg8::bfhi(v.w); }
        const float rn = 1.f / (float)n; v4u o;
        o.x = pk2(s[0] * rn - pg8::bflo(cur.x), s[1] * rn - pg8::bfhi(cur.x)); o.y = pk2(s[2] * rn - pg8::bflo(cur.y), s[3] * rn - pg8::bfhi(cur.y));
        o.z = pk2(s[4] * rn - pg8::bflo(cur.z), s[5] * rn - pg8::bfhi(cur.z)); o.w = pk2(s[6] * rn - pg8::bflo(cur.w), s[7] * rn - pg8::bfhi(cur.w));
        *(v4u*)(PO + row * 1024 + c0) = o;
    }
}
__device__ __forceinline__ float lam_value(const Ptrs& P) { float a = 0.f, b = 0.f; for (int d = 0; d < 64; ++d) { a += P.lq1[d] * P.lk1[d]; b += P.lq2[d] * P.lk2[d]; } return __expf(a) - __expf(b) + 0.2f; }
__device__ __forceinline__ void ph_combine(Frame& F, const Ptrs& P) {
    const bf16* O16 = (const bf16*)(P.ws + WS_O16); bf16* OA = (bf16*)(P.ws + WS_APO); const float lam = lam_value(P);
    const int gw = F.vcu * NWAVES + F.wave, NGW = F.G * NWAVES, h = F.lane >> 4, e0 = (F.lane & 15) * 8;
    float sg[8];
#pragma unroll
    for (int j = 0; j < 8; ++j) sg[j] = P.subln[e0 + j] * 0.8f;
    for (int row = gw; row < M; row += NGW) {
        const v4u a = *(const v4u*)(O16 + (size_t)row * 1024 + h * 256 + e0), b = *(const v4u*)(O16 + (size_t)row * 1024 + h * 256 + 128 + e0);
        f32x4 a0, a1, b0, b1; pg8::unpack8(a, a0, a1); pg8::unpack8(b, b0, b1); a0 -= b0 * lam; a1 -= b1 * lam;
        float ss = (a0[0] * a0[0] + a0[1] * a0[1]) + (a0[2] * a0[2] + a0[3] * a0[3]) + (a1[0] * a1[0] + a1[1] * a1[1]) + (a1[2] * a1[2] + a1[3] * a1[3]);
        ss += __shfl_xor(ss, 1); ss += __shfl_xor(ss, 2); ss += __shfl_xor(ss, 4); ss += __shfl_xor(ss, 8);
        const float r = rsqrtf(ss * (1.f / 128.f) + LN_EPS);
#pragma unroll
        for (int j = 0; j < 4; ++j) { a0[j] *= r * sg[j]; a1[j] *= r * sg[4 + j]; }
        *(v4u*)(OA + (size_t)row * 1024 + h * 128 + e0) = pg8::pack8(a0, a1);
    }
}
__device__ __forceinline__ void ph6_ln1_route(Frame& F, const Ptrs& P) {
    unsigned char* ws = P.ws;
    const unsigned keep0 = F.MISC[8], keep1 = F.MISC[9];
    __syncthreads();
    { LAS f32x4* img = (LAS f32x4*)F.lds; const f32x4* src = (const f32x4*)P.w_router;
      for (int i = F.tid; i < 1024 * 8; i += 512) { const int k = i >> 3, q = i & 7; img[(k ^ ((k >> 3) & 1)) * 8 + q] = src[i]; } }
    { const size_t n4 = (size_t)M * PLE / 4, st = (size_t)F.G * 512; const f32x4* src = (const f32x4*)P.p; unsigned long long* dst = (unsigned long long*)(ws + WS_PB);
      for (size_t i = (size_t)blockIdx.x * 512 + F.tid; i < n4; i += st) { const f32x4 v = src[i]; dst[i] = (unsigned long long)pk2(v.x, v.y) | ((unsigned long long)pk2(v.z, v.w) << 32); } }
    __syncthreads();
    float* X1 = P.out; bf16* X1B = (bf16*)(ws + WS_X1B);
    const int lane = F.lane, eg = lane & 7, ko = lane >> 3;
    LAS float* xrow = (LAS float*)(F.lds + 131072 + 4096 * F.wave);
    f32x4 gam[4], bet[4];
#pragma unroll
    for (int j = 0; j < 4; ++j) { gam[j] = ((const f32x4*)P.ln1g)[lane + 64 * j]; bet[j] = ((const f32x4*)P.ln1b)[lane + 64 * j]; }
    const f32x4 brt = ((const f32x4*)P.b_router)[eg];
    int my_e[4] = {0, 0, 0, 0}; float my_g[4] = {0.f, 0.f, 0.f, 0.f};
    for (int chunk = blockIdx.x; chunk < M / 256; chunk += F.G) {
        for (int i = 0; i < 32; ++i) {
            const int row = chunk * 256 + F.wave * 32 + i;
            f32x4 v[4]; float s = 0.f;
#pragma unroll
            for (int j = 0; j < 4; ++j) { v[j] = ((const f32x4*)(X1 + (size_t)row * 1024))[lane + 64 * j]; s += (v[j].x + v[j].y) + (v[j].z + v[j].w); }
            const float mean = wave_sum(s) * (1.f / 1024.f); float s2 = 0.f;
#pragma unroll
            for (int j = 0; j < 4; ++j) { v[j] = v[j] - mean; s2 += (v[j].x * v[j].x + v[j].y * v[j].y) + (v[j].z * v[j].z + v[j].w * v[j].w); }
            const float rstd = rsqrtf(wave_sum(s2) * (1.f / 1024.f) + LN_EPS);
#pragma unroll
            for (int j = 0; j < 4; ++j) { v[j] = v[j] * rstd * gam[j] + bet[j];
                ((f32x4*)(X1 + (size_t)row * 1024))[lane + 64 * j] = v[j];
                ((unsigned long long*)(X1B + (size_t)row * 1024))[lane + 64 * j] = (unsigned long long)pk2(v[j].x, v[j].y) | ((unsigned long long)pk2(v[j].z, v[j].w) << 32);
                if (MOE_FP8) ((unsigned*)(ws + WS_X1F8 + (size_t)row * 1024))[lane + 64 * j] = pg8::pk4_fp8(v[j].x, v[j].y, v[j].z, v[j].w);
                ((LAS f32x4*)xrow)[lane + 64 * j] = v[j]; }
            LDS_WAIT(); asm volatile("" ::: "memory");
            f32x4 acc = {0.f, 0.f, 0.f, 0.f};
#pragma unroll 4
            for (int sidx = 0; sidx < 32; ++sidx) { const f32x4 xv = ((const LAS f32x4*)xrow)[sidx * 8 + ko];
#pragma unroll
                for (int q = 0; q < 4; ++q) { const int k = 32 * sidx + 4 * ko + q; const f32x4 w = ((const LAS f32x4*)F.lds)[(k ^ ((k >> 3) & 1)) * 8 + eg]; acc += w * xv[q]; } }
#pragma unroll
            for (int q = 0; q < 4; ++q) { acc[q] += __shfl_xor(acc[q], 8); acc[q] += __shfl_xor(acc[q], 16); acc[q] += __shfl_xor(acc[q], 32); }
            acc += brt;
            float tv[4]; int ti[4];
#pragma unroll
            for (int r = 0; r < 4; ++r) { float bv = acc[0]; int bi = 4 * eg;
#pragma unroll
                for (int q = 1; q < 4; ++q) if (acc[q] > bv) { bv = acc[q]; bi = 4 * eg + q; }
#pragma unroll
                for (int o = 1; o < 8; o <<= 1) { const float ov = __shfl_xor(bv, o); const int oi = __shfl_xor(bi, o); if (ov > bv || (ov == bv && oi < bi)) { bv = ov; bi = oi; } }
                tv[r] = bv; ti[r] = bi;
#pragma unroll
                for (int q = 0; q < 4; ++q) if (bi == 4 * eg + q) acc[q] = -INFINITY; }
            const float e1 = __expf(tv[1] - tv[0]), e2 = __expf(tv[2] - tv[0]), e3 = __expf(tv[3] - tv[0]), rs = 1.f / (1.f + e1 + e2 + e3);
            if (lane == i) { my_e[0] = ti[0]; my_e[1] = ti[1]; my_e[2] = ti[2]; my_e[3] = ti[3]; my_g[0] = rs; my_g[1] = e1 * rs; my_g[2] = e2 * rs; my_g[3] = e3 * rs; }
        }
        __syncthreads();
        LAS int* cntl = (LAS int*)(F.lds + 131072); LAS int* basel = cntl + 32;
        if (F.tid < 32) cntl[F.tid] = 0;
        __syncthreads();
        int rk[4] = {0, 0, 0, 0};
        if (lane < 32) {
#pragma unroll
            for (int k = 0; k < 4; ++k) rk[k] = __hip_atomic_fetch_add(&cntl[my_e[k]], 1, __ATOMIC_RELAXED, __HIP_MEMORY_SCOPE_WORKGROUP); }
        __syncthreads();
        if (F.tid < 32) basel[F.tid] = (int)__hip_atomic_fetch_add(F.ctl + CW_CNT + F.tid, (unsigned)cntl[F.tid], RLX_AGENT);
        __syncthreads();
        if (lane < 32) { const int row = chunk * 256 + F.wave * 32 + lane; int* LIST = (int*)(ws + WS_LIST); float* GATEL = (float*)(ws + WS_GATEL); float* GATE = (float*)(ws + WS_GATE);
#pragma unroll
            for (int k = 0; k < 4; ++k) { const size_t o = (size_t)my_e[k] * 65536 + (size_t)(basel[my_e[k]] + rk[k]); LIST[o] = row * 4 + k; GATEL[o] = my_g[k]; GATE[row * 4 + k] = my_g[k]; } }
        __syncthreads();
    }
    if (F.tid == 0) { F.MISC[8] = keep0; F.MISC[9] = keep1; }
    __syncthreads();
}
__device__ __forceinline__ void ph10_final(Frame& F, const Ptrs& P) {
    const bf16* YS1 = (const bf16*)(P.ws + WS_YS1); const bf16* YS2 = (const bf16*)(P.ws + WS_YS2); const bf16* YS3 = (const bf16*)(P.ws + WS_YS3);
    const int gw = F.vcu * NWAVES + F.wave, NGW = F.G * NWAVES, lane = F.lane;
    f32x4 gam[4], bet[4];
#pragma unroll
    for (int j = 0; j < 4; ++j) { gam[j] = ((const f32x4*)P.ln2g)[lane + 64 * j]; bet[j] = ((const f32x4*)P.ln2b)[lane + 64 * j]; }
    for (int row = gw; row < M; row += NGW) {
        f32x4 v[4]; float s = 0.f;
#pragma unroll
        for (int j = 0; j < 4; ++j) { const size_t o = (size_t)row * 256 + lane + 64 * j; v[j] = ((const f32x4*)P.out)[o];
            const unsigned long long a = ((const unsigned long long*)YS1)[o], b = ((const unsigned long long*)YS2)[o], c = ((const unsigned long long*)YS3)[o];
            const unsigned a0 = (unsigned)a, a1 = (unsigned)(a >> 32), b0 = (unsigned)b, b1 = (unsigned)(b >> 32), c0 = (unsigned)c, c1 = (unsigned)(c >> 32);
            v[j].x += (pg8::bflo(a0) + pg8::bflo(b0)) + pg8::bflo(c0); v[j].y += (pg8::bfhi(a0) + pg8::bfhi(b0)) + pg8::bfhi(c0);
            v[j].z += (pg8::bflo(a1) + pg8::bflo(b1)) + pg8::bflo(c1); v[j].w += (pg8::bfhi(a1) + pg8::bfhi(b1)) + pg8::bfhi(c1);
            s += (v[j].x + v[j].y) + (v[j].z + v[j].w); }
        const float mean = wave_sum(s) * (1.f / 1024.f); float s2 = 0.f;
#pragma unroll
        for (int j = 0; j < 4; ++j) { v[j] = v[j] - mean; s2 += (v[j].x * v[j].x + v[j].y * v[j].y) + (v[j].z * v[j].z + v[j].w * v[j].w); }
        const float rstd = rsqrtf(wave_sum(s2) * (1.f / 1024.f) + LN_EPS);
#pragma unroll
        for (int j = 0; j < 4; ++j) ((f32x4*)P.out)[(size_t)row * 256 + lane + 64 * j] = v[j] * rstd * gam[j] + bet[j];
    }
}
__device__ __forceinline__ void moe_tables(Frame& F) {
    LAS int* cnt = (LAS int*)(F.lds + pg8::TAB_CNT); LAS int* blk0 = (LAS int*)(F.lds + pg8::TAB_BLK0); LAS int* row0 = (LAS int*)(F.lds + pg8::TAB_ROW0);
    __syncthreads();
    if (F.tid < 32) cnt[F.tid] = (int)__hip_atomic_load(F.ctl + CW_CNT + F.tid, RLX_AGENT);
    __syncthreads();
    if (F.tid == 0) { int b = 0, r = 0; for (int e = 0; e < 32; ++e) { blk0[e] = b; row0[e] = r; b += (cnt[e] + 255) >> 8; r += cnt[e]; } blk0[32] = b; row0[32] = r; }
    __syncthreads();
}

constexpr int NPHASE = 11;
struct Args { Ptrs P; int ph_lo, ph_hi; };
__global__ void __launch_bounds__(NWAVES * 64, 2) mk_fwd(Args args) {
    extern __shared__ __attribute__((aligned(16))) unsigned char lds[];
    Frame F; const Ptrs& P = args.P;
    F.lds = (LAS unsigned char*)lds; F.MISC = (volatile LAS unsigned*)(F.lds + MISC_OFF);
    F.wave = __builtin_amdgcn_readfirstlane(threadIdx.x >> 6); F.lane = lane_id(); F.tid = F.wave * 64 + F.lane;
#define REFRESH() do { F.lane = lane_id(); asm volatile("" : "+v"(F.lane)); F.tid = F.wave * 64 + F.lane; } while (0)
    F.G = gridDim.x; { const int bx = blockIdx.x; F.vcu = (F.G % 8 == 0) ? (bx % 8) * (F.G / 8) + bx / 8 : bx; }
    unsigned char* ws = P.ws; F.ctl = (gu32*)(ws + WS_CTL);
    for (int u = F.tid; u < 1024 / 4; u += NWAVES * 64) ((LAS unsigned*)(F.lds + LDSCTL_OFF))[u] = 0u;
    __syncthreads();
    const int lo = args.ph_lo, hi = args.ph_hi;
    XcdBarrier bar = xcd_barrier_post((unsigned*)(F.ctl + CW_BAR) + lo * XCD_BAR_WORDS, F.MISC + 8);
#ifndef PH_COMPILE
#define PH_COMPILE 0x7ff
#endif
#define IN(k) ((((PH_COMPILE) >> (k)) & 1) && lo <= (k) && (k) < hi)
#define SEAM(k) do { if (IN(k) && IN((k) + 1)) xcd_barrier(bar); } while (0)
#ifndef REP2_MASK
#define REP2_MASK 0
#endif
#define REPS(k) for (int rep_ = 0; rep_ < ((((REP2_MASK) >> (k)) & 1) ? 2 : 1); ++rep_)
    bf16 *XB = (bf16*)(ws + WS_XB), *Q = (bf16*)(ws + WS_Q), *K = (bf16*)(ws + WS_K), *V = (bf16*)(ws + WS_V), *U = (bf16*)(ws + WS_U), *G = (bf16*)(ws + WS_G);
    bf16 *O16 = (bf16*)(ws + WS_O16), *APO = (bf16*)(ws + WS_APO), *MIX = (bf16*)(ws + WS_MIX), *X1B = (bf16*)(ws + WS_X1B), *HB = (bf16*)(ws + WS_HB), *PB = (bf16*)(ws + WS_PB);
    bf16* T = (bf16*)(ws + WS_T);

    if (IN(0)) REPS(0) { REFRESH(); ph0_prologue(F, P); } SEAM(0);
    if (IN(1)) REPS(1) {
        pg8::Gemm g{XB, (const bf16*)(ws + WS_WIN), 1024}; pg8::StaticOrder S; S.init(M, 4096, F.G, (int)blockIdx.x);
        pg8::EpiProj E{Q, K, V, U, G, P.b_gate, C2Q, 0};
        pg8::gemm_phase(F.lds, F.wave, g, S, E);
    } SEAM(1);
    if (IN(2)) REPS(2) {
        const attn_body::AttnTensors AT{(const attn_body::bf16*)Q, (const attn_body::bf16*)K, (const attn_body::bf16*)V, (attn_body::bf16*)O16};
        attn_body::attn_phase<8>((char*)lds + RING_OFF, AT, F.vcu, F.G, F.wave);
#ifndef NO_POOL
        REFRESH(); ph_pool(F, P);
#endif
    } SEAM(2);
    if (IN(3)) REPS(3) { REFRESH(); ph_combine(F, P); } SEAM(3);
    if (IN(4)) REPS(4) {
        pg8::StaticOrder S; S.init(M, 1024, F.G, (int)blockIdx.x);
        pg8::Gemm g{APO, (const bf16*)(ws + WS_WCAT), 1024}; pg8::EpiMixCat E{MIX, G}; pg8::gemm_phase(F.lds, F.wave, g, S, E);
    } SEAM(4);
    if (IN(5)) REPS(5) {
        pg8::Gemm g{MIX, (const bf16*)(ws + WS_WOUT), 1024}; pg8::StaticOrder S; S.init(M, 1024, F.G, (int)blockIdx.x);
        pg8::EpiF32<0> E{P.out, P.x, ALPHA, 0};
        pg8::gemm_phase(F.lds, F.wave, g, S, E);
    } SEAM(5);
    if (IN(6)) { REFRESH(); ph6_ln1_route(F, P); } SEAM(6);
    if (IN(7)) {
        pg8::StaticOrder S; S.init(M, 1024, F.G, (int)blockIdx.x);
#ifndef NO_PH7A
        { pg8::Gemm g{PB, (const bf16*)(ws + WS_WPP), 256}; pg8::EpiF32<1> E{(float*)T, nullptr, 0.f, 0}; pg8::gemm_phase(F.lds, F.wave, g, S, E); }
#endif
        VM_WAIT(); __syncthreads();
#ifndef NO_PH7B
        { pg8::Gemm g{X1B, (const bf16*)(ws + WS_WPG), 1024}; pg8::EpiF32<2> E{P.out, (const float*)T, ALPHA, 0}; pg8::gemm_phase(F.lds, F.wave, g, S, E); }
#endif
    } SEAM(7);
    if (IN(8)) REPS(8) {
        REFRESH(); moe_tables(F);
        pg8::Gemm g{MOE_FP8 ? (const bf16*)(ws + WS_X1F8) : X1B, (const bf16*)(ws + WS_WUP), MOE_FP8 ? 512 : 1024};
        pg8::MoeOrder<true, MOE_FP8> S{8, F.G, (int)blockIdx.x, (const int*)(ws + WS_LIST), (const float*)(ws + WS_GATEL), (size_t)2048 * 1024 * (MOE_FP8 ? 1 : 2)};
        pg8::EpiUp<MOE_FP8> E{HB, P.b_up, MOE_FP8 ? 1.f / WUP_SCALE : 1.f, 0};
        pg8::gemm_phase(F.lds, F.wave, g, S, E);
    } SEAM(8);
    if (IN(9)) {
        REFRESH(); moe_tables(F);
        pg8::Gemm g{HB, (const bf16*)(ws + WS_WDN), MOE_FP8 ? 512 : 1024};
        pg8::MoeOrder<false, MOE_FP8> S{4, F.G, (int)blockIdx.x, (const int*)(ws + WS_LIST), (const float*)(ws + WS_GATEL), (size_t)1024 * 1024 * (MOE_FP8 ? 1 : 2)};
        pg8::EpiDown E{P.out, (bf16*)(ws + WS_YS1), (bf16*)(ws + WS_YS2), (bf16*)(ws + WS_YS3), P.b_down, MOE_FP8 ? 1.f / (WDN_SCALE) : 1.f, 0};
        pg8::gemm_phase(F.lds, F.wave, g, S, E);
    } SEAM(9);
    if (IN(10)) { REFRESH(); ph10_final(F, P); }
#undef IN
#undef SEAM
}
#ifndef FAST_MASK
#define FAST_MASK 0x7ff
#endif
#ifndef MERGE_FAST
#define MERGE_FAST 1
#endif
extern "C" void kernel_launch(void* const* d_in, const int* in_sizes, int n_in, void* d_out, int out_size, void* d_ws, size_t ws_size, hipStream_t stream) {
    static int grid = 0;
    if (grid == 0) {
        if (n_in != 26 || ws_size < WS_END || out_size != M * D) { fprintf(stderr, "kernel_launch: unexpected shapes (n_in %d, ws %zu, out %d)\n", n_in, ws_size, out_size); grid = -1; return; }
        int dev = 0, cus = 0, per_cu = 0;
        if (hipGetDevice(&dev) != hipSuccess || hipDeviceGetAttribute(&cus, hipDeviceAttributeMultiprocessorCount, dev) != hipSuccess) { grid = -1; return; }
        if (hipFuncSetAttribute((const void*)mk_fwd, hipFuncAttributeMaxDynamicSharedMemorySize, LDS_BYTES) != hipSuccess) { fprintf(stderr, "kernel_launch: hipFuncSetAttribute failed\n"); grid = -1; return; }
        if (hipOccupancyMaxActiveBlocksPerMultiprocessor(&per_cu, (const void*)mk_fwd, NWAVES * 64, LDS_BYTES) != hipSuccess || per_cu < 1) fprintf(stderr, "kernel_launch: occupancy query says %d\n", per_cu);
        (void)hipGetLastError();
        grid = cus;
    }
    if (grid < 0) return;
    Ptrs P{};
    { const float** pp = (const float**)&P; for (int i = 0; i < 26; ++i) pp[i] = (const float*)d_in[i]; }
    P.out = (float*)d_out; P.ws = (unsigned char*)d_ws;
    unsigned char* ws = (unsigned char*)d_ws; float* out = (float*)d_out;
    unsigned* CTL = (unsigned*)(ws + WS_CTL); unsigned* CNT = CTL + CW_CNT; int* LIST = (int*)(ws + WS_LIST); float* GATE = (float*)(ws + WS_GATE); float* GATEL = (float*)(ws + WS_GATEL); float* WPCF = (float*)(ws + WS_WPCF);
    bf16 *XB = (bf16*)(ws + WS_XB), *PB = (bf16*)(ws + WS_PB), *Q = (bf16*)(ws + WS_Q), *K = (bf16*)(ws + WS_K), *V = (bf16*)(ws + WS_V), *U = (bf16*)(ws + WS_U), *G = (bf16*)(ws + WS_G);
    bf16 *O16 = (bf16*)(ws + WS_O16), *OA = (bf16*)(ws + WS_APO), *PO = (bf16*)(ws + WS_APO) + 512, *MIX = (bf16*)(ws + WS_MIX), *X1B = (bf16*)(ws + WS_X1B), *HB = (bf16*)(ws + WS_HB);
    bf16 *YS1 = (bf16*)(ws + WS_YS1), *YS2 = (bf16*)(ws + WS_YS2), *YS3 = (bf16*)(ws + WS_YS3); bf16* T = (bf16*)(ws + WS_T);
    (void)hipMemsetAsync(ws + WS_CTL, 0, CTL_ZERO_BYTES, stream);
    const unsigned fm = FAST_MASK;
    for (int ph = 0; ph < NPHASE;) {
        if ((fm >> ph) & 1u) {
            int hi = ph + 1; if (MERGE_FAST) while (hi < NPHASE && ((fm >> hi) & 1u)) ++hi;
            Args a{}; a.P = P; a.ph_lo = ph; a.ph_hi = hi;
            hipLaunchKernelGGL(mk_fwd, dim3(grid), dim3(NWAVES * 64), LDS_BYTES, stream, a);
            if (fm != 0x7ffu && ph == 0) { nv::k_fold_pool<<<512, 256, 0, stream>>>(P.w_pmix, P.pscale, P.w_pbr, WPCF); }
            ph = hi; continue;
        }
        switch (ph) {
        case 0: nv::k_cvt_bf16<<<2048, 256, 0, stream>>>(P.x, XB, (size_t)M * D / 4); nv::k_fold_pool<<<512, 256, 0, stream>>>(P.w_pmix, P.pscale, P.w_pbr, WPCF); break;
        case 1: nv::k_gemm<false><<<dim3(4096 / 64, M / 64, 1), 256, 0, stream>>>(nv::RowDense{XB, 1024, 0}, nv::EpiProj{Q, K, V, U, G, P.b_gate, C2Q, 0}, P.w_in, 0, 4096, 1024, 0, 0); break;
        case 2: nv::k_attn<<<dim3(SEQ / 256, 16, BATCH), 256, 0, stream>>>(Q, K, V, O16); nv::k_pool<<<(unsigned)((size_t)M * 512 / 256), 256, 0, stream>>>(U, PO); break;
        case 3: nv::k_combine<<<M / 4, 256, 0, stream>>>(O16, OA, P.lq1, P.lk1, P.lq2, P.lk2, P.subln); break;
        case 4: nv::k_gemm<false><<<dim3(1024 / 64, M / 64, 1), 256, 0, stream>>>(nv::RowDense{OA, 1024, 0}, nv::EpiMixA{MIX, G}, P.w_abr, 0, 1024, 512, 0, 0);
                nv::k_gemm<false><<<dim3(1024 / 64, M / 64, 1), 256, 0, stream>>>(nv::RowDense{PO, 1024, 0}, nv::EpiMixB{MIX, G}, WPCF, 0, 1024, 512, 0, 0); break;
        case 5: nv::k_gemm<false><<<dim3(1024 / 64, M / 64, 1), 256, 0, stream>>>(nv::RowDense{MIX, 1024, 0}, nv::EpiPre1{out, P.x, ALPHA, 0}, P.w_out, 0, 1024, 1024, 0, 0); break;
        case 6: nv::k_ln1_route<<<M, 256, 0, stream>>>(out, X1B, P.ln1g, P.ln1b, P.w_router, P.b_router, CNT, LIST, GATE, GATEL);
                nv::k_cvt_bf16<<<2048, 256, 0, stream>>>(P.p, PB, (size_t)M * PLE / 4); break;
        case 7: nv::k_gemm<false><<<dim3(1024 / 64, M / 64, 1), 256, 0, stream>>>(nv::RowDense{PB, 256, 0}, nv::EpiStoreF32{T}, P.w_pp, 0, 1024, 256, 0, 0);
                nv::k_gemm<false><<<dim3(1024 / 64, M / 64, 1), 256, 0, stream>>>(nv::RowDense{X1B, 1024, 0}, nv::EpiBase{out, T, ALPHA, 0}, P.w_pg, 0, 1024, 1024, 0, 0); break;
        case 8: nv::k_gemm<true><<<dim3(1024 / 64, M / 64, NEXP), 256, 0, stream>>>(nv::RowGather{X1B, LIST, CNT}, nv::EpiUp{HB, P.b_up, CNT}, P.w_up, (size_t)1024 * 2048, 2048, 1024, 1024, 0); break;
        case 9: nv::k_gemm<false><<<dim3(1024 / 64, M / 64, NEXP), 256, 0, stream>>>(nv::RowSlots{HB, CNT}, nv::EpiDown{out, YS1, YS2, YS3, P.b_down, LIST, GATE, CNT}, P.w_down, (size_t)1024 * 1024, 1024, 1024, 0, 0); break;
        case 10: nv::k_final<<<M, 256, 0, stream>>>(out, YS1, YS2, YS3, P.ln2g, P.ln2b); break;
        }
        ++ph;
    }
}
```

```cpp
#define FAST_MASK 0x7ff
#include <hip/hip_runtime.h>
#include <hip/hip_bf16.h>
#include <cstdio>
#include <cstdint>
#include <cmath>

#define GAS __attribute__((address_space(1)))
#define LAS __attribute__((address_space(3)))
typedef unsigned short bf16;
typedef unsigned v4u __attribute__((ext_vector_type(4)));
typedef float f32x4 __attribute__((ext_vector_type(4)));
typedef short bf16x8 __attribute__((ext_vector_type(8)));
typedef GAS unsigned gu32;
typedef GAS unsigned long long gu64;
#define RLX_AGENT __ATOMIC_RELAXED, __HIP_MEMORY_SCOPE_AGENT
#define LDS_WAIT() asm volatile("s_waitcnt lgkmcnt(0)" ::: "memory")
#define VM_WAIT() asm volatile("s_waitcnt vmcnt(0)" ::: "memory")
__device__ __forceinline__ unsigned f2bf(float f) { unsigned u = __builtin_bit_cast(unsigned, f); return (u + 0x7fffu + ((u >> 16) & 1u)) >> 16; }
__device__ __forceinline__ unsigned pk2(float lo, float hi) { return f2bf(lo) | (f2bf(hi) << 16); }

__device__ __forceinline__ int lane_id() { return (int)__builtin_amdgcn_mbcnt_hi(~0u, __builtin_amdgcn_mbcnt_lo(~0u, 0u)); }

constexpr int BATCH = 16, SEQ = 4096, D = 1024, M = BATCH * SEQ;
constexpr int NEXP = 32, TOPK = 4, NASSIGN = M * TOPK, FF = 1024, PLE = 256;
constexpr float LN_EPS = 1e-5f;
constexpr float ALPHA = 1.189207115002721f;
constexpr float C2Q = 0.125f * 1.4426950408889634f;

constexpr size_t MiB = 1u << 20;
constexpr size_t WS_CTL = 0, CTL_ZERO_BYTES = 1 * MiB;
constexpr size_t WS_LIST = 1 * MiB;
constexpr size_t WS_GATEL = 9 * MiB;
constexpr size_t WS_GATE = 17 * MiB;
constexpr size_t WS_WPCF = 18 * MiB;
constexpr size_t WS_WIN = 20 * MiB, WS_WCAT = 28 * MiB, WS_WOUT = 30 * MiB, WS_WPG = 32 * MiB, WS_WPP = 34 * MiB;
constexpr size_t WS_WDN = 36 * MiB, WS_WUP = 100 * MiB;
constexpr size_t WS_XB = 228 * MiB;
constexpr size_t WS_APO = 228 * MiB;
constexpr size_t WS_X1B = 228 * MiB;
constexpr size_t WS_Q = 356 * MiB, WS_K = 420 * MiB, WS_V = 484 * MiB, WS_U = 548 * MiB;
constexpr size_t WS_G = 612 * MiB;
constexpr size_t WS_O16 = 868 * MiB;
constexpr size_t WS_PB = 868 * MiB;
constexpr size_t WS_MIX = 356 * MiB;
constexpr size_t WS_T = 356 * MiB;
constexpr size_t WS_HB = 356 * MiB;
constexpr size_t WS_YS1 = 100 * MiB, WS_YS2 = 228 * MiB, WS_YS3 = 868 * MiB;
constexpr size_t WS_X1F8 = 900 * MiB;
constexpr size_t WS_END = 1024 * MiB;
#ifndef MOE_FP8
#define MOE_FP8 1
#endif
constexpr float WUP_SCALE = 32.f, WDN_SCALE = 64.f;
constexpr float ATT_SKIP = 40.f;
constexpr int CW_TMO = 0, CW_CODE = 1;
constexpr int CW_CNT = 64;
constexpr int CW_AQ = 128;
constexpr int CW_PN = 65536;
constexpr int CW_BAR = 4096;
namespace nv {
__device__ __forceinline__ float bf2f(bf16 b) { return __builtin_bit_cast(float, (unsigned)b << 16); }
__device__ __forceinline__ bf16 f2b(float f) { return (bf16)f2bf(f); }
__device__ __forceinline__ float sigm(float v) { return 1.f / (1.f + __expf(-v)); }

__global__ void k_zero_ctl(unsigned* p, int n) { int i = blockIdx.x * blockDim.x + threadIdx.x; if (i < n) p[i] = 0u; }
__global__ void k_cvt_bf16(const float* in, bf16* out, size_t n4) {
    size_t i = (size_t)blockIdx.x * blockDim.x + threadIdx.x; const size_t st = (size_t)gridDim.x * blockDim.x;
    for (; i < n4; i += st) { const f32x4 v = ((const f32x4*)in)[i]; unsigned long long o = (unsigned long long)pk2(v.x, v.y) | ((unsigned long long)pk2(v.z, v.w) << 32); ((unsigned long long*)out)[i] = o; }
}
__global__ void k_fold_pool(const float* wmix, const float* scale, const float* wpb, float* Wpc) {
    const int row = blockIdx.x, g = row >> 7, c = row & 127;
    __shared__ float wm[128];
    if (threadIdx.x < 128) wm[threadIdx.x] = wmix[(g * 128 + c) * 128 + threadIdx.x] * scale[g * 128 + threadIdx.x];
    __syncthreads();
    for (int n = threadIdx.x; n < 1024; n += 256) { float s = 0.f; for (int d = 0; d < 128; ++d) s += wm[d] * wpb[(size_t)(g * 128 + d) * 1024 + n]; Wpc[(size_t)row * 1024 + n] = s; }
}

template <bool DUAL, class RowF, class Epi>
__global__ void __launch_bounds__(256) k_gemm(RowF rf, Epi epi, const float* W, size_t wz, int ldw, int K, int dualoff, int pad_) {
    __shared__ float As[16][68]; __shared__ float Bs[16][64]; __shared__ float Bs2[DUAL ? 16 : 1][64];
    const int tid = threadIdx.x, ty = tid >> 4, tx = tid & 15, z = blockIdx.z;
    const int row0 = blockIdx.y * 64, col0 = blockIdx.x * 64;
    if (!rf.active(z, row0)) return;
    const float* Wz = W + (size_t)z * wz;
    float acc[4][4] = {}, acc2[4][4] = {};
    const int ar = tid >> 2, ak = (tid & 3) * 4; const bf16* arow = rf.row(z, row0 + ar);
    const int bk = tid >> 4, bc = (tid & 15) * 4;
    for (int k0 = 0; k0 < K; k0 += 16) {
        { const unsigned long long v = arow ? *(const unsigned long long*)(arow + k0 + ak) : 0ull;
          As[ak + 0][ar] = bf2f((bf16)(v & 0xffff)); As[ak + 1][ar] = bf2f((bf16)((v >> 16) & 0xffff)); As[ak + 2][ar] = bf2f((bf16)((v >> 32) & 0xffff)); As[ak + 3][ar] = bf2f((bf16)(v >> 48)); }
        { const f32x4 v = *(const f32x4*)(Wz + (size_t)(k0 + bk) * ldw + col0 + bc); Bs[bk][bc] = v.x; Bs[bk][bc + 1] = v.y; Bs[bk][bc + 2] = v.z; Bs[bk][bc + 3] = v.w;
          if (DUAL) { const f32x4 w = *(const f32x4*)(Wz + (size_t)(k0 + bk) * ldw + dualoff + col0 + bc); Bs2[bk][bc] = w.x; Bs2[bk][bc + 1] = w.y; Bs2[bk][bc + 2] = w.z; Bs2[bk][bc + 3] = w.w; } }
        __syncthreads();
#pragma unroll
        for (int k = 0; k < 16; ++k) { float a[4], b[4], b2[4];
#pragma unroll
            for (int i = 0; i < 4; ++i) { a[i] = As[k][ty * 4 + i]; b[i] = Bs[k][tx * 4 + i]; b2[i] = DUAL ? Bs2[k][tx * 4 + i] : 0.f; }
#pragma unroll
            for (int i = 0; i < 4; ++i)
#pragma unroll
                for (int j = 0; j < 4; ++j) { acc[i][j] += a[i] * b[j]; if (DUAL) acc2[i][j] += a[i] * b2[j]; } }
        __syncthreads();
    }
#pragma unroll
    for (int i = 0; i < 4; ++i)
#pragma unroll
        for (int j = 0; j < 4; ++j) epi(z, row0 + ty * 4 + i, col0 + tx * 4 + j, acc[i][j], acc2[i][j]);
}
struct RowDense { const bf16* A; int lda; int pad; __device__ bool active(int, int) const { return true; } __device__ const bf16* row(int, int r) const { return A + (size_t)r * lda; } };

struct EpiProj { bf16 *Q, *K, *V, *U, *G; const float* bg; float c2; int pad;
    __device__ void operator()(int, int r, int c, float v, float) const {
        if (c < 512) Q[(size_t)r * 512 + c] = f2b(v * c2); else if (c < 1024) K[(size_t)r * 512 + c - 512] = f2b(v); else if (c < 1536) V[(size_t)r * 512 + c - 1024] = f2b(v);
        else if (c < 2048) U[(size_t)r * 512 + c - 1536] = f2b(v); else G[(size_t)r * 2048 + c - 2048] = f2b(sigm(v + bg[c - 2048])); } };
struct EpiMixA { bf16* MIX; const bf16* G; __device__ void operator()(int, int r, int c, float v, float) const { MIX[(size_t)r * 1024 + c] = f2b(bf2f(G[(size_t)r * 2048 + c]) * v); } };
struct EpiMixB { bf16* MIX; const bf16* G; __device__ void operator()(int, int r, int c, float v, float) const { MIX[(size_t)r * 1024 + c] = f2b(bf2f(MIX[(size_t)r * 1024 + c]) + bf2f(G[(size_t)r * 2048 + 1024 + c]) * v); } };
struct EpiPre1 { float* out; const float* x; float alpha; int pad; __device__ void operator()(int, int r, int c, float v, float) const { out[(size_t)r * 1024 + c] = alpha * x[(size_t)r * 1024 + c] + v; } };
struct EpiStoreF32 { bf16* T; __device__ void operator()(int, int r, int c, float v, float) const { T[(size_t)r * 1024 + c] = f2b(v); } };
struct EpiBase { float* base; const bf16* T; float alpha; int pad; __device__ void operator()(int, int r, int c, float v, float) const { const size_t i = (size_t)r * 1024 + c; base[i] = alpha * base[i] + sigm(v) * bf2f(T[i]); } };

__global__ void __launch_bounds__(256) k_attn(const bf16* Q, const bf16* K, const bf16* V, bf16* O16) {
    __shared__ float Ks[64][64]; __shared__ float Vs[64][64];
    const int qb = blockIdx.x, vh = blockIdx.y, b = blockIdx.z, tid = threadIdx.x;
    const int hm = vh >> 1, half = vh & 1, h = hm >> 1;
    const float c2 = exp2f(-2.f * (h + 1)) * 1.4426950408889634f;
    const int i = qb * 256 + tid; const size_t rowb = (size_t)b * SEQ;
    float q[64], acc[64];
    { const bf16* qp = Q + (rowb + i) * 512 + hm * 64;
#pragma unroll
      for (int d = 0; d < 64; ++d) { q[d] = bf2f(qp[d]); acc[d] = 0.f; } }
    float m = -INFINITY, l = 0.f;
    const int ntile = (qb * 256 + 256) / 64;
    for (int t = 0; t < ntile; ++t) {
        __syncthreads();
        for (int e = tid; e < 64 * 64; e += 256) { const int j = e >> 6, d = e & 63; const size_t r = rowb + t * 64 + j;
            Ks[j][d] = bf2f(K[r * 512 + hm * 64 + d]); Vs[j][d] = bf2f(V[r * 512 + h * 128 + half * 64 + d]); }
        __syncthreads();
        for (int j = 0; j < 64; ++j) { const int jj = t * 64 + j; if (jj > i) break;
            float s = 0.f;
#pragma unroll
            for (int d = 0; d < 64; ++d) s += q[d] * Ks[j][d];
            s -= c2 * (float)(i - jj);
            if (s > m) { const float f = exp2f(m - s); l *= f;
#pragma unroll
                for (int d = 0; d < 64; ++d) acc[d] *= f;
                m = s; }
            const float p = exp2f(s - m); l += p;
#pragma unroll
            for (int d = 0; d < 64; ++d) acc[d] += p * Vs[j][d]; }
    }
    const float rl = 1.f / l; bf16* op = O16 + (rowb + i) * 1024 + h * 256 + (hm & 1) * 128 + half * 64;
#pragma unroll
    for (int d = 0; d < 64; ++d) op[d] = f2b(acc[d] * rl);
}
__device__ __forceinline__ float lam_value(const float* lq1, const float* lk1, const float* lq2, const float* lk2) {
    float a = 0.f, b = 0.f; for (int d = 0; d < 64; ++d) { a += lq1[d] * lk1[d]; b += lq2[d] * lk2[d]; } return __expf(a) - __expf(b) + 0.2f; }
__global__ void __launch_bounds__(256) k_combine(const bf16* O16, bf16* OA, const float* lq1, const float* lk1, const float* lq2, const float* lk2, const float* sg) {
    const float lam = lam_value(lq1, lk1, lq2, lk2);
    const int row = blockIdx.x * 4 + (threadIdx.x >> 6), lane = threadIdx.x & 63, h = lane >> 4, e0 = (lane & 15) * 8;
    const bf16* a = O16 + (size_t)row * 1024 + h * 256 + e0; const bf16* bb = a + 128;
    float o[8], ss = 0.f;
#pragma unroll
    for (int j = 0; j < 8; ++j) { o[j] = bf2f(a[j]) - lam * bf2f(bb[j]); ss += o[j] * o[j]; }
    ss += __shfl_xor(ss, 1); ss += __shfl_xor(ss, 2); ss += __shfl_xor(ss, 4); ss += __shfl_xor(ss, 8);
    const float r = rsqrtf(ss * (1.f / 128.f) + LN_EPS) * 0.8f;
#pragma unroll
    for (int j = 0; j < 8; ++j) OA[(size_t)row * 1024 + h * 128 + e0 + j] = f2b(o[j] * r * sg[e0 + j]);
}
__global__ void __launch_bounds__(256) k_pool(const bf16* U, bf16* PO) {
    const size_t idx = (size_t)blockIdx.x * 256 + threadIdx.x; const int c = (int)(idx & 511); const size_t row = idx >> 9; const int pos = (int)(row & (SEQ - 1));
    const int w = 2 << (c >> 7); const int n = pos + 1 < w ? pos + 1 : w; float s = 0.f;
    for (int k = 0; k < n; ++k) s += bf2f(U[(row - k) * 512 + c]);
    PO[row * 1024 + c] = f2b(s / (float)n - bf2f(U[row * 512 + c]));
}
__global__ void __launch_bounds__(256) k_ln1_route(float* X1, bf16* X1B, const float* g, const float* bta, const float* wr, const float* br, unsigned* CNT, int* LIST, float* GATE, float* GATEL) {
    __shared__ float xs[1024]; __shared__ float red[8]; __shared__ float part[8][32]; __shared__ float lg[32];
    const int row = blockIdx.x, tid = threadIdx.x, lane = tid & 63, wv = tid >> 6;
    f32x4 v = ((const f32x4*)(X1 + (size_t)row * 1024))[tid];
    float s = (v.x + v.y) + (v.z + v.w); for (int o = 1; o < 64; o <<= 1) s += __shfl_xor(s, o);
    if (lane == 0) red[wv] = s; __syncthreads(); const float mean = (red[0] + red[1] + red[2] + red[3]) * (1.f / 1024.f); __syncthreads();
    v = v - mean; float q = (v.x * v.x + v.y * v.y) + (v.z * v.z + v.w * v.w); for (int o = 1; o < 64; o <<= 1) q += __shfl_xor(q, o);
    if (lane == 0) red[wv] = q; __syncthreads(); const float rstd = rsqrtf((red[0] + red[1] + red[2] + red[3]) * (1.f / 1024.f) + LN_EPS);
    const f32x4 gg = ((const f32x4*)g)[tid], bb = ((const f32x4*)bta)[tid]; v = v * rstd * gg + bb;
    ((f32x4*)(X1 + (size_t)row * 1024))[tid] = v; ((unsigned long long*)(X1B + (size_t)row * 1024))[tid] = (unsigned long long)pk2(v.x, v.y) | ((unsigned long long)pk2(v.z, v.w) << 32);
    xs[tid * 4] = v.x; xs[tid * 4 + 1] = v.y; xs[tid * 4 + 2] = v.z; xs[tid * 4 + 3] = v.w; __syncthreads();
    { const int e = tid & 31, pt = tid >> 5; float a = 0.f; for (int k = pt * 128; k < pt * 128 + 128; ++k) a += xs[k] * wr[k * 32 + e]; part[pt][e] = a; }
    __syncthreads();
    if (tid < 32) { float a = br[tid]; for (int pt = 0; pt < 8; ++pt) a += part[pt][tid]; lg[tid] = a; }
    __syncthreads();
    if (tid == 0) { int id[4]; float vv[4]; unsigned used = 0u;
        for (int k = 0; k < 4; ++k) { int bi = 0; float bv = -INFINITY; for (int e = 0; e < 32; ++e) if (!((used >> e) & 1u) && lg[e] > bv) { bv = lg[e]; bi = e; } used |= 1u << bi; id[k] = bi; vv[k] = bv; }
        float es[4], sum = 0.f; for (int k = 0; k < 4; ++k) { es[k] = __expf(vv[k] - vv[0]); sum += es[k]; }
        for (int k = 0; k < 4; ++k) { const unsigned pos = atomicAdd(&CNT[id[k]], 1u); LIST[(size_t)id[k] * 65536 + pos] = row * 4 + k; GATEL[(size_t)id[k] * 65536 + pos] = es[k] / sum; GATE[row * 4 + k] = es[k] / sum; } }
}
struct RowGather { const bf16* X1B; const int* LIST; const unsigned* CNT;
    __device__ bool active(int e, int row0) const { return (unsigned)row0 < CNT[e]; }
    __device__ const bf16* row(int e, int r) const { return (unsigned)r < CNT[e] ? X1B + (size_t)(LIST[(size_t)e * 65536 + r] >> 2) * 1024 : nullptr; } };
__device__ __forceinline__ unsigned slot_off(const unsigned* CNT, int e) { unsigned o = 0; for (int i = 0; i < e; ++i) o += CNT[i]; return o; }
struct EpiUp { bf16* HB; const float* bup; const unsigned* CNT;
    __device__ void operator()(int e, int r, int c, float glu, float lin) const { if ((unsigned)r >= CNT[e]) return;
        glu += bup[e * 2048 + c]; lin += bup[e * 2048 + 1024 + c]; glu = fminf(glu, 7.f); lin = fminf(fmaxf(lin, -7.f), 7.f);
        HB[(size_t)(slot_off(CNT, e) + r) * 1024 + c] = f2b(glu * sigm(1.702f * glu) * (lin + 1.f)); } };
struct RowSlots { const bf16* HB; const unsigned* CNT;
    __device__ bool active(int e, int row0) const { return (unsigned)row0 < CNT[e]; }
    __device__ const bf16* row(int e, int r) const { return (unsigned)r < CNT[e] ? HB + (size_t)(slot_off(CNT, e) + r) * 1024 : nullptr; } };
struct EpiDown { float* base; bf16* YS1; bf16* YS2; bf16* YS3; const float* bdn; const int* LIST; const float* GATE; const unsigned* CNT;
    __device__ void operator()(int e, int r, int c, float v, float) const { if ((unsigned)r >= CNT[e]) return;
        const int a = LIST[(size_t)e * 65536 + r], tok = a >> 2, k = a & 3; const float y = (v + bdn[e * 1024 + c]) * GATE[a]; const size_t i = (size_t)tok * 1024 + c;
        if (k == 0) base[i] += y; else if (k == 1) YS1[i] = f2b(y); else if (k == 2) YS2[i] = f2b(y); else YS3[i] = f2b(y); } };
__global__ void __launch_bounds__(256) k_final(float* out, const bf16* YS1, const bf16* YS2, const bf16* YS3, const float* g, const float* bta) {
    __shared__ float red[8]; const int row = blockIdx.x, tid = threadIdx.x, lane = tid & 63, wv = tid >> 6; const size_t i0 = (size_t)row * 1024 + tid * 4;
    f32x4 v = *(const f32x4*)(out + i0);
    const bf16* ys[3] = {YS1, YS2, YS3};
    for (int k = 0; k < 3; ++k) { const unsigned long long w = *(const unsigned long long*)(ys[k] + i0); v.x += bf2f((bf16)(w & 0xffff)); v.y += bf2f((bf16)((w >> 16) & 0xffff)); v.z += bf2f((bf16)((w >> 32) & 0xffff)); v.w += bf2f((bf16)(w >> 48)); }
    float s = (v.x + v.y) + (v.z + v.w); for (int o = 1; o < 64; o <<= 1) s += __shfl_xor(s, o);
    if (lane == 0) red[wv] = s; __syncthreads(); const float mean = (red[0] + red[1] + red[2] + red[3]) * (1.f / 1024.f); __syncthreads();
    v = v - mean; float q = (v.x * v.x + v.y * v.y) + (v.z * v.z + v.w * v.w); for (int o = 1; o < 64; o <<= 1) q += __shfl_xor(q, o);
    if (lane == 0) red[wv] = q; __syncthreads(); const float rstd = rsqrtf((red[0] + red[1] + red[2] + red[3]) * (1.f / 1024.f) + LN_EPS);
    const f32x4 gg = ((const f32x4*)g)[tid], bb = ((const f32x4*)bta)[tid]; *(f32x4*)(out + i0) = v * rstd * gg + bb;
}
}
namespace pg8 {
#define PG8_LAS __attribute__((address_space(3)))
typedef unsigned short bf16_t;
typedef unsigned u32x4 __attribute__((ext_vector_type(4)));
typedef float f32x2 __attribute__((ext_vector_type(2)));
constexpr int BM = 256, BK = 64, HALF = 128, HTB = HALF * BK * 2  , STAGE_BYTES = 8 * HTB, NXCD = 8, WGM = 8;
constexpr int TAB_OFF = 131072 + 1024;
constexpr int TAB_CNT = TAB_OFF, TAB_BLK0 = TAB_OFF + 128, TAB_ROW0 = TAB_OFF + 384, TAB_IDS = TAB_OFF + 1024, TAB_GATES = TAB_OFF + 1024 + 2048;

__host__ __device__ __forceinline__ int lds_byte(int r, int c) { const int st = (r >> 4) * 2 + (c >> 5), rr = r & 15, cc = c & 31, ob = rr * 64 + cc * 2; return st * 1024 + (ob ^ (((ob >> 9) & 1) << 5)); }
__host__ __device__ __forceinline__ void stage_rc(int b, int& R, int& C) { const int st = b / 1024, sb = b % 1024, swz = sb ^ (((sb >> 9) & 1) << 5); R = (st >> 1) * 16 + swz / 64; C = (st & 1) * 32 + (swz % 64) / 2; }
__host__ __device__ __forceinline__ int perm32(int rho) { const int n = rho >> 4, i = rho & 15; return 8 * (i >> 2) + 4 * n + (i & 3); }

struct Unit { int pm, pn, e, nvalid; };
struct Gemm { const bf16_t* A; const bf16_t* Bt; int K; };

struct StaticOrder {
    static constexpr bool TABLES = false, FP8 = false;
    int nM, nN, nwg, G, c;
    __host__ __device__ void init(int M, int N, int G_, int c_) { nM = M / BM; nN = N / BM; nwg = nM * nN; G = G_; c = c_; }
    __device__ __forceinline__ bool next(int i, Unit& u, PG8_LAS unsigned char*) const {
        const long L = (long)i * G + c; if (L >= nwg) return false;
        int wgid = (int)L; { const int q = nwg / NXCD, r = nwg % NXCD, xcd = wgid % NXCD, off = wgid / NXCD; wgid = (xcd < r ? xcd * (q + 1) : r * (q + 1) + (xcd - r) * q) + off; }
        const int nig = WGM * nN, gid = wgid / nig, fm = gid * WGM, gsz = (nM - fm) < WGM ? (nM - fm) : WGM;
        u.pm = fm + ((wgid % nig) % gsz); u.pn = (wgid % nig) / gsz; u.e = 0; u.nvalid = 256; return true;
    }
    __device__ __forceinline__ const char* b_tile(const Gemm& g, const Unit& u) const { return (const char*)g.Bt + (size_t)u.pn * (size_t)(BM * 2) * g.K; }
    __device__ __forceinline__ void a_offsets(const Gemm& g, const Unit& u, PG8_LAS unsigned char*, int, const int (&R)[2], const int (&C)[2], unsigned (&off)[2][2]) const {
#pragma unroll
        for (int h = 0; h < 2; ++h)
#pragma unroll
            for (int i = 0; i < 2; ++i) off[h][i] = (unsigned)(((u.pm * BM + h * HALF + R[i]) * g.K + C[i]) * 2);
    }
    __device__ __forceinline__ void issue_tables(const Unit&, PG8_LAS unsigned char*, int, int) const {}
};

struct DenseF8Order : StaticOrder { static constexpr bool FP8 = true; };

template <bool GATHER_, bool FP8_> struct MoeOrder {
    static constexpr bool TABLES = true; static constexpr bool GATHER = GATHER_, FP8 = FP8_;
    int NT, G, c; const int* LIST; const float* GATEL; size_t bstride;
    __device__ __forceinline__ bool next(int i, Unit& u, PG8_LAS unsigned char* lds) const {
        const PG8_LAS int* cnt = (const PG8_LAS int*)(lds + TAB_CNT); const PG8_LAS int* blk0 = (const PG8_LAS int*)(lds + TAB_BLK0);
        const int L = i * G + c; const int total = blk0[32] * NT; if (L >= total) return false;
        const int blk = L / NT; int e = 0;
#pragma unroll 1
        for (int j = 1; j < 32; ++j) e += (blk >= blk0[j]) ? 1 : 0;
        e = __builtin_amdgcn_readfirstlane(e);
        u.e = e; u.pm = __builtin_amdgcn_readfirstlane(blk - blk0[e]); u.pn = L % NT; const int left = __builtin_amdgcn_readfirstlane(cnt[e]) - 256 * u.pm; u.nvalid = left < 256 ? left : 256; return true;
    }
    __device__ __forceinline__ const char* b_tile(const Gemm& g, const Unit& u) const { return (const char*)g.Bt + (size_t)u.e * bstride + (size_t)u.pn * (size_t)(BM * 2) * g.K; }
    __device__ __forceinline__ void a_offsets(const Gemm& g, const Unit& u, PG8_LAS unsigned char* lds, int buf, const int (&R)[2], const int (&C)[2], unsigned (&off)[2][2]) const {
        const PG8_LAS int* ids = (const PG8_LAS int*)(lds + TAB_IDS) + buf * 256; const PG8_LAS int* row0 = (const PG8_LAS int*)(lds + TAB_ROW0);
#pragma unroll
        for (int h = 0; h < 2; ++h)
#pragma unroll
            for (int i = 0; i < 2; ++i) { const int r = h * HALF + R[i];
                if (GATHER) { const int tok = (r < u.nvalid) ? (ids[r] >> 2) : 0; off[h][i] = (unsigned)((tok * g.K + C[i]) * 2); }
                else off[h][i] = (unsigned)(((row0[u.e] + u.pm * BM + r) * g.K + C[i]) * 2); }
    }
    __device__ __forceinline__ void issue_tables(const Unit& u, PG8_LAS unsigned char* lds, int buf, int lane) const {
        const size_t o = (size_t)u.e * 65536 + (size_t)u.pm * 256 + lane * 4;
        __builtin_amdgcn_global_load_lds((const unsigned*)(LIST + o), (PG8_LAS unsigned*)(lds + TAB_IDS + buf * 1024), 16, 0, 0);
        if (!GATHER) __builtin_amdgcn_global_load_lds((const unsigned*)(GATEL + o), (PG8_LAS unsigned*)(lds + TAB_GATES + buf * 1024), 16, 0, 0);
    }
};

__device__ __forceinline__ unsigned cvt_pk_bf16(float lo, float hi) { unsigned r; asm volatile("v_cvt_pk_bf16_f32 %0, %1, %2" : "=v"(r) : "v"(lo), "v"(hi)); return r; }
__device__ __forceinline__ float bflo(unsigned w) { return __builtin_bit_cast(float, w << 16); }
__device__ __forceinline__ float bfhi(unsigned w) { return __builtin_bit_cast(float, w & 0xffff0000u); }
__device__ __forceinline__ float sigm(float v) { return __builtin_amdgcn_rcpf(1.f + __builtin_amdgcn_exp2f(-1.4426950408889634f * v)); }
__device__ __forceinline__ u32x4 pack8(const f32x4& v0, const f32x4& v1) { u32x4 w; w.x = cvt_pk_bf16(v0[0], v0[1]); w.y = cvt_pk_bf16(v0[2], v0[3]); w.z = cvt_pk_bf16(v1[0], v1[1]); w.w = cvt_pk_bf16(v1[2], v1[3]); return w; }
__device__ __forceinline__ void unpack8(const u32x4& w, f32x4& v0, f32x4& v1) { v0 = (f32x4){bflo(w.x), bfhi(w.x), bflo(w.y), bfhi(w.y)}; v1 = (f32x4){bflo(w.z), bfhi(w.z), bflo(w.w), bfhi(w.w)}; }
typedef f32x4 Acc[2][2][4][2];
typedef int i32x4 __attribute__((ext_vector_type(4)));
typedef int i32x8 __attribute__((ext_vector_type(8)));
struct bf16x8p { bf16x8 k[2]; };
template <bool F8> struct Frag { typedef bf16x8p T; };
template <> struct Frag<true> { typedef i32x8 T; };
__device__ __forceinline__ void frag_set(i32x8& d, const i32x4& lo, const i32x4& hi) { d = __builtin_shufflevector(lo, hi, 0, 1, 2, 3, 4, 5, 6, 7); }
__device__ __forceinline__ void frag_set(bf16x8p& d, const bf16x8& lo, const bf16x8& hi) { d.k[0] = lo; d.k[1] = hi; }
__device__ __forceinline__ void frag_mma(f32x4& c, const i32x8& b, const i32x8& a) { c = __builtin_amdgcn_mfma_scale_f32_16x16x128_f8f6f4(b, a, c, 0, 0, 0, 0, 0, 0); }
__device__ __forceinline__ void frag_mma(f32x4& c, const bf16x8p& b, const bf16x8p& a) { c = __builtin_amdgcn_mfma_f32_16x16x32_bf16(b.k[0], a.k[0], c, 0, 0, 0); c = __builtin_amdgcn_mfma_f32_16x16x32_bf16(b.k[1], a.k[1], c, 0, 0, 0); }
__device__ __forceinline__ unsigned pk4_fp8(float a, float b, float c, float d) { unsigned w = __builtin_amdgcn_cvt_pk_fp8_f32(a, b, 0u, false); return __builtin_amdgcn_cvt_pk_fp8_f32(c, d, w, true); }
template <class E> struct has_mid { template <class T> static constexpr bool f(decltype(T::MID)*) { return T::MID; } template <class T> static constexpr bool f(...) { return false; } static constexpr bool value = f<E>(nullptr); };

struct EpiProj {
    static constexpr bool PERM = true;
    bf16_t *Q, *K, *V, *U, *G; const float* bg; float* PN; float c2; int pad;
    __device__ __forceinline__ void operator()(const Acc& acc, const Unit& u, int wr, int wc, int fr_, int fq_, PG8_LAS unsigned char*, int) const {
        int fr = fr_, fq = fq_; asm volatile("" : "+v"(fr), "+v"(fq));
        const int row0 = u.pm * BM + wr * 64 + fr; const bool isg = u.pn >= 8;
        bf16_t* base; int ldc, colt; float sc = 1.f;
        if (isg) { base = G; ldc = 2048; colt = (u.pn - 8) * BM; } else { const int t = u.pn >> 1; base = t == 0 ? Q : t == 1 ? K : t == 2 ? V : U; ldc = 512; colt = (u.pn & 1) * BM; if (t == 0) sc = c2; }
        const int col0 = colt + wc * 32 + 8 * fq;
        f32x4 bv[2][2];
#pragma unroll
        for (int bj = 0; bj < 2; ++bj)
#pragma unroll
            for (int n = 0; n < 2; ++n) bv[bj][n] = isg ? *(const f32x4*)(bg + col0 + bj * HALF + 4 * n) : (f32x4){0.f, 0.f, 0.f, 0.f};
#pragma unroll
        for (int ai = 0; ai < 2; ++ai)
#pragma unroll
            for (int m = 0; m < 4; ++m) { bf16_t* rowp = base + (size_t)(row0 + ai * HALF + m * 16) * ldc + col0;
#pragma unroll
                for (int bj = 0; bj < 2; ++bj) { f32x4 v0 = acc[ai][bj][m][0] + bv[bj][0], v1 = acc[ai][bj][m][1] + bv[bj][1];
                    if (isg) {
#pragma unroll
                        for (int i = 0; i < 4; ++i) { v0[i] = sigm(v0[i]); v1[i] = sigm(v1[i]); } }
                    v0 = v0 * sc; v1 = v1 * sc; *(u32x4*)(rowp + bj * HALF) = pack8(v0, v1); } }
        if (u.pn < 4) {
            float* tab = PN + (u.pn >> 1) * 16384; const int R0 = u.pm * BM, b = R0 >> 12;
#pragma unroll
            for (int ai = 0; ai < 2; ++ai)
#pragma unroll
                for (int bj = 0; bj < 2; ++bj) { float mx = 0.f;
#pragma unroll
                    for (int m = 0; m < 4; ++m) { f32x4 v0 = acc[ai][bj][m][0] * sc, v1 = acc[ai][bj][m][1] * sc;
                        float s = (v0[0] * v0[0] + v0[1] * v0[1]) + (v0[2] * v0[2] + v0[3] * v0[3]) + (v1[0] * v1[0] + v1[1] * v1[1]) + (v1[2] * v1[2] + v1[3] * v1[3]);
                        s += __shfl_xor(s, 16); s += __shfl_xor(s, 32); mx = fmaxf(mx, s); }
                    mx = fmaxf(mx, __shfl_xor(mx, 1)); mx = fmaxf(mx, __shfl_xor(mx, 2)); mx = fmaxf(mx, __shfl_xor(mx, 4)); mx = fmaxf(mx, __shfl_xor(mx, 8));
                    const int tile = ((R0 & 4095) >> 6) + 2 * ai + wr, hm = (u.pn & 1) * 4 + 2 * bj + (wc >> 1);
                    if (fr == 0 && fq == 0) tab[((b * 8 + hm) * 64 + tile) * 2 + (wc & 1)] = mx; }
        }
    }
};
struct EpiMixCat {
    static constexpr bool PERM = true, MID = true;
    bf16_t* MIX; const bf16_t* G;
    __device__ __forceinline__ void mid(Acc& acc, const Unit& u, int wr, int wc, int fr_, int fq_) const {
        int fr = fr_, fq = fq_; asm volatile("" : "+v"(fr), "+v"(fq));
        const int row0 = u.pm * BM + wr * 64 + fr, col0 = u.pn * BM + wc * 32 + 8 * fq;
#pragma unroll
        for (int ai = 0; ai < 2; ++ai)
#pragma unroll
            for (int m = 0; m < 4; ++m) { const size_t r = (size_t)(row0 + ai * HALF + m * 16);
#pragma unroll
                for (int bj = 0; bj < 2; ++bj) { const int c = col0 + bj * HALF;
                    const u32x4 aw = *(const u32x4*)(G + r * 2048 + c), pw = *(const u32x4*)(G + r * 2048 + 1024 + c); f32x4 a0, a1, p0, p1; unpack8(aw, a0, a1); unpack8(pw, p0, p1);
#pragma unroll
                    for (int i = 0; i < 4; ++i) { acc[ai][bj][m][0][i] *= a0[i] * __builtin_amdgcn_rcpf(fmaxf(p0[i], 8.67e-19f)); acc[ai][bj][m][1][i] *= a1[i] * __builtin_amdgcn_rcpf(fmaxf(p1[i], 8.67e-19f)); }
                    asm volatile("" : "+v"(acc[ai][bj][m][0]), "+v"(acc[ai][bj][m][1]) :: "memory"); } }
    }
    __device__ __forceinline__ void operator()(const Acc& acc, const Unit& u, int wr, int wc, int fr_, int fq_, PG8_LAS unsigned char*, int) const {
        int fr = fr_, fq = fq_; asm volatile("" : "+v"(fr), "+v"(fq));
        const int row0 = u.pm * BM + wr * 64 + fr, col0 = u.pn * BM + wc * 32 + 8 * fq;
#pragma unroll
        for (int ai = 0; ai < 2; ++ai)
#pragma unroll
            for (int m = 0; m < 4; ++m) { const size_t r = (size_t)(row0 + ai * HALF + m * 16);
#pragma unroll
                for (int bj = 0; bj < 2; ++bj) { const int c = col0 + bj * HALF;
                    const u32x4 pw = *(const u32x4*)(G + r * 2048 + 1024 + c); f32x4 p0, p1; unpack8(pw, p0, p1);
#pragma unroll
                    for (int i = 0; i < 4; ++i) { p0[i] = fmaxf(p0[i], 8.67e-19f); p1[i] = fmaxf(p1[i], 8.67e-19f); }
                    *(u32x4*)(MIX + r * 1024 + c) = pack8(acc[ai][bj][m][0] * p0, acc[ai][bj][m][1] * p1); }
                asm volatile("" ::: "memory"); }
    }
};
template <int MODE> struct EpiF32 {
    static constexpr bool PERM = false;
    float* out; const float* aux; float alpha; float dsc;
    __device__ __forceinline__ void operator()(const Acc& acc, const Unit& u, int wr, int wc, int fr_, int fq_, PG8_LAS unsigned char*, int) const {
        int fr = fr_, fq = fq_; asm volatile("" : "+v"(fr), "+v"(fq));
        const int col0 = u.pn * BM + wc * 32 + 4 * fq;
#pragma unroll
        for (int ai = 0; ai < 2; ++ai)
#pragma unroll
            for (int m = 0; m < 4; ++m) { const size_t off = (size_t)(u.pm * BM + ai * HALF + wr * 64 + m * 16 + fr) * 1024 + col0;
#pragma unroll
                for (int bj = 0; bj < 2; ++bj) {
#pragma unroll
                    for (int n = 0; n < 2; ++n) { const size_t o = off + bj * HALF + n * 16; const f32x4 a = acc[ai][bj][m][n]; f32x4 r;
                        if (MODE == 1) { f32x2 w; unsigned* wp = (unsigned*)&w; wp[0] = cvt_pk_bf16(a[0], a[1]); wp[1] = cvt_pk_bf16(a[2], a[3]); *(f32x2*)((bf16_t*)out + o) = w; continue; }
                        if (MODE == 0) r = *(const f32x4*)(aux + o) * alpha + a;
                        else { const f32x2 tw = *(const f32x2*)((const bf16_t*)aux + o); const unsigned* tp = (const unsigned*)&tw; const f32x4 t = {bflo(tp[0]), bfhi(tp[0]), bflo(tp[1]), bfhi(tp[1])}; const f32x4 b = *(const f32x4*)(out + o); r = b * alpha;
#pragma unroll
                            for (int i = 0; i < 4; ++i) r[i] += sigm(a[i] * dsc) * t[i]; }
                        *(f32x4*)(out + o) = r; }
                  if (MODE == 2) asm volatile("" ::: "memory"); }
                if (m & 1) asm volatile("" ::: "memory"); }
    }
};
template <bool F8> struct EpiUp {
    static constexpr bool PERM = true;
    void* HB; const float* bup; float dsc; int pad;
    __device__ __forceinline__ void operator()(const Acc& acc, const Unit& u, int wr, int wc, int fr_, int fq_, PG8_LAS unsigned char* lds, int) const {
        int fr = fr_, fq = fq_; asm volatile("" : "+v"(fr), "+v"(fq));
        const PG8_LAS int* row0t = (const PG8_LAS int*)(lds + TAB_ROW0); const int srow = row0t[u.e] + u.pm * BM;
        const int c0 = u.pn * HALF + wc * 32 + 8 * fq; const float* bp = bup + (size_t)u.e * 2048 + c0;
        const f32x4 bg0 = *(const f32x4*)(bp), bg1 = *(const f32x4*)(bp + 4), bl0 = *(const f32x4*)(bp + 1024), bl1 = *(const f32x4*)(bp + 1028);
#pragma unroll
        for (int ai = 0; ai < 2; ++ai)
#pragma unroll
            for (int m = 0; m < 4; ++m) { const int r = ai * HALF + wr * 64 + m * 16 + fr;
                f32x4 g0 = acc[ai][0][m][0] * dsc + bg0, g1 = acc[ai][0][m][1] * dsc + bg1, l0 = acc[ai][1][m][0] * dsc + bl0, l1 = acc[ai][1][m][1] * dsc + bl1;
#pragma unroll
                for (int i = 0; i < 4; ++i) { float a = fminf(g0[i], 7.f), b = fminf(fmaxf(l0[i], -7.f), 7.f); g0[i] = a * sigm(1.702f * a) * (b + 1.f);
                                              a = fminf(g1[i], 7.f); b = fminf(fmaxf(l1[i], -7.f), 7.f); g1[i] = a * sigm(1.702f * a) * (b + 1.f); }
                if (r < u.nvalid) {
                    if (F8) { f32x2 w; unsigned* wp = (unsigned*)&w; wp[0] = pk4_fp8(g0[0], g0[1], g0[2], g0[3]); wp[1] = pk4_fp8(g1[0], g1[1], g1[2], g1[3]); *(f32x2*)((unsigned char*)HB + (size_t)(srow + r) * 1024 + c0) = w; }
                    else *(u32x4*)((bf16_t*)HB + (size_t)(srow + r) * 1024 + c0) = pack8(g0, g1); } }
    }
};
struct EpiDown {
    static constexpr bool PERM = true;
    float* base; bf16_t* YS1; bf16_t* YS2; bf16_t* YS3; const float* bdn; float dsc; int pad;
    __device__ __forceinline__ void operator()(const Acc& acc, const Unit& u, int wr, int wc, int fr_, int fq_, PG8_LAS unsigned char* lds, int buf) const {
        int fr = fr_, fq = fq_; asm volatile("" : "+v"(fr), "+v"(fq));
        const PG8_LAS int* ids = (const PG8_LAS int*)(lds + TAB_IDS) + buf * 256; const PG8_LAS float* gates = (const PG8_LAS float*)(lds + TAB_GATES) + buf * 256;
        const int col0 = u.pn * BM + wc * 32 + 8 * fq; const float* bp = bdn + (size_t)u.e * 1024 + col0;
        f32x4 bv[2][2];
#pragma unroll
        for (int bj = 0; bj < 2; ++bj)
#pragma unroll
            for (int n = 0; n < 2; ++n) bv[bj][n] = *(const f32x4*)(bp + bj * HALF + 4 * n);
#pragma unroll
        for (int ai = 0; ai < 2; ++ai)
#pragma unroll
            for (int m = 0; m < 4; ++m) { const int r = ai * HALF + wr * 64 + m * 16 + fr;
                if (r < u.nvalid) { const int a = ids[r]; const float gt = gates[r]; const int k = a & 3; const size_t o = (size_t)(a >> 2) * 1024 + col0;
#pragma unroll
                    for (int bj = 0; bj < 2; ++bj) { const f32x4 v0 = (acc[ai][bj][m][0] * dsc + bv[bj][0]) * gt, v1 = (acc[ai][bj][m][1] * dsc + bv[bj][1]) * gt; const size_t oo = o + bj * HALF;
                        if (k == 0) { *(f32x4*)(base + oo) += v0; *(f32x4*)(base + oo + 4) += v1; }
                        else { bf16_t* yp = k == 1 ? YS1 : k == 2 ? YS2 : YS3; *(u32x4*)(yp + oo) = pack8(v0, v1); } } } }
    }
};

template <class Epi, class Sched>
__device__ __forceinline__ void gemm_phase(PG8_LAS unsigned char* lds, const int wid, const Gemm g, const Sched& S, const Epi& E) {
    int lane = lane_id(); asm volatile("" : "+v"(lane));
    const int tid = wid * 64 + lane, wr = wid >> 2, wc = wid & 3, fr = lane & 15, fq = lane >> 4;
    const int K = g.K, nt = K / BK;
    int RA[2], CA[2]; unsigned voffA[2], voffB[2];
#pragma unroll
    for (int i = 0; i < 2; ++i) { int R, C; stage_rc(tid * 16 + i * 8192, R, C); const int Rb = Epi::PERM ? ((R & ~31) + perm32(R & 31)) : R; RA[i] = R; CA[i] = C; voffA[i] = (unsigned)(R * K + C) * 2u; voffB[i] = (unsigned)(Rb * K + C) * 2u; }
    const size_t tstep = (size_t)BM * K * 2;
    const size_t kstep = (size_t)(BK * 2);
    const size_t hstep = (size_t)HALF * K * 2;
    const unsigned ldsw = (unsigned)wid * 1024u;
    const int aoff = lds_byte(wr * 64 + fr, fq * 8), boff = lds_byte(wc * 32 + fr, fq * 8);
#define PG8_SA(b, h) (((b) * 2 + (h)) * HTB)
#define PG8_SB(b, h) ((4 + (b) * 2 + (h)) * HTB)
#define PG8_STAGE(bufoff, gbase, voff) do { _Pragma("unroll") for (int _i = 0; _i < 2; ++_i) \
        __builtin_amdgcn_global_load_lds((const unsigned*)((const char*)(gbase) + (voff)[_i]), (PG8_LAS unsigned*)(lds + (bufoff) + ldsw + _i * 8192), 16, 0, 0); } while (0)
#define PG8_STAGE_A(bufoff, ubase, h, OFF) do { if constexpr (Sched::TABLES) PG8_STAGE(bufoff, ubase, OFF[h]); else PG8_STAGE(bufoff, (ubase) + ((h) ? hstep : 0), voffA); } while (0)
#define PG8_LDA(dst, b, h) do { _Pragma("unroll") for (int m = 0; m < 4; ++m) { if constexpr (Sched::FP8) dst##8[m] = __builtin_shufflevector(*(const PG8_LAS i32x4*)(lds + PG8_SA(b, h) + aoff + m * 2048), *(const PG8_LAS i32x4*)(lds + PG8_SA(b, h) + aoff + m * 2048 + 1024), 0, 1, 2, 3, 4, 5, 6, 7); \
        else { _Pragma("unroll") for (int k = 0; k < 2; ++k) dst[m][k] = *(const PG8_LAS bf16x8*)(lds + PG8_SA(b, h) + aoff + m * 2048 + k * 1024); } } } while (0)
#define PG8_LDB(dst, b, h) do { _Pragma("unroll") for (int n = 0; n < 2; ++n) { if constexpr (Sched::FP8) dst##8[n] = __builtin_shufflevector(*(const PG8_LAS i32x4*)(lds + PG8_SB(b, h) + boff + n * 2048), *(const PG8_LAS i32x4*)(lds + PG8_SB(b, h) + boff + n * 2048 + 1024), 0, 1, 2, 3, 4, 5, 6, 7); \
        else { _Pragma("unroll") for (int k = 0; k < 2; ++k) dst[n][k] = *(const PG8_LAS bf16x8*)(lds + PG8_SB(b, h) + boff + n * 2048 + k * 1024); } } } while (0)
#define PG8_MMA(ai, bj, At, Bt) do { __builtin_amdgcn_s_setprio(1); if constexpr (Sched::FP8) asm volatile("s_nop 1"); _Pragma("unroll") for (int m = 0; m < 4; ++m) _Pragma("unroll") for (int n = 0; n < 2; ++n) { \
        if constexpr (Sched::FP8) asm volatile("v_mfma_f32_16x16x128_f8f6f4 %0, %1, %2, %0" : "+v"(acc[ai][bj][m][n]) : "v"(Bt##8[n]), "v"(At##8[m]));   \
        else { _Pragma("unroll") for (int k = 0; k < 2; ++k) acc[ai][bj][m][n] = __builtin_amdgcn_mfma_f32_16x16x32_bf16(Bt[n][k], At[m][k], acc[ai][bj][m][n], 0, 0, 0); } } __builtin_amdgcn_s_setprio(0); } while (0)
#define PG8_WAIT_V(n) asm volatile("s_waitcnt vmcnt(" #n ")" ::: "memory")
#define PG8_WAIT_L(n) asm volatile("s_waitcnt lgkmcnt(" #n ")" ::: "memory")
#define PG8_BAR __builtin_amdgcn_s_barrier()
#define PG8_SCHED __builtin_amdgcn_sched_barrier(0)
    Unit cur, nxt; int ui = 0;
    if (!S.next(0, cur, lds)) return;
    if constexpr (Sched::TABLES) {
        if (wid == 0) S.issue_tables(cur, lds, 0, lane);
        PG8_WAIT_V(0); PG8_BAR;
    }
    Acc acc;
#pragma unroll
    for (int a = 0; a < 2; ++a)
#pragma unroll
        for (int b = 0; b < 2; ++b)
#pragma unroll
            for (int m = 0; m < 4; ++m)
#pragma unroll
                for (int n = 0; n < 2; ++n) acc[a][b][m][n] = (f32x4){0.f, 0.f, 0.f, 0.f};
    bf16x8 At[4][2], B0[2][2], B1[2][2];
    i32x8 At8[4], B08[2], B18[2];
    unsigned offc[2][2], offn[2][2];
    if constexpr (Sched::TABLES) { S.a_offsets(g, cur, lds, 0, RA, CA, offc);
#pragma unroll
        for (int h = 0; h < 2; ++h)
#pragma unroll
            for (int i = 0; i < 2; ++i) offn[h][i] = offc[h][i]; }
    const char* const Ab = (const char*)g.A;
    const char* cA = Sched::TABLES ? Ab : Ab + (size_t)cur.pm * tstep;
    const char* cB = S.b_tile(g, cur);
    PG8_STAGE(PG8_SB(0, 0), cB, voffB); PG8_STAGE(PG8_SB(0, 1), cB + hstep, voffB); PG8_STAGE_A(PG8_SA(0, 0), cA, 0, offc); PG8_STAGE_A(PG8_SA(0, 1), cA, 1, offc);
    if (wr == 1) PG8_BAR;
    PG8_WAIT_V(2); PG8_BAR;
    PG8_STAGE(PG8_SB(1, 0), cB + kstep, voffB); PG8_STAGE_A(PG8_SA(1, 0), cA + kstep, 0, offc); PG8_STAGE(PG8_SB(1, 1), cB + hstep + kstep, voffB);
    PG8_WAIT_V(6); PG8_BAR;
    for (;;) {
        const bool has_next = S.next(ui + 1, nxt, lds);
        const char* nB = has_next ? S.b_tile(g, nxt) : cB;
        const char* nA = Sched::TABLES ? Ab : (has_next ? Ab + (size_t)nxt.pm * tstep : cA);
#pragma nounroll
        for (int t = 0; t < nt; t += 2) {
            const bool last = (t == nt - 2);
            if constexpr (has_mid<Epi>::value) { if (t == nt / 2) E.mid(acc, cur, wr, wc, fr, fq); }
            if constexpr (Sched::TABLES) {
                if (t == 2 && has_next && wid == 0) S.issue_tables(nxt, lds, (ui + 1) & 1, lane);
                if (t == (nt >= 16 ? nt - 6 : nt - 2) && has_next) S.a_offsets(g, nxt, lds, (ui + 1) & 1, RA, CA, offn);
            }
            unsigned o2[2][2];
            if constexpr (Sched::TABLES) {
#pragma unroll
                for (int h = 0; h < 2; ++h)
#pragma unroll
                    for (int i = 0; i < 2; ++i) o2[h][i] = last ? offn[h][i] : offc[h][i]; }
            const char* a1 = cA + (size_t)(t + 1) * kstep;
            const char* a2 = last ? nA : cA + (size_t)(t + 2) * kstep; const char* b2 = last ? nB : cB + (size_t)(t + 2) * kstep;
            const char* a3 = a2 + kstep; const char* b3 = b2 + kstep;
            PG8_LDB(B0, 0, 0); PG8_LDB(B1, 0, 1); PG8_SCHED; PG8_LDA(At, 0, 0); PG8_STAGE_A(PG8_SA(1, 1), a1, 1, offc);
            PG8_WAIT_V(8); PG8_WAIT_L(0); PG8_BAR; PG8_MMA(0, 0, At, B0); PG8_MMA(0, 1, At, B1); PG8_BAR; PG8_SCHED;
            PG8_LDA(At, 0, 1); PG8_STAGE(PG8_SB(0, 0), b2, voffB); PG8_STAGE(PG8_SB(0, 1), b2 + hstep, voffB); PG8_STAGE_A(PG8_SA(0, 0), a2, 0, o2);
            PG8_WAIT_V(8); PG8_WAIT_L(0); PG8_BAR; PG8_MMA(1, 0, At, B0); PG8_MMA(1, 1, At, B1); PG8_BAR; PG8_SCHED;
            PG8_LDB(B0, 1, 0); PG8_LDB(B1, 1, 1); PG8_SCHED; PG8_LDA(At, 1, 0); PG8_STAGE_A(PG8_SA(0, 1), a2, 1, o2);
            PG8_WAIT_V(8); PG8_WAIT_L(0); PG8_BAR; PG8_MMA(0, 0, At, B0); PG8_MMA(0, 1, At, B1); PG8_BAR; PG8_SCHED;
            PG8_LDA(At, 1, 1); PG8_STAGE(PG8_SB(1, 0), b3, voffB); PG8_STAGE(PG8_SB(1, 1), b3 + hstep, voffB); PG8_STAGE_A(PG8_SA(1, 0), a3, 0, o2);
            PG8_WAIT_V(8); PG8_WAIT_L(0); PG8_BAR; PG8_MMA(1, 0, At, B0); PG8_MMA(1, 1, At, B1); PG8_BAR; PG8_SCHED;
        }
        if (wr == 0) PG8_BAR;
        E(acc, cur, wr, wc, fr, fq, lds, ui & 1);
        if (!has_next) break;
#pragma unroll
        for (int a = 0; a < 2; ++a)
#pragma unroll
            for (int b = 0; b < 2; ++b)
#pragma unroll
                for (int m = 0; m < 4; ++m)
#pragma unroll
                    for (int n = 0; n < 2; ++n) acc[a][b][m][n] = (f32x4){0.f, 0.f, 0.f, 0.f};
        cur = nxt; cB = nB; cA = nA; ++ui;
        if constexpr (Sched::TABLES) {
#pragma unroll
            for (int h = 0; h < 2; ++h)
#pragma unroll
                for (int i = 0; i < 2; ++i) offc[h][i] = offn[h][i]; }
        if (wr == 1) PG8_BAR;
    }
    PG8_WAIT_V(0);
    PG8_BAR;
#undef PG8_SA
#undef PG8_SB
#undef PG8_STAGE
#undef PG8_STAGE_A
#undef PG8_LDA
#undef PG8_LDB
#undef PG8_MMA
#undef PG8_WAIT_V
#undef PG8_WAIT_L
#undef PG8_BAR
#undef PG8_SCHED
}
}
namespace attn_body {
using bf16=__hip_bfloat16;
using bf16x8=__attribute__((ext_vector_type(8)))short;
using s16x4=__attribute__((ext_vector_type(4)))short;
using f32x16=__attribute__((ext_vector_type(16)))float;
using u32x4=__attribute__((ext_vector_type(4)))unsigned;
constexpr int BATCH=16,SEQ=4096,D=64,DM=512,DMO=1024;
constexpr int NW=8,QBLK=32,QB=QBLK*NW,KVBLK=64,NQB=SEQ/QB;
constexpr int ATTN_UNIT_ROWS=QB;
__device__ __forceinline__ int crow(int r,int hi){return (r&3)+8*(r>>2)+4*hi;}
#define SBAR() __builtin_amdgcn_sched_barrier(0)
__device__ __forceinline__ void cmask(f32x16&p0,f32x16&p1,int jb,int qrel,int hi){
  const float NEG=-INFINITY; int kb=64*jb+4*hi; asm volatile("":"+v"(kb));
  #pragma unroll
  for(int r=0;r<16;++r){int kv=kb+(r&3)+8*(r>>2); if(kv>qrel)p0[r]=NEG; if(kv+32>qrel)p1[r]=NEG;}
}

constexpr int NSLOT=3, SLOTB=8192;
constexpr int LDS_K=0, LDS_V=NSLOT*SLOTB, LDS_WS=2*NSLOT*SLOTB, LDS_OST=LDS_WS+NW*64*4, LDS_BYTES=LDS_OST+NW*4096;
constexpr float C2=0.125f*1.4426950408889634f;
__device__ __forceinline__ void glds16(const void*gsrc,unsigned lds_dst){unsigned keep;
  asm volatile("s_mov_b32 %0, m0\n\ts_mov_b32 m0, %2\n\ts_nop 0\n\tglobal_load_lds_dwordx4 %1, off\n\ts_mov_b32 m0, %0":"=&s"(keep):"v"(gsrc),"s"(lds_dst):"memory");}
__device__ __forceinline__ float max3f(float a,float b,float c){float r;asm("v_max3_f32 %0, %1, %2, %3":"=v"(r):"v"(a),"v"(b),"v"(c));return r;}
__device__ __forceinline__ float max2f(float a,float b){float r;asm("v_max_f32_e32 %0, %1, %2":"=v"(r):"v"(a),"v"(b));return r;}
__device__ __forceinline__ float fadd_s(float a,float b){float r;asm("v_add_f32_e32 %0, %1, %2":"=v"(r):"v"(a),"v"(b));return r;}
__device__ __forceinline__ float fsub_s(float a,float b){float r;asm("v_sub_f32_e32 %0, %1, %2":"=v"(r):"v"(a),"v"(b));return r;}
typedef float f32x2_t __attribute__((ext_vector_type(2))); typedef __bf16 bf16x2_t __attribute__((ext_vector_type(2)));
__device__ __forceinline__ unsigned cvtpk_s(float lo,float hi){f32x2_t v={lo,hi};bf16x2_t b=__builtin_convertvector(v,bf16x2_t);return __builtin_bit_cast(unsigned,b);}
#define WAIT_BAR(N) asm volatile("s_waitcnt vmcnt(" #N ") lgkmcnt(0)\n\ts_barrier":::"memory")

__device__ __forceinline__ void qkt(f32x16&p0,f32x16&p1,const char*Kslot,const bf16x8*qr,const f32x16&i0,const f32x16&i1,int r32,int hi){
  const char*kb=Kslot+hi*1024+r32*16;
  #pragma unroll
  for(int d0=0;d0<4;++d0){
    const bf16x8 b0=*reinterpret_cast<const bf16x8*>(kb+d0*2048);
    const bf16x8 b1=*reinterpret_cast<const bf16x8*>(kb+d0*2048+512);
    if(d0==0){p0=__builtin_amdgcn_mfma_f32_32x32x16_bf16(b0,qr[0],i0,0,0,0);p1=__builtin_amdgcn_mfma_f32_32x32x16_bf16(b1,qr[0],i1,0,0,0);}
    else{p0=__builtin_amdgcn_mfma_f32_32x32x16_bf16(b0,qr[d0],p0,0,0,0);p1=__builtin_amdgcn_mfma_f32_32x32x16_bf16(b1,qr[d0],p1,0,0,0);}}
}
typedef __attribute__((address_space(3))) const char* lds_cptr;
typedef short v4i16_t __attribute__((ext_vector_type(4)));
__device__ __forceinline__ void kload8(bf16x8*kf,lds_cptr kp){
  kf[0]=*(const __attribute__((address_space(3))) bf16x8*)(kp);      kf[1]=*(const __attribute__((address_space(3))) bf16x8*)(kp+512);
  kf[2]=*(const __attribute__((address_space(3))) bf16x8*)(kp+2048); kf[3]=*(const __attribute__((address_space(3))) bf16x8*)(kp+2560);
  kf[4]=*(const __attribute__((address_space(3))) bf16x8*)(kp+4096); kf[5]=*(const __attribute__((address_space(3))) bf16x8*)(kp+4608);
  kf[6]=*(const __attribute__((address_space(3))) bf16x8*)(kp+6144); kf[7]=*(const __attribute__((address_space(3))) bf16x8*)(kp+6656);
}
__device__ __forceinline__ void kload2(bf16x8*kf,lds_cptr kp,int j){ kf[2*j]=*(const __attribute__((address_space(3))) bf16x8*)(kp+j*2048); kf[2*j+1]=*(const __attribute__((address_space(3))) bf16x8*)(kp+j*2048+512); }
__device__ __forceinline__ s16x4 vtr(lds_cptr p){ return __builtin_bit_cast(s16x4,__builtin_amdgcn_ds_read_tr16_b64_v4i16((__attribute__((address_space(3))) v4i16_t*)p)); }
__device__ __forceinline__ float rowmax(const f32x16&p0,const f32x16&p1){
  float a=max3f(p0[0],p0[1],p1[0]),b=max3f(p0[2],p0[3],p1[1]);a=max3f(a,p1[2],p1[3]);
  #pragma unroll
  for(int r=4;r<16;r+=4){a=max3f(a,p0[r],p0[r+1]);b=max3f(b,p0[r+2],p0[r+3]);a=max3f(a,p1[r],p1[r+1]);b=max3f(b,p1[r+2],p1[r+3]);}
  const float m=max2f(a,b);
  auto rr=__builtin_amdgcn_permlane32_swap(__float_as_uint(m),__float_as_uint(m),false,false);
  return max2f(__uint_as_float(rr[0]),__uint_as_float(rr[1]));
}
__device__ __forceinline__ void pv(f32x16*o,int vb,bf16x8 pa0,bf16x8 pa1,bf16x8 pa2,bf16x8 pa3){
  #pragma unroll
  for(int d0=0;d0<2;++d0){s16x4 lo[4],hi[4];
    #pragma unroll
    for(int ks=0;ks<4;++ks){
      asm volatile("ds_read_b64_tr_b16 %0,%1 offset:%c2":"=&v"(lo[ks]):"v"(vb),"i"(d0*4096+ks*1024):"memory");
      asm volatile("ds_read_b64_tr_b16 %0,%1 offset:%c2":"=&v"(hi[ks]):"v"(vb),"i"(d0*4096+ks*1024+512):"memory");}
    asm volatile("s_waitcnt lgkmcnt(0)":::"memory");SBAR();
    #define PK(k) (bf16x8){lo[k][0],lo[k][1],lo[k][2],lo[k][3],hi[k][0],hi[k][1],hi[k][2],hi[k][3]}
    o[d0]=__builtin_amdgcn_mfma_f32_32x32x16_bf16(pa0,PK(0),o[d0],0,0,0);
    o[d0]=__builtin_amdgcn_mfma_f32_32x32x16_bf16(pa1,PK(1),o[d0],0,0,0);
    o[d0]=__builtin_amdgcn_mfma_f32_32x32x16_bf16(pa2,PK(2),o[d0],0,0,0);
    o[d0]=__builtin_amdgcn_mfma_f32_32x32x16_bf16(pa3,PK(3),o[d0],0,0,0);
    #undef PK
  }
}

#ifndef ATTN_STORE16
#define ATTN_STORE16(p,v) (*(u32x4*)(p)=(v))
#endif
template<int THRL> __device__ __forceinline__ void attn_unit(int b,int hm,int half,int qb,float cs,const int wid,const float*PN,const bf16*Q,const bf16*__restrict__ K,const bf16*__restrict__ V,bf16*O,char*shm){
  int lane=lane_id(); asm volatile("":"+v"(lane));
  const int r32=lane&31,hi=lane>>5;
  const long rowbase=(long)b*SEQ; const int q0=qb*QB;
  const int NTf=(q0+QB)/KVBLK;
  int t0=0;
  { const float*pq=PN+((b*8+hm)*64)*2, *pk=PN+16384+((b*8+hm)*64)*2; float qm=0.f,km=0.f;
    if(lane<4){const float*p_=pq+(4*qb+lane)*2; qm=p_[0]+p_[1];} if(lane<NTf){const float*p_=pk+lane*2; km=p_[0]+p_[1];}
    _Pragma("unroll") for(int o_=1;o_<64;o_<<=1){qm=__builtin_fmaxf(qm,__shfl_xor(qm,o_));km=__builtin_fmaxf(km,__shfl_xor(km,o_));}
    const float need=(ATT_SKIP+2.04f*__builtin_sqrtf(qm*km))/cs;
    const float tf=((float)(q0-63)-need)*(1.f/64.f); int tt=tf>0.f?(int)tf:0; tt&=~1; if(tt>NTf-4)tt=NTf-4; t0=__builtin_amdgcn_readfirstlane(tt); }
  const bf16*Qw=Q+(rowbase+q0+wid*QBLK)*DM+hm*D;
  const bf16*Kh=K+(rowbase+64*t0)*DM+hm*D,*Vh=V+(rowbase+64*t0)*DM+(hm>>1)*128+half*64;
  const unsigned lds0=(unsigned)(uintptr_t)shm;
  float*wsf=(float*)(shm+LDS_WS)+wid*64;
  const bf16*ksrc=Kh+(long)lane*DM+wid*8;
  const bf16*vsrc=Vh+(long)(16*(wid&3)+(lane>>2))*DM+(wid>>2)*32+(lane&3)*8;
  const unsigned kdst=lds0+LDS_K+wid*1024, vdst=lds0+LDS_V+wid*1024;
  #define DMA_K(t,slot) glds16(ksrc+(long)(t)*KVBLK*DM,(unsigned)__builtin_amdgcn_readfirstlane(kdst+(slot)))
  #define DMA_V(t,slot) glds16(vsrc+(long)(t)*KVBLK*DM,(unsigned)__builtin_amdgcn_readfirstlane(vdst+(slot)))
  const int vb0=(int)(lds0+LDS_V)+((lane>>4)&1)*32+(lane&3)*8+(4*hi+((lane&15)>>2))*64;
  const char*Kbase=shm+LDS_K; bf16x8 kf[8];
  const lds_cptr shm3=(lds_cptr)shm; const lds_cptr kp0=shm3+LDS_K+hi*1024+r32*16; const lds_cptr vp0=shm3+LDS_V+((lane>>4)&1)*32+(lane&3)*8+(4*hi+((lane&15)>>2))*64;
  const int NT=NTf-t0;
  DMA_K(0,0);DMA_V(0,0);DMA_K(1,SLOTB);
  bf16x8 qr[4];
  #pragma unroll
  for(int d0=0;d0<4;++d0)qr[d0]=*reinterpret_cast<const bf16x8*>(&Qw[(long)r32*DM+d0*16+hi*8]);
  float mhat=0.f,l_reg=0.f;f32x16 o[2];o[0]=f32x16{};o[1]=f32x16{};
  const int qrel=wid*QBLK+r32;
  float nb=-cs*(float)(q0+qrel-4*hi-64*t0);
  const float cs8=__builtin_bit_cast(float,__builtin_amdgcn_readfirstlane(__builtin_bit_cast(int,8.f*cs)));
  #define CINIT1(C,t,X) do{ C[0]=nb+cs*(float)(64*(t)+(X)); C[1]=C[0]+cs; C[2]=C[1]+cs; C[3]=C[2]+cs; _Pragma("unroll") for(int r=4;r<16;++r) C[r]=C[r-4]+cs8; asm volatile("":"+v"(C)); }while(0)
  #define CINIT(C0,C1,t) do{ CINIT1(C0,t,0); CINIT1(C1,t,32); }while(0)
  #define CMASK(P0,P1,t) do{int jb_=(t)-(NT-4); if(jb_>=0)cmask(P0,P1,jb_,qrel,hi);}while(0)
  bool resc=false;
  #define START(P0,P1) do{ const float rm=rowmax(P0,P1); resc=false; \
    { const float dl=rm; mhat=fadd_s(mhat,dl); nb=fsub_s(nb,dl); \
      _Pragma("unroll") for(int r=0;r<16;++r){P0[r]=fsub_s(P0[r],dl);P1[r]=fsub_s(P1[r],dl);} } \
    _Pragma("unroll") for(int r=0;r<16;++r)P0[r]=__builtin_amdgcn_exp2f(P0[r]); }while(0)
  #define RESC() do{ if(resc){ asm volatile("s_waitcnt lgkmcnt(0)":::"memory"); \
      _Pragma("unroll") for(int d_=0;d_<2;++d_) _Pragma("unroll") for(int r=0;r<16;++r)o[d_][r]*=wsf[crow(r,hi)]; } }while(0)
  f32x16 pA0,pA1,pB0,pB1;
  int sl_prev=0,sl_cur=0,sl_next=SLOTB;
  #define ROT() do{sl_prev=sl_cur;sl_cur=sl_next;sl_next=(sl_next==(NSLOT-1)*SLOTB)?0:sl_next+SLOTB;}while(0)
  DMA_K(2,2*SLOTB);
  WAIT_BAR(3);
  { f32x16 i0_,i1_; CINIT(i0_,i1_,0); qkt(pA0,pA1,Kbase,qr,i0_,i1_,r32,hi); } asm volatile("s_nop 15\n\ts_nop 7":"+v"(pA0),"+v"(pA1));CMASK(pA0,pA1,0);
  START(pA0,pA1);
  _Pragma("unroll") for(int r=0;r<16;++r)pA1[r]=__builtin_amdgcn_exp2f(pA1[r]);
  WAIT_BAR(0);
  DMA_K(3,0);DMA_V(1,SLOTB);
  ROT();
  kload8(kf,kp0+sl_cur);
  WAIT_BAR(2);
  s16x4 vlo[8],vhi[8]; u32x4 pw0,pw1,pw2,pw3;
  #define PKW(P,B) cvtpk_s(P[B],P[B+1])
  #define PAF(k) __builtin_bit_cast(bf16x8,pw##k)
  #define VFR(i) (bf16x8){vlo[i][0],vlo[i][1],vlo[i][2],vlo[i][3],vhi[i][0],vhi[i][1],vhi[i][2],vhi[i][3]}
  #define PIN(x) asm volatile("":"+v"(x))
  #define MX3(a,b,c) __builtin_fmaxf(__builtin_fmaxf((a),(b)),(c))
  #define GAPA(MF,A0,A1,A2,A3,W0,W1,PW) do{ MF; sacc+=A0; sacc+=A1; sacc+=A2; sacc+=A3; PIN(sacc); W0; W1; PIN(PW); SBAR(); }while(0)
  #define EX(v) __builtin_amdgcn_exp2f(v)
  #define GAPB(MF,X,B) do{ MF; X[B]=EX(X[B]); X[B+1]=EX(X[B+1]); X[B+2]=EX(X[B+2]); X[B+3]=EX(X[B+3]); PIN(X); SBAR(); }while(0)
  #define VRD(i) do{ vlo[i]=vtr(vp_+(((i)>>2)*4096+((i)&3)*1024)); vhi[i]=vtr(vp_+(((i)>>2)*4096+((i)&3)*1024+512)); }while(0)
  #define KRD(G,j) do{ if(G){ kload2(kf,kp0+sl_next,j); SBAR(); } }while(0)
  #define STEP(C0,C1,P0,P1,t,GK,GV,GL) do{ SBAR(); \
    const lds_cptr vp_=vp0+sl_prev; \
    VRD(0); SBAR(); float sacc=(P0[0]+P0[1]); CINIT1(C0,t,0); SBAR(); \
    GAPA(C0=__builtin_amdgcn_mfma_f32_32x32x16_bf16(kf[0],qr[0],C0,0,0,0), P0[2],P0[3],P0[4],P0[5],     pw0[0]=PKW(P0,0), pw0[1]=PKW(P0,2), pw0); \
    VRD(4); SBAR(); CINIT1(C1,t,32); SBAR(); GAPA(C1=__builtin_amdgcn_mfma_f32_32x32x16_bf16(kf[1],qr[0],C1,0,0,0), P0[6],P0[7],P0[8],P0[9],     pw0[2]=PKW(P0,4), pw0[3]=PKW(P0,6), pw0); \
    VRD(1); SBAR(); GAPA(C0=__builtin_amdgcn_mfma_f32_32x32x16_bf16(kf[2],qr[1],C0,0,0,0),   P0[10],P0[11],P0[12],P0[13], pw1[0]=PKW(P0,8), pw1[1]=PKW(P0,10), pw1); \
    VRD(5); SBAR(); GAPA(C1=__builtin_amdgcn_mfma_f32_32x32x16_bf16(kf[3],qr[1],C1,0,0,0),   P0[14],P0[15],P1[0],P1[1],   pw1[2]=PKW(P0,12),pw1[3]=PKW(P0,14), pw1); \
    VRD(2); SBAR(); GAPA(C0=__builtin_amdgcn_mfma_f32_32x32x16_bf16(kf[4],qr[2],C0,0,0,0),   P1[2],P1[3],P1[4],P1[5],     pw2[0]=PKW(P1,0), pw2[1]=PKW(P1,2), pw2); \
    VRD(6); SBAR(); GAPA(C1=__builtin_amdgcn_mfma_f32_32x32x16_bf16(kf[5],qr[2],C1,0,0,0),   P1[6],P1[7],P1[8],P1[9],     pw2[2]=PKW(P1,4), pw2[3]=PKW(P1,6), pw2); \
    VRD(3); SBAR(); GAPA(C0=__builtin_amdgcn_mfma_f32_32x32x16_bf16(kf[6],qr[3],C0,0,0,0),   P1[10],P1[11],P1[12],P1[13], pw3[0]=PKW(P1,8), pw3[1]=PKW(P1,10), pw3); \
    VRD(7); SBAR(); GAPA(C1=__builtin_amdgcn_mfma_f32_32x32x16_bf16(kf[7],qr[3],C1,0,0,0),   P1[14],P1[15],0.f,0.f,       pw3[2]=PKW(P1,12),pw3[3]=PKW(P1,14), pw3); \
    l_reg+=sacc; \
    if(GK){DMA_K((t)+3,sl_cur);} if(GV){DMA_V((t)+1,sl_next);} \
    CMASK(C0,C1,t); \
    { float a=MX3(C0[0],C0[1],C1[0]),b=MX3(C0[2],C0[3],C1[1]); a=MX3(a,C1[2],C1[3]); \
      _Pragma("unroll") for(int r=4;r<16;r+=4){a=MX3(a,C0[r],C0[r+1]);b=MX3(b,C0[r+2],C0[r+3]);a=MX3(a,C1[r],C1[r+1]);b=MX3(b,C1[r+2],C1[r+3]);} \
      float rm=__builtin_fmaxf(a,b); { auto rr=__builtin_amdgcn_permlane32_swap(__float_as_uint(rm),__float_as_uint(rm),false,false); rm=__builtin_fmaxf(__uint_as_float(rr[0]),__uint_as_float(rr[1])); } \
      resc=false; \
      if(__builtin_expect(__any(rm>(float)THRL),0)){ const float dl=__builtin_fmaxf(rm,0.f); mhat+=dl; nb-=dl; \
        _Pragma("unroll") for(int r=0;r<16;++r){C0[r]-=dl;C1[r]-=dl;} \
        const float f=__builtin_amdgcn_exp2f(-dl); l_reg*=f; if(hi==0)wsf[r32]=f; resc=true; } } \
    SBAR(); \
    GAPB(o[0]=__builtin_amdgcn_mfma_f32_32x32x16_bf16(PAF(0),VFR(0),o[0],0,0,0), C0,0); \
    GAPB(o[1]=__builtin_amdgcn_mfma_f32_32x32x16_bf16(PAF(0),VFR(4),o[1],0,0,0), C0,4); \
    KRD(GL,0); GAPB(o[0]=__builtin_amdgcn_mfma_f32_32x32x16_bf16(PAF(1),VFR(1),o[0],0,0,0), C0,8); \
    KRD(GL,1); GAPB(o[1]=__builtin_amdgcn_mfma_f32_32x32x16_bf16(PAF(1),VFR(5),o[1],0,0,0), C0,12); \
    KRD(GL,2); GAPB(o[0]=__builtin_amdgcn_mfma_f32_32x32x16_bf16(PAF(2),VFR(2),o[0],0,0,0), C1,0); \
    KRD(GL,3); GAPB(o[1]=__builtin_amdgcn_mfma_f32_32x32x16_bf16(PAF(2),VFR(6),o[1],0,0,0), C1,4); \
    GAPB(o[0]=__builtin_amdgcn_mfma_f32_32x32x16_bf16(PAF(3),VFR(3),o[0],0,0,0), C1,8); \
    GAPB(o[1]=__builtin_amdgcn_mfma_f32_32x32x16_bf16(PAF(3),VFR(7),o[1],0,0,0), C1,12); \
    }while(0)
  int t=1;
  #undef CMASK
  #define CMASK(P0,P1,t) do{}while(0)
  for(;t+5<NT;t+=2){
    STEP(pB0,pB1,pA0,pA1,t,true,true,true);     WAIT_BAR(2); RESC(); ROT();
    STEP(pA0,pA1,pB0,pB1,t+1,true,true,true);   WAIT_BAR(2); RESC(); ROT();
  }
  #undef CMASK
  #define CMASK(P0,P1,t) do{int jb_=(t)-(NT-4); if(jb_>=0)cmask(P0,P1,jb_,qrel,hi);}while(0)
  #define ENDW(tt) do{ if((tt)+3<NT){WAIT_BAR(2);} else if((tt)+2<NT){WAIT_BAR(1);} else {WAIT_BAR(0);} }while(0)
  for(;t+1<NT;t+=2){
    STEP(pB0,pB1,pA0,pA1,t,(t+3<NT),(t+1<NT),(t+1<NT));       ENDW(t);   RESC(); ROT();
    STEP(pA0,pA1,pB0,pB1,t+1,(t+4<NT),(t+2<NT),(t+2<NT));     ENDW(t+1); RESC(); ROT();
  }
  STEP(pB0,pB1,pA0,pA1,NT-1,false,false,false); RESC();
  { float sacc=pB0[0]+pB0[1]; _Pragma("unroll") for(int r=2;r<16;++r)sacc+=pB0[r]; _Pragma("unroll") for(int r=0;r<16;++r)sacc+=pB1[r]; l_reg+=sacc;
    pw0=(u32x4){PKW(pB0,0),PKW(pB0,2),PKW(pB0,4),PKW(pB0,6)};pw1=(u32x4){PKW(pB0,8),PKW(pB0,10),PKW(pB0,12),PKW(pB0,14)};pw2=(u32x4){PKW(pB1,0),PKW(pB1,2),PKW(pB1,4),PKW(pB1,6)};pw3=(u32x4){PKW(pB1,8),PKW(pB1,10),PKW(pB1,12),PKW(pB1,14)};
    SBAR(); pv(o,vb0+sl_cur,PAF(0),PAF(1),PAF(2),PAF(3)); }
  #undef PKW
  #undef PAF
  #undef VFR
  #undef PIN
  #undef MX3
  #undef GAPA
  #undef GAPB
  #undef EX
  #undef VRD
  #undef KRD
  #undef STEP
  #undef ENDW
  {auto rr=__builtin_amdgcn_permlane32_swap(__float_as_uint(l_reg),__float_as_uint(l_reg),false,false);l_reg=__uint_as_float(rr[0])+__uint_as_float(rr[1]);}
  if(hi==0)wsf[32+r32]=l_reg;asm volatile("s_waitcnt lgkmcnt(0)":::"memory");
  float rli[16];
  #pragma unroll
  for(int r=0;r<16;++r)rli[r]=__builtin_amdgcn_rcpf(wsf[32+crow(r,hi)]);
  bf16*Ow=O+(rowbase+q0+wid*QBLK)*DMO+(hm>>1)*256+(hm&1)*128+half*64;
  { bf16*stg=(bf16*)(shm+LDS_OST)+wid*2048;
    int eoff=hi*256+r32; asm volatile("":"+v"(eoff));
    #pragma unroll
    for(int r=0;r<16;++r){const int orow=(r&3)+8*(r>>2);
      #pragma unroll
      for(int d0=0;d0<2;++d0)stg[eoff+orow*64+d0*32]=__float2bfloat16(o[d0][r]*rli[r]);}
    asm volatile("s_waitcnt lgkmcnt(0)":::"memory");
    #pragma unroll
    for(int i=0;i<4;++i){const int row=i*8+(lane>>3),ch=lane&7; const u32x4 v=*(const u32x4*)(stg+row*64+ch*8); ATTN_STORE16(Ow+(long)row*DMO+ch*8,v);} }
  asm volatile("s_waitcnt lgkmcnt(0)\n\ts_barrier":::"memory");
  #undef DMA_K
  #undef DMA_V
  #undef CMASK
  #undef START
  #undef RESC
  #undef ROT
  #undef CINIT
  #undef CINIT1
}
constexpr int ATTN_LDS_BYTES=LDS_BYTES;
struct AttnTensors { const bf16* Q; const bf16* K; const bf16* V; bf16* O; const float* PN; unsigned* queue; };
__device__ __forceinline__ void unit_of(int u,int&b,int&vh,int&qb){ if(u<2048){qb=15-(u>>7);const int r=u&127;b=r>>3;vh=8+(r&7);} else if(u<3072){const int v=u-2048;qb=15-(v>>6);const int r=v&63;b=r>>2;vh=4+(r&3);} else {const int v=u-3072;qb=15-(v>>6);const int r=v&63;b=r>>2;vh=r&3;} }
template<int THRL=8> __device__ __forceinline__ void attn_phase(char*lds,const AttnTensors&T,const int wid){
  volatile __attribute__((address_space(3))) int* slot=(volatile __attribute__((address_space(3))) int*)(lds+LDS_BYTES);
  const bool lead=(wid==0)&&(lane_id()==0);
  if(lead) *slot=(int)__hip_atomic_fetch_add(T.queue,1u,__ATOMIC_RELAXED,__HIP_MEMORY_SCOPE_AGENT);
  asm volatile("s_waitcnt vmcnt(0) lgkmcnt(0)\n\ts_barrier":::"memory");
  int cur=__builtin_amdgcn_readfirstlane(*slot);
  asm volatile("s_waitcnt lgkmcnt(0)\n\ts_barrier":::"memory");
  while(cur<BATCH*16*NQB){
    int nxt=0; if(lead) nxt=(int)__hip_atomic_fetch_add(T.queue,1u,__ATOMIC_RELAXED,__HIP_MEMORY_SCOPE_AGENT);
    int b,vh,qb; unit_of(cur,b,vh,qb); const int hm=vh>>1,half=vh&1;
    const float cs=__builtin_bit_cast(float,__builtin_amdgcn_readfirstlane(__builtin_bit_cast(int,__builtin_amdgcn_exp2f(-2.f*(float)((hm>>1)+1))*1.4426950408889634f)));
    attn_unit<THRL>(b,hm,half,qb,cs,wid,T.PN,T.Q,T.K,T.V,T.O,lds);
    if(lead) *slot=nxt;
    asm volatile("s_waitcnt vmcnt(0) lgkmcnt(0)\n\ts_barrier":::"memory");
    cur=__builtin_amdgcn_readfirstlane(*slot);
    asm volatile("s_waitcnt lgkmcnt(0)\n\ts_barrier":::"memory");
  }
}
#undef SBAR
#undef WAIT_BAR
}
constexpr int NWAVES = 8;
constexpr int RING_OFF = 0, RING_BYTES = 131072;
constexpr int LDSCTL_OFF = RING_BYTES, MISC_OFF = LDSCTL_OFF + 320;
constexpr int LDS_BYTES = 163840;

#define XB_TMO      128
#define XB_XCNT(j)  (256  + 64 * (j))
#define XB_XSUB(j)  (1280 + 64 * (j))
#define XB_XGEN(j)  (2304 + 64 * (j))
#define XB_TOP      3328
#define XB_TOPGEN   3392
#define XCD_BAR_WORDS 3456
#define XB_SPIN_CAP (1u << 18)
__device__ __forceinline__ unsigned xb_ld(unsigned* p)              { return __hip_atomic_load(p, __ATOMIC_RELAXED, __HIP_MEMORY_SCOPE_AGENT); }
__device__ __forceinline__ unsigned xb_add(unsigned* p, unsigned v) { return __hip_atomic_fetch_add(p, v, __ATOMIC_RELAXED, __HIP_MEMORY_SCOPE_AGENT); }
__device__ __forceinline__ unsigned xb_xcc_id() { return (unsigned)__builtin_amdgcn_s_getreg((3 << 11) | 20) & 0xFu; }
#define XB_SPIN(cond, bar) do { unsigned _sp = 0; while (cond) { __builtin_amdgcn_s_sleep(1); \
    if ((++_sp & 255u) == 0u) { if (xb_ld(&(bar)[XB_TMO])) break; if (_sp > XB_SPIN_CAP) { atomicAdd(&(bar)[XB_TMO], 1u); break; } } } } while (0)
struct XcdBarrier { unsigned* bar; unsigned x; volatile LAS unsigned* st; bool wave0; };
__device__ __forceinline__ XcdBarrier xcd_barrier_post(unsigned* bar, volatile LAS unsigned* st) {
    XcdBarrier b; b.bar = bar; b.x = xb_xcc_id(); b.st = st; b.wave0 = __builtin_amdgcn_readfirstlane(threadIdx.x >> 6) == 0;
    if (threadIdx.x == 0) (void)xb_add(&bar[XB_XCNT(b.x)], 1u);
    return b;
}
__device__ __forceinline__ void xcd_barrier_complete(unsigned* bar, unsigned x, unsigned& nloc, unsigned& nx) {
    const unsigned G = gridDim.x * gridDim.y * gridDim.z;
    unsigned sum, cnt, mine, sp = 0u;
    for (;;) {
        sum = 0u; cnt = 0u; mine = 0u;
#pragma unroll
        for (unsigned j = 0; j < 16; ++j) { const unsigned c = xb_ld(&bar[XB_XCNT(j)]); sum += c; cnt += (c > 0u) ? 1u : 0u; mine = (j == x) ? c : mine; }
        if (sum == G) break;
        __builtin_amdgcn_s_sleep(1);
        if ((++sp & 255u) == 0u) { if (xb_ld(&bar[XB_TMO])) break; if (sp > XB_SPIN_CAP) { atomicAdd(&bar[XB_TMO], 1u); break; } }
    }
    nloc = mine > 0u ? mine : 1u; nx = cnt > 0u ? cnt : 1u;
}
__device__ __forceinline__ void xcd_barrier(const XcdBarrier& b) {
    asm volatile("s_waitcnt vmcnt(0)" ::: "memory");
    __syncthreads();
    if (b.wave0 && lane_id() == 0) {
        unsigned* bar = b.bar;
        __builtin_amdgcn_s_waitcnt(0);
        unsigned nloc = b.st[0], nx = b.st[1];
        if (nloc == 0u) { xcd_barrier_complete(bar, b.x, nloc, nx); b.st[0] = nloc; b.st[1] = nx; }
        const unsigned old = xb_add(&bar[XB_XSUB(b.x)], 1u);
        const unsigned gen = old / nloc;
        if (old + 1u == (gen + 1u) * nloc) {
            __builtin_amdgcn_fence(__ATOMIC_RELEASE, "agent");
            asm volatile("s_waitcnt vmcnt(0)" ::: "memory");
            const unsigned og = xb_add(&bar[XB_TOP], 1u);
            const unsigned tg = og / nx;
            if (og + 1u == (tg + 1u) * nx) xb_add(&bar[XB_TOPGEN], 1u);
            else XB_SPIN(xb_ld(&bar[XB_TOPGEN]) == tg, bar);
            __builtin_amdgcn_fence(__ATOMIC_ACQUIRE, "agent");
            xb_add(&bar[XB_XGEN(b.x)], 1u);
            asm volatile("s_waitcnt vmcnt(0)" ::: "memory");
        } else {
            XB_SPIN(xb_ld(&bar[XB_XGEN(b.x)]) == gen, bar);
            __builtin_amdgcn_fence(__ATOMIC_ACQUIRE, "agent");
            asm volatile("s_waitcnt vmcnt(0)" ::: "memory");
        }
    }
    __syncthreads();
}

struct Frame {
    LAS unsigned char* lds; volatile LAS unsigned* MISC; gu32* ctl;
    int tid, lane, wave, vcu, G;
};
__device__ __forceinline__ float bf2f_(unsigned short b) { return __builtin_bit_cast(float, (unsigned)b << 16); }
__device__ __forceinline__ float wave_sum(float v) {
#pragma unroll
    for (int o = 1; o < 64; o <<= 1) v += __shfl_xor(v, o);
    return v;
}
__device__ __forceinline__ void p0_transpose_item(const float* W, int ldw, int K, bf16* WT, int k0, int n0, int drow0, LAS float* scr, int lane) {
#pragma unroll 8
    for (int i = 0; i < 32; ++i) { const int kk = 2 * i + (lane >> 5); scr[kk * 33 + (lane & 31)] = W[(size_t)(k0 + kk) * ldw + n0 + (lane & 31)]; }
    LDS_WAIT(); asm volatile("" ::: "memory");
    const int c = lane & 7;
#pragma unroll
    for (int j = 0; j < 4; ++j) { const int n = (lane >> 3) + 8 * j; const LAS float* s = scr + (8 * c) * 33 + n;
        v4u o; o.x = pk2(s[0 * 33], s[1 * 33]); o.y = pk2(s[2 * 33], s[3 * 33]); o.z = pk2(s[4 * 33], s[5 * 33]); o.w = pk2(s[6 * 33], s[7 * 33]);
        *(GAS v4u*)(WT + (size_t)(drow0 + n) * K + k0 + 8 * c) = o; }
    LDS_WAIT(); asm volatile("" ::: "memory");
}
__device__ __forceinline__ void p0_transpose_item_f8(const float* W, int ldw, int K, unsigned char* WT, int k0, int n0, int drow0, float scale, LAS float* scr, int lane) {
#pragma unroll 8
    for (int i = 0; i < 32; ++i) { const int kk = 2 * i + (lane >> 5); scr[kk * 33 + (lane & 31)] = W[(size_t)(k0 + kk) * ldw + n0 + (lane & 31)] * scale; }
    LDS_WAIT(); asm volatile("" ::: "memory");
    const int c = lane & 3;
#pragma unroll
    for (int j = 0; j < 2; ++j) { const int n = (lane >> 2) + 16 * j; const LAS float* s = scr + (16 * c) * 33 + n;
        v4u o; o.x = pg8::pk4_fp8(s[0 * 33], s[1 * 33], s[2 * 33], s[3 * 33]); o.y = pg8::pk4_fp8(s[4 * 33], s[5 * 33], s[6 * 33], s[7 * 33]);
        o.z = pg8::pk4_fp8(s[8 * 33], s[9 * 33], s[10 * 33], s[11 * 33]); o.w = pg8::pk4_fp8(s[12 * 33], s[13 * 33], s[14 * 33], s[15 * 33]);
        *(GAS v4u*)(WT + (size_t)(drow0 + n) * K + k0 + 16 * c) = o; }
    LDS_WAIT(); asm volatile("" ::: "memory");
}
struct Ptrs {
    const float *x, *p, *w_in, *b_gate, *lq1, *lk1, *lq2, *lk2, *subln, *w_abr, *w_pmix, *pscale, *w_pbr, *w_out, *ln1g, *ln1b, *w_router, *b_router, *w_up, *b_up, *w_down, *b_down, *w_pg, *w_pp, *ln2g, *ln2b;
    float* out; unsigned char* ws;
};
__device__ __forceinline__ void ph0_prologue(Frame& F, const Ptrs& P) {
    unsigned char* ws = P.ws;
    LAS float* scr = (LAS float*)(F.lds + RING_OFF + F.wave * 16384);
    const int gw = F.vcu * NWAVES + F.wave, NGW = F.G * NWAVES;
    { const size_t n4 = (size_t)M * D / 4, st = (size_t)F.G * 512; const f32x4* src = (const f32x4*)P.x; unsigned long long* dst = (unsigned long long*)(ws + WS_XB);
      for (size_t i = (size_t)blockIdx.x * 512 + F.tid; i < n4; i += st) { const f32x4 v = src[i]; dst[i] = (unsigned long long)pk2(v.x, v.y) | ((unsigned long long)pk2(v.z, v.w) << 32); } }
    constexpr int I_IN = 16 * 128, I_A = 8 * 32, I_O = 16 * 32, I_PG = 16 * 32, I_PP = 4 * 32, I_UP1 = 16 * 64, I_DN1 = 16 * 32;
    constexpr int I_UP = NEXP * I_UP1, I_DN = NEXP * I_DN1, NITEMS = I_IN + I_A + I_O + I_PG + I_PP + I_UP + I_DN;
    for (int it = gw; it < NITEMS; it += NGW) {
        int r = it;
        if (r < I_IN) { const int nb = 128; p0_transpose_item(P.w_in, 4096, 1024, (bf16*)(ws + WS_WIN), 64 * (r / nb), 32 * (r % nb), 32 * (r % nb), scr, F.lane); continue; } r -= I_IN;
        if (r < I_A) { const int nb = 32; p0_transpose_item(P.w_abr, 1024, 1024, (bf16*)(ws + WS_WCAT), 64 * (r / nb), 32 * (r % nb), 32 * (r % nb), scr, F.lane); continue; } r -= I_A;
        if (r < I_O) { const int nb = 32; p0_transpose_item(P.w_out, 1024, 1024, (bf16*)(ws + WS_WOUT), 64 * (r / nb), 32 * (r % nb), 32 * (r % nb), scr, F.lane); continue; } r -= I_O;
        if (r < I_PG) { const int nb = 32; if (MOE_FP8) p0_transpose_item_f8(P.w_pg, 1024, 1024, ws + WS_WPG, 64 * (r / nb), 32 * (r % nb), 32 * (r % nb), WUP_SCALE, scr, F.lane);
            else p0_transpose_item(P.w_pg, 1024, 1024, (bf16*)(ws + WS_WPG), 64 * (r / nb), 32 * (r % nb), 32 * (r % nb), scr, F.lane); continue; } r -= I_PG;
        if (r < I_PP) { const int nb = 32; p0_transpose_item(P.w_pp, 1024, 256, (bf16*)(ws + WS_WPP), 64 * (r / nb), 32 * (r % nb), 32 * (r % nb), scr, F.lane); continue; } r -= I_PP;
        if (r < I_UP) { const int e = r / I_UP1, q = r % I_UP1, nb = 64, n0 = 32 * (q % nb);
            const int bj = n0 >> 10, pn = (n0 & 1023) >> 7, cp = n0 & 127;
            if (MOE_FP8) p0_transpose_item_f8(P.w_up + (size_t)e * 1024 * 2048, 2048, 1024, ws + WS_WUP + (size_t)e * 2048 * 1024, 64 * (q / nb), n0, 256 * pn + 128 * bj + cp, WUP_SCALE, scr, F.lane);
            else p0_transpose_item(P.w_up + (size_t)e * 1024 * 2048, 2048, 1024, (bf16*)(ws + WS_WUP) + (size_t)e * 2048 * 1024, 64 * (q / nb), n0, 256 * pn + 128 * bj + cp, scr, F.lane);
            continue; } r -= I_UP;
        { const int e = r / I_DN1, q = r % I_DN1, nb = 32;
            if (MOE_FP8) p0_transpose_item_f8(P.w_down + (size_t)e * 1024 * 1024, 1024, 1024, ws + WS_WDN + (size_t)e * 1024 * 1024, 64 * (q / nb), 32 * (q % nb), 32 * (q % nb), WDN_SCALE, scr, F.lane);
            else p0_transpose_item(P.w_down + (size_t)e * 1024 * 1024, 1024, 1024, (bf16*)(ws + WS_WDN) + (size_t)e * 1024 * 1024, 64 * (q / nb), 32 * (q % nb), 32 * (q % nb), scr, F.lane); }
    }
    { bf16* WPC = (bf16*)(ws + WS_WCAT) + 512;
      for (int k = blockIdx.x; k < 512; k += F.G) { const int g = k >> 7;
          float a0 = 0.f, a1 = 0.f; const float* wm = P.w_pmix + (size_t)k * 128; const float* sc = P.pscale + g * 128; const float* wb = P.w_pbr + (size_t)(g * 128) * 1024;
          for (int d = 0; d < 128; ++d) { const float w = wm[d] * sc[d]; a0 += w * wb[(size_t)d * 1024 + F.tid]; a1 += w * wb[(size_t)d * 1024 + 512 + F.tid]; }
          WPC[(size_t)F.tid * 1024 + k] = (bf16)f2bf(a0); WPC[(size_t)(F.tid + 512) * 1024 + k] = (bf16)f2bf(a1); } }
}
__device__ __forceinline__ void ph_pool(Frame& F, const Ptrs& P) {
    const bf16* U = (const bf16*)(P.ws + WS_U); bf16* PO = (bf16*)(P.ws + WS_APO) + 512;
    const size_t nitem = (size_t)M * 64, st = (size_t)F.G * 512;
    for (size_t idx = (size_t)blockIdx.x * 512 + F.tid; idx < nitem; idx += st) {
        const size_t row = idx >> 6; const int cg = (int)(idx & 63), c0 = cg * 8, pos = (int)(row & (SEQ - 1)), w = 2 << (c0 >> 7), n = pos + 1 < w ? pos + 1 : w;
        float s[8] = {0.f, 0.f, 0.f, 0.f, 0.f, 0.f, 0.f, 0.f}; v4u cur = *(const v4u*)(U + row * 512 + c0);
        for (int k = 0; k < n; ++k) { const v4u v = k == 0 ? cur : *(const v4u*)(U + (row - k) * 512 + c0);
            s[0] += pg8::bflo(v.x); s[1] += pg8::bfhi(v.x); s[2] += pg8::bflo(v.y); s[3] += pg8::bfhi(v.y); s[4] += pg8::bflo(v.z); s[5] += pg8::bfhi(v.z); s[6] += pg8::bflo(v.w); s[7] += pg8::bfhi(v.w); }
        const float rn = 1.f / (float)n; v4u o;
        o.x = pk2(s[0] * rn - pg8::bflo(cur.x), s[1] * rn - pg8::bfhi(cur.x)); o.y = pk2(s[2] * rn - pg8::bflo(cur.y), s[3] * rn - pg8::bfhi(cur.y));
        o.z = pk2(s[4] * rn - pg8::bflo(cur.z), s[5] * rn - pg8::bfhi(cur.z)); o.w = pk2(s[6] * rn - pg8::bflo(cur.w), s[7] * rn - pg8::bfhi(cur.w));
        *(v4u*)(PO + row * 1024 + c0) = o;
    }
}
__device__ __forceinline__ float lam_value(const Ptrs& P) { float a = 0.f, b = 0.f; for (int d = 0; d < 64; ++d) { a += P.lq1[d] * P.lk1[d]; b += P.lq2[d] * P.lk2[d]; } return __expf(a) - __expf(b) + 0.2f; }
__device__ __forceinline__ void ph_combine(Frame& F, const Ptrs& P) {
    const bf16* O16 = (const bf16*)(P.ws + WS_O16); bf16* OA = (bf16*)(P.ws + WS_APO); const float lam = lam_value(P);
    const int gw = F.vcu * NWAVES + F.wave, NGW = F.G * NWAVES, h = F.lane >> 4, e0 = (F.lane & 15) * 8;
    float sg[8];
#pragma unroll
    for (int j = 0; j < 8; ++j) sg[j] = P.subln[e0 + j] * 0.8f;
    for (int row = gw; row < M; row += NGW) {
        const v4u a = *(const v4u*)(O16 + (size_t)row * 1024 + h * 256 + e0), b = *(const v4u*)(O16 + (size_t)row * 1024 + h * 256 + 128 + e0);
        f32x4 a0, a1, b0, b1; pg8::unpack8(a, a0, a1); pg8::unpack8(b, b0, b1); a0 -= b0 * lam; a1 -= b1 * lam;
        float ss = (a0[0] * a0[0] + a0[1] * a0[1]) + (a0[2] * a0[2] + a0[3] * a0[3]) + (a1[0] * a1[0] + a1[1] * a1[1]) + (a1[2] * a1[2] + a1[3] * a1[3]);
        ss += __shfl_xor(ss, 1); ss += __shfl_xor(ss, 2); ss += __shfl_xor(ss, 4); ss += __shfl_xor(ss, 8);
        const float r = rsqrtf(ss * (1.f / 128.f) + LN_EPS);
#pragma unroll
        for (int j = 0; j < 4; ++j) { a0[j] *= r * sg[j]; a1[j] *= r * sg[4 + j]; }
        *(v4u*)(OA + (size_t)row * 1024 + h * 128 + e0) = pg8::pack8(a0, a1);
    }
}
__device__ __forceinline__ void ph6_ln1_route(Frame& F, const Ptrs& P) {
    unsigned char* ws = P.ws;
    const unsigned keep0 = F.MISC[8], keep1 = F.MISC[9];
    __syncthreads();
    { LAS f32x4* img = (LAS f32x4*)F.lds; const f32x4* src = (const f32x4*)P.w_router;
      for (int i = F.tid; i < 1024 * 8; i += 512) { const int k = i >> 3, q = i & 7; img[(k ^ ((k >> 3) & 1)) * 8 + q] = src[i]; } }
    { const size_t n4 = (size_t)M * PLE / 4, st = (size_t)F.G * 512; const f32x4* src = (const f32x4*)P.p; unsigned long long* dst = (unsigned long long*)(ws + WS_PB);
      for (size_t i = (size_t)blockIdx.x * 512 + F.tid; i < n4; i += st) { const f32x4 v = src[i]; dst[i] = (unsigned long long)pk2(v.x, v.y) | ((unsigned long long)pk2(v.z, v.w) << 32); } }
    __syncthreads();
    float* X1 = P.out; bf16* X1B = (bf16*)(ws + WS_X1B);
    const int lane = F.lane, eg = lane & 7, ko = lane >> 3;
    LAS float* xrow = (LAS float*)(F.lds + 131072 + 4096 * F.wave);
    f32x4 gam[4], bet[4];
#pragma unroll
    for (int j = 0; j < 4; ++j) { gam[j] = ((const f32x4*)P.ln1g)[lane + 64 * j]; bet[j] = ((const f32x4*)P.ln1b)[lane + 64 * j]; }
    const f32x4 brt = ((const f32x4*)P.b_router)[eg];
    int my_e[4] = {0, 0, 0, 0}; float my_g[4] = {0.f, 0.f, 0.f, 0.f};
    for (int chunk = blockIdx.x; chunk < M / 256; chunk += F.G) {
        for (int i = 0; i < 32; ++i) {
            const int row = chunk * 256 + F.wave * 32 + i;
            f32x4 v[4]; float s = 0.f;
#pragma unroll
            for (int j = 0; j < 4; ++j) { v[j] = ((const f32x4*)(X1 + (size_t)row * 1024))[lane + 64 * j]; s += (v[j].x + v[j].y) + (v[j].z + v[j].w); }
            const float mean = wave_sum(s) * (1.f / 1024.f); float s2 = 0.f;
#pragma unroll
            for (int j = 0; j < 4; ++j) { v[j] = v[j] - mean; s2 += (v[j].x * v[j].x + v[j].y * v[j].y) + (v[j].z * v[j].z + v[j].w * v[j].w); }
            const float rstd = rsqrtf(wave_sum(s2) * (1.f / 1024.f) + LN_EPS);
#pragma unroll
            for (int j = 0; j < 4; ++j) { v[j] = v[j] * rstd * gam[j] + bet[j];
                ((f32x4*)(X1 + (size_t)row * 1024))[lane + 64 * j] = v[j];
                ((unsigned long long*)(X1B + (size_t)row * 1024))[lane + 64 * j] = (unsigned long long)pk2(v[j].x, v[j].y) | ((unsigned long long)pk2(v[j].z, v[j].w) << 32);
                if (MOE_FP8) ((unsigned*)(ws + WS_X1F8 + (size_t)row * 1024))[lane + 64 * j] = pg8::pk4_fp8(v[j].x, v[j].y, v[j].z, v[j].w);
                ((LAS f32x4*)xrow)[lane + 64 * j] = v[j]; }
            LDS_WAIT(); asm volatile("" ::: "memory");
            f32x4 acc = {0.f, 0.f, 0.f, 0.f};
#pragma unroll 4
            for (int sidx = 0; sidx < 32; ++sidx) { const f32x4 xv = ((const LAS f32x4*)xrow)[sidx * 8 + ko];
#pragma unroll
                for (int q = 0; q < 4; ++q) { const int k = 32 * sidx + 4 * ko + q; const f32x4 w = ((const LAS f32x4*)F.lds)[(k ^ ((k >> 3) & 1)) * 8 + eg]; acc += w * xv[q]; } }
#pragma unroll
            for (int q = 0; q < 4; ++q) { acc[q] += __shfl_xor(acc[q], 8); acc[q] += __shfl_xor(acc[q], 16); acc[q] += __shfl_xor(acc[q], 32); }
            acc += brt;
            float tv[4]; int ti[4];
#pragma unroll
            for (int r = 0; r < 4; ++r) { float bv = acc[0]; int bi = 4 * eg;
#pragma unroll
                for (int q = 1; q < 4; ++q) if (acc[q] > bv) { bv = acc[q]; bi = 4 * eg + q; }
#pragma unroll
                for (int o = 1; o < 8; o <<= 1) { const float ov = __shfl_xor(bv, o); const int oi = __shfl_xor(bi, o); if (ov > bv || (ov == bv && oi < bi)) { bv = ov; bi = oi; } }
                tv[r] = bv; ti[r] = bi;
#pragma unroll
                for (int q = 0; q < 4; ++q) if (bi == 4 * eg + q) acc[q] = -INFINITY; }
            const float e1 = __expf(tv[1] - tv[0]), e2 = __expf(tv[2] - tv[0]), e3 = __expf(tv[3] - tv[0]), rs = 1.f / (1.f + e1 + e2 + e3);
            if (lane == i) { my_e[0] = ti[0]; my_e[1] = ti[1]; my_e[2] = ti[2]; my_e[3] = ti[3]; my_g[0] = rs; my_g[1] = e1 * rs; my_g[2] = e2 * rs; my_g[3] = e3 * rs; }
        }
        __syncthreads();
        LAS int* cntl = (LAS int*)(F.lds + 131072); LAS int* basel = cntl + 32;
        if (F.tid < 32) cntl[F.tid] = 0;
        __syncthreads();
        int rk[4] = {0, 0, 0, 0};
        if (lane < 32) {
#pragma unroll
            for (int k = 0; k < 4; ++k) rk[k] = __hip_atomic_fetch_add(&cntl[my_e[k]], 1, __ATOMIC_RELAXED, __HIP_MEMORY_SCOPE_WORKGROUP); }
        __syncthreads();
        if (F.tid < 32) basel[F.tid] = (int)__hip_atomic_fetch_add(F.ctl + CW_CNT + F.tid, (unsigned)cntl[F.tid], RLX_AGENT);
        __syncthreads();
        if (lane < 32) { const int row = chunk * 256 + F.wave * 32 + lane; int* LIST = (int*)(ws + WS_LIST); float* GATEL = (float*)(ws + WS_GATEL); float* GATE = (float*)(ws + WS_GATE);
#pragma unroll
            for (int k = 0; k < 4; ++k) { const size_t o = (size_t)my_e[k] * 65536 + (size_t)(basel[my_e[k]] + rk[k]); LIST[o] = row * 4 + k; GATEL[o] = my_g[k]; GATE[row * 4 + k] = my_g[k]; } }
        __syncthreads();
    }
    if (F.tid == 0) { F.MISC[8] = keep0; F.MISC[9] = keep1; }
    __syncthreads();
}
__device__ __forceinline__ void ph10_final(Frame& F, const Ptrs& P) {
    const bf16* YS1 = (const bf16*)(P.ws + WS_YS1); const bf16* YS2 = (const bf16*)(P.ws + WS_YS2); const bf16* YS3 = (const bf16*)(P.ws + WS_YS3);
    const int gw = F.vcu * NWAVES + F.wave, NGW = F.G * NWAVES, lane = F.lane;
    f32x4 gam[4], bet[4];
#pragma unroll
    for (int j = 0; j < 4; ++j) { gam[j] = ((const f32x4*)P.ln2g)[lane + 64 * j]; bet[j] = ((const f32x4*)P.ln2b)[lane + 64 * j]; }
    for (int row = gw; row < M; row += NGW) {
        f32x4 v[4]; float s = 0.f;
#pragma unroll
        for (int j = 0; j < 4; ++j) { const size_t o = (size_t)row * 256 + lane + 64 * j; v[j] = ((const f32x4*)P.out)[o];
            const unsigned long long a = ((const unsigned long long*)YS1)[o], b = ((const unsigned long long*)YS2)[o], c = ((const unsigned long long*)YS3)[o];
            const unsigned a0 = (unsigned)a, a1 = (unsigned)(a >> 32), b0 = (unsigned)b, b1 = (unsigned)(b >> 32), c0 = (unsigned)c, c1 = (unsigned)(c >> 32);
            v[j].x += (pg8::bflo(a0) + pg8::bflo(b0)) + pg8::bflo(c0); v[j].y += (pg8::bfhi(a0) + pg8::bfhi(b0)) + pg8::bfhi(c0);
            v[j].z += (pg8::bflo(a1) + pg8::bflo(b1)) + pg8::bflo(c1); v[j].w += (pg8::bfhi(a1) + pg8::bfhi(b1)) + pg8::bfhi(c1);
            s += (v[j].x + v[j].y) + (v[j].z + v[j].w); }
        const float mean = wave_sum(s) * (1.f / 1024.f); float s2 = 0.f;
#pragma unroll
        for (int j = 0; j < 4; ++j) { v[j] = v[j] - mean; s2 += (v[j].x * v[j].x + v[j].y * v[j].y) + (v[j].z * v[j].z + v[j].w * v[j].w); }
        const float rstd = rsqrtf(wave_sum(s2) * (1.f / 1024.f) + LN_EPS);
#pragma unroll
        for (int j = 0; j < 4; ++j) ((f32x4*)P.out)[(size_t)row * 256 + lane + 64 * j] = v[j] * rstd * gam[j] + bet[j];
    }
}
__device__ __forceinline__ void moe_tables(Frame& F) {
    LAS int* cnt = (LAS int*)(F.lds + pg8::TAB_CNT); LAS int* blk0 = (LAS int*)(F.lds + pg8::TAB_BLK0); LAS int* row0 = (LAS int*)(F.lds + pg8::TAB_ROW0);
    __syncthreads();
    if (F.tid < 32) cnt[F.tid] = (int)__hip_atomic_load(F.ctl + CW_CNT + F.tid, RLX_AGENT);
    __syncthreads();
    if (F.tid == 0) { int b = 0, r = 0; for (int e = 0; e < 32; ++e) { blk0[e] = b; row0[e] = r; b += (cnt[e] + 255) >> 8; r += cnt[e]; } blk0[32] = b; row0[32] = r; }
    __syncthreads();
}

constexpr int NPHASE = 11;
struct Args { Ptrs P; int ph_lo, ph_hi; };
__global__ void __launch_bounds__(NWAVES * 64, 2) mk_fwd(Args args) {
    extern __shared__ __attribute__((aligned(16))) unsigned char lds[];
    Frame F; const Ptrs& P = args.P;
    F.lds = (LAS unsigned char*)lds; F.MISC = (volatile LAS unsigned*)(F.lds + MISC_OFF);
    F.wave = __builtin_amdgcn_readfirstlane(threadIdx.x >> 6); F.lane = lane_id(); F.tid = F.wave * 64 + F.lane;
#define REFRESH() do { F.lane = lane_id(); asm volatile("" : "+v"(F.lane)); F.tid = F.wave * 64 + F.lane; } while (0)
    F.G = gridDim.x; { const int bx = blockIdx.x; F.vcu = (F.G % 8 == 0) ? (bx % 8) * (F.G / 8) + bx / 8 : bx; }
    unsigned char* ws = P.ws; F.ctl = (gu32*)(ws + WS_CTL);
    for (int u = F.tid; u < 1024 / 4; u += NWAVES * 64) ((LAS unsigned*)(F.lds + LDSCTL_OFF))[u] = 0u;
    __syncthreads();
    const int lo = args.ph_lo, hi = args.ph_hi;
    XcdBarrier bar = xcd_barrier_post((unsigned*)(F.ctl + CW_BAR) + lo * XCD_BAR_WORDS, F.MISC + 8);
#ifndef PH_COMPILE
#define PH_COMPILE 0x7ff
#endif
#define IN(k) ((((PH_COMPILE) >> (k)) & 1) && lo <= (k) && (k) < hi)
#define SEAM(k) do { if (IN(k) && IN((k) + 1)) xcd_barrier(bar); } while (0)
#ifndef REP2_MASK
#define REP2_MASK 0
#endif
#define REPS(k) for (int rep_ = 0; rep_ < ((((REP2_MASK) >> (k)) & 1) ? 2 : 1); ++rep_)
    bf16 *XB = (bf16*)(ws + WS_XB), *Q = (bf16*)(ws + WS_Q), *K = (bf16*)(ws + WS_K), *V = (bf16*)(ws + WS_V), *U = (bf16*)(ws + WS_U), *G = (bf16*)(ws + WS_G);
    bf16 *O16 = (bf16*)(ws + WS_O16), *APO = (bf16*)(ws + WS_APO), *MIX = (bf16*)(ws + WS_MIX), *X1B = (bf16*)(ws + WS_X1B), *HB = (bf16*)(ws + WS_HB), *PB = (bf16*)(ws + WS_PB);
    bf16* T = (bf16*)(ws + WS_T);

    if (IN(0)) REPS(0) { REFRESH(); ph0_prologue(F, P); } SEAM(0);
    if (IN(1)) REPS(1) {
        pg8::Gemm g{XB, (const bf16*)(ws + WS_WIN), 1024}; pg8::StaticOrder S; S.init(M, 4096, F.G, (int)blockIdx.x);
        pg8::EpiProj E{Q, K, V, U, G, P.b_gate, (float*)(F.ctl + CW_PN), C2Q, 0};
        pg8::gemm_phase(F.lds, F.wave, g, S, E);
    } SEAM(1);
    if (IN(2)) REPS(2) {
        const attn_body::AttnTensors AT{(const attn_body::bf16*)Q, (const attn_body::bf16*)K, (const attn_body::bf16*)V, (attn_body::bf16*)O16, (const float*)(F.ctl + CW_PN), (unsigned*)(F.ctl + CW_AQ)};
        attn_body::attn_phase<8>((char*)lds + RING_OFF, AT, F.wave);
#ifndef NO_POOL
        REFRESH(); ph_pool(F, P);
#endif
    } SEAM(2);
    if (IN(3)) REPS(3) { REFRESH(); ph_combine(F, P); } SEAM(3);
    if (IN(4)) REPS(4) {
        pg8::StaticOrder S; S.init(M, 1024, F.G, (int)blockIdx.x);
        pg8::Gemm g{APO, (const bf16*)(ws + WS_WCAT), 1024}; pg8::EpiMixCat E{MIX, G}; pg8::gemm_phase(F.lds, F.wave, g, S, E);
    } SEAM(4);
    if (IN(5)) REPS(5) {
        pg8::Gemm g{MIX, (const bf16*)(ws + WS_WOUT), 1024}; pg8::StaticOrder S; S.init(M, 1024, F.G, (int)blockIdx.x);
        pg8::EpiF32<0> E{P.out, P.x, ALPHA, 1.f};
        pg8::gemm_phase(F.lds, F.wave, g, S, E);
    } SEAM(5);
    if (IN(6)) { REFRESH(); ph6_ln1_route(F, P); } SEAM(6);
    if (IN(7)) {
        pg8::StaticOrder S; S.init(M, 1024, F.G, (int)blockIdx.x);
#ifndef NO_PH7A
        { pg8::Gemm g{PB, (const bf16*)(ws + WS_WPP), 256}; pg8::EpiF32<1> E{(float*)T, nullptr, 0.f, 1.f}; pg8::gemm_phase(F.lds, F.wave, g, S, E); }
#endif
        VM_WAIT(); __syncthreads();
#ifndef NO_PH7B
        if (MOE_FP8) { pg8::DenseF8Order S8; S8.init(M, 1024, F.G, (int)blockIdx.x);
            pg8::Gemm g{(const bf16*)(ws + WS_X1F8), (const bf16*)(ws + WS_WPG), 512}; pg8::EpiF32<2> E{P.out, (const float*)T, ALPHA, 1.f / WUP_SCALE}; pg8::gemm_phase(F.lds, F.wave, g, S8, E); }
        else { pg8::Gemm g{X1B, (const bf16*)(ws + WS_WPG), 1024}; pg8::EpiF32<2> E{P.out, (const float*)T, ALPHA, 1.f}; pg8::gemm_phase(F.lds, F.wave, g, S, E); }
#endif
    } SEAM(7);
    if (IN(8)) REPS(8) {
        REFRESH(); moe_tables(F);
        pg8::Gemm g{MOE_FP8 ? (const bf16*)(ws + WS_X1F8) : X1B, (const bf16*)(ws + WS_WUP), MOE_FP8 ? 512 : 1024};
        pg8::MoeOrder<true, MOE_FP8> S{8, F.G, (int)blockIdx.x, (const int*)(ws + WS_LIST), (const float*)(ws + WS_GATEL), (size_t)2048 * 1024 * (MOE_FP8 ? 1 : 2)};
        pg8::EpiUp<MOE_FP8> E{HB, P.b_up, MOE_FP8 ? 1.f / WUP_SCALE : 1.f, 0};
        pg8::gemm_phase(F.lds, F.wave, g, S, E);
    } SEAM(8);
    if (IN(9)) {
        REFRESH(); moe_tables(F);
        pg8::Gemm g{HB, (const bf16*)(ws + WS_WDN), MOE_FP8 ? 512 : 1024};
        pg8::MoeOrder<false, MOE_FP8> S{4, F.G, (int)blockIdx.x, (const int*)(ws + WS_LIST), (const float*)(ws + WS_GATEL), (size_t)1024 * 1024 * (MOE_FP8 ? 1 : 2)};
        pg8::EpiDown E{P.out, (bf16*)(ws + WS_YS1), (bf16*)(ws + WS_YS2), (bf16*)(ws + WS_YS3), P.b_down, MOE_FP8 ? 1.f / (WDN_SCALE) : 1.f, 0};
        pg8::gemm_phase(F.lds, F.wave, g, S, E);
    } SEAM(9);
    if (IN(10)) { REFRESH(); ph10_final(F, P); }
#undef IN
#undef SEAM
}
#ifndef FAST_MASK
#define FAST_MASK 0x7ff
#endif
#ifndef MERGE_FAST
#define MERGE_FAST 1
#endif
extern "C" void kernel_launch(void* const* d_in, const int* in_sizes, int n_in, void* d_out, int out_size, void* d_ws, size_t ws_size, hipStream_t stream) {
    static int grid = 0;
    if (grid == 0) {
        if (n_in != 26 || ws_size < WS_END || out_size != M * D) { fprintf(stderr, "kernel_launch: unexpected shapes (n_in %d, ws %zu, out %d)\n", n_in, ws_size, out_size); grid = -1; return; }
        int dev = 0, cus = 0, per_cu = 0;
        if (hipGetDevice(&dev) != hipSuccess || hipDeviceGetAttribute(&cus, hipDeviceAttributeMultiprocessorCount, dev) != hipSuccess) { grid = -1; return; }
        if (hipFuncSetAttribute((const void*)mk_fwd, hipFuncAttributeMaxDynamicSharedMemorySize, LDS_BYTES) != hipSuccess) { fprintf(stderr, "kernel_launch: hipFuncSetAttribute failed\n"); grid = -1; return; }
        if (hipOccupancyMaxActiveBlocksPerMultiprocessor(&per_cu, (const void*)mk_fwd, NWAVES * 64, LDS_BYTES) != hipSuccess || per_cu < 1) fprintf(stderr, "kernel_launch: occupancy query says %d\n", per_cu);
        (void)hipGetLastError();
        grid = cus;
    }
    if (grid < 0) return;
    Ptrs P{};
    { const float** pp = (const float**)&P; for (int i = 0; i < 26; ++i) pp[i] = (const float*)d_in[i]; }
    P.out = (float*)d_out; P.ws = (unsigned char*)d_ws;
    unsigned char* ws = (unsigned char*)d_ws; float* out = (float*)d_out;
    unsigned* CTL = (unsigned*)(ws + WS_CTL); unsigned* CNT = CTL + CW_CNT; int* LIST = (int*)(ws + WS_LIST); float* GATE = (float*)(ws + WS_GATE); float* GATEL = (float*)(ws + WS_GATEL); float* WPCF = (float*)(ws + WS_WPCF);
    bf16 *XB = (bf16*)(ws + WS_XB), *PB = (bf16*)(ws + WS_PB), *Q = (bf16*)(ws + WS_Q), *K = (bf16*)(ws + WS_K), *V = (bf16*)(ws + WS_V), *U = (bf16*)(ws + WS_U), *G = (bf16*)(ws + WS_G);
    bf16 *O16 = (bf16*)(ws + WS_O16), *OA = (bf16*)(ws + WS_APO), *PO = (bf16*)(ws + WS_APO) + 512, *MIX = (bf16*)(ws + WS_MIX), *X1B = (bf16*)(ws + WS_X1B), *HB = (bf16*)(ws + WS_HB);
    bf16 *YS1 = (bf16*)(ws + WS_YS1), *YS2 = (bf16*)(ws + WS_YS2), *YS3 = (bf16*)(ws + WS_YS3); bf16* T = (bf16*)(ws + WS_T);
    (void)hipMemsetAsync(ws + WS_CTL, 0, CTL_ZERO_BYTES, stream);
    const unsigned fm = FAST_MASK;
    for (int ph = 0; ph < NPHASE;) {
        if ((fm >> ph) & 1u) {
            int hi = ph + 1; if (MERGE_FAST) while (hi < NPHASE && ((fm >> hi) & 1u)) ++hi;
            Args a{}; a.P = P; a.ph_lo = ph; a.ph_hi = hi;
            hipLaunchKernelGGL(mk_fwd, dim3(grid), dim3(NWAVES * 64), LDS_BYTES, stream, a);
            if (fm != 0x7ffu && ph == 0) { nv::k_fold_pool<<<512, 256, 0, stream>>>(P.w_pmix, P.pscale, P.w_pbr, WPCF); }
            ph = hi; continue;
        }
        switch (ph) {
        case 0: nv::k_cvt_bf16<<<2048, 256, 0, stream>>>(P.x, XB, (size_t)M * D / 4); nv::k_fold_pool<<<512, 256, 0, stream>>>(P.w_pmix, P.pscale, P.w_pbr, WPCF); break;
        case 1: nv::k_gemm<false><<<dim3(4096 / 64, M / 64, 1), 256, 0, stream>>>(nv::RowDense{XB, 1024, 0}, nv::EpiProj{Q, K, V, U, G, P.b_gate, C2Q, 0}, P.w_in, 0, 4096, 1024, 0, 0); break;
        case 2: nv::k_attn<<<dim3(SEQ / 256, 16, BATCH), 256, 0, stream>>>(Q, K, V, O16); nv::k_pool<<<(unsigned)((size_t)M * 512 / 256), 256, 0, stream>>>(U, PO); break;
        case 3: nv::k_combine<<<M / 4, 256, 0, stream>>>(O16, OA, P.lq1, P.lk1, P.lq2, P.lk2, P.subln); break;
        case 4: nv::k_gemm<false><<<dim3(1024 / 64, M / 64, 1), 256, 0, stream>>>(nv::RowDense{OA, 1024, 0}, nv::EpiMixA{MIX, G}, P.w_abr, 0, 1024, 512, 0, 0);
                nv::k_gemm<false><<<dim3(1024 / 64, M / 64, 1), 256, 0, stream>>>(nv::RowDense{PO, 1024, 0}, nv::EpiMixB{MIX, G}, WPCF, 0, 1024, 512, 0, 0); break;
        case 5: nv::k_gemm<false><<<dim3(1024 / 64, M / 64, 1), 256, 0, stream>>>(nv::RowDense{MIX, 1024, 0}, nv::EpiPre1{out, P.x, ALPHA, 0}, P.w_out, 0, 1024, 1024, 0, 0); break;
        case 6: nv::k_ln1_route<<<M, 256, 0, stream>>>(out, X1B, P.ln1g, P.ln1b, P.w_router, P.b_router, CNT, LIST, GATE, GATEL);
                nv::k_cvt_bf16<<<2048, 256, 0, stream>>>(P.p, PB, (size_t)M * PLE / 4); break;
        case 7: nv::k_gemm<false><<<dim3(1024 / 64, M / 64, 1), 256, 0, stream>>>(nv::RowDense{PB, 256, 0}, nv::EpiStoreF32{T}, P.w_pp, 0, 1024, 256, 0, 0);
                nv::k_gemm<false><<<dim3(1024 / 64, M / 64, 1), 256, 0, stream>>>(nv::RowDense{X1B, 1024, 0}, nv::EpiBase{out, T, ALPHA, 0}, P.w_pg, 0, 1024, 1024, 0, 0); break;
        case 8: nv::k_gemm<true><<<dim3(1024 / 64, M / 64, NEXP), 256, 0, stream>>>(nv::RowGather{X1B, LIST, CNT}, nv::EpiUp{HB, P.b_up, CNT}, P.w_up, (size_t)1024 * 2048, 2048, 1024, 1024, 0); break;
        case 9: nv::k_gemm<false><<<dim3(1024 / 64, M / 64, NEXP), 256, 0, stream>>>(nv::RowSlots{HB, CNT}, nv::EpiDown{out, YS1, YS2, YS3, P.b_down, LIST, GATE, CNT}, P.w_down, (size_t)1024 * 1024, 1024, 1024, 0, 0); break;
        case 10: nv::k_final<<<M, 256, 0, stream>>>(out, YS1, YS2, YS3, P.ln2g, P.ln2b); break;
        }
        ++ph;
    }
}
```

```cpp
#define FAST_MASK 0x7ff
#include <hip/hip_runtime.h>
#include <hip/hip_bf16.h>
#include <cstdio>
#include <cstdint>
#include <cmath>

#define GAS __attribute__((address_space(1)))
#define LAS __attribute__((address_space(3)))
typedef unsigned short bf16;
typedef unsigned v4u __attribute__((ext_vector_type(4)));
typedef float f32x4 __attribute__((ext_vector_type(4)));
typedef short bf16x8 __attribute__((ext_vector_type(8)));
typedef GAS unsigned gu32;
typedef GAS unsigned long long gu64;
#define RLX_AGENT __ATOMIC_RELAXED, __HIP_MEMORY_SCOPE_AGENT
#define LDS_WAIT() asm volatile("s_waitcnt lgkmcnt(0)" ::: "memory")
#define VM_WAIT() asm volatile("s_waitcnt vmcnt(0)" ::: "memory")
__device__ __forceinline__ unsigned f2bf(float f) { unsigned u = __builtin_bit_cast(unsigned, f); return (u + 0x7fffu + ((u >> 16) & 1u)) >> 16; }
__device__ __forceinline__ unsigned pk2(float lo, float hi) { return f2bf(lo) | (f2bf(hi) << 16); }

__device__ __forceinline__ int lane_id() { return (int)__builtin_amdgcn_mbcnt_hi(~0u, __builtin_amdgcn_mbcnt_lo(~0u, 0u)); }

constexpr int BATCH = 16, SEQ = 4096, D = 1024, M = BATCH * SEQ;
constexpr int NEXP = 32, TOPK = 4, NASSIGN = M * TOPK, FF = 1024, PLE = 256;
constexpr float LN_EPS = 1e-5f;
constexpr float ALPHA = 1.189207115002721f;
constexpr float C2Q = 0.125f * 1.4426950408889634f;

constexpr size_t MiB = 1u << 20;
constexpr size_t WS_CTL = 0, CTL_ZERO_BYTES = 1 * MiB;
constexpr size_t WS_LIST = 1 * MiB;
constexpr size_t WS_GATEL = 9 * MiB;
constexpr size_t WS_GATE = 17 * MiB;
constexpr size_t WS_WPCF = 18 * MiB;
constexpr size_t WS_WIN = 20 * MiB, WS_WCAT = 28 * MiB, WS_WOUT = 30 * MiB, WS_WPG = 32 * MiB, WS_WPP = 34 * MiB;
constexpr size_t WS_WDN = 36 * MiB, WS_WUP = 100 * MiB;
constexpr size_t WS_XB = 228 * MiB;
constexpr size_t WS_APO = 228 * MiB;
constexpr size_t WS_X1B = 228 * MiB;
constexpr size_t WS_Q = 356 * MiB, WS_K = 420 * MiB, WS_V = 484 * MiB, WS_U = 548 * MiB;
constexpr size_t WS_G = 612 * MiB;
constexpr size_t WS_O16 = 868 * MiB;
constexpr size_t WS_PB = 868 * MiB;
constexpr size_t WS_MIX = 356 * MiB;
constexpr size_t WS_T = 356 * MiB;
constexpr size_t WS_HB = 356 * MiB;
constexpr size_t WS_YS1 = 100 * MiB, WS_YS2 = 228 * MiB, WS_YS3 = 868 * MiB;
constexpr size_t WS_X1F8 = 900 * MiB;
constexpr size_t WS_YS0 = 612 * MiB;
constexpr size_t WS_PLE = 740 * MiB;
constexpr size_t WS_END = 1024 * MiB;
#ifndef MOE_FP8
#define MOE_FP8 1
#endif
constexpr float WUP_SCALE = 32.f, WDN_SCALE = 64.f;
#ifndef PROJ_F8_FROM
#define PROJ_F8_FROM 8
#endif
constexpr size_t WS_XF8 = 900 * MiB;
constexpr size_t WS_WIN8 = WS_WIN + (size_t)PROJ_F8_FROM * 256 * 1024 * 2;
constexpr float ATT_SKIP = 40.f;
constexpr int CW_TMO = 0, CW_CODE = 1;
constexpr int CW_CNT = 64;
constexpr int CW_AQ = 128;
constexpr int CW_PN = 65536;
constexpr int CW_BAR = 4096;
namespace nv {
__device__ __forceinline__ float bf2f(bf16 b) { return __builtin_bit_cast(float, (unsigned)b << 16); }
__device__ __forceinline__ bf16 f2b(float f) { return (bf16)f2bf(f); }
__device__ __forceinline__ float sigm(float v) { return 1.f / (1.f + __expf(-v)); }

__global__ void k_zero_ctl(unsigned* p, int n) { int i = blockIdx.x * blockDim.x + threadIdx.x; if (i < n) p[i] = 0u; }
__global__ void k_cvt_bf16(const float* in, bf16* out, size_t n4) {
    size_t i = (size_t)blockIdx.x * blockDim.x + threadIdx.x; const size_t st = (size_t)gridDim.x * blockDim.x;
    for (; i < n4; i += st) { const f32x4 v = ((const f32x4*)in)[i]; unsigned long long o = (unsigned long long)pk2(v.x, v.y) | ((unsigned long long)pk2(v.z, v.w) << 32); ((unsigned long long*)out)[i] = o; }
}
__global__ void k_fold_pool(const float* wmix, const float* scale, const float* wpb, float* Wpc) {
    const int row = blockIdx.x, g = row >> 7, c = row & 127;
    __shared__ float wm[128];
    if (threadIdx.x < 128) wm[threadIdx.x] = wmix[(g * 128 + c) * 128 + threadIdx.x] * scale[g * 128 + threadIdx.x];
    __syncthreads();
    for (int n = threadIdx.x; n < 1024; n += 256) { float s = 0.f; for (int d = 0; d < 128; ++d) s += wm[d] * wpb[(size_t)(g * 128 + d) * 1024 + n]; Wpc[(size_t)row * 1024 + n] = s; }
}

template <bool DUAL, class RowF, class Epi>
__global__ void __launch_bounds__(256) k_gemm(RowF rf, Epi epi, const float* W, size_t wz, int ldw, int K, int dualoff, int pad_) {
    __shared__ float As[16][68]; __shared__ float Bs[16][64]; __shared__ float Bs2[DUAL ? 16 : 1][64];
    const int tid = threadIdx.x, ty = tid >> 4, tx = tid & 15, z = blockIdx.z;
    const int row0 = blockIdx.y * 64, col0 = blockIdx.x * 64;
    if (!rf.active(z, row0)) return;
    const float* Wz = W + (size_t)z * wz;
    float acc[4][4] = {}, acc2[4][4] = {};
    const int ar = tid >> 2, ak = (tid & 3) * 4; const bf16* arow = rf.row(z, row0 + ar);
    const int bk = tid >> 4, bc = (tid & 15) * 4;
    for (int k0 = 0; k0 < K; k0 += 16) {
        { const unsigned long long v = arow ? *(const unsigned long long*)(arow + k0 + ak) : 0ull;
          As[ak + 0][ar] = bf2f((bf16)(v & 0xffff)); As[ak + 1][ar] = bf2f((bf16)((v >> 16) & 0xffff)); As[ak + 2][ar] = bf2f((bf16)((v >> 32) & 0xffff)); As[ak + 3][ar] = bf2f((bf16)(v >> 48)); }
        { const f32x4 v = *(const f32x4*)(Wz + (size_t)(k0 + bk) * ldw + col0 + bc); Bs[bk][bc] = v.x; Bs[bk][bc + 1] = v.y; Bs[bk][bc + 2] = v.z; Bs[bk][bc + 3] = v.w;
          if (DUAL) { const f32x4 w = *(const f32x4*)(Wz + (size_t)(k0 + bk) * ldw + dualoff + col0 + bc); Bs2[bk][bc] = w.x; Bs2[bk][bc + 1] = w.y; Bs2[bk][bc + 2] = w.z; Bs2[bk][bc + 3] = w.w; } }
        __syncthreads();
#pragma unroll
        for (int k = 0; k < 16; ++k) { float a[4], b[4], b2[4];
#pragma unroll
            for (int i = 0; i < 4; ++i) { a[i] = As[k][ty * 4 + i]; b[i] = Bs[k][tx * 4 + i]; b2[i] = DUAL ? Bs2[k][tx * 4 + i] : 0.f; }
#pragma unroll
            for (int i = 0; i < 4; ++i)
#pragma unroll
                for (int j = 0; j < 4; ++j) { acc[i][j] += a[i] * b[j]; if (DUAL) acc2[i][j] += a[i] * b2[j]; } }
        __syncthreads();
    }
#pragma unroll
    for (int i = 0; i < 4; ++i)
#pragma unroll
        for (int j = 0; j < 4; ++j) epi(z, row0 + ty * 4 + i, col0 + tx * 4 + j, acc[i][j], acc2[i][j]);
}
struct RowDense { const bf16* A; int lda; int pad; __device__ bool active(int, int) const { return true; } __device__ const bf16* row(int, int r) const { return A + (size_t)r * lda; } };

struct EpiProj { bf16 *Q, *K, *V, *U, *G; const float* bg; float c2; int pad;
    __device__ void operator()(int, int r, int c, float v, float) const {
        if (c < 512) Q[(size_t)r * 512 + c] = f2b(v * c2); else if (c < 1024) K[(size_t)r * 512 + c - 512] = f2b(v); else if (c < 1536) V[(size_t)r * 512 + c - 1024] = f2b(v);
        else if (c < 2048) U[(size_t)r * 512 + c - 1536] = f2b(v); else G[(size_t)r * 2048 + c - 2048] = f2b(sigm(v + bg[c - 2048])); } };
struct EpiMixA { bf16* MIX; const bf16* G; __device__ void operator()(int, int r, int c, float v, float) const { MIX[(size_t)r * 1024 + c] = f2b(bf2f(G[(size_t)r * 2048 + c]) * v); } };
struct EpiMixB { bf16* MIX; const bf16* G; __device__ void operator()(int, int r, int c, float v, float) const { MIX[(size_t)r * 1024 + c] = f2b(bf2f(MIX[(size_t)r * 1024 + c]) + bf2f(G[(size_t)r * 2048 + 1024 + c]) * v); } };
struct EpiPre1 { float* out; const float* x; float alpha; int pad; __device__ void operator()(int, int r, int c, float v, float) const { out[(size_t)r * 1024 + c] = alpha * x[(size_t)r * 1024 + c] + v; } };
struct EpiStoreF32 { bf16* T; __device__ void operator()(int, int r, int c, float v, float) const { T[(size_t)r * 1024 + c] = f2b(v); } };
struct EpiBase { float* base; const bf16* T; float alpha; int pad; __device__ void operator()(int, int r, int c, float v, float) const { const size_t i = (size_t)r * 1024 + c; base[i] = alpha * base[i] + sigm(v) * bf2f(T[i]); } };

__global__ void __launch_bounds__(256) k_attn(const bf16* Q, const bf16* K, const bf16* V, bf16* O16) {
    __shared__ float Ks[64][64]; __shared__ float Vs[64][64];
    const int qb = blockIdx.x, vh = blockIdx.y, b = blockIdx.z, tid = threadIdx.x;
    const int hm = vh >> 1, half = vh & 1, h = hm >> 1;
    const float c2 = exp2f(-2.f * (h + 1)) * 1.4426950408889634f;
    const int i = qb * 256 + tid; const size_t rowb = (size_t)b * SEQ;
    float q[64], acc[64];
    { const bf16* qp = Q + (rowb + i) * 512 + hm * 64;
#pragma unroll
      for (int d = 0; d < 64; ++d) { q[d] = bf2f(qp[d]); acc[d] = 0.f; } }
    float m = -INFINITY, l = 0.f;
    const int ntile = (qb * 256 + 256) / 64;
    for (int t = 0; t < ntile; ++t) {
        __syncthreads();
        for (int e = tid; e < 64 * 64; e += 256) { const int j = e >> 6, d = e & 63; const size_t r = rowb + t * 64 + j;
            Ks[j][d] = bf2f(K[r * 512 + hm * 64 + d]); Vs[j][d] = bf2f(V[r * 512 + h * 128 + half * 64 + d]); }
        __syncthreads();
        for (int j = 0; j < 64; ++j) { const int jj = t * 64 + j; if (jj > i) break;
            float s = 0.f;
#pragma unroll
            for (int d = 0; d < 64; ++d) s += q[d] * Ks[j][d];
            s -= c2 * (float)(i - jj);
            if (s > m) { const float f = exp2f(m - s); l *= f;
#pragma unroll
                for (int d = 0; d < 64; ++d) acc[d] *= f;
                m = s; }
            const float p = exp2f(s - m); l += p;
#pragma unroll
            for (int d = 0; d < 64; ++d) acc[d] += p * Vs[j][d]; }
    }
    const float rl = 1.f / l; bf16* op = O16 + (rowb + i) * 1024 + h * 256 + (hm & 1) * 128 + half * 64;
#pragma unroll
    for (int d = 0; d < 64; ++d) op[d] = f2b(acc[d] * rl);
}
__device__ __forceinline__ float lam_value(const float* lq1, const float* lk1, const float* lq2, const float* lk2) {
    float a = 0.f, b = 0.f; for (int d = 0; d < 64; ++d) { a += lq1[d] * lk1[d]; b += lq2[d] * lk2[d]; } return __expf(a) - __expf(b) + 0.2f; }
__global__ void __launch_bounds__(256) k_combine(const bf16* O16, bf16* OA, const float* lq1, const float* lk1, const float* lq2, const float* lk2, const float* sg) {
    const float lam = lam_value(lq1, lk1, lq2, lk2);
    const int row = blockIdx.x * 4 + (threadIdx.x >> 6), lane = threadIdx.x & 63, h = lane >> 4, e0 = (lane & 15) * 8;
    const bf16* a = O16 + (size_t)row * 1024 + h * 256 + e0; const bf16* bb = a + 128;
    float o[8], ss = 0.f;
#pragma unroll
    for (int j = 0; j < 8; ++j) { o[j] = bf2f(a[j]) - lam * bf2f(bb[j]); ss += o[j] * o[j]; }
    ss += __shfl_xor(ss, 1); ss += __shfl_xor(ss, 2); ss += __shfl_xor(ss, 4); ss += __shfl_xor(ss, 8);
    const float r = rsqrtf(ss * (1.f / 128.f) + LN_EPS) * 0.8f;
#pragma unroll
    for (int j = 0; j < 8; ++j) OA[(size_t)row * 1024 + h * 128 + e0 + j] = f2b(o[j] * r * sg[e0 + j]);
}
__global__ void __launch_bounds__(256) k_pool(const bf16* U, bf16* PO) {
    const size_t idx = (size_t)blockIdx.x * 256 + threadIdx.x; const int c = (int)(idx & 511); const size_t row = idx >> 9; const int pos = (int)(row & (SEQ - 1));
    const int w = 2 << (c >> 7); const int n = pos + 1 < w ? pos + 1 : w; float s = 0.f;
    for (int k = 0; k < n; ++k) s += bf2f(U[(row - k) * 512 + c]);
    PO[row * 1024 + c] = f2b(s / (float)n - bf2f(U[row * 512 + c]));
}
__global__ void __launch_bounds__(256) k_ln1_route(float* X1, bf16* X1B, const float* g, const float* bta, const float* wr, const float* br, unsigned* CNT, int* LIST, float* GATE, float* GATEL) {
    __shared__ float xs[1024]; __shared__ float red[8]; __shared__ float part[8][32]; __shared__ float lg[32];
    const int row = blockIdx.x, tid = threadIdx.x, lane = tid & 63, wv = tid >> 6;
    f32x4 v = ((const f32x4*)(X1 + (size_t)row * 1024))[tid];
    float s = (v.x + v.y) + (v.z + v.w); for (int o = 1; o < 64; o <<= 1) s += __shfl_xor(s, o);
    if (lane == 0) red[wv] = s; __syncthreads(); const float mean = (red[0] + red[1] + red[2] + red[3]) * (1.f / 1024.f); __syncthreads();
    v = v - mean; float q = (v.x * v.x + v.y * v.y) + (v.z * v.z + v.w * v.w); for (int o = 1; o < 64; o <<= 1) q += __shfl_xor(q, o);
    if (lane == 0) red[wv] = q; __syncthreads(); const float rstd = rsqrtf((red[0] + red[1] + red[2] + red[3]) * (1.f / 1024.f) + LN_EPS);
    const f32x4 gg = ((const f32x4*)g)[tid], bb = ((const f32x4*)bta)[tid]; v = v * rstd * gg + bb;
    ((f32x4*)(X1 + (size_t)row * 1024))[tid] = v; ((unsigned long long*)(X1B + (size_t)row * 1024))[tid] = (unsigned long long)pk2(v.x, v.y) | ((unsigned long long)pk2(v.z, v.w) << 32);
    xs[tid * 4] = v.x; xs[tid * 4 + 1] = v.y; xs[tid * 4 + 2] = v.z; xs[tid * 4 + 3] = v.w; __syncthreads();
    { const int e = tid & 31, pt = tid >> 5; float a = 0.f; for (int k = pt * 128; k < pt * 128 + 128; ++k) a += xs[k] * wr[k * 32 + e]; part[pt][e] = a; }
    __syncthreads();
    if (tid < 32) { float a = br[tid]; for (int pt = 0; pt < 8; ++pt) a += part[pt][tid]; lg[tid] = a; }
    __syncthreads();
    if (tid == 0) { int id[4]; float vv[4]; unsigned used = 0u;
        for (int k = 0; k < 4; ++k) { int bi = 0; float bv = -INFINITY; for (int e = 0; e < 32; ++e) if (!((used >> e) & 1u) && lg[e] > bv) { bv = lg[e]; bi = e; } used |= 1u << bi; id[k] = bi; vv[k] = bv; }
        float es[4], sum = 0.f; for (int k = 0; k < 4; ++k) { es[k] = __expf(vv[k] - vv[0]); sum += es[k]; }
        for (int k = 0; k < 4; ++k) { const unsigned pos = atomicAdd(&CNT[id[k]], 1u); LIST[(size_t)id[k] * 65536 + pos] = row * 4 + k; GATEL[(size_t)id[k] * 65536 + pos] = es[k] / sum; GATE[row * 4 + k] = es[k] / sum; } }
}
struct RowGather { const bf16* X1B; const int* LIST; const unsigned* CNT;
    __device__ bool active(int e, int row0) const { return (unsigned)row0 < CNT[e]; }
    __device__ const bf16* row(int e, int r) const { return (unsigned)r < CNT[e] ? X1B + (size_t)(LIST[(size_t)e * 65536 + r] >> 2) * 1024 : nullptr; } };
__device__ __forceinline__ unsigned slot_off(const unsigned* CNT, int e) { unsigned o = 0; for (int i = 0; i < e; ++i) o += CNT[i]; return o; }
struct EpiUp { bf16* HB; const float* bup; const unsigned* CNT;
    __device__ void operator()(int e, int r, int c, float glu, float lin) const { if ((unsigned)r >= CNT[e]) return;
        glu += bup[e * 2048 + c]; lin += bup[e * 2048 + 1024 + c]; glu = fminf(glu, 7.f); lin = fminf(fmaxf(lin, -7.f), 7.f);
        HB[(size_t)(slot_off(CNT, e) + r) * 1024 + c] = f2b(glu * sigm(1.702f * glu) * (lin + 1.f)); } };
struct RowSlots { const bf16* HB; const unsigned* CNT;
    __device__ bool active(int e, int row0) const { return (unsigned)row0 < CNT[e]; }
    __device__ const bf16* row(int e, int r) const { return (unsigned)r < CNT[e] ? HB + (size_t)(slot_off(CNT, e) + r) * 1024 : nullptr; } };
struct EpiDown { float* base; bf16* YS1; bf16* YS2; bf16* YS3; const float* bdn; const int* LIST; const float* GATE; const unsigned* CNT;
    __device__ void operator()(int e, int r, int c, float v, float) const { if ((unsigned)r >= CNT[e]) return;
        const int a = LIST[(size_t)e * 65536 + r], tok = a >> 2, k = a & 3; const float y = (v + bdn[e * 1024 + c]) * GATE[a]; const size_t i = (size_t)tok * 1024 + c;
        if (k == 0) base[i] += y; else if (k == 1) YS1[i] = f2b(y); else if (k == 2) YS2[i] = f2b(y); else YS3[i] = f2b(y); } };
__global__ void __launch_bounds__(256) k_final(float* out, const bf16* YS1, const bf16* YS2, const bf16* YS3, const float* g, const float* bta) {
    __shared__ float red[8]; const int row = blockIdx.x, tid = threadIdx.x, lane = tid & 63, wv = tid >> 6; const size_t i0 = (size_t)row * 1024 + tid * 4;
    f32x4 v = *(const f32x4*)(out + i0);
    const bf16* ys[3] = {YS1, YS2, YS3};
    for (int k = 0; k < 3; ++k) { const unsigned long long w = *(const unsigned long long*)(ys[k] + i0); v.x += bf2f((bf16)(w & 0xffff)); v.y += bf2f((bf16)((w >> 16) & 0xffff)); v.z += bf2f((bf16)((w >> 32) & 0xffff)); v.w += bf2f((bf16)(w >> 48)); }
    float s = (v.x + v.y) + (v.z + v.w); for (int o = 1; o < 64; o <<= 1) s += __shfl_xor(s, o);
    if (lane == 0) red[wv] = s; __syncthreads(); const float mean = (red[0] + red[1] + red[2] + red[3]) * (1.f / 1024.f); __syncthreads();
    v = v - mean; float q = (v.x * v.x + v.y * v.y) + (v.z * v.z + v.w * v.w); for (int o = 1; o < 64; o <<= 1) q += __shfl_xor(q, o);
    if (lane == 0) red[wv] = q; __syncthreads(); const float rstd = rsqrtf((red[0] + red[1] + red[2] + red[3]) * (1.f / 1024.f) + LN_EPS);
    const f32x4 gg = ((const f32x4*)g)[tid], bb = ((const f32x4*)bta)[tid]; *(f32x4*)(out + i0) = v * rstd * gg + bb;
}
}
namespace pg8 {
#define PG8_LAS __attribute__((address_space(3)))
typedef unsigned short bf16_t;
typedef unsigned u32x4 __attribute__((ext_vector_type(4)));
typedef float f32x2 __attribute__((ext_vector_type(2)));
constexpr int BM = 256, BK = 64, HALF = 128, HTB = HALF * BK * 2  , STAGE_BYTES = 8 * HTB, NXCD = 8, WGM = 8;
constexpr int TAB_OFF = 131072 + 1024;
constexpr int TAB_CNT = TAB_OFF, TAB_BLK0 = TAB_OFF + 128, TAB_ROW0 = TAB_OFF + 384, TAB_IDS = TAB_OFF + 1024, TAB_GATES = TAB_OFF + 1024 + 2048;

__host__ __device__ __forceinline__ int lds_byte(int r, int c) { const int st = (r >> 4) * 2 + (c >> 5), rr = r & 15, cc = c & 31, ob = rr * 64 + cc * 2; return st * 1024 + (ob ^ (((ob >> 9) & 1) << 5)); }
__host__ __device__ __forceinline__ void stage_rc(int b, int& R, int& C) { const int st = b / 1024, sb = b % 1024, swz = sb ^ (((sb >> 9) & 1) << 5); R = (st >> 1) * 16 + swz / 64; C = (st & 1) * 32 + (swz % 64) / 2; }
__host__ __device__ __forceinline__ int perm32(int rho) { const int n = rho >> 4, i = rho & 15; return 8 * (i >> 2) + 4 * n + (i & 3); }

struct Unit { int pm, pn, e, nvalid; };
struct Gemm { const bf16_t* A; const bf16_t* Bt; int K; };

struct StaticOrder {
    static constexpr bool TABLES = false, FP8 = false;
    int nM, nN, nwg, G, c;
    __host__ __device__ void init(int M, int N, int G_, int c_) { nM = M / BM; nN = N / BM; nwg = nM * nN; G = G_; c = c_; }
    __device__ __forceinline__ bool next(int i, Unit& u, PG8_LAS unsigned char*) const {
        const long L = (long)i * G + c; if (L >= nwg) return false;
        int wgid = (int)L; { const int q = nwg / NXCD, r = nwg % NXCD, xcd = wgid % NXCD, off = wgid / NXCD; wgid = (xcd < r ? xcd * (q + 1) : r * (q + 1) + (xcd - r) * q) + off; }
        const int nig = WGM * nN, gid = wgid / nig, fm = gid * WGM, gsz = (nM - fm) < WGM ? (nM - fm) : WGM;
        u.pm = fm + ((wgid % nig) % gsz); u.pn = (wgid % nig) / gsz; u.e = 0; u.nvalid = 256; return true;
    }
    __device__ __forceinline__ const char* b_tile(const Gemm& g, const Unit& u) const { return (const char*)g.Bt + (size_t)u.pn * (size_t)(BM * 2) * g.K; }
    __device__ __forceinline__ void a_offsets(const Gemm& g, const Unit& u, PG8_LAS unsigned char*, int, const int (&R)[2], const int (&C)[2], unsigned (&off)[2][2]) const {
#pragma unroll
        for (int h = 0; h < 2; ++h)
#pragma unroll
            for (int i = 0; i < 2; ++i) off[h][i] = (unsigned)(((u.pm * BM + h * HALF + R[i]) * g.K + C[i]) * 2);
    }
    __device__ __forceinline__ void issue_tables(const Unit&, PG8_LAS unsigned char*, int, int) const {}
};

struct DenseF8Order : StaticOrder { static constexpr bool FP8 = true; };

template <bool GATHER_, bool FP8_> struct MoeOrder {
    static constexpr bool TABLES = true; static constexpr bool GATHER = GATHER_, FP8 = FP8_;
    int NT, G, c; const int* LIST; const float* GATEL; size_t bstride;
    __device__ __forceinline__ bool next(int i, Unit& u, PG8_LAS unsigned char* lds) const {
        const PG8_LAS int* cnt = (const PG8_LAS int*)(lds + TAB_CNT); const PG8_LAS int* blk0 = (const PG8_LAS int*)(lds + TAB_BLK0);
        const int L = i * G + c; const int total = blk0[32] * NT; if (L >= total) return false;
        const int blk = L / NT; int e = 0;
#pragma unroll 1
        for (int j = 1; j < 32; ++j) e += (blk >= blk0[j]) ? 1 : 0;
        e = __builtin_amdgcn_readfirstlane(e);
        u.e = e; u.pm = __builtin_amdgcn_readfirstlane(blk - blk0[e]); u.pn = L % NT; const int left = __builtin_amdgcn_readfirstlane(cnt[e]) - 256 * u.pm; u.nvalid = left < 256 ? left : 256; return true;
    }
    __device__ __forceinline__ const char* b_tile(const Gemm& g, const Unit& u) const { return (const char*)g.Bt + (size_t)u.e * bstride + (size_t)u.pn * (size_t)(BM * 2) * g.K; }
    __device__ __forceinline__ void a_offsets(const Gemm& g, const Unit& u, PG8_LAS unsigned char* lds, int buf, const int (&R)[2], const int (&C)[2], unsigned (&off)[2][2]) const {
        const PG8_LAS int* ids = (const PG8_LAS int*)(lds + TAB_IDS) + buf * 256; const PG8_LAS int* row0 = (const PG8_LAS int*)(lds + TAB_ROW0);
#pragma unroll
        for (int h = 0; h < 2; ++h)
#pragma unroll
            for (int i = 0; i < 2; ++i) { const int r = h * HALF + R[i];
                if (GATHER) { const int tok = (r < u.nvalid) ? (ids[r] >> 2) : 0; off[h][i] = (unsigned)((tok * g.K + C[i]) * 2); }
                else off[h][i] = (unsigned)(((row0[u.e] + u.pm * BM + r) * g.K + C[i]) * 2); }
    }
    __device__ __forceinline__ void issue_tables(const Unit& u, PG8_LAS unsigned char* lds, int buf, int lane) const {
        const size_t o = (size_t)u.e * 65536 + (size_t)u.pm * 256 + lane * 4;
        __builtin_amdgcn_global_load_lds((const unsigned*)(LIST + o), (PG8_LAS unsigned*)(lds + TAB_IDS + buf * 1024), 16, 0, 0);
        if (!GATHER) __builtin_amdgcn_global_load_lds((const unsigned*)(GATEL + o), (PG8_LAS unsigned*)(lds + TAB_GATES + buf * 1024), 16, 0, 0);
    }
};

__device__ __forceinline__ unsigned cvt_pk_bf16(float lo, float hi) { unsigned r; asm volatile("v_cvt_pk_bf16_f32 %0, %1, %2" : "=v"(r) : "v"(lo), "v"(hi)); return r; }
__device__ __forceinline__ float bflo(unsigned w) { return __builtin_bit_cast(float, w << 16); }
__device__ __forceinline__ float bfhi(unsigned w) { return __builtin_bit_cast(float, w & 0xffff0000u); }
__device__ __forceinline__ float sigm(float v) { return __builtin_amdgcn_rcpf(1.f + __builtin_amdgcn_exp2f(-1.4426950408889634f * v)); }
__device__ __forceinline__ u32x4 pack8(const f32x4& v0, const f32x4& v1) { u32x4 w; w.x = cvt_pk_bf16(v0[0], v0[1]); w.y = cvt_pk_bf16(v0[2], v0[3]); w.z = cvt_pk_bf16(v1[0], v1[1]); w.w = cvt_pk_bf16(v1[2], v1[3]); return w; }
__device__ __forceinline__ void unpack8(const u32x4& w, f32x4& v0, f32x4& v1) { v0 = (f32x4){bflo(w.x), bfhi(w.x), bflo(w.y), bfhi(w.y)}; v1 = (f32x4){bflo(w.z), bfhi(w.z), bflo(w.w), bfhi(w.w)}; }
typedef f32x4 Acc[2][2][4][2];
typedef int i32x4 __attribute__((ext_vector_type(4)));
typedef int i32x8 __attribute__((ext_vector_type(8)));
struct bf16x8p { bf16x8 k[2]; };
template <bool F8> struct Frag { typedef bf16x8p T; };
template <> struct Frag<true> { typedef i32x8 T; };
__device__ __forceinline__ void frag_set(i32x8& d, const i32x4& lo, const i32x4& hi) { d = __builtin_shufflevector(lo, hi, 0, 1, 2, 3, 4, 5, 6, 7); }
__device__ __forceinline__ void frag_set(bf16x8p& d, const bf16x8& lo, const bf16x8& hi) { d.k[0] = lo; d.k[1] = hi; }
__device__ __forceinline__ void frag_mma(f32x4& c, const i32x8& b, const i32x8& a) { c = __builtin_amdgcn_mfma_scale_f32_16x16x128_f8f6f4(b, a, c, 0, 0, 0, 0, 0, 0); }
__device__ __forceinline__ void frag_mma(f32x4& c, const bf16x8p& b, const bf16x8p& a) { c = __builtin_amdgcn_mfma_f32_16x16x32_bf16(b.k[0], a.k[0], c, 0, 0, 0); c = __builtin_amdgcn_mfma_f32_16x16x32_bf16(b.k[1], a.k[1], c, 0, 0, 0); }
__device__ __forceinline__ unsigned pk4_fp8(float a, float b, float c, float d) { unsigned w = __builtin_amdgcn_cvt_pk_fp8_f32(a, b, 0u, false); return __builtin_amdgcn_cvt_pk_fp8_f32(c, d, w, true); }
template <class E> struct has_mid { template <class T> static constexpr bool f(decltype(T::MID)*) { return T::MID; } template <class T> static constexpr bool f(...) { return false; } static constexpr bool value = f<E>(nullptr); };

struct EpiProj {
    static constexpr bool PERM = true;
    bf16_t *Q, *K, *V, *U, *G; const float* bg; float* PN; float c2; float dsc; int pn_base; int pad;
    __device__ __forceinline__ void operator()(const Acc& acc, const Unit& u, int wr, int wc, int fr_, int fq_, PG8_LAS unsigned char*, int) const {
        int fr = fr_, fq = fq_; asm volatile("" : "+v"(fr), "+v"(fq));
        const int pn = u.pn + pn_base; const int row0 = u.pm * BM + wr * 64 + fr; const bool isg = pn >= 8;
        bf16_t* base; int ldc, colt; float sc = dsc;
        if (isg) { base = G; ldc = 2048; colt = (pn - 8) * BM; } else { const int t = pn >> 1; base = t == 0 ? Q : t == 1 ? K : t == 2 ? V : U; ldc = 512; colt = (pn & 1) * BM; if (t == 0) sc = c2 * dsc; }
        const int col0 = colt + wc * 32 + 8 * fq;
        f32x4 bv[2][2];
#pragma unroll
        for (int bj = 0; bj < 2; ++bj)
#pragma unroll
            for (int n = 0; n < 2; ++n) bv[bj][n] = isg ? *(const f32x4*)(bg + col0 + bj * HALF + 4 * n) : (f32x4){0.f, 0.f, 0.f, 0.f};
#pragma unroll
        for (int ai = 0; ai < 2; ++ai)
#pragma unroll
            for (int m = 0; m < 4; ++m) { bf16_t* rowp = base + (size_t)(row0 + ai * HALF + m * 16) * ldc + col0;
#pragma unroll
                for (int bj = 0; bj < 2; ++bj) { f32x4 v0 = acc[ai][bj][m][0] * sc + bv[bj][0], v1 = acc[ai][bj][m][1] * sc + bv[bj][1];
                    if (isg) {
#pragma unroll
                        for (int i = 0; i < 4; ++i) { v0[i] = sigm(v0[i]); v1[i] = sigm(v1[i]); } }
                    *(u32x4*)(rowp + bj * HALF) = pack8(v0, v1); } }
        if (pn < 4) {
            float* tab = PN + (pn >> 1) * 16384; const int R0 = u.pm * BM, b = R0 >> 12;
#pragma unroll
            for (int ai = 0; ai < 2; ++ai)
#pragma unroll
                for (int bj = 0; bj < 2; ++bj) { float mx = 0.f;
#pragma unroll
                    for (int m = 0; m < 4; ++m) { f32x4 v0 = acc[ai][bj][m][0] * sc, v1 = acc[ai][bj][m][1] * sc;
                        float s = (v0[0] * v0[0] + v0[1] * v0[1]) + (v0[2] * v0[2] + v0[3] * v0[3]) + (v1[0] * v1[0] + v1[1] * v1[1]) + (v1[2] * v1[2] + v1[3] * v1[3]);
                        s += __shfl_xor(s, 16); s += __shfl_xor(s, 32); mx = fmaxf(mx, s); }
                    mx = fmaxf(mx, __shfl_xor(mx, 1)); mx = fmaxf(mx, __shfl_xor(mx, 2)); mx = fmaxf(mx, __shfl_xor(mx, 4)); mx = fmaxf(mx, __shfl_xor(mx, 8));
                    const int tile = ((R0 & 4095) >> 6) + 2 * ai + wr, hm = (pn & 1) * 4 + 2 * bj + (wc >> 1);
                    if (fr == 0 && fq == 0) tab[((b * 8 + hm) * 64 + tile) * 2 + (wc & 1)] = mx; }
        }
    }
};
struct EpiMixCat {
    static constexpr bool PERM = true, MID = true;
    bf16_t* MIX; const bf16_t* G;
    __device__ __forceinline__ void mid(Acc& acc, const Unit& u, int wr, int wc, int fr_, int fq_) const {
        int fr = fr_, fq = fq_; asm volatile("" : "+v"(fr), "+v"(fq));
        const int row0 = u.pm * BM + wr * 64 + fr, col0 = u.pn * BM + wc * 32 + 8 * fq;
#pragma unroll
        for (int ai = 0; ai < 2; ++ai)
#pragma unroll
            for (int m = 0; m < 4; ++m) { const size_t r = (size_t)(row0 + ai * HALF + m * 16);
#pragma unroll
                for (int bj = 0; bj < 2; ++bj) { const int c = col0 + bj * HALF;
                    const u32x4 aw = *(const u32x4*)(G + r * 2048 + c), pw = *(const u32x4*)(G + r * 2048 + 1024 + c); f32x4 a0, a1, p0, p1; unpack8(aw, a0, a1); unpack8(pw, p0, p1);
#pragma unroll
                    for (int i = 0; i < 4; ++i) { acc[ai][bj][m][0][i] *= a0[i] * __builtin_amdgcn_rcpf(fmaxf(p0[i], 8.67e-19f)); acc[ai][bj][m][1][i] *= a1[i] * __builtin_amdgcn_rcpf(fmaxf(p1[i], 8.67e-19f)); }
                    asm volatile("" : "+v"(acc[ai][bj][m][0]), "+v"(acc[ai][bj][m][1]) :: "memory"); } }
    }
    __device__ __forceinline__ void operator()(const Acc& acc, const Unit& u, int wr, int wc, int fr_, int fq_, PG8_LAS unsigned char*, int) const {
        int fr = fr_, fq = fq_; asm volatile("" : "+v"(fr), "+v"(fq));
        const int row0 = u.pm * BM + wr * 64 + fr, col0 = u.pn * BM + wc * 32 + 8 * fq;
#pragma unroll
        for (int ai = 0; ai < 2; ++ai)
#pragma unroll
            for (int m = 0; m < 4; ++m) { const size_t r = (size_t)(row0 + ai * HALF + m * 16);
#pragma unroll
                for (int bj = 0; bj < 2; ++bj) { const int c = col0 + bj * HALF;
                    const u32x4 pw = *(const u32x4*)(G + r * 2048 + 1024 + c); f32x4 p0, p1; unpack8(pw, p0, p1);
#pragma unroll
                    for (int i = 0; i < 4; ++i) { p0[i] = fmaxf(p0[i], 8.67e-19f); p1[i] = fmaxf(p1[i], 8.67e-19f); }
                    *(u32x4*)(MIX + r * 1024 + c) = pack8(acc[ai][bj][m][0] * p0, acc[ai][bj][m][1] * p1); }
                asm volatile("" ::: "memory"); }
    }
};
template <int MODE> struct EpiF32 {
    static constexpr bool PERM = false;
    float* out; const float* aux; float alpha; float dsc;
    __device__ __forceinline__ void operator()(const Acc& acc, const Unit& u, int wr, int wc, int fr_, int fq_, PG8_LAS unsigned char*, int) const {
        int fr = fr_, fq = fq_; asm volatile("" : "+v"(fr), "+v"(fq));
        const int col0 = u.pn * BM + wc * 32 + 4 * fq;
#pragma unroll
        for (int ai = 0; ai < 2; ++ai)
#pragma unroll
            for (int m = 0; m < 4; ++m) { const size_t off = (size_t)(u.pm * BM + ai * HALF + wr * 64 + m * 16 + fr) * 1024 + col0;
#pragma unroll
                for (int bj = 0; bj < 2; ++bj) {
#pragma unroll
                    for (int n = 0; n < 2; ++n) { const size_t o = off + bj * HALF + n * 16; const f32x4 a = acc[ai][bj][m][n]; f32x4 r;
                        if (MODE == 1) { f32x2 w; unsigned* wp = (unsigned*)&w; wp[0] = cvt_pk_bf16(a[0], a[1]); wp[1] = cvt_pk_bf16(a[2], a[3]); *(f32x2*)((bf16_t*)out + o) = w; continue; }
                        if (MODE == 0) r = *(const f32x4*)(aux + o) * alpha + a;
                        else if (MODE == 3) { const f32x2 tw = *(const f32x2*)((const bf16_t*)aux + o); const unsigned* tp = (const unsigned*)&tw; f32x2 w; unsigned* wp = (unsigned*)&w;
                            wp[0] = cvt_pk_bf16(sigm(a[0] * dsc) * bflo(tp[0]), sigm(a[1] * dsc) * bfhi(tp[0])); wp[1] = cvt_pk_bf16(sigm(a[2] * dsc) * bflo(tp[1]), sigm(a[3] * dsc) * bfhi(tp[1])); *(f32x2*)((bf16_t*)out + o) = w; continue; }
                        else { const f32x2 tw = *(const f32x2*)((const bf16_t*)aux + o); const unsigned* tp = (const unsigned*)&tw; const f32x4 t = {bflo(tp[0]), bfhi(tp[0]), bflo(tp[1]), bfhi(tp[1])}; const f32x4 b = *(const f32x4*)(out + o); r = b * alpha;
#pragma unroll
                            for (int i = 0; i < 4; ++i) r[i] += sigm(a[i] * dsc) * t[i]; }
                        *(f32x4*)(out + o) = r; }
                  if (MODE == 2) asm volatile("" ::: "memory"); }
                if (m & 1) asm volatile("" ::: "memory"); }
    }
};
template <bool F8> struct EpiUp {
    static constexpr bool PERM = true;
    void* HB; const float* bup; float dsc; int pad;
    __device__ __forceinline__ void operator()(const Acc& acc, const Unit& u, int wr, int wc, int fr_, int fq_, PG8_LAS unsigned char* lds, int) const {
        int fr = fr_, fq = fq_; asm volatile("" : "+v"(fr), "+v"(fq));
        const PG8_LAS int* row0t = (const PG8_LAS int*)(lds + TAB_ROW0); const int srow = row0t[u.e] + u.pm * BM;
        const int c0 = u.pn * HALF + wc * 32 + 8 * fq; const float* bp = bup + (size_t)u.e * 2048 + c0;
        const f32x4 bg0 = *(const f32x4*)(bp), bg1 = *(const f32x4*)(bp + 4), bl0 = *(const f32x4*)(bp + 1024), bl1 = *(const f32x4*)(bp + 1028);
#pragma unroll
        for (int ai = 0; ai < 2; ++ai)
#pragma unroll
            for (int m = 0; m < 4; ++m) { const int r = ai * HALF + wr * 64 + m * 16 + fr;
                f32x4 g0 = acc[ai][0][m][0] * dsc + bg0, g1 = acc[ai][0][m][1] * dsc + bg1, l0 = acc[ai][1][m][0] * dsc + bl0, l1 = acc[ai][1][m][1] * dsc + bl1;
#pragma unroll
                for (int i = 0; i < 4; ++i) { float a = fminf(g0[i], 7.f), b = fminf(fmaxf(l0[i], -7.f), 7.f); g0[i] = a * sigm(1.702f * a) * (b + 1.f);
                                              a = fminf(g1[i], 7.f); b = fminf(fmaxf(l1[i], -7.f), 7.f); g1[i] = a * sigm(1.702f * a) * (b + 1.f); }
                if (r < u.nvalid) {
                    if (F8) { f32x2 w; unsigned* wp = (unsigned*)&w; wp[0] = pk4_fp8(g0[0], g0[1], g0[2], g0[3]); wp[1] = pk4_fp8(g1[0], g1[1], g1[2], g1[3]); *(f32x2*)((unsigned char*)HB + (size_t)(srow + r) * 1024 + c0) = w; }
                    else *(u32x4*)((bf16_t*)HB + (size_t)(srow + r) * 1024 + c0) = pack8(g0, g1); } }
    }
};
struct EpiDown {
    static constexpr bool PERM = true;
    bf16_t* YS0; bf16_t* YS1; bf16_t* YS2; bf16_t* YS3; const float* bdn; float dsc; int pad;
    __device__ __forceinline__ void operator()(const Acc& acc, const Unit& u, int wr, int wc, int fr_, int fq_, PG8_LAS unsigned char* lds, int buf) const {
        int fr = fr_, fq = fq_; asm volatile("" : "+v"(fr), "+v"(fq));
        const PG8_LAS int* ids = (const PG8_LAS int*)(lds + TAB_IDS) + buf * 256; const PG8_LAS float* gates = (const PG8_LAS float*)(lds + TAB_GATES) + buf * 256;
        const int col0 = u.pn * BM + wc * 32 + 8 * fq; const float* bp = bdn + (size_t)u.e * 1024 + col0;
        f32x4 bv[2][2];
#pragma unroll
        for (int bj = 0; bj < 2; ++bj)
#pragma unroll
            for (int n = 0; n < 2; ++n) bv[bj][n] = *(const f32x4*)(bp + bj * HALF + 4 * n);
#pragma unroll
        for (int ai = 0; ai < 2; ++ai)
#pragma unroll
            for (int m = 0; m < 4; ++m) { const int r = ai * HALF + wr * 64 + m * 16 + fr;
                if (r < u.nvalid) { const int a = ids[r]; const float gt = gates[r]; const int k = a & 3; const size_t o = (size_t)(a >> 2) * 1024 + col0;
#pragma unroll
                    for (int bj = 0; bj < 2; ++bj) { const f32x4 v0 = (acc[ai][bj][m][0] * dsc + bv[bj][0]) * gt, v1 = (acc[ai][bj][m][1] * dsc + bv[bj][1]) * gt; const size_t oo = o + bj * HALF;
                        bf16_t* yp = k == 0 ? YS0 : k == 1 ? YS1 : k == 2 ? YS2 : YS3; *(u32x4*)(yp + oo) = pack8(v0, v1); } } }
    }
};

template <class Epi, class Sched>
__device__ __forceinline__ void gemm_phase(PG8_LAS unsigned char* lds, const int wid, const Gemm g, const Sched& S, const Epi& E) {
    int lane = lane_id(); asm volatile("" : "+v"(lane));
    const int tid = wid * 64 + lane, wr = wid >> 2, wc = wid & 3, fr = lane & 15, fq = lane >> 4;
    const int K = g.K, nt = K / BK;
    int RA[2], CA[2]; unsigned voffA[2], voffB[2];
#pragma unroll
    for (int i = 0; i < 2; ++i) { int R, C; stage_rc(tid * 16 + i * 8192, R, C); const int Rb = Epi::PERM ? ((R & ~31) + perm32(R & 31)) : R; RA[i] = R; CA[i] = C; voffA[i] = (unsigned)(R * K + C) * 2u; voffB[i] = (unsigned)(Rb * K + C) * 2u; }
    const size_t tstep = (size_t)BM * K * 2;
    const size_t kstep = (size_t)(BK * 2);
    const size_t hstep = (size_t)HALF * K * 2;
    const unsigned ldsw = (unsigned)wid * 1024u;
    const int aoff = lds_byte(wr * 64 + fr, fq * 8), boff = lds_byte(wc * 32 + fr, fq * 8);
#define PG8_SA(b, h) (((b) * 2 + (h)) * HTB)
#define PG8_SB(b, h) ((4 + (b) * 2 + (h)) * HTB)
#define PG8_STAGE(bufoff, gbase, voff) do { _Pragma("unroll") for (int _i = 0; _i < 2; ++_i) \
        __builtin_amdgcn_global_load_lds((const unsigned*)((const char*)(gbase) + (voff)[_i]), (PG8_LAS unsigned*)(lds + (bufoff) + ldsw + _i * 8192), 16, 0, 0); } while (0)
#define PG8_STAGE_A(bufoff, ubase, h, OFF) do { if constexpr (Sched::TABLES) PG8_STAGE(bufoff, ubase, OFF[h]); else PG8_STAGE(bufoff, (ubase) + ((h) ? hstep : 0), voffA); } while (0)
#define PG8_LDA(dst, b, h) do { _Pragma("unroll") for (int m = 0; m < 4; ++m) { if constexpr (Sched::FP8) dst##8[m] = __builtin_shufflevector(*(const PG8_LAS i32x4*)(lds + PG8_SA(b, h) + aoff + m * 2048), *(const PG8_LAS i32x4*)(lds + PG8_SA(b, h) + aoff + m * 2048 + 1024), 0, 1, 2, 3, 4, 5, 6, 7); \
        else { _Pragma("unroll") for (int k = 0; k < 2; ++k) dst[m][k] = *(const PG8_LAS bf16x8*)(lds + PG8_SA(b, h) + aoff + m * 2048 + k * 1024); } } } while (0)
#define PG8_LDB(dst, b, h) do { _Pragma("unroll") for (int n = 0; n < 2; ++n) { if constexpr (Sched::FP8) dst##8[n] = __builtin_shufflevector(*(const PG8_LAS i32x4*)(lds + PG8_SB(b, h) + boff + n * 2048), *(const PG8_LAS i32x4*)(lds + PG8_SB(b, h) + boff + n * 2048 + 1024), 0, 1, 2, 3, 4, 5, 6, 7); \
        else { _Pragma("unroll") for (int k = 0; k < 2; ++k) dst[n][k] = *(const PG8_LAS bf16x8*)(lds + PG8_SB(b, h) + boff + n * 2048 + k * 1024); } } } while (0)
#define PG8_MMA(ai, bj, At, Bt) do { __builtin_amdgcn_s_setprio(1); if constexpr (Sched::FP8) asm volatile("s_nop 1"); _Pragma("unroll") for (int m = 0; m < 4; ++m) _Pragma("unroll") for (int n = 0; n < 2; ++n) { \
        if constexpr (Sched::FP8) asm volatile("v_mfma_f32_16x16x128_f8f6f4 %0, %1, %2, %0" : "+v"(acc[ai][bj][m][n]) : "v"(Bt##8[n]), "v"(At##8[m]));   \
        else { _Pragma("unroll") for (int k = 0; k < 2; ++k) acc[ai][bj][m][n] = __builtin_amdgcn_mfma_f32_16x16x32_bf16(Bt[n][k], At[m][k], acc[ai][bj][m][n], 0, 0, 0); } } __builtin_amdgcn_s_setprio(0); } while (0)
#define PG8_WAIT_V(n) asm volatile("s_waitcnt vmcnt(" #n ")" ::: "memory")
#define PG8_WAIT_L(n) asm volatile("s_waitcnt lgkmcnt(" #n ")" ::: "memory")
#define PG8_BAR __builtin_amdgcn_s_barrier()
#define PG8_SCHED __builtin_amdgcn_sched_barrier(0)
    Unit cur, nxt; int ui = 0;
    if (!S.next(0, cur, lds)) return;
    if constexpr (Sched::TABLES) {
        if (wid == 0) S.issue_tables(cur, lds, 0, lane);
        PG8_WAIT_V(0); PG8_BAR;
    }
    Acc acc;
#pragma unroll
    for (int a = 0; a < 2; ++a)
#pragma unroll
        for (int b = 0; b < 2; ++b)
#pragma unroll
            for (int m = 0; m < 4; ++m)
#pragma unroll
                for (int n = 0; n < 2; ++n) acc[a][b][m][n] = (f32x4){0.f, 0.f, 0.f, 0.f};
    bf16x8 At[4][2], B0[2][2], B1[2][2];
    i32x8 At8[4], B08[2], B18[2];
    unsigned offc[2][2], offn[2][2];
    if constexpr (Sched::TABLES) { S.a_offsets(g, cur, lds, 0, RA, CA, offc);
#pragma unroll
        for (int h = 0; h < 2; ++h)
#pragma unroll
            for (int i = 0; i < 2; ++i) offn[h][i] = offc[h][i]; }
    const char* const Ab = (const char*)g.A;
    const char* cA = Sched::TABLES ? Ab : Ab + (size_t)cur.pm * tstep;
    const char* cB = S.b_tile(g, cur);
    PG8_STAGE(PG8_SB(0, 0), cB, voffB); PG8_STAGE(PG8_SB(0, 1), cB + hstep, voffB); PG8_STAGE_A(PG8_SA(0, 0), cA, 0, offc); PG8_STAGE_A(PG8_SA(0, 1), cA, 1, offc);
    if (wr == 1) PG8_BAR;
    PG8_WAIT_V(2); PG8_BAR;
    PG8_STAGE(PG8_SB(1, 0), cB + kstep, voffB); PG8_STAGE_A(PG8_SA(1, 0), cA + kstep, 0, offc); PG8_STAGE(PG8_SB(1, 1), cB + hstep + kstep, voffB);
    PG8_WAIT_V(6); PG8_BAR;
    for (;;) {
        const bool has_next = S.next(ui + 1, nxt, lds);
        const char* nB = has_next ? S.b_tile(g, nxt) : cB;
        const char* nA = Sched::TABLES ? Ab : (has_next ? Ab + (size_t)nxt.pm * tstep : cA);
#pragma nounroll
        for (int t = 0; t < nt; t += 2) {
            const bool last = (t == nt - 2);
            if constexpr (has_mid<Epi>::value) { if (t == nt / 2) E.mid(acc, cur, wr, wc, fr, fq); }
            if constexpr (Sched::TABLES) {
                if (t == 2 && has_next && wid == 0) S.issue_tables(nxt, lds, (ui + 1) & 1, lane);
                if (t == (nt >= 16 ? nt - 6 : nt - 2) && has_next) S.a_offsets(g, nxt, lds, (ui + 1) & 1, RA, CA, offn);
            }
            unsigned o2[2][2];
            if constexpr (Sched::TABLES) {
#pragma unroll
                for (int h = 0; h < 2; ++h)
#pragma unroll
                    for (int i = 0; i < 2; ++i) o2[h][i] = last ? offn[h][i] : offc[h][i]; }
            const char* a1 = cA + (size_t)(t + 1) * kstep;
            const char* a2 = last ? nA : cA + (size_t)(t + 2) * kstep; const char* b2 = last ? nB : cB + (size_t)(t + 2) * kstep;
            const char* a3 = a2 + kstep; const char* b3 = b2 + kstep;
            PG8_LDB(B0, 0, 0); PG8_LDB(B1, 0, 1); PG8_SCHED; PG8_LDA(At, 0, 0); PG8_STAGE_A(PG8_SA(1, 1), a1, 1, offc);
            PG8_WAIT_V(8); PG8_WAIT_L(0); PG8_BAR; PG8_MMA(0, 0, At, B0); PG8_MMA(0, 1, At, B1); PG8_BAR; PG8_SCHED;
            PG8_LDA(At, 0, 1); PG8_STAGE(PG8_SB(0, 0), b2, voffB); PG8_STAGE(PG8_SB(0, 1), b2 + hstep, voffB); PG8_STAGE_A(PG8_SA(0, 0), a2, 0, o2);
            PG8_WAIT_V(8); PG8_WAIT_L(0); PG8_BAR; PG8_MMA(1, 0, At, B0); PG8_MMA(1, 1, At, B1); PG8_BAR; PG8_SCHED;
            PG8_LDB(B0, 1, 0); PG8_LDB(B1, 1, 1); PG8_SCHED; PG8_LDA(At, 1, 0); PG8_STAGE_A(PG8_SA(0, 1), a2, 1, o2);
            PG8_WAIT_V(8); PG8_WAIT_L(0); PG8_BAR; PG8_MMA(0, 0, At, B0); PG8_MMA(0, 1, At, B1); PG8_BAR; PG8_SCHED;
            PG8_LDA(At, 1, 1); PG8_STAGE(PG8_SB(1, 0), b3, voffB); PG8_STAGE(PG8_SB(1, 1), b3 + hstep, voffB); PG8_STAGE_A(PG8_SA(1, 0), a3, 0, o2);
            PG8_WAIT_V(8); PG8_WAIT_L(0); PG8_BAR; PG8_MMA(1, 0, At, B0); PG8_MMA(1, 1, At, B1); PG8_BAR; PG8_SCHED;
        }
        if (wr == 0) PG8_BAR;
        E(acc, cur, wr, wc, fr, fq, lds, ui & 1);
        if (!has_next) break;
#pragma unroll
        for (int a = 0; a < 2; ++a)
#pragma unroll
            for (int b = 0; b < 2; ++b)
#pragma unroll
                for (int m = 0; m < 4; ++m)
#pragma unroll
                    for (int n = 0; n < 2; ++n) acc[a][b][m][n] = (f32x4){0.f, 0.f, 0.f, 0.f};
        cur = nxt; cB = nB; cA = nA; ++ui;
        if constexpr (Sched::TABLES) {
#pragma unroll
            for (int h = 0; h < 2; ++h)
#pragma unroll
                for (int i = 0; i < 2; ++i) offc[h][i] = offn[h][i]; }
        if (wr == 1) PG8_BAR;
    }
    PG8_WAIT_V(0);
    PG8_BAR;
#undef PG8_SA
#undef PG8_SB
#undef PG8_STAGE
#undef PG8_STAGE_A
#undef PG8_LDA
#undef PG8_LDB
#undef PG8_MMA
#undef PG8_WAIT_V
#undef PG8_WAIT_L
#undef PG8_BAR
#undef PG8_SCHED
}
}
namespace attn_body {
using bf16=__hip_bfloat16;
using bf16x8=__attribute__((ext_vector_type(8)))short;
using s16x4=__attribute__((ext_vector_type(4)))short;
using f32x16=__attribute__((ext_vector_type(16)))float;
using u32x4=__attribute__((ext_vector_type(4)))unsigned;
constexpr int BATCH=16,SEQ=4096,D=64,DM=512,DMO=1024;
constexpr int NW=8,QBLK=32,QB=QBLK*NW,KVBLK=64,NQB=SEQ/QB;
constexpr int ATTN_UNIT_ROWS=QB;
__device__ __forceinline__ int crow(int r,int hi){return (r&3)+8*(r>>2)+4*hi;}
#define SBAR() __builtin_amdgcn_sched_barrier(0)
__device__ __forceinline__ void cmask(f32x16&p0,f32x16&p1,int jb,int qrel,int hi){
  const float NEG=-INFINITY; int kb=64*jb+4*hi; asm volatile("":"+v"(kb));
  #pragma unroll
  for(int r=0;r<16;++r){int kv=kb+(r&3)+8*(r>>2); if(kv>qrel)p0[r]=NEG; if(kv+32>qrel)p1[r]=NEG;}
}

constexpr int NSLOT=3, SLOTB=8192;
constexpr int LDS_K=0, LDS_V=NSLOT*SLOTB, LDS_WS=2*NSLOT*SLOTB, LDS_OST=LDS_WS+NW*64*4, LDS_BYTES=LDS_OST+NW*4096;
constexpr float C2=0.125f*1.4426950408889634f;
__device__ __forceinline__ void glds16(const void*gsrc,unsigned lds_dst){unsigned keep;
  asm volatile("s_mov_b32 %0, m0\n\ts_mov_b32 m0, %2\n\ts_nop 0\n\tglobal_load_lds_dwordx4 %1, off\n\ts_mov_b32 m0, %0":"=&s"(keep):"v"(gsrc),"s"(lds_dst):"memory");}
__device__ __forceinline__ float max3f(float a,float b,float c){float r;asm("v_max3_f32 %0, %1, %2, %3":"=v"(r):"v"(a),"v"(b),"v"(c));return r;}
__device__ __forceinline__ float max2f(float a,float b){float r;asm("v_max_f32_e32 %0, %1, %2":"=v"(r):"v"(a),"v"(b));return r;}
__device__ __forceinline__ float fadd_s(float a,float b){float r;asm("v_add_f32_e32 %0, %1, %2":"=v"(r):"v"(a),"v"(b));return r;}
__device__ __forceinline__ float fsub_s(float a,float b){float r;asm("v_sub_f32_e32 %0, %1, %2":"=v"(r):"v"(a),"v"(b));return r;}
typedef float f32x2_t __attribute__((ext_vector_type(2))); typedef __bf16 bf16x2_t __attribute__((ext_vector_type(2)));
__device__ __forceinline__ unsigned cvtpk_s(float lo,float hi){f32x2_t v={lo,hi};bf16x2_t b=__builtin_convertvector(v,bf16x2_t);return __builtin_bit_cast(unsigned,b);}
#define WAIT_BAR(N) asm volatile("s_waitcnt vmcnt(" #N ") lgkmcnt(0)\n\ts_barrier":::"memory")

__device__ __forceinline__ void qkt(f32x16&p0,f32x16&p1,const char*Kslot,const bf16x8*qr,const f32x16&i0,const f32x16&i1,int r32,int hi){
  const char*kb=Kslot+hi*1024+r32*16;
  #pragma unroll
  for(int d0=0;d0<4;++d0){
    const bf16x8 b0=*reinterpret_cast<const bf16x8*>(kb+d0*2048);
    const bf16x8 b1=*reinterpret_cast<const bf16x8*>(kb+d0*2048+512);
    if(d0==0){p0=__builtin_amdgcn_mfma_f32_32x32x16_bf16(b0,qr[0],i0,0,0,0);p1=__builtin_amdgcn_mfma_f32_32x32x16_bf16(b1,qr[0],i1,0,0,0);}
    else{p0=__builtin_amdgcn_mfma_f32_32x32x16_bf16(b0,qr[d0],p0,0,0,0);p1=__builtin_amdgcn_mfma_f32_32x32x16_bf16(b1,qr[d0],p1,0,0,0);}}
}
typedef __attribute__((address_space(3))) const char* lds_cptr;
typedef short v4i16_t __attribute__((ext_vector_type(4)));
__device__ __forceinline__ void kload8(bf16x8*kf,lds_cptr kp){
  kf[0]=*(const __attribute__((address_space(3))) bf16x8*)(kp);      kf[1]=*(const __attribute__((address_space(3))) bf16x8*)(kp+512);
  kf[2]=*(const __attribute__((address_space(3))) bf16x8*)(kp+2048); kf[3]=*(const __attribute__((address_space(3))) bf16x8*)(kp+2560);
  kf[4]=*(const __attribute__((address_space(3))) bf16x8*)(kp+4096); kf[5]=*(const __attribute__((address_space(3))) bf16x8*)(kp+4608);
  kf[6]=*(const __attribute__((address_space(3))) bf16x8*)(kp+6144); kf[7]=*(const __attribute__((address_space(3))) bf16x8*)(kp+6656);
}
__device__ __forceinline__ void kload2(bf16x8*kf,lds_cptr kp,int j){ kf[2*j]=*(const __attribute__((address_space(3))) bf16x8*)(kp+j*2048); kf[2*j+1]=*(const __attribute__((address_space(3))) bf16x8*)(kp+j*2048+512); }
__device__ __forceinline__ s16x4 vtr(lds_cptr p){ return __builtin_bit_cast(s16x4,__builtin_amdgcn_ds_read_tr16_b64_v4i16((__attribute__((address_space(3))) v4i16_t*)p)); }
__device__ __forceinline__ float rowmax(const f32x16&p0,const f32x16&p1){
  float a=max3f(p0[0],p0[1],p1[0]),b=max3f(p0[2],p0[3],p1[1]);a=max3f(a,p1[2],p1[3]);
  #pragma unroll
  for(int r=4;r<16;r+=4){a=max3f(a,p0[r],p0[r+1]);b=max3f(b,p0[r+2],p0[r+3]);a=max3f(a,p1[r],p1[r+1]);b=max3f(b,p1[r+2],p1[r+3]);}
  const float m=max2f(a,b);
  auto rr=__builtin_amdgcn_permlane32_swap(__float_as_uint(m),__float_as_uint(m),false,false);
  return max2f(__uint_as_float(rr[0]),__uint_as_float(rr[1]));
}
__device__ __forceinline__ void pv(f32x16*o,int vb,bf16x8 pa0,bf16x8 pa1,bf16x8 pa2,bf16x8 pa3){
  #pragma unroll
  for(int d0=0;d0<2;++d0){s16x4 lo[4],hi[4];
    #pragma unroll
    for(int ks=0;ks<4;++ks){
      asm volatile("ds_read_b64_tr_b16 %0,%1 offset:%c2":"=&v"(lo[ks]):"v"(vb),"i"(d0*4096+ks*1024):"memory");
      asm volatile("ds_read_b64_tr_b16 %0,%1 offset:%c2":"=&v"(hi[ks]):"v"(vb),"i"(d0*4096+ks*1024+512):"memory");}
    asm volatile("s_waitcnt lgkmcnt(0)":::"memory");SBAR();
    #define PK(k) (bf16x8){lo[k][0],lo[k][1],lo[k][2],lo[k][3],hi[k][0],hi[k][1],hi[k][2],hi[k][3]}
    o[d0]=__builtin_amdgcn_mfma_f32_32x32x16_bf16(pa0,PK(0),o[d0],0,0,0);
    o[d0]=__builtin_amdgcn_mfma_f32_32x32x16_bf16(pa1,PK(1),o[d0],0,0,0);
    o[d0]=__builtin_amdgcn_mfma_f32_32x32x16_bf16(pa2,PK(2),o[d0],0,0,0);
    o[d0]=__builtin_amdgcn_mfma_f32_32x32x16_bf16(pa3,PK(3),o[d0],0,0,0);
    #undef PK
  }
}

#ifndef ATTN_STORE16
#define ATTN_STORE16(p,v) (*(u32x4*)(p)=(v))
#endif
template<int THRL> __device__ __forceinline__ void attn_unit(int b,int hm,int half,int qb,float cs,const int wid,const float*PN,const bf16*Q,const bf16*__restrict__ K,const bf16*__restrict__ V,bf16*O,char*shm){
  int lane=lane_id(); asm volatile("":"+v"(lane));
  const int r32=lane&31,hi=lane>>5;
  const long rowbase=(long)b*SEQ; const int q0=qb*QB;
  const int NTf=(q0+QB)/KVBLK;
  int t0=0; float uref=0.f;
  { const float*pq=PN+((b*8+hm)*64)*2, *pk=PN+16384+((b*8+hm)*64)*2; float qm=0.f,km=0.f;
    if(lane<4){const float*p_=pq+(4*qb+lane)*2; qm=p_[0]+p_[1];} if(lane<NTf){const float*p_=pk+lane*2; km=p_[0]+p_[1];}
    _Pragma("unroll") for(int o_=1;o_<64;o_<<=1){qm=__builtin_fmaxf(qm,__shfl_xor(qm,o_));km=__builtin_fmaxf(km,__shfl_xor(km,o_));}
    const float need=(ATT_SKIP+2.04f*__builtin_sqrtf(qm*km))/cs;
    const float tf=((float)(q0-63)-need)*(1.f/64.f); int tt=tf>0.f?(int)tf:0; tt&=~1; if(tt>NTf-4)tt=NTf-4; t0=__builtin_amdgcn_readfirstlane(tt); uref=1.02f*__builtin_sqrtf(qm*km); }
  const bf16*Qw=Q+(rowbase+q0+wid*QBLK)*DM+hm*D;
  const bf16*Kh=K+(rowbase+64*t0)*DM+hm*D,*Vh=V+(rowbase+64*t0)*DM+(hm>>1)*128+half*64;
  const unsigned lds0=(unsigned)(uintptr_t)shm;
  float*wsf=(float*)(shm+LDS_WS)+wid*64;
  const bf16*ksrc=Kh+(long)lane*DM+wid*8;
  const bf16*vsrc=Vh+(long)(16*(wid&3)+(lane>>2))*DM+(wid>>2)*32+(lane&3)*8;
  const unsigned kdst=lds0+LDS_K+wid*1024, vdst=lds0+LDS_V+wid*1024;
  #define DMA_K(t,slot) glds16(ksrc+(long)(t)*KVBLK*DM,(unsigned)__builtin_amdgcn_readfirstlane(kdst+(slot)))
  #define DMA_V(t,slot) glds16(vsrc+(long)(t)*KVBLK*DM,(unsigned)__builtin_amdgcn_readfirstlane(vdst+(slot)))
  const int vb0=(int)(lds0+LDS_V)+((lane>>4)&1)*32+(lane&3)*8+(4*hi+((lane&15)>>2))*64;
  const char*Kbase=shm+LDS_K; bf16x8 kf[8];
  const lds_cptr shm3=(lds_cptr)shm; const lds_cptr kp0=shm3+LDS_K+hi*1024+r32*16; const lds_cptr vp0=shm3+LDS_V+((lane>>4)&1)*32+(lane&3)*8+(4*hi+((lane&15)>>2))*64;
  const int NT=NTf-t0;
  DMA_K(0,0);DMA_V(0,0);DMA_K(1,SLOTB);
  bf16x8 qr[4];
  #pragma unroll
  for(int d0=0;d0<4;++d0)qr[d0]=*reinterpret_cast<const bf16x8*>(&Qw[(long)r32*DM+d0*16+hi*8]);
  float mhat=0.f,l_reg=0.f;f32x16 o[2];o[0]=f32x16{};o[1]=f32x16{};
  const int qrel=wid*QBLK+r32;
  float nb=-uref-cs*(float)(q0+qrel-4*hi-64*t0);
  const float cs8=__builtin_bit_cast(float,__builtin_amdgcn_readfirstlane(__builtin_bit_cast(int,8.f*cs)));
  #define CINIT1(C,t,X) do{ C[0]=nb+cs*(float)(64*(t)+(X)); C[1]=C[0]+cs; C[2]=C[1]+cs; C[3]=C[2]+cs; _Pragma("unroll") for(int r=4;r<16;++r) C[r]=C[r-4]+cs8; asm volatile("":"+v"(C)); }while(0)
  #define CINIT(C0,C1,t) do{ CINIT1(C0,t,0); CINIT1(C1,t,32); }while(0)
  #define CMASK(P0,P1,t) do{int jb_=(t)-(NT-4); if(jb_>=0)cmask(P0,P1,jb_,qrel,hi);}while(0)
  bool resc=false;
  #define START(P0,P1) do{ const float rm=rowmax(P0,P1); resc=false; \
    { const float dl=0.f; (void)rm; mhat=fadd_s(mhat,dl); nb=fsub_s(nb,dl);     \
      _Pragma("unroll") for(int r=0;r<16;++r){P0[r]=fsub_s(P0[r],dl);P1[r]=fsub_s(P1[r],dl);} } \
    _Pragma("unroll") for(int r=0;r<16;++r)P0[r]=__builtin_amdgcn_exp2f(P0[r]); }while(0)
  #define RESC() do{ if(resc){ asm volatile("s_waitcnt lgkmcnt(0)":::"memory"); \
      _Pragma("unroll") for(int d_=0;d_<2;++d_) _Pragma("unroll") for(int r=0;r<16;++r)o[d_][r]*=wsf[crow(r,hi)]; } }while(0)
  f32x16 pA0,pA1,pB0,pB1;
  int sl_prev=0,sl_cur=0,sl_next=SLOTB;
  #define ROT() do{sl_prev=sl_cur;sl_cur=sl_next;sl_next=(sl_next==(NSLOT-1)*SLOTB)?0:sl_next+SLOTB;}while(0)
  DMA_K(2,2*SLOTB);
  WAIT_BAR(3);
  { f32x16 i0_,i1_; CINIT(i0_,i1_,0); qkt(pA0,pA1,Kbase,qr,i0_,i1_,r32,hi); } asm volatile("s_nop 15\n\ts_nop 7":"+v"(pA0),"+v"(pA1));CMASK(pA0,pA1,0);
  START(pA0,pA1);
  _Pragma("unroll") for(int r=0;r<16;++r)pA1[r]=__builtin_amdgcn_exp2f(pA1[r]);
  WAIT_BAR(0);
  DMA_K(3,0);DMA_V(1,SLOTB);
  ROT();
  kload8(kf,kp0+sl_cur);
  WAIT_BAR(2);
  s16x4 vlo[8],vhi[8]; u32x4 pw0,pw1,pw2,pw3;
  #define PKW(P,B) cvtpk_s(P[B],P[B+1])
  #define PAF(k) __builtin_bit_cast(bf16x8,pw##k)
  #define VFR(i) (bf16x8){vlo[i][0],vlo[i][1],vlo[i][2],vlo[i][3],vhi[i][0],vhi[i][1],vhi[i][2],vhi[i][3]}
  #define PIN(x) asm volatile("":"+v"(x))
  #define MX3(a,b,c) __builtin_fmaxf(__builtin_fmaxf((a),(b)),(c))
  #define GAPA(MF,A0,A1,A2,A3,W0,W1,PW) do{ MF; sacc+=A0; sacc+=A1; sacc+=A2; sacc+=A3; PIN(sacc); W0; W1; PIN(PW); SBAR(); }while(0)
  #define EX(v) __builtin_amdgcn_exp2f(v)
  #define GAPB(MF,X,B) do{ MF; X[B]=EX(X[B]); X[B+1]=EX(X[B+1]); X[B+2]=EX(X[B+2]); X[B+3]=EX(X[B+3]); PIN(X); SBAR(); }while(0)
  #define VRD(i) do{ vlo[i]=vtr(vp_+(((i)>>2)*4096+((i)&3)*1024)); vhi[i]=vtr(vp_+(((i)>>2)*4096+((i)&3)*1024+512)); }while(0)
  #define KRD(G,j) do{ if(G){ kload2(kf,kp0+sl_next,j); SBAR(); } }while(0)
  #define STEP(C0,C1,P0,P1,t,GK,GV,GL) do{ SBAR(); \
    const lds_cptr vp_=vp0+sl_prev; \
    VRD(0); SBAR(); float sacc=(P0[0]+P0[1]); CINIT1(C0,t,0); SBAR(); \
    GAPA(C0=__builtin_amdgcn_mfma_f32_32x32x16_bf16(kf[0],qr[0],C0,0,0,0), P0[2],P0[3],P0[4],P0[5],     pw0[0]=PKW(P0,0), pw0[1]=PKW(P0,2), pw0); \
    VRD(4); SBAR(); CINIT1(C1,t,32); SBAR(); GAPA(C1=__builtin_amdgcn_mfma_f32_32x32x16_bf16(kf[1],qr[0],C1,0,0,0), P0[6],P0[7],P0[8],P0[9],     pw0[2]=PKW(P0,4), pw0[3]=PKW(P0,6), pw0); \
    VRD(1); SBAR(); GAPA(C0=__builtin_amdgcn_mfma_f32_32x32x16_bf16(kf[2],qr[1],C0,0,0,0),   P0[10],P0[11],P0[12],P0[13], pw1[0]=PKW(P0,8), pw1[1]=PKW(P0,10), pw1); \
    VRD(5); SBAR(); GAPA(C1=__builtin_amdgcn_mfma_f32_32x32x16_bf16(kf[3],qr[1],C1,0,0,0),   P0[14],P0[15],P1[0],P1[1],   pw1[2]=PKW(P0,12),pw1[3]=PKW(P0,14), pw1); \
    VRD(2); SBAR(); GAPA(C0=__builtin_amdgcn_mfma_f32_32x32x16_bf16(kf[4],qr[2],C0,0,0,0),   P1[2],P1[3],P1[4],P1[5],     pw2[0]=PKW(P1,0), pw2[1]=PKW(P1,2), pw2); \
    VRD(6); SBAR(); GAPA(C1=__builtin_amdgcn_mfma_f32_32x32x16_bf16(kf[5],qr[2],C1,0,0,0),   P1[6],P1[7],P1[8],P1[9],     pw2[2]=PKW(P1,4), pw2[3]=PKW(P1,6), pw2); \
    VRD(3); SBAR(); GAPA(C0=__builtin_amdgcn_mfma_f32_32x32x16_bf16(kf[6],qr[3],C0,0,0,0),   P1[10],P1[11],P1[12],P1[13], pw3[0]=PKW(P1,8), pw3[1]=PKW(P1,10), pw3); \
    VRD(7); SBAR(); GAPA(C1=__builtin_amdgcn_mfma_f32_32x32x16_bf16(kf[7],qr[3],C1,0,0,0),   P1[14],P1[15],0.f,0.f,       pw3[2]=PKW(P1,12),pw3[3]=PKW(P1,14), pw3); \
    l_reg+=sacc; \
    if(GK){DMA_K((t)+3,sl_cur);} if(GV){DMA_V((t)+1,sl_next);} \
    CMASK(C0,C1,t); \
    { float a=MX3(C0[0],C0[1],C1[0]),b=MX3(C0[2],C0[3],C1[1]); a=MX3(a,C1[2],C1[3]); \
      _Pragma("unroll") for(int r=4;r<16;r+=4){a=MX3(a,C0[r],C0[r+1]);b=MX3(b,C0[r+2],C0[r+3]);a=MX3(a,C1[r],C1[r+1]);b=MX3(b,C1[r+2],C1[r+3]);} \
      float rm=__builtin_fmaxf(a,b); { auto rr=__builtin_amdgcn_permlane32_swap(__float_as_uint(rm),__float_as_uint(rm),false,false); rm=__builtin_fmaxf(__uint_as_float(rr[0]),__uint_as_float(rr[1])); } \
      resc=false; \
      if(__builtin_expect(__any(rm>(float)THRL),0)){ const float dl=__builtin_fmaxf(rm,0.f); mhat+=dl; nb-=dl; \
        _Pragma("unroll") for(int r=0;r<16;++r){C0[r]-=dl;C1[r]-=dl;} \
        const float f=__builtin_amdgcn_exp2f(-dl); l_reg*=f; if(hi==0)wsf[r32]=f; resc=true; } } \
    SBAR(); \
    GAPB(o[0]=__builtin_amdgcn_mfma_f32_32x32x16_bf16(PAF(0),VFR(0),o[0],0,0,0), C0,0); \
    GAPB(o[1]=__builtin_amdgcn_mfma_f32_32x32x16_bf16(PAF(0),VFR(4),o[1],0,0,0), C0,4); \
    KRD(GL,0); GAPB(o[0]=__builtin_amdgcn_mfma_f32_32x32x16_bf16(PAF(1),VFR(1),o[0],0,0,0), C0,8); \
    KRD(GL,1); GAPB(o[1]=__builtin_amdgcn_mfma_f32_32x32x16_bf16(PAF(1),VFR(5),o[1],0,0,0), C0,12); \
    KRD(GL,2); GAPB(o[0]=__builtin_amdgcn_mfma_f32_32x32x16_bf16(PAF(2),VFR(2),o[0],0,0,0), C1,0); \
    KRD(GL,3); GAPB(o[1]=__builtin_amdgcn_mfma_f32_32x32x16_bf16(PAF(2),VFR(6),o[1],0,0,0), C1,4); \
    GAPB(o[0]=__builtin_amdgcn_mfma_f32_32x32x16_bf16(PAF(3),VFR(3),o[0],0,0,0), C1,8); \
    GAPB(o[1]=__builtin_amdgcn_mfma_f32_32x32x16_bf16(PAF(3),VFR(7),o[1],0,0,0), C1,12); \
    }while(0)
  int t=1;
  #undef CMASK
  #define CMASK(P0,P1,t) do{}while(0)
  for(;t+5<NT;t+=2){
    STEP(pB0,pB1,pA0,pA1,t,true,true,true);     WAIT_BAR(2); RESC(); ROT();
    STEP(pA0,pA1,pB0,pB1,t+1,true,true,true);   WAIT_BAR(2); RESC(); ROT();
  }
  #undef CMASK
  #define CMASK(P0,P1,t) do{int jb_=(t)-(NT-4); if(jb_>=0)cmask(P0,P1,jb_,qrel,hi);}while(0)
  #define ENDW(tt) do{ if((tt)+3<NT){WAIT_BAR(2);} else if((tt)+2<NT){WAIT_BAR(1);} else {WAIT_BAR(0);} }while(0)
  for(;t+1<NT;t+=2){
    STEP(pB0,pB1,pA0,pA1,t,(t+3<NT),(t+1<NT),(t+1<NT));       ENDW(t);   RESC(); ROT();
    STEP(pA0,pA1,pB0,pB1,t+1,(t+4<NT),(t+2<NT),(t+2<NT));     ENDW(t+1); RESC(); ROT();
  }
  STEP(pB0,pB1,pA0,pA1,NT-1,false,false,false); RESC();
  { float sacc=pB0[0]+pB0[1]; _Pragma("unroll") for(int r=2;r<16;++r)sacc+=pB0[r]; _Pragma("unroll") for(int r=0;r<16;++r)sacc+=pB1[r]; l_reg+=sacc;
    pw0=(u32x4){PKW(pB0,0),PKW(pB0,2),PKW(pB0,4),PKW(pB0,6)};pw1=(u32x4){PKW(pB0,8),PKW(pB0,10),PKW(pB0,12),PKW(pB0,14)};pw2=(u32x4){PKW(pB1,0),PKW(pB1,2),PKW(pB1,4),PKW(pB1,6)};pw3=(u32x4){PKW(pB1,8),PKW(pB1,10),PKW(pB1,12),PKW(pB1,14)};
    SBAR(); pv(o,vb0+sl_cur,PAF(0),PAF(1),PAF(2),PAF(3)); }
  #undef PKW
  #undef PAF
  #undef VFR
  #undef PIN
  #undef MX3
  #undef GAPA
  #undef GAPB
  #undef EX
  #undef VRD
  #undef KRD
  #undef STEP
  #undef ENDW
  {auto rr=__builtin_amdgcn_permlane32_swap(__float_as_uint(l_reg),__float_as_uint(l_reg),false,false);l_reg=__uint_as_float(rr[0])+__uint_as_float(rr[1]);}
  if(hi==0)wsf[32+r32]=l_reg;asm volatile("s_waitcnt lgkmcnt(0)":::"memory");
  float rli[16];
  #pragma unroll
  for(int r=0;r<16;++r)rli[r]=__builtin_amdgcn_rcpf(wsf[32+crow(r,hi)]);
  bf16*Ow=O+(rowbase+q0+wid*QBLK)*DMO+(hm>>1)*256+(hm&1)*128+half*64;
  { bf16*stg=(bf16*)(shm+LDS_OST)+wid*2048;
    int eoff=hi*256+r32; asm volatile("":"+v"(eoff));
    #pragma unroll
    for(int r=0;r<16;++r){const int orow=(r&3)+8*(r>>2);
      #pragma unroll
      for(int d0=0;d0<2;++d0)stg[eoff+orow*64+d0*32]=__float2bfloat16(o[d0][r]*rli[r]);}
    asm volatile("s_waitcnt lgkmcnt(0)":::"memory");
    #pragma unroll
    for(int i=0;i<4;++i){const int row=i*8+(lane>>3),ch=lane&7; const u32x4 v=*(const u32x4*)(stg+row*64+ch*8); ATTN_STORE16(Ow+(long)row*DMO+ch*8,v);} }
  asm volatile("s_waitcnt lgkmcnt(0)\n\ts_barrier":::"memory");
  #undef DMA_K
  #undef DMA_V
  #undef CMASK
  #undef START
  #undef RESC
  #undef ROT
  #undef CINIT
  #undef CINIT1
}
constexpr int ATTN_LDS_BYTES=LDS_BYTES;
struct AttnTensors { const bf16* Q; const bf16* K; const bf16* V; bf16* O; const float* PN; unsigned* queue; };
__device__ __forceinline__ void unit_of(int u,int&b,int&vh,int&qb){ if(u<2048){qb=15-(u>>7);const int r=u&127;b=r>>3;vh=8+(r&7);} else if(u<3072){const int v=u-2048;qb=15-(v>>6);const int r=v&63;b=r>>2;vh=4+(r&3);} else {const int v=u-3072;qb=15-(v>>6);const int r=v&63;b=r>>2;vh=r&3;} }
template<int THRL=8> __device__ __forceinline__ void attn_phase(char*lds,const AttnTensors&T,const int wid){
  volatile __attribute__((address_space(3))) int* slot=(volatile __attribute__((address_space(3))) int*)(lds+LDS_BYTES);
  const bool lead=(wid==0)&&(lane_id()==0);
  if(lead) *slot=(int)__hip_atomic_fetch_add(T.queue,1u,__ATOMIC_RELAXED,__HIP_MEMORY_SCOPE_AGENT);
  asm volatile("s_waitcnt vmcnt(0) lgkmcnt(0)\n\ts_barrier":::"memory");
  int cur=__builtin_amdgcn_readfirstlane(*slot);
  asm volatile("s_waitcnt lgkmcnt(0)\n\ts_barrier":::"memory");
  while(cur<BATCH*16*NQB){
    int nxt=0; if(lead) nxt=(int)__hip_atomic_fetch_add(T.queue,1u,__ATOMIC_RELAXED,__HIP_MEMORY_SCOPE_AGENT);
    int b,vh,qb; unit_of(cur,b,vh,qb); const int hm=vh>>1,half=vh&1;
    const float cs=__builtin_bit_cast(float,__builtin_amdgcn_readfirstlane(__builtin_bit_cast(int,__builtin_amdgcn_exp2f(-2.f*(float)((hm>>1)+1))*1.4426950408889634f)));
    attn_unit<THRL>(b,hm,half,qb,cs,wid,T.PN,T.Q,T.K,T.V,T.O,lds);
    if(lead) *slot=nxt;
    asm volatile("s_waitcnt vmcnt(0) lgkmcnt(0)\n\ts_barrier":::"memory");
    cur=__builtin_amdgcn_readfirstlane(*slot);
    asm volatile("s_waitcnt lgkmcnt(0)\n\ts_barrier":::"memory");
  }
}
#undef SBAR
#undef WAIT_BAR
}
constexpr int NWAVES = 8;
constexpr int RING_OFF = 0, RING_BYTES = 131072;
constexpr int LDSCTL_OFF = RING_BYTES, MISC_OFF = LDSCTL_OFF + 320;
constexpr int LDS_BYTES = 163840;

#define XB_TMO      128
#define XB_XCNT(j)  (256  + 64 * (j))
#define XB_XSUB(j)  (1280 + 64 * (j))
#define XB_XGEN(j)  (2304 + 64 * (j))
#define XB_TOP      3328
#define XB_TOPGEN   3392
#define XCD_BAR_WORDS 3456
#define XB_SPIN_CAP (1u << 18)
__device__ __forceinline__ unsigned xb_ld(unsigned* p)              { return __hip_atomic_load(p, __ATOMIC_RELAXED, __HIP_MEMORY_SCOPE_AGENT); }
__device__ __forceinline__ unsigned xb_add(unsigned* p, unsigned v) { return __hip_atomic_fetch_add(p, v, __ATOMIC_RELAXED, __HIP_MEMORY_SCOPE_AGENT); }
__device__ __forceinline__ unsigned xb_xcc_id() { return (unsigned)__builtin_amdgcn_s_getreg((3 << 11) | 20) & 0xFu; }
#define XB_SPIN(cond, bar) do { unsigned _sp = 0; while (cond) { __builtin_amdgcn_s_sleep(1); \
    if ((++_sp & 255u) == 0u) { if (xb_ld(&(bar)[XB_TMO])) break; if (_sp > XB_SPIN_CAP) { atomicAdd(&(bar)[XB_TMO], 1u); break; } } } } while (0)
struct XcdBarrier { unsigned* bar; unsigned x; volatile LAS unsigned* st; bool wave0; };
__device__ __forceinline__ XcdBarrier xcd_barrier_post(unsigned* bar, volatile LAS unsigned* st) {
    XcdBarrier b; b.bar = bar; b.x = xb_xcc_id(); b.st = st; b.wave0 = __builtin_amdgcn_readfirstlane(threadIdx.x >> 6) == 0;
    if (threadIdx.x == 0) (void)xb_add(&bar[XB_XCNT(b.x)], 1u);
    return b;
}
__device__ __forceinline__ void xcd_barrier_complete(unsigned* bar, unsigned x, unsigned& nloc, unsigned& nx) {
    const unsigned G = gridDim.x * gridDim.y * gridDim.z;
    unsigned sum, cnt, mine, sp = 0u;
    for (;;) {
        sum = 0u; cnt = 0u; mine = 0u;
#pragma unroll
        for (unsigned j = 0; j < 16; ++j) { const unsigned c = xb_ld(&bar[XB_XCNT(j)]); sum += c; cnt += (c > 0u) ? 1u : 0u; mine = (j == x) ? c : mine; }
        if (sum == G) break;
        __builtin_amdgcn_s_sleep(1);
        if ((++sp & 255u) == 0u) { if (xb_ld(&bar[XB_TMO])) break; if (sp > XB_SPIN_CAP) { atomicAdd(&bar[XB_TMO], 1u); break; } }
    }
    nloc = mine > 0u ? mine : 1u; nx = cnt > 0u ? cnt : 1u;
}
__device__ __forceinline__ void xcd_barrier(const XcdBarrier& b) {
    asm volatile("s_waitcnt vmcnt(0)" ::: "memory");
    __syncthreads();
    if (b.wave0 && lane_id() == 0) {
        unsigned* bar = b.bar;
        __builtin_amdgcn_s_waitcnt(0);
        unsigned nloc = b.st[0], nx = b.st[1];
        if (nloc == 0u) { xcd_barrier_complete(bar, b.x, nloc, nx); b.st[0] = nloc; b.st[1] = nx; }
        const unsigned old = xb_add(&bar[XB_XSUB(b.x)], 1u);
        const unsigned gen = old / nloc;
        if (old + 1u == (gen + 1u) * nloc) {
            __builtin_amdgcn_fence(__ATOMIC_RELEASE, "agent");
            asm volatile("s_waitcnt vmcnt(0)" ::: "memory");
            const unsigned og = xb_add(&bar[XB_TOP], 1u);
            const unsigned tg = og / nx;
            if (og + 1u == (tg + 1u) * nx) xb_add(&bar[XB_TOPGEN], 1u);
            else XB_SPIN(xb_ld(&bar[XB_TOPGEN]) == tg, bar);
            __builtin_amdgcn_fence(__ATOMIC_ACQUIRE, "agent");
            xb_add(&bar[XB_XGEN(b.x)], 1u);
            asm volatile("s_waitcnt vmcnt(0)" ::: "memory");
        } else {
            XB_SPIN(xb_ld(&bar[XB_XGEN(b.x)]) == gen, bar);
            __builtin_amdgcn_fence(__ATOMIC_ACQUIRE, "agent");
            asm volatile("s_waitcnt vmcnt(0)" ::: "memory");
        }
    }
    __syncthreads();
}

struct Frame {
    LAS unsigned char* lds; volatile LAS unsigned* MISC; gu32* ctl;
    int tid, lane, wave, vcu, G;
};
__device__ __forceinline__ float bf2f_(unsigned short b) { return __builtin_bit_cast(float, (unsigned)b << 16); }
__device__ __forceinline__ float wave_sum(float v) {
#pragma unroll
    for (int o = 1; o < 64; o <<= 1) v += __shfl_xor(v, o);
    return v;
}
__device__ __forceinline__ void p0_transpose_item(const float* W, int ldw, int K, bf16* WT, int k0, int n0, int drow0, LAS float* scr, int lane) {
#pragma unroll 8
    for (int i = 0; i < 32; ++i) { const int kk = 2 * i + (lane >> 5); scr[kk * 33 + (lane & 31)] = W[(size_t)(k0 + kk) * ldw + n0 + (lane & 31)]; }
    LDS_WAIT(); asm volatile("" ::: "memory");
    const int c = lane & 7;
#pragma unroll
    for (int j = 0; j < 4; ++j) { const int n = (lane >> 3) + 8 * j; const LAS float* s = scr + (8 * c) * 33 + n;
        v4u o; o.x = pk2(s[0 * 33], s[1 * 33]); o.y = pk2(s[2 * 33], s[3 * 33]); o.z = pk2(s[4 * 33], s[5 * 33]); o.w = pk2(s[6 * 33], s[7 * 33]);
        *(GAS v4u*)(WT + (size_t)(drow0 + n) * K + k0 + 8 * c) = o; }
    LDS_WAIT(); asm volatile("" ::: "memory");
}
__device__ __forceinline__ void p0_transpose_item_f8(const float* W, int ldw, int K, unsigned char* WT, int k0, int n0, int drow0, float scale, LAS float* scr, int lane) {
#pragma unroll 8
    for (int i = 0; i < 32; ++i) { const int kk = 2 * i + (lane >> 5); scr[kk * 33 + (lane & 31)] = W[(size_t)(k0 + kk) * ldw + n0 + (lane & 31)] * scale; }
    LDS_WAIT(); asm volatile("" ::: "memory");
    const int c = lane & 3;
#pragma unroll
    for (int j = 0; j < 2; ++j) { const int n = (lane >> 2) + 16 * j; const LAS float* s = scr + (16 * c) * 33 + n;
        v4u o; o.x = pg8::pk4_fp8(s[0 * 33], s[1 * 33], s[2 * 33], s[3 * 33]); o.y = pg8::pk4_fp8(s[4 * 33], s[5 * 33], s[6 * 33], s[7 * 33]);
        o.z = pg8::pk4_fp8(s[8 * 33], s[9 * 33], s[10 * 33], s[11 * 33]); o.w = pg8::pk4_fp8(s[12 * 33], s[13 * 33], s[14 * 33], s[15 * 33]);
        *(GAS v4u*)(WT + (size_t)(drow0 + n) * K + k0 + 16 * c) = o; }
    LDS_WAIT(); asm volatile("" ::: "memory");
}
struct Ptrs {
    const float *x, *p, *w_in, *b_gate, *lq1, *lk1, *lq2, *lk2, *subln, *w_abr, *w_pmix, *pscale, *w_pbr, *w_out, *ln1g, *ln1b, *w_router, *b_router, *w_up, *b_up, *w_down, *b_down, *w_pg, *w_pp, *ln2g, *ln2b;
    float* out; unsigned char* ws;
};
__device__ __forceinline__ void ph0_prologue(Frame& F, const Ptrs& P) {
    unsigned char* ws = P.ws;
    LAS float* scr = (LAS float*)(F.lds + RING_OFF + F.wave * 16384);
    const int gw = F.vcu * NWAVES + F.wave, NGW = F.G * NWAVES;
    { const size_t n4 = (size_t)M * D / 4, st = (size_t)F.G * 512; const f32x4* src = (const f32x4*)P.x; unsigned long long* dst = (unsigned long long*)(ws + WS_XB);
      unsigned* dst8 = (unsigned*)(ws + WS_XF8);
      for (size_t i = (size_t)blockIdx.x * 512 + F.tid; i < n4; i += st) { const f32x4 v = src[i]; dst[i] = (unsigned long long)pk2(v.x, v.y) | ((unsigned long long)pk2(v.z, v.w) << 32);
          if (PROJ_F8_FROM < 16) dst8[i] = pg8::pk4_fp8(v.x, v.y, v.z, v.w); } }
    constexpr int I_IN = 16 * 128, I_A = 8 * 32, I_O = 16 * 32, I_PG = 16 * 32, I_PP = 4 * 32, I_UP1 = 16 * 64, I_DN1 = 16 * 32;
    constexpr int I_UP = NEXP * I_UP1, I_DN = NEXP * I_DN1, NITEMS = I_IN + I_A + I_O + I_PG + I_PP + I_UP + I_DN;
    for (int it = gw; it < NITEMS; it += NGW) {
        int r = it;
        if (r < I_IN) { const int nb = 128, n0 = 32 * (r % nb);
            if (n0 >= 256 * PROJ_F8_FROM) p0_transpose_item_f8(P.w_in, 4096, 1024, ws + WS_WIN8, 64 * (r / nb), n0, n0 - 256 * PROJ_F8_FROM, WUP_SCALE, scr, F.lane);
            else p0_transpose_item(P.w_in, 4096, 1024, (bf16*)(ws + WS_WIN), 64 * (r / nb), n0, n0, scr, F.lane); continue; } r -= I_IN;
        if (r < I_A) { const int nb = 32; p0_transpose_item(P.w_abr, 1024, 1024, (bf16*)(ws + WS_WCAT), 64 * (r / nb), 32 * (r % nb), 32 * (r % nb), scr, F.lane); continue; } r -= I_A;
        if (r < I_O) { const int nb = 32; p0_transpose_item(P.w_out, 1024, 1024, (bf16*)(ws + WS_WOUT), 64 * (r / nb), 32 * (r % nb), 32 * (r % nb), scr, F.lane); continue; } r -= I_O;
        if (r < I_PG) { const int nb = 32; if (MOE_FP8) p0_transpose_item_f8(P.w_pg, 1024, 1024, ws + WS_WPG, 64 * (r / nb), 32 * (r % nb), 32 * (r % nb), WUP_SCALE, scr, F.lane);
            else p0_transpose_item(P.w_pg, 1024, 1024, (bf16*)(ws + WS_WPG), 64 * (r / nb), 32 * (r % nb), 32 * (r % nb), scr, F.lane); continue; } r -= I_PG;
        if (r < I_PP) { const int nb = 32; p0_transpose_item(P.w_pp, 1024, 256, (bf16*)(ws + WS_WPP), 64 * (r / nb), 32 * (r % nb), 32 * (r % nb), scr, F.lane); continue; } r -= I_PP;
        if (r < I_UP) { const int e = r / I_UP1, q = r % I_UP1, nb = 64, n0 = 32 * (q % nb);
            const int bj = n0 >> 10, pn = (n0 & 1023) >> 7, cp = n0 & 127;
            if (MOE_FP8) p0_transpose_item_f8(P.w_up + (size_t)e * 1024 * 2048, 2048, 1024, ws + WS_WUP + (size_t)e * 2048 * 1024, 64 * (q / nb), n0, 256 * pn + 128 * bj + cp, WUP_SCALE, scr, F.lane);
            else p0_transpose_item(P.w_up + (size_t)e * 1024 * 2048, 2048, 1024, (bf16*)(ws + WS_WUP) + (size_t)e * 2048 * 1024, 64 * (q / nb), n0, 256 * pn + 128 * bj + cp, scr, F.lane);
            continue; } r -= I_UP;
        { const int e = r / I_DN1, q = r % I_DN1, nb = 32;
            if (MOE_FP8) p0_transpose_item_f8(P.w_down + (size_t)e * 1024 * 1024, 1024, 1024, ws + WS_WDN + (size_t)e * 1024 * 1024, 64 * (q / nb), 32 * (q % nb), 32 * (q % nb), WDN_SCALE, scr, F.lane);
            else p0_transpose_item(P.w_down + (size_t)e * 1024 * 1024, 1024, 1024, (bf16*)(ws + WS_WDN) + (size_t)e * 1024 * 1024, 64 * (q / nb), 32 * (q % nb), 32 * (q % nb), scr, F.lane); }
    }
    { bf16* WPC = (bf16*)(ws + WS_WCAT) + 512;
      for (int k = blockIdx.x; k < 512; k += F.G) { const int g = k >> 7;
          float a0 = 0.f, a1 = 0.f; const float* wm = P.w_pmix + (size_t)k * 128; const float* sc = P.pscale + g * 128; const float* wb = P.w_pbr + (size_t)(g * 128) * 1024;
          for (int d = 0; d < 128; ++d) { const float w = wm[d] * sc[d]; a0 += w * wb[(size_t)d * 1024 + F.tid]; a1 += w * wb[(size_t)d * 1024 + 512 + F.tid]; }
          WPC[(size_t)F.tid * 1024 + k] = (bf16)f2bf(a0); WPC[(size_t)(F.tid + 512) * 1024 + k] = (bf16)f2bf(a1); } }
}
__device__ __forceinline__ void ph_pool(Frame& F, const Ptrs& P) {
    const bf16* U = (const bf16*)(P.ws + WS_U); bf16* PO = (bf16*)(P.ws + WS_APO) + 512;
    const size_t nitem = (size_t)M * 64, st = (size_t)F.G * 512;
    for (size_t idx = (size_t)blockIdx.x * 512 + F.tid; idx < nitem; idx += st) {
        const size_t row = idx >> 6; const int cg = (int)(idx & 63), c0 = cg * 8, pos = (int)(row & (SEQ - 1)), w = 2 << (c0 >> 7), n = pos + 1 < w ? pos + 1 : w;
        float s[8] = {0.f, 0.f, 0.f, 0.f, 0.f, 0.f, 0.f, 0.f}; v4u cur = *(const v4u*)(U + row * 512 + c0);
        for (int k = 0; k < n; ++k) { const v4u v = k == 0 ? cur : *(const v4u*)(U + (row - k) * 512 + c0);
            s[0] += pg8::bflo(v.x); s[1] += pg8::bfhi(v.x); s[2] += pg8::bflo(v.y); s[3] += pg8::bfhi(v.y); s[4] += pg8::bflo(v.z); s[5] += pg8::bfhi(v.z); s[6] += pg8::bflo(v.w); s[7] += pg8::bfhi(v.w); }
        const float rn = 1.f / (float)n; v4u o;
        o.x = pk2(s[0] * rn - pg8::bflo(cur.x), s[1] * rn - pg8::bfhi(cur.x)); o.y = pk2(s[2] * rn - pg8::bflo(cur.y), s[3] * rn - pg8::bfhi(cur.y));
        o.z = pk2(s[4] * rn - pg8::bflo(cur.z), s[5] * rn - pg8::bfhi(cur.z)); o.w = pk2(s[6] * rn - pg8::bflo(cur.w), s[7] * rn - pg8::bfhi(cur.w));
        *(v4u*)(PO + row * 1024 + c0) = o;
    }
}
__device__ __forceinline__ float lam_value(const Ptrs& P) { float a = 0.f, b = 0.f; for (int d = 0; d < 64; ++d) { a += P.lq1[d] * P.lk1[d]; b += P.lq2[d] * P.lk2[d]; } return __expf(a) - __expf(b) + 0.2f; }
__device__ __forceinline__ void ph_combine(Frame& F, const Ptrs& P) {
    const bf16* O16 = (const bf16*)(P.ws + WS_O16); bf16* OA = (bf16*)(P.ws + WS_APO); const float lam = lam_value(P);
    const int gw = F.vcu * NWAVES + F.wave, NGW = F.G * NWAVES, h = F.lane >> 4, e0 = (F.lane & 15) * 8;
    float sg[8];
#pragma unroll
    for (int j = 0; j < 8; ++j) sg[j] = P.subln[e0 + j] * 0.8f;
    for (int row = gw; row < M; row += NGW) {
        const v4u a = *(const v4u*)(O16 + (size_t)row * 1024 + h * 256 + e0), b = *(const v4u*)(O16 + (size_t)row * 1024 + h * 256 + 128 + e0);
        f32x4 a0, a1, b0, b1; pg8::unpack8(a, a0, a1); pg8::unpack8(b, b0, b1); a0 -= b0 * lam; a1 -= b1 * lam;
        float ss = (a0[0] * a0[0] + a0[1] * a0[1]) + (a0[2] * a0[2] + a0[3] * a0[3]) + (a1[0] * a1[0] + a1[1] * a1[1]) + (a1[2] * a1[2] + a1[3] * a1[3]);
        ss += __shfl_xor(ss, 1); ss += __shfl_xor(ss, 2); ss += __shfl_xor(ss, 4); ss += __shfl_xor(ss, 8);
        const float r = rsqrtf(ss * (1.f / 128.f) + LN_EPS);
#pragma unroll
        for (int j = 0; j < 4; ++j) { a0[j] *= r * sg[j]; a1[j] *= r * sg[4 + j]; }
        *(v4u*)(OA + (size_t)row * 1024 + h * 128 + e0) = pg8::pack8(a0, a1);
    }
}
__device__ __forceinline__ void ph6_ln1_route(Frame& F, const Ptrs& P, const bool dry) {
    unsigned char* ws = P.ws;
    const unsigned keep0 = F.MISC[8], keep1 = F.MISC[9];
    __syncthreads();
    { LAS f32x4* img = (LAS f32x4*)F.lds; const f32x4* src = (const f32x4*)P.w_router;
      for (int i = F.tid; i < 1024 * 8; i += 512) { const int k = i >> 3, q = i & 7; img[(k ^ ((k >> 3) & 1)) * 8 + q] = src[i]; } }
    { const size_t n4 = (size_t)M * PLE / 4, st = (size_t)F.G * 512; const f32x4* src = (const f32x4*)P.p; unsigned long long* dst = (unsigned long long*)(ws + (dry ? 804 * MiB : WS_PB));
      for (size_t i = (size_t)blockIdx.x * 512 + F.tid; i < n4; i += st) { const f32x4 v = src[i]; dst[i] = (unsigned long long)pk2(v.x, v.y) | ((unsigned long long)pk2(v.z, v.w) << 32); } }
    __syncthreads();
    const float* X1in = P.out; float* X1 = dry ? (float*)(ws + 356 * MiB) : P.out; bf16* X1B = (bf16*)(ws + (dry ? 612 * MiB : WS_X1B)); unsigned char* X1F8 = ws + (dry ? 740 * MiB : WS_X1F8);
    const int lane = F.lane, eg = lane & 7, ko = lane >> 3;
    LAS float* xrow = (LAS float*)(F.lds + 131072 + 4096 * F.wave);
    f32x4 gam[4], bet[4];
#pragma unroll
    for (int j = 0; j < 4; ++j) { gam[j] = ((const f32x4*)P.ln1g)[lane + 64 * j]; bet[j] = ((const f32x4*)P.ln1b)[lane + 64 * j]; }
    const f32x4 brt = ((const f32x4*)P.b_router)[eg];
    int my_e[4] = {0, 0, 0, 0}; float my_g[4] = {0.f, 0.f, 0.f, 0.f};
    for (int chunk = blockIdx.x; chunk < M / 256; chunk += F.G) {
        for (int i = 0; i < 32; ++i) {
            const int row = chunk * 256 + F.wave * 32 + i;
            f32x4 v[4]; float s = 0.f;
#pragma unroll
            for (int j = 0; j < 4; ++j) { v[j] = ((const f32x4*)(X1in + (size_t)row * 1024))[lane + 64 * j]; s += (v[j].x + v[j].y) + (v[j].z + v[j].w); }
            const float mean = wave_sum(s) * (1.f / 1024.f); float s2 = 0.f;
#pragma unroll
            for (int j = 0; j < 4; ++j) { v[j] = v[j] - mean; s2 += (v[j].x * v[j].x + v[j].y * v[j].y) + (v[j].z * v[j].z + v[j].w * v[j].w); }
            const float rstd = rsqrtf(wave_sum(s2) * (1.f / 1024.f) + LN_EPS);
#pragma unroll
            for (int j = 0; j < 4; ++j) { v[j] = v[j] * rstd * gam[j] + bet[j];
                ((f32x4*)(X1 + (size_t)row * 1024))[lane + 64 * j] = v[j];
                ((unsigned long long*)(X1B + (size_t)row * 1024))[lane + 64 * j] = (unsigned long long)pk2(v[j].x, v[j].y) | ((unsigned long long)pk2(v[j].z, v[j].w) << 32);
                if (MOE_FP8) ((unsigned*)(X1F8 + (size_t)row * 1024))[lane + 64 * j] = pg8::pk4_fp8(v[j].x, v[j].y, v[j].z, v[j].w);
                ((LAS f32x4*)xrow)[lane + 64 * j] = v[j]; }
            LDS_WAIT(); asm volatile("" ::: "memory");
            f32x4 acc = {0.f, 0.f, 0.f, 0.f};
#pragma unroll 4
            for (int sidx = 0; sidx < 32; ++sidx) { const f32x4 xv = ((const LAS f32x4*)xrow)[sidx * 8 + ko];
#pragma unroll
                for (int q = 0; q < 4; ++q) { const int k = 32 * sidx + 4 * ko + q; const f32x4 w = ((const LAS f32x4*)F.lds)[(k ^ ((k >> 3) & 1)) * 8 + eg]; acc += w * xv[q]; } }
#pragma unroll
            for (int q = 0; q < 4; ++q) { acc[q] += __shfl_xor(acc[q], 8); acc[q] += __shfl_xor(acc[q], 16); acc[q] += __shfl_xor(acc[q], 32); }
            acc += brt;
            float tv[4]; int ti[4];
#pragma unroll
            for (int r = 0; r < 4; ++r) { float bv = acc[0]; int bi = 4 * eg;
#pragma unroll
                for (int q = 1; q < 4; ++q) if (acc[q] > bv) { bv = acc[q]; bi = 4 * eg + q; }
#pragma unroll
                for (int o = 1; o < 8; o <<= 1) { const float ov = __shfl_xor(bv, o); const int oi = __shfl_xor(bi, o); if (ov > bv || (ov == bv && oi < bi)) { bv = ov; bi = oi; } }
                tv[r] = bv; ti[r] = bi;
#pragma unroll
                for (int q = 0; q < 4; ++q) if (bi == 4 * eg + q) acc[q] = -INFINITY; }
            const float e1 = __expf(tv[1] - tv[0]), e2 = __expf(tv[2] - tv[0]), e3 = __expf(tv[3] - tv[0]), rs = 1.f / (1.f + e1 + e2 + e3);
            if (lane == i) { my_e[0] = ti[0]; my_e[1] = ti[1]; my_e[2] = ti[2]; my_e[3] = ti[3]; my_g[0] = rs; my_g[1] = e1 * rs; my_g[2] = e2 * rs; my_g[3] = e3 * rs; }
        }
        __syncthreads();
        LAS int* cntl = (LAS int*)(F.lds + 131072); LAS int* basel = cntl + 32;
        if (F.tid < 32) cntl[F.tid] = 0;
        __syncthreads();
        int rk[4] = {0, 0, 0, 0};
        if (lane < 32) {
#pragma unroll
            for (int k = 0; k < 4; ++k) rk[k] = __hip_atomic_fetch_add(&cntl[my_e[k]], 1, __ATOMIC_RELAXED, __HIP_MEMORY_SCOPE_WORKGROUP); }
        __syncthreads();
        if (F.tid < 32) basel[F.tid] = (int)__hip_atomic_fetch_add(F.ctl + CW_CNT + (dry ? 32 : 0) + F.tid, (unsigned)cntl[F.tid], RLX_AGENT);
        __syncthreads();
        if (lane < 32) { const int row = chunk * 256 + F.wave * 32 + lane; int* LIST = (int*)(ws + (dry ? 836 * MiB : WS_LIST)); float* GATEL = (float*)(ws + (dry ? 844 * MiB : WS_GATEL)); float* GATE = (float*)(ws + (dry ? 852 * MiB : WS_GATE));
#pragma unroll
            for (int k = 0; k < 4; ++k) { const size_t o = (size_t)my_e[k] * 65536 + (size_t)(basel[my_e[k]] + rk[k]); LIST[o] = row * 4 + k; GATEL[o] = my_g[k]; GATE[row * 4 + k] = my_g[k]; } }
        __syncthreads();
    }
    if (F.tid == 0) { F.MISC[8] = keep0; F.MISC[9] = keep1; }
    __syncthreads();
}
__device__ __forceinline__ void ph10_final(Frame& F, const Ptrs& P, const bool dry) {
    float* dst = dry ? (float*)(P.ws + 356 * MiB) : P.out;
    const bf16* PLEB = (const bf16*)(P.ws + WS_PLE); const bf16* YS0 = (const bf16*)(P.ws + WS_YS0); const bf16* YS1 = (const bf16*)(P.ws + WS_YS1); const bf16* YS2 = (const bf16*)(P.ws + WS_YS2); const bf16* YS3 = (const bf16*)(P.ws + WS_YS3);
    const int gw = F.vcu * NWAVES + F.wave, NGW = F.G * NWAVES, lane = F.lane;
    f32x4 gam[4], bet[4];
#pragma unroll
    for (int j = 0; j < 4; ++j) { gam[j] = ((const f32x4*)P.ln2g)[lane + 64 * j]; bet[j] = ((const f32x4*)P.ln2b)[lane + 64 * j]; }
    for (int row = gw; row < M; row += NGW) {
        f32x4 v[4]; float s = 0.f;
#pragma unroll
        for (int j = 0; j < 4; ++j) { const size_t o = (size_t)row * 256 + lane + 64 * j; v[j] = ((const f32x4*)P.out)[o] * ALPHA;
            { const unsigned long long e = ((const unsigned long long*)PLEB)[o]; const unsigned e0 = (unsigned)e, e1 = (unsigned)(e >> 32); v[j].x += pg8::bflo(e0); v[j].y += pg8::bfhi(e0); v[j].z += pg8::bflo(e1); v[j].w += pg8::bfhi(e1); }
            const unsigned long long a = ((const unsigned long long*)YS1)[o], b = ((const unsigned long long*)YS2)[o], c = ((const unsigned long long*)YS3)[o], d = ((const unsigned long long*)YS0)[o];
            const unsigned a0 = (unsigned)a, a1 = (unsigned)(a >> 32), b0 = (unsigned)b, b1 = (unsigned)(b >> 32), c0 = (unsigned)c, c1 = (unsigned)(c >> 32), d0 = (unsigned)d, d1 = (unsigned)(d >> 32);
            v[j].x += (pg8::bflo(d0) + pg8::bflo(a0)) + (pg8::bflo(b0) + pg8::bflo(c0)); v[j].y += (pg8::bfhi(d0) + pg8::bfhi(a0)) + (pg8::bfhi(b0) + pg8::bfhi(c0));
            v[j].z += (pg8::bflo(d1) + pg8::bflo(a1)) + (pg8::bflo(b1) + pg8::bflo(c1)); v[j].w += (pg8::bfhi(d1) + pg8::bfhi(a1)) + (pg8::bfhi(b1) + pg8::bfhi(c1));
            s += (v[j].x + v[j].y) + (v[j].z + v[j].w); }
        const float mean = wave_sum(s) * (1.f / 1024.f); float s2 = 0.f;
#pragma unroll
        for (int j = 0; j < 4; ++j) { v[j] = v[j] - mean; s2 += (v[j].x * v[j].x + v[j].y * v[j].y) + (v[j].z * v[j].z + v[j].w * v[j].w); }
        const float rstd = rsqrtf(wave_sum(s2) * (1.f / 1024.f) + LN_EPS);
#pragma unroll
        for (int j = 0; j < 4; ++j) ((f32x4*)dst)[(size_t)row * 256 + lane + 64 * j] = v[j] * rstd * gam[j] + bet[j];
    }
}
__device__ __forceinline__ void moe_tables(Frame& F) {
    LAS int* cnt = (LAS int*)(F.lds + pg8::TAB_CNT); LAS int* blk0 = (LAS int*)(F.lds + pg8::TAB_BLK0); LAS int* row0 = (LAS int*)(F.lds + pg8::TAB_ROW0);
    __syncthreads();
    if (F.tid < 32) cnt[F.tid] = (int)__hip_atomic_load(F.ctl + CW_CNT + F.tid, RLX_AGENT);
    __syncthreads();
    if (F.tid == 0) { int b = 0, r = 0; for (int e = 0; e < 32; ++e) { blk0[e] = b; row0[e] = r; b += (cnt[e] + 255) >> 8; r += cnt[e]; } blk0[32] = b; row0[32] = r; }
    __syncthreads();
}

constexpr int NPHASE = 11;
struct Args { Ptrs P; int ph_lo, ph_hi; };
__global__ void __launch_bounds__(NWAVES * 64, 2) mk_fwd(Args args) {
    extern __shared__ __attribute__((aligned(16))) unsigned char lds[];
    Frame F; const Ptrs& P = args.P;
    F.lds = (LAS unsigned char*)lds; F.MISC = (volatile LAS unsigned*)(F.lds + MISC_OFF);
    F.wave = __builtin_amdgcn_readfirstlane(threadIdx.x >> 6); F.lane = lane_id(); F.tid = F.wave * 64 + F.lane;
#define REFRESH() do { F.lane = lane_id(); asm volatile("" : "+v"(F.lane)); F.tid = F.wave * 64 + F.lane; } while (0)
    F.G = gridDim.x; { const int bx = blockIdx.x; F.vcu = (F.G % 8 == 0) ? (bx % 8) * (F.G / 8) + bx / 8 : bx; }
    unsigned char* ws = P.ws; F.ctl = (gu32*)(ws + WS_CTL);
    for (int u = F.tid; u < 1024 / 4; u += NWAVES * 64) ((LAS unsigned*)(F.lds + LDSCTL_OFF))[u] = 0u;
    __syncthreads();
    const int lo = args.ph_lo, hi = args.ph_hi;
    XcdBarrier bar = xcd_barrier_post((unsigned*)(F.ctl + CW_BAR) + lo * XCD_BAR_WORDS, F.MISC + 8);
#ifndef PH_COMPILE
#define PH_COMPILE 0x7ff
#endif
#define IN(k) ((((PH_COMPILE) >> (k)) & 1) && lo <= (k) && (k) < hi)
#define SEAM(k) do { if (IN(k) && IN((k) + 1)) xcd_barrier(bar); } while (0)
#ifndef REP2_MASK
#define REP2_MASK 0
#endif
#define REPS(k) for (int rep_ = 0; rep_ < ((((REP2_MASK) >> (k)) & 1) ? 2 : 1); ++rep_)
    bf16 *XB = (bf16*)(ws + WS_XB), *Q = (bf16*)(ws + WS_Q), *K = (bf16*)(ws + WS_K), *V = (bf16*)(ws + WS_V), *U = (bf16*)(ws + WS_U), *G = (bf16*)(ws + WS_G);
    bf16 *O16 = (bf16*)(ws + WS_O16), *APO = (bf16*)(ws + WS_APO), *MIX = (bf16*)(ws + WS_MIX), *X1B = (bf16*)(ws + WS_X1B), *HB = (bf16*)(ws + WS_HB), *PB = (bf16*)(ws + WS_PB);
    bf16* T = (bf16*)(ws + WS_T);

    if (IN(0)) REPS(0) { REFRESH(); ph0_prologue(F, P); } SEAM(0);
    if (IN(1)) REPS(1) {
        { pg8::Gemm g{XB, (const bf16*)(ws + WS_WIN), 1024}; pg8::StaticOrder S; S.init(M, 256 * (PROJ_F8_FROM < 16 ? PROJ_F8_FROM : 16), F.G, (int)blockIdx.x);
          pg8::EpiProj E{Q, K, V, U, G, P.b_gate, (float*)(F.ctl + CW_PN), C2Q, 1.f, 0, 0};
          pg8::gemm_phase(F.lds, F.wave, g, S, E); }
        if (PROJ_F8_FROM < 16) {
          pg8::Gemm g{(const bf16*)(ws + WS_XF8), (const bf16*)(ws + WS_WIN8), 512}; pg8::DenseF8Order S; S.init(M, 256 * (16 - PROJ_F8_FROM), F.G, (int)blockIdx.x);
          pg8::EpiProj E{Q, K, V, U, G, P.b_gate, (float*)(F.ctl + CW_PN), C2Q, 1.f / WUP_SCALE, PROJ_F8_FROM, 0};
          pg8::gemm_phase(F.lds, F.wave, g, S, E); }
    } SEAM(1);
    if (IN(2)) REPS(2) {
        const attn_body::AttnTensors AT{(const attn_body::bf16*)Q, (const attn_body::bf16*)K, (const attn_body::bf16*)V, (attn_body::bf16*)O16, (const float*)(F.ctl + CW_PN), (unsigned*)(F.ctl + CW_AQ)};
        attn_body::attn_phase<8>((char*)lds + RING_OFF, AT, F.wave);
#ifdef TIME_PH2
        { attn_body::AttnTensors AT2 = AT; AT2.queue = (unsigned*)(F.ctl + CW_AQ + 64); attn_body::attn_phase<8>((char*)lds + RING_OFF, AT2, F.wave); }
#endif
#ifndef NO_POOL
        REFRESH(); ph_pool(F, P);
#endif
    } SEAM(2);
    if (IN(3)) REPS(3) { REFRESH(); ph_combine(F, P); } SEAM(3);
    if (IN(4)) REPS(4) {
        pg8::StaticOrder S; S.init(M, 1024, F.G, (int)blockIdx.x);
        pg8::Gemm g{APO, (const bf16*)(ws + WS_WCAT), 1024}; pg8::EpiMixCat E{MIX, G}; pg8::gemm_phase(F.lds, F.wave, g, S, E);
    } SEAM(4);
    if (IN(5)) REPS(5) {
        pg8::Gemm g{MIX, (const bf16*)(ws + WS_WOUT), 1024}; pg8::StaticOrder S; S.init(M, 1024, F.G, (int)blockIdx.x);
        pg8::EpiF32<0> E{P.out, P.x, ALPHA, 1.f};
        pg8::gemm_phase(F.lds, F.wave, g, S, E);
    } SEAM(5);
#ifndef DRY_MASK
#define DRY_MASK 0
#endif
    if (IN(6)) { if ((DRY_MASK >> 6) & 1) { REFRESH(); ph6_ln1_route(F, P, true); } REFRESH(); ph6_ln1_route(F, P, false); } SEAM(6);
    if (IN(7)) {
        pg8::StaticOrder S; S.init(M, 1024, F.G, (int)blockIdx.x);
#ifndef NO_PH7A
        { pg8::Gemm g{PB, (const bf16*)(ws + WS_WPP), 256}; pg8::EpiF32<1> E{(float*)T, nullptr, 0.f, 1.f}; pg8::gemm_phase(F.lds, F.wave, g, S, E); }
#endif
        VM_WAIT(); __syncthreads();
#ifndef NO_PH7B
        if (MOE_FP8) { pg8::DenseF8Order S8; S8.init(M, 1024, F.G, (int)blockIdx.x);
            pg8::Gemm g{(const bf16*)(ws + WS_X1F8), (const bf16*)(ws + WS_WPG), 512}; pg8::EpiF32<3> E{(float*)(ws + WS_PLE), (const float*)T, ALPHA, 1.f / WUP_SCALE}; pg8::gemm_phase(F.lds, F.wave, g, S8, E); }
        else { pg8::Gemm g{X1B, (const bf16*)(ws + WS_WPG), 1024}; pg8::EpiF32<3> E{(float*)(ws + WS_PLE), (const float*)T, ALPHA, 1.f}; pg8::gemm_phase(F.lds, F.wave, g, S, E); }
#endif
    } SEAM(7);
    if (IN(8)) REPS(8) {
        REFRESH(); moe_tables(F);
        pg8::Gemm g{MOE_FP8 ? (const bf16*)(ws + WS_X1F8) : X1B, (const bf16*)(ws + WS_WUP), MOE_FP8 ? 512 : 1024};
        pg8::MoeOrder<true, MOE_FP8> S{8, F.G, (int)blockIdx.x, (const int*)(ws + WS_LIST), (const float*)(ws + WS_GATEL), (size_t)2048 * 1024 * (MOE_FP8 ? 1 : 2)};
        pg8::EpiUp<MOE_FP8> E{HB, P.b_up, MOE_FP8 ? 1.f / WUP_SCALE : 1.f, 0};
        pg8::gemm_phase(F.lds, F.wave, g, S, E);
    } SEAM(8);
    if (IN(9)) {
        REFRESH(); moe_tables(F);
        pg8::Gemm g{HB, (const bf16*)(ws + WS_WDN), MOE_FP8 ? 512 : 1024};
        pg8::MoeOrder<false, MOE_FP8> S{4, F.G, (int)blockIdx.x, (const int*)(ws + WS_LIST), (const float*)(ws + WS_GATEL), (size_t)1024 * 1024 * (MOE_FP8 ? 1 : 2)};
        pg8::EpiDown E{(bf16*)(ws + WS_YS0), (bf16*)(ws + WS_YS1), (bf16*)(ws + WS_YS2), (bf16*)(ws + WS_YS3), P.b_down, MOE_FP8 ? 1.f / (WDN_SCALE) : 1.f, 0};
        pg8::gemm_phase(F.lds, F.wave, g, S, E);
    } SEAM(9);
    if (IN(10)) { if ((DRY_MASK >> 10) & 1) { REFRESH(); ph10_final(F, P, true); } REFRESH(); ph10_final(F, P, false); }
#undef IN
#undef SEAM
}
#ifndef FAST_MASK
#define FAST_MASK 0x7ff
#endif
#ifndef MERGE_FAST
#define MERGE_FAST 1
#endif
extern "C" void kernel_launch(void* const* d_in, const int* in_sizes, int n_in, void* d_out, int out_size, void* d_ws, size_t ws_size, hipStream_t stream) {
    static int grid = 0;
    if (grid == 0) {
        if (n_in != 26 || ws_size < WS_END || out_size != M * D) { fprintf(stderr, "kernel_launch: unexpected shapes (n_in %d, ws %zu, out %d)\n", n_in, ws_size, out_size); grid = -1; return; }
        int dev = 0, cus = 0, per_cu = 0;
        if (hipGetDevice(&dev) != hipSuccess || hipDeviceGetAttribute(&cus, hipDeviceAttributeMultiprocessorCount, dev) != hipSuccess) { grid = -1; return; }
        if (hipFuncSetAttribute((const void*)mk_fwd, hipFuncAttributeMaxDynamicSharedMemorySize, LDS_BYTES) != hipSuccess) { fprintf(stderr, "kernel_launch: hipFuncSetAttribute failed\n"); grid = -1; return; }
        if (hipOccupancyMaxActiveBlocksPerMultiprocessor(&per_cu, (const void*)mk_fwd, NWAVES * 64, LDS_BYTES) != hipSuccess || per_cu < 1) fprintf(stderr, "kernel_launch: occupancy query says %d\n", per_cu);
        (void)hipGetLastError();
        grid = cus;
    }
    if (grid < 0) return;
    Ptrs P{};
    { const float** pp = (const float**)&P; for (int i = 0; i < 26; ++i) pp[i] = (const float*)d_in[i]; }
    P.out = (float*)d_out; P.ws = (unsigned char*)d_ws;
    unsigned char* ws = (unsigned char*)d_ws; float* out = (float*)d_out;
    unsigned* CTL = (unsigned*)(ws + WS_CTL); unsigned* CNT = CTL + CW_CNT; int* LIST = (int*)(ws + WS_LIST); float* GATE = (float*)(ws + WS_GATE); float* GATEL = (float*)(ws + WS_GATEL); float* WPCF = (float*)(ws + WS_WPCF);
    bf16 *XB = (bf16*)(ws + WS_XB), *PB = (bf16*)(ws + WS_PB), *Q = (bf16*)(ws + WS_Q), *K = (bf16*)(ws + WS_K), *V = (bf16*)(ws + WS_V), *U = (bf16*)(ws + WS_U), *G = (bf16*)(ws + WS_G);
    bf16 *O16 = (bf16*)(ws + WS_O16), *OA = (bf16*)(ws + WS_APO), *PO = (bf16*)(ws + WS_APO) + 512, *MIX = (bf16*)(ws + WS_MIX), *X1B = (bf16*)(ws + WS_X1B), *HB = (bf16*)(ws + WS_HB);
    bf16 *YS1 = (bf16*)(ws + WS_YS1), *YS2 = (bf16*)(ws + WS_YS2), *YS3 = (bf16*)(ws + WS_YS3); bf16* T = (bf16*)(ws + WS_T);
    (void)hipMemsetAsync(ws + WS_CTL, 0, CTL_ZERO_BYTES, stream);
    const unsigned fm = FAST_MASK;
    for (int ph = 0; ph < NPHASE;) {
        if ((fm >> ph) & 1u) {
            int hi = ph + 1; if (MERGE_FAST) while (hi < NPHASE && ((fm >> hi) & 1u)) ++hi;
            Args a{}; a.P = P; a.ph_lo = ph; a.ph_hi = hi;
            hipLaunchKernelGGL(mk_fwd, dim3(grid), dim3(NWAVES * 64), LDS_BYTES, stream, a);
            if (fm != 0x7ffu && ph == 0) { nv::k_fold_pool<<<512, 256, 0, stream>>>(P.w_pmix, P.pscale, P.w_pbr, WPCF); }
            ph = hi; continue;
        }
        switch (ph) {
        case 0: nv::k_cvt_bf16<<<2048, 256, 0, stream>>>(P.x, XB, (size_t)M * D / 4); nv::k_fold_pool<<<512, 256, 0, stream>>>(P.w_pmix, P.pscale, P.w_pbr, WPCF); break;
        case 1: nv::k_gemm<false><<<dim3(4096 / 64, M / 64, 1), 256, 0, stream>>>(nv::RowDense{XB, 1024, 0}, nv::EpiProj{Q, K, V, U, G, P.b_gate, C2Q, 0}, P.w_in, 0, 4096, 1024, 0, 0); break;
        case 2: nv::k_attn<<<dim3(SEQ / 256, 16, BATCH), 256, 0, stream>>>(Q, K, V, O16); nv::k_pool<<<(unsigned)((size_t)M * 512 / 256), 256, 0, stream>>>(U, PO); break;
        case 3: nv::k_combine<<<M / 4, 256, 0, stream>>>(O16, OA, P.lq1, P.lk1, P.lq2, P.lk2, P.subln); break;
        case 4: nv::k_gemm<false><<<dim3(1024 / 64, M / 64, 1), 256, 0, stream>>>(nv::RowDense{OA, 1024, 0}, nv::EpiMixA{MIX, G}, P.w_abr, 0, 1024, 512, 0, 0);
                nv::k_gemm<false><<<dim3(1024 / 64, M / 64, 1), 256, 0, stream>>>(nv::RowDense{PO, 1024, 0}, nv::EpiMixB{MIX, G}, WPCF, 0, 1024, 512, 0, 0); break;
        case 5: nv::k_gemm<false><<<dim3(1024 / 64, M / 64, 1), 256, 0, stream>>>(nv::RowDense{MIX, 1024, 0}, nv::EpiPre1{out, P.x, ALPHA, 0}, P.w_out, 0, 1024, 1024, 0, 0); break;
        case 6: nv::k_ln1_route<<<M, 256, 0, stream>>>(out, X1B, P.ln1g, P.ln1b, P.w_router, P.b_router, CNT, LIST, GATE, GATEL);
                nv::k_cvt_bf16<<<2048, 256, 0, stream>>>(P.p, PB, (size_t)M * PLE / 4); break;
        case 7: nv::k_gemm<false><<<dim3(1024 / 64, M / 64, 1), 256, 0, stream>>>(nv::RowDense{PB, 256, 0}, nv::EpiStoreF32{T}, P.w_pp, 0, 1024, 256, 0, 0);
                nv::k_gemm<false><<<dim3(1024 / 64, M / 64, 1), 256, 0, stream>>>(nv::RowDense{X1B, 1024, 0}, nv::EpiBase{out, T, ALPHA, 0}, P.w_pg, 0, 1024, 1024, 0, 0); break;
        case 8: nv::k_gemm<true><<<dim3(1024 / 64, M / 64, NEXP), 256, 0, stream>>>(nv::RowGather{X1B, LIST, CNT}, nv::EpiUp{HB, P.b_up, CNT}, P.w_up, (size_t)1024 * 2048, 2048, 1024, 1024, 0); break;
        case 9: nv::k_gemm<false><<<dim3(1024 / 64, M / 64, NEXP), 256, 0, stream>>>(nv::RowSlots{HB, CNT}, nv::EpiDown{out, YS1, YS2, YS3, P.b_down, LIST, GATE, CNT}, P.w_down, (size_t)1024 * 1024, 1024, 1024, 0, 0); break;
        case 10: nv::k_final<<<M, 256, 0, stream>>>(out, YS1, YS2, YS3, P.ln2g, P.ln2b); break;
        }
        ++ph;
    }
}
```

```cpp
#define FAST_MASK 0x7ff
#include <hip/hip_runtime.h>
#include <hip/hip_bf16.h>
#include <cstdio>
#include <cstdint>
#include <cmath>

#define GAS __attribute__((address_space(1)))
#define LAS __attribute__((address_space(3)))
typedef unsigned short bf16;
typedef unsigned v4u __attribute__((ext_vector_type(4)));
typedef float f32x4 __attribute__((ext_vector_type(4)));
typedef short bf16x8 __attribute__((ext_vector_type(8)));
typedef GAS unsigned gu32;
typedef GAS unsigned long long gu64;
#define RLX_AGENT __ATOMIC_RELAXED, __HIP_MEMORY_SCOPE_AGENT
#define LDS_WAIT() asm volatile("s_waitcnt lgkmcnt(0)" ::: "memory")
#define VM_WAIT() asm volatile("s_waitcnt vmcnt(0)" ::: "memory")
__device__ __forceinline__ unsigned f2bf(float f) { unsigned u = __builtin_bit_cast(unsigned, f); return (u + 0x7fffu + ((u >> 16) & 1u)) >> 16; }
__device__ __forceinline__ unsigned pk2(float lo, float hi) { return f2bf(lo) | (f2bf(hi) << 16); }

__device__ __forceinline__ int lane_id() { return (int)__builtin_amdgcn_mbcnt_hi(~0u, __builtin_amdgcn_mbcnt_lo(~0u, 0u)); }

constexpr int BATCH = 16, SEQ = 4096, D = 1024, M = BATCH * SEQ;
constexpr int NEXP = 32, TOPK = 4, NASSIGN = M * TOPK, FF = 1024, PLE = 256;
constexpr float LN_EPS = 1e-5f;
constexpr float ALPHA = 1.189207115002721f;
constexpr float C2Q = 0.125f * 1.4426950408889634f;

constexpr size_t MiB = 1u << 20;
constexpr size_t WS_CTL = 0, CTL_ZERO_BYTES = 1 * MiB;
constexpr size_t WS_LIST = 1 * MiB;
constexpr size_t WS_GATEL = 9 * MiB;
constexpr size_t WS_GATE = 17 * MiB;
constexpr size_t WS_WPCF = 18 * MiB;
constexpr size_t WS_WIN = 20 * MiB, WS_WCAT = 28 * MiB, WS_WOUT = 30 * MiB, WS_WPG = 32 * MiB, WS_WPP = 34 * MiB;
constexpr size_t WS_WDN = 36 * MiB, WS_WUP = 100 * MiB;
constexpr size_t WS_XB = 228 * MiB;
constexpr size_t WS_APO = 228 * MiB;
constexpr size_t WS_X1B = 228 * MiB;
constexpr size_t WS_Q = 356 * MiB, WS_K = 420 * MiB, WS_V = 484 * MiB, WS_U = 548 * MiB;
constexpr size_t WS_G = 612 * MiB;
constexpr size_t WS_O16 = 868 * MiB;
constexpr size_t WS_PB = 868 * MiB;
constexpr size_t WS_MIX = 356 * MiB;
constexpr size_t WS_T = 356 * MiB;
constexpr size_t WS_HB = 356 * MiB;
constexpr size_t WS_YS1 = 100 * MiB, WS_YS2 = 228 * MiB, WS_YS3 = 868 * MiB;
constexpr size_t WS_X1F8 = 900 * MiB;
constexpr size_t WS_YS0 = 612 * MiB;
constexpr size_t WS_PLE = 740 * MiB;
constexpr size_t WS_END = 1024 * MiB;
#ifndef MOE_FP8
#define MOE_FP8 1
#endif
constexpr float WUP_SCALE = 32.f, WDN_SCALE = 64.f;
#ifndef PROJ_F8_FROM
#define PROJ_F8_FROM 8
#endif
constexpr size_t WS_XF8 = 900 * MiB;
constexpr size_t WS_WIN8 = WS_WIN + (size_t)PROJ_F8_FROM * 256 * 1024 * 2;
constexpr float ATT_SKIP = 40.f;
constexpr int CW_TMO = 0, CW_CODE = 1;
constexpr int CW_CNT = 64;
constexpr int CW_AQ = 128;
constexpr int CW_PN = 65536;
constexpr int CW_BAR = 4096;
namespace nv {
__device__ __forceinline__ float bf2f(bf16 b) { return __builtin_bit_cast(float, (unsigned)b << 16); }
__device__ __forceinline__ bf16 f2b(float f) { return (bf16)f2bf(f); }
__device__ __forceinline__ float sigm(float v) { return 1.f / (1.f + __expf(-v)); }

__global__ void k_zero_ctl(unsigned* p, int n) { int i = blockIdx.x * blockDim.x + threadIdx.x; if (i < n) p[i] = 0u; }
__global__ void k_cvt_bf16(const float* in, bf16* out, size_t n4) {
    size_t i = (size_t)blockIdx.x * blockDim.x + threadIdx.x; const size_t st = (size_t)gridDim.x * blockDim.x;
    for (; i < n4; i += st) { const f32x4 v = ((const f32x4*)in)[i]; unsigned long long o = (unsigned long long)pk2(v.x, v.y) | ((unsigned long long)pk2(v.z, v.w) << 32); ((unsigned long long*)out)[i] = o; }
}
__global__ void k_fold_pool(const float* wmix, const float* scale, const float* wpb, float* Wpc) {
    const int row = blockIdx.x, g = row >> 7, c = row & 127;
    __shared__ float wm[128];
    if (threadIdx.x < 128) wm[threadIdx.x] = wmix[(g * 128 + c) * 128 + threadIdx.x] * scale[g * 128 + threadIdx.x];
    __syncthreads();
    for (int n = threadIdx.x; n < 1024; n += 256) { float s = 0.f; for (int d = 0; d < 128; ++d) s += wm[d] * wpb[(size_t)(g * 128 + d) * 1024 + n]; Wpc[(size_t)row * 1024 + n] = s; }
}

template <bool DUAL, class RowF, class Epi>
__global__ void __launch_bounds__(256) k_gemm(RowF rf, Epi epi, const float* W, size_t wz, int ldw, int K, int dualoff, int pad_) {
    __shared__ float As[16][68]; __shared__ float Bs[16][64]; __shared__ float Bs2[DUAL ? 16 : 1][64];
    const int tid = threadIdx.x, ty = tid >> 4, tx = tid & 15, z = blockIdx.z;
    const int row0 = blockIdx.y * 64, col0 = blockIdx.x * 64;
    if (!rf.active(z, row0)) return;
    const float* Wz = W + (size_t)z * wz;
    float acc[4][4] = {}, acc2[4][4] = {};
    const int ar = tid >> 2, ak = (tid & 3) * 4; const bf16* arow = rf.row(z, row0 + ar);
    const int bk = tid >> 4, bc = (tid & 15) * 4;
    for (int k0 = 0; k0 < K; k0 += 16) {
        { const unsigned long long v = arow ? *(const unsigned long long*)(arow + k0 + ak) : 0ull;
          As[ak + 0][ar] = bf2f((bf16)(v & 0xffff)); As[ak + 1][ar] = bf2f((bf16)((v >> 16) & 0xffff)); As[ak + 2][ar] = bf2f((bf16)((v >> 32) & 0xffff)); As[ak + 3][ar] = bf2f((bf16)(v >> 48)); }
        { const f32x4 v = *(const f32x4*)(Wz + (size_t)(k0 + bk) * ldw + col0 + bc); Bs[bk][bc] = v.x; Bs[bk][bc + 1] = v.y; Bs[bk][bc + 2] = v.z; Bs[bk][bc + 3] = v.w;
          if (DUAL) { const f32x4 w = *(const f32x4*)(Wz + (size_t)(k0 + bk) * ldw + dualoff + col0 + bc); Bs2[bk][bc] = w.x; Bs2[bk][bc + 1] = w.y; Bs2[bk][bc + 2] = w.z; Bs2[bk][bc + 3] = w.w; } }
        __syncthreads();
#pragma unroll
        for (int k = 0; k < 16; ++k) { float a[4], b[4], b2[4];
#pragma unroll
            for (int i = 0; i < 4; ++i) { a[i] = As[k][ty * 4 + i]; b[i] = Bs[k][tx * 4 + i]; b2[i] = DUAL ? Bs2[k][tx * 4 + i] : 0.f; }
#pragma unroll
            for (int i = 0; i < 4; ++i)
#pragma unroll
                for (int j = 0; j < 4; ++j) { acc[i][j] += a[i] * b[j]; if (DUAL) acc2[i][j] += a[i] * b2[j]; } }
        __syncthreads();
    }
#pragma unroll
    for (int i = 0; i < 4; ++i)
#pragma unroll
        for (int j = 0; j < 4; ++j) epi(z, row0 + ty * 4 + i, col0 + tx * 4 + j, acc[i][j], acc2[i][j]);
}
struct RowDense { const bf16* A; int lda; int pad; __device__ bool active(int, int) const { return true; } __device__ const bf16* row(int, int r) const { return A + (size_t)r * lda; } };

struct EpiProj { bf16 *Q, *K, *V, *U, *G; const float* bg; float c2; int pad;
    __device__ void operator()(int, int r, int c, float v, float) const {
        if (c < 512) Q[(size_t)r * 512 + c] = f2b(v * c2); else if (c < 1024) K[(size_t)r * 512 + c - 512] = f2b(v); else if (c < 1536) V[(size_t)r * 512 + c - 1024] = f2b(v);
        else if (c < 2048) U[(size_t)r * 512 + c - 1536] = f2b(v); else G[(size_t)r * 2048 + c - 2048] = f2b(sigm(v + bg[c - 2048])); } };
struct EpiMixA { bf16* MIX; const bf16* G; __device__ void operator()(int, int r, int c, float v, float) const { MIX[(size_t)r * 1024 + c] = f2b(bf2f(G[(size_t)r * 2048 + c]) * v); } };
struct EpiMixB { bf16* MIX; const bf16* G; __device__ void operator()(int, int r, int c, float v, float) const { MIX[(size_t)r * 1024 + c] = f2b(bf2f(MIX[(size_t)r * 1024 + c]) + bf2f(G[(size_t)r * 2048 + 1024 + c]) * v); } };
struct EpiPre1 { float* out; const float* x; float alpha; int pad; __device__ void operator()(int, int r, int c, float v, float) const { out[(size_t)r * 1024 + c] = alpha * x[(size_t)r * 1024 + c] + v; } };
struct EpiStoreF32 { bf16* T; __device__ void operator()(int, int r, int c, float v, float) const { T[(size_t)r * 1024 + c] = f2b(v); } };
struct EpiBase { float* base; const bf16* T; float alpha; int pad; __device__ void operator()(int, int r, int c, float v, float) const { const size_t i = (size_t)r * 1024 + c; base[i] = alpha * base[i] + sigm(v) * bf2f(T[i]); } };

__global__ void __launch_bounds__(256) k_attn(const bf16* Q, const bf16* K, const bf16* V, bf16* O16) {
    __shared__ float Ks[64][64]; __shared__ float Vs[64][64];
    const int qb = blockIdx.x, vh = blockIdx.y, b = blockIdx.z, tid = threadIdx.x;
    const int hm = vh >> 1, half = vh & 1, h = hm >> 1;
    const float c2 = exp2f(-2.f * (h + 1)) * 1.4426950408889634f;
    const int i = qb * 256 + tid; const size_t rowb = (size_t)b * SEQ;
    float q[64], acc[64];
    { const bf16* qp = Q + (rowb + i) * 512 + hm * 64;
#pragma unroll
      for (int d = 0; d < 64; ++d) { q[d] = bf2f(qp[d]); acc[d] = 0.f; } }
    float m = -INFINITY, l = 0.f;
    const int ntile = (qb * 256 + 256) / 64;
    for (int t = 0; t < ntile; ++t) {
        __syncthreads();
        for (int e = tid; e < 64 * 64; e += 256) { const int j = e >> 6, d = e & 63; const size_t r = rowb + t * 64 + j;
            Ks[j][d] = bf2f(K[r * 512 + hm * 64 + d]); Vs[j][d] = bf2f(V[r * 512 + h * 128 + half * 64 + d]); }
        __syncthreads();
        for (int j = 0; j < 64; ++j) { const int jj = t * 64 + j; if (jj > i) break;
            float s = 0.f;
#pragma unroll
            for (int d = 0; d < 64; ++d) s += q[d] * Ks[j][d];
            s -= c2 * (float)(i - jj);
            if (s > m) { const float f = exp2f(m - s); l *= f;
#pragma unroll
                for (int d = 0; d < 64; ++d) acc[d] *= f;
                m = s; }
            const float p = exp2f(s - m); l += p;
#pragma unroll
            for (int d = 0; d < 64; ++d) acc[d] += p * Vs[j][d]; }
    }
    const float rl = 1.f / l; bf16* op = O16 + (rowb + i) * 1024 + h * 256 + (hm & 1) * 128 + half * 64;
#pragma unroll
    for (int d = 0; d < 64; ++d) op[d] = f2b(acc[d] * rl);
}
__device__ __forceinline__ float lam_value(const float* lq1, const float* lk1, const float* lq2, const float* lk2) {
    float a = 0.f, b = 0.f; for (int d = 0; d < 64; ++d) { a += lq1[d] * lk1[d]; b += lq2[d] * lk2[d]; } return __expf(a) - __expf(b) + 0.2f; }
__global__ void __launch_bounds__(256) k_combine(const bf16* O16, bf16* OA, const float* lq1, const float* lk1, const float* lq2, const float* lk2, const float* sg) {
    const float lam = lam_value(lq1, lk1, lq2, lk2);
    const int row = blockIdx.x * 4 + (threadIdx.x >> 6), lane = threadIdx.x & 63, h = lane >> 4, e0 = (lane & 15) * 8;
    const bf16* a = O16 + (size_t)row * 1024 + h * 256 + e0; const bf16* bb = a + 128;
    float o[8], ss = 0.f;
#pragma unroll
    for (int j = 0; j < 8; ++j) { o[j] = bf2f(a[j]) - lam * bf2f(bb[j]); ss += o[j] * o[j]; }
    ss += __shfl_xor(ss, 1); ss += __shfl_xor(ss, 2); ss += __shfl_xor(ss, 4); ss += __shfl_xor(ss, 8);
    const float r = rsqrtf(ss * (1.f / 128.f) + LN_EPS) * 0.8f;
#pragma unroll
    for (int j = 0; j < 8; ++j) OA[(size_t)row * 1024 + h * 128 + e0 + j] = f2b(o[j] * r * sg[e0 + j]);
}
__global__ void __launch_bounds__(256) k_pool(const bf16* U, bf16* PO) {
    const size_t idx = (size_t)blockIdx.x * 256 + threadIdx.x; const int c = (int)(idx & 511); const size_t row = idx >> 9; const int pos = (int)(row & (SEQ - 1));
    const int w = 2 << (c >> 7); const int n = pos + 1 < w ? pos + 1 : w; float s = 0.f;
    for (int k = 0; k < n; ++k) s += bf2f(U[(row - k) * 512 + c]);
    PO[row * 1024 + c] = f2b(s / (float)n - bf2f(U[row * 512 + c]));
}
__global__ void __launch_bounds__(256) k_ln1_route(float* X1, bf16* X1B, const float* g, const float* bta, const float* wr, const float* br, unsigned* CNT, int* LIST, float* GATE, float* GATEL) {
    __shared__ float xs[1024]; __shared__ float red[8]; __shared__ float part[8][32]; __shared__ float lg[32];
    const int row = blockIdx.x, tid = threadIdx.x, lane = tid & 63, wv = tid >> 6;
    f32x4 v = ((const f32x4*)(X1 + (size_t)row * 1024))[tid];
    float s = (v.x + v.y) + (v.z + v.w); for (int o = 1; o < 64; o <<= 1) s += __shfl_xor(s, o);
    if (lane == 0) red[wv] = s; __syncthreads(); const float mean = (red[0] + red[1] + red[2] + red[3]) * (1.f / 1024.f); __syncthreads();
    v = v - mean; float q = (v.x * v.x + v.y * v.y) + (v.z * v.z + v.w * v.w); for (int o = 1; o < 64; o <<= 1) q += __shfl_xor(q, o);
    if (lane == 0) red[wv] = q; __syncthreads(); const float rstd = rsqrtf((red[0] + red[1] + red[2] + red[3]) * (1.f / 1024.f) + LN_EPS);
    const f32x4 gg = ((const f32x4*)g)[tid], bb = ((const f32x4*)bta)[tid]; v = v * rstd * gg + bb;
    ((f32x4*)(X1 + (size_t)row * 1024))[tid] = v; ((unsigned long long*)(X1B + (size_t)row * 1024))[tid] = (unsigned long long)pk2(v.x, v.y) | ((unsigned long long)pk2(v.z, v.w) << 32);
    xs[tid * 4] = v.x; xs[tid * 4 + 1] = v.y; xs[tid * 4 + 2] = v.z; xs[tid * 4 + 3] = v.w; __syncthreads();
    { const int e = tid & 31, pt = tid >> 5; float a = 0.f; for (int k = pt * 128; k < pt * 128 + 128; ++k) a += xs[k] * wr[k * 32 + e]; part[pt][e] = a; }
    __syncthreads();
    if (tid < 32) { float a = br[tid]; for (int pt = 0; pt < 8; ++pt) a += part[pt][tid]; lg[tid] = a; }
    __syncthreads();
    if (tid == 0) { int id[4]; float vv[4]; unsigned used = 0u;
        for (int k = 0; k < 4; ++k) { int bi = 0; float bv = -INFINITY; for (int e = 0; e < 32; ++e) if (!((used >> e) & 1u) && lg[e] > bv) { bv = lg[e]; bi = e; } used |= 1u << bi; id[k] = bi; vv[k] = bv; }
        float es[4], sum = 0.f; for (int k = 0; k < 4; ++k) { es[k] = __expf(vv[k] - vv[0]); sum += es[k]; }
        for (int k = 0; k < 4; ++k) { const unsigned pos = atomicAdd(&CNT[id[k]], 1u); LIST[(size_t)id[k] * 65536 + pos] = row * 4 + k; GATEL[(size_t)id[k] * 65536 + pos] = es[k] / sum; GATE[row * 4 + k] = es[k] / sum; } }
}
struct RowGather { const bf16* X1B; const int* LIST; const unsigned* CNT;
    __device__ bool active(int e, int row0) const { return (unsigned)row0 < CNT[e]; }
    __device__ const bf16* row(int e, int r) const { return (unsigned)r < CNT[e] ? X1B + (size_t)(LIST[(size_t)e * 65536 + r] >> 2) * 1024 : nullptr; } };
__device__ __forceinline__ unsigned slot_off(const unsigned* CNT, int e) { unsigned o = 0; for (int i = 0; i < e; ++i) o += CNT[i]; return o; }
struct EpiUp { bf16* HB; const float* bup; const unsigned* CNT;
    __device__ void operator()(int e, int r, int c, float glu, float lin) const { if ((unsigned)r >= CNT[e]) return;
        glu += bup[e * 2048 + c]; lin += bup[e * 2048 + 1024 + c]; glu = fminf(glu, 7.f); lin = fminf(fmaxf(lin, -7.f), 7.f);
        HB[(size_t)(slot_off(CNT, e) + r) * 1024 + c] = f2b(glu * sigm(1.702f * glu) * (lin + 1.f)); } };
struct RowSlots { const bf16* HB; const unsigned* CNT;
    __device__ bool active(int e, int row0) const { return (unsigned)row0 < CNT[e]; }
    __device__ const bf16* row(int e, int r) const { return (unsigned)r < CNT[e] ? HB + (size_t)(slot_off(CNT, e) + r) * 1024 : nullptr; } };
struct EpiDown { float* base; bf16* YS1; bf16* YS2; bf16* YS3; const float* bdn; const int* LIST; const float* GATE; const unsigned* CNT;
    __device__ void operator()(int e, int r, int c, float v, float) const { if ((unsigned)r >= CNT[e]) return;
        const int a = LIST[(size_t)e * 65536 + r], tok = a >> 2, k = a & 3; const float y = (v + bdn[e * 1024 + c]) * GATE[a]; const size_t i = (size_t)tok * 1024 + c;
        if (k == 0) base[i] += y; else if (k == 1) YS1[i] = f2b(y); else if (k == 2) YS2[i] = f2b(y); else YS3[i] = f2b(y); } };
__global__ void __launch_bounds__(256) k_final(float* out, const bf16* YS1, const bf16* YS2, const bf16* YS3, const float* g, const float* bta) {
    __shared__ float red[8]; const int row = blockIdx.x, tid = threadIdx.x, lane = tid & 63, wv = tid >> 6; const size_t i0 = (size_t)row * 1024 + tid * 4;
    f32x4 v = *(const f32x4*)(out + i0);
    const bf16* ys[3] = {YS1, YS2, YS3};
    for (int k = 0; k < 3; ++k) { const unsigned long long w = *(const unsigned long long*)(ys[k] + i0); v.x += bf2f((bf16)(w & 0xffff)); v.y += bf2f((bf16)((w >> 16) & 0xffff)); v.z += bf2f((bf16)((w >> 32) & 0xffff)); v.w += bf2f((bf16)(w >> 48)); }
    float s = (v.x + v.y) + (v.z + v.w); for (int o = 1; o < 64; o <<= 1) s += __shfl_xor(s, o);
    if (lane == 0) red[wv] = s; __syncthreads(); const float mean = (red[0] + red[1] + red[2] + red[3]) * (1.f / 1024.f); __syncthreads();
    v = v - mean; float q = (v.x * v.x + v.y * v.y) + (v.z * v.z + v.w * v.w); for (int o = 1; o < 64; o <<= 1) q += __shfl_xor(q, o);
    if (lane == 0) red[wv] = q; __syncthreads(); const float rstd = rsqrtf((red[0] + red[1] + red[2] + red[3]) * (1.f / 1024.f) + LN_EPS);
    const f32x4 gg = ((const f32x4*)g)[tid], bb = ((const f32x4*)bta)[tid]; *(f32x4*)(out + i0) = v * rstd * gg + bb;
}
}
namespace pg8 {
#define PG8_LAS __attribute__((address_space(3)))
typedef unsigned short bf16_t;
typedef unsigned u32x4 __attribute__((ext_vector_type(4)));
typedef float f32x2 __attribute__((ext_vector_type(2)));
constexpr int BM = 256, BK = 64, HALF = 128, HTB = HALF * BK * 2  , STAGE_BYTES = 8 * HTB, NXCD = 8, WGM = 8;
constexpr int TAB_OFF = 131072 + 1024;
constexpr int TAB_CNT = TAB_OFF, TAB_BLK0 = TAB_OFF + 128, TAB_ROW0 = TAB_OFF + 384, TAB_IDS = TAB_OFF + 1024, TAB_GATES = TAB_OFF + 1024 + 2048;

__host__ __device__ __forceinline__ int lds_byte(int r, int c) { const int st = (r >> 4) * 2 + (c >> 5), rr = r & 15, cc = c & 31, ob = rr * 64 + cc * 2; return st * 1024 + (ob ^ (((ob >> 9) & 1) << 5)); }
__host__ __device__ __forceinline__ void stage_rc(int b, int& R, int& C) { const int st = b / 1024, sb = b % 1024, swz = sb ^ (((sb >> 9) & 1) << 5); R = (st >> 1) * 16 + swz / 64; C = (st & 1) * 32 + (swz % 64) / 2; }
__host__ __device__ __forceinline__ int perm32(int rho) { const int n = rho >> 4, i = rho & 15; return 8 * (i >> 2) + 4 * n + (i & 3); }

struct Unit { int pm, pn, e, nvalid; };
struct Gemm { const bf16_t* A; const bf16_t* Bt; int K; };

struct StaticOrder {
    static constexpr bool TABLES = false, FP8 = false;
    int nM, nN, nwg, G, c;
    __host__ __device__ void init(int M, int N, int G_, int c_) { nM = M / BM; nN = N / BM; nwg = nM * nN; G = G_; c = c_; }
    __device__ __forceinline__ bool next(int i, Unit& u, PG8_LAS unsigned char*) const {
        const long L = (long)i * G + c; if (L >= nwg) return false;
        int wgid = (int)L; { const int q = nwg / NXCD, r = nwg % NXCD, xcd = wgid % NXCD, off = wgid / NXCD; wgid = (xcd < r ? xcd * (q + 1) : r * (q + 1) + (xcd - r) * q) + off; }
        const int nig = WGM * nN, gid = wgid / nig, fm = gid * WGM, gsz = (nM - fm) < WGM ? (nM - fm) : WGM;
        u.pm = fm + ((wgid % nig) % gsz); u.pn = (wgid % nig) / gsz; u.e = 0; u.nvalid = 256; return true;
    }
    __device__ __forceinline__ const char* b_tile(const Gemm& g, const Unit& u) const { return (const char*)g.Bt + (size_t)u.pn * (size_t)(BM * 2) * g.K; }
    __device__ __forceinline__ void a_offsets(const Gemm& g, const Unit& u, PG8_LAS unsigned char*, int, const int (&R)[2], const int (&C)[2], unsigned (&off)[2][2]) const {
#pragma unroll
        for (int h = 0; h < 2; ++h)
#pragma unroll
            for (int i = 0; i < 2; ++i) off[h][i] = (unsigned)(((u.pm * BM + h * HALF + R[i]) * g.K + C[i]) * 2);
    }
    __device__ __forceinline__ void issue_tables(const Unit&, PG8_LAS unsigned char*, int, int) const {}
};

struct DenseF8Order : StaticOrder { static constexpr bool FP8 = true; };

template <bool GATHER_, bool FP8_> struct MoeOrder {
    static constexpr bool TABLES = true; static constexpr bool GATHER = GATHER_, FP8 = FP8_;
    int NT, G, c; const int* LIST; const float* GATEL; size_t bstride;
    __device__ __forceinline__ bool next(int i, Unit& u, PG8_LAS unsigned char* lds) const {
        const PG8_LAS int* cnt = (const PG8_LAS int*)(lds + TAB_CNT); const PG8_LAS int* blk0 = (const PG8_LAS int*)(lds + TAB_BLK0);
        const int L = i * G + c; const int total = blk0[32] * NT; if (L >= total) return false;
        const int blk = L / NT; int e = 0;
#pragma unroll 1
        for (int j = 1; j < 32; ++j) e += (blk >= blk0[j]) ? 1 : 0;
        e = __builtin_amdgcn_readfirstlane(e);
        u.e = e; u.pm = __builtin_amdgcn_readfirstlane(blk - blk0[e]); u.pn = L % NT; const int left = __builtin_amdgcn_readfirstlane(cnt[e]) - 256 * u.pm; u.nvalid = left < 256 ? left : 256; return true;
    }
    __device__ __forceinline__ const char* b_tile(const Gemm& g, const Unit& u) const { return (const char*)g.Bt + (size_t)u.e * bstride + (size_t)u.pn * (size_t)(BM * 2) * g.K; }
    __device__ __forceinline__ void a_offsets(const Gemm& g, const Unit& u, PG8_LAS unsigned char* lds, int buf, const int (&R)[2], const int (&C)[2], unsigned (&off)[2][2]) const {
        const PG8_LAS int* ids = (const PG8_LAS int*)(lds + TAB_IDS) + buf * 256; const PG8_LAS int* row0 = (const PG8_LAS int*)(lds + TAB_ROW0);
#pragma unroll
        for (int h = 0; h < 2; ++h)
#pragma unroll
            for (int i = 0; i < 2; ++i) { const int r = h * HALF + R[i];
                if (GATHER) { const int tok = (r < u.nvalid) ? (ids[r] >> 2) : 0; off[h][i] = (unsigned)((tok * g.K + C[i]) * 2); }
                else off[h][i] = (unsigned)(((row0[u.e] + u.pm * BM + r) * g.K + C[i]) * 2); }
    }
    __device__ __forceinline__ void issue_tables(const Unit& u, PG8_LAS unsigned char* lds, int buf, int lane) const {
        const size_t o = (size_t)u.e * 65536 + (size_t)u.pm * 256 + lane * 4;
        __builtin_amdgcn_global_load_lds((const unsigned*)(LIST + o), (PG8_LAS unsigned*)(lds + TAB_IDS + buf * 1024), 16, 0, 0);
        if (!GATHER) __builtin_amdgcn_global_load_lds((const unsigned*)(GATEL + o), (PG8_LAS unsigned*)(lds + TAB_GATES + buf * 1024), 16, 0, 0);
    }
};

__device__ __forceinline__ unsigned cvt_pk_bf16(float lo, float hi) { unsigned r; asm volatile("v_cvt_pk_bf16_f32 %0, %1, %2" : "=v"(r) : "v"(lo), "v"(hi)); return r; }
__device__ __forceinline__ float bflo(unsigned w) { return __builtin_bit_cast(float, w << 16); }
__device__ __forceinline__ float bfhi(unsigned w) { return __builtin_bit_cast(float, w & 0xffff0000u); }
__device__ __forceinline__ float sigm(float v) { return __builtin_amdgcn_rcpf(1.f + __builtin_amdgcn_exp2f(-1.4426950408889634f * v)); }
__device__ __forceinline__ u32x4 pack8(const f32x4& v0, const f32x4& v1) { u32x4 w; w.x = cvt_pk_bf16(v0[0], v0[1]); w.y = cvt_pk_bf16(v0[2], v0[3]); w.z = cvt_pk_bf16(v1[0], v1[1]); w.w = cvt_pk_bf16(v1[2], v1[3]); return w; }
__device__ __forceinline__ void unpack8(const u32x4& w, f32x4& v0, f32x4& v1) { v0 = (f32x4){bflo(w.x), bfhi(w.x), bflo(w.y), bfhi(w.y)}; v1 = (f32x4){bflo(w.z), bfhi(w.z), bflo(w.w), bfhi(w.w)}; }
typedef f32x4 Acc[2][2][4][2];
typedef int i32x4 __attribute__((ext_vector_type(4)));
typedef int i32x8 __attribute__((ext_vector_type(8)));
struct bf16x8p { bf16x8 k[2]; };
template <bool F8> struct Frag { typedef bf16x8p T; };
template <> struct Frag<true> { typedef i32x8 T; };
__device__ __forceinline__ void frag_set(i32x8& d, const i32x4& lo, const i32x4& hi) { d = __builtin_shufflevector(lo, hi, 0, 1, 2, 3, 4, 5, 6, 7); }
__device__ __forceinline__ void frag_set(bf16x8p& d, const bf16x8& lo, const bf16x8& hi) { d.k[0] = lo; d.k[1] = hi; }
__device__ __forceinline__ void frag_mma(f32x4& c, const i32x8& b, const i32x8& a) { c = __builtin_amdgcn_mfma_scale_f32_16x16x128_f8f6f4(b, a, c, 0, 0, 0, 0, 0, 0); }
__device__ __forceinline__ void frag_mma(f32x4& c, const bf16x8p& b, const bf16x8p& a) { c = __builtin_amdgcn_mfma_f32_16x16x32_bf16(b.k[0], a.k[0], c, 0, 0, 0); c = __builtin_amdgcn_mfma_f32_16x16x32_bf16(b.k[1], a.k[1], c, 0, 0, 0); }
__device__ __forceinline__ unsigned pk4_fp8(float a, float b, float c, float d) { unsigned w = __builtin_amdgcn_cvt_pk_fp8_f32(a, b, 0u, false); return __builtin_amdgcn_cvt_pk_fp8_f32(c, d, w, true); }
template <class E> struct has_mid { template <class T> static constexpr bool f(decltype(T::MID)*) { return T::MID; } template <class T> static constexpr bool f(...) { return false; } static constexpr bool value = f<E>(nullptr); };

struct EpiProj {
    static constexpr bool PERM = true;
    bf16_t *Q, *K, *V, *U, *G; const float* bg; float* PN; float c2; float dsc; int pn_base; int pad;
    __device__ __forceinline__ void operator()(const Acc& acc, const Unit& u, int wr, int wc, int fr_, int fq_, PG8_LAS unsigned char*, int) const {
        int fr = fr_, fq = fq_; asm volatile("" : "+v"(fr), "+v"(fq));
        const int pn = u.pn + pn_base; const int row0 = u.pm * BM + wr * 64 + fr; const bool isg = pn >= 8;
        bf16_t* base; int ldc, colt; float sc = dsc;
        if (isg) { base = G; ldc = 2048; colt = (pn - 8) * BM; } else { const int t = pn >> 1; base = t == 0 ? Q : t == 1 ? K : t == 2 ? V : U; ldc = 512; colt = (pn & 1) * BM; if (t == 0) sc = c2 * dsc; }
        const int col0 = colt + wc * 32 + 8 * fq;
        f32x4 bv[2][2];
#pragma unroll
        for (int bj = 0; bj < 2; ++bj)
#pragma unroll
            for (int n = 0; n < 2; ++n) bv[bj][n] = isg ? *(const f32x4*)(bg + col0 + bj * HALF + 4 * n) : (f32x4){0.f, 0.f, 0.f, 0.f};
#pragma unroll
        for (int ai = 0; ai < 2; ++ai)
#pragma unroll
            for (int m = 0; m < 4; ++m) { bf16_t* rowp = base + (size_t)(row0 + ai * HALF + m * 16) * ldc + col0;
#pragma unroll
                for (int bj = 0; bj < 2; ++bj) { f32x4 v0 = acc[ai][bj][m][0] * sc + bv[bj][0], v1 = acc[ai][bj][m][1] * sc + bv[bj][1];
                    if (isg) {
#pragma unroll
                        for (int i = 0; i < 4; ++i) { v0[i] = sigm(v0[i]); v1[i] = sigm(v1[i]); } }
                    *(u32x4*)(rowp + bj * HALF) = pack8(v0, v1); } }
        if (pn < 4) {
            float* tab = PN + (pn >> 1) * 16384; const int R0 = u.pm * BM, b = R0 >> 12;
#pragma unroll
            for (int ai = 0; ai < 2; ++ai)
#pragma unroll
                for (int bj = 0; bj < 2; ++bj) { float mx = 0.f;
#pragma unroll
                    for (int m = 0; m < 4; ++m) { f32x4 v0 = acc[ai][bj][m][0] * sc, v1 = acc[ai][bj][m][1] * sc;
                        float s = (v0[0] * v0[0] + v0[1] * v0[1]) + (v0[2] * v0[2] + v0[3] * v0[3]) + (v1[0] * v1[0] + v1[1] * v1[1]) + (v1[2] * v1[2] + v1[3] * v1[3]);
                        s += __shfl_xor(s, 16); s += __shfl_xor(s, 32); mx = fmaxf(mx, s); }
                    mx = fmaxf(mx, __shfl_xor(mx, 1)); mx = fmaxf(mx, __shfl_xor(mx, 2)); mx = fmaxf(mx, __shfl_xor(mx, 4)); mx = fmaxf(mx, __shfl_xor(mx, 8));
                    const int tile = ((R0 & 4095) >> 6) + 2 * ai + wr, hm = (pn & 1) * 4 + 2 * bj + (wc >> 1);
                    if (fr == 0 && fq == 0) tab[((b * 8 + hm) * 64 + tile) * 2 + (wc & 1)] = mx; }
        }
    }
};
struct EpiMixCat {
    static constexpr bool PERM = true, MID = true;
    bf16_t* MIX; const bf16_t* G;
    __device__ __forceinline__ void mid(Acc& acc, const Unit& u, int wr, int wc, int fr_, int fq_) const {
        int fr = fr_, fq = fq_; asm volatile("" : "+v"(fr), "+v"(fq));
        const int row0 = u.pm * BM + wr * 64 + fr, col0 = u.pn * BM + wc * 32 + 8 * fq;
#pragma unroll
        for (int ai = 0; ai < 2; ++ai)
#pragma unroll
            for (int m = 0; m < 4; ++m) { const size_t r = (size_t)(row0 + ai * HALF + m * 16);
#pragma unroll
                for (int bj = 0; bj < 2; ++bj) { const int c = col0 + bj * HALF;
                    const u32x4 aw = *(const u32x4*)(G + r * 2048 + c), pw = *(const u32x4*)(G + r * 2048 + 1024 + c); f32x4 a0, a1, p0, p1; unpack8(aw, a0, a1); unpack8(pw, p0, p1);
#pragma unroll
                    for (int i = 0; i < 4; ++i) { acc[ai][bj][m][0][i] *= a0[i] * __builtin_amdgcn_rcpf(fmaxf(p0[i], 8.67e-19f)); acc[ai][bj][m][1][i] *= a1[i] * __builtin_amdgcn_rcpf(fmaxf(p1[i], 8.67e-19f)); }
                    asm volatile("" : "+v"(acc[ai][bj][m][0]), "+v"(acc[ai][bj][m][1]) :: "memory"); } }
    }
    __device__ __forceinline__ void operator()(const Acc& acc, const Unit& u, int wr, int wc, int fr_, int fq_, PG8_LAS unsigned char*, int) const {
        int fr = fr_, fq = fq_; asm volatile("" : "+v"(fr), "+v"(fq));
        const int row0 = u.pm * BM + wr * 64 + fr, col0 = u.pn * BM + wc * 32 + 8 * fq;
#pragma unroll
        for (int ai = 0; ai < 2; ++ai)
#pragma unroll
            for (int m = 0; m < 4; ++m) { const size_t r = (size_t)(row0 + ai * HALF + m * 16);
#pragma unroll
                for (int bj = 0; bj < 2; ++bj) { const int c = col0 + bj * HALF;
                    const u32x4 pw = *(const u32x4*)(G + r * 2048 + 1024 + c); f32x4 p0, p1; unpack8(pw, p0, p1);
#pragma unroll
                    for (int i = 0; i < 4; ++i) { p0[i] = fmaxf(p0[i], 8.67e-19f); p1[i] = fmaxf(p1[i], 8.67e-19f); }
                    *(u32x4*)(MIX + r * 1024 + c) = pack8(acc[ai][bj][m][0] * p0, acc[ai][bj][m][1] * p1); }
                asm volatile("" ::: "memory"); }
    }
};
template <int MODE> struct EpiF32 {
    static constexpr bool PERM = false;
    float* out; const float* aux; float alpha; float dsc;
    __device__ __forceinline__ void operator()(const Acc& acc, const Unit& u, int wr, int wc, int fr_, int fq_, PG8_LAS unsigned char*, int) const {
        int fr = fr_, fq = fq_; asm volatile("" : "+v"(fr), "+v"(fq));
        const int col0 = u.pn * BM + wc * 32 + 4 * fq;
#pragma unroll
        for (int ai = 0; ai < 2; ++ai)
#pragma unroll
            for (int m = 0; m < 4; ++m) { const size_t off = (size_t)(u.pm * BM + ai * HALF + wr * 64 + m * 16 + fr) * 1024 + col0;
#pragma unroll
                for (int bj = 0; bj < 2; ++bj) {
#pragma unroll
                    for (int n = 0; n < 2; ++n) { const size_t o = off + bj * HALF + n * 16; const f32x4 a = acc[ai][bj][m][n]; f32x4 r;
                        if (MODE == 1) { f32x2 w; unsigned* wp = (unsigned*)&w; wp[0] = cvt_pk_bf16(a[0], a[1]); wp[1] = cvt_pk_bf16(a[2], a[3]); *(f32x2*)((bf16_t*)out + o) = w; continue; }
                        if (MODE == 0) r = *(const f32x4*)(aux + o) * alpha + a;
                        else if (MODE == 3) { const f32x2 tw = *(const f32x2*)((const bf16_t*)aux + o); const unsigned* tp = (const unsigned*)&tw; f32x2 w; unsigned* wp = (unsigned*)&w;
                            wp[0] = cvt_pk_bf16(sigm(a[0] * dsc) * bflo(tp[0]), sigm(a[1] * dsc) * bfhi(tp[0])); wp[1] = cvt_pk_bf16(sigm(a[2] * dsc) * bflo(tp[1]), sigm(a[3] * dsc) * bfhi(tp[1])); *(f32x2*)((bf16_t*)out + o) = w; continue; }
                        else { const f32x2 tw = *(const f32x2*)((const bf16_t*)aux + o); const unsigned* tp = (const unsigned*)&tw; const f32x4 t = {bflo(tp[0]), bfhi(tp[0]), bflo(tp[1]), bfhi(tp[1])}; const f32x4 b = *(const f32x4*)(out + o); r = b * alpha;
#pragma unroll
                            for (int i = 0; i < 4; ++i) r[i] += sigm(a[i] * dsc) * t[i]; }
                        *(f32x4*)(out + o) = r; }
                  if (MODE == 2) asm volatile("" ::: "memory"); }
                if (m & 1) asm volatile("" ::: "memory"); }
    }
};
template <bool F8> struct EpiUp {
    static constexpr bool PERM = true;
    void* HB; const float* bup; float dsc; int pad;
    __device__ __forceinline__ void operator()(const Acc& acc, const Unit& u, int wr, int wc, int fr_, int fq_, PG8_LAS unsigned char* lds, int) const {
        int fr = fr_, fq = fq_; asm volatile("" : "+v"(fr), "+v"(fq));
        const PG8_LAS int* row0t = (const PG8_LAS int*)(lds + TAB_ROW0); const int srow = row0t[u.e] + u.pm * BM;
        const int c0 = u.pn * HALF + wc * 32 + 8 * fq; const float* bp = bup + (size_t)u.e * 2048 + c0;
        const f32x4 bg0 = *(const f32x4*)(bp), bg1 = *(const f32x4*)(bp + 4), bl0 = *(const f32x4*)(bp + 1024), bl1 = *(const f32x4*)(bp + 1028);
#pragma unroll
        for (int ai = 0; ai < 2; ++ai)
#pragma unroll
            for (int m = 0; m < 4; ++m) { const int r = ai * HALF + wr * 64 + m * 16 + fr;
                f32x4 g0 = acc[ai][0][m][0] * dsc + bg0, g1 = acc[ai][0][m][1] * dsc + bg1, l0 = acc[ai][1][m][0] * dsc + bl0, l1 = acc[ai][1][m][1] * dsc + bl1;
#pragma unroll
                for (int i = 0; i < 4; ++i) { float a = fminf(g0[i], 7.f), b = fminf(fmaxf(l0[i], -7.f), 7.f); g0[i] = a * sigm(1.702f * a) * (b + 1.f);
                                              a = fminf(g1[i], 7.f); b = fminf(fmaxf(l1[i], -7.f), 7.f); g1[i] = a * sigm(1.702f * a) * (b + 1.f); }
                if (r < u.nvalid) {
                    if (F8) { f32x2 w; unsigned* wp = (unsigned*)&w; wp[0] = pk4_fp8(g0[0], g0[1], g0[2], g0[3]); wp[1] = pk4_fp8(g1[0], g1[1], g1[2], g1[3]); *(f32x2*)((unsigned char*)HB + (size_t)(srow + r) * 1024 + c0) = w; }
                    else *(u32x4*)((bf16_t*)HB + (size_t)(srow + r) * 1024 + c0) = pack8(g0, g1); } }
    }
};
struct EpiDown {
    static constexpr bool PERM = true;
    bf16_t* YS0; bf16_t* YS1; bf16_t* YS2; bf16_t* YS3; const float* bdn; float dsc; int pad;
    __device__ __forceinline__ void operator()(const Acc& acc, const Unit& u, int wr, int wc, int fr_, int fq_, PG8_LAS unsigned char* lds, int buf) const {
        int fr = fr_, fq = fq_; asm volatile("" : "+v"(fr), "+v"(fq));
        const PG8_LAS int* ids = (const PG8_LAS int*)(lds + TAB_IDS) + buf * 256; const PG8_LAS float* gates = (const PG8_LAS float*)(lds + TAB_GATES) + buf * 256;
        const int col0 = u.pn * BM + wc * 32 + 8 * fq; const float* bp = bdn + (size_t)u.e * 1024 + col0;
        f32x4 bv[2][2];
#pragma unroll
        for (int bj = 0; bj < 2; ++bj)
#pragma unroll
            for (int n = 0; n < 2; ++n) bv[bj][n] = *(const f32x4*)(bp + bj * HALF + 4 * n);
#pragma unroll
        for (int ai = 0; ai < 2; ++ai)
#pragma unroll
            for (int m = 0; m < 4; ++m) { const int r = ai * HALF + wr * 64 + m * 16 + fr;
                if (r < u.nvalid) { const int a = ids[r]; const float gt = gates[r]; const int k = a & 3; const size_t o = (size_t)(a >> 2) * 1024 + col0;
#pragma unroll
                    for (int bj = 0; bj < 2; ++bj) { const f32x4 v0 = (acc[ai][bj][m][0] * dsc + bv[bj][0]) * gt, v1 = (acc[ai][bj][m][1] * dsc + bv[bj][1]) * gt; const size_t oo = o + bj * HALF;
                        bf16_t* yp = k == 0 ? YS0 : k == 1 ? YS1 : k == 2 ? YS2 : YS3; *(u32x4*)(yp + oo) = pack8(v0, v1); } } }
    }
};

template <class Epi, class Sched>
__device__ __forceinline__ void gemm_phase(PG8_LAS unsigned char* lds, const int wid, const Gemm g, const Sched& S, const Epi& E) {
    int lane = lane_id(); asm volatile("" : "+v"(lane));
    const int tid = wid * 64 + lane, wr = wid >> 2, wc = wid & 3, fr = lane & 15, fq = lane >> 4;
    const int K = g.K, nt = K / BK;
    int RA[2], CA[2]; unsigned voffA[2], voffB[2];
#pragma unroll
    for (int i = 0; i < 2; ++i) { int R, C; stage_rc(tid * 16 + i * 8192, R, C); const int Rb = Epi::PERM ? ((R & ~31) + perm32(R & 31)) : R; RA[i] = R; CA[i] = C; voffA[i] = (unsigned)(R * K + C) * 2u; voffB[i] = (unsigned)(Rb * K + C) * 2u; }
    const size_t tstep = (size_t)BM * K * 2;
    const size_t kstep = (size_t)(BK * 2);
    const size_t hstep = (size_t)HALF * K * 2;
    const unsigned ldsw = (unsigned)wid * 1024u;
    const int aoff = lds_byte(wr * 64 + fr, fq * 8), boff = lds_byte(wc * 32 + fr, fq * 8);
#define PG8_SA(b, h) (((b) * 2 + (h)) * HTB)
#define PG8_SB(b, h) ((4 + (b) * 2 + (h)) * HTB)
#define PG8_STAGE(bufoff, gbase, voff) do { _Pragma("unroll") for (int _i = 0; _i < 2; ++_i) \
        __builtin_amdgcn_global_load_lds((const unsigned*)((const char*)(gbase) + (voff)[_i]), (PG8_LAS unsigned*)(lds + (bufoff) + ldsw + _i * 8192), 16, 0, 0); } while (0)
#define PG8_STAGE_A(bufoff, ubase, h, OFF) do { if constexpr (Sched::TABLES) PG8_STAGE(bufoff, ubase, OFF[h]); else PG8_STAGE(bufoff, (ubase) + ((h) ? hstep : 0), voffA); } while (0)
#define PG8_LDA(dst, b, h) do { _Pragma("unroll") for (int m = 0; m < 4; ++m) { if constexpr (Sched::FP8) dst##8[m] = __builtin_shufflevector(*(const PG8_LAS i32x4*)(lds + PG8_SA(b, h) + aoff + m * 2048), *(const PG8_LAS i32x4*)(lds + PG8_SA(b, h) + aoff + m * 2048 + 1024), 0, 1, 2, 3, 4, 5, 6, 7); \
        else { _Pragma("unroll") for (int k = 0; k < 2; ++k) dst[m][k] = *(const PG8_LAS bf16x8*)(lds + PG8_SA(b, h) + aoff + m * 2048 + k * 1024); } } } while (0)
#define PG8_LDB(dst, b, h) do { _Pragma("unroll") for (int n = 0; n < 2; ++n) { if constexpr (Sched::FP8) dst##8[n] = __builtin_shufflevector(*(const PG8_LAS i32x4*)(lds + PG8_SB(b, h) + boff + n * 2048), *(const PG8_LAS i32x4*)(lds + PG8_SB(b, h) + boff + n * 2048 + 1024), 0, 1, 2, 3, 4, 5, 6, 7); \
        else { _Pragma("unroll") for (int k = 0; k < 2; ++k) dst[n][k] = *(const PG8_LAS bf16x8*)(lds + PG8_SB(b, h) + boff + n * 2048 + k * 1024); } } } while (0)
#define PG8_MMA(ai, bj, At, Bt) do { __builtin_amdgcn_s_setprio(1); if constexpr (Sched::FP8) asm volatile("s_nop 1"); _Pragma("unroll") for (int m = 0; m < 4; ++m) _Pragma("unroll") for (int n = 0; n < 2; ++n) { \
        if constexpr (Sched::FP8) asm volatile("v_mfma_f32_16x16x128_f8f6f4 %0, %1, %2, %0" : "+v"(acc[ai][bj][m][n]) : "v"(Bt##8[n]), "v"(At##8[m]));   \
        else { _Pragma("unroll") for (int k = 0; k < 2; ++k) acc[ai][bj][m][n] = __builtin_amdgcn_mfma_f32_16x16x32_bf16(Bt[n][k], At[m][k], acc[ai][bj][m][n], 0, 0, 0); } } __builtin_amdgcn_s_setprio(0); } while (0)
#define PG8_WAIT_V(n) asm volatile("s_waitcnt vmcnt(" #n ")" ::: "memory")
#define PG8_WAIT_L(n) asm volatile("s_waitcnt lgkmcnt(" #n ")" ::: "memory")
#define PG8_BAR __builtin_amdgcn_s_barrier()
#define PG8_SCHED __builtin_amdgcn_sched_barrier(0)
    Unit cur, nxt; int ui = 0;
    if (!S.next(0, cur, lds)) return;
    if constexpr (Sched::TABLES) {
        if (wid == 0) S.issue_tables(cur, lds, 0, lane);
        PG8_WAIT_V(0); PG8_BAR;
    }
    Acc acc;
#pragma unroll
    for (int a = 0; a < 2; ++a)
#pragma unroll
        for (int b = 0; b < 2; ++b)
#pragma unroll
            for (int m = 0; m < 4; ++m)
#pragma unroll
                for (int n = 0; n < 2; ++n) acc[a][b][m][n] = (f32x4){0.f, 0.f, 0.f, 0.f};
    bf16x8 At[4][2], B0[2][2], B1[2][2];
    i32x8 At8[4], B08[2], B18[2];
    unsigned offc[2][2], offn[2][2];
    if constexpr (Sched::TABLES) { S.a_offsets(g, cur, lds, 0, RA, CA, offc);
#pragma unroll
        for (int h = 0; h < 2; ++h)
#pragma unroll
            for (int i = 0; i < 2; ++i) offn[h][i] = offc[h][i]; }
    const char* const Ab = (const char*)g.A;
    const char* cA = Sched::TABLES ? Ab : Ab + (size_t)cur.pm * tstep;
    const char* cB = S.b_tile(g, cur);
    PG8_STAGE(PG8_SB(0, 0), cB, voffB); PG8_STAGE(PG8_SB(0, 1), cB + hstep, voffB); PG8_STAGE_A(PG8_SA(0, 0), cA, 0, offc); PG8_STAGE_A(PG8_SA(0, 1), cA, 1, offc);
    if (wr == 1) PG8_BAR;
    PG8_WAIT_V(2); PG8_BAR;
    PG8_STAGE(PG8_SB(1, 0), cB + kstep, voffB); PG8_STAGE_A(PG8_SA(1, 0), cA + kstep, 0, offc); PG8_STAGE(PG8_SB(1, 1), cB + hstep + kstep, voffB);
    PG8_WAIT_V(6); PG8_BAR;
    for (;;) {
        const bool has_next = S.next(ui + 1, nxt, lds);
        const char* nB = has_next ? S.b_tile(g, nxt) : cB;
        const char* nA = Sched::TABLES ? Ab : (has_next ? Ab + (size_t)nxt.pm * tstep : cA);
#pragma nounroll
        for (int t = 0; t < nt; t += 2) {
            const bool last = (t == nt - 2);
            if constexpr (has_mid<Epi>::value) { if (t == nt / 2) E.mid(acc, cur, wr, wc, fr, fq); }
            if constexpr (Sched::TABLES) {
                if (t == 2 && has_next && wid == 0) S.issue_tables(nxt, lds, (ui + 1) & 1, lane);
                if (t == (nt >= 16 ? nt - 6 : nt - 2) && has_next) S.a_offsets(g, nxt, lds, (ui + 1) & 1, RA, CA, offn);
            }
            unsigned o2[2][2];
            if constexpr (Sched::TABLES) {
#pragma unroll
                for (int h = 0; h < 2; ++h)
#pragma unroll
                    for (int i = 0; i < 2; ++i) o2[h][i] = last ? offn[h][i] : offc[h][i]; }
            const char* a1 = cA + (size_t)(t + 1) * kstep;
            const char* a2 = last ? nA : cA + (size_t)(t + 2) * kstep; const char* b2 = last ? nB : cB + (size_t)(t + 2) * kstep;
            const char* a3 = a2 + kstep; const char* b3 = b2 + kstep;
            PG8_LDB(B0, 0, 0); PG8_LDB(B1, 0, 1); PG8_SCHED; PG8_LDA(At, 0, 0); PG8_STAGE_A(PG8_SA(1, 1), a1, 1, offc);
            PG8_WAIT_V(8); PG8_WAIT_L(0); PG8_BAR; PG8_MMA(0, 0, At, B0); PG8_MMA(0, 1, At, B1); PG8_BAR; PG8_SCHED;
            PG8_LDA(At, 0, 1); PG8_STAGE(PG8_SB(0, 0), b2, voffB); PG8_STAGE(PG8_SB(0, 1), b2 + hstep, voffB); PG8_STAGE_A(PG8_SA(0, 0), a2, 0, o2);
            PG8_WAIT_V(8); PG8_WAIT_L(0); PG8_BAR; PG8_MMA(1, 0, At, B0); PG8_MMA(1, 1, At, B1); PG8_BAR; PG8_SCHED;
            PG8_LDB(B0, 1, 0); PG8_LDB(B1, 1, 1); PG8_SCHED; PG8_LDA(At, 1, 0); PG8_STAGE_A(PG8_SA(0, 1), a2, 1, o2);
            PG8_WAIT_V(8); PG8_WAIT_L(0); PG8_BAR; PG8_MMA(0, 0, At, B0); PG8_MMA(0, 1, At, B1); PG8_BAR; PG8_SCHED;
            PG8_LDA(At, 1, 1); PG8_STAGE(PG8_SB(1, 0), b3, voffB); PG8_STAGE(PG8_SB(1, 1), b3 + hstep, voffB); PG8_STAGE_A(PG8_SA(1, 0), a3, 0, o2);
            PG8_WAIT_V(8); PG8_WAIT_L(0); PG8_BAR; PG8_MMA(1, 0, At, B0); PG8_MMA(1, 1, At, B1); PG8_BAR; PG8_SCHED;
        }
        if (wr == 0) PG8_BAR;
        E(acc, cur, wr, wc, fr, fq, lds, ui & 1);
        if (!has_next) break;
#pragma unroll
        for (int a = 0; a < 2; ++a)
#pragma unroll
            for (int b = 0; b < 2; ++b)
#pragma unroll
                for (int m = 0; m < 4; ++m)
#pragma unroll
                    for (int n = 0; n < 2; ++n) acc[a][b][m][n] = (f32x4){0.f, 0.f, 0.f, 0.f};
        cur = nxt; cB = nB; cA = nA; ++ui;
        if constexpr (Sched::TABLES) {
#pragma unroll
            for (int h = 0; h < 2; ++h)
#pragma unroll
                for (int i = 0; i < 2; ++i) offc[h][i] = offn[h][i]; }
        if (wr == 1) PG8_BAR;
    }
    PG8_WAIT_V(0);
    PG8_BAR;
#undef PG8_SA
#undef PG8_SB
#undef PG8_STAGE
#undef PG8_STAGE_A
#undef PG8_LDA
#undef PG8_LDB
#undef PG8_MMA
#undef PG8_WAIT_V
#undef PG8_WAIT_L
#undef PG8_BAR
#undef PG8_SCHED
}
}
namespace attn_body {
using bf16=__hip_bfloat16;
using bf16x8=__attribute__((ext_vector_type(8)))short;
using s16x4=__attribute__((ext_vector_type(4)))short;
using f32x16=__attribute__((ext_vector_type(16)))float;
using u32x4=__attribute__((ext_vector_type(4)))unsigned;
constexpr int BATCH=16,SEQ=4096,D=64,DM=512,DMO=1024;
constexpr int NW=8,QBLK=32,QB=QBLK*NW,KVBLK=64,NQB=SEQ/QB;
constexpr int ATTN_UNIT_ROWS=QB;
__device__ __forceinline__ int crow(int r,int hi){return (r&3)+8*(r>>2)+4*hi;}
#define SBAR() __builtin_amdgcn_sched_barrier(0)
__device__ __forceinline__ void cmask(f32x16&p0,f32x16&p1,int jb,int qrel,int hi){
  const float NEG=-INFINITY; int kb=64*jb+4*hi; asm volatile("":"+v"(kb));
  #pragma unroll
  for(int r=0;r<16;++r){int kv=kb+(r&3)+8*(r>>2); if(kv>qrel)p0[r]=NEG; if(kv+32>qrel)p1[r]=NEG;}
}

constexpr int NSLOT=3, SLOTB=8192;
constexpr int LDS_K=0, LDS_V=NSLOT*SLOTB, LDS_WS=2*NSLOT*SLOTB, LDS_OST=LDS_WS+NW*64*4, LDS_BYTES=LDS_OST+NW*4096;
constexpr float C2=0.125f*1.4426950408889634f;
__device__ __forceinline__ void glds16(const void*gsrc,unsigned lds_dst){unsigned keep;
  asm volatile("s_mov_b32 %0, m0\n\ts_mov_b32 m0, %2\n\ts_nop 0\n\tglobal_load_lds_dwordx4 %1, off\n\ts_mov_b32 m0, %0":"=&s"(keep):"v"(gsrc),"s"(lds_dst):"memory");}
__device__ __forceinline__ float max3f(float a,float b,float c){float r;asm("v_max3_f32 %0, %1, %2, %3":"=v"(r):"v"(a),"v"(b),"v"(c));return r;}
__device__ __forceinline__ float max2f(float a,float b){float r;asm("v_max_f32_e32 %0, %1, %2":"=v"(r):"v"(a),"v"(b));return r;}
__device__ __forceinline__ float fadd_s(float a,float b){float r;asm("v_add_f32_e32 %0, %1, %2":"=v"(r):"v"(a),"v"(b));return r;}
__device__ __forceinline__ float fsub_s(float a,float b){float r;asm("v_sub_f32_e32 %0, %1, %2":"=v"(r):"v"(a),"v"(b));return r;}
typedef float f32x2_t __attribute__((ext_vector_type(2))); typedef __bf16 bf16x2_t __attribute__((ext_vector_type(2)));
__device__ __forceinline__ unsigned cvtpk_s(float lo,float hi){f32x2_t v={lo,hi};bf16x2_t b=__builtin_convertvector(v,bf16x2_t);return __builtin_bit_cast(unsigned,b);}
#define WAIT_BAR(N) asm volatile("s_waitcnt vmcnt(" #N ") lgkmcnt(0)\n\ts_barrier":::"memory")

__device__ __forceinline__ void qkt(f32x16&p0,f32x16&p1,const char*Kslot,const bf16x8*qr,const f32x16&i0,const f32x16&i1,int r32,int hi){
  const char*kb=Kslot+hi*1024+r32*16;
  #pragma unroll
  for(int d0=0;d0<4;++d0){
    const bf16x8 b0=*reinterpret_cast<const bf16x8*>(kb+d0*2048);
    const bf16x8 b1=*reinterpret_cast<const bf16x8*>(kb+d0*2048+512);
    if(d0==0){p0=__builtin_amdgcn_mfma_f32_32x32x16_bf16(b0,qr[0],i0,0,0,0);p1=__builtin_amdgcn_mfma_f32_32x32x16_bf16(b1,qr[0],i1,0,0,0);}
    else{p0=__builtin_amdgcn_mfma_f32_32x32x16_bf16(b0,qr[d0],p0,0,0,0);p1=__builtin_amdgcn_mfma_f32_32x32x16_bf16(b1,qr[d0],p1,0,0,0);}}
}
typedef __attribute__((address_space(3))) const char* lds_cptr;
typedef short v4i16_t __attribute__((ext_vector_type(4)));
__device__ __forceinline__ void kload8(bf16x8*kf,lds_cptr kp){
  kf[0]=*(const __attribute__((address_space(3))) bf16x8*)(kp);      kf[1]=*(const __attribute__((address_space(3))) bf16x8*)(kp+512);
  kf[2]=*(const __attribute__((address_space(3))) bf16x8*)(kp+2048); kf[3]=*(const __attribute__((address_space(3))) bf16x8*)(kp+2560);
  kf[4]=*(const __attribute__((address_space(3))) bf16x8*)(kp+4096); kf[5]=*(const __attribute__((address_space(3))) bf16x8*)(kp+4608);
  kf[6]=*(const __attribute__((address_space(3))) bf16x8*)(kp+6144); kf[7]=*(const __attribute__((address_space(3))) bf16x8*)(kp+6656);
}
__device__ __forceinline__ void kload2(bf16x8*kf,lds_cptr kp,int j){ kf[2*j]=*(const __attribute__((address_space(3))) bf16x8*)(kp+j*2048); kf[2*j+1]=*(const __attribute__((address_space(3))) bf16x8*)(kp+j*2048+512); }
__device__ __forceinline__ s16x4 vtr(lds_cptr p){ return __builtin_bit_cast(s16x4,__builtin_amdgcn_ds_read_tr16_b64_v4i16((__attribute__((address_space(3))) v4i16_t*)p)); }
__device__ __forceinline__ float rowmax(const f32x16&p0,const f32x16&p1){
  float a=max3f(p0[0],p0[1],p1[0]),b=max3f(p0[2],p0[3],p1[1]);a=max3f(a,p1[2],p1[3]);
  #pragma unroll
  for(int r=4;r<16;r+=4){a=max3f(a,p0[r],p0[r+1]);b=max3f(b,p0[r+2],p0[r+3]);a=max3f(a,p1[r],p1[r+1]);b=max3f(b,p1[r+2],p1[r+3]);}
  const float m=max2f(a,b);
  auto rr=__builtin_amdgcn_permlane32_swap(__float_as_uint(m),__float_as_uint(m),false,false);
  return max2f(__uint_as_float(rr[0]),__uint_as_float(rr[1]));
}
__device__ __forceinline__ void pv(f32x16*o,int vb,bf16x8 pa0,bf16x8 pa1,bf16x8 pa2,bf16x8 pa3){
  #pragma unroll
  for(int d0=0;d0<2;++d0){s16x4 lo[4],hi[4];
    #pragma unroll
    for(int ks=0;ks<4;++ks){
      asm volatile("ds_read_b64_tr_b16 %0,%1 offset:%c2":"=&v"(lo[ks]):"v"(vb),"i"(d0*4096+ks*1024):"memory");
      asm volatile("ds_read_b64_tr_b16 %0,%1 offset:%c2":"=&v"(hi[ks]):"v"(vb),"i"(d0*4096+ks*1024+512):"memory");}
    asm volatile("s_waitcnt lgkmcnt(0)":::"memory");SBAR();
    #define PK(k) (bf16x8){lo[k][0],lo[k][1],lo[k][2],lo[k][3],hi[k][0],hi[k][1],hi[k][2],hi[k][3]}
    o[d0]=__builtin_amdgcn_mfma_f32_32x32x16_bf16(pa0,PK(0),o[d0],0,0,0);
    o[d0]=__builtin_amdgcn_mfma_f32_32x32x16_bf16(pa1,PK(1),o[d0],0,0,0);
    o[d0]=__builtin_amdgcn_mfma_f32_32x32x16_bf16(pa2,PK(2),o[d0],0,0,0);
    o[d0]=__builtin_amdgcn_mfma_f32_32x32x16_bf16(pa3,PK(3),o[d0],0,0,0);
    #undef PK
  }
}

#ifndef ATTN_STORE16
#define ATTN_STORE16(p,v) (*(u32x4*)(p)=(v))
#endif
template<int THRL> __device__ __forceinline__ void attn_unit(int b,int hm,int half,int qb,float cs,const int wid,const float*PN,const bf16*Q,const bf16*__restrict__ K,const bf16*__restrict__ V,bf16*O,char*shm){
  int lane=lane_id(); asm volatile("":"+v"(lane));
  const int r32=lane&31,hi=lane>>5;
  const long rowbase=(long)b*SEQ; const int q0=qb*QB;
  const int NTf=(q0+QB)/KVBLK;
  int t0=0; float uref=0.f;
  { const float*pq=PN+((b*8+hm)*64)*2, *pk=PN+16384+((b*8+hm)*64)*2; float qm=0.f,km=0.f;
    if(lane<4){const float*p_=pq+(4*qb+lane)*2; qm=p_[0]+p_[1];} if(lane<NTf){const float*p_=pk+lane*2; km=p_[0]+p_[1];}
    _Pragma("unroll") for(int o_=1;o_<64;o_<<=1){qm=__builtin_fmaxf(qm,__shfl_xor(qm,o_));km=__builtin_fmaxf(km,__shfl_xor(km,o_));}
    const float need=(ATT_SKIP+2.04f*__builtin_sqrtf(qm*km))/cs;
    const float tf=((float)(q0-63)-need)*(1.f/64.f); int tt=tf>0.f?(int)tf:0; tt&=~1; if(tt>NTf-4)tt=NTf-4; t0=__builtin_amdgcn_readfirstlane(tt); uref=1.02f*__builtin_sqrtf(qm*km); }
  const bf16*Qw=Q+(rowbase+q0+wid*QBLK)*DM+hm*D;
  const bf16*Kh=K+(rowbase+64*t0)*DM+hm*D,*Vh=V+(rowbase+64*t0)*DM+(hm>>1)*128+half*64;
  const unsigned lds0=(unsigned)(uintptr_t)shm;
  float*wsf=(float*)(shm+LDS_WS)+wid*64;
  const bf16*ksrc=Kh+(long)lane*DM+wid*8;
  const bf16*vsrc=Vh+(long)(16*(wid&3)+(lane>>2))*DM+(wid>>2)*32+(lane&3)*8;
  const unsigned kdst=lds0+LDS_K+wid*1024, vdst=lds0+LDS_V+wid*1024;
  #define DMA_K(t,slot) glds16(ksrc+(long)(t)*KVBLK*DM,(unsigned)__builtin_amdgcn_readfirstlane(kdst+(slot)))
  #define DMA_V(t,slot) glds16(vsrc+(long)(t)*KVBLK*DM,(unsigned)__builtin_amdgcn_readfirstlane(vdst+(slot)))
  const int vb0=(int)(lds0+LDS_V)+((lane>>4)&1)*32+(lane&3)*8+(4*hi+((lane&15)>>2))*64;
  const char*Kbase=shm+LDS_K; bf16x8 kf[8];
  const lds_cptr shm3=(lds_cptr)shm; const lds_cptr kp0=shm3+LDS_K+hi*1024+r32*16; const lds_cptr vp0=shm3+LDS_V+((lane>>4)&1)*32+(lane&3)*8+(4*hi+((lane&15)>>2))*64;
  const int NT=NTf-t0;
  DMA_K(0,0);DMA_V(0,0);DMA_K(1,SLOTB);
  bf16x8 qr[4];
  #pragma unroll
  for(int d0=0;d0<4;++d0)qr[d0]=*reinterpret_cast<const bf16x8*>(&Qw[(long)r32*DM+d0*16+hi*8]);
  float mhat=0.f,l_reg=0.f;f32x16 o[2];o[0]=f32x16{};o[1]=f32x16{};
  const int qrel=wid*QBLK+r32;
  float nb=-uref-cs*(float)(q0+qrel-4*hi-64*t0);
  const float cs8=__builtin_bit_cast(float,__builtin_amdgcn_readfirstlane(__builtin_bit_cast(int,8.f*cs)));
  #define CINIT1(C,t,X) do{ C[0]=nb+cs*(float)(64*(t)+(X)); C[1]=C[0]+cs; C[2]=C[1]+cs; C[3]=C[2]+cs; _Pragma("unroll") for(int r=4;r<16;++r) C[r]=C[r-4]+cs8; asm volatile("":"+v"(C)); }while(0)
  #define CINIT(C0,C1,t) do{ CINIT1(C0,t,0); CINIT1(C1,t,32); }while(0)
  #define CMASK(P0,P1,t) do{int jb_=(t)-(NT-4); if(jb_>=0)cmask(P0,P1,jb_,qrel,hi);}while(0)
  bool resc=false;
  #define START(P0,P1) do{ const float rm=rowmax(P0,P1); resc=false; \
    { const float dl=0.f; (void)rm; mhat=fadd_s(mhat,dl); nb=fsub_s(nb,dl);     \
      _Pragma("unroll") for(int r=0;r<16;++r){P0[r]=fsub_s(P0[r],dl);P1[r]=fsub_s(P1[r],dl);} } \
    _Pragma("unroll") for(int r=0;r<16;++r)P0[r]=__builtin_amdgcn_exp2f(P0[r]); }while(0)
  #define RESC() do{ if(THRL>=0&&resc){ asm volatile("s_waitcnt lgkmcnt(0)":::"memory"); \
      _Pragma("unroll") for(int d_=0;d_<2;++d_) _Pragma("unroll") for(int r=0;r<16;++r)o[d_][r]*=wsf[crow(r,hi)]; } }while(0)
  f32x16 pA0,pA1,pB0,pB1;
  int sl_prev=0,sl_cur=0,sl_next=SLOTB;
  #define ROT() do{sl_prev=sl_cur;sl_cur=sl_next;sl_next=(sl_next==(NSLOT-1)*SLOTB)?0:sl_next+SLOTB;}while(0)
  DMA_K(2,2*SLOTB);
  WAIT_BAR(3);
  { f32x16 i0_,i1_; CINIT(i0_,i1_,0); qkt(pA0,pA1,Kbase,qr,i0_,i1_,r32,hi); } asm volatile("s_nop 15\n\ts_nop 7":"+v"(pA0),"+v"(pA1));CMASK(pA0,pA1,0);
  START(pA0,pA1);
  _Pragma("unroll") for(int r=0;r<16;++r)pA1[r]=__builtin_amdgcn_exp2f(pA1[r]);
  WAIT_BAR(0);
  DMA_K(3,0);DMA_V(1,SLOTB);
  ROT();
  kload8(kf,kp0+sl_cur);
  WAIT_BAR(2);
  s16x4 vlo[8],vhi[8]; u32x4 pw0,pw1,pw2,pw3;
  #define PKW(P,B) cvtpk_s(P[B],P[B+1])
  #define PAF(k) __builtin_bit_cast(bf16x8,pw##k)
  #define VFR(i) (bf16x8){vlo[i][0],vlo[i][1],vlo[i][2],vlo[i][3],vhi[i][0],vhi[i][1],vhi[i][2],vhi[i][3]}
  #define PIN(x) asm volatile("":"+v"(x))
  #define MX3(a,b,c) __builtin_fmaxf(__builtin_fmaxf((a),(b)),(c))
  #define GAPA(MF,A0,A1,A2,A3,W0,W1,PW) do{ MF; sacc+=A0; sacc+=A1; sacc+=A2; sacc+=A3; PIN(sacc); W0; W1; PIN(PW); SBAR(); }while(0)
  #define EX(v) __builtin_amdgcn_exp2f(v)
  #define GAPB(MF,X,B) do{ MF; X[B]=EX(X[B]); X[B+1]=EX(X[B+1]); X[B+2]=EX(X[B+2]); X[B+3]=EX(X[B+3]); PIN(X); SBAR(); }while(0)
  #define VRD(i) do{ vlo[i]=vtr(vp_+(((i)>>2)*4096+((i)&3)*1024)); vhi[i]=vtr(vp_+(((i)>>2)*4096+((i)&3)*1024+512)); }while(0)
  #define KRD(G,j) do{ if(G){ kload2(kf,kp0+sl_next,j); SBAR(); } }while(0)
  #define STEP(C0,C1,P0,P1,t,GK,GV,GL) do{ SBAR(); \
    const lds_cptr vp_=vp0+sl_prev; \
    VRD(0); SBAR(); float sacc=(P0[0]+P0[1]); CINIT1(C0,t,0); SBAR(); \
    GAPA(C0=__builtin_amdgcn_mfma_f32_32x32x16_bf16(kf[0],qr[0],C0,0,0,0), P0[2],P0[3],P0[4],P0[5],     pw0[0]=PKW(P0,0), pw0[1]=PKW(P0,2), pw0); \
    VRD(4); SBAR(); CINIT1(C1,t,32); SBAR(); GAPA(C1=__builtin_amdgcn_mfma_f32_32x32x16_bf16(kf[1],qr[0],C1,0,0,0), P0[6],P0[7],P0[8],P0[9],     pw0[2]=PKW(P0,4), pw0[3]=PKW(P0,6), pw0); \
    VRD(1); SBAR(); GAPA(C0=__builtin_amdgcn_mfma_f32_32x32x16_bf16(kf[2],qr[1],C0,0,0,0),   P0[10],P0[11],P0[12],P0[13], pw1[0]=PKW(P0,8), pw1[1]=PKW(P0,10), pw1); \
    VRD(5); SBAR(); GAPA(C1=__builtin_amdgcn_mfma_f32_32x32x16_bf16(kf[3],qr[1],C1,0,0,0),   P0[14],P0[15],P1[0],P1[1],   pw1[2]=PKW(P0,12),pw1[3]=PKW(P0,14), pw1); \
    VRD(2); SBAR(); GAPA(C0=__builtin_amdgcn_mfma_f32_32x32x16_bf16(kf[4],qr[2],C0,0,0,0),   P1[2],P1[3],P1[4],P1[5],     pw2[0]=PKW(P1,0), pw2[1]=PKW(P1,2), pw2); \
    VRD(6); SBAR(); GAPA(C1=__builtin_amdgcn_mfma_f32_32x32x16_bf16(kf[5],qr[2],C1,0,0,0),   P1[6],P1[7],P1[8],P1[9],     pw2[2]=PKW(P1,4), pw2[3]=PKW(P1,6), pw2); \
    VRD(3); SBAR(); GAPA(C0=__builtin_amdgcn_mfma_f32_32x32x16_bf16(kf[6],qr[3],C0,0,0,0),   P1[10],P1[11],P1[12],P1[13], pw3[0]=PKW(P1,8), pw3[1]=PKW(P1,10), pw3); \
    VRD(7); SBAR(); GAPA(C1=__builtin_amdgcn_mfma_f32_32x32x16_bf16(kf[7],qr[3],C1,0,0,0),   P1[14],P1[15],0.f,0.f,       pw3[2]=PKW(P1,12),pw3[3]=PKW(P1,14), pw3); \
    l_reg+=sacc; \
    if(GK){DMA_K((t)+3,sl_cur);} if(GV){DMA_V((t)+1,sl_next);} \
    CMASK(C0,C1,t); \
    { float a=MX3(C0[0],C0[1],C1[0]),b=MX3(C0[2],C0[3],C1[1]); a=MX3(a,C1[2],C1[3]); \
      _Pragma("unroll") for(int r=4;r<16;r+=4){a=MX3(a,C0[r],C0[r+1]);b=MX3(b,C0[r+2],C0[r+3]);a=MX3(a,C1[r],C1[r+1]);b=MX3(b,C1[r+2],C1[r+3]);} \
      float rm=__builtin_fmaxf(a,b); { auto rr=__builtin_amdgcn_permlane32_swap(__float_as_uint(rm),__float_as_uint(rm),false,false); rm=__builtin_fmaxf(__uint_as_float(rr[0]),__uint_as_float(rr[1])); } \
      resc=false; \
      if(THRL>=0&&__builtin_expect(__any(rm>(float)THRL),0)){ const float dl=__builtin_fmaxf(rm,0.f); mhat+=dl; nb-=dl; \
        _Pragma("unroll") for(int r=0;r<16;++r){C0[r]-=dl;C1[r]-=dl;} \
        const float f=__builtin_amdgcn_exp2f(-dl); l_reg*=f; if(hi==0)wsf[r32]=f; resc=true; } } \
    SBAR(); \
    GAPB(o[0]=__builtin_amdgcn_mfma_f32_32x32x16_bf16(PAF(0),VFR(0),o[0],0,0,0), C0,0); \
    GAPB(o[1]=__builtin_amdgcn_mfma_f32_32x32x16_bf16(PAF(0),VFR(4),o[1],0,0,0), C0,4); \
    KRD(GL,0); GAPB(o[0]=__builtin_amdgcn_mfma_f32_32x32x16_bf16(PAF(1),VFR(1),o[0],0,0,0), C0,8); \
    KRD(GL,1); GAPB(o[1]=__builtin_amdgcn_mfma_f32_32x32x16_bf16(PAF(1),VFR(5),o[1],0,0,0), C0,12); \
    KRD(GL,2); GAPB(o[0]=__builtin_amdgcn_mfma_f32_32x32x16_bf16(PAF(2),VFR(2),o[0],0,0,0), C1,0); \
    KRD(GL,3); GAPB(o[1]=__builtin_amdgcn_mfma_f32_32x32x16_bf16(PAF(2),VFR(6),o[1],0,0,0), C1,4); \
    GAPB(o[0]=__builtin_amdgcn_mfma_f32_32x32x16_bf16(PAF(3),VFR(3),o[0],0,0,0), C1,8); \
    GAPB(o[1]=__builtin_amdgcn_mfma_f32_32x32x16_bf16(PAF(3),VFR(7),o[1],0,0,0), C1,12); \
    }while(0)
  int t=1;
  #undef CMASK
  #define CMASK(P0,P1,t) do{}while(0)
  for(;t+5<NT;t+=2){
    STEP(pB0,pB1,pA0,pA1,t,true,true,true);     WAIT_BAR(2); RESC(); ROT();
    STEP(pA0,pA1,pB0,pB1,t+1,true,true,true);   WAIT_BAR(2); RESC(); ROT();
  }
  #undef CMASK
  #define CMASK(P0,P1,t) do{int jb_=(t)-(NT-4); if(jb_>=0)cmask(P0,P1,jb_,qrel,hi);}while(0)
  #define ENDW(tt) do{ if((tt)+3<NT){WAIT_BAR(2);} else if((tt)+2<NT){WAIT_BAR(1);} else {WAIT_BAR(0);} }while(0)
  for(;t+1<NT;t+=2){
    STEP(pB0,pB1,pA0,pA1,t,(t+3<NT),(t+1<NT),(t+1<NT));       ENDW(t);   RESC(); ROT();
    STEP(pA0,pA1,pB0,pB1,t+1,(t+4<NT),(t+2<NT),(t+2<NT));     ENDW(t+1); RESC(); ROT();
  }
  STEP(pB0,pB1,pA0,pA1,NT-1,false,false,false); RESC();
  { float sacc=pB0[0]+pB0[1]; _Pragma("unroll") for(int r=2;r<16;++r)sacc+=pB0[r]; _Pragma("unroll") for(int r=0;r<16;++r)sacc+=pB1[r]; l_reg+=sacc;
    pw0=(u32x4){PKW(pB0,0),PKW(pB0,2),PKW(pB0,4),PKW(pB0,6)};pw1=(u32x4){PKW(pB0,8),PKW(pB0,10),PKW(pB0,12),PKW(pB0,14)};pw2=(u32x4){PKW(pB1,0),PKW(pB1,2),PKW(pB1,4),PKW(pB1,6)};pw3=(u32x4){PKW(pB1,8),PKW(pB1,10),PKW(pB1,12),PKW(pB1,14)};
    SBAR(); pv(o,vb0+sl_cur,PAF(0),PAF(1),PAF(2),PAF(3)); }
  #undef PKW
  #undef PAF
  #undef VFR
  #undef PIN
  #undef MX3
  #undef GAPA
  #undef GAPB
  #undef EX
  #undef VRD
  #undef KRD
  #undef STEP
  #undef ENDW
  {auto rr=__builtin_amdgcn_permlane32_swap(__float_as_uint(l_reg),__float_as_uint(l_reg),false,false);l_reg=__uint_as_float(rr[0])+__uint_as_float(rr[1]);}
  if(hi==0)wsf[32+r32]=l_reg;asm volatile("s_waitcnt lgkmcnt(0)":::"memory");
  float rli[16];
  #pragma unroll
  for(int r=0;r<16;++r)rli[r]=__builtin_amdgcn_rcpf(wsf[32+crow(r,hi)]);
  bf16*Ow=O+(rowbase+q0+wid*QBLK)*DMO+(hm>>1)*256+(hm&1)*128+half*64;
  { bf16*stg=(bf16*)(shm+LDS_OST)+wid*2048;
    int eoff=hi*256+r32; asm volatile("":"+v"(eoff));
    #pragma unroll
    for(int r=0;r<16;++r){const int orow=(r&3)+8*(r>>2);
      #pragma unroll
      for(int d0=0;d0<2;++d0)stg[eoff+orow*64+d0*32]=__float2bfloat16(o[d0][r]*rli[r]);}
    asm volatile("s_waitcnt lgkmcnt(0)":::"memory");
    #pragma unroll
    for(int i=0;i<4;++i){const int row=i*8+(lane>>3),ch=lane&7; const u32x4 v=*(const u32x4*)(stg+row*64+ch*8); ATTN_STORE16(Ow+(long)row*DMO+ch*8,v);} }
  asm volatile("s_waitcnt lgkmcnt(0)\n\ts_barrier":::"memory");
  #undef DMA_K
  #undef DMA_V
  #undef CMASK
  #undef START
  #undef RESC
  #undef ROT
  #undef CINIT
  #undef CINIT1
}
constexpr int ATTN_LDS_BYTES=LDS_BYTES;
struct AttnTensors { const bf16* Q; const bf16* K; const bf16* V; bf16* O; const float* PN; unsigned* queue; };
__device__ __forceinline__ void unit_of(int u,int&b,int&vh,int&qb){ if(u<2048){qb=15-(u>>7);const int r=u&127;b=r>>3;vh=8+(r&7);} else if(u<3072){const int v=u-2048;qb=15-(v>>6);const int r=v&63;b=r>>2;vh=4+(r&3);} else {const int v=u-3072;qb=15-(v>>6);const int r=v&63;b=r>>2;vh=r&3;} }
template<int THRL=8> __device__ __forceinline__ void attn_phase(char*lds,const AttnTensors&T,const int wid){
  volatile __attribute__((address_space(3))) int* slot=(volatile __attribute__((address_space(3))) int*)(lds+LDS_BYTES);
  const bool lead=(wid==0)&&(lane_id()==0);
  if(lead) *slot=(int)__hip_atomic_fetch_add(T.queue,1u,__ATOMIC_RELAXED,__HIP_MEMORY_SCOPE_AGENT);
  asm volatile("s_waitcnt vmcnt(0) lgkmcnt(0)\n\ts_barrier":::"memory");
  int cur=__builtin_amdgcn_readfirstlane(*slot);
  asm volatile("s_waitcnt lgkmcnt(0)\n\ts_barrier":::"memory");
  while(cur<BATCH*16*NQB){
    int nxt=0; if(lead) nxt=(int)__hip_atomic_fetch_add(T.queue,1u,__ATOMIC_RELAXED,__HIP_MEMORY_SCOPE_AGENT);
    int b,vh,qb; unit_of(cur,b,vh,qb); const int hm=vh>>1,half=vh&1;
    const float cs=__builtin_bit_cast(float,__builtin_amdgcn_readfirstlane(__builtin_bit_cast(int,__builtin_amdgcn_exp2f(-2.f*(float)((hm>>1)+1))*1.4426950408889634f)));
    attn_unit<THRL>(b,hm,half,qb,cs,wid,T.PN,T.Q,T.K,T.V,T.O,lds);
    if(lead) *slot=nxt;
    asm volatile("s_waitcnt vmcnt(0) lgkmcnt(0)\n\ts_barrier":::"memory");
    cur=__builtin_amdgcn_readfirstlane(*slot);
    asm volatile("s_waitcnt lgkmcnt(0)\n\ts_barrier":::"memory");
  }
}
#undef SBAR
#undef WAIT_BAR
}
constexpr int NWAVES = 8;
constexpr int RING_OFF = 0, RING_BYTES = 131072;
constexpr int LDSCTL_OFF = RING_BYTES, MISC_OFF = LDSCTL_OFF + 320;
constexpr int LDS_BYTES = 163840;

#define XB_TMO      128
#define XB_XCNT(j)  (256  + 64 * (j))
#define XB_XSUB(j)  (1280 + 64 * (j))
#define XB_XGEN(j)  (2304 + 64 * (j))
#define XB_TOP      3328
#define XB_TOPGEN   3392
#define XCD_BAR_WORDS 3456
#define XB_SPIN_CAP (1u << 18)
__device__ __forceinline__ unsigned xb_ld(unsigned* p)              { return __hip_atomic_load(p, __ATOMIC_RELAXED, __HIP_MEMORY_SCOPE_AGENT); }
__device__ __forceinline__ unsigned xb_add(unsigned* p, unsigned v) { return __hip_atomic_fetch_add(p, v, __ATOMIC_RELAXED, __HIP_MEMORY_SCOPE_AGENT); }
__device__ __forceinline__ unsigned xb_xcc_id() { return (unsigned)__builtin_amdgcn_s_getreg((3 << 11) | 20) & 0xFu; }
#define XB_SPIN(cond, bar) do { unsigned _sp = 0; while (cond) { __builtin_amdgcn_s_sleep(1); \
    if ((++_sp & 255u) == 0u) { if (xb_ld(&(bar)[XB_TMO])) break; if (_sp > XB_SPIN_CAP) { atomicAdd(&(bar)[XB_TMO], 1u); break; } } } } while (0)
struct XcdBarrier { unsigned* bar; unsigned x; volatile LAS unsigned* st; bool wave0; };
__device__ __forceinline__ XcdBarrier xcd_barrier_post(unsigned* bar, volatile LAS unsigned* st) {
    XcdBarrier b; b.bar = bar; b.x = xb_xcc_id(); b.st = st; b.wave0 = __builtin_amdgcn_readfirstlane(threadIdx.x >> 6) == 0;
    if (threadIdx.x == 0) (void)xb_add(&bar[XB_XCNT(b.x)], 1u);
    return b;
}
__device__ __forceinline__ void xcd_barrier_complete(unsigned* bar, unsigned x, unsigned& nloc, unsigned& nx) {
    const unsigned G = gridDim.x * gridDim.y * gridDim.z;
    unsigned sum, cnt, mine, sp = 0u;
    for (;;) {
        sum = 0u; cnt = 0u; mine = 0u;
#pragma unroll
        for (unsigned j = 0; j < 16; ++j) { const unsigned c = xb_ld(&bar[XB_XCNT(j)]); sum += c; cnt += (c > 0u) ? 1u : 0u; mine = (j == x) ? c : mine; }
        if (sum == G) break;
        __builtin_amdgcn_s_sleep(1);
        if ((++sp & 255u) == 0u) { if (xb_ld(&bar[XB_TMO])) break; if (sp > XB_SPIN_CAP) { atomicAdd(&bar[XB_TMO], 1u); break; } }
    }
    nloc = mine > 0u ? mine : 1u; nx = cnt > 0u ? cnt : 1u;
}
__device__ __forceinline__ void xcd_barrier(const XcdBarrier& b) {
    asm volatile("s_waitcnt vmcnt(0)" ::: "memory");
    __syncthreads();
    if (b.wave0 && lane_id() == 0) {
        unsigned* bar = b.bar;
        __builtin_amdgcn_s_waitcnt(0);
        unsigned nloc = b.st[0], nx = b.st[1];
        if (nloc == 0u) { xcd_barrier_complete(bar, b.x, nloc, nx); b.st[0] = nloc; b.st[1] = nx; }
        const unsigned old = xb_add(&bar[XB_XSUB(b.x)], 1u);
        const unsigned gen = old / nloc;
        if (old + 1u == (gen + 1u) * nloc) {
            __builtin_amdgcn_fence(__ATOMIC_RELEASE, "agent");
            asm volatile("s_waitcnt vmcnt(0)" ::: "memory");
            const unsigned og = xb_add(&bar[XB_TOP], 1u);
            const unsigned tg = og / nx;
            if (og + 1u == (tg + 1u) * nx) xb_add(&bar[XB_TOPGEN], 1u);
            else XB_SPIN(xb_ld(&bar[XB_TOPGEN]) == tg, bar);
            __builtin_amdgcn_fence(__ATOMIC_ACQUIRE, "agent");
            xb_add(&bar[XB_XGEN(b.x)], 1u);
            asm volatile("s_waitcnt vmcnt(0)" ::: "memory");
        } else {
            XB_SPIN(xb_ld(&bar[XB_XGEN(b.x)]) == gen, bar);
            __builtin_amdgcn_fence(__ATOMIC_ACQUIRE, "agent");
            asm volatile("s_waitcnt vmcnt(0)" ::: "memory");
        }
    }
    __syncthreads();
}

struct Frame {
    LAS unsigned char* lds; volatile LAS unsigned* MISC; gu32* ctl;
    int tid, lane, wave, vcu, G;
};
__device__ __forceinline__ float bf2f_(unsigned short b) { return __builtin_bit_cast(float, (unsigned)b << 16); }
__device__ __forceinline__ float wave_sum(float v) {
#pragma unroll
    for (int o = 1; o < 64; o <<= 1) v += __shfl_xor(v, o);
    return v;
}
__device__ __forceinline__ void p0_transpose_item(const float* W, int ldw, int K, bf16* WT, int k0, int n0, int drow0, LAS float* scr, int lane) {
#pragma unroll 8
    for (int i = 0; i < 32; ++i) { const int kk = 2 * i + (lane >> 5); scr[kk * 33 + (lane & 31)] = W[(size_t)(k0 + kk) * ldw + n0 + (lane & 31)]; }
    LDS_WAIT(); asm volatile("" ::: "memory");
    const int c = lane & 7;
#pragma unroll
    for (int j = 0; j < 4; ++j) { const int n = (lane >> 3) + 8 * j; const LAS float* s = scr + (8 * c) * 33 + n;
        v4u o; o.x = pk2(s[0 * 33], s[1 * 33]); o.y = pk2(s[2 * 33], s[3 * 33]); o.z = pk2(s[4 * 33], s[5 * 33]); o.w = pk2(s[6 * 33], s[7 * 33]);
        *(GAS v4u*)(WT + (size_t)(drow0 + n) * K + k0 + 8 * c) = o; }
    LDS_WAIT(); asm volatile("" ::: "memory");
}
__device__ __forceinline__ void p0_transpose_item_f8(const float* W, int ldw, int K, unsigned char* WT, int k0, int n0, int drow0, float scale, LAS float* scr, int lane) {
#pragma unroll 8
    for (int i = 0; i < 32; ++i) { const int kk = 2 * i + (lane >> 5); scr[kk * 33 + (lane & 31)] = W[(size_t)(k0 + kk) * ldw + n0 + (lane & 31)] * scale; }
    LDS_WAIT(); asm volatile("" ::: "memory");
    const int c = lane & 3;
#pragma unroll
    for (int j = 0; j < 2; ++j) { const int n = (lane >> 2) + 16 * j; const LAS float* s = scr + (16 * c) * 33 + n;
        v4u o; o.x = pg8::pk4_fp8(s[0 * 33], s[1 * 33], s[2 * 33], s[3 * 33]); o.y = pg8::pk4_fp8(s[4 * 33], s[5 * 33], s[6 * 33], s[7 * 33]);
        o.z = pg8::pk4_fp8(s[8 * 33], s[9 * 33], s[10 * 33], s[11 * 33]); o.w = pg8::pk4_fp8(s[12 * 33], s[13 * 33], s[14 * 33], s[15 * 33]);
        *(GAS v4u*)(WT + (size_t)(drow0 + n) * K + k0 + 16 * c) = o; }
    LDS_WAIT(); asm volatile("" ::: "memory");
}
struct Ptrs {
    const float *x, *p, *w_in, *b_gate, *lq1, *lk1, *lq2, *lk2, *subln, *w_abr, *w_pmix, *pscale, *w_pbr, *w_out, *ln1g, *ln1b, *w_router, *b_router, *w_up, *b_up, *w_down, *b_down, *w_pg, *w_pp, *ln2g, *ln2b;
    float* out; unsigned char* ws;
};
__device__ __forceinline__ void ph0_prologue(Frame& F, const Ptrs& P) {
    unsigned char* ws = P.ws;
    LAS float* scr = (LAS float*)(F.lds + RING_OFF + F.wave * 16384);
    const int gw = F.vcu * NWAVES + F.wave, NGW = F.G * NWAVES;
    { const size_t n4 = (size_t)M * D / 4, st = (size_t)F.G * 512; const f32x4* src = (const f32x4*)P.x; unsigned long long* dst = (unsigned long long*)(ws + WS_XB);
      unsigned* dst8 = (unsigned*)(ws + WS_XF8);
      for (size_t i = (size_t)blockIdx.x * 512 + F.tid; i < n4; i += st) { const f32x4 v = src[i]; dst[i] = (unsigned long long)pk2(v.x, v.y) | ((unsigned long long)pk2(v.z, v.w) << 32);
          if (PROJ_F8_FROM < 16) dst8[i] = pg8::pk4_fp8(v.x, v.y, v.z, v.w); } }
    constexpr int I_IN = 16 * 128, I_A = 8 * 32, I_O = 16 * 32, I_PG = 16 * 32, I_PP = 4 * 32, I_UP1 = 16 * 64, I_DN1 = 16 * 32;
    constexpr int I_UP = NEXP * I_UP1, I_DN = NEXP * I_DN1, NITEMS = I_IN + I_A + I_O + I_PG + I_PP + I_UP + I_DN;
    for (int it = gw; it < NITEMS; it += NGW) {
        int r = it;
        if (r < I_IN) { const int nb = 128, n0 = 32 * (r % nb);
            if (n0 >= 256 * PROJ_F8_FROM) p0_transpose_item_f8(P.w_in, 4096, 1024, ws + WS_WIN8, 64 * (r / nb), n0, n0 - 256 * PROJ_F8_FROM, WUP_SCALE, scr, F.lane);
            else p0_transpose_item(P.w_in, 4096, 1024, (bf16*)(ws + WS_WIN), 64 * (r / nb), n0, n0, scr, F.lane); continue; } r -= I_IN;
        if (r < I_A) { const int nb = 32; p0_transpose_item(P.w_abr, 1024, 1024, (bf16*)(ws + WS_WCAT), 64 * (r / nb), 32 * (r % nb), 32 * (r % nb), scr, F.lane); continue; } r -= I_A;
        if (r < I_O) { const int nb = 32; p0_transpose_item(P.w_out, 1024, 1024, (bf16*)(ws + WS_WOUT), 64 * (r / nb), 32 * (r % nb), 32 * (r % nb), scr, F.lane); continue; } r -= I_O;
        if (r < I_PG) { const int nb = 32; if (MOE_FP8) p0_transpose_item_f8(P.w_pg, 1024, 1024, ws + WS_WPG, 64 * (r / nb), 32 * (r % nb), 32 * (r % nb), WUP_SCALE, scr, F.lane);
            else p0_transpose_item(P.w_pg, 1024, 1024, (bf16*)(ws + WS_WPG), 64 * (r / nb), 32 * (r % nb), 32 * (r % nb), scr, F.lane); continue; } r -= I_PG;
        if (r < I_PP) { const int nb = 32; p0_transpose_item(P.w_pp, 1024, 256, (bf16*)(ws + WS_WPP), 64 * (r / nb), 32 * (r % nb), 32 * (r % nb), scr, F.lane); continue; } r -= I_PP;
        if (r < I_UP) { const int e = r / I_UP1, q = r % I_UP1, nb = 64, n0 = 32 * (q % nb);
            const int bj = n0 >> 10, pn = (n0 & 1023) >> 7, cp = n0 & 127;
            if (MOE_FP8) p0_transpose_item_f8(P.w_up + (size_t)e * 1024 * 2048, 2048, 1024, ws + WS_WUP + (size_t)e * 2048 * 1024, 64 * (q / nb), n0, 256 * pn + 128 * bj + cp, WUP_SCALE, scr, F.lane);
            else p0_transpose_item(P.w_up + (size_t)e * 1024 * 2048, 2048, 1024, (bf16*)(ws + WS_WUP) + (size_t)e * 2048 * 1024, 64 * (q / nb), n0, 256 * pn + 128 * bj + cp, scr, F.lane);
            continue; } r -= I_UP;
        { const int e = r / I_DN1, q = r % I_DN1, nb = 32;
            if (MOE_FP8) p0_transpose_item_f8(P.w_down + (size_t)e * 1024 * 1024, 1024, 1024, ws + WS_WDN + (size_t)e * 1024 * 1024, 64 * (q / nb), 32 * (q % nb), 32 * (q % nb), WDN_SCALE, scr, F.lane);
            else p0_transpose_item(P.w_down + (size_t)e * 1024 * 1024, 1024, 1024, (bf16*)(ws + WS_WDN) + (size_t)e * 1024 * 1024, 64 * (q / nb), 32 * (q % nb), 32 * (q % nb), scr, F.lane); }
    }
    { bf16* WPC = (bf16*)(ws + WS_WCAT) + 512;
      for (int k = blockIdx.x; k < 512; k += F.G) { const int g = k >> 7;
          float a0 = 0.f, a1 = 0.f; const float* wm = P.w_pmix + (size_t)k * 128; const float* sc = P.pscale + g * 128; const float* wb = P.w_pbr + (size_t)(g * 128) * 1024;
          for (int d = 0; d < 128; ++d) { const float w = wm[d] * sc[d]; a0 += w * wb[(size_t)d * 1024 + F.tid]; a1 += w * wb[(size_t)d * 1024 + 512 + F.tid]; }
          WPC[(size_t)F.tid * 1024 + k] = (bf16)f2bf(a0); WPC[(size_t)(F.tid + 512) * 1024 + k] = (bf16)f2bf(a1); } }
}
__device__ __forceinline__ void ph_pool(Frame& F, const Ptrs& P) {
    const bf16* U = (const bf16*)(P.ws + WS_U); bf16* PO = (bf16*)(P.ws + WS_APO) + 512;
    const size_t nitem = (size_t)M * 64, st = (size_t)F.G * 512;
    for (size_t idx = (size_t)blockIdx.x * 512 + F.tid; idx < nitem; idx += st) {
        const size_t row = idx >> 6; const int cg = (int)(idx & 63), c0 = cg * 8, pos = (int)(row & (SEQ - 1)), w = 2 << (c0 >> 7), n = pos + 1 < w ? pos + 1 : w;
        float s[8] = {0.f, 0.f, 0.f, 0.f, 0.f, 0.f, 0.f, 0.f}; v4u cur = *(const v4u*)(U + row * 512 + c0);
        for (int k = 0; k < n; ++k) { const v4u v = k == 0 ? cur : *(const v4u*)(U + (row - k) * 512 + c0);
            s[0] += pg8::bflo(v.x); s[1] += pg8::bfhi(v.x); s[2] += pg8::bflo(v.y); s[3] += pg8::bfhi(v.y); s[4] += pg8::bflo(v.z); s[5] += pg8::bfhi(v.z); s[6] += pg8::bflo(v.w); s[7] += pg8::bfhi(v.w); }
        const float rn = 1.f / (float)n; v4u o;
        o.x = pk2(s[0] * rn - pg8::bflo(cur.x), s[1] * rn - pg8::bfhi(cur.x)); o.y = pk2(s[2] * rn - pg8::bflo(cur.y), s[3] * rn - pg8::bfhi(cur.y));
        o.z = pk2(s[4] * rn - pg8::bflo(cur.z), s[5] * rn - pg8::bfhi(cur.z)); o.w = pk2(s[6] * rn - pg8::bflo(cur.w), s[7] * rn - pg8::bfhi(cur.w));
        *(v4u*)(PO + row * 1024 + c0) = o;
    }
}
__device__ __forceinline__ float lam_value(const Ptrs& P) { float a = 0.f, b = 0.f; for (int d = 0; d < 64; ++d) { a += P.lq1[d] * P.lk1[d]; b += P.lq2[d] * P.lk2[d]; } return __expf(a) - __expf(b) + 0.2f; }
__device__ __forceinline__ void ph_combine(Frame& F, const Ptrs& P) {
    const bf16* O16 = (const bf16*)(P.ws + WS_O16); bf16* OA = (bf16*)(P.ws + WS_APO); const float lam = lam_value(P);
    const int gw = F.vcu * NWAVES + F.wave, NGW = F.G * NWAVES, h = F.lane >> 4, e0 = (F.lane & 15) * 8;
    float sg[8];
#pragma unroll
    for (int j = 0; j < 8; ++j) sg[j] = P.subln[e0 + j] * 0.8f;
    for (int row = gw; row < M; row += NGW) {
        const v4u a = *(const v4u*)(O16 + (size_t)row * 1024 + h * 256 + e0), b = *(const v4u*)(O16 + (size_t)row * 1024 + h * 256 + 128 + e0);
        f32x4 a0, a1, b0, b1; pg8::unpack8(a, a0, a1); pg8::unpack8(b, b0, b1); a0 -= b0 * lam; a1 -= b1 * lam;
        float ss = (a0[0] * a0[0] + a0[1] * a0[1]) + (a0[2] * a0[2] + a0[3] * a0[3]) + (a1[0] * a1[0] + a1[1] * a1[1]) + (a1[2] * a1[2] + a1[3] * a1[3]);
        ss += __shfl_xor(ss, 1); ss += __shfl_xor(ss, 2); ss += __shfl_xor(ss, 4); ss += __shfl_xor(ss, 8);
        const float r = rsqrtf(ss * (1.f / 128.f) + LN_EPS);
#pragma unroll
        for (int j = 0; j < 4; ++j) { a0[j] *= r * sg[j]; a1[j] *= r * sg[4 + j]; }
        *(v4u*)(OA + (size_t)row * 1024 + h * 128 + e0) = pg8::pack8(a0, a1);
    }
}
typedef float f32x16_ __attribute__((ext_vector_type(16)));
__device__ __forceinline__ void hilo8(const f32x4& a, const f32x4& b, bf16x8& hi, bf16x8& lo) {
    unsigned h[4], l[4];
    h[0] = pg8::cvt_pk_bf16(a[0], a[1]); h[1] = pg8::cvt_pk_bf16(a[2], a[3]); h[2] = pg8::cvt_pk_bf16(b[0], b[1]); h[3] = pg8::cvt_pk_bf16(b[2], b[3]);
    l[0] = pg8::cvt_pk_bf16(a[0] - pg8::bflo(h[0]), a[1] - pg8::bfhi(h[0])); l[1] = pg8::cvt_pk_bf16(a[2] - pg8::bflo(h[1]), a[3] - pg8::bfhi(h[1]));
    l[2] = pg8::cvt_pk_bf16(b[0] - pg8::bflo(h[2]), b[1] - pg8::bfhi(h[2])); l[3] = pg8::cvt_pk_bf16(b[2] - pg8::bflo(h[3]), b[3] - pg8::bfhi(h[3]));
    v4u hv = {h[0], h[1], h[2], h[3]}, lv = {l[0], l[1], l[2], l[3]}; hi = __builtin_bit_cast(bf16x8, hv); lo = __builtin_bit_cast(bf16x8, lv);
}
__device__ __forceinline__ void ph6_ln1_route(Frame& F, const Ptrs& P, const bool dry) {
    unsigned char* ws = P.ws;
    constexpr int XT_OFF = 0, XT_PITCH = 1028, PL_OFF = 16 * XT_PITCH * 4, LG_OFF = PL_OFF + 8 * 16 * 32 * 4, RS_OFF = LG_OFF + 256 * 33 * 4;
    static_assert(RS_OFF + 256 <= RING_BYTES, "ph6 LDS map");
    { const size_t n4 = (size_t)M * PLE / 4, st = (size_t)F.G * 512; const f32x4* src = (const f32x4*)P.p; unsigned long long* dst = (unsigned long long*)(ws + (dry ? 804 * MiB : WS_PB));
      for (size_t i = (size_t)blockIdx.x * 512 + F.tid; i < n4; i += st) { const f32x4 v = src[i]; dst[i] = (unsigned long long)pk2(v.x, v.y) | ((unsigned long long)pk2(v.z, v.w) << 32); } }
    const float* X1in = P.out; float* X1 = dry ? (float*)(ws + 356 * MiB) : P.out; bf16* X1B = (bf16*)(ws + (dry ? 612 * MiB : WS_X1B)); unsigned char* X1F8 = ws + (dry ? 740 * MiB : WS_X1F8);
    const int lane = F.lane, wave = F.wave, e = lane & 31, kh = lane >> 5;
    LAS float* XT = (LAS float*)(F.lds + XT_OFF); LAS float* PL = (LAS float*)(F.lds + PL_OFF); LAS float* LG = (LAS float*)(F.lds + LG_OFF);
    bf16x8 bh[8], bl[8];
#pragma unroll
    for (int s = 0; s < 8; ++s) { const float* wp = P.w_router + (size_t)(128 * wave + 16 * s + 8 * kh) * 32 + e;
        const f32x4 a = {wp[0], wp[32], wp[64], wp[96]}, b = {wp[128], wp[160], wp[192], wp[224]}; hilo8(a, b, bh[s], bl[s]); }
    f32x4 gam[4], bet[4];
#pragma unroll
    for (int j = 0; j < 4; ++j) { gam[j] = ((const f32x4*)P.ln1g)[lane + 64 * j]; bet[j] = ((const f32x4*)P.ln1b)[lane + 64 * j]; }
    const float brt = P.b_router[e];
    for (int chunk = blockIdx.x; chunk < M / 256; chunk += F.G) {
        f32x4 v[2][4];
#pragma unroll
        for (int i = 0; i < 2; ++i)
#pragma unroll
            for (int j = 0; j < 4; ++j) v[i][j] = ((const f32x4*)(X1in + (size_t)(chunk * 256 + 2 * wave + i) * 1024))[lane + 64 * j];
#pragma unroll 1
        for (int step = 0; step < 16; ++step) {
            f32x4 nx[2][4];
            if (step < 15) {
#pragma unroll
                for (int i = 0; i < 2; ++i)
#pragma unroll
                    for (int j = 0; j < 4; ++j) nx[i][j] = ((const f32x4*)(X1in + (size_t)(chunk * 256 + (step + 1) * 16 + 2 * wave + i) * 1024))[lane + 64 * j]; }
            float s0 = 0.f, s1 = 0.f;
#pragma unroll
            for (int j = 0; j < 4; ++j) { s0 += (v[0][j].x + v[0][j].y) + (v[0][j].z + v[0][j].w); s1 += (v[1][j].x + v[1][j].y) + (v[1][j].z + v[1][j].w); }
#pragma unroll
            for (int o = 1; o < 64; o <<= 1) { s0 += __shfl_xor(s0, o); s1 += __shfl_xor(s1, o); }
            const float m0 = s0 * (1.f / 1024.f), m1 = s1 * (1.f / 1024.f); float q0 = 0.f, q1 = 0.f;
#pragma unroll
            for (int j = 0; j < 4; ++j) { v[0][j] = v[0][j] - m0; v[1][j] = v[1][j] - m1;
                q0 += (v[0][j].x * v[0][j].x + v[0][j].y * v[0][j].y) + (v[0][j].z * v[0][j].z + v[0][j].w * v[0][j].w); q1 += (v[1][j].x * v[1][j].x + v[1][j].y * v[1][j].y) + (v[1][j].z * v[1][j].z + v[1][j].w * v[1][j].w); }
#pragma unroll
            for (int o = 1; o < 64; o <<= 1) { q0 += __shfl_xor(q0, o); q1 += __shfl_xor(q1, o); }
            const float r0 = rsqrtf(q0 * (1.f / 1024.f) + LN_EPS), r1 = rsqrtf(q1 * (1.f / 1024.f) + LN_EPS);
#pragma unroll
            for (int i = 0; i < 2; ++i) { const int rl = 2 * wave + i; const size_t row = (size_t)chunk * 256 + step * 16 + rl; const float rs = i ? r1 : r0;
#pragma unroll
                for (int j = 0; j < 4; ++j) { const f32x4 y = v[i][j] * rs * gam[j] + bet[j];
                    ((f32x4*)(X1 + row * 1024))[lane + 64 * j] = y;
                    ((unsigned long long*)(X1B + row * 1024))[lane + 64 * j] = (unsigned long long)pk2(y.x, y.y) | ((unsigned long long)pk2(y.z, y.w) << 32);
                    if (MOE_FP8) ((unsigned*)(X1F8 + row * 1024))[lane + 64 * j] = pg8::pk4_fp8(y.x, y.y, y.z, y.w);
                    *(LAS f32x4*)(XT + rl * XT_PITCH + 4 * (lane + 64 * j)) = y; } }
            __syncthreads();
            f32x16_ acc = {};
#pragma unroll
            for (int s = 0; s < 8; ++s) { const LAS float* xp = XT + (lane & 15) * XT_PITCH + 128 * wave + 16 * s + 8 * kh;
                const f32x4 a = *(const LAS f32x4*)xp, b = *(const LAS f32x4*)(xp + 4); bf16x8 ah, al; hilo8(a, b, ah, al);
                acc = __builtin_amdgcn_mfma_f32_32x32x16_bf16(ah, bh[s], acc, 0, 0, 0); acc = __builtin_amdgcn_mfma_f32_32x32x16_bf16(al, bh[s], acc, 0, 0, 0); acc = __builtin_amdgcn_mfma_f32_32x32x16_bf16(ah, bl[s], acc, 0, 0, 0); }
#pragma unroll
            for (int i = 0; i < 8; ++i) PL[(wave * 16 + (i & 3) + 8 * (i >> 2) + 4 * kh) * 32 + e] = acc[i];
            __syncthreads();
            { const int row = F.tid >> 5, ee = F.tid & 31; float sum = 0.f;
#pragma unroll
              for (int w = 0; w < 8; ++w) sum += PL[(w * 16 + row) * 32 + ee];
              LG[(step * 16 + row) * 33 + ee] = sum + __shfl(brt, ee); }
            if (step < 15) {
#pragma unroll
                for (int i = 0; i < 2; ++i)
#pragma unroll
                    for (int j = 0; j < 4; ++j) v[i][j] = nx[i][j]; }
        }
        __syncthreads();
        LAS int* cntl = (LAS int*)(F.lds + RS_OFF); LAS int* basel = cntl + 32;
        if (F.tid < 32) cntl[F.tid] = 0;
        int my_e[4] = {0, 0, 0, 0}; float my_g[4] = {0.f, 0.f, 0.f, 0.f};
        if (F.tid < 256) { float lg[32];
#pragma unroll
            for (int k = 0; k < 32; ++k) lg[k] = LG[F.tid * 33 + k];
            float tv[4];
#pragma unroll
            for (int r = 0; r < 4; ++r) { float bv = lg[0]; int bi = 0;
#pragma unroll
                for (int k = 1; k < 32; ++k) if (lg[k] > bv) { bv = lg[k]; bi = k; }
                tv[r] = bv; my_e[r] = bi;
#pragma unroll
                for (int k = 0; k < 32; ++k) if (k == bi) lg[k] = -INFINITY; }
            const float e1 = __expf(tv[1] - tv[0]), e2 = __expf(tv[2] - tv[0]), e3 = __expf(tv[3] - tv[0]), rs = 1.f / (1.f + e1 + e2 + e3);
            my_g[0] = rs; my_g[1] = e1 * rs; my_g[2] = e2 * rs; my_g[3] = e3 * rs; }
        __syncthreads();
        int rk[4] = {0, 0, 0, 0};
        if (F.tid < 256) {
#pragma unroll
            for (int k = 0; k < 4; ++k) rk[k] = __hip_atomic_fetch_add(&cntl[my_e[k]], 1, __ATOMIC_RELAXED, __HIP_MEMORY_SCOPE_WORKGROUP); }
        __syncthreads();
        if (F.tid < 32) basel[F.tid] = (int)__hip_atomic_fetch_add(F.ctl + CW_CNT + (dry ? 32 : 0) + F.tid, (unsigned)cntl[F.tid], RLX_AGENT);
        __syncthreads();
        if (F.tid < 256) { const int row = chunk * 256 + F.tid; int* LIST = (int*)(ws + (dry ? 836 * MiB : WS_LIST)); float* GATEL = (float*)(ws + (dry ? 844 * MiB : WS_GATEL)); float* GATE = (float*)(ws + (dry ? 852 * MiB : WS_GATE));
#pragma unroll
            for (int k = 0; k < 4; ++k) { const size_t o = (size_t)my_e[k] * 65536 + (size_t)(basel[my_e[k]] + rk[k]); LIST[o] = row * 4 + k; GATEL[o] = my_g[k]; GATE[row * 4 + k] = my_g[k]; } }
        __syncthreads();
    }
}
__device__ __forceinline__ void ph10_final(Frame& F, const Ptrs& P, const bool dry) {
    float* dst = dry ? (float*)(P.ws + 356 * MiB) : P.out;
    const bf16* PLEB = (const bf16*)(P.ws + WS_PLE); const bf16* YS0 = (const bf16*)(P.ws + WS_YS0); const bf16* YS1 = (const bf16*)(P.ws + WS_YS1); const bf16* YS2 = (const bf16*)(P.ws + WS_YS2); const bf16* YS3 = (const bf16*)(P.ws + WS_YS3);
    const int gw = F.vcu * NWAVES + F.wave, NGW = F.G * NWAVES, lane = F.lane;
    f32x4 gam[4], bet[4];
#pragma unroll
    for (int j = 0; j < 4; ++j) { gam[j] = ((const f32x4*)P.ln2g)[lane + 64 * j]; bet[j] = ((const f32x4*)P.ln2b)[lane + 64 * j]; }
    for (int row = gw; row < M; row += NGW) {
        f32x4 v[4]; float s = 0.f;
#pragma unroll
        for (int j = 0; j < 4; ++j) { const size_t o = (size_t)row * 256 + lane + 64 * j; v[j] = ((const f32x4*)P.out)[o] * ALPHA;
            { const unsigned long long e = ((const unsigned long long*)PLEB)[o]; const unsigned e0 = (unsigned)e, e1 = (unsigned)(e >> 32); v[j].x += pg8::bflo(e0); v[j].y += pg8::bfhi(e0); v[j].z += pg8::bflo(e1); v[j].w += pg8::bfhi(e1); }
            const unsigned long long a = ((const unsigned long long*)YS1)[o], b = ((const unsigned long long*)YS2)[o], c = ((const unsigned long long*)YS3)[o], d = ((const unsigned long long*)YS0)[o];
            const unsigned a0 = (unsigned)a, a1 = (unsigned)(a >> 32), b0 = (unsigned)b, b1 = (unsigned)(b >> 32), c0 = (unsigned)c, c1 = (unsigned)(c >> 32), d0 = (unsigned)d, d1 = (unsigned)(d >> 32);
            v[j].x += (pg8::bflo(d0) + pg8::bflo(a0)) + (pg8::bflo(b0) + pg8::bflo(c0)); v[j].y += (pg8::bfhi(d0) + pg8::bfhi(a0)) + (pg8::bfhi(b0) + pg8::bfhi(c0));
            v[j].z += (pg8::bflo(d1) + pg8::bflo(a1)) + (pg8::bflo(b1) + pg8::bflo(c1)); v[j].w += (pg8::bfhi(d1) + pg8::bfhi(a1)) + (pg8::bfhi(b1) + pg8::bfhi(c1));
            s += (v[j].x + v[j].y) + (v[j].z + v[j].w); }
        const float mean = wave_sum(s) * (1.f / 1024.f); float s2 = 0.f;
#pragma unroll
        for (int j = 0; j < 4; ++j) { v[j] = v[j] - mean; s2 += (v[j].x * v[j].x + v[j].y * v[j].y) + (v[j].z * v[j].z + v[j].w * v[j].w); }
        const float rstd = rsqrtf(wave_sum(s2) * (1.f / 1024.f) + LN_EPS);
#pragma unroll
        for (int j = 0; j < 4; ++j) ((f32x4*)dst)[(size_t)row * 256 + lane + 64 * j] = v[j] * rstd * gam[j] + bet[j];
    }
}
__device__ __forceinline__ void moe_tables(Frame& F) {
    LAS int* cnt = (LAS int*)(F.lds + pg8::TAB_CNT); LAS int* blk0 = (LAS int*)(F.lds + pg8::TAB_BLK0); LAS int* row0 = (LAS int*)(F.lds + pg8::TAB_ROW0);
    __syncthreads();
    if (F.tid < 32) cnt[F.tid] = (int)__hip_atomic_load(F.ctl + CW_CNT + F.tid, RLX_AGENT);
    __syncthreads();
    if (F.tid == 0) { int b = 0, r = 0; for (int e = 0; e < 32; ++e) { blk0[e] = b; row0[e] = r; b += (cnt[e] + 255) >> 8; r += cnt[e]; } blk0[32] = b; row0[32] = r; }
    __syncthreads();
}

constexpr int NPHASE = 11;
struct Args { Ptrs P; int ph_lo, ph_hi; };
__global__ void __launch_bounds__(NWAVES * 64, 2) mk_fwd(Args args) {
    extern __shared__ __attribute__((aligned(16))) unsigned char lds[];
    Frame F; const Ptrs& P = args.P;
    F.lds = (LAS unsigned char*)lds; F.MISC = (volatile LAS unsigned*)(F.lds + MISC_OFF);
    F.wave = __builtin_amdgcn_readfirstlane(threadIdx.x >> 6); F.lane = lane_id(); F.tid = F.wave * 64 + F.lane;
#define REFRESH() do { F.lane = lane_id(); asm volatile("" : "+v"(F.lane)); F.tid = F.wave * 64 + F.lane; } while (0)
    F.G = gridDim.x; { const int bx = blockIdx.x; F.vcu = (F.G % 8 == 0) ? (bx % 8) * (F.G / 8) + bx / 8 : bx; }
    unsigned char* ws = P.ws; F.ctl = (gu32*)(ws + WS_CTL);
    for (int u = F.tid; u < 1024 / 4; u += NWAVES * 64) ((LAS unsigned*)(F.lds + LDSCTL_OFF))[u] = 0u;
    __syncthreads();
    const int lo = args.ph_lo, hi = args.ph_hi;
    XcdBarrier bar = xcd_barrier_post((unsigned*)(F.ctl + CW_BAR) + lo * XCD_BAR_WORDS, F.MISC + 8);
#ifndef PH_COMPILE
#define PH_COMPILE 0x7ff
#endif
#define IN(k) ((((PH_COMPILE) >> (k)) & 1) && lo <= (k) && (k) < hi)
#define SEAM(k) do { if (IN(k) && IN((k) + 1)) xcd_barrier(bar); } while (0)
#ifndef REP2_MASK
#define REP2_MASK 0
#endif
#define REPS(k) for (int rep_ = 0; rep_ < ((((REP2_MASK) >> (k)) & 1) ? 2 : 1); ++rep_)
    bf16 *XB = (bf16*)(ws + WS_XB), *Q = (bf16*)(ws + WS_Q), *K = (bf16*)(ws + WS_K), *V = (bf16*)(ws + WS_V), *U = (bf16*)(ws + WS_U), *G = (bf16*)(ws + WS_G);
    bf16 *O16 = (bf16*)(ws + WS_O16), *APO = (bf16*)(ws + WS_APO), *MIX = (bf16*)(ws + WS_MIX), *X1B = (bf16*)(ws + WS_X1B), *HB = (bf16*)(ws + WS_HB), *PB = (bf16*)(ws + WS_PB);
    bf16* T = (bf16*)(ws + WS_T);

    if (IN(0)) REPS(0) { REFRESH(); ph0_prologue(F, P); } SEAM(0);
    if (IN(1)) REPS(1) {
        { pg8::Gemm g{XB, (const bf16*)(ws + WS_WIN), 1024}; pg8::StaticOrder S; S.init(M, 256 * (PROJ_F8_FROM < 16 ? PROJ_F8_FROM : 16), F.G, (int)blockIdx.x);
          pg8::EpiProj E{Q, K, V, U, G, P.b_gate, (float*)(F.ctl + CW_PN), C2Q, 1.f, 0, 0};
          pg8::gemm_phase(F.lds, F.wave, g, S, E); }
        if (PROJ_F8_FROM < 16) {
          pg8::Gemm g{(const bf16*)(ws + WS_XF8), (const bf16*)(ws + WS_WIN8), 512}; pg8::DenseF8Order S; S.init(M, 256 * (16 - PROJ_F8_FROM), F.G, (int)blockIdx.x);
          pg8::EpiProj E{Q, K, V, U, G, P.b_gate, (float*)(F.ctl + CW_PN), C2Q, 1.f / WUP_SCALE, PROJ_F8_FROM, 0};
          pg8::gemm_phase(F.lds, F.wave, g, S, E); }
    } SEAM(1);
    if (IN(2)) REPS(2) {
        const attn_body::AttnTensors AT{(const attn_body::bf16*)Q, (const attn_body::bf16*)K, (const attn_body::bf16*)V, (attn_body::bf16*)O16, (const float*)(F.ctl + CW_PN), (unsigned*)(F.ctl + CW_AQ)};
        attn_body::attn_phase<-1>((char*)lds + RING_OFF, AT, F.wave);
#ifdef TIME_PH2
        { attn_body::AttnTensors AT2 = AT; AT2.queue = (unsigned*)(F.ctl + CW_AQ + 64); attn_body::attn_phase<-1>((char*)lds + RING_OFF, AT2, F.wave); }
#endif
#ifndef NO_POOL
        REFRESH(); ph_pool(F, P);
#endif
    } SEAM(2);
    if (IN(3)) REPS(3) { REFRESH(); ph_combine(F, P); } SEAM(3);
    if (IN(4)) REPS(4) {
        pg8::StaticOrder S; S.init(M, 1024, F.G, (int)blockIdx.x);
        pg8::Gemm g{APO, (const bf16*)(ws + WS_WCAT), 1024}; pg8::EpiMixCat E{MIX, G}; pg8::gemm_phase(F.lds, F.wave, g, S, E);
    } SEAM(4);
    if (IN(5)) REPS(5) {
        pg8::Gemm g{MIX, (const bf16*)(ws + WS_WOUT), 1024}; pg8::StaticOrder S; S.init(M, 1024, F.G, (int)blockIdx.x);
        pg8::EpiF32<0> E{P.out, P.x, ALPHA, 1.f};
        pg8::gemm_phase(F.lds, F.wave, g, S, E);
    } SEAM(5);
#ifndef DRY_MASK
#define DRY_MASK 0
#endif
    if (IN(6)) { if ((DRY_MASK >> 6) & 1) { REFRESH(); ph6_ln1_route(F, P, true); } REFRESH(); ph6_ln1_route(F, P, false); } SEAM(6);
    if (IN(7)) {
        pg8::StaticOrder S; S.init(M, 1024, F.G, (int)blockIdx.x);
#ifndef NO_PH7A
        { pg8::Gemm g{PB, (const bf16*)(ws + WS_WPP), 256}; pg8::EpiF32<1> E{(float*)T, nullptr, 0.f, 1.f}; pg8::gemm_phase(F.lds, F.wave, g, S, E); }
#endif
        VM_WAIT(); __syncthreads();
#ifndef NO_PH7B
        if (MOE_FP8) { pg8::DenseF8Order S8; S8.init(M, 1024, F.G, (int)blockIdx.x);
            pg8::Gemm g{(const bf16*)(ws + WS_X1F8), (const bf16*)(ws + WS_WPG), 512}; pg8::EpiF32<3> E{(float*)(ws + WS_PLE), (const float*)T, ALPHA, 1.f / WUP_SCALE}; pg8::gemm_phase(F.lds, F.wave, g, S8, E); }
        else { pg8::Gemm g{X1B, (const bf16*)(ws + WS_WPG), 1024}; pg8::EpiF32<3> E{(float*)(ws + WS_PLE), (const float*)T, ALPHA, 1.f}; pg8::gemm_phase(F.lds, F.wave, g, S, E); }
#endif
    } SEAM(7);
    if (IN(8)) REPS(8) {
        REFRESH(); moe_tables(F);
        pg8::Gemm g{MOE_FP8 ? (const bf16*)(ws + WS_X1F8) : X1B, (const bf16*)(ws + WS_WUP), MOE_FP8 ? 512 : 1024};
        pg8::MoeOrder<true, MOE_FP8> S{8, F.G, (int)blockIdx.x, (const int*)(ws + WS_LIST), (const float*)(ws + WS_GATEL), (size_t)2048 * 1024 * (MOE_FP8 ? 1 : 2)};
        pg8::EpiUp<MOE_FP8> E{HB, P.b_up, MOE_FP8 ? 1.f / WUP_SCALE : 1.f, 0};
        pg8::gemm_phase(F.lds, F.wave, g, S, E);
    } SEAM(8);
    if (IN(9)) {
        REFRESH(); moe_tables(F);
        pg8::Gemm g{HB, (const bf16*)(ws + WS_WDN), MOE_FP8 ? 512 : 1024};
        pg8::MoeOrder<false, MOE_FP8> S{4, F.G, (int)blockIdx.x, (const int*)(ws + WS_LIST), (const float*)(ws + WS_GATEL), (size_t)1024 * 1024 * (MOE_FP8 ? 1 : 2)};
        pg8::EpiDown E{(bf16*)(ws + WS_YS0), (bf16*)(ws + WS_YS1), (bf16*)(ws + WS_YS2), (bf16*)(ws + WS_YS3), P.b_down, MOE_FP8 ? 1.f / (WDN_SCALE) : 1.f, 0};
        pg8::gemm_phase(F.lds, F.wave, g, S, E);
    } SEAM(9);
    if (IN(10)) { if ((DRY_MASK >> 10) & 1) { REFRESH(); ph10_final(F, P, true); } REFRESH(); ph10_final(F, P, false); }
#undef IN
#undef SEAM
}
#ifndef FAST_MASK
#define FAST_MASK 0x7ff
#endif
#ifndef MERGE_FAST
#define MERGE_FAST 1
#endif
extern "C" void kernel_launch(void* const* d_in, const int* in_sizes, int n_in, void* d_out, int out_size, void* d_ws, size_t ws_size, hipStream_t stream) {
    static int grid = 0;
    if (grid == 0) {
        if (n_in != 26 || ws_size < WS_END || out_size != M * D) { fprintf(stderr, "kernel_launch: unexpected shapes (n_in %d, ws %zu, out %d)\n", n_in, ws_size, out_size); grid = -1; return; }
        int dev = 0, cus = 0, per_cu = 0;
        if (hipGetDevice(&dev) != hipSuccess || hipDeviceGetAttribute(&cus, hipDeviceAttributeMultiprocessorCount, dev) != hipSuccess) { grid = -1; return; }
        if (hipFuncSetAttribute((const void*)mk_fwd, hipFuncAttributeMaxDynamicSharedMemorySize, LDS_BYTES) != hipSuccess) { fprintf(stderr, "kernel_launch: hipFuncSetAttribute failed\n"); grid = -1; return; }
        if (hipOccupancyMaxActiveBlocksPerMultiprocessor(&per_cu, (const void*)mk_fwd, NWAVES * 64, LDS_BYTES) != hipSuccess || per_cu < 1) fprintf(stderr, "kernel_launch: occupancy query says %d\n", per_cu);
        (void)hipGetLastError();
        grid = cus;
    }
    if (grid < 0) return;
    Ptrs P{};
    { const float** pp = (const float**)&P; for (int i = 0; i < 26; ++i) pp[i] = (const float*)d_in[i]; }
    P.out = (float*)d_out; P.ws = (unsigned char*)d_ws;
    unsigned char* ws = (unsigned char*)d_ws; float* out = (float*)d_out;
    unsigned* CTL = (unsigned*)(ws + WS_CTL); unsigned* CNT = CTL + CW_CNT; int* LIST = (int*)(ws + WS_LIST); float* GATE = (float*)(ws + WS_GATE); float* GATEL = (float*)(ws + WS_GATEL); float* WPCF = (float*)(ws + WS_WPCF);
    bf16 *XB = (bf16*)(ws + WS_XB), *PB = (bf16*)(ws + WS_PB), *Q = (bf16*)(ws + WS_Q), *K = (bf16*)(ws + WS_K), *V = (bf16*)(ws + WS_V), *U = (bf16*)(ws + WS_U), *G = (bf16*)(ws + WS_G);
    bf16 *O16 = (bf16*)(ws + WS_O16), *OA = (bf16*)(ws + WS_APO), *PO = (bf16*)(ws + WS_APO) + 512, *MIX = (bf16*)(ws + WS_MIX), *X1B = (bf16*)(ws + WS_X1B), *HB = (bf16*)(ws + WS_HB);
    bf16 *YS1 = (bf16*)(ws + WS_YS1), *YS2 = (bf16*)(ws + WS_YS2), *YS3 = (bf16*)(ws + WS_YS3); bf16* T = (bf16*)(ws + WS_T);
    (void)hipMemsetAsync(ws + WS_CTL, 0, CTL_ZERO_BYTES, stream);
    const unsigned fm = FAST_MASK;
    for (int ph = 0; ph < NPHASE;) {
        if ((fm >> ph) & 1u) {
            int hi = ph + 1; if (MERGE_FAST) while (hi < NPHASE && ((fm >> hi) & 1u)) ++hi;
            Args a{}; a.P = P; a.ph_lo = ph; a.ph_hi = hi;
            hipLaunchKernelGGL(mk_fwd, dim3(grid), dim3(NWAVES * 64), LDS_BYTES, stream, a);
            if (fm != 0x7ffu && ph == 0) { nv::k_fold_pool<<<512, 256, 0, stream>>>(P.w_pmix, P.pscale, P.w_pbr, WPCF); }
            ph = hi; continue;
        }
        switch (ph) {
        case 0: nv::k_cvt_bf16<<<2048, 256, 0, stream>>>(P.x, XB, (size_t)M * D / 4); nv::k_fold_pool<<<512, 256, 0, stream>>>(P.w_pmix, P.pscale, P.w_pbr, WPCF); break;
        case 1: nv::k_gemm<false><<<dim3(4096 / 64, M / 64, 1), 256, 0, stream>>>(nv::RowDense{XB, 1024, 0}, nv::EpiProj{Q, K, V, U, G, P.b_gate, C2Q, 0}, P.w_in, 0, 4096, 1024, 0, 0); break;
        case 2: nv::k_attn<<<dim3(SEQ / 256, 16, BATCH), 256, 0, stream>>>(Q, K, V, O16); nv::k_pool<<<(unsigned)((size_t)M * 512 / 256), 256, 0, stream>>>(U, PO); break;
        case 3: nv::k_combine<<<M / 4, 256, 0, stream>>>(O16, OA, P.lq1, P.lk1, P.lq2, P.lk2, P.subln); break;
        case 4: nv::k_gemm<false><<<dim3(1024 / 64, M / 64, 1), 256, 0, stream>>>(nv::RowDense{OA, 1024, 0}, nv::EpiMixA{MIX, G}, P.w_abr, 0, 1024, 512, 0, 0);
                nv::k_gemm<false><<<dim3(1024 / 64, M / 64, 1), 256, 0, stream>>>(nv::RowDense{PO, 1024, 0}, nv::EpiMixB{MIX, G}, WPCF, 0, 1024, 512, 0, 0); break;
        case 5: nv::k_gemm<false><<<dim3(1024 / 64, M / 64, 1), 256, 0, stream>>>(nv::RowDense{MIX, 1024, 0}, nv::EpiPre1{out, P.x, ALPHA, 0}, P.w_out, 0, 1024, 1024, 0, 0); break;
        case 6: nv::k_ln1_route<<<M, 256, 0, stream>>>(out, X1B, P.ln1g, P.ln1b, P.w_router, P.b_router, CNT, LIST, GATE, GATEL);
                nv::k_cvt_bf16<<<2048, 256, 0, stream>>>(P.p, PB, (size_t)M * PLE / 4); break;
        case 7: nv::k_gemm<false><<<dim3(1024 / 64, M / 64, 1), 256, 0, stream>>>(nv::RowDense{PB, 256, 0}, nv::EpiStoreF32{T}, P.w_pp, 0, 1024, 256, 0, 0);
                nv::k_gemm<false><<<dim3(1024 / 64, M / 64, 1), 256, 0, stream>>>(nv::RowDense{X1B, 1024, 0}, nv::EpiBase{out, T, ALPHA, 0}, P.w_pg, 0, 1024, 1024, 0, 0); break;
        case 8: nv::k_gemm<true><<<dim3(1024 / 64, M / 64, NEXP), 256, 0, stream>>>(nv::RowGather{X1B, LIST, CNT}, nv::EpiUp{HB, P.b_up, CNT}, P.w_up, (size_t)1024 * 2048, 2048, 1024, 1024, 0); break;
        case 9: nv::k_gemm<false><<<dim3(1024 / 64, M / 64, NEXP), 256, 0, stream>>>(nv::RowSlots{HB, CNT}, nv::EpiDown{out, YS1, YS2, YS3, P.b_down, LIST, GATE, CNT}, P.w_down, (size_t)1024 * 1024, 1024, 1024, 0, 0); break;
        case 10: nv::k_final<<<M, 256, 0, stream>>>(out, YS1, YS2, YS3, P.ln2g, P.ln2b); break;
        }
        ++ph;
    }
}
```

```cpp
#define FAST_MASK 0x7ff
#include <hip/hip_runtime.h>
#include <hip/hip_bf16.h>
#include <cstdio>
#include <cstdint>
#include <cmath>

#define GAS __attribute__((address_space(1)))
#define LAS __attribute__((address_space(3)))
typedef unsigned short bf16;
typedef unsigned v4u __attribute__((ext_vector_type(4)));
typedef float f32x4 __attribute__((ext_vector_type(4)));
typedef short bf16x8 __attribute__((ext_vector_type(8)));
typedef GAS unsigned gu32;
typedef GAS unsigned long long gu64;
#define RLX_AGENT __ATOMIC_RELAXED, __HIP_MEMORY_SCOPE_AGENT
#define LDS_WAIT() asm volatile("s_waitcnt lgkmcnt(0)" ::: "memory")
#define VM_WAIT() asm volatile("s_waitcnt vmcnt(0)" ::: "memory")
__device__ __forceinline__ unsigned f2bf(float f) { unsigned u = __builtin_bit_cast(unsigned, f); return (u + 0x7fffu + ((u >> 16) & 1u)) >> 16; }
__device__ __forceinline__ unsigned pk2(float lo, float hi) { return f2bf(lo) | (f2bf(hi) << 16); }

__device__ __forceinline__ int lane_id() { return (int)__builtin_amdgcn_mbcnt_hi(~0u, __builtin_amdgcn_mbcnt_lo(~0u, 0u)); }

constexpr int BATCH = 16, SEQ = 4096, D = 1024, M = BATCH * SEQ;
constexpr int NEXP = 32, TOPK = 4, NASSIGN = M * TOPK, FF = 1024, PLE = 256;
constexpr float LN_EPS = 1e-5f;
constexpr float ALPHA = 1.189207115002721f;
constexpr float C2Q = 0.125f * 1.4426950408889634f;

constexpr size_t MiB = 1u << 20;
constexpr size_t WS_CTL = 0, CTL_ZERO_BYTES = 1 * MiB;
constexpr size_t WS_LIST = 1 * MiB;
constexpr size_t WS_GATEL = 9 * MiB;
constexpr size_t WS_GATE = 17 * MiB;
constexpr size_t WS_WPCF = 18 * MiB;
constexpr size_t WS_WIN = 20 * MiB, WS_WCAT = 28 * MiB, WS_WOUT = 30 * MiB, WS_WPG = 32 * MiB, WS_WPP = 34 * MiB;
constexpr size_t WS_WDN = 36 * MiB, WS_WUP = 100 * MiB;
constexpr size_t WS_XB = 228 * MiB;
constexpr size_t WS_APO = 228 * MiB;
constexpr size_t WS_X1B = 228 * MiB;
constexpr size_t WS_Q = 356 * MiB, WS_K = 420 * MiB, WS_V = 484 * MiB, WS_U = 548 * MiB;
constexpr size_t WS_G = 612 * MiB;
constexpr size_t WS_O16 = 868 * MiB;
constexpr size_t WS_PB = 868 * MiB;
constexpr size_t WS_MIX = 356 * MiB;
constexpr size_t WS_T = 356 * MiB;
constexpr size_t WS_HB = 356 * MiB;
constexpr size_t WS_YS1 = 100 * MiB, WS_YS2 = 228 * MiB, WS_YS3 = 868 * MiB;
constexpr size_t WS_X1F8 = 900 * MiB;
constexpr size_t WS_YS0 = 612 * MiB;
constexpr size_t WS_PLE = 740 * MiB;
constexpr size_t WS_END = 1024 * MiB;
#ifndef MOE_FP8
#define MOE_FP8 1
#endif
constexpr float WUP_SCALE = 32.f, WDN_SCALE = 64.f;
#ifndef PROJ_F8_FROM
#define PROJ_F8_FROM 8
#endif
constexpr size_t WS_XF8 = 900 * MiB;
constexpr size_t WS_WIN8 = WS_WIN + (size_t)PROJ_F8_FROM * 256 * 1024 * 2;
constexpr float YS_SCALE = 16.f;
constexpr float ATT_SKIP = 40.f;
constexpr int CW_TMO = 0, CW_CODE = 1;
constexpr int CW_CNT = 64;
constexpr int CW_AQ = 128;
constexpr int CW_PN = 65536;
constexpr int CW_BAR = 4096;
namespace nv {
__device__ __forceinline__ float bf2f(bf16 b) { return __builtin_bit_cast(float, (unsigned)b << 16); }
__device__ __forceinline__ bf16 f2b(float f) { return (bf16)f2bf(f); }
__device__ __forceinline__ float sigm(float v) { return 1.f / (1.f + __expf(-v)); }

__global__ void k_zero_ctl(unsigned* p, int n) { int i = blockIdx.x * blockDim.x + threadIdx.x; if (i < n) p[i] = 0u; }
__global__ void k_cvt_bf16(const float* in, bf16* out, size_t n4) {
    size_t i = (size_t)blockIdx.x * blockDim.x + threadIdx.x; const size_t st = (size_t)gridDim.x * blockDim.x;
    for (; i < n4; i += st) { const f32x4 v = ((const f32x4*)in)[i]; unsigned long long o = (unsigned long long)pk2(v.x, v.y) | ((unsigned long long)pk2(v.z, v.w) << 32); ((unsigned long long*)out)[i] = o; }
}
__global__ void k_fold_pool(const float* wmix, const float* scale, const float* wpb, float* Wpc) {
    const int row = blockIdx.x, g = row >> 7, c = row & 127;
    __shared__ float wm[128];
    if (threadIdx.x < 128) wm[threadIdx.x] = wmix[(g * 128 + c) * 128 + threadIdx.x] * scale[g * 128 + threadIdx.x];
    __syncthreads();
    for (int n = threadIdx.x; n < 1024; n += 256) { float s = 0.f; for (int d = 0; d < 128; ++d) s += wm[d] * wpb[(size_t)(g * 128 + d) * 1024 + n]; Wpc[(size_t)row * 1024 + n] = s; }
}

template <bool DUAL, class RowF, class Epi>
__global__ void __launch_bounds__(256) k_gemm(RowF rf, Epi epi, const float* W, size_t wz, int ldw, int K, int dualoff, int pad_) {
    __shared__ float As[16][68]; __shared__ float Bs[16][64]; __shared__ float Bs2[DUAL ? 16 : 1][64];
    const int tid = threadIdx.x, ty = tid >> 4, tx = tid & 15, z = blockIdx.z;
    const int row0 = blockIdx.y * 64, col0 = blockIdx.x * 64;
    if (!rf.active(z, row0)) return;
    const float* Wz = W + (size_t)z * wz;
    float acc[4][4] = {}, acc2[4][4] = {};
    const int ar = tid >> 2, ak = (tid & 3) * 4; const bf16* arow = rf.row(z, row0 + ar);
    const int bk = tid >> 4, bc = (tid & 15) * 4;
    for (int k0 = 0; k0 < K; k0 += 16) {
        { const unsigned long long v = arow ? *(const unsigned long long*)(arow + k0 + ak) : 0ull;
          As[ak + 0][ar] = bf2f((bf16)(v & 0xffff)); As[ak + 1][ar] = bf2f((bf16)((v >> 16) & 0xffff)); As[ak + 2][ar] = bf2f((bf16)((v >> 32) & 0xffff)); As[ak + 3][ar] = bf2f((bf16)(v >> 48)); }
        { const f32x4 v = *(const f32x4*)(Wz + (size_t)(k0 + bk) * ldw + col0 + bc); Bs[bk][bc] = v.x; Bs[bk][bc + 1] = v.y; Bs[bk][bc + 2] = v.z; Bs[bk][bc + 3] = v.w;
          if (DUAL) { const f32x4 w = *(const f32x4*)(Wz + (size_t)(k0 + bk) * ldw + dualoff + col0 + bc); Bs2[bk][bc] = w.x; Bs2[bk][bc + 1] = w.y; Bs2[bk][bc + 2] = w.z; Bs2[bk][bc + 3] = w.w; } }
        __syncthreads();
#pragma unroll
        for (int k = 0; k < 16; ++k) { float a[4], b[4], b2[4];
#pragma unroll
            for (int i = 0; i < 4; ++i) { a[i] = As[k][ty * 4 + i]; b[i] = Bs[k][tx * 4 + i]; b2[i] = DUAL ? Bs2[k][tx * 4 + i] : 0.f; }
#pragma unroll
            for (int i = 0; i < 4; ++i)
#pragma unroll
                for (int j = 0; j < 4; ++j) { acc[i][j] += a[i] * b[j]; if (DUAL) acc2[i][j] += a[i] * b2[j]; } }
        __syncthreads();
    }
#pragma unroll
    for (int i = 0; i < 4; ++i)
#pragma unroll
        for (int j = 0; j < 4; ++j) epi(z, row0 + ty * 4 + i, col0 + tx * 4 + j, acc[i][j], acc2[i][j]);
}
struct RowDense { const bf16* A; int lda; int pad; __device__ bool active(int, int) const { return true; } __device__ const bf16* row(int, int r) const { return A + (size_t)r * lda; } };

struct EpiProj { bf16 *Q, *K, *V, *U, *G; const float* bg; float c2; int pad;
    __device__ void operator()(int, int r, int c, float v, float) const {
        if (c < 512) Q[(size_t)r * 512 + c] = f2b(v * c2); else if (c < 1024) K[(size_t)r * 512 + c - 512] = f2b(v); else if (c < 1536) V[(size_t)r * 512 + c - 1024] = f2b(v);
        else if (c < 2048) U[(size_t)r * 512 + c - 1536] = f2b(v); else G[(size_t)r * 2048 + c - 2048] = f2b(sigm(v + bg[c - 2048])); } };
struct EpiMixA { bf16* MIX; const bf16* G; __device__ void operator()(int, int r, int c, float v, float) const { MIX[(size_t)r * 1024 + c] = f2b(bf2f(G[(size_t)r * 2048 + c]) * v); } };
struct EpiMixB { bf16* MIX; const bf16* G; __device__ void operator()(int, int r, int c, float v, float) const { MIX[(size_t)r * 1024 + c] = f2b(bf2f(MIX[(size_t)r * 1024 + c]) + bf2f(G[(size_t)r * 2048 + 1024 + c]) * v); } };
struct EpiPre1 { float* out; const float* x; float alpha; int pad; __device__ void operator()(int, int r, int c, float v, float) const { out[(size_t)r * 1024 + c] = alpha * x[(size_t)r * 1024 + c] + v; } };
struct EpiStoreF32 { bf16* T; __device__ void operator()(int, int r, int c, float v, float) const { T[(size_t)r * 1024 + c] = f2b(v); } };
struct EpiBase { float* base; const bf16* T; float alpha; int pad; __device__ void operator()(int, int r, int c, float v, float) const { const size_t i = (size_t)r * 1024 + c; base[i] = alpha * base[i] + sigm(v) * bf2f(T[i]); } };

__global__ void __launch_bounds__(256) k_attn(const bf16* Q, const bf16* K, const bf16* V, bf16* O16) {
    __shared__ float Ks[64][64]; __shared__ float Vs[64][64];
    const int qb = blockIdx.x, vh = blockIdx.y, b = blockIdx.z, tid = threadIdx.x;
    const int hm = vh >> 1, half = vh & 1, h = hm >> 1;
    const float c2 = exp2f(-2.f * (h + 1)) * 1.4426950408889634f;
    const int i = qb * 256 + tid; const size_t rowb = (size_t)b * SEQ;
    float q[64], acc[64];
    { const bf16* qp = Q + (rowb + i) * 512 + hm * 64;
#pragma unroll
      for (int d = 0; d < 64; ++d) { q[d] = bf2f(qp[d]); acc[d] = 0.f; } }
    float m = -INFINITY, l = 0.f;
    const int ntile = (qb * 256 + 256) / 64;
    for (int t = 0; t < ntile; ++t) {
        __syncthreads();
        for (int e = tid; e < 64 * 64; e += 256) { const int j = e >> 6, d = e & 63; const size_t r = rowb + t * 64 + j;
            Ks[j][d] = bf2f(K[r * 512 + hm * 64 + d]); Vs[j][d] = bf2f(V[r * 512 + h * 128 + half * 64 + d]); }
        __syncthreads();
        for (int j = 0; j < 64; ++j) { const int jj = t * 64 + j; if (jj > i) break;
            float s = 0.f;
#pragma unroll
            for (int d = 0; d < 64; ++d) s += q[d] * Ks[j][d];
            s -= c2 * (float)(i - jj);
            if (s > m) { const float f = exp2f(m - s); l *= f;
#pragma unroll
                for (int d = 0; d < 64; ++d) acc[d] *= f;
                m = s; }
            const float p = exp2f(s - m); l += p;
#pragma unroll
            for (int d = 0; d < 64; ++d) acc[d] += p * Vs[j][d]; }
    }
    const float rl = 1.f / l; bf16* op = O16 + (rowb + i) * 1024 + h * 256 + (hm & 1) * 128 + half * 64;
#pragma unroll
    for (int d = 0; d < 64; ++d) op[d] = f2b(acc[d] * rl);
}
__device__ __forceinline__ float lam_value(const float* lq1, const float* lk1, const float* lq2, const float* lk2) {
    float a = 0.f, b = 0.f; for (int d = 0; d < 64; ++d) { a += lq1[d] * lk1[d]; b += lq2[d] * lk2[d]; } return __expf(a) - __expf(b) + 0.2f; }
__global__ void __launch_bounds__(256) k_combine(const bf16* O16, bf16* OA, const float* lq1, const float* lk1, const float* lq2, const float* lk2, const float* sg) {
    const float lam = lam_value(lq1, lk1, lq2, lk2);
    const int row = blockIdx.x * 4 + (threadIdx.x >> 6), lane = threadIdx.x & 63, h = lane >> 4, e0 = (lane & 15) * 8;
    const bf16* a = O16 + (size_t)row * 1024 + h * 256 + e0; const bf16* bb = a + 128;
    float o[8], ss = 0.f;
#pragma unroll
    for (int j = 0; j < 8; ++j) { o[j] = bf2f(a[j]) - lam * bf2f(bb[j]); ss += o[j] * o[j]; }
    ss += __shfl_xor(ss, 1); ss += __shfl_xor(ss, 2); ss += __shfl_xor(ss, 4); ss += __shfl_xor(ss, 8);
    const float r = rsqrtf(ss * (1.f / 128.f) + LN_EPS) * 0.8f;
#pragma unroll
    for (int j = 0; j < 8; ++j) OA[(size_t)row * 1024 + h * 128 + e0 + j] = f2b(o[j] * r * sg[e0 + j]);
}
__global__ void __launch_bounds__(256) k_pool(const bf16* U, bf16* PO) {
    const size_t idx = (size_t)blockIdx.x * 256 + threadIdx.x; const int c = (int)(idx & 511); const size_t row = idx >> 9; const int pos = (int)(row & (SEQ - 1));
    const int w = 2 << (c >> 7); const int n = pos + 1 < w ? pos + 1 : w; float s = 0.f;
    for (int k = 0; k < n; ++k) s += bf2f(U[(row - k) * 512 + c]);
    PO[row * 1024 + c] = f2b(s / (float)n - bf2f(U[row * 512 + c]));
}
__global__ void __launch_bounds__(256) k_ln1_route(float* X1, bf16* X1B, const float* g, const float* bta, const float* wr, const float* br, unsigned* CNT, int* LIST, float* GATE, float* GATEL) {
    __shared__ float xs[1024]; __shared__ float red[8]; __shared__ float part[8][32]; __shared__ float lg[32];
    const int row = blockIdx.x, tid = threadIdx.x, lane = tid & 63, wv = tid >> 6;
    f32x4 v = ((const f32x4*)(X1 + (size_t)row * 1024))[tid];
    float s = (v.x + v.y) + (v.z + v.w); for (int o = 1; o < 64; o <<= 1) s += __shfl_xor(s, o);
    if (lane == 0) red[wv] = s; __syncthreads(); const float mean = (red[0] + red[1] + red[2] + red[3]) * (1.f / 1024.f); __syncthreads();
    v = v - mean; float q = (v.x * v.x + v.y * v.y) + (v.z * v.z + v.w * v.w); for (int o = 1; o < 64; o <<= 1) q += __shfl_xor(q, o);
    if (lane == 0) red[wv] = q; __syncthreads(); const float rstd = rsqrtf((red[0] + red[1] + red[2] + red[3]) * (1.f / 1024.f) + LN_EPS);
    const f32x4 gg = ((const f32x4*)g)[tid], bb = ((const f32x4*)bta)[tid]; v = v * rstd * gg + bb;
    ((f32x4*)(X1 + (size_t)row * 1024))[tid] = v; ((unsigned long long*)(X1B + (size_t)row * 1024))[tid] = (unsigned long long)pk2(v.x, v.y) | ((unsigned long long)pk2(v.z, v.w) << 32);
    xs[tid * 4] = v.x; xs[tid * 4 + 1] = v.y; xs[tid * 4 + 2] = v.z; xs[tid * 4 + 3] = v.w; __syncthreads();
    { const int e = tid & 31, pt = tid >> 5; float a = 0.f; for (int k = pt * 128; k < pt * 128 + 128; ++k) a += xs[k] * wr[k * 32 + e]; part[pt][e] = a; }
    __syncthreads();
    if (tid < 32) { float a = br[tid]; for (int pt = 0; pt < 8; ++pt) a += part[pt][tid]; lg[tid] = a; }
    __syncthreads();
    if (tid == 0) { int id[4]; float vv[4]; unsigned used = 0u;
        for (int k = 0; k < 4; ++k) { int bi = 0; float bv = -INFINITY; for (int e = 0; e < 32; ++e) if (!((used >> e) & 1u) && lg[e] > bv) { bv = lg[e]; bi = e; } used |= 1u << bi; id[k] = bi; vv[k] = bv; }
        float es[4], sum = 0.f; for (int k = 0; k < 4; ++k) { es[k] = __expf(vv[k] - vv[0]); sum += es[k]; }
        for (int k = 0; k < 4; ++k) { const unsigned pos = atomicAdd(&CNT[id[k]], 1u); LIST[(size_t)id[k] * 65536 + pos] = row * 4 + k; GATEL[(size_t)id[k] * 65536 + pos] = es[k] / sum; GATE[row * 4 + k] = es[k] / sum; } }
}
struct RowGather { const bf16* X1B; const int* LIST; const unsigned* CNT;
    __device__ bool active(int e, int row0) const { return (unsigned)row0 < CNT[e]; }
    __device__ const bf16* row(int e, int r) const { return (unsigned)r < CNT[e] ? X1B + (size_t)(LIST[(size_t)e * 65536 + r] >> 2) * 1024 : nullptr; } };
__device__ __forceinline__ unsigned slot_off(const unsigned* CNT, int e) { unsigned o = 0; for (int i = 0; i < e; ++i) o += CNT[i]; return o; }
struct EpiUp { bf16* HB; const float* bup; const unsigned* CNT;
    __device__ void operator()(int e, int r, int c, float glu, float lin) const { if ((unsigned)r >= CNT[e]) return;
        glu += bup[e * 2048 + c]; lin += bup[e * 2048 + 1024 + c]; glu = fminf(glu, 7.f); lin = fminf(fmaxf(lin, -7.f), 7.f);
        HB[(size_t)(slot_off(CNT, e) + r) * 1024 + c] = f2b(glu * sigm(1.702f * glu) * (lin + 1.f)); } };
struct RowSlots { const bf16* HB; const unsigned* CNT;
    __device__ bool active(int e, int row0) const { return (unsigned)row0 < CNT[e]; }
    __device__ const bf16* row(int e, int r) const { return (unsigned)r < CNT[e] ? HB + (size_t)(slot_off(CNT, e) + r) * 1024 : nullptr; } };
struct EpiDown { float* base; bf16* YS1; bf16* YS2; bf16* YS3; const float* bdn; const int* LIST; const float* GATE; const unsigned* CNT;
    __device__ void operator()(int e, int r, int c, float v, float) const { if ((unsigned)r >= CNT[e]) return;
        const int a = LIST[(size_t)e * 65536 + r], tok = a >> 2, k = a & 3; const float y = (v + bdn[e * 1024 + c]) * GATE[a]; const size_t i = (size_t)tok * 1024 + c;
        if (k == 0) base[i] += y; else if (k == 1) YS1[i] = f2b(y); else if (k == 2) YS2[i] = f2b(y); else YS3[i] = f2b(y); } };
__global__ void __launch_bounds__(256) k_final(float* out, const bf16* YS1, const bf16* YS2, const bf16* YS3, const float* g, const float* bta) {
    __shared__ float red[8]; const int row = blockIdx.x, tid = threadIdx.x, lane = tid & 63, wv = tid >> 6; const size_t i0 = (size_t)row * 1024 + tid * 4;
    f32x4 v = *(const f32x4*)(out + i0);
    const bf16* ys[3] = {YS1, YS2, YS3};
    for (int k = 0; k < 3; ++k) { const unsigned long long w = *(const unsigned long long*)(ys[k] + i0); v.x += bf2f((bf16)(w & 0xffff)); v.y += bf2f((bf16)((w >> 16) & 0xffff)); v.z += bf2f((bf16)((w >> 32) & 0xffff)); v.w += bf2f((bf16)(w >> 48)); }
    float s = (v.x + v.y) + (v.z + v.w); for (int o = 1; o < 64; o <<= 1) s += __shfl_xor(s, o);
    if (lane == 0) red[wv] = s; __syncthreads(); const float mean = (red[0] + red[1] + red[2] + red[3]) * (1.f / 1024.f); __syncthreads();
    v = v - mean; float q = (v.x * v.x + v.y * v.y) + (v.z * v.z + v.w * v.w); for (int o = 1; o < 64; o <<= 1) q += __shfl_xor(q, o);
    if (lane == 0) red[wv] = q; __syncthreads(); const float rstd = rsqrtf((red[0] + red[1] + red[2] + red[3]) * (1.f / 1024.f) + LN_EPS);
    const f32x4 gg = ((const f32x4*)g)[tid], bb = ((const f32x4*)bta)[tid]; *(f32x4*)(out + i0) = v * rstd * gg + bb;
}
}
namespace pg8 {
#define PG8_LAS __attribute__((address_space(3)))
typedef unsigned short bf16_t;
typedef unsigned u32x4 __attribute__((ext_vector_type(4)));
typedef float f32x2 __attribute__((ext_vector_type(2)));
constexpr int BM = 256, BK = 64, HALF = 128, HTB = HALF * BK * 2  , STAGE_BYTES = 8 * HTB, NXCD = 8, WGM = 8;
constexpr int TAB_OFF = 131072 + 1024;
constexpr int TAB_CNT = TAB_OFF, TAB_BLK0 = TAB_OFF + 128, TAB_ROW0 = TAB_OFF + 384, TAB_IDS = TAB_OFF + 1024, TAB_GATES = TAB_OFF + 1024 + 2048;

__host__ __device__ __forceinline__ int lds_byte(int r, int c) { const int st = (r >> 4) * 2 + (c >> 5), rr = r & 15, cc = c & 31, ob = rr * 64 + cc * 2; return st * 1024 + (ob ^ (((ob >> 9) & 1) << 5)); }
__host__ __device__ __forceinline__ void stage_rc(int b, int& R, int& C) { const int st = b / 1024, sb = b % 1024, swz = sb ^ (((sb >> 9) & 1) << 5); R = (st >> 1) * 16 + swz / 64; C = (st & 1) * 32 + (swz % 64) / 2; }
__host__ __device__ __forceinline__ int perm32(int rho) { const int n = rho >> 4, i = rho & 15; return 8 * (i >> 2) + 4 * n + (i & 3); }

struct Unit { int pm, pn, e, nvalid; };
struct Gemm { const bf16_t* A; const bf16_t* Bt; int K; };

struct StaticOrder {
    static constexpr bool TABLES = false, FP8 = false;
    int nM, nN, nwg, G, c;
    __host__ __device__ void init(int M, int N, int G_, int c_) { nM = M / BM; nN = N / BM; nwg = nM * nN; G = G_; c = c_; }
    __device__ __forceinline__ bool next(int i, Unit& u, PG8_LAS unsigned char*) const {
        const long L = (long)i * G + c; if (L >= nwg) return false;
        int wgid = (int)L; { const int q = nwg / NXCD, r = nwg % NXCD, xcd = wgid % NXCD, off = wgid / NXCD; wgid = (xcd < r ? xcd * (q + 1) : r * (q + 1) + (xcd - r) * q) + off; }
        const int nig = WGM * nN, gid = wgid / nig, fm = gid * WGM, gsz = (nM - fm) < WGM ? (nM - fm) : WGM;
        u.pm = fm + ((wgid % nig) % gsz); u.pn = (wgid % nig) / gsz; u.e = 0; u.nvalid = 256; return true;
    }
    __device__ __forceinline__ const char* b_tile(const Gemm& g, const Unit& u) const { return (const char*)g.Bt + (size_t)u.pn * (size_t)(BM * 2) * g.K; }
    __device__ __forceinline__ void a_offsets(const Gemm& g, const Unit& u, PG8_LAS unsigned char*, int, const int (&R)[2], const int (&C)[2], unsigned (&off)[2][2]) const {
#pragma unroll
        for (int h = 0; h < 2; ++h)
#pragma unroll
            for (int i = 0; i < 2; ++i) off[h][i] = (unsigned)(((u.pm * BM + h * HALF + R[i]) * g.K + C[i]) * 2);
    }
    __device__ __forceinline__ void issue_tables(const Unit&, PG8_LAS unsigned char*, int, int) const {}
};

struct DenseF8Order : StaticOrder { static constexpr bool FP8 = true; };

template <bool GATHER_, bool FP8_> struct MoeOrder {
    static constexpr bool TABLES = true; static constexpr bool GATHER = GATHER_, FP8 = FP8_;
    int NT, G, c; const int* LIST; const float* GATEL; size_t bstride;
    __device__ __forceinline__ bool next(int i, Unit& u, PG8_LAS unsigned char* lds) const {
        const PG8_LAS int* cnt = (const PG8_LAS int*)(lds + TAB_CNT); const PG8_LAS int* blk0 = (const PG8_LAS int*)(lds + TAB_BLK0);
        const int L = i * G + c; const int total = blk0[32] * NT; if (L >= total) return false;
        const int blk = L / NT; int e = 0;
#pragma unroll 1
        for (int j = 1; j < 32; ++j) e += (blk >= blk0[j]) ? 1 : 0;
        e = __builtin_amdgcn_readfirstlane(e);
        u.e = e; u.pm = __builtin_amdgcn_readfirstlane(blk - blk0[e]); u.pn = L % NT; const int left = __builtin_amdgcn_readfirstlane(cnt[e]) - 256 * u.pm; u.nvalid = left < 256 ? left : 256; return true;
    }
    __device__ __forceinline__ const char* b_tile(const Gemm& g, const Unit& u) const { return (const char*)g.Bt + (size_t)u.e * bstride + (size_t)u.pn * (size_t)(BM * 2) * g.K; }
    __device__ __forceinline__ void a_offsets(const Gemm& g, const Unit& u, PG8_LAS unsigned char* lds, int buf, const int (&R)[2], const int (&C)[2], unsigned (&off)[2][2]) const {
        const PG8_LAS int* ids = (const PG8_LAS int*)(lds + TAB_IDS) + buf * 256; const PG8_LAS int* row0 = (const PG8_LAS int*)(lds + TAB_ROW0);
#pragma unroll
        for (int h = 0; h < 2; ++h)
#pragma unroll
            for (int i = 0; i < 2; ++i) { const int r = h * HALF + R[i];
                if (GATHER) { const int tok = (r < u.nvalid) ? (ids[r] >> 2) : 0; off[h][i] = (unsigned)((tok * g.K + C[i]) * 2); }
                else off[h][i] = (unsigned)(((row0[u.e] + u.pm * BM + r) * g.K + C[i]) * 2); }
    }
    __device__ __forceinline__ void issue_tables(const Unit& u, PG8_LAS unsigned char* lds, int buf, int lane) const {
        const size_t o = (size_t)u.e * 65536 + (size_t)u.pm * 256 + lane * 4;
        __builtin_amdgcn_global_load_lds((const unsigned*)(LIST + o), (PG8_LAS unsigned*)(lds + TAB_IDS + buf * 1024), 16, 0, 0);
        if (!GATHER) __builtin_amdgcn_global_load_lds((const unsigned*)(GATEL + o), (PG8_LAS unsigned*)(lds + TAB_GATES + buf * 1024), 16, 0, 0);
    }
};

__device__ __forceinline__ unsigned cvt_pk_bf16(float lo, float hi) { unsigned r; asm volatile("v_cvt_pk_bf16_f32 %0, %1, %2" : "=v"(r) : "v"(lo), "v"(hi)); return r; }
__device__ __forceinline__ float bflo(unsigned w) { return __builtin_bit_cast(float, w << 16); }
__device__ __forceinline__ float bfhi(unsigned w) { return __builtin_bit_cast(float, w & 0xffff0000u); }
__device__ __forceinline__ float sigm(float v) { return __builtin_amdgcn_rcpf(1.f + __builtin_amdgcn_exp2f(-1.4426950408889634f * v)); }
__device__ __forceinline__ u32x4 pack8(const f32x4& v0, const f32x4& v1) { u32x4 w; w.x = cvt_pk_bf16(v0[0], v0[1]); w.y = cvt_pk_bf16(v0[2], v0[3]); w.z = cvt_pk_bf16(v1[0], v1[1]); w.w = cvt_pk_bf16(v1[2], v1[3]); return w; }
__device__ __forceinline__ void unpack8(const u32x4& w, f32x4& v0, f32x4& v1) { v0 = (f32x4){bflo(w.x), bfhi(w.x), bflo(w.y), bfhi(w.y)}; v1 = (f32x4){bflo(w.z), bfhi(w.z), bflo(w.w), bfhi(w.w)}; }
typedef f32x4 Acc[2][2][4][2];
typedef int i32x4 __attribute__((ext_vector_type(4)));
typedef int i32x8 __attribute__((ext_vector_type(8)));
struct bf16x8p { bf16x8 k[2]; };
template <bool F8> struct Frag { typedef bf16x8p T; };
template <> struct Frag<true> { typedef i32x8 T; };
__device__ __forceinline__ void frag_set(i32x8& d, const i32x4& lo, const i32x4& hi) { d = __builtin_shufflevector(lo, hi, 0, 1, 2, 3, 4, 5, 6, 7); }
__device__ __forceinline__ void frag_set(bf16x8p& d, const bf16x8& lo, const bf16x8& hi) { d.k[0] = lo; d.k[1] = hi; }
__device__ __forceinline__ void frag_mma(f32x4& c, const i32x8& b, const i32x8& a) { c = __builtin_amdgcn_mfma_scale_f32_16x16x128_f8f6f4(b, a, c, 0, 0, 0, 0, 0, 0); }
__device__ __forceinline__ void frag_mma(f32x4& c, const bf16x8p& b, const bf16x8p& a) { c = __builtin_amdgcn_mfma_f32_16x16x32_bf16(b.k[0], a.k[0], c, 0, 0, 0); c = __builtin_amdgcn_mfma_f32_16x16x32_bf16(b.k[1], a.k[1], c, 0, 0, 0); }
__device__ __forceinline__ unsigned pk4_fp8(float a, float b, float c, float d) { unsigned w = __builtin_amdgcn_cvt_pk_fp8_f32(a, b, 0u, false); return __builtin_amdgcn_cvt_pk_fp8_f32(c, d, w, true); }
template <class E> struct has_mid { template <class T> static constexpr bool f(decltype(T::MID)*) { return T::MID; } template <class T> static constexpr bool f(...) { return false; } static constexpr bool value = f<E>(nullptr); };

struct EpiProj {
    static constexpr bool PERM = true;
    bf16_t *Q, *K, *V, *U, *G; const float* bg; float* PN; float c2; float dsc; int pn_base; int pad;
    __device__ __forceinline__ void operator()(const Acc& acc, const Unit& u, int wr, int wc, int fr_, int fq_, PG8_LAS unsigned char*, int) const {
        int fr = fr_, fq = fq_; asm volatile("" : "+v"(fr), "+v"(fq));
        const int pn = u.pn + pn_base; const int row0 = u.pm * BM + wr * 64 + fr; const bool isg = pn >= 8;
        bf16_t* base; int ldc, colt; float sc = dsc;
        if (isg) { base = G; ldc = 2048; colt = (pn - 8) * BM; } else { const int t = pn >> 1; base = t == 0 ? Q : t == 1 ? K : t == 2 ? V : U; ldc = 512; colt = (pn & 1) * BM; if (t == 0) sc = c2 * dsc; }
        const int col0 = colt + wc * 32 + 8 * fq;
        f32x4 bv[2][2];
#pragma unroll
        for (int bj = 0; bj < 2; ++bj)
#pragma unroll
            for (int n = 0; n < 2; ++n) bv[bj][n] = isg ? *(const f32x4*)(bg + col0 + bj * HALF + 4 * n) : (f32x4){0.f, 0.f, 0.f, 0.f};
#pragma unroll
        for (int ai = 0; ai < 2; ++ai)
#pragma unroll
            for (int m = 0; m < 4; ++m) { bf16_t* rowp = base + (size_t)(row0 + ai * HALF + m * 16) * ldc + col0;
#pragma unroll
                for (int bj = 0; bj < 2; ++bj) { f32x4 v0 = acc[ai][bj][m][0] * sc + bv[bj][0], v1 = acc[ai][bj][m][1] * sc + bv[bj][1];
                    if (isg) {
#pragma unroll
                        for (int i = 0; i < 4; ++i) { v0[i] = sigm(v0[i]); v1[i] = sigm(v1[i]); } }
                    *(u32x4*)(rowp + bj * HALF) = pack8(v0, v1); } }
        if (pn < 4) {
            float* tab = PN + (pn >> 1) * 16384; const int R0 = u.pm * BM, b = R0 >> 12;
#pragma unroll
            for (int ai = 0; ai < 2; ++ai)
#pragma unroll
                for (int bj = 0; bj < 2; ++bj) { float mx = 0.f;
#pragma unroll
                    for (int m = 0; m < 4; ++m) { f32x4 v0 = acc[ai][bj][m][0] * sc, v1 = acc[ai][bj][m][1] * sc;
                        float s = (v0[0] * v0[0] + v0[1] * v0[1]) + (v0[2] * v0[2] + v0[3] * v0[3]) + (v1[0] * v1[0] + v1[1] * v1[1]) + (v1[2] * v1[2] + v1[3] * v1[3]);
                        s += __shfl_xor(s, 16); s += __shfl_xor(s, 32); mx = fmaxf(mx, s); }
                    mx = fmaxf(mx, __shfl_xor(mx, 1)); mx = fmaxf(mx, __shfl_xor(mx, 2)); mx = fmaxf(mx, __shfl_xor(mx, 4)); mx = fmaxf(mx, __shfl_xor(mx, 8));
                    const int tile = ((R0 & 4095) >> 6) + 2 * ai + wr, hm = (pn & 1) * 4 + 2 * bj + (wc >> 1);
                    if (fr == 0 && fq == 0) tab[((b * 8 + hm) * 64 + tile) * 2 + (wc & 1)] = mx; }
        }
    }
};
struct EpiMixCat {
    static constexpr bool PERM = true, MID = true;
    bf16_t* MIX; const bf16_t* G;
    __device__ __forceinline__ void mid(Acc& acc, const Unit& u, int wr, int wc, int fr_, int fq_) const {
        int fr = fr_, fq = fq_; asm volatile("" : "+v"(fr), "+v"(fq));
        const int row0 = u.pm * BM + wr * 64 + fr, col0 = u.pn * BM + wc * 32 + 8 * fq;
#pragma unroll
        for (int ai = 0; ai < 2; ++ai)
#pragma unroll
            for (int m = 0; m < 4; ++m) { const size_t r = (size_t)(row0 + ai * HALF + m * 16);
#pragma unroll
                for (int bj = 0; bj < 2; ++bj) { const int c = col0 + bj * HALF;
                    const u32x4 aw = *(const u32x4*)(G + r * 2048 + c), pw = *(const u32x4*)(G + r * 2048 + 1024 + c); f32x4 a0, a1, p0, p1; unpack8(aw, a0, a1); unpack8(pw, p0, p1);
#pragma unroll
                    for (int i = 0; i < 4; ++i) { acc[ai][bj][m][0][i] *= a0[i] * __builtin_amdgcn_rcpf(fmaxf(p0[i], 8.67e-19f)); acc[ai][bj][m][1][i] *= a1[i] * __builtin_amdgcn_rcpf(fmaxf(p1[i], 8.67e-19f)); }
                    asm volatile("" : "+v"(acc[ai][bj][m][0]), "+v"(acc[ai][bj][m][1]) :: "memory"); } }
    }
    __device__ __forceinline__ void operator()(const Acc& acc, const Unit& u, int wr, int wc, int fr_, int fq_, PG8_LAS unsigned char*, int) const {
        int fr = fr_, fq = fq_; asm volatile("" : "+v"(fr), "+v"(fq));
        const int row0 = u.pm * BM + wr * 64 + fr, col0 = u.pn * BM + wc * 32 + 8 * fq;
#pragma unroll
        for (int ai = 0; ai < 2; ++ai)
#pragma unroll
            for (int m = 0; m < 4; ++m) { const size_t r = (size_t)(row0 + ai * HALF + m * 16);
#pragma unroll
                for (int bj = 0; bj < 2; ++bj) { const int c = col0 + bj * HALF;
                    const u32x4 pw = *(const u32x4*)(G + r * 2048 + 1024 + c); f32x4 p0, p1; unpack8(pw, p0, p1);
#pragma unroll
                    for (int i = 0; i < 4; ++i) { p0[i] = fmaxf(p0[i], 8.67e-19f); p1[i] = fmaxf(p1[i], 8.67e-19f); }
                    *(u32x4*)(MIX + r * 1024 + c) = pack8(acc[ai][bj][m][0] * p0, acc[ai][bj][m][1] * p1); }
                asm volatile("" ::: "memory"); }
    }
};
template <int MODE> struct EpiF32 {
    static constexpr bool PERM = false;
    float* out; const float* aux; float alpha; float dsc;
    __device__ __forceinline__ void operator()(const Acc& acc, const Unit& u, int wr, int wc, int fr_, int fq_, PG8_LAS unsigned char*, int) const {
        int fr = fr_, fq = fq_; asm volatile("" : "+v"(fr), "+v"(fq));
        const int col0 = u.pn * BM + wc * 32 + 4 * fq;
#pragma unroll
        for (int ai = 0; ai < 2; ++ai)
#pragma unroll
            for (int m = 0; m < 4; ++m) { const size_t off = (size_t)(u.pm * BM + ai * HALF + wr * 64 + m * 16 + fr) * 1024 + col0;
#pragma unroll
                for (int bj = 0; bj < 2; ++bj) {
#pragma unroll
                    for (int n = 0; n < 2; ++n) { const size_t o = off + bj * HALF + n * 16; const f32x4 a = acc[ai][bj][m][n]; f32x4 r;
                        if (MODE == 1) { f32x2 w; unsigned* wp = (unsigned*)&w; wp[0] = cvt_pk_bf16(a[0], a[1]); wp[1] = cvt_pk_bf16(a[2], a[3]); *(f32x2*)((bf16_t*)out + o) = w; continue; }
                        if (MODE == 0) r = *(const f32x4*)(aux + o) * alpha + a;
                        else if (MODE == 3) { const f32x2 tw = *(const f32x2*)((const bf16_t*)aux + o); const unsigned* tp = (const unsigned*)&tw; f32x2 w; unsigned* wp = (unsigned*)&w;
                            wp[0] = cvt_pk_bf16(sigm(a[0] * dsc) * bflo(tp[0]), sigm(a[1] * dsc) * bfhi(tp[0])); wp[1] = cvt_pk_bf16(sigm(a[2] * dsc) * bflo(tp[1]), sigm(a[3] * dsc) * bfhi(tp[1])); *(f32x2*)((bf16_t*)out + o) = w; continue; }
                        else { const f32x2 tw = *(const f32x2*)((const bf16_t*)aux + o); const unsigned* tp = (const unsigned*)&tw; const f32x4 t = {bflo(tp[0]), bfhi(tp[0]), bflo(tp[1]), bfhi(tp[1])}; const f32x4 b = *(const f32x4*)(out + o); r = b * alpha;
#pragma unroll
                            for (int i = 0; i < 4; ++i) r[i] += sigm(a[i] * dsc) * t[i]; }
                        *(f32x4*)(out + o) = r; }
                  if (MODE == 2) asm volatile("" ::: "memory"); }
                if (m & 1) asm volatile("" ::: "memory"); }
    }
};
template <bool F8> struct EpiUp {
    static constexpr bool PERM = true;
    void* HB; const float* bup; float dsc; int pad;
    __device__ __forceinline__ void operator()(const Acc& acc, const Unit& u, int wr, int wc, int fr_, int fq_, PG8_LAS unsigned char* lds, int) const {
        int fr = fr_, fq = fq_; asm volatile("" : "+v"(fr), "+v"(fq));
        const PG8_LAS int* row0t = (const PG8_LAS int*)(lds + TAB_ROW0); const int srow = row0t[u.e] + u.pm * BM;
        const int c0 = u.pn * HALF + wc * 32 + 8 * fq; const float* bp = bup + (size_t)u.e * 2048 + c0;
        const f32x4 bg0 = *(const f32x4*)(bp), bg1 = *(const f32x4*)(bp + 4), bl0 = *(const f32x4*)(bp + 1024), bl1 = *(const f32x4*)(bp + 1028);
#pragma unroll
        for (int ai = 0; ai < 2; ++ai)
#pragma unroll
            for (int m = 0; m < 4; ++m) { const int r = ai * HALF + wr * 64 + m * 16 + fr;
                f32x4 g0 = acc[ai][0][m][0] * dsc + bg0, g1 = acc[ai][0][m][1] * dsc + bg1, l0 = acc[ai][1][m][0] * dsc + bl0, l1 = acc[ai][1][m][1] * dsc + bl1;
#pragma unroll
                for (int i = 0; i < 4; ++i) { float a = fminf(g0[i], 7.f), b = fminf(fmaxf(l0[i], -7.f), 7.f); g0[i] = a * sigm(1.702f * a) * (b + 1.f);
                                              a = fminf(g1[i], 7.f); b = fminf(fmaxf(l1[i], -7.f), 7.f); g1[i] = a * sigm(1.702f * a) * (b + 1.f); }
                if (r < u.nvalid) {
                    if (F8) { f32x2 w; unsigned* wp = (unsigned*)&w; wp[0] = pk4_fp8(g0[0], g0[1], g0[2], g0[3]); wp[1] = pk4_fp8(g1[0], g1[1], g1[2], g1[3]); *(f32x2*)((unsigned char*)HB + (size_t)(srow + r) * 1024 + c0) = w; }
                    else *(u32x4*)((bf16_t*)HB + (size_t)(srow + r) * 1024 + c0) = pack8(g0, g1); } }
    }
};
struct EpiDown {
    static constexpr bool PERM = true;
    unsigned char* YS0; unsigned char* YS1; unsigned char* YS2; unsigned char* YS3; const float* bdn; float dsc; float osc;
    __device__ __forceinline__ void operator()(const Acc& acc, const Unit& u, int wr, int wc, int fr_, int fq_, PG8_LAS unsigned char* lds, int buf) const {
        int fr = fr_, fq = fq_; asm volatile("" : "+v"(fr), "+v"(fq));
        const PG8_LAS int* ids = (const PG8_LAS int*)(lds + TAB_IDS) + buf * 256; const PG8_LAS float* gates = (const PG8_LAS float*)(lds + TAB_GATES) + buf * 256;
        const int col0 = u.pn * BM + wc * 32 + 8 * fq; const float* bp = bdn + (size_t)u.e * 1024 + col0;
        f32x4 bv[2][2];
#pragma unroll
        for (int bj = 0; bj < 2; ++bj)
#pragma unroll
            for (int n = 0; n < 2; ++n) bv[bj][n] = *(const f32x4*)(bp + bj * HALF + 4 * n);
#pragma unroll
        for (int ai = 0; ai < 2; ++ai)
#pragma unroll
            for (int m = 0; m < 4; ++m) { const int r = ai * HALF + wr * 64 + m * 16 + fr;
                if (r < u.nvalid) { const int a = ids[r]; const float gt = gates[r]; const int k = a & 3; const size_t o = (size_t)(a >> 2) * 1024 + col0;
#pragma unroll
                    for (int bj = 0; bj < 2; ++bj) { const float gs = gt * osc; const f32x4 v0 = (acc[ai][bj][m][0] * dsc + bv[bj][0]) * gs, v1 = (acc[ai][bj][m][1] * dsc + bv[bj][1]) * gs; const size_t oo = o + bj * HALF;
                        unsigned char* yp = k == 0 ? YS0 : k == 1 ? YS1 : k == 2 ? YS2 : YS3; f32x2 w; unsigned* wp = (unsigned*)&w; wp[0] = pk4_fp8(v0[0], v0[1], v0[2], v0[3]); wp[1] = pk4_fp8(v1[0], v1[1], v1[2], v1[3]); *(f32x2*)(yp + oo) = w; } } }
    }
};

template <class Epi, class Sched>
__device__ __forceinline__ void gemm_phase(PG8_LAS unsigned char* lds, const int wid, const Gemm g, const Sched& S, const Epi& E) {
    int lane = lane_id(); asm volatile("" : "+v"(lane));
    const int tid = wid * 64 + lane, wr = wid >> 2, wc = wid & 3, fr = lane & 15, fq = lane >> 4;
    const int K = g.K, nt = K / BK;
    int RA[2], CA[2]; unsigned voffA[2], voffB[2];
#pragma unroll
    for (int i = 0; i < 2; ++i) { int R, C; stage_rc(tid * 16 + i * 8192, R, C); const int Rb = Epi::PERM ? ((R & ~31) + perm32(R & 31)) : R; RA[i] = R; CA[i] = C; voffA[i] = (unsigned)(R * K + C) * 2u; voffB[i] = (unsigned)(Rb * K + C) * 2u; }
    const size_t tstep = (size_t)BM * K * 2;
    const size_t kstep = (size_t)(BK * 2);
    const size_t hstep = (size_t)HALF * K * 2;
    const unsigned ldsw = (unsigned)wid * 1024u;
    const int aoff = lds_byte(wr * 64 + fr, fq * 8), boff = lds_byte(wc * 32 + fr, fq * 8);
#define PG8_SA(b, h) (((b) * 2 + (h)) * HTB)
#define PG8_SB(b, h) ((4 + (b) * 2 + (h)) * HTB)
#define PG8_STAGE(bufoff, gbase, voff) do { _Pragma("unroll") for (int _i = 0; _i < 2; ++_i) \
        __builtin_amdgcn_global_load_lds((const unsigned*)((const char*)(gbase) + (voff)[_i]), (PG8_LAS unsigned*)(lds + (bufoff) + ldsw + _i * 8192), 16, 0, 0); } while (0)
#define PG8_STAGE_A(bufoff, ubase, h, OFF) do { if constexpr (Sched::TABLES) PG8_STAGE(bufoff, ubase, OFF[h]); else PG8_STAGE(bufoff, (ubase) + ((h) ? hstep : 0), voffA); } while (0)
#define PG8_LDA(dst, b, h) do { _Pragma("unroll") for (int m = 0; m < 4; ++m) { if constexpr (Sched::FP8) dst##8[m] = __builtin_shufflevector(*(const PG8_LAS i32x4*)(lds + PG8_SA(b, h) + aoff + m * 2048), *(const PG8_LAS i32x4*)(lds + PG8_SA(b, h) + aoff + m * 2048 + 1024), 0, 1, 2, 3, 4, 5, 6, 7); \
        else { _Pragma("unroll") for (int k = 0; k < 2; ++k) dst[m][k] = *(const PG8_LAS bf16x8*)(lds + PG8_SA(b, h) + aoff + m * 2048 + k * 1024); } } } while (0)
#define PG8_LDB(dst, b, h) do { _Pragma("unroll") for (int n = 0; n < 2; ++n) { if constexpr (Sched::FP8) dst##8[n] = __builtin_shufflevector(*(const PG8_LAS i32x4*)(lds + PG8_SB(b, h) + boff + n * 2048), *(const PG8_LAS i32x4*)(lds + PG8_SB(b, h) + boff + n * 2048 + 1024), 0, 1, 2, 3, 4, 5, 6, 7); \
        else { _Pragma("unroll") for (int k = 0; k < 2; ++k) dst[n][k] = *(const PG8_LAS bf16x8*)(lds + PG8_SB(b, h) + boff + n * 2048 + k * 1024); } } } while (0)
#define PG8_MMA(ai, bj, At, Bt) do { __builtin_amdgcn_s_setprio(1); if constexpr (Sched::FP8) asm volatile("s_nop 1"); _Pragma("unroll") for (int m = 0; m < 4; ++m) _Pragma("unroll") for (int n = 0; n < 2; ++n) { \
        if constexpr (Sched::FP8) asm volatile("v_mfma_f32_16x16x128_f8f6f4 %0, %1, %2, %0" : "+v"(acc[ai][bj][m][n]) : "v"(Bt##8[n]), "v"(At##8[m]));   \
        else { _Pragma("unroll") for (int k = 0; k < 2; ++k) acc[ai][bj][m][n] = __builtin_amdgcn_mfma_f32_16x16x32_bf16(Bt[n][k], At[m][k], acc[ai][bj][m][n], 0, 0, 0); } } __builtin_amdgcn_s_setprio(0); } while (0)
#define PG8_WAIT_V(n) asm volatile("s_waitcnt vmcnt(" #n ")" ::: "memory")
#define PG8_WAIT_L(n) asm volatile("s_waitcnt lgkmcnt(" #n ")" ::: "memory")
#define PG8_BAR __builtin_amdgcn_s_barrier()
#define PG8_SCHED __builtin_amdgcn_sched_barrier(0)
    Unit cur, nxt; int ui = 0;
    if (!S.next(0, cur, lds)) return;
    if constexpr (Sched::TABLES) {
        if (wid == 0) S.issue_tables(cur, lds, 0, lane);
        PG8_WAIT_V(0); PG8_BAR;
    }
    Acc acc;
#pragma unroll
    for (int a = 0; a < 2; ++a)
#pragma unroll
        for (int b = 0; b < 2; ++b)
#pragma unroll
            for (int m = 0; m < 4; ++m)
#pragma unroll
                for (int n = 0; n < 2; ++n) acc[a][b][m][n] = (f32x4){0.f, 0.f, 0.f, 0.f};
    bf16x8 At[4][2], B0[2][2], B1[2][2];
    i32x8 At8[4], B08[2], B18[2];
    unsigned offc[2][2], offn[2][2];
    if constexpr (Sched::TABLES) { S.a_offsets(g, cur, lds, 0, RA, CA, offc);
#pragma unroll
        for (int h = 0; h < 2; ++h)
#pragma unroll
            for (int i = 0; i < 2; ++i) offn[h][i] = offc[h][i]; }
    const char* const Ab = (const char*)g.A;
    const char* cA = Sched::TABLES ? Ab : Ab + (size_t)cur.pm * tstep;
    const char* cB = S.b_tile(g, cur);
    PG8_STAGE(PG8_SB(0, 0), cB, voffB); PG8_STAGE(PG8_SB(0, 1), cB + hstep, voffB); PG8_STAGE_A(PG8_SA(0, 0), cA, 0, offc); PG8_STAGE_A(PG8_SA(0, 1), cA, 1, offc);
    if (wr == 1) PG8_BAR;
    PG8_WAIT_V(2); PG8_BAR;
    PG8_STAGE(PG8_SB(1, 0), cB + kstep, voffB); PG8_STAGE_A(PG8_SA(1, 0), cA + kstep, 0, offc); PG8_STAGE(PG8_SB(1, 1), cB + hstep + kstep, voffB);
    PG8_WAIT_V(6); PG8_BAR;
    for (;;) {
        const bool has_next = S.next(ui + 1, nxt, lds);
        const char* nB = has_next ? S.b_tile(g, nxt) : cB;
        const char* nA = Sched::TABLES ? Ab : (has_next ? Ab + (size_t)nxt.pm * tstep : cA);
#pragma nounroll
        for (int t = 0; t < nt; t += 2) {
            const bool last = (t == nt - 2);
            if constexpr (has_mid<Epi>::value) { if (t == nt / 2) E.mid(acc, cur, wr, wc, fr, fq); }
            if constexpr (Sched::TABLES) {
                if (t == 2 && has_next && wid == 0) S.issue_tables(nxt, lds, (ui + 1) & 1, lane);
                if (t == (nt >= 16 ? nt - 6 : nt - 2) && has_next) S.a_offsets(g, nxt, lds, (ui + 1) & 1, RA, CA, offn);
            }
            unsigned o2[2][2];
            if constexpr (Sched::TABLES) {
#pragma unroll
                for (int h = 0; h < 2; ++h)
#pragma unroll
                    for (int i = 0; i < 2; ++i) o2[h][i] = last ? offn[h][i] : offc[h][i]; }
            const char* a1 = cA + (size_t)(t + 1) * kstep;
            const char* a2 = last ? nA : cA + (size_t)(t + 2) * kstep; const char* b2 = last ? nB : cB + (size_t)(t + 2) * kstep;
            const char* a3 = a2 + kstep; const char* b3 = b2 + kstep;
            PG8_LDB(B0, 0, 0); PG8_LDB(B1, 0, 1); PG8_SCHED; PG8_LDA(At, 0, 0); PG8_STAGE_A(PG8_SA(1, 1), a1, 1, offc);
            PG8_WAIT_V(8); PG8_WAIT_L(0); PG8_BAR; PG8_MMA(0, 0, At, B0); PG8_MMA(0, 1, At, B1); PG8_BAR; PG8_SCHED;
            PG8_LDA(At, 0, 1); PG8_STAGE(PG8_SB(0, 0), b2, voffB); PG8_STAGE(PG8_SB(0, 1), b2 + hstep, voffB); PG8_STAGE_A(PG8_SA(0, 0), a2, 0, o2);
            PG8_WAIT_V(8); PG8_WAIT_L(0); PG8_BAR; PG8_MMA(1, 0, At, B0); PG8_MMA(1, 1, At, B1); PG8_BAR; PG8_SCHED;
            PG8_LDB(B0, 1, 0); PG8_LDB(B1, 1, 1); PG8_SCHED; PG8_LDA(At, 1, 0); PG8_STAGE_A(PG8_SA(0, 1), a2, 1, o2);
            PG8_WAIT_V(8); PG8_WAIT_L(0); PG8_BAR; PG8_MMA(0, 0, At, B0); PG8_MMA(0, 1, At, B1); PG8_BAR; PG8_SCHED;
            PG8_LDA(At, 1, 1); PG8_STAGE(PG8_SB(1, 0), b3, voffB); PG8_STAGE(PG8_SB(1, 1), b3 + hstep, voffB); PG8_STAGE_A(PG8_SA(1, 0), a3, 0, o2);
            PG8_WAIT_V(8); PG8_WAIT_L(0); PG8_BAR; PG8_MMA(1, 0, At, B0); PG8_MMA(1, 1, At, B1); PG8_BAR; PG8_SCHED;
        }
        if (wr == 0) PG8_BAR;
        E(acc, cur, wr, wc, fr, fq, lds, ui & 1);
        if (!has_next) break;
#pragma unroll
        for (int a = 0; a < 2; ++a)
#pragma unroll
            for (int b = 0; b < 2; ++b)
#pragma unroll
                for (int m = 0; m < 4; ++m)
#pragma unroll
                    for (int n = 0; n < 2; ++n) acc[a][b][m][n] = (f32x4){0.f, 0.f, 0.f, 0.f};
        cur = nxt; cB = nB; cA = nA; ++ui;
        if constexpr (Sched::TABLES) {
#pragma unroll
            for (int h = 0; h < 2; ++h)
#pragma unroll
                for (int i = 0; i < 2; ++i) offc[h][i] = offn[h][i]; }
        if (wr == 1) PG8_BAR;
    }
    PG8_WAIT_V(0);
    PG8_BAR;
#undef PG8_SA
#undef PG8_SB
#undef PG8_STAGE
#undef PG8_STAGE_A
#undef PG8_LDA
#undef PG8_LDB
#undef PG8_MMA
#undef PG8_WAIT_V
#undef PG8_WAIT_L
#undef PG8_BAR
#undef PG8_SCHED
}
}
namespace attn_body {
using bf16=__hip_bfloat16;
using bf16x8=__attribute__((ext_vector_type(8)))short;
using s16x4=__attribute__((ext_vector_type(4)))short;
using f32x16=__attribute__((ext_vector_type(16)))float;
using u32x4=__attribute__((ext_vector_type(4)))unsigned;
constexpr int BATCH=16,SEQ=4096,D=64,DM=512,DMO=1024;
constexpr int NW=8,QBLK=32,QB=QBLK*NW,KVBLK=64,NQB=SEQ/QB;
constexpr int ATTN_UNIT_ROWS=QB;
__device__ __forceinline__ int crow(int r,int hi){return (r&3)+8*(r>>2)+4*hi;}
#define SBAR() __builtin_amdgcn_sched_barrier(0)
__device__ __forceinline__ void cmask(f32x16&p0,f32x16&p1,int jb,int qrel,int hi){
  const float NEG=-INFINITY; int kb=64*jb+4*hi; asm volatile("":"+v"(kb));
  #pragma unroll
  for(int r=0;r<16;++r){int kv=kb+(r&3)+8*(r>>2); if(kv>qrel)p0[r]=NEG; if(kv+32>qrel)p1[r]=NEG;}
}

constexpr int NSLOT=3, SLOTB=8192;
constexpr int LDS_K=0, LDS_V=NSLOT*SLOTB, LDS_WS=2*NSLOT*SLOTB, LDS_OST=LDS_WS+NW*64*4, LDS_BYTES=LDS_OST+NW*4096;
constexpr float C2=0.125f*1.4426950408889634f;
__device__ __forceinline__ void glds16(const void*gsrc,unsigned lds_dst){unsigned keep;
  asm volatile("s_mov_b32 %0, m0\n\ts_mov_b32 m0, %2\n\ts_nop 0\n\tglobal_load_lds_dwordx4 %1, off\n\ts_mov_b32 m0, %0":"=&s"(keep):"v"(gsrc),"s"(lds_dst):"memory");}
__device__ __forceinline__ float max3f(float a,float b,float c){float r;asm("v_max3_f32 %0, %1, %2, %3":"=v"(r):"v"(a),"v"(b),"v"(c));return r;}
__device__ __forceinline__ float max2f(float a,float b){float r;asm("v_max_f32_e32 %0, %1, %2":"=v"(r):"v"(a),"v"(b));return r;}
__device__ __forceinline__ float fadd_s(float a,float b){float r;asm("v_add_f32_e32 %0, %1, %2":"=v"(r):"v"(a),"v"(b));return r;}
__device__ __forceinline__ float fsub_s(float a,float b){float r;asm("v_sub_f32_e32 %0, %1, %2":"=v"(r):"v"(a),"v"(b));return r;}
typedef float f32x2_t __attribute__((ext_vector_type(2))); typedef __bf16 bf16x2_t __attribute__((ext_vector_type(2)));
__device__ __forceinline__ unsigned cvtpk_s(float lo,float hi){f32x2_t v={lo,hi};bf16x2_t b=__builtin_convertvector(v,bf16x2_t);return __builtin_bit_cast(unsigned,b);}
#define WAIT_BAR(N) asm volatile("s_waitcnt vmcnt(" #N ") lgkmcnt(0)\n\ts_barrier":::"memory")

__device__ __forceinline__ void qkt(f32x16&p0,f32x16&p1,const char*Kslot,const bf16x8*qr,const f32x16&i0,const f32x16&i1,int r32,int hi){
  const char*kb=Kslot+hi*1024+r32*16;
  #pragma unroll
  for(int d0=0;d0<4;++d0){
    const bf16x8 b0=*reinterpret_cast<const bf16x8*>(kb+d0*2048);
    const bf16x8 b1=*reinterpret_cast<const bf16x8*>(kb+d0*2048+512);
    if(d0==0){p0=__builtin_amdgcn_mfma_f32_32x32x16_bf16(b0,qr[0],i0,0,0,0);p1=__builtin_amdgcn_mfma_f32_32x32x16_bf16(b1,qr[0],i1,0,0,0);}
    else{p0=__builtin_amdgcn_mfma_f32_32x32x16_bf16(b0,qr[d0],p0,0,0,0);p1=__builtin_amdgcn_mfma_f32_32x32x16_bf16(b1,qr[d0],p1,0,0,0);}}
}
typedef __attribute__((address_space(3))) const char* lds_cptr;
typedef short v4i16_t __attribute__((ext_vector_type(4)));
__device__ __forceinline__ void kload8(bf16x8*kf,lds_cptr kp){
  kf[0]=*(const __attribute__((address_space(3))) bf16x8*)(kp);      kf[1]=*(const __attribute__((address_space(3))) bf16x8*)(kp+512);
  kf[2]=*(const __attribute__((address_space(3))) bf16x8*)(kp+2048); kf[3]=*(const __attribute__((address_space(3))) bf16x8*)(kp+2560);
  kf[4]=*(const __attribute__((address_space(3))) bf16x8*)(kp+4096); kf[5]=*(const __attribute__((address_space(3))) bf16x8*)(kp+4608);
  kf[6]=*(const __attribute__((address_space(3))) bf16x8*)(kp+6144); kf[7]=*(const __attribute__((address_space(3))) bf16x8*)(kp+6656);
}
__device__ __forceinline__ void kload2(bf16x8*kf,lds_cptr kp,int j){ kf[2*j]=*(const __attribute__((address_space(3))) bf16x8*)(kp+j*2048); kf[2*j+1]=*(const __attribute__((address_space(3))) bf16x8*)(kp+j*2048+512); }
__device__ __forceinline__ s16x4 vtr(lds_cptr p){ return __builtin_bit_cast(s16x4,__builtin_amdgcn_ds_read_tr16_b64_v4i16((__attribute__((address_space(3))) v4i16_t*)p)); }
__device__ __forceinline__ float rowmax(const f32x16&p0,const f32x16&p1){
  float a=max3f(p0[0],p0[1],p1[0]),b=max3f(p0[2],p0[3],p1[1]);a=max3f(a,p1[2],p1[3]);
  #pragma unroll
  for(int r=4;r<16;r+=4){a=max3f(a,p0[r],p0[r+1]);b=max3f(b,p0[r+2],p0[r+3]);a=max3f(a,p1[r],p1[r+1]);b=max3f(b,p1[r+2],p1[r+3]);}
  const float m=max2f(a,b);
  auto rr=__builtin_amdgcn_permlane32_swap(__float_as_uint(m),__float_as_uint(m),false,false);
  return max2f(__uint_as_float(rr[0]),__uint_as_float(rr[1]));
}
__device__ __forceinline__ void pv(f32x16*o,int vb,bf16x8 pa0,bf16x8 pa1,bf16x8 pa2,bf16x8 pa3){
  #pragma unroll
  for(int d0=0;d0<2;++d0){s16x4 lo[4],hi[4];
    #pragma unroll
    for(int ks=0;ks<4;++ks){
      asm volatile("ds_read_b64_tr_b16 %0,%1 offset:%c2":"=&v"(lo[ks]):"v"(vb),"i"(d0*4096+ks*1024):"memory");
      asm volatile("ds_read_b64_tr_b16 %0,%1 offset:%c2":"=&v"(hi[ks]):"v"(vb),"i"(d0*4096+ks*1024+512):"memory");}
    asm volatile("s_waitcnt lgkmcnt(0)":::"memory");SBAR();
    #define PK(k) (bf16x8){lo[k][0],lo[k][1],lo[k][2],lo[k][3],hi[k][0],hi[k][1],hi[k][2],hi[k][3]}
    o[d0]=__builtin_amdgcn_mfma_f32_32x32x16_bf16(pa0,PK(0),o[d0],0,0,0);
    o[d0]=__builtin_amdgcn_mfma_f32_32x32x16_bf16(pa1,PK(1),o[d0],0,0,0);
    o[d0]=__builtin_amdgcn_mfma_f32_32x32x16_bf16(pa2,PK(2),o[d0],0,0,0);
    o[d0]=__builtin_amdgcn_mfma_f32_32x32x16_bf16(pa3,PK(3),o[d0],0,0,0);
    #undef PK
  }
}

#ifndef ATTN_STORE16
#define ATTN_STORE16(p,v) (*(u32x4*)(p)=(v))
#endif
template<int THRL> __device__ __forceinline__ void attn_unit(int b,int hm,int half,int qb,float cs,const int wid,const float*PN,const bf16*Q,const bf16*__restrict__ K,const bf16*__restrict__ V,bf16*O,char*shm){
  int lane=lane_id(); asm volatile("":"+v"(lane));
  const int r32=lane&31,hi=lane>>5;
  const long rowbase=(long)b*SEQ; const int q0=qb*QB;
  const int NTf=(q0+QB)/KVBLK;
  int t0=0; float uref=0.f;
  { const float*pq=PN+((b*8+hm)*64)*2, *pk=PN+16384+((b*8+hm)*64)*2; float qm=0.f,km=0.f;
    if(lane<4){const float*p_=pq+(4*qb+lane)*2; qm=p_[0]+p_[1];} if(lane<NTf){const float*p_=pk+lane*2; km=p_[0]+p_[1];}
    _Pragma("unroll") for(int o_=1;o_<64;o_<<=1){qm=__builtin_fmaxf(qm,__shfl_xor(qm,o_));km=__builtin_fmaxf(km,__shfl_xor(km,o_));}
    const float need=(ATT_SKIP+2.04f*__builtin_sqrtf(qm*km))/cs;
    const float tf=((float)(q0-63)-need)*(1.f/64.f); int tt=tf>0.f?(int)tf:0; tt&=~1; if(tt>NTf-4)tt=NTf-4; t0=__builtin_amdgcn_readfirstlane(tt); uref=1.02f*__builtin_sqrtf(qm*km); }
  const bf16*Qw=Q+(rowbase+q0+wid*QBLK)*DM+hm*D;
  const bf16*Kh=K+(rowbase+64*t0)*DM+hm*D,*Vh=V+(rowbase+64*t0)*DM+(hm>>1)*128+half*64;
  const unsigned lds0=(unsigned)(uintptr_t)shm;
  float*wsf=(float*)(shm+LDS_WS)+wid*64;
  const bf16*ksrc=Kh+(long)lane*DM+wid*8;
  const bf16*vsrc=Vh+(long)(16*(wid&3)+(lane>>2))*DM+(wid>>2)*32+(lane&3)*8;
  const unsigned kdst=lds0+LDS_K+wid*1024, vdst=lds0+LDS_V+wid*1024;
  #define DMA_K(t,slot) glds16(ksrc+(long)(t)*KVBLK*DM,(unsigned)__builtin_amdgcn_readfirstlane(kdst+(slot)))
  #define DMA_V(t,slot) glds16(vsrc+(long)(t)*KVBLK*DM,(unsigned)__builtin_amdgcn_readfirstlane(vdst+(slot)))
  const int vb0=(int)(lds0+LDS_V)+((lane>>4)&1)*32+(lane&3)*8+(4*hi+((lane&15)>>2))*64;
  const char*Kbase=shm+LDS_K; bf16x8 kf[8];
  const lds_cptr shm3=(lds_cptr)shm; const lds_cptr kp0=shm3+LDS_K+hi*1024+r32*16; const lds_cptr vp0=shm3+LDS_V+((lane>>4)&1)*32+(lane&3)*8+(4*hi+((lane&15)>>2))*64;
  const int NT=NTf-t0;
  DMA_K(0,0);DMA_V(0,0);DMA_K(1,SLOTB);
  bf16x8 qr[4];
  #pragma unroll
  for(int d0=0;d0<4;++d0)qr[d0]=*reinterpret_cast<const bf16x8*>(&Qw[(long)r32*DM+d0*16+hi*8]);
  float mhat=0.f,l_reg=0.f;f32x16 o[2];o[0]=f32x16{};o[1]=f32x16{};
  const int qrel=wid*QBLK+r32;
  float nb=-uref-cs*(float)(q0+qrel-4*hi-64*t0);
  const float cs8=__builtin_bit_cast(float,__builtin_amdgcn_readfirstlane(__builtin_bit_cast(int,8.f*cs)));
  #define CINIT1(C,t,X) do{ C[0]=nb+cs*(float)(64*(t)+(X)); C[1]=C[0]+cs; C[2]=C[1]+cs; C[3]=C[2]+cs; _Pragma("unroll") for(int r=4;r<16;++r) C[r]=C[r-4]+cs8; asm volatile("":"+v"(C)); }while(0)
  #define CINIT(C0,C1,t) do{ CINIT1(C0,t,0); CINIT1(C1,t,32); }while(0)
  #define CMASK(P0,P1,t) do{int jb_=(t)-(NT-4); if(jb_>=0)cmask(P0,P1,jb_,qrel,hi);}while(0)
  bool resc=false;
  #define START(P0,P1) do{ const float rm=rowmax(P0,P1); resc=false; \
    { const float dl=0.f; (void)rm; mhat=fadd_s(mhat,dl); nb=fsub_s(nb,dl);     \
      _Pragma("unroll") for(int r=0;r<16;++r){P0[r]=fsub_s(P0[r],dl);P1[r]=fsub_s(P1[r],dl);} } \
    _Pragma("unroll") for(int r=0;r<16;++r)P0[r]=__builtin_amdgcn_exp2f(P0[r]); }while(0)
  #define RESC() do{ if(THRL>=0&&resc){ asm volatile("s_waitcnt lgkmcnt(0)":::"memory"); \
      _Pragma("unroll") for(int d_=0;d_<2;++d_) _Pragma("unroll") for(int r=0;r<16;++r)o[d_][r]*=wsf[crow(r,hi)]; } }while(0)
  f32x16 pA0,pA1,pB0,pB1;
  int sl_prev=0,sl_cur=0,sl_next=SLOTB;
  #define ROT() do{sl_prev=sl_cur;sl_cur=sl_next;sl_next=(sl_next==(NSLOT-1)*SLOTB)?0:sl_next+SLOTB;}while(0)
  DMA_K(2,2*SLOTB);
  WAIT_BAR(3);
  { f32x16 i0_,i1_; CINIT(i0_,i1_,0); qkt(pA0,pA1,Kbase,qr,i0_,i1_,r32,hi); } asm volatile("s_nop 15\n\ts_nop 7":"+v"(pA0),"+v"(pA1));CMASK(pA0,pA1,0);
  START(pA0,pA1);
  _Pragma("unroll") for(int r=0;r<16;++r)pA1[r]=__builtin_amdgcn_exp2f(pA1[r]);
  WAIT_BAR(0);
  DMA_K(3,0);DMA_V(1,SLOTB);
  ROT();
  kload8(kf,kp0+sl_cur);
  WAIT_BAR(2);
  s16x4 vlo[8],vhi[8]; u32x4 pw0,pw1,pw2,pw3;
  #define PKW(P,B) cvtpk_s(P[B],P[B+1])
  #define PAF(k) __builtin_bit_cast(bf16x8,pw##k)
  #define VFR(i) (bf16x8){vlo[i][0],vlo[i][1],vlo[i][2],vlo[i][3],vhi[i][0],vhi[i][1],vhi[i][2],vhi[i][3]}
  #define PIN(x) asm volatile("":"+v"(x))
  #define MX3(a,b,c) __builtin_fmaxf(__builtin_fmaxf((a),(b)),(c))
  #define GAPA(MF,A0,A1,A2,A3,W0,W1,PW) do{ MF; sacc+=A0; sacc+=A1; sacc+=A2; sacc+=A3; PIN(sacc); W0; W1; PIN(PW); SBAR(); }while(0)
  #define EX(v) __builtin_amdgcn_exp2f(v)
  #define GAPB(MF,X,B) do{ MF; X[B]=EX(X[B]); X[B+1]=EX(X[B+1]); X[B+2]=EX(X[B+2]); X[B+3]=EX(X[B+3]); PIN(X); SBAR(); }while(0)
  #define VRD(i) do{ vlo[i]=vtr(vp_+(((i)>>2)*4096+((i)&3)*1024)); vhi[i]=vtr(vp_+(((i)>>2)*4096+((i)&3)*1024+512)); }while(0)
  #define KRD(G,j) do{ if(G){ kload2(kf,kp0+sl_next,j); SBAR(); } }while(0)
  #define STEP(C0,C1,P0,P1,t,GK,GV,GL) do{ SBAR(); \
    const lds_cptr vp_=vp0+sl_prev; \
    VRD(0); SBAR(); float sacc=(P0[0]+P0[1]); CINIT1(C0,t,0); SBAR(); \
    GAPA(C0=__builtin_amdgcn_mfma_f32_32x32x16_bf16(kf[0],qr[0],C0,0,0,0), P0[2],P0[3],P0[4],P0[5],     pw0[0]=PKW(P0,0), pw0[1]=PKW(P0,2), pw0); \
    VRD(4); SBAR(); CINIT1(C1,t,32); SBAR(); GAPA(C1=__builtin_amdgcn_mfma_f32_32x32x16_bf16(kf[1],qr[0],C1,0,0,0), P0[6],P0[7],P0[8],P0[9],     pw0[2]=PKW(P0,4), pw0[3]=PKW(P0,6), pw0); \
    VRD(1); SBAR(); GAPA(C0=__builtin_amdgcn_mfma_f32_32x32x16_bf16(kf[2],qr[1],C0,0,0,0),   P0[10],P0[11],P0[12],P0[13], pw1[0]=PKW(P0,8), pw1[1]=PKW(P0,10), pw1); \
    VRD(5); SBAR(); GAPA(C1=__builtin_amdgcn_mfma_f32_32x32x16_bf16(kf[3],qr[1],C1,0,0,0),   P0[14],P0[15],P1[0],P1[1],   pw1[2]=PKW(P0,12),pw1[3]=PKW(P0,14), pw1); \
    VRD(2); SBAR(); GAPA(C0=__builtin_amdgcn_mfma_f32_32x32x16_bf16(kf[4],qr[2],C0,0,0,0),   P1[2],P1[3],P1[4],P1[5],     pw2[0]=PKW(P1,0), pw2[1]=PKW(P1,2), pw2); \
    VRD(6); SBAR(); GAPA(C1=__builtin_amdgcn_mfma_f32_32x32x16_bf16(kf[5],qr[2],C1,0,0,0),   P1[6],P1[7],P1[8],P1[9],     pw2[2]=PKW(P1,4), pw2[3]=PKW(P1,6), pw2); \
    VRD(3); SBAR(); GAPA(C0=__builtin_amdgcn_mfma_f32_32x32x16_bf16(kf[6],qr[3],C0,0,0,0),   P1[10],P1[11],P1[12],P1[13], pw3[0]=PKW(P1,8), pw3[1]=PKW(P1,10), pw3); \
    VRD(7); SBAR(); GAPA(C1=__builtin_amdgcn_mfma_f32_32x32x16_bf16(kf[7],qr[3],C1,0,0,0),   P1[14],P1[15],0.f,0.f,       pw3[2]=PKW(P1,12),pw3[3]=PKW(P1,14), pw3); \
    l_reg+=sacc; \
    if(GK){DMA_K((t)+3,sl_cur);} if(GV){DMA_V((t)+1,sl_next);} \
    CMASK(C0,C1,t); \
    { float a=MX3(C0[0],C0[1],C1[0]),b=MX3(C0[2],C0[3],C1[1]); a=MX3(a,C1[2],C1[3]); \
      _Pragma("unroll") for(int r=4;r<16;r+=4){a=MX3(a,C0[r],C0[r+1]);b=MX3(b,C0[r+2],C0[r+3]);a=MX3(a,C1[r],C1[r+1]);b=MX3(b,C1[r+2],C1[r+3]);} \
      float rm=__builtin_fmaxf(a,b); { auto rr=__builtin_amdgcn_permlane32_swap(__float_as_uint(rm),__float_as_uint(rm),false,false); rm=__builtin_fmaxf(__uint_as_float(rr[0]),__uint_as_float(rr[1])); } \
      resc=false; \
      if(THRL>=0&&__builtin_expect(__any(rm>(float)THRL),0)){ const float dl=__builtin_fmaxf(rm,0.f); mhat+=dl; nb-=dl; \
        _Pragma("unroll") for(int r=0;r<16;++r){C0[r]-=dl;C1[r]-=dl;} \
        const float f=__builtin_amdgcn_exp2f(-dl); l_reg*=f; if(hi==0)wsf[r32]=f; resc=true; } } \
    SBAR(); \
    GAPB(o[0]=__builtin_amdgcn_mfma_f32_32x32x16_bf16(PAF(0),VFR(0),o[0],0,0,0), C0,0); \
    GAPB(o[1]=__builtin_amdgcn_mfma_f32_32x32x16_bf16(PAF(0),VFR(4),o[1],0,0,0), C0,4); \
    KRD(GL,0); GAPB(o[0]=__builtin_amdgcn_mfma_f32_32x32x16_bf16(PAF(1),VFR(1),o[0],0,0,0), C0,8); \
    KRD(GL,1); GAPB(o[1]=__builtin_amdgcn_mfma_f32_32x32x16_bf16(PAF(1),VFR(5),o[1],0,0,0), C0,12); \
    KRD(GL,2); GAPB(o[0]=__builtin_amdgcn_mfma_f32_32x32x16_bf16(PAF(2),VFR(2),o[0],0,0,0), C1,0); \
    KRD(GL,3); GAPB(o[1]=__builtin_amdgcn_mfma_f32_32x32x16_bf16(PAF(2),VFR(6),o[1],0,0,0), C1,4); \
    GAPB(o[0]=__builtin_amdgcn_mfma_f32_32x32x16_bf16(PAF(3),VFR(3),o[0],0,0,0), C1,8); \
    GAPB(o[1]=__builtin_amdgcn_mfma_f32_32x32x16_bf16(PAF(3),VFR(7),o[1],0,0,0), C1,12); \
    }while(0)
  int t=1;
  #undef CMASK
  #define CMASK(P0,P1,t) do{}while(0)
  for(;t+5<NT;t+=2){
    STEP(pB0,pB1,pA0,pA1,t,true,true,true);     WAIT_BAR(2); RESC(); ROT();
    STEP(pA0,pA1,pB0,pB1,t+1,true,true,true);   WAIT_BAR(2); RESC(); ROT();
  }
  #undef CMASK
  #define CMASK(P0,P1,t) do{int jb_=(t)-(NT-4); if(jb_>=0)cmask(P0,P1,jb_,qrel,hi);}while(0)
  #define ENDW(tt) do{ if((tt)+3<NT){WAIT_BAR(2);} else if((tt)+2<NT){WAIT_BAR(1);} else {WAIT_BAR(0);} }while(0)
  for(;t+1<NT;t+=2){
    STEP(pB0,pB1,pA0,pA1,t,(t+3<NT),(t+1<NT),(t+1<NT));       ENDW(t);   RESC(); ROT();
    STEP(pA0,pA1,pB0,pB1,t+1,(t+4<NT),(t+2<NT),(t+2<NT));     ENDW(t+1); RESC(); ROT();
  }
  STEP(pB0,pB1,pA0,pA1,NT-1,false,false,false); RESC();
  { float sacc=pB0[0]+pB0[1]; _Pragma("unroll") for(int r=2;r<16;++r)sacc+=pB0[r]; _Pragma("unroll") for(int r=0;r<16;++r)sacc+=pB1[r]; l_reg+=sacc;
    pw0=(u32x4){PKW(pB0,0),PKW(pB0,2),PKW(pB0,4),PKW(pB0,6)};pw1=(u32x4){PKW(pB0,8),PKW(pB0,10),PKW(pB0,12),PKW(pB0,14)};pw2=(u32x4){PKW(pB1,0),PKW(pB1,2),PKW(pB1,4),PKW(pB1,6)};pw3=(u32x4){PKW(pB1,8),PKW(pB1,10),PKW(pB1,12),PKW(pB1,14)};
    SBAR(); pv(o,vb0+sl_cur,PAF(0),PAF(1),PAF(2),PAF(3)); }
  #undef PKW
  #undef PAF
  #undef VFR
  #undef PIN
  #undef MX3
  #undef GAPA
  #undef GAPB
  #undef EX
  #undef VRD
  #undef KRD
  #undef STEP
  #undef ENDW
  {auto rr=__builtin_amdgcn_permlane32_swap(__float_as_uint(l_reg),__float_as_uint(l_reg),false,false);l_reg=__uint_as_float(rr[0])+__uint_as_float(rr[1]);}
  if(hi==0)wsf[32+r32]=l_reg;asm volatile("s_waitcnt lgkmcnt(0)":::"memory");
  float rli[16];
  #pragma unroll
  for(int r=0;r<16;++r)rli[r]=__builtin_amdgcn_rcpf(wsf[32+crow(r,hi)]);
  bf16*Ow=O+(rowbase+q0+wid*QBLK)*DMO+(hm>>1)*256+(hm&1)*128+half*64;
  { bf16*stg=(bf16*)(shm+LDS_OST)+wid*2048;
    int eoff=hi*256+r32; asm volatile("":"+v"(eoff));
    #pragma unroll
    for(int r=0;r<16;++r){const int orow=(r&3)+8*(r>>2);
      #pragma unroll
      for(int d0=0;d0<2;++d0)stg[eoff+orow*64+d0*32]=__float2bfloat16(o[d0][r]*rli[r]);}
    asm volatile("s_waitcnt lgkmcnt(0)":::"memory");
    #pragma unroll
    for(int i=0;i<4;++i){const int row=i*8+(lane>>3),ch=lane&7; const u32x4 v=*(const u32x4*)(stg+row*64+ch*8); ATTN_STORE16(Ow+(long)row*DMO+ch*8,v);} }
  asm volatile("s_waitcnt lgkmcnt(0)\n\ts_barrier":::"memory");
  #undef DMA_K
  #undef DMA_V
  #undef CMASK
  #undef START
  #undef RESC
  #undef ROT
  #undef CINIT
  #undef CINIT1
}
constexpr int ATTN_LDS_BYTES=LDS_BYTES;
struct AttnTensors { const bf16* Q; const bf16* K; const bf16* V; bf16* O; const float* PN; unsigned* queue; };
__device__ __forceinline__ void unit_of(int u,int&b,int&vh,int&qb){ if(u<2048){qb=15-(u>>7);const int r=u&127;b=r>>3;vh=8+(r&7);} else if(u<3072){const int v=u-2048;qb=15-(v>>6);const int r=v&63;b=r>>2;vh=4+(r&3);} else {const int v=u-3072;qb=15-(v>>6);const int r=v&63;b=r>>2;vh=r&3;} }
template<int THRL=8> __device__ __forceinline__ void attn_phase(char*lds,const AttnTensors&T,const int wid){
  volatile __attribute__((address_space(3))) int* slot=(volatile __attribute__((address_space(3))) int*)(lds+LDS_BYTES);
  const bool lead=(wid==0)&&(lane_id()==0);
  if(lead) *slot=(int)__hip_atomic_fetch_add(T.queue,1u,__ATOMIC_RELAXED,__HIP_MEMORY_SCOPE_AGENT);
  asm volatile("s_waitcnt vmcnt(0) lgkmcnt(0)\n\ts_barrier":::"memory");
  int cur=__builtin_amdgcn_readfirstlane(*slot);
  asm volatile("s_waitcnt lgkmcnt(0)\n\ts_barrier":::"memory");
  while(cur<BATCH*16*NQB){
    int nxt=0; if(lead) nxt=(int)__hip_atomic_fetch_add(T.queue,1u,__ATOMIC_RELAXED,__HIP_MEMORY_SCOPE_AGENT);
    int b,vh,qb; unit_of(cur,b,vh,qb); const int hm=vh>>1,half=vh&1;
    const float cs=__builtin_bit_cast(float,__builtin_amdgcn_readfirstlane(__builtin_bit_cast(int,__builtin_amdgcn_exp2f(-2.f*(float)((hm>>1)+1))*1.4426950408889634f)));
    attn_unit<THRL>(b,hm,half,qb,cs,wid,T.PN,T.Q,T.K,T.V,T.O,lds);
    if(lead) *slot=nxt;
    asm volatile("s_waitcnt vmcnt(0) lgkmcnt(0)\n\ts_barrier":::"memory");
    cur=__builtin_amdgcn_readfirstlane(*slot);
    asm volatile("s_waitcnt lgkmcnt(0)\n\ts_barrier":::"memory");
  }
}
#undef SBAR
#undef WAIT_BAR
}
constexpr int NWAVES = 8;
constexpr int RING_OFF = 0, RING_BYTES = 131072;
constexpr int LDSCTL_OFF = RING_BYTES, MISC_OFF = LDSCTL_OFF + 320;
constexpr int LDS_BYTES = 163840;

#define XB_TMO      128
#define XB_XCNT(j)  (256  + 64 * (j))
#define XB_XSUB(j)  (1280 + 64 * (j))
#define XB_XGEN(j)  (2304 + 64 * (j))
#define XB_TOP      3328
#define XB_TOPGEN   3392
#define XCD_BAR_WORDS 3456
#define XB_SPIN_CAP (1u << 18)
__device__ __forceinline__ unsigned xb_ld(unsigned* p)              { return __hip_atomic_load(p, __ATOMIC_RELAXED, __HIP_MEMORY_SCOPE_AGENT); }
__device__ __forceinline__ unsigned xb_add(unsigned* p, unsigned v) { return __hip_atomic_fetch_add(p, v, __ATOMIC_RELAXED, __HIP_MEMORY_SCOPE_AGENT); }
__device__ __forceinline__ unsigned xb_xcc_id() { return (unsigned)__builtin_amdgcn_s_getreg((3 << 11) | 20) & 0xFu; }
#define XB_SPIN(cond, bar) do { unsigned _sp = 0; while (cond) { __builtin_amdgcn_s_sleep(1); \
    if ((++_sp & 255u) == 0u) { if (xb_ld(&(bar)[XB_TMO])) break; if (_sp > XB_SPIN_CAP) { atomicAdd(&(bar)[XB_TMO], 1u); break; } } } } while (0)
struct XcdBarrier { unsigned* bar; unsigned x; volatile LAS unsigned* st; bool wave0; };
__device__ __forceinline__ XcdBarrier xcd_barrier_post(unsigned* bar, volatile LAS unsigned* st) {
    XcdBarrier b; b.bar = bar; b.x = xb_xcc_id(); b.st = st; b.wave0 = __builtin_amdgcn_readfirstlane(threadIdx.x >> 6) == 0;
    if (threadIdx.x == 0) (void)xb_add(&bar[XB_XCNT(b.x)], 1u);
    return b;
}
__device__ __forceinline__ void xcd_barrier_complete(unsigned* bar, unsigned x, unsigned& nloc, unsigned& nx) {
    const unsigned G = gridDim.x * gridDim.y * gridDim.z;
    unsigned sum, cnt, mine, sp = 0u;
    for (;;) {
        sum = 0u; cnt = 0u; mine = 0u;
#pragma unroll
        for (unsigned j = 0; j < 16; ++j) { const unsigned c = xb_ld(&bar[XB_XCNT(j)]); sum += c; cnt += (c > 0u) ? 1u : 0u; mine = (j == x) ? c : mine; }
        if (sum == G) break;
        __builtin_amdgcn_s_sleep(1);
        if ((++sp & 255u) == 0u) { if (xb_ld(&bar[XB_TMO])) break; if (sp > XB_SPIN_CAP) { atomicAdd(&bar[XB_TMO], 1u); break; } }
    }
    nloc = mine > 0u ? mine : 1u; nx = cnt > 0u ? cnt : 1u;
}
__device__ __forceinline__ void xcd_barrier(const XcdBarrier& b) {
    asm volatile("s_waitcnt vmcnt(0)" ::: "memory");
    __syncthreads();
    if (b.wave0 && lane_id() == 0) {
        unsigned* bar = b.bar;
        __builtin_amdgcn_s_waitcnt(0);
        unsigned nloc = b.st[0], nx = b.st[1];
        if (nloc == 0u) { xcd_barrier_complete(bar, b.x, nloc, nx); b.st[0] = nloc; b.st[1] = nx; }
        const unsigned old = xb_add(&bar[XB_XSUB(b.x)], 1u);
        const unsigned gen = old / nloc;
        if (old + 1u == (gen + 1u) * nloc) {
            __builtin_amdgcn_fence(__ATOMIC_RELEASE, "agent");
            asm volatile("s_waitcnt vmcnt(0)" ::: "memory");
            const unsigned og = xb_add(&bar[XB_TOP], 1u);
            const unsigned tg = og / nx;
            if (og + 1u == (tg + 1u) * nx) xb_add(&bar[XB_TOPGEN], 1u);
            else XB_SPIN(xb_ld(&bar[XB_TOPGEN]) == tg, bar);
            __builtin_amdgcn_fence(__ATOMIC_ACQUIRE, "agent");
            xb_add(&bar[XB_XGEN(b.x)], 1u);
            asm volatile("s_waitcnt vmcnt(0)" ::: "memory");
        } else {
            XB_SPIN(xb_ld(&bar[XB_XGEN(b.x)]) == gen, bar);
            __builtin_amdgcn_fence(__ATOMIC_ACQUIRE, "agent");
            asm volatile("s_waitcnt vmcnt(0)" ::: "memory");
        }
    }
    __syncthreads();
}

struct Frame {
    LAS unsigned char* lds; volatile LAS unsigned* MISC; gu32* ctl;
    int tid, lane, wave, vcu, G;
};
__device__ __forceinline__ float bf2f_(unsigned short b) { return __builtin_bit_cast(float, (unsigned)b << 16); }
__device__ __forceinline__ float wave_sum(float v) {
#pragma unroll
    for (int o = 1; o < 64; o <<= 1) v += __shfl_xor(v, o);
    return v;
}
__device__ __forceinline__ void p0_transpose_item(const float* W, int ldw, int K, bf16* WT, int k0, int n0, int drow0, LAS float* scr, int lane) {
#pragma unroll 8
    for (int i = 0; i < 32; ++i) { const int kk = 2 * i + (lane >> 5); scr[kk * 33 + (lane & 31)] = W[(size_t)(k0 + kk) * ldw + n0 + (lane & 31)]; }
    LDS_WAIT(); asm volatile("" ::: "memory");
    const int c = lane & 7;
#pragma unroll
    for (int j = 0; j < 4; ++j) { const int n = (lane >> 3) + 8 * j; const LAS float* s = scr + (8 * c) * 33 + n;
        v4u o; o.x = pk2(s[0 * 33], s[1 * 33]); o.y = pk2(s[2 * 33], s[3 * 33]); o.z = pk2(s[4 * 33], s[5 * 33]); o.w = pk2(s[6 * 33], s[7 * 33]);
        *(GAS v4u*)(WT + (size_t)(drow0 + n) * K + k0 + 8 * c) = o; }
    LDS_WAIT(); asm volatile("" ::: "memory");
}
__device__ __forceinline__ void p0_transpose_item_f8(const float* W, int ldw, int K, unsigned char* WT, int k0, int n0, int drow0, float scale, LAS float* scr, int lane) {
#pragma unroll 8
    for (int i = 0; i < 32; ++i) { const int kk = 2 * i + (lane >> 5); scr[kk * 33 + (lane & 31)] = W[(size_t)(k0 + kk) * ldw + n0 + (lane & 31)] * scale; }
    LDS_WAIT(); asm volatile("" ::: "memory");
    const int c = lane & 3;
#pragma unroll
    for (int j = 0; j < 2; ++j) { const int n = (lane >> 2) + 16 * j; const LAS float* s = scr + (16 * c) * 33 + n;
        v4u o; o.x = pg8::pk4_fp8(s[0 * 33], s[1 * 33], s[2 * 33], s[3 * 33]); o.y = pg8::pk4_fp8(s[4 * 33], s[5 * 33], s[6 * 33], s[7 * 33]);
        o.z = pg8::pk4_fp8(s[8 * 33], s[9 * 33], s[10 * 33], s[11 * 33]); o.w = pg8::pk4_fp8(s[12 * 33], s[13 * 33], s[14 * 33], s[15 * 33]);
        *(GAS v4u*)(WT + (size_t)(drow0 + n) * K + k0 + 16 * c) = o; }
    LDS_WAIT(); asm volatile("" ::: "memory");
}
struct Ptrs {
    const float *x, *p, *w_in, *b_gate, *lq1, *lk1, *lq2, *lk2, *subln, *w_abr, *w_pmix, *pscale, *w_pbr, *w_out, *ln1g, *ln1b, *w_router, *b_router, *w_up, *b_up, *w_down, *b_down, *w_pg, *w_pp, *ln2g, *ln2b;
    float* out; unsigned char* ws;
};
__device__ __forceinline__ void ph0_prologue(Frame& F, const Ptrs& P) {
    unsigned char* ws = P.ws;
    LAS float* scr = (LAS float*)(F.lds + RING_OFF + F.wave * 16384);
    const int gw = F.vcu * NWAVES + F.wave, NGW = F.G * NWAVES;
    { const size_t n4 = (size_t)M * D / 4, st = (size_t)F.G * 512; const f32x4* src = (const f32x4*)P.x; unsigned long long* dst = (unsigned long long*)(ws + WS_XB);
      unsigned* dst8 = (unsigned*)(ws + WS_XF8);
      for (size_t i = (size_t)blockIdx.x * 512 + F.tid; i < n4; i += st) { const f32x4 v = src[i]; dst[i] = (unsigned long long)pk2(v.x, v.y) | ((unsigned long long)pk2(v.z, v.w) << 32);
          if (PROJ_F8_FROM < 16) dst8[i] = pg8::pk4_fp8(v.x, v.y, v.z, v.w); } }
    constexpr int I_IN = 16 * 128, I_A = 8 * 32, I_O = 16 * 32, I_PG = 16 * 32, I_PP = 4 * 32, I_UP1 = 16 * 64, I_DN1 = 16 * 32;
    constexpr int I_UP = NEXP * I_UP1, I_DN = NEXP * I_DN1, NITEMS = I_IN + I_A + I_O + I_PG + I_PP + I_UP + I_DN;
    for (int it = gw; it < NITEMS; it += NGW) {
        int r = it;
        if (r < I_IN) { const int nb = 128, n0 = 32 * (r % nb);
            if (n0 >= 256 * PROJ_F8_FROM) p0_transpose_item_f8(P.w_in, 4096, 1024, ws + WS_WIN8, 64 * (r / nb), n0, n0 - 256 * PROJ_F8_FROM, WUP_SCALE, scr, F.lane);
            else p0_transpose_item(P.w_in, 4096, 1024, (bf16*)(ws + WS_WIN), 64 * (r / nb), n0, n0, scr, F.lane); continue; } r -= I_IN;
        if (r < I_A) { const int nb = 32; p0_transpose_item(P.w_abr, 1024, 1024, (bf16*)(ws + WS_WCAT), 64 * (r / nb), 32 * (r % nb), 32 * (r % nb), scr, F.lane); continue; } r -= I_A;
        if (r < I_O) { const int nb = 32; p0_transpose_item(P.w_out, 1024, 1024, (bf16*)(ws + WS_WOUT), 64 * (r / nb), 32 * (r % nb), 32 * (r % nb), scr, F.lane); continue; } r -= I_O;
        if (r < I_PG) { const int nb = 32; if (MOE_FP8) p0_transpose_item_f8(P.w_pg, 1024, 1024, ws + WS_WPG, 64 * (r / nb), 32 * (r % nb), 32 * (r % nb), WUP_SCALE, scr, F.lane);
            else p0_transpose_item(P.w_pg, 1024, 1024, (bf16*)(ws + WS_WPG), 64 * (r / nb), 32 * (r % nb), 32 * (r % nb), scr, F.lane); continue; } r -= I_PG;
        if (r < I_PP) { const int nb = 32; p0_transpose_item(P.w_pp, 1024, 256, (bf16*)(ws + WS_WPP), 64 * (r / nb), 32 * (r % nb), 32 * (r % nb), scr, F.lane); continue; } r -= I_PP;
        if (r < I_UP) { const int e = r / I_UP1, q = r % I_UP1, nb = 64, n0 = 32 * (q % nb);
            const int bj = n0 >> 10, pn = (n0 & 1023) >> 7, cp = n0 & 127;
            if (MOE_FP8) p0_transpose_item_f8(P.w_up + (size_t)e * 1024 * 2048, 2048, 1024, ws + WS_WUP + (size_t)e * 2048 * 1024, 64 * (q / nb), n0, 256 * pn + 128 * bj + cp, WUP_SCALE, scr, F.lane);
            else p0_transpose_item(P.w_up + (size_t)e * 1024 * 2048, 2048, 1024, (bf16*)(ws + WS_WUP) + (size_t)e * 2048 * 1024, 64 * (q / nb), n0, 256 * pn + 128 * bj + cp, scr, F.lane);
            continue; } r -= I_UP;
        { const int e = r / I_DN1, q = r % I_DN1, nb = 32;
            if (MOE_FP8) p0_transpose_item_f8(P.w_down + (size_t)e * 1024 * 1024, 1024, 1024, ws + WS_WDN + (size_t)e * 1024 * 1024, 64 * (q / nb), 32 * (q % nb), 32 * (q % nb), WDN_SCALE, scr, F.lane);
            else p0_transpose_item(P.w_down + (size_t)e * 1024 * 1024, 1024, 1024, (bf16*)(ws + WS_WDN) + (size_t)e * 1024 * 1024, 64 * (q / nb), 32 * (q % nb), 32 * (q % nb), scr, F.lane); }
    }
    { bf16* WPC = (bf16*)(ws + WS_WCAT) + 512;
      for (int k = blockIdx.x; k < 512; k += F.G) { const int g = k >> 7;
          float a0 = 0.f, a1 = 0.f; const float* wm = P.w_pmix + (size_t)k * 128; const float* sc = P.pscale + g * 128; const float* wb = P.w_pbr + (size_t)(g * 128) * 1024;
          for (int d = 0; d < 128; ++d) { const float w = wm[d] * sc[d]; a0 += w * wb[(size_t)d * 1024 + F.tid]; a1 += w * wb[(size_t)d * 1024 + 512 + F.tid]; }
          WPC[(size_t)F.tid * 1024 + k] = (bf16)f2bf(a0); WPC[(size_t)(F.tid + 512) * 1024 + k] = (bf16)f2bf(a1); } }
}
__device__ __forceinline__ void ph_pool(Frame& F, const Ptrs& P) {
    const bf16* U = (const bf16*)(P.ws + WS_U); bf16* PO = (bf16*)(P.ws + WS_APO) + 512;
    const size_t nitem = (size_t)M * 64, st = (size_t)F.G * 512;
    for (size_t idx = (size_t)blockIdx.x * 512 + F.tid; idx < nitem; idx += st) {
        const size_t row = idx >> 6; const int cg = (int)(idx & 63), c0 = cg * 8, pos = (int)(row & (SEQ - 1)), w = 2 << (c0 >> 7), n = pos + 1 < w ? pos + 1 : w;
        float s[8] = {0.f, 0.f, 0.f, 0.f, 0.f, 0.f, 0.f, 0.f}; v4u cur = *(const v4u*)(U + row * 512 + c0);
        for (int k = 0; k < n; ++k) { const v4u v = k == 0 ? cur : *(const v4u*)(U + (row - k) * 512 + c0);
            s[0] += pg8::bflo(v.x); s[1] += pg8::bfhi(v.x); s[2] += pg8::bflo(v.y); s[3] += pg8::bfhi(v.y); s[4] += pg8::bflo(v.z); s[5] += pg8::bfhi(v.z); s[6] += pg8::bflo(v.w); s[7] += pg8::bfhi(v.w); }
        const float rn = 1.f / (float)n; v4u o;
        o.x = pk2(s[0] * rn - pg8::bflo(cur.x), s[1] * rn - pg8::bfhi(cur.x)); o.y = pk2(s[2] * rn - pg8::bflo(cur.y), s[3] * rn - pg8::bfhi(cur.y));
        o.z = pk2(s[4] * rn - pg8::bflo(cur.z), s[5] * rn - pg8::bfhi(cur.z)); o.w = pk2(s[6] * rn - pg8::bflo(cur.w), s[7] * rn - pg8::bfhi(cur.w));
        *(v4u*)(PO + row * 1024 + c0) = o;
    }
}
__device__ __forceinline__ float lam_value(const Ptrs& P) { float a = 0.f, b = 0.f; for (int d = 0; d < 64; ++d) { a += P.lq1[d] * P.lk1[d]; b += P.lq2[d] * P.lk2[d]; } return __expf(a) - __expf(b) + 0.2f; }
__device__ __forceinline__ void ph_combine(Frame& F, const Ptrs& P) {
    const bf16* O16 = (const bf16*)(P.ws + WS_O16); bf16* OA = (bf16*)(P.ws + WS_APO); const float lam = lam_value(P);
    const int gw = F.vcu * NWAVES + F.wave, NGW = F.G * NWAVES, h = F.lane >> 4, e0 = (F.lane & 15) * 8;
    float sg[8];
#pragma unroll
    for (int j = 0; j < 8; ++j) sg[j] = P.subln[e0 + j] * 0.8f;
    for (int row = gw; row < M; row += NGW) {
        const v4u a = *(const v4u*)(O16 + (size_t)row * 1024 + h * 256 + e0), b = *(const v4u*)(O16 + (size_t)row * 1024 + h * 256 + 128 + e0);
        f32x4 a0, a1, b0, b1; pg8::unpack8(a, a0, a1); pg8::unpack8(b, b0, b1); a0 -= b0 * lam; a1 -= b1 * lam;
        float ss = (a0[0] * a0[0] + a0[1] * a0[1]) + (a0[2] * a0[2] + a0[3] * a0[3]) + (a1[0] * a1[0] + a1[1] * a1[1]) + (a1[2] * a1[2] + a1[3] * a1[3]);
        ss += __shfl_xor(ss, 1); ss += __shfl_xor(ss, 2); ss += __shfl_xor(ss, 4); ss += __shfl_xor(ss, 8);
        const float r = rsqrtf(ss * (1.f / 128.f) + LN_EPS);
#pragma unroll
        for (int j = 0; j < 4; ++j) { a0[j] *= r * sg[j]; a1[j] *= r * sg[4 + j]; }
        *(v4u*)(OA + (size_t)row * 1024 + h * 128 + e0) = pg8::pack8(a0, a1);
    }
}
typedef float f32x16_ __attribute__((ext_vector_type(16)));
__device__ __forceinline__ void hilo8(const f32x4& a, const f32x4& b, bf16x8& hi, bf16x8& lo) {
    unsigned h[4], l[4];
    h[0] = pg8::cvt_pk_bf16(a[0], a[1]); h[1] = pg8::cvt_pk_bf16(a[2], a[3]); h[2] = pg8::cvt_pk_bf16(b[0], b[1]); h[3] = pg8::cvt_pk_bf16(b[2], b[3]);
    l[0] = pg8::cvt_pk_bf16(a[0] - pg8::bflo(h[0]), a[1] - pg8::bfhi(h[0])); l[1] = pg8::cvt_pk_bf16(a[2] - pg8::bflo(h[1]), a[3] - pg8::bfhi(h[1]));
    l[2] = pg8::cvt_pk_bf16(b[0] - pg8::bflo(h[2]), b[1] - pg8::bfhi(h[2])); l[3] = pg8::cvt_pk_bf16(b[2] - pg8::bflo(h[3]), b[3] - pg8::bfhi(h[3]));
    v4u hv = {h[0], h[1], h[2], h[3]}, lv = {l[0], l[1], l[2], l[3]}; hi = __builtin_bit_cast(bf16x8, hv); lo = __builtin_bit_cast(bf16x8, lv);
}
__device__ __forceinline__ void ph6_ln1_route(Frame& F, const Ptrs& P, const bool dry) {
    unsigned char* ws = P.ws;
    constexpr int XT_OFF = 0, XT_PITCH = 1028, PL_OFF = 16 * XT_PITCH * 4, LG_OFF = PL_OFF + 8 * 16 * 32 * 4, RS_OFF = LG_OFF + 256 * 33 * 4;
    static_assert(RS_OFF + 256 <= RING_BYTES, "ph6 LDS map");
    { const size_t n4 = (size_t)M * PLE / 4, st = (size_t)F.G * 512; const f32x4* src = (const f32x4*)P.p; unsigned long long* dst = (unsigned long long*)(ws + (dry ? 804 * MiB : WS_PB));
      for (size_t i = (size_t)blockIdx.x * 512 + F.tid; i < n4; i += st) { const f32x4 v = src[i]; dst[i] = (unsigned long long)pk2(v.x, v.y) | ((unsigned long long)pk2(v.z, v.w) << 32); } }
    const float* X1in = P.out; float* X1 = dry ? (float*)(ws + 356 * MiB) : P.out; bf16* X1B = (bf16*)(ws + (dry ? 612 * MiB : WS_X1B)); unsigned char* X1F8 = ws + (dry ? 740 * MiB : WS_X1F8);
    const int lane = F.lane, wave = F.wave, e = lane & 31, kh = lane >> 5;
    LAS float* XT = (LAS float*)(F.lds + XT_OFF); LAS float* PL = (LAS float*)(F.lds + PL_OFF); LAS float* LG = (LAS float*)(F.lds + LG_OFF);
    bf16x8 bh[8], bl[8];
#pragma unroll
    for (int s = 0; s < 8; ++s) { const float* wp = P.w_router + (size_t)(128 * wave + 16 * s + 8 * kh) * 32 + e;
        const f32x4 a = {wp[0], wp[32], wp[64], wp[96]}, b = {wp[128], wp[160], wp[192], wp[224]}; hilo8(a, b, bh[s], bl[s]); }
    f32x4 gam[4], bet[4];
#pragma unroll
    for (int j = 0; j < 4; ++j) { gam[j] = ((const f32x4*)P.ln1g)[lane + 64 * j]; bet[j] = ((const f32x4*)P.ln1b)[lane + 64 * j]; }
    const float brt = P.b_router[e];
    for (int chunk = blockIdx.x; chunk < M / 256; chunk += F.G) {
        f32x4 v[2][4];
#pragma unroll
        for (int i = 0; i < 2; ++i)
#pragma unroll
            for (int j = 0; j < 4; ++j) v[i][j] = ((const f32x4*)(X1in + (size_t)(chunk * 256 + 2 * wave + i) * 1024))[lane + 64 * j];
#pragma unroll 1
        for (int step = 0; step < 16; ++step) {
            f32x4 nx[2][4];
            if (step < 15) {
#pragma unroll
                for (int i = 0; i < 2; ++i)
#pragma unroll
                    for (int j = 0; j < 4; ++j) nx[i][j] = ((const f32x4*)(X1in + (size_t)(chunk * 256 + (step + 1) * 16 + 2 * wave + i) * 1024))[lane + 64 * j]; }
            float s0 = 0.f, s1 = 0.f;
#pragma unroll
            for (int j = 0; j < 4; ++j) { s0 += (v[0][j].x + v[0][j].y) + (v[0][j].z + v[0][j].w); s1 += (v[1][j].x + v[1][j].y) + (v[1][j].z + v[1][j].w); }
#pragma unroll
            for (int o = 1; o < 64; o <<= 1) { s0 += __shfl_xor(s0, o); s1 += __shfl_xor(s1, o); }
            const float m0 = s0 * (1.f / 1024.f), m1 = s1 * (1.f / 1024.f); float q0 = 0.f, q1 = 0.f;
#pragma unroll
            for (int j = 0; j < 4; ++j) { v[0][j] = v[0][j] - m0; v[1][j] = v[1][j] - m1;
                q0 += (v[0][j].x * v[0][j].x + v[0][j].y * v[0][j].y) + (v[0][j].z * v[0][j].z + v[0][j].w * v[0][j].w); q1 += (v[1][j].x * v[1][j].x + v[1][j].y * v[1][j].y) + (v[1][j].z * v[1][j].z + v[1][j].w * v[1][j].w); }
#pragma unroll
            for (int o = 1; o < 64; o <<= 1) { q0 += __shfl_xor(q0, o); q1 += __shfl_xor(q1, o); }
            const float r0 = rsqrtf(q0 * (1.f / 1024.f) + LN_EPS), r1 = rsqrtf(q1 * (1.f / 1024.f) + LN_EPS);
#pragma unroll
            for (int i = 0; i < 2; ++i) { const int rl = 2 * wave + i; const size_t row = (size_t)chunk * 256 + step * 16 + rl; const float rs = i ? r1 : r0;
#pragma unroll
                for (int j = 0; j < 4; ++j) { const f32x4 y = v[i][j] * rs * gam[j] + bet[j];
                    ((f32x4*)(X1 + row * 1024))[lane + 64 * j] = y;
                    ((unsigned long long*)(X1B + row * 1024))[lane + 64 * j] = (unsigned long long)pk2(y.x, y.y) | ((unsigned long long)pk2(y.z, y.w) << 32);
                    if (MOE_FP8) ((unsigned*)(X1F8 + row * 1024))[lane + 64 * j] = pg8::pk4_fp8(y.x, y.y, y.z, y.w);
                    *(LAS f32x4*)(XT + rl * XT_PITCH + 4 * (lane + 64 * j)) = y; } }
            __syncthreads();
            f32x16_ acc = {};
#pragma unroll
            for (int s = 0; s < 8; ++s) { const LAS float* xp = XT + (lane & 15) * XT_PITCH + 128 * wave + 16 * s + 8 * kh;
                const f32x4 a = *(const LAS f32x4*)xp, b = *(const LAS f32x4*)(xp + 4); bf16x8 ah, al; hilo8(a, b, ah, al);
                acc = __builtin_amdgcn_mfma_f32_32x32x16_bf16(ah, bh[s], acc, 0, 0, 0); acc = __builtin_amdgcn_mfma_f32_32x32x16_bf16(al, bh[s], acc, 0, 0, 0); acc = __builtin_amdgcn_mfma_f32_32x32x16_bf16(ah, bl[s], acc, 0, 0, 0); }
#pragma unroll
            for (int i = 0; i < 8; ++i) PL[(wave * 16 + (i & 3) + 8 * (i >> 2) + 4 * kh) * 32 + e] = acc[i];
            __syncthreads();
            { const int row = F.tid >> 5, ee = F.tid & 31; float sum = 0.f;
#pragma unroll
              for (int w = 0; w < 8; ++w) sum += PL[(w * 16 + row) * 32 + ee];
              LG[(step * 16 + row) * 33 + ee] = sum + __shfl(brt, ee); }
            if (step < 15) {
#pragma unroll
                for (int i = 0; i < 2; ++i)
#pragma unroll
                    for (int j = 0; j < 4; ++j) v[i][j] = nx[i][j]; }
        }
        __syncthreads();
        LAS int* cntl = (LAS int*)(F.lds + RS_OFF); LAS int* basel = cntl + 32;
        if (F.tid < 32) cntl[F.tid] = 0;
        int my_e[4] = {0, 0, 0, 0}; float my_g[4] = {0.f, 0.f, 0.f, 0.f};
        if (F.tid < 256) { float lg[32];
#pragma unroll
            for (int k = 0; k < 32; ++k) lg[k] = LG[F.tid * 33 + k];
            float tv[4];
#pragma unroll
            for (int r = 0; r < 4; ++r) { float bv = lg[0]; int bi = 0;
#pragma unroll
                for (int k = 1; k < 32; ++k) if (lg[k] > bv) { bv = lg[k]; bi = k; }
                tv[r] = bv; my_e[r] = bi;
#pragma unroll
                for (int k = 0; k < 32; ++k) if (k == bi) lg[k] = -INFINITY; }
            const float e1 = __expf(tv[1] - tv[0]), e2 = __expf(tv[2] - tv[0]), e3 = __expf(tv[3] - tv[0]), rs = 1.f / (1.f + e1 + e2 + e3);
            my_g[0] = rs; my_g[1] = e1 * rs; my_g[2] = e2 * rs; my_g[3] = e3 * rs; }
        __syncthreads();
        int rk[4] = {0, 0, 0, 0};
        if (F.tid < 256) {
#pragma unroll
            for (int k = 0; k < 4; ++k) rk[k] = __hip_atomic_fetch_add(&cntl[my_e[k]], 1, __ATOMIC_RELAXED, __HIP_MEMORY_SCOPE_WORKGROUP); }
        __syncthreads();
        if (F.tid < 32) basel[F.tid] = (int)__hip_atomic_fetch_add(F.ctl + CW_CNT + (dry ? 32 : 0) + F.tid, (unsigned)cntl[F.tid], RLX_AGENT);
        __syncthreads();
        if (F.tid < 256) { const int row = chunk * 256 + F.tid; int* LIST = (int*)(ws + (dry ? 836 * MiB : WS_LIST)); float* GATEL = (float*)(ws + (dry ? 844 * MiB : WS_GATEL)); float* GATE = (float*)(ws + (dry ? 852 * MiB : WS_GATE));
#pragma unroll
            for (int k = 0; k < 4; ++k) { const size_t o = (size_t)my_e[k] * 65536 + (size_t)(basel[my_e[k]] + rk[k]); LIST[o] = row * 4 + k; GATEL[o] = my_g[k]; GATE[row * 4 + k] = my_g[k]; } }
        __syncthreads();
    }
}
__device__ __forceinline__ void ph10_final(Frame& F, const Ptrs& P, const bool dry) {
    float* dst = dry ? (float*)(P.ws + 356 * MiB) : P.out;
    const bf16* PLEB = (const bf16*)(P.ws + WS_PLE); const unsigned char* YS0 = P.ws + WS_YS0; const unsigned char* YS1 = P.ws + WS_YS1; const unsigned char* YS2 = P.ws + WS_YS2; const unsigned char* YS3 = P.ws + WS_YS3;
    const int gw = F.vcu * NWAVES + F.wave, NGW = F.G * NWAVES, lane = F.lane;
    f32x4 gam[4], bet[4];
#pragma unroll
    for (int j = 0; j < 4; ++j) { gam[j] = ((const f32x4*)P.ln2g)[lane + 64 * j]; bet[j] = ((const f32x4*)P.ln2b)[lane + 64 * j]; }
    for (int row = gw; row < M; row += NGW) {
        f32x4 v[4]; float s = 0.f;
#pragma unroll
        for (int j = 0; j < 4; ++j) { const size_t o = (size_t)row * 256 + lane + 64 * j; v[j] = ((const f32x4*)P.out)[o] * ALPHA;
            { const unsigned long long e = ((const unsigned long long*)PLEB)[o]; const unsigned e0 = (unsigned)e, e1 = (unsigned)(e >> 32); v[j].x += pg8::bflo(e0); v[j].y += pg8::bfhi(e0); v[j].z += pg8::bflo(e1); v[j].w += pg8::bfhi(e1); }
            { const unsigned a = ((const unsigned*)YS0)[o], b = ((const unsigned*)YS1)[o], c = ((const unsigned*)YS2)[o], d = ((const unsigned*)YS3)[o]; constexpr float is = 1.f / YS_SCALE;
              typedef float f32x2_ __attribute__((ext_vector_type(2)));
              const f32x2_ a0 = __builtin_amdgcn_cvt_pk_f32_fp8(a, false), a1 = __builtin_amdgcn_cvt_pk_f32_fp8(a, true), b0 = __builtin_amdgcn_cvt_pk_f32_fp8(b, false), b1 = __builtin_amdgcn_cvt_pk_f32_fp8(b, true);
              const f32x2_ c0 = __builtin_amdgcn_cvt_pk_f32_fp8(c, false), c1 = __builtin_amdgcn_cvt_pk_f32_fp8(c, true), d0 = __builtin_amdgcn_cvt_pk_f32_fp8(d, false), d1 = __builtin_amdgcn_cvt_pk_f32_fp8(d, true);
              v[j].x += ((a0[0] + b0[0]) + (c0[0] + d0[0])) * is; v[j].y += ((a0[1] + b0[1]) + (c0[1] + d0[1])) * is; v[j].z += ((a1[0] + b1[0]) + (c1[0] + d1[0])) * is; v[j].w += ((a1[1] + b1[1]) + (c1[1] + d1[1])) * is; }
            s += (v[j].x + v[j].y) + (v[j].z + v[j].w); }
        const float mean = wave_sum(s) * (1.f / 1024.f); float s2 = 0.f;
#pragma unroll
        for (int j = 0; j < 4; ++j) { v[j] = v[j] - mean; s2 += (v[j].x * v[j].x + v[j].y * v[j].y) + (v[j].z * v[j].z + v[j].w * v[j].w); }
        const float rstd = rsqrtf(wave_sum(s2) * (1.f / 1024.f) + LN_EPS);
#pragma unroll
        for (int j = 0; j < 4; ++j) ((f32x4*)dst)[(size_t)row * 256 + lane + 64 * j] = v[j] * rstd * gam[j] + bet[j];
    }
}
__device__ __forceinline__ void moe_tables(Frame& F) {
    LAS int* cnt = (LAS int*)(F.lds + pg8::TAB_CNT); LAS int* blk0 = (LAS int*)(F.lds + pg8::TAB_BLK0); LAS int* row0 = (LAS int*)(F.lds + pg8::TAB_ROW0);
    __syncthreads();
    if (F.tid < 32) cnt[F.tid] = (int)__hip_atomic_load(F.ctl + CW_CNT + F.tid, RLX_AGENT);
    __syncthreads();
    if (F.tid == 0) { int b = 0, r = 0; for (int e = 0; e < 32; ++e) { blk0[e] = b; row0[e] = r; b += (cnt[e] + 255) >> 8; r += cnt[e]; } blk0[32] = b; row0[32] = r; }
    __syncthreads();
}

constexpr int NPHASE = 11;
struct Args { Ptrs P; int ph_lo, ph_hi; };
__global__ void __launch_bounds__(NWAVES * 64, 2) mk_fwd(Args args) {
    extern __shared__ __attribute__((aligned(16))) unsigned char lds[];
    Frame F; const Ptrs& P = args.P;
    F.lds = (LAS unsigned char*)lds; F.MISC = (volatile LAS unsigned*)(F.lds + MISC_OFF);
    F.wave = __builtin_amdgcn_readfirstlane(threadIdx.x >> 6); F.lane = lane_id(); F.tid = F.wave * 64 + F.lane;
#define REFRESH() do { F.lane = lane_id(); asm volatile("" : "+v"(F.lane)); F.tid = F.wave * 64 + F.lane; } while (0)
    F.G = gridDim.x; { const int bx = blockIdx.x; F.vcu = (F.G % 8 == 0) ? (bx % 8) * (F.G / 8) + bx / 8 : bx; }
    unsigned char* ws = P.ws; F.ctl = (gu32*)(ws + WS_CTL);
    for (int u = F.tid; u < 1024 / 4; u += NWAVES * 64) ((LAS unsigned*)(F.lds + LDSCTL_OFF))[u] = 0u;
    __syncthreads();
    const int lo = args.ph_lo, hi = args.ph_hi;
    XcdBarrier bar = xcd_barrier_post((unsigned*)(F.ctl + CW_BAR) + lo * XCD_BAR_WORDS, F.MISC + 8);
#ifndef PH_COMPILE
#define PH_COMPILE 0x7ff
#endif
#define IN(k) ((((PH_COMPILE) >> (k)) & 1) && lo <= (k) && (k) < hi)
#define SEAM(k) do { if (IN(k) && IN((k) + 1)) xcd_barrier(bar); } while (0)
#ifndef REP2_MASK
#define REP2_MASK 0
#endif
#define REPS(k) for (int rep_ = 0; rep_ < ((((REP2_MASK) >> (k)) & 1) ? 2 : 1); ++rep_)
    bf16 *XB = (bf16*)(ws + WS_XB), *Q = (bf16*)(ws + WS_Q), *K = (bf16*)(ws + WS_K), *V = (bf16*)(ws + WS_V), *U = (bf16*)(ws + WS_U), *G = (bf16*)(ws + WS_G);
    bf16 *O16 = (bf16*)(ws + WS_O16), *APO = (bf16*)(ws + WS_APO), *MIX = (bf16*)(ws + WS_MIX), *X1B = (bf16*)(ws + WS_X1B), *HB = (bf16*)(ws + WS_HB), *PB = (bf16*)(ws + WS_PB);
    bf16* T = (bf16*)(ws + WS_T);

    if (IN(0)) REPS(0) { REFRESH(); ph0_prologue(F, P); } SEAM(0);
    if (IN(1)) REPS(1) {
        { pg8::Gemm g{XB, (const bf16*)(ws + WS_WIN), 1024}; pg8::StaticOrder S; S.init(M, 256 * (PROJ_F8_FROM < 16 ? PROJ_F8_FROM : 16), F.G, (int)blockIdx.x);
          pg8::EpiProj E{Q, K, V, U, G, P.b_gate, (float*)(F.ctl + CW_PN), C2Q, 1.f, 0, 0};
          pg8::gemm_phase(F.lds, F.wave, g, S, E); }
        if (PROJ_F8_FROM < 16) {
          pg8::Gemm g{(const bf16*)(ws + WS_XF8), (const bf16*)(ws + WS_WIN8), 512}; pg8::DenseF8Order S; S.init(M, 256 * (16 - PROJ_F8_FROM), F.G, (int)blockIdx.x);
          pg8::EpiProj E{Q, K, V, U, G, P.b_gate, (float*)(F.ctl + CW_PN), C2Q, 1.f / WUP_SCALE, PROJ_F8_FROM, 0};
          pg8::gemm_phase(F.lds, F.wave, g, S, E); }
    } SEAM(1);
    if (IN(2)) REPS(2) {
        const attn_body::AttnTensors AT{(const attn_body::bf16*)Q, (const attn_body::bf16*)K, (const attn_body::bf16*)V, (attn_body::bf16*)O16, (const float*)(F.ctl + CW_PN), (unsigned*)(F.ctl + CW_AQ)};
        attn_body::attn_phase<-1>((char*)lds + RING_OFF, AT, F.wave);
#ifdef TIME_PH2
        { attn_body::AttnTensors AT2 = AT; AT2.queue = (unsigned*)(F.ctl + CW_AQ + 64); attn_body::attn_phase<-1>((char*)lds + RING_OFF, AT2, F.wave); }
#endif
#ifndef NO_POOL
        REFRESH(); ph_pool(F, P);
#endif
    } SEAM(2);
    if (IN(3)) REPS(3) { REFRESH(); ph_combine(F, P); } SEAM(3);
    if (IN(4)) REPS(4) {
        pg8::StaticOrder S; S.init(M, 1024, F.G, (int)blockIdx.x);
        pg8::Gemm g{APO, (const bf16*)(ws + WS_WCAT), 1024}; pg8::EpiMixCat E{MIX, G}; pg8::gemm_phase(F.lds, F.wave, g, S, E);
    } SEAM(4);
    if (IN(5)) REPS(5) {
        pg8::Gemm g{MIX, (const bf16*)(ws + WS_WOUT), 1024}; pg8::StaticOrder S; S.init(M, 1024, F.G, (int)blockIdx.x);
        pg8::EpiF32<0> E{P.out, P.x, ALPHA, 1.f};
        pg8::gemm_phase(F.lds, F.wave, g, S, E);
    } SEAM(5);
#ifndef DRY_MASK
#define DRY_MASK 0
#endif
    if (IN(6)) { if ((DRY_MASK >> 6) & 1) { REFRESH(); ph6_ln1_route(F, P, true); } REFRESH(); ph6_ln1_route(F, P, false); } SEAM(6);
    if (IN(7)) REPS(7) {
        pg8::StaticOrder S; S.init(M, 1024, F.G, (int)blockIdx.x);
#ifndef NO_PH7A
        { pg8::Gemm g{PB, (const bf16*)(ws + WS_WPP), 256}; pg8::EpiF32<1> E{(float*)T, nullptr, 0.f, 1.f}; pg8::gemm_phase(F.lds, F.wave, g, S, E); }
#endif
        VM_WAIT(); __syncthreads();
#ifndef NO_PH7B
        if (MOE_FP8) { pg8::DenseF8Order S8; S8.init(M, 1024, F.G, (int)blockIdx.x);
            pg8::Gemm g{(const bf16*)(ws + WS_X1F8), (const bf16*)(ws + WS_WPG), 512}; pg8::EpiF32<3> E{(float*)(ws + WS_PLE), (const float*)T, ALPHA, 1.f / WUP_SCALE}; pg8::gemm_phase(F.lds, F.wave, g, S8, E); }
        else { pg8::Gemm g{X1B, (const bf16*)(ws + WS_WPG), 1024}; pg8::EpiF32<3> E{(float*)(ws + WS_PLE), (const float*)T, ALPHA, 1.f}; pg8::gemm_phase(F.lds, F.wave, g, S, E); }
#endif
    } SEAM(7);
    if (IN(8)) REPS(8) {
        REFRESH(); moe_tables(F);
        pg8::Gemm g{MOE_FP8 ? (const bf16*)(ws + WS_X1F8) : X1B, (const bf16*)(ws + WS_WUP), MOE_FP8 ? 512 : 1024};
        pg8::MoeOrder<true, MOE_FP8> S{8, F.G, (int)blockIdx.x, (const int*)(ws + WS_LIST), (const float*)(ws + WS_GATEL), (size_t)2048 * 1024 * (MOE_FP8 ? 1 : 2)};
        pg8::EpiUp<MOE_FP8> E{HB, P.b_up, MOE_FP8 ? 1.f / WUP_SCALE : 1.f, 0};
        pg8::gemm_phase(F.lds, F.wave, g, S, E);
    } SEAM(8);
    if (IN(9)) REPS(9) {
        REFRESH(); moe_tables(F);
        pg8::Gemm g{HB, (const bf16*)(ws + WS_WDN), MOE_FP8 ? 512 : 1024};
        pg8::MoeOrder<false, MOE_FP8> S{4, F.G, (int)blockIdx.x, (const int*)(ws + WS_LIST), (const float*)(ws + WS_GATEL), (size_t)1024 * 1024 * (MOE_FP8 ? 1 : 2)};
        pg8::EpiDown E{ws + WS_YS0, ws + WS_YS1, ws + WS_YS2, ws + WS_YS3, P.b_down, MOE_FP8 ? 1.f / (WDN_SCALE) : 1.f, YS_SCALE};
        pg8::gemm_phase(F.lds, F.wave, g, S, E);
    } SEAM(9);
    if (IN(10)) { if ((DRY_MASK >> 10) & 1) { REFRESH(); ph10_final(F, P, true); } REFRESH(); ph10_final(F, P, false); }
#undef IN
#undef SEAM
}
#ifndef FAST_MASK
#define FAST_MASK 0x7ff
#endif
#ifndef MERGE_FAST
#define MERGE_FAST 1
#endif
extern "C" void kernel_launch(void* const* d_in, const int* in_sizes, int n_in, void* d_out, int out_size, void* d_ws, size_t ws_size, hipStream_t stream) {
    static int grid = 0;
    if (grid == 0) {
        if (n_in != 26 || ws_size < WS_END || out_size != M * D) { fprintf(stderr, "kernel_launch: unexpected shapes (n_in %d, ws %zu, out %d)\n", n_in, ws_size, out_size); grid = -1; return; }
        int dev = 0, cus = 0, per_cu = 0;
        if (hipGetDevice(&dev) != hipSuccess || hipDeviceGetAttribute(&cus, hipDeviceAttributeMultiprocessorCount, dev) != hipSuccess) { grid = -1; return; }
        if (hipFuncSetAttribute((const void*)mk_fwd, hipFuncAttributeMaxDynamicSharedMemorySize, LDS_BYTES) != hipSuccess) { fprintf(stderr, "kernel_launch: hipFuncSetAttribute failed\n"); grid = -1; return; }
        if (hipOccupancyMaxActiveBlocksPerMultiprocessor(&per_cu, (const void*)mk_fwd, NWAVES * 64, LDS_BYTES) != hipSuccess || per_cu < 1) fprintf(stderr, "kernel_launch: occupancy query says %d\n", per_cu);
        (void)hipGetLastError();
        grid = cus;
    }
    if (grid < 0) return;
    Ptrs P{};
    { const float** pp = (const float**)&P; for (int i = 0; i < 26; ++i) pp[i] = (const float*)d_in[i]; }
    P.out = (float*)d_out; P.ws = (unsigned char*)d_ws;
    unsigned char* ws = (unsigned char*)d_ws; float* out = (float*)d_out;
    unsigned* CTL = (unsigned*)(ws + WS_CTL); unsigned* CNT = CTL + CW_CNT; int* LIST = (int*)(ws + WS_LIST); float* GATE = (float*)(ws + WS_GATE); float* GATEL = (float*)(ws + WS_GATEL); float* WPCF = (float*)(ws + WS_WPCF);
    bf16 *XB = (bf16*)(ws + WS_XB), *PB = (bf16*)(ws + WS_PB), *Q = (bf16*)(ws + WS_Q), *K = (bf16*)(ws + WS_K), *V = (bf16*)(ws + WS_V), *U = (bf16*)(ws + WS_U), *G = (bf16*)(ws + WS_G);
    bf16 *O16 = (bf16*)(ws + WS_O16), *OA = (bf16*)(ws + WS_APO), *PO = (bf16*)(ws + WS_APO) + 512, *MIX = (bf16*)(ws + WS_MIX), *X1B = (bf16*)(ws + WS_X1B), *HB = (bf16*)(ws + WS_HB);
    bf16 *YS1 = (bf16*)(ws + WS_YS1), *YS2 = (bf16*)(ws + WS_YS2), *YS3 = (bf16*)(ws + WS_YS3); bf16* T = (bf16*)(ws + WS_T);
    (void)hipMemsetAsync(ws + WS_CTL, 0, CTL_ZERO_BYTES, stream);
    const unsigned fm = FAST_MASK;
    for (int ph = 0; ph < NPHASE;) {
        if ((fm >> ph) & 1u) {
            int hi = ph + 1; if (MERGE_FAST) while (hi < NPHASE && ((fm >> hi) & 1u)) ++hi;
            Args a{}; a.P = P; a.ph_lo = ph; a.ph_hi = hi;
            hipLaunchKernelGGL(mk_fwd, dim3(grid), dim3(NWAVES * 64), LDS_BYTES, stream, a);
            if (fm != 0x7ffu && ph == 0) { nv::k_fold_pool<<<512, 256, 0, stream>>>(P.w_pmix, P.pscale, P.w_pbr, WPCF); }
            ph = hi; continue;
        }
        switch (ph) {
        case 0: nv::k_cvt_bf16<<<2048, 256, 0, stream>>>(P.x, XB, (size_t)M * D / 4); nv::k_fold_pool<<<512, 256, 0, stream>>>(P.w_pmix, P.pscale, P.w_pbr, WPCF); break;
        case 1: nv::k_gemm<false><<<dim3(4096 / 64, M / 64, 1), 256, 0, stream>>>(nv::RowDense{XB, 1024, 0}, nv::EpiProj{Q, K, V, U, G, P.b_gate, C2Q, 0}, P.w_in, 0, 4096, 1024, 0, 0); break;
        case 2: nv::k_attn<<<dim3(SEQ / 256, 16, BATCH), 256, 0, stream>>>(Q, K, V, O16); nv::k_pool<<<(unsigned)((size_t)M * 512 / 256), 256, 0, stream>>>(U, PO); break;
        case 3: nv::k_combine<<<M / 4, 256, 0, stream>>>(O16, OA, P.lq1, P.lk1, P.lq2, P.lk2, P.subln); break;
        case 4: nv::k_gemm<false><<<dim3(1024 / 64, M / 64, 1), 256, 0, stream>>>(nv::RowDense{OA, 1024, 0}, nv::EpiMixA{MIX, G}, P.w_abr, 0, 1024, 512, 0, 0);
                nv::k_gemm<false><<<dim3(1024 / 64, M / 64, 1), 256, 0, stream>>>(nv::RowDense{PO, 1024, 0}, nv::EpiMixB{MIX, G}, WPCF, 0, 1024, 512, 0, 0); break;
        case 5: nv::k_gemm<false><<<dim3(1024 / 64, M / 64, 1), 256, 0, stream>>>(nv::RowDense{MIX, 1024, 0}, nv::EpiPre1{out, P.x, ALPHA, 0}, P.w_out, 0, 1024, 1024, 0, 0); break;
        case 6: nv::k_ln1_route<<<M, 256, 0, stream>>>(out, X1B, P.ln1g, P.ln1b, P.w_router, P.b_router, CNT, LIST, GATE, GATEL);
                nv::k_cvt_bf16<<<2048, 256, 0, stream>>>(P.p, PB, (size_t)M * PLE / 4); break;
        case 7: nv::k_gemm<false><<<dim3(1024 / 64, M / 64, 1), 256, 0, stream>>>(nv::RowDense{PB, 256, 0}, nv::EpiStoreF32{T}, P.w_pp, 0, 1024, 256, 0, 0);
                nv::k_gemm<false><<<dim3(1024 / 64, M / 64, 1), 256, 0, stream>>>(nv::RowDense{X1B, 1024, 0}, nv::EpiBase{out, T, ALPHA, 0}, P.w_pg, 0, 1024, 1024, 0, 0); break;
        case 8: nv::k_gemm<true><<<dim3(1024 / 64, M / 64, NEXP), 256, 0, stream>>>(nv::RowGather{X1B, LIST, CNT}, nv::EpiUp{HB, P.b_up, CNT}, P.w_up, (size_t)1024 * 2048, 2048, 1024, 1024, 0); break;
        case 9: nv::k_gemm<false><<<dim3(1024 / 64, M / 64, NEXP), 256, 0, stream>>>(nv::RowSlots{HB, CNT}, nv::EpiDown{out, YS1, YS2, YS3, P.b_down, LIST, GATE, CNT}, P.w_down, (size_t)1024 * 1024, 1024, 1024, 0, 0); break;
        case 10: nv::k_final<<<M, 256, 0, stream>>>(out, YS1, YS2, YS3, P.ln2g, P.ln2b); break;
        }
        ++ph;
    }
}
```

```cpp
#define FAST_MASK 0x7ff
#include <hip/hip_runtime.h>
#include <hip/hip_bf16.h>
#include <cstdio>
#include <cstdint>
#include <cmath>

#define GAS __attribute__((address_space(1)))
#define LAS __attribute__((address_space(3)))
typedef unsigned short bf16;
typedef unsigned v4u __attribute__((ext_vector_type(4)));
typedef float f32x4 __attribute__((ext_vector_type(4)));
typedef short bf16x8 __attribute__((ext_vector_type(8)));
typedef GAS unsigned gu32;
typedef GAS unsigned long long gu64;
#define RLX_AGENT __ATOMIC_RELAXED, __HIP_MEMORY_SCOPE_AGENT
#define LDS_WAIT() asm volatile("s_waitcnt lgkmcnt(0)" ::: "memory")
#define VM_WAIT() asm volatile("s_waitcnt vmcnt(0)" ::: "memory")
__device__ __forceinline__ unsigned f2bf(float f) { unsigned u = __builtin_bit_cast(unsigned, f); return (u + 0x7fffu + ((u >> 16) & 1u)) >> 16; }
__device__ __forceinline__ unsigned pk2(float lo, float hi) { return f2bf(lo) | (f2bf(hi) << 16); }

__device__ __forceinline__ int lane_id() { return (int)__builtin_amdgcn_mbcnt_hi(~0u, __builtin_amdgcn_mbcnt_lo(~0u, 0u)); }

constexpr int BATCH = 16, SEQ = 4096, D = 1024, M = BATCH * SEQ;
constexpr int NEXP = 32, TOPK = 4, NASSIGN = M * TOPK, FF = 1024, PLE = 256;
constexpr float LN_EPS = 1e-5f;
constexpr float ALPHA = 1.189207115002721f;
constexpr float C2Q = 0.125f * 1.4426950408889634f;

constexpr size_t MiB = 1u << 20;
constexpr size_t WS_CTL = 0, CTL_ZERO_BYTES = 1 * MiB;
constexpr size_t WS_LIST = 1 * MiB;
constexpr size_t WS_GATEL = 9 * MiB;
constexpr size_t WS_GATE = 17 * MiB;
constexpr size_t WS_WPCF = 18 * MiB;
constexpr size_t WS_WIN = 20 * MiB, WS_WCAT = 28 * MiB, WS_WOUT = 30 * MiB, WS_WPG = 32 * MiB, WS_WPP = 34 * MiB;
constexpr size_t WS_WDN = 36 * MiB, WS_WUP = 100 * MiB;
constexpr size_t WS_XB = 228 * MiB;
constexpr size_t WS_APO = 228 * MiB;
constexpr size_t WS_X1B = 228 * MiB;
constexpr size_t WS_Q = 356 * MiB, WS_K = 420 * MiB, WS_V = 484 * MiB, WS_U = 548 * MiB;
constexpr size_t WS_G = 612 * MiB;
constexpr size_t WS_O16 = 868 * MiB;
constexpr size_t WS_PB = 868 * MiB;
constexpr size_t WS_MIX = 356 * MiB;
constexpr size_t WS_T = 356 * MiB;
constexpr size_t WS_HB = 356 * MiB;
constexpr size_t WS_YS1 = 100 * MiB, WS_YS2 = 228 * MiB, WS_YS3 = 868 * MiB;
constexpr size_t WS_X1F8 = 900 * MiB;
constexpr size_t WS_YS0 = 612 * MiB;
constexpr size_t WS_PLE = 740 * MiB;
constexpr size_t WS_END = 1024 * MiB;
#ifndef MOE_FP8
#define MOE_FP8 1
#endif
constexpr float WUP_SCALE = 32.f, WDN_SCALE = 64.f;
#ifndef PROJ_F8_FROM
#define PROJ_F8_FROM 8
#endif
constexpr size_t WS_XF8 = 900 * MiB;
constexpr size_t WS_WIN8 = WS_WIN + (size_t)PROJ_F8_FROM * 256 * 1024 * 2;
constexpr float YS_SCALE = 16.f;
constexpr float ATT_SKIP = 40.f;
constexpr int CW_TMO = 0, CW_CODE = 1;
constexpr int CW_CNT = 64;
constexpr int CW_AQ = 128;
constexpr int CW_PN = 65536;
constexpr int CW_BAR = 4096;
namespace nv {
__device__ __forceinline__ float bf2f(bf16 b) { return __builtin_bit_cast(float, (unsigned)b << 16); }
__device__ __forceinline__ bf16 f2b(float f) { return (bf16)f2bf(f); }
__device__ __forceinline__ float sigm(float v) { return 1.f / (1.f + __expf(-v)); }

__global__ void k_zero_ctl(unsigned* p, int n) { int i = blockIdx.x * blockDim.x + threadIdx.x; if (i < n) p[i] = 0u; }
__global__ void k_cvt_bf16(const float* in, bf16* out, size_t n4) {
    size_t i = (size_t)blockIdx.x * blockDim.x + threadIdx.x; const size_t st = (size_t)gridDim.x * blockDim.x;
    for (; i < n4; i += st) { const f32x4 v = ((const f32x4*)in)[i]; unsigned long long o = (unsigned long long)pk2(v.x, v.y) | ((unsigned long long)pk2(v.z, v.w) << 32); ((unsigned long long*)out)[i] = o; }
}
__global__ void k_fold_pool(const float* wmix, const float* scale, const float* wpb, float* Wpc) {
    const int row = blockIdx.x, g = row >> 7, c = row & 127;
    __shared__ float wm[128];
    if (threadIdx.x < 128) wm[threadIdx.x] = wmix[(g * 128 + c) * 128 + threadIdx.x] * scale[g * 128 + threadIdx.x];
    __syncthreads();
    for (int n = threadIdx.x; n < 1024; n += 256) { float s = 0.f; for (int d = 0; d < 128; ++d) s += wm[d] * wpb[(size_t)(g * 128 + d) * 1024 + n]; Wpc[(size_t)row * 1024 + n] = s; }
}

template <bool DUAL, class RowF, class Epi>
__global__ void __launch_bounds__(256) k_gemm(RowF rf, Epi epi, const float* W, size_t wz, int ldw, int K, int dualoff, int pad_) {
    __shared__ float As[16][68]; __shared__ float Bs[16][64]; __shared__ float Bs2[DUAL ? 16 : 1][64];
    const int tid = threadIdx.x, ty = tid >> 4, tx = tid & 15, z = blockIdx.z;
    const int row0 = blockIdx.y * 64, col0 = blockIdx.x * 64;
    if (!rf.active(z, row0)) return;
    const float* Wz = W + (size_t)z * wz;
    float acc[4][4] = {}, acc2[4][4] = {};
    const int ar = tid >> 2, ak = (tid & 3) * 4; const bf16* arow = rf.row(z, row0 + ar);
    const int bk = tid >> 4, bc = (tid & 15) * 4;
    for (int k0 = 0; k0 < K; k0 += 16) {
        { const unsigned long long v = arow ? *(const unsigned long long*)(arow + k0 + ak) : 0ull;
          As[ak + 0][ar] = bf2f((bf16)(v & 0xffff)); As[ak + 1][ar] = bf2f((bf16)((v >> 16) & 0xffff)); As[ak + 2][ar] = bf2f((bf16)((v >> 32) & 0xffff)); As[ak + 3][ar] = bf2f((bf16)(v >> 48)); }
        { const f32x4 v = *(const f32x4*)(Wz + (size_t)(k0 + bk) * ldw + col0 + bc); Bs[bk][bc] = v.x; Bs[bk][bc + 1] = v.y; Bs[bk][bc + 2] = v.z; Bs[bk][bc + 3] = v.w;
          if (DUAL) { const f32x4 w = *(const f32x4*)(Wz + (size_t)(k0 + bk) * ldw + dualoff + col0 + bc); Bs2[bk][bc] = w.x; Bs2[bk][bc + 1] = w.y; Bs2[bk][bc + 2] = w.z; Bs2[bk][bc + 3] = w.w; } }
        __syncthreads();
#pragma unroll
        for (int k = 0; k < 16; ++k) { float a[4], b[4], b2[4];
#pragma unroll
            for (int i = 0; i < 4; ++i) { a[i] = As[k][ty * 4 + i]; b[i] = Bs[k][tx * 4 + i]; b2[i] = DUAL ? Bs2[k][tx * 4 + i] : 0.f; }
#pragma unroll
            for (int i = 0; i < 4; ++i)
#pragma unroll
                for (int j = 0; j < 4; ++j) { acc[i][j] += a[i] * b[j]; if (DUAL) acc2[i][j] += a[i] * b2[j]; } }
        __syncthreads();
    }
#pragma unroll
    for (int i = 0; i < 4; ++i)
#pragma unroll
        for (int j = 0; j < 4; ++j) epi(z, row0 + ty * 4 + i, col0 + tx * 4 + j, acc[i][j], acc2[i][j]);
}
struct RowDense { const bf16* A; int lda; int pad; __device__ bool active(int, int) const { return true; } __device__ const bf16* row(int, int r) const { return A + (size_t)r * lda; } };

struct EpiProj { bf16 *Q, *K, *V, *U, *G; const float* bg; float c2; int pad;
    __device__ void operator()(int, int r, int c, float v, float) const {
        if (c < 512) Q[(size_t)r * 512 + c] = f2b(v * c2); else if (c < 1024) K[(size_t)r * 512 + c - 512] = f2b(v); else if (c < 1536) V[(size_t)r * 512 + c - 1024] = f2b(v);
        else if (c < 2048) U[(size_t)r * 512 + c - 1536] = f2b(v); else G[(size_t)r * 2048 + c - 2048] = f2b(sigm(v + bg[c - 2048])); } };
struct EpiMixA { bf16* MIX; const bf16* G; __device__ void operator()(int, int r, int c, float v, float) const { MIX[(size_t)r * 1024 + c] = f2b(bf2f(G[(size_t)r * 2048 + c]) * v); } };
struct EpiMixB { bf16* MIX; const bf16* G; __device__ void operator()(int, int r, int c, float v, float) const { MIX[(size_t)r * 1024 + c] = f2b(bf2f(MIX[(size_t)r * 1024 + c]) + bf2f(G[(size_t)r * 2048 + 1024 + c]) * v); } };
struct EpiPre1 { float* out; const float* x; float alpha; int pad; __device__ void operator()(int, int r, int c, float v, float) const { out[(size_t)r * 1024 + c] = alpha * x[(size_t)r * 1024 + c] + v; } };
struct EpiStoreF32 { bf16* T; __device__ void operator()(int, int r, int c, float v, float) const { T[(size_t)r * 1024 + c] = f2b(v); } };
struct EpiBase { float* base; const bf16* T; float alpha; int pad; __device__ void operator()(int, int r, int c, float v, float) const { const size_t i = (size_t)r * 1024 + c; base[i] = alpha * base[i] + sigm(v) * bf2f(T[i]); } };

__global__ void __launch_bounds__(256) k_attn(const bf16* Q, const bf16* K, const bf16* V, bf16* O16) {
    __shared__ float Ks[64][64]; __shared__ float Vs[64][64];
    const int qb = blockIdx.x, vh = blockIdx.y, b = blockIdx.z, tid = threadIdx.x;
    const int hm = vh >> 1, half = vh & 1, h = hm >> 1;
    const float c2 = exp2f(-2.f * (h + 1)) * 1.4426950408889634f;
    const int i = qb * 256 + tid; const size_t rowb = (size_t)b * SEQ;
    float q[64], acc[64];
    { const bf16* qp = Q + (rowb + i) * 512 + hm * 64;
#pragma unroll
      for (int d = 0; d < 64; ++d) { q[d] = bf2f(qp[d]); acc[d] = 0.f; } }
    float m = -INFINITY, l = 0.f;
    const int ntile = (qb * 256 + 256) / 64;
    for (int t = 0; t < ntile; ++t) {
        __syncthreads();
        for (int e = tid; e < 64 * 64; e += 256) { const int j = e >> 6, d = e & 63; const size_t r = rowb + t * 64 + j;
            Ks[j][d] = bf2f(K[r * 512 + hm * 64 + d]); Vs[j][d] = bf2f(V[r * 512 + h * 128 + half * 64 + d]); }
        __syncthreads();
        for (int j = 0; j < 64; ++j) { const int jj = t * 64 + j; if (jj > i) break;
            float s = 0.f;
#pragma unroll
            for (int d = 0; d < 64; ++d) s += q[d] * Ks[j][d];
            s -= c2 * (float)(i - jj);
            if (s > m) { const float f = exp2f(m - s); l *= f;
#pragma unroll
                for (int d = 0; d < 64; ++d) acc[d] *= f;
                m = s; }
            const float p = exp2f(s - m); l += p;
#pragma unroll
            for (int d = 0; d < 64; ++d) acc[d] += p * Vs[j][d]; }
    }
    const float rl = 1.f / l; bf16* op = O16 + (rowb + i) * 1024 + h * 256 + (hm & 1) * 128 + half * 64;
#pragma unroll
    for (int d = 0; d < 64; ++d) op[d] = f2b(acc[d] * rl);
}
__device__ __forceinline__ float lam_value(const float* lq1, const float* lk1, const float* lq2, const float* lk2) {
    float a = 0.f, b = 0.f; for (int d = 0; d < 64; ++d) { a += lq1[d] * lk1[d]; b += lq2[d] * lk2[d]; } return __expf(a) - __expf(b) + 0.2f; }
__global__ void __launch_bounds__(256) k_combine(const bf16* O16, bf16* OA, const float* lq1, const float* lk1, const float* lq2, const float* lk2, const float* sg) {
    const float lam = lam_value(lq1, lk1, lq2, lk2);
    const int row = blockIdx.x * 4 + (threadIdx.x >> 6), lane = threadIdx.x & 63, h = lane >> 4, e0 = (lane & 15) * 8;
    const bf16* a = O16 + (size_t)row * 1024 + h * 256 + e0; const bf16* bb = a + 128;
    float o[8], ss = 0.f;
#pragma unroll
    for (int j = 0; j < 8; ++j) { o[j] = bf2f(a[j]) - lam * bf2f(bb[j]); ss += o[j] * o[j]; }
    ss += __shfl_xor(ss, 1); ss += __shfl_xor(ss, 2); ss += __shfl_xor(ss, 4); ss += __shfl_xor(ss, 8);
    const float r = rsqrtf(ss * (1.f / 128.f) + LN_EPS) * 0.8f;
#pragma unroll
    for (int j = 0; j < 8; ++j) OA[(size_t)row * 1024 + h * 128 + e0 + j] = f2b(o[j] * r * sg[e0 + j]);
}
__global__ void __launch_bounds__(256) k_pool(const bf16* U, bf16* PO) {
    const size_t idx = (size_t)blockIdx.x * 256 + threadIdx.x; const int c = (int)(idx & 511); const size_t row = idx >> 9; const int pos = (int)(row & (SEQ - 1));
    const int w = 2 << (c >> 7); const int n = pos + 1 < w ? pos + 1 : w; float s = 0.f;
    for (int k = 0; k < n; ++k) s += bf2f(U[(row - k) * 512 + c]);
    PO[row * 1024 + c] = f2b(s / (float)n - bf2f(U[row * 512 + c]));
}
__global__ void __launch_bounds__(256) k_ln1_route(float* X1, bf16* X1B, const float* g, const float* bta, const float* wr, const float* br, unsigned* CNT, int* LIST, float* GATE, float* GATEL) {
    __shared__ float xs[1024]; __shared__ float red[8]; __shared__ float part[8][32]; __shared__ float lg[32];
    const int row = blockIdx.x, tid = threadIdx.x, lane = tid & 63, wv = tid >> 6;
    f32x4 v = ((const f32x4*)(X1 + (size_t)row * 1024))[tid];
    float s = (v.x + v.y) + (v.z + v.w); for (int o = 1; o < 64; o <<= 1) s += __shfl_xor(s, o);
    if (lane == 0) red[wv] = s; __syncthreads(); const float mean = (red[0] + red[1] + red[2] + red[3]) * (1.f / 1024.f); __syncthreads();
    v = v - mean; float q = (v.x * v.x + v.y * v.y) + (v.z * v.z + v.w * v.w); for (int o = 1; o < 64; o <<= 1) q += __shfl_xor(q, o);
    if (lane == 0) red[wv] = q; __syncthreads(); const float rstd = rsqrtf((red[0] + red[1] + red[2] + red[3]) * (1.f / 1024.f) + LN_EPS);
    const f32x4 gg = ((const f32x4*)g)[tid], bb = ((const f32x4*)bta)[tid]; v = v * rstd * gg + bb;
    ((f32x4*)(X1 + (size_t)row * 1024))[tid] = v; ((unsigned long long*)(X1B + (size_t)row * 1024))[tid] = (unsigned long long)pk2(v.x, v.y) | ((unsigned long long)pk2(v.z, v.w) << 32);
    xs[tid * 4] = v.x; xs[tid * 4 + 1] = v.y; xs[tid * 4 + 2] = v.z; xs[tid * 4 + 3] = v.w; __syncthreads();
    { const int e = tid & 31, pt = tid >> 5; float a = 0.f; for (int k = pt * 128; k < pt * 128 + 128; ++k) a += xs[k] * wr[k * 32 + e]; part[pt][e] = a; }
    __syncthreads();
    if (tid < 32) { float a = br[tid]; for (int pt = 0; pt < 8; ++pt) a += part[pt][tid]; lg[tid] = a; }
    __syncthreads();
    if (tid == 0) { int id[4]; float vv[4]; unsigned used = 0u;
        for (int k = 0; k < 4; ++k) { int bi = 0; float bv = -INFINITY; for (int e = 0; e < 32; ++e) if (!((used >> e) & 1u) && lg[e] > bv) { bv = lg[e]; bi = e; } used |= 1u << bi; id[k] = bi; vv[k] = bv; }
        float es[4], sum = 0.f; for (int k = 0; k < 4; ++k) { es[k] = __expf(vv[k] - vv[0]); sum += es[k]; }
        for (int k = 0; k < 4; ++k) { const unsigned pos = atomicAdd(&CNT[id[k]], 1u); LIST[(size_t)id[k] * 65536 + pos] = row * 4 + k; GATEL[(size_t)id[k] * 65536 + pos] = es[k] / sum; GATE[row * 4 + k] = es[k] / sum; } }
}
struct RowGather { const bf16* X1B; const int* LIST; const unsigned* CNT;
    __device__ bool active(int e, int row0) const { return (unsigned)row0 < CNT[e]; }
    __device__ const bf16* row(int e, int r) const { return (unsigned)r < CNT[e] ? X1B + (size_t)(LIST[(size_t)e * 65536 + r] >> 2) * 1024 : nullptr; } };
__device__ __forceinline__ unsigned slot_off(const unsigned* CNT, int e) { unsigned o = 0; for (int i = 0; i < e; ++i) o += CNT[i]; return o; }
struct EpiUp { bf16* HB; const float* bup; const unsigned* CNT;
    __device__ void operator()(int e, int r, int c, float glu, float lin) const { if ((unsigned)r >= CNT[e]) return;
        glu += bup[e * 2048 + c]; lin += bup[e * 2048 + 1024 + c]; glu = fminf(glu, 7.f); lin = fminf(fmaxf(lin, -7.f), 7.f);
        HB[(size_t)(slot_off(CNT, e) + r) * 1024 + c] = f2b(glu * sigm(1.702f * glu) * (lin + 1.f)); } };
struct RowSlots { const bf16* HB; const unsigned* CNT;
    __device__ bool active(int e, int row0) const { return (unsigned)row0 < CNT[e]; }
    __device__ const bf16* row(int e, int r) const { return (unsigned)r < CNT[e] ? HB + (size_t)(slot_off(CNT, e) + r) * 1024 : nullptr; } };
struct EpiDown { float* base; bf16* YS1; bf16* YS2; bf16* YS3; const float* bdn; const int* LIST; const float* GATE; const unsigned* CNT;
    __device__ void operator()(int e, int r, int c, float v, float) const { if ((unsigned)r >= CNT[e]) return;
        const int a = LIST[(size_t)e * 65536 + r], tok = a >> 2, k = a & 3; const float y = (v + bdn[e * 1024 + c]) * GATE[a]; const size_t i = (size_t)tok * 1024 + c;
        if (k == 0) base[i] += y; else if (k == 1) YS1[i] = f2b(y); else if (k == 2) YS2[i] = f2b(y); else YS3[i] = f2b(y); } };
__global__ void __launch_bounds__(256) k_final(float* out, const bf16* YS1, const bf16* YS2, const bf16* YS3, const float* g, const float* bta) {
    __shared__ float red[8]; const int row = blockIdx.x, tid = threadIdx.x, lane = tid & 63, wv = tid >> 6; const size_t i0 = (size_t)row * 1024 + tid * 4;
    f32x4 v = *(const f32x4*)(out + i0);
    const bf16* ys[3] = {YS1, YS2, YS3};
    for (int k = 0; k < 3; ++k) { const unsigned long long w = *(const unsigned long long*)(ys[k] + i0); v.x += bf2f((bf16)(w & 0xffff)); v.y += bf2f((bf16)((w >> 16) & 0xffff)); v.z += bf2f((bf16)((w >> 32) & 0xffff)); v.w += bf2f((bf16)(w >> 48)); }
    float s = (v.x + v.y) + (v.z + v.w); for (int o = 1; o < 64; o <<= 1) s += __shfl_xor(s, o);
    if (lane == 0) red[wv] = s; __syncthreads(); const float mean = (red[0] + red[1] + red[2] + red[3]) * (1.f / 1024.f); __syncthreads();
    v = v - mean; float q = (v.x * v.x + v.y * v.y) + (v.z * v.z + v.w * v.w); for (int o = 1; o < 64; o <<= 1) q += __shfl_xor(q, o);
    if (lane == 0) red[wv] = q; __syncthreads(); const float rstd = rsqrtf((red[0] + red[1] + red[2] + red[3]) * (1.f / 1024.f) + LN_EPS);
    const f32x4 gg = ((const f32x4*)g)[tid], bb = ((const f32x4*)bta)[tid]; *(f32x4*)(out + i0) = v * rstd * gg + bb;
}
}
namespace pg8 {
#define PG8_LAS __attribute__((address_space(3)))
typedef unsigned short bf16_t;
typedef unsigned u32x4 __attribute__((ext_vector_type(4)));
typedef float f32x2 __attribute__((ext_vector_type(2)));
constexpr int BM = 256, BK = 64, HALF = 128, HTB = HALF * BK * 2  , STAGE_BYTES = 8 * HTB, NXCD = 8, WGM = 8;
constexpr int TAB_OFF = 131072 + 1024;
constexpr int TAB_CNT = TAB_OFF, TAB_BLK0 = TAB_OFF + 128, TAB_ROW0 = TAB_OFF + 384, TAB_IDS = TAB_OFF + 1024, TAB_GATES = TAB_OFF + 1024 + 2048;

__host__ __device__ __forceinline__ int lds_byte(int r, int c) { const int st = (r >> 4) * 2 + (c >> 5), rr = r & 15, cc = c & 31, ob = rr * 64 + cc * 2; return st * 1024 + (ob ^ (((ob >> 9) & 1) << 5)); }
__host__ __device__ __forceinline__ void stage_rc(int b, int& R, int& C) { const int st = b / 1024, sb = b % 1024, swz = sb ^ (((sb >> 9) & 1) << 5); R = (st >> 1) * 16 + swz / 64; C = (st & 1) * 32 + (swz % 64) / 2; }
__host__ __device__ __forceinline__ int perm32(int rho) { const int n = rho >> 4, i = rho & 15; return 8 * (i >> 2) + 4 * n + (i & 3); }

struct Unit { int pm, pn, e, nvalid; };
struct Gemm { const bf16_t* A; const bf16_t* Bt; int K; };

struct StaticOrder {
    static constexpr bool TABLES = false, FP8 = false;
    int nM, nN, nwg, G, c;
    __host__ __device__ void init(int M, int N, int G_, int c_) { nM = M / BM; nN = N / BM; nwg = nM * nN; G = G_; c = c_; }
    __device__ __forceinline__ bool next(int i, Unit& u, PG8_LAS unsigned char*) const {
        const long L = (long)i * G + c; if (L >= nwg) return false;
        int wgid = (int)L; { const int q = nwg / NXCD, r = nwg % NXCD, xcd = wgid % NXCD, off = wgid / NXCD; wgid = (xcd < r ? xcd * (q + 1) : r * (q + 1) + (xcd - r) * q) + off; }
        const int nig = WGM * nN, gid = wgid / nig, fm = gid * WGM, gsz = (nM - fm) < WGM ? (nM - fm) : WGM;
        u.pm = fm + ((wgid % nig) % gsz); u.pn = (wgid % nig) / gsz; u.e = 0; u.nvalid = 256; return true;
    }
    __device__ __forceinline__ const char* b_tile(const Gemm& g, const Unit& u) const { return (const char*)g.Bt + (size_t)u.pn * (size_t)(BM * 2) * g.K; }
    __device__ __forceinline__ void a_offsets(const Gemm& g, const Unit& u, PG8_LAS unsigned char*, int, const int (&R)[2], const int (&C)[2], unsigned (&off)[2][2]) const {
#pragma unroll
        for (int h = 0; h < 2; ++h)
#pragma unroll
            for (int i = 0; i < 2; ++i) off[h][i] = (unsigned)(((u.pm * BM + h * HALF + R[i]) * g.K + C[i]) * 2);
    }
    __device__ __forceinline__ void issue_tables(const Unit&, PG8_LAS unsigned char*, int, int) const {}
};

struct DenseF8Order : StaticOrder { static constexpr bool FP8 = true; };

template <bool GATHER_, bool FP8_> struct MoeOrder {
    static constexpr bool TABLES = true; static constexpr bool GATHER = GATHER_, FP8 = FP8_;
    int NT, G, c; const int* LIST; const float* GATEL; size_t bstride;
    __device__ __forceinline__ bool next(int i, Unit& u, PG8_LAS unsigned char* lds) const {
        const PG8_LAS int* cnt = (const PG8_LAS int*)(lds + TAB_CNT); const PG8_LAS int* blk0 = (const PG8_LAS int*)(lds + TAB_BLK0);
        int cp = c; if (G == 256) cp = NT == 8 ? (((c & 7) + 8 * (c >> 6)) * 8 + ((c >> 3) & 7)) : (((c & 7) + 8 * (c >> 5)) * 4 + ((c >> 3) & 3));
        const int L = i * G + cp; const int total = blk0[32] * NT; if (L >= total) return false;
        const int blk = L / NT; int e = 0;
#pragma unroll 1
        for (int j = 1; j < 32; ++j) e += (blk >= blk0[j]) ? 1 : 0;
        e = __builtin_amdgcn_readfirstlane(e);
        u.e = e; u.pm = __builtin_amdgcn_readfirstlane(blk - blk0[e]); u.pn = L % NT; const int left = __builtin_amdgcn_readfirstlane(cnt[e]) - 256 * u.pm; u.nvalid = left < 256 ? left : 256; return true;
    }
    __device__ __forceinline__ const char* b_tile(const Gemm& g, const Unit& u) const { return (const char*)g.Bt + (size_t)u.e * bstride + (size_t)u.pn * (size_t)(BM * 2) * g.K; }
    __device__ __forceinline__ void a_offsets(const Gemm& g, const Unit& u, PG8_LAS unsigned char* lds, int buf, const int (&R)[2], const int (&C)[2], unsigned (&off)[2][2]) const {
        const PG8_LAS int* ids = (const PG8_LAS int*)(lds + TAB_IDS) + buf * 256; const PG8_LAS int* row0 = (const PG8_LAS int*)(lds + TAB_ROW0);
#pragma unroll
        for (int h = 0; h < 2; ++h)
#pragma unroll
            for (int i = 0; i < 2; ++i) { const int r = h * HALF + R[i];
                if (GATHER) { const int tok = (r < u.nvalid) ? (ids[r] >> 2) : 0; off[h][i] = (unsigned)((tok * g.K + C[i]) * 2); }
                else off[h][i] = (unsigned)(((row0[u.e] + u.pm * BM + r) * g.K + C[i]) * 2); }
    }
    __device__ __forceinline__ void issue_tables(const Unit& u, PG8_LAS unsigned char* lds, int buf, int lane) const {
        const size_t o = (size_t)u.e * 65536 + (size_t)u.pm * 256 + lane * 4;
        __builtin_amdgcn_global_load_lds((const unsigned*)(LIST + o), (PG8_LAS unsigned*)(lds + TAB_IDS + buf * 1024), 16, 0, 0);
        if (!GATHER) __builtin_amdgcn_global_load_lds((const unsigned*)(GATEL + o), (PG8_LAS unsigned*)(lds + TAB_GATES + buf * 1024), 16, 0, 0);
    }
};

__device__ __forceinline__ unsigned cvt_pk_bf16(float lo, float hi) { unsigned r; asm volatile("v_cvt_pk_bf16_f32 %0, %1, %2" : "=v"(r) : "v"(lo), "v"(hi)); return r; }
__device__ __forceinline__ float bflo(unsigned w) { return __builtin_bit_cast(float, w << 16); }
__device__ __forceinline__ float bfhi(unsigned w) { return __builtin_bit_cast(float, w & 0xffff0000u); }
__device__ __forceinline__ float sigm(float v) { return __builtin_amdgcn_rcpf(1.f + __builtin_amdgcn_exp2f(-1.4426950408889634f * v)); }
__device__ __forceinline__ u32x4 pack8(const f32x4& v0, const f32x4& v1) { u32x4 w; w.x = cvt_pk_bf16(v0[0], v0[1]); w.y = cvt_pk_bf16(v0[2], v0[3]); w.z = cvt_pk_bf16(v1[0], v1[1]); w.w = cvt_pk_bf16(v1[2], v1[3]); return w; }
__device__ __forceinline__ void unpack8(const u32x4& w, f32x4& v0, f32x4& v1) { v0 = (f32x4){bflo(w.x), bfhi(w.x), bflo(w.y), bfhi(w.y)}; v1 = (f32x4){bflo(w.z), bfhi(w.z), bflo(w.w), bfhi(w.w)}; }
typedef f32x4 Acc[2][2][4][2];
typedef int i32x4 __attribute__((ext_vector_type(4)));
typedef int i32x8 __attribute__((ext_vector_type(8)));
struct bf16x8p { bf16x8 k[2]; };
template <bool F8> struct Frag { typedef bf16x8p T; };
template <> struct Frag<true> { typedef i32x8 T; };
__device__ __forceinline__ void frag_set(i32x8& d, const i32x4& lo, const i32x4& hi) { d = __builtin_shufflevector(lo, hi, 0, 1, 2, 3, 4, 5, 6, 7); }
__device__ __forceinline__ void frag_set(bf16x8p& d, const bf16x8& lo, const bf16x8& hi) { d.k[0] = lo; d.k[1] = hi; }
__device__ __forceinline__ void frag_mma(f32x4& c, const i32x8& b, const i32x8& a) { c = __builtin_amdgcn_mfma_scale_f32_16x16x128_f8f6f4(b, a, c, 0, 0, 0, 0, 0, 0); }
__device__ __forceinline__ void frag_mma(f32x4& c, const bf16x8p& b, const bf16x8p& a) { c = __builtin_amdgcn_mfma_f32_16x16x32_bf16(b.k[0], a.k[0], c, 0, 0, 0); c = __builtin_amdgcn_mfma_f32_16x16x32_bf16(b.k[1], a.k[1], c, 0, 0, 0); }
__device__ __forceinline__ unsigned pk4_fp8(float a, float b, float c, float d) { unsigned w = __builtin_amdgcn_cvt_pk_fp8_f32(a, b, 0u, false); return __builtin_amdgcn_cvt_pk_fp8_f32(c, d, w, true); }
template <class E> struct has_mid { template <class T> static constexpr bool f(decltype(T::MID)*) { return T::MID; } template <class T> static constexpr bool f(...) { return false; } static constexpr bool value = f<E>(nullptr); };

struct EpiProj {
    static constexpr bool PERM = true;
    bf16_t *Q, *K, *V, *U, *G; const float* bg; float* PN; float c2; float dsc; int pn_base; int pad;
    __device__ __forceinline__ void operator()(const Acc& acc, const Unit& u, int wr, int wc, int fr_, int fq_, PG8_LAS unsigned char*, int) const {
        int fr = fr_, fq = fq_; asm volatile("" : "+v"(fr), "+v"(fq));
        const int pn = u.pn + pn_base; const int row0 = u.pm * BM + wr * 64 + fr; const bool isg = pn >= 8;
        bf16_t* base; int ldc, colt; float sc = dsc;
        if (isg) { base = G; ldc = 2048; colt = (pn - 8) * BM; } else { const int t = pn >> 1; base = t == 0 ? Q : t == 1 ? K : t == 2 ? V : U; ldc = 512; colt = (pn & 1) * BM; if (t == 0) sc = c2 * dsc; }
        const int col0 = colt + wc * 32 + 8 * fq;
        f32x4 bv[2][2];
#pragma unroll
        for (int bj = 0; bj < 2; ++bj)
#pragma unroll
            for (int n = 0; n < 2; ++n) bv[bj][n] = isg ? *(const f32x4*)(bg + col0 + bj * HALF + 4 * n) : (f32x4){0.f, 0.f, 0.f, 0.f};
#pragma unroll
        for (int ai = 0; ai < 2; ++ai)
#pragma unroll
            for (int m = 0; m < 4; ++m) { bf16_t* rowp = base + (size_t)(row0 + ai * HALF + m * 16) * ldc + col0;
#pragma unroll
                for (int bj = 0; bj < 2; ++bj) { f32x4 v0 = acc[ai][bj][m][0] * sc + bv[bj][0], v1 = acc[ai][bj][m][1] * sc + bv[bj][1];
                    if (isg) {
#pragma unroll
                        for (int i = 0; i < 4; ++i) { v0[i] = sigm(v0[i]); v1[i] = sigm(v1[i]); } }
                    *(u32x4*)(rowp + bj * HALF) = pack8(v0, v1); } }
        if (pn < 4) {
            float* tab = PN + (pn >> 1) * 16384; const int R0 = u.pm * BM, b = R0 >> 12;
#pragma unroll
            for (int ai = 0; ai < 2; ++ai)
#pragma unroll
                for (int bj = 0; bj < 2; ++bj) { float mx = 0.f;
#pragma unroll
                    for (int m = 0; m < 4; ++m) { f32x4 v0 = acc[ai][bj][m][0] * sc, v1 = acc[ai][bj][m][1] * sc;
                        float s = (v0[0] * v0[0] + v0[1] * v0[1]) + (v0[2] * v0[2] + v0[3] * v0[3]) + (v1[0] * v1[0] + v1[1] * v1[1]) + (v1[2] * v1[2] + v1[3] * v1[3]);
                        s += __shfl_xor(s, 16); s += __shfl_xor(s, 32); mx = fmaxf(mx, s); }
                    mx = fmaxf(mx, __shfl_xor(mx, 1)); mx = fmaxf(mx, __shfl_xor(mx, 2)); mx = fmaxf(mx, __shfl_xor(mx, 4)); mx = fmaxf(mx, __shfl_xor(mx, 8));
                    const int tile = ((R0 & 4095) >> 6) + 2 * ai + wr, hm = (pn & 1) * 4 + 2 * bj + (wc >> 1);
                    if (fr == 0 && fq == 0) tab[((b * 8 + hm) * 64 + tile) * 2 + (wc & 1)] = mx; }
        }
    }
};
struct EpiMixCat {
    static constexpr bool PERM = true, MID = true;
    bf16_t* MIX; const bf16_t* G;
    __device__ __forceinline__ void mid(Acc& acc, const Unit& u, int wr, int wc, int fr_, int fq_) const {
        int fr = fr_, fq = fq_; asm volatile("" : "+v"(fr), "+v"(fq));
        const int row0 = u.pm * BM + wr * 64 + fr, col0 = u.pn * BM + wc * 32 + 8 * fq;
#pragma unroll
        for (int ai = 0; ai < 2; ++ai)
#pragma unroll
            for (int m = 0; m < 4; ++m) { const size_t r = (size_t)(row0 + ai * HALF + m * 16);
#pragma unroll
                for (int bj = 0; bj < 2; ++bj) { const int c = col0 + bj * HALF;
                    const u32x4 aw = *(const u32x4*)(G + r * 2048 + c), pw = *(const u32x4*)(G + r * 2048 + 1024 + c); f32x4 a0, a1, p0, p1; unpack8(aw, a0, a1); unpack8(pw, p0, p1);
#pragma unroll
                    for (int i = 0; i < 4; ++i) { acc[ai][bj][m][0][i] *= a0[i] * __builtin_amdgcn_rcpf(fmaxf(p0[i], 8.67e-19f)); acc[ai][bj][m][1][i] *= a1[i] * __builtin_amdgcn_rcpf(fmaxf(p1[i], 8.67e-19f)); }
                    asm volatile("" : "+v"(acc[ai][bj][m][0]), "+v"(acc[ai][bj][m][1]) :: "memory"); } }
    }
    __device__ __forceinline__ void operator()(const Acc& acc, const Unit& u, int wr, int wc, int fr_, int fq_, PG8_LAS unsigned char*, int) const {
        int fr = fr_, fq = fq_; asm volatile("" : "+v"(fr), "+v"(fq));
        const int row0 = u.pm * BM + wr * 64 + fr, col0 = u.pn * BM + wc * 32 + 8 * fq;
#pragma unroll
        for (int ai = 0; ai < 2; ++ai)
#pragma unroll
            for (int m = 0; m < 4; ++m) { const size_t r = (size_t)(row0 + ai * HALF + m * 16);
#pragma unroll
                for (int bj = 0; bj < 2; ++bj) { const int c = col0 + bj * HALF;
                    const u32x4 pw = *(const u32x4*)(G + r * 2048 + 1024 + c); f32x4 p0, p1; unpack8(pw, p0, p1);
#pragma unroll
                    for (int i = 0; i < 4; ++i) { p0[i] = fmaxf(p0[i], 8.67e-19f); p1[i] = fmaxf(p1[i], 8.67e-19f); }
                    *(u32x4*)(MIX + r * 1024 + c) = pack8(acc[ai][bj][m][0] * p0, acc[ai][bj][m][1] * p1); }
                asm volatile("" ::: "memory"); }
    }
};
template <int MODE> struct EpiF32 {
    static constexpr bool PERM = false;
    float* out; const float* aux; float alpha; float dsc;
    __device__ __forceinline__ void operator()(const Acc& acc, const Unit& u, int wr, int wc, int fr_, int fq_, PG8_LAS unsigned char*, int) const {
        int fr = fr_, fq = fq_; asm volatile("" : "+v"(fr), "+v"(fq));
        const int col0 = u.pn * BM + wc * 32 + 4 * fq;
#pragma unroll
        for (int ai = 0; ai < 2; ++ai)
#pragma unroll
            for (int m = 0; m < 4; ++m) { const size_t off = (size_t)(u.pm * BM + ai * HALF + wr * 64 + m * 16 + fr) * 1024 + col0;
#pragma unroll
                for (int bj = 0; bj < 2; ++bj) {
#pragma unroll
                    for (int n = 0; n < 2; ++n) { const size_t o = off + bj * HALF + n * 16; const f32x4 a = acc[ai][bj][m][n]; f32x4 r;
                        if (MODE == 1) { f32x2 w; unsigned* wp = (unsigned*)&w; wp[0] = cvt_pk_bf16(a[0], a[1]); wp[1] = cvt_pk_bf16(a[2], a[3]); *(f32x2*)((bf16_t*)out + o) = w; continue; }
                        if (MODE == 0) r = *(const f32x4*)(aux + o) * alpha + a;
                        else if (MODE == 3) { const f32x2 tw = *(const f32x2*)((const bf16_t*)aux + o); const unsigned* tp = (const unsigned*)&tw; f32x2 w; unsigned* wp = (unsigned*)&w;
                            wp[0] = cvt_pk_bf16(sigm(a[0] * dsc) * bflo(tp[0]), sigm(a[1] * dsc) * bfhi(tp[0])); wp[1] = cvt_pk_bf16(sigm(a[2] * dsc) * bflo(tp[1]), sigm(a[3] * dsc) * bfhi(tp[1])); *(f32x2*)((bf16_t*)out + o) = w; continue; }
                        else { const f32x2 tw = *(const f32x2*)((const bf16_t*)aux + o); const unsigned* tp = (const unsigned*)&tw; const f32x4 t = {bflo(tp[0]), bfhi(tp[0]), bflo(tp[1]), bfhi(tp[1])}; const f32x4 b = *(const f32x4*)(out + o); r = b * alpha;
#pragma unroll
                            for (int i = 0; i < 4; ++i) r[i] += sigm(a[i] * dsc) * t[i]; }
                        *(f32x4*)(out + o) = r; }
                  if (MODE == 2) asm volatile("" ::: "memory"); }
                if (m & 1) asm volatile("" ::: "memory"); }
    }
};
template <bool F8> struct EpiUp {
    static constexpr bool PERM = true;
    void* HB; const float* bup; float dsc; int pad;
    __device__ __forceinline__ void operator()(const Acc& acc, const Unit& u, int wr, int wc, int fr_, int fq_, PG8_LAS unsigned char* lds, int) const {
        int fr = fr_, fq = fq_; asm volatile("" : "+v"(fr), "+v"(fq));
        const PG8_LAS int* row0t = (const PG8_LAS int*)(lds + TAB_ROW0); const int srow = row0t[u.e] + u.pm * BM;
        const int c0 = u.pn * HALF + wc * 32 + 8 * fq; const float* bp = bup + (size_t)u.e * 2048 + c0;
        const f32x4 bg0 = *(const f32x4*)(bp), bg1 = *(const f32x4*)(bp + 4), bl0 = *(const f32x4*)(bp + 1024), bl1 = *(const f32x4*)(bp + 1028);
#pragma unroll
        for (int ai = 0; ai < 2; ++ai)
#pragma unroll
            for (int m = 0; m < 4; ++m) { const int r = ai * HALF + wr * 64 + m * 16 + fr;
                f32x4 g0 = acc[ai][0][m][0] * dsc + bg0, g1 = acc[ai][0][m][1] * dsc + bg1, l0 = acc[ai][1][m][0] * dsc + bl0, l1 = acc[ai][1][m][1] * dsc + bl1;
#pragma unroll
                for (int i = 0; i < 4; ++i) { float a = fminf(g0[i], 7.f), b = fminf(fmaxf(l0[i], -7.f), 7.f); g0[i] = a * sigm(1.702f * a) * (b + 1.f);
                                              a = fminf(g1[i], 7.f); b = fminf(fmaxf(l1[i], -7.f), 7.f); g1[i] = a * sigm(1.702f * a) * (b + 1.f); }
                if (r < u.nvalid) {
                    if (F8) { f32x2 w; unsigned* wp = (unsigned*)&w; wp[0] = pk4_fp8(g0[0], g0[1], g0[2], g0[3]); wp[1] = pk4_fp8(g1[0], g1[1], g1[2], g1[3]); *(f32x2*)((unsigned char*)HB + (size_t)(srow + r) * 1024 + c0) = w; }
                    else *(u32x4*)((bf16_t*)HB + (size_t)(srow + r) * 1024 + c0) = pack8(g0, g1); } }
    }
};
struct EpiDown {
    static constexpr bool PERM = true;
    unsigned char* YS0; unsigned char* YS1; unsigned char* YS2; unsigned char* YS3; const float* bdn; float dsc; float osc;
    __device__ __forceinline__ void operator()(const Acc& acc, const Unit& u, int wr, int wc, int fr_, int fq_, PG8_LAS unsigned char* lds, int buf) const {
        int fr = fr_, fq = fq_; asm volatile("" : "+v"(fr), "+v"(fq));
        const PG8_LAS int* ids = (const PG8_LAS int*)(lds + TAB_IDS) + buf * 256; const PG8_LAS float* gates = (const PG8_LAS float*)(lds + TAB_GATES) + buf * 256;
        const int col0 = u.pn * BM + wc * 32 + 8 * fq; const float* bp = bdn + (size_t)u.e * 1024 + col0;
        f32x4 bv[2][2];
#pragma unroll
        for (int bj = 0; bj < 2; ++bj)
#pragma unroll
            for (int n = 0; n < 2; ++n) bv[bj][n] = *(const f32x4*)(bp + bj * HALF + 4 * n);
#pragma unroll
        for (int ai = 0; ai < 2; ++ai)
#pragma unroll
            for (int m = 0; m < 4; ++m) { const int r = ai * HALF + wr * 64 + m * 16 + fr;
                if (r < u.nvalid) { const int a = ids[r]; const float gt = gates[r]; const int k = a & 3; const size_t o = (size_t)(a >> 2) * 1024 + col0;
#pragma unroll
                    for (int bj = 0; bj < 2; ++bj) { const float gs = gt * osc; const f32x4 v0 = (acc[ai][bj][m][0] * dsc + bv[bj][0]) * gs, v1 = (acc[ai][bj][m][1] * dsc + bv[bj][1]) * gs; const size_t oo = o + bj * HALF;
                        unsigned char* yp = k == 0 ? YS0 : k == 1 ? YS1 : k == 2 ? YS2 : YS3; f32x2 w; unsigned* wp = (unsigned*)&w; wp[0] = pk4_fp8(v0[0], v0[1], v0[2], v0[3]); wp[1] = pk4_fp8(v1[0], v1[1], v1[2], v1[3]); *(f32x2*)(yp + oo) = w; } } }
    }
};

template <class Epi, class Sched>
__device__ __forceinline__ void gemm_phase(PG8_LAS unsigned char* lds, const int wid, const Gemm g, const Sched& S, const Epi& E) {
    int lane = lane_id(); asm volatile("" : "+v"(lane));
    const int tid = wid * 64 + lane, wr = wid >> 2, wc = wid & 3, fr = lane & 15, fq = lane >> 4;
    const int K = g.K, nt = K / BK;
    int RA[2], CA[2]; unsigned voffA[2], voffB[2];
#pragma unroll
    for (int i = 0; i < 2; ++i) { int R, C; stage_rc(tid * 16 + i * 8192, R, C); const int Rb = Epi::PERM ? ((R & ~31) + perm32(R & 31)) : R; RA[i] = R; CA[i] = C; voffA[i] = (unsigned)(R * K + C) * 2u; voffB[i] = (unsigned)(Rb * K + C) * 2u; }
    const size_t tstep = (size_t)BM * K * 2;
    const size_t kstep = (size_t)(BK * 2);
    const size_t hstep = (size_t)HALF * K * 2;
    const unsigned ldsw = (unsigned)wid * 1024u;
    const int aoff = lds_byte(wr * 64 + fr, fq * 8), boff = lds_byte(wc * 32 + fr, fq * 8);
#define PG8_SA(b, h) (((b) * 2 + (h)) * HTB)
#define PG8_SB(b, h) ((4 + (b) * 2 + (h)) * HTB)
#define PG8_STAGE(bufoff, gbase, voff) do { _Pragma("unroll") for (int _i = 0; _i < 2; ++_i) \
        __builtin_amdgcn_global_load_lds((const unsigned*)((const char*)(gbase) + (voff)[_i]), (PG8_LAS unsigned*)(lds + (bufoff) + ldsw + _i * 8192), 16, 0, 0); } while (0)
#define PG8_STAGE_A(bufoff, ubase, h, OFF) do { if constexpr (Sched::TABLES) PG8_STAGE(bufoff, ubase, OFF[h]); else PG8_STAGE(bufoff, (ubase) + ((h) ? hstep : 0), voffA); } while (0)
#define PG8_LDA(dst, b, h) do { _Pragma("unroll") for (int m = 0; m < 4; ++m) { if constexpr (Sched::FP8) dst##8[m] = __builtin_shufflevector(*(const PG8_LAS i32x4*)(lds + PG8_SA(b, h) + aoff + m * 2048), *(const PG8_LAS i32x4*)(lds + PG8_SA(b, h) + aoff + m * 2048 + 1024), 0, 1, 2, 3, 4, 5, 6, 7); \
        else { _Pragma("unroll") for (int k = 0; k < 2; ++k) dst[m][k] = *(const PG8_LAS bf16x8*)(lds + PG8_SA(b, h) + aoff + m * 2048 + k * 1024); } } } while (0)
#define PG8_LDB(dst, b, h) do { _Pragma("unroll") for (int n = 0; n < 2; ++n) { if constexpr (Sched::FP8) dst##8[n] = __builtin_shufflevector(*(const PG8_LAS i32x4*)(lds + PG8_SB(b, h) + boff + n * 2048), *(const PG8_LAS i32x4*)(lds + PG8_SB(b, h) + boff + n * 2048 + 1024), 0, 1, 2, 3, 4, 5, 6, 7); \
        else { _Pragma("unroll") for (int k = 0; k < 2; ++k) dst[n][k] = *(const PG8_LAS bf16x8*)(lds + PG8_SB(b, h) + boff + n * 2048 + k * 1024); } } } while (0)
#define PG8_MMA(ai, bj, At, Bt) do { __builtin_amdgcn_s_setprio(1); if constexpr (Sched::FP8) asm volatile("s_nop 1"); _Pragma("unroll") for (int m = 0; m < 4; ++m) _Pragma("unroll") for (int n = 0; n < 2; ++n) { \
        if constexpr (Sched::FP8) asm volatile("v_mfma_f32_16x16x128_f8f6f4 %0, %1, %2, %0" : "+v"(acc[ai][bj][m][n]) : "v"(Bt##8[n]), "v"(At##8[m]));   \
        else { _Pragma("unroll") for (int k = 0; k < 2; ++k) acc[ai][bj][m][n] = __builtin_amdgcn_mfma_f32_16x16x32_bf16(Bt[n][k], At[m][k], acc[ai][bj][m][n], 0, 0, 0); } } __builtin_amdgcn_s_setprio(0); } while (0)
#define PG8_WAIT_V(n) asm volatile("s_waitcnt vmcnt(" #n ")" ::: "memory")
#define PG8_WAIT_L(n) asm volatile("s_waitcnt lgkmcnt(" #n ")" ::: "memory")
#define PG8_BAR __builtin_amdgcn_s_barrier()
#define PG8_SCHED __builtin_amdgcn_sched_barrier(0)
    Unit cur, nxt; int ui = 0;
    if (!S.next(0, cur, lds)) return;
    if constexpr (Sched::TABLES) {
        if (wid == 0) S.issue_tables(cur, lds, 0, lane);
        PG8_WAIT_V(0); PG8_BAR;
    }
    Acc acc;
#pragma unroll
    for (int a = 0; a < 2; ++a)
#pragma unroll
        for (int b = 0; b < 2; ++b)
#pragma unroll
            for (int m = 0; m < 4; ++m)
#pragma unroll
                for (int n = 0; n < 2; ++n) acc[a][b][m][n] = (f32x4){0.f, 0.f, 0.f, 0.f};
    bf16x8 At[4][2], B0[2][2], B1[2][2];
    i32x8 At8[4], B08[2], B18[2];
    unsigned offc[2][2], offn[2][2];
    if constexpr (Sched::TABLES) { S.a_offsets(g, cur, lds, 0, RA, CA, offc);
#pragma unroll
        for (int h = 0; h < 2; ++h)
#pragma unroll
            for (int i = 0; i < 2; ++i) offn[h][i] = offc[h][i]; }
    const char* const Ab = (const char*)g.A;
    const char* cA = Sched::TABLES ? Ab : Ab + (size_t)cur.pm * tstep;
    const char* cB = S.b_tile(g, cur);
    PG8_STAGE(PG8_SB(0, 0), cB, voffB); PG8_STAGE(PG8_SB(0, 1), cB + hstep, voffB); PG8_STAGE_A(PG8_SA(0, 0), cA, 0, offc); PG8_STAGE_A(PG8_SA(0, 1), cA, 1, offc);
    if (wr == 1) PG8_BAR;
    PG8_WAIT_V(2); PG8_BAR;
    PG8_STAGE(PG8_SB(1, 0), cB + kstep, voffB); PG8_STAGE_A(PG8_SA(1, 0), cA + kstep, 0, offc); PG8_STAGE(PG8_SB(1, 1), cB + hstep + kstep, voffB);
    PG8_WAIT_V(6); PG8_BAR;
    for (;;) {
        const bool has_next = S.next(ui + 1, nxt, lds);
        const char* nB = has_next ? S.b_tile(g, nxt) : cB;
        const char* nA = Sched::TABLES ? Ab : (has_next ? Ab + (size_t)nxt.pm * tstep : cA);
#pragma nounroll
        for (int t = 0; t < nt; t += 2) {
            const bool last = (t == nt - 2);
            if constexpr (has_mid<Epi>::value) { if (t == nt / 2) E.mid(acc, cur, wr, wc, fr, fq); }
            if constexpr (Sched::TABLES) {
                if (t == 2 && has_next && wid == 0) S.issue_tables(nxt, lds, (ui + 1) & 1, lane);
                if (t == (nt >= 16 ? nt - 6 : nt - 2) && has_next) S.a_offsets(g, nxt, lds, (ui + 1) & 1, RA, CA, offn);
            }
            unsigned o2[2][2];
            if constexpr (Sched::TABLES) {
#pragma unroll
                for (int h = 0; h < 2; ++h)
#pragma unroll
                    for (int i = 0; i < 2; ++i) o2[h][i] = last ? offn[h][i] : offc[h][i]; }
            const char* a1 = cA + (size_t)(t + 1) * kstep;
            const char* a2 = last ? nA : cA + (size_t)(t + 2) * kstep; const char* b2 = last ? nB : cB + (size_t)(t + 2) * kstep;
            const char* a3 = a2 + kstep; const char* b3 = b2 + kstep;
            PG8_LDB(B0, 0, 0); PG8_LDB(B1, 0, 1); PG8_SCHED; PG8_LDA(At, 0, 0); PG8_STAGE_A(PG8_SA(1, 1), a1, 1, offc);
            PG8_WAIT_V(8); PG8_WAIT_L(0); PG8_BAR; PG8_MMA(0, 0, At, B0); PG8_MMA(0, 1, At, B1); PG8_BAR; PG8_SCHED;
            PG8_LDA(At, 0, 1); PG8_STAGE(PG8_SB(0, 0), b2, voffB); PG8_STAGE(PG8_SB(0, 1), b2 + hstep, voffB); PG8_STAGE_A(PG8_SA(0, 0), a2, 0, o2);
            PG8_WAIT_V(8); PG8_WAIT_L(0); PG8_BAR; PG8_MMA(1, 0, At, B0); PG8_MMA(1, 1, At, B1); PG8_BAR; PG8_SCHED;
            PG8_LDB(B0, 1, 0); PG8_LDB(B1, 1, 1); PG8_SCHED; PG8_LDA(At, 1, 0); PG8_STAGE_A(PG8_SA(0, 1), a2, 1, o2);
            PG8_WAIT_V(8); PG8_WAIT_L(0); PG8_BAR; PG8_MMA(0, 0, At, B0); PG8_MMA(0, 1, At, B1); PG8_BAR; PG8_SCHED;
            PG8_LDA(At, 1, 1); PG8_STAGE(PG8_SB(1, 0), b3, voffB); PG8_STAGE(PG8_SB(1, 1), b3 + hstep, voffB); PG8_STAGE_A(PG8_SA(1, 0), a3, 0, o2);
            PG8_WAIT_V(8); PG8_WAIT_L(0); PG8_BAR; PG8_MMA(1, 0, At, B0); PG8_MMA(1, 1, At, B1); PG8_BAR; PG8_SCHED;
        }
        if (wr == 0) PG8_BAR;
        E(acc, cur, wr, wc, fr, fq, lds, ui & 1);
        if (!has_next) break;
#pragma unroll
        for (int a = 0; a < 2; ++a)
#pragma unroll
            for (int b = 0; b < 2; ++b)
#pragma unroll
                for (int m = 0; m < 4; ++m)
#pragma unroll
                    for (int n = 0; n < 2; ++n) acc[a][b][m][n] = (f32x4){0.f, 0.f, 0.f, 0.f};
        cur = nxt; cB = nB; cA = nA; ++ui;
        if constexpr (Sched::TABLES) {
#pragma unroll
            for (int h = 0; h < 2; ++h)
#pragma unroll
                for (int i = 0; i < 2; ++i) offc[h][i] = offn[h][i]; }
        if (wr == 1) PG8_BAR;
    }
    PG8_WAIT_V(0);
    PG8_BAR;
#undef PG8_SA
#undef PG8_SB
#undef PG8_STAGE
#undef PG8_STAGE_A
#undef PG8_LDA
#undef PG8_LDB
#undef PG8_MMA
#undef PG8_WAIT_V
#undef PG8_WAIT_L
#undef PG8_BAR
#undef PG8_SCHED
}
}
namespace attn_body {
using bf16=__hip_bfloat16;
using bf16x8=__attribute__((ext_vector_type(8)))short;
using s16x4=__attribute__((ext_vector_type(4)))short;
using f32x16=__attribute__((ext_vector_type(16)))float;
using u32x4=__attribute__((ext_vector_type(4)))unsigned;
using f32x4_=__attribute__((ext_vector_type(4)))float;
constexpr int BATCH=16,SEQ=4096,D=64,DM=512,DMO=1024;
constexpr int NW=8,QBLK=32,QB=QBLK*NW,KVBLK=64,NQB=SEQ/QB;
constexpr int ATTN_UNIT_ROWS=QB;
__device__ __forceinline__ int crow(int r,int hi){return (r&3)+8*(r>>2)+4*hi;}
#define SBAR() __builtin_amdgcn_sched_barrier(0)
__device__ __forceinline__ void cmask(f32x16&p0,f32x16&p1,int jb,int qrel,int hi){
  const float NEG=-INFINITY; int kb=64*jb+4*hi; asm volatile("":"+v"(kb));
  #pragma unroll
  for(int r=0;r<16;++r){int kv=kb+(r&3)+8*(r>>2); if(kv>qrel)p0[r]=NEG; if(kv+32>qrel)p1[r]=NEG;}
}

constexpr int NSLOT=3, SLOTB=8192;
constexpr int LDS_K=0, LDS_V=NSLOT*SLOTB, LDS_WS=2*NSLOT*SLOTB, LDS_OST=LDS_WS+NW*64*4, LDS_BYTES=LDS_OST+NW*4096;
constexpr float C2=0.125f*1.4426950408889634f;
__device__ __forceinline__ void glds16(const void*gsrc,unsigned lds_dst){unsigned keep;
  asm volatile("s_mov_b32 %0, m0\n\ts_mov_b32 m0, %2\n\ts_nop 0\n\tglobal_load_lds_dwordx4 %1, off\n\ts_mov_b32 m0, %0":"=&s"(keep):"v"(gsrc),"s"(lds_dst):"memory");}
__device__ __forceinline__ float max3f(float a,float b,float c){float r;asm("v_max3_f32 %0, %1, %2, %3":"=v"(r):"v"(a),"v"(b),"v"(c));return r;}
__device__ __forceinline__ float max2f(float a,float b){float r;asm("v_max_f32_e32 %0, %1, %2":"=v"(r):"v"(a),"v"(b));return r;}
__device__ __forceinline__ float fadd_s(float a,float b){float r;asm("v_add_f32_e32 %0, %1, %2":"=v"(r):"v"(a),"v"(b));return r;}
__device__ __forceinline__ float fsub_s(float a,float b){float r;asm("v_sub_f32_e32 %0, %1, %2":"=v"(r):"v"(a),"v"(b));return r;}
typedef float f32x2_t __attribute__((ext_vector_type(2))); typedef __bf16 bf16x2_t __attribute__((ext_vector_type(2)));
__device__ __forceinline__ unsigned cvtpk_s(float lo,float hi){f32x2_t v={lo,hi};bf16x2_t b=__builtin_convertvector(v,bf16x2_t);return __builtin_bit_cast(unsigned,b);}
#define WAIT_BAR(N) asm volatile("s_waitcnt vmcnt(" #N ") lgkmcnt(0)\n\ts_barrier":::"memory")

__device__ __forceinline__ void qkt(f32x16&p0,f32x16&p1,const char*Kslot,const bf16x8*qr,const f32x16&i0,const f32x16&i1,int r32,int hi){
  const char*kb=Kslot+hi*1024+r32*16;
  #pragma unroll
  for(int d0=0;d0<4;++d0){
    const bf16x8 b0=*reinterpret_cast<const bf16x8*>(kb+d0*2048);
    const bf16x8 b1=*reinterpret_cast<const bf16x8*>(kb+d0*2048+512);
    if(d0==0){p0=__builtin_amdgcn_mfma_f32_32x32x16_bf16(b0,qr[0],i0,0,0,0);p1=__builtin_amdgcn_mfma_f32_32x32x16_bf16(b1,qr[0],i1,0,0,0);}
    else{p0=__builtin_amdgcn_mfma_f32_32x32x16_bf16(b0,qr[d0],p0,0,0,0);p1=__builtin_amdgcn_mfma_f32_32x32x16_bf16(b1,qr[d0],p1,0,0,0);}}
}
typedef __attribute__((address_space(3))) const char* lds_cptr;
typedef short v4i16_t __attribute__((ext_vector_type(4)));
__device__ __forceinline__ void kload8(bf16x8*kf,lds_cptr kp){
  kf[0]=*(const __attribute__((address_space(3))) bf16x8*)(kp);      kf[1]=*(const __attribute__((address_space(3))) bf16x8*)(kp+512);
  kf[2]=*(const __attribute__((address_space(3))) bf16x8*)(kp+2048); kf[3]=*(const __attribute__((address_space(3))) bf16x8*)(kp+2560);
  kf[4]=*(const __attribute__((address_space(3))) bf16x8*)(kp+4096); kf[5]=*(const __attribute__((address_space(3))) bf16x8*)(kp+4608);
  kf[6]=*(const __attribute__((address_space(3))) bf16x8*)(kp+6144); kf[7]=*(const __attribute__((address_space(3))) bf16x8*)(kp+6656);
}
__device__ __forceinline__ void kload2(bf16x8*kf,lds_cptr kp,int j){ kf[2*j]=*(const __attribute__((address_space(3))) bf16x8*)(kp+j*2048); kf[2*j+1]=*(const __attribute__((address_space(3))) bf16x8*)(kp+j*2048+512); }
__device__ __forceinline__ s16x4 vtr(lds_cptr p){ return __builtin_bit_cast(s16x4,__builtin_amdgcn_ds_read_tr16_b64_v4i16((__attribute__((address_space(3))) v4i16_t*)p)); }
__device__ __forceinline__ float rowmax(const f32x16&p0,const f32x16&p1){
  float a=max3f(p0[0],p0[1],p1[0]),b=max3f(p0[2],p0[3],p1[1]);a=max3f(a,p1[2],p1[3]);
  #pragma unroll
  for(int r=4;r<16;r+=4){a=max3f(a,p0[r],p0[r+1]);b=max3f(b,p0[r+2],p0[r+3]);a=max3f(a,p1[r],p1[r+1]);b=max3f(b,p1[r+2],p1[r+3]);}
  const float m=max2f(a,b);
  auto rr=__builtin_amdgcn_permlane32_swap(__float_as_uint(m),__float_as_uint(m),false,false);
  return max2f(__uint_as_float(rr[0]),__uint_as_float(rr[1]));
}
__device__ __forceinline__ void pv(f32x16*o,int vb,bf16x8 pa0,bf16x8 pa1,bf16x8 pa2,bf16x8 pa3){
  #pragma unroll
  for(int d0=0;d0<2;++d0){s16x4 lo[4],hi[4];
    #pragma unroll
    for(int ks=0;ks<4;++ks){
      asm volatile("ds_read_b64_tr_b16 %0,%1 offset:%c2":"=&v"(lo[ks]):"v"(vb),"i"(d0*4096+ks*1024):"memory");
      asm volatile("ds_read_b64_tr_b16 %0,%1 offset:%c2":"=&v"(hi[ks]):"v"(vb),"i"(d0*4096+ks*1024+512):"memory");}
    asm volatile("s_waitcnt lgkmcnt(0)":::"memory");SBAR();
    #define PK(k) (bf16x8){lo[k][0],lo[k][1],lo[k][2],lo[k][3],hi[k][0],hi[k][1],hi[k][2],hi[k][3]}
    o[d0]=__builtin_amdgcn_mfma_f32_32x32x16_bf16(pa0,PK(0),o[d0],0,0,0);
    o[d0]=__builtin_amdgcn_mfma_f32_32x32x16_bf16(pa1,PK(1),o[d0],0,0,0);
    o[d0]=__builtin_amdgcn_mfma_f32_32x32x16_bf16(pa2,PK(2),o[d0],0,0,0);
    o[d0]=__builtin_amdgcn_mfma_f32_32x32x16_bf16(pa3,PK(3),o[d0],0,0,0);
    #undef PK
  }
}

#ifndef ATTN_STORE16
#define ATTN_STORE16(p,v) (*(u32x4*)(p)=(v))
#endif
template<int THRL> __device__ __forceinline__ void attn_unit(int b,int hm,int half,int qb,float cs,const int wid,const int t0,const float uref,const bf16*Q,const bf16*__restrict__ K,const bf16*__restrict__ V,bf16*O,char*shm){
  int lane=lane_id(); asm volatile("":"+v"(lane));
  const int r32=lane&31,hi=lane>>5;
  const long rowbase=(long)b*SEQ; const int q0=qb*QB;
  const int NTf=(q0+QB)/KVBLK;
  const bf16*Qw=Q+(rowbase+q0+wid*QBLK)*DM+hm*D;
  const bf16*Kh=K+(rowbase+64*t0)*DM+hm*D,*Vh=V+(rowbase+64*t0)*DM+(hm>>1)*128+half*64;
  const unsigned lds0=(unsigned)(uintptr_t)shm;
  float*wsf=(float*)(shm+LDS_WS)+wid*64;
  const bf16*ksrc=Kh+(long)lane*DM+wid*8;
  const bf16*vsrc=Vh+(long)(16*(wid&3)+(lane>>2))*DM+(wid>>2)*32+(lane&3)*8;
  const unsigned kdst=lds0+LDS_K+wid*1024, vdst=lds0+LDS_V+wid*1024;
  #define DMA_K(t,slot) glds16(ksrc+(long)(t)*KVBLK*DM,(unsigned)__builtin_amdgcn_readfirstlane(kdst+(slot)))
  #define DMA_V(t,slot) glds16(vsrc+(long)(t)*KVBLK*DM,(unsigned)__builtin_amdgcn_readfirstlane(vdst+(slot)))
  const int vb0=(int)(lds0+LDS_V)+((lane>>4)&1)*32+(lane&3)*8+(4*hi+((lane&15)>>2))*64;
  const char*Kbase=shm+LDS_K; bf16x8 kf[8];
  const lds_cptr shm3=(lds_cptr)shm; const lds_cptr kp0=shm3+LDS_K+hi*1024+r32*16; const lds_cptr vp0=shm3+LDS_V+((lane>>4)&1)*32+(lane&3)*8+(4*hi+((lane&15)>>2))*64;
  const int NT=NTf-t0;
  DMA_K(0,0);DMA_V(0,0);DMA_K(1,SLOTB);
  bf16x8 qr[4];
  #pragma unroll
  for(int d0=0;d0<4;++d0)qr[d0]=*reinterpret_cast<const bf16x8*>(&Qw[(long)r32*DM+d0*16+hi*8]);
  float mhat=0.f,l_reg=0.f;f32x16 o[2];o[0]=f32x16{};o[1]=f32x16{};
  const int qrel=wid*QBLK+r32;
  float nb=-uref-cs*(float)(q0+qrel-4*hi-64*t0);
  const float cs8=__builtin_bit_cast(float,__builtin_amdgcn_readfirstlane(__builtin_bit_cast(int,8.f*cs)));
  #define CINIT1(C,t,X) do{ C[0]=nb+cs*(float)(64*(t)+(X)); C[1]=C[0]+cs; C[2]=C[1]+cs; C[3]=C[2]+cs; _Pragma("unroll") for(int r=4;r<16;++r) C[r]=C[r-4]+cs8; asm volatile("":"+v"(C)); }while(0)
  #define CINIT(C0,C1,t) do{ CINIT1(C0,t,0); CINIT1(C1,t,32); }while(0)
  #define CMASK(P0,P1,t) do{int jb_=(t)-(NT-4); if(jb_>=0)cmask(P0,P1,jb_,qrel,hi);}while(0)
  bool resc=false;
  #define START(P0,P1) do{ const float rm=rowmax(P0,P1); resc=false; \
    { const float dl=0.f; (void)rm; mhat=fadd_s(mhat,dl); nb=fsub_s(nb,dl);     \
      _Pragma("unroll") for(int r=0;r<16;++r){P0[r]=fsub_s(P0[r],dl);P1[r]=fsub_s(P1[r],dl);} } \
    _Pragma("unroll") for(int r=0;r<16;++r)P0[r]=__builtin_amdgcn_exp2f(P0[r]); }while(0)
  #define RESC() do{ if(THRL>=0&&resc){ asm volatile("s_waitcnt lgkmcnt(0)":::"memory"); \
      _Pragma("unroll") for(int d_=0;d_<2;++d_) _Pragma("unroll") for(int r=0;r<16;++r)o[d_][r]*=wsf[crow(r,hi)]; } }while(0)
  f32x16 pA0,pA1,pB0,pB1;
  int sl_prev=0,sl_cur=0,sl_next=SLOTB;
  #define ROT() do{sl_prev=sl_cur;sl_cur=sl_next;sl_next=(sl_next==(NSLOT-1)*SLOTB)?0:sl_next+SLOTB;}while(0)
  DMA_K(2,2*SLOTB);
  WAIT_BAR(3);
  { f32x16 i0_,i1_; CINIT(i0_,i1_,0); qkt(pA0,pA1,Kbase,qr,i0_,i1_,r32,hi); } asm volatile("s_nop 15\n\ts_nop 7":"+v"(pA0),"+v"(pA1));CMASK(pA0,pA1,0);
  START(pA0,pA1);
  _Pragma("unroll") for(int r=0;r<16;++r)pA1[r]=__builtin_amdgcn_exp2f(pA1[r]);
  WAIT_BAR(0);
  DMA_K(3,0);DMA_V(1,SLOTB);
  ROT();
  kload8(kf,kp0+sl_cur);
  WAIT_BAR(2);
  s16x4 vlo[8],vhi[8]; u32x4 pw0,pw1,pw2,pw3;
  #define PKW(P,B) cvtpk_s(P[B],P[B+1])
  #define PAF(k) __builtin_bit_cast(bf16x8,pw##k)
  #define VFR(i) (bf16x8){vlo[i][0],vlo[i][1],vlo[i][2],vlo[i][3],vhi[i][0],vhi[i][1],vhi[i][2],vhi[i][3]}
  #define PIN(x) asm volatile("":"+v"(x))
  #define MX3(a,b,c) __builtin_fmaxf(__builtin_fmaxf((a),(b)),(c))
  #define GAPA(MF,A0,A1,A2,A3,W0,W1,PW) do{ MF; sacc+=A0; sacc+=A1; sacc+=A2; sacc+=A3; PIN(sacc); W0; W1; PIN(PW); SBAR(); }while(0)
  #define EX(v) __builtin_amdgcn_exp2f(v)
  #define GAPB(MF,X,B) do{ MF; X[B]=EX(X[B]); X[B+1]=EX(X[B+1]); X[B+2]=EX(X[B+2]); X[B+3]=EX(X[B+3]); PIN(X); SBAR(); }while(0)
  #define VRD(i) do{ vlo[i]=vtr(vp_+(((i)>>2)*4096+((i)&3)*1024)); vhi[i]=vtr(vp_+(((i)>>2)*4096+((i)&3)*1024+512)); }while(0)
  #define KRD(G,j) do{ if(G){ kload2(kf,kp0+sl_next,j); SBAR(); } }while(0)
  #define STEP(C0,C1,P0,P1,t,GK,GV,GL) do{ SBAR(); \
    const lds_cptr vp_=vp0+sl_prev; \
    VRD(0); SBAR(); float sacc=(P0[0]+P0[1]); CINIT1(C0,t,0); SBAR(); \
    GAPA(C0=__builtin_amdgcn_mfma_f32_32x32x16_bf16(kf[0],qr[0],C0,0,0,0), P0[2],P0[3],P0[4],P0[5],     pw0[0]=PKW(P0,0), pw0[1]=PKW(P0,2), pw0); \
    VRD(4); SBAR(); CINIT1(C1,t,32); SBAR(); GAPA(C1=__builtin_amdgcn_mfma_f32_32x32x16_bf16(kf[1],qr[0],C1,0,0,0), P0[6],P0[7],P0[8],P0[9],     pw0[2]=PKW(P0,4), pw0[3]=PKW(P0,6), pw0); \
    VRD(1); SBAR(); GAPA(C0=__builtin_amdgcn_mfma_f32_32x32x16_bf16(kf[2],qr[1],C0,0,0,0),   P0[10],P0[11],P0[12],P0[13], pw1[0]=PKW(P0,8), pw1[1]=PKW(P0,10), pw1); \
    VRD(5); SBAR(); GAPA(C1=__builtin_amdgcn_mfma_f32_32x32x16_bf16(kf[3],qr[1],C1,0,0,0),   P0[14],P0[15],P1[0],P1[1],   pw1[2]=PKW(P0,12),pw1[3]=PKW(P0,14), pw1); \
    VRD(2); SBAR(); GAPA(C0=__builtin_amdgcn_mfma_f32_32x32x16_bf16(kf[4],qr[2],C0,0,0,0),   P1[2],P1[3],P1[4],P1[5],     pw2[0]=PKW(P1,0), pw2[1]=PKW(P1,2), pw2); \
    VRD(6); SBAR(); GAPA(C1=__builtin_amdgcn_mfma_f32_32x32x16_bf16(kf[5],qr[2],C1,0,0,0),   P1[6],P1[7],P1[8],P1[9],     pw2[2]=PKW(P1,4), pw2[3]=PKW(P1,6), pw2); \
    VRD(3); SBAR(); GAPA(C0=__builtin_amdgcn_mfma_f32_32x32x16_bf16(kf[6],qr[3],C0,0,0,0),   P1[10],P1[11],P1[12],P1[13], pw3[0]=PKW(P1,8), pw3[1]=PKW(P1,10), pw3); \
    VRD(7); SBAR(); GAPA(C1=__builtin_amdgcn_mfma_f32_32x32x16_bf16(kf[7],qr[3],C1,0,0,0),   P1[14],P1[15],0.f,0.f,       pw3[2]=PKW(P1,12),pw3[3]=PKW(P1,14), pw3); \
    l_reg+=sacc; \
    if(GK){DMA_K((t)+3,sl_cur);} if(GV){DMA_V((t)+1,sl_next);} \
    CMASK(C0,C1,t); \
    { float a=MX3(C0[0],C0[1],C1[0]),b=MX3(C0[2],C0[3],C1[1]); a=MX3(a,C1[2],C1[3]); \
      _Pragma("unroll") for(int r=4;r<16;r+=4){a=MX3(a,C0[r],C0[r+1]);b=MX3(b,C0[r+2],C0[r+3]);a=MX3(a,C1[r],C1[r+1]);b=MX3(b,C1[r+2],C1[r+3]);} \
      float rm=__builtin_fmaxf(a,b); { auto rr=__builtin_amdgcn_permlane32_swap(__float_as_uint(rm),__float_as_uint(rm),false,false); rm=__builtin_fmaxf(__uint_as_float(rr[0]),__uint_as_float(rr[1])); } \
      resc=false; \
      if(THRL>=0&&__builtin_expect(__any(rm>(float)THRL),0)){ const float dl=__builtin_fmaxf(rm,0.f); mhat+=dl; nb-=dl; \
        _Pragma("unroll") for(int r=0;r<16;++r){C0[r]-=dl;C1[r]-=dl;} \
        const float f=__builtin_amdgcn_exp2f(-dl); l_reg*=f; if(hi==0)wsf[r32]=f; resc=true; } } \
    SBAR(); \
    GAPB(o[0]=__builtin_amdgcn_mfma_f32_32x32x16_bf16(PAF(0),VFR(0),o[0],0,0,0), C0,0); \
    GAPB(o[1]=__builtin_amdgcn_mfma_f32_32x32x16_bf16(PAF(0),VFR(4),o[1],0,0,0), C0,4); \
    KRD(GL,0); GAPB(o[0]=__builtin_amdgcn_mfma_f32_32x32x16_bf16(PAF(1),VFR(1),o[0],0,0,0), C0,8); \
    KRD(GL,1); GAPB(o[1]=__builtin_amdgcn_mfma_f32_32x32x16_bf16(PAF(1),VFR(5),o[1],0,0,0), C0,12); \
    KRD(GL,2); GAPB(o[0]=__builtin_amdgcn_mfma_f32_32x32x16_bf16(PAF(2),VFR(2),o[0],0,0,0), C1,0); \
    KRD(GL,3); GAPB(o[1]=__builtin_amdgcn_mfma_f32_32x32x16_bf16(PAF(2),VFR(6),o[1],0,0,0), C1,4); \
    GAPB(o[0]=__builtin_amdgcn_mfma_f32_32x32x16_bf16(PAF(3),VFR(3),o[0],0,0,0), C1,8); \
    GAPB(o[1]=__builtin_amdgcn_mfma_f32_32x32x16_bf16(PAF(3),VFR(7),o[1],0,0,0), C1,12); \
    }while(0)
  int t=1;
  #undef CMASK
  #define CMASK(P0,P1,t) do{}while(0)
  for(;t+5<NT;t+=2){
    STEP(pB0,pB1,pA0,pA1,t,true,true,true);     WAIT_BAR(2); RESC(); ROT();
    STEP(pA0,pA1,pB0,pB1,t+1,true,true,true);   WAIT_BAR(2); RESC(); ROT();
  }
  #undef CMASK
  #define CMASK(P0,P1,t) do{int jb_=(t)-(NT-4); if(jb_>=0)cmask(P0,P1,jb_,qrel,hi);}while(0)
  #define ENDW(tt) do{ if((tt)+3<NT){WAIT_BAR(2);} else if((tt)+2<NT){WAIT_BAR(1);} else {WAIT_BAR(0);} }while(0)
  for(;t+1<NT;t+=2){
    STEP(pB0,pB1,pA0,pA1,t,(t+3<NT),(t+1<NT),(t+1<NT));       ENDW(t);   RESC(); ROT();
    STEP(pA0,pA1,pB0,pB1,t+1,(t+4<NT),(t+2<NT),(t+2<NT));     ENDW(t+1); RESC(); ROT();
  }
  STEP(pB0,pB1,pA0,pA1,NT-1,false,false,false); RESC();
  { float sacc=pB0[0]+pB0[1]; _Pragma("unroll") for(int r=2;r<16;++r)sacc+=pB0[r]; _Pragma("unroll") for(int r=0;r<16;++r)sacc+=pB1[r]; l_reg+=sacc;
    pw0=(u32x4){PKW(pB0,0),PKW(pB0,2),PKW(pB0,4),PKW(pB0,6)};pw1=(u32x4){PKW(pB0,8),PKW(pB0,10),PKW(pB0,12),PKW(pB0,14)};pw2=(u32x4){PKW(pB1,0),PKW(pB1,2),PKW(pB1,4),PKW(pB1,6)};pw3=(u32x4){PKW(pB1,8),PKW(pB1,10),PKW(pB1,12),PKW(pB1,14)};
    SBAR(); pv(o,vb0+sl_cur,PAF(0),PAF(1),PAF(2),PAF(3)); }
  #undef PKW
  #undef PAF
  #undef VFR
  #undef PIN
  #undef MX3
  #undef GAPA
  #undef GAPB
  #undef EX
  #undef VRD
  #undef KRD
  #undef STEP
  #undef ENDW
  {auto rr=__builtin_amdgcn_permlane32_swap(__float_as_uint(l_reg),__float_as_uint(l_reg),false,false);l_reg=__uint_as_float(rr[0])+__uint_as_float(rr[1]);}
  if(hi==0)wsf[32+r32]=l_reg;asm volatile("s_waitcnt lgkmcnt(0)":::"memory");
  float rli[16];
  #pragma unroll
  for(int r=0;r<16;++r)rli[r]=__builtin_amdgcn_rcpf(wsf[32+crow(r,hi)]);
  bf16*Ow=O+(rowbase+q0+wid*QBLK)*DMO+(hm>>1)*256+(hm&1)*128+half*64;
  { bf16*stg=(bf16*)(shm+LDS_OST)+wid*2048;
    int eoff=hi*256+r32; asm volatile("":"+v"(eoff));
    #pragma unroll
    for(int r=0;r<16;++r){const int orow=(r&3)+8*(r>>2);
      #pragma unroll
      for(int d0=0;d0<2;++d0)stg[eoff+orow*64+d0*32]=__float2bfloat16(o[d0][r]*rli[r]);}
    asm volatile("s_waitcnt lgkmcnt(0)":::"memory");
    #pragma unroll
    for(int i=0;i<4;++i){const int row=i*8+(lane>>3),ch=lane&7; const u32x4 v=*(const u32x4*)(stg+row*64+ch*8); ATTN_STORE16(Ow+(long)row*DMO+ch*8,v);} }
  asm volatile("s_waitcnt lgkmcnt(0)\n\ts_barrier":::"memory");
  #undef DMA_K
  #undef DMA_V
  #undef CMASK
  #undef START
  #undef RESC
  #undef ROT
  #undef CINIT
  #undef CINIT1
}
constexpr int ATTN_LDS_BYTES=LDS_BYTES;
struct AttnTensors { const bf16* Q; const bf16* K; const bf16* V; bf16* O; const float* PN; unsigned* queue; };
constexpr int LDS_SLOT=LDS_BYTES, LDS_T0=LDS_BYTES+1024, LDS_UREF=LDS_T0+8192, ATTN_LDS_TOTAL=LDS_UREF+8192;
__device__ __forceinline__ void unit_of(int u,int&b,int&vh,int&qb){ if(u<2048){qb=15-(u>>7);const int r=u&127;b=r>>3;vh=8+(r&7);} else if(u<3072){const int v=u-2048;qb=15-(v>>6);const int r=v&63;b=r>>2;vh=4+(r&3);} else {const int v=u-3072;qb=15-(v>>6);const int r=v&63;b=r>>2;vh=r&3;} }
__device__ __forceinline__ void attn_tables(char*lds,const float*PN,int tid){
  const int bhm=tid>>2,part=tid&3; const float*pq=PN+(bhm*64+16*part)*2,*pk=PN+16384+(bhm*64+16*part)*2;
  float kq[16],qq[16];
  #pragma unroll
  for(int i=0;i<8;++i){ const f32x4_ a=*(const f32x4_*)(pk+4*i),c=*(const f32x4_*)(pq+4*i); kq[2*i]=a[0]+a[1];kq[2*i+1]=a[2]+a[3];qq[2*i]=c[0]+c[1];qq[2*i+1]=c[2]+c[3]; }
  float km[4]; { float m=0.f;
    #pragma unroll
    for(int i=0;i<16;++i){ m=__builtin_fmaxf(m,kq[i]); if((i&3)==3)km[i>>2]=m; } }
  float before=0.f;
  #pragma unroll
  for(int p=0;p<3;++p){ const float tot=__shfl(km[3],(tid&~3)+p); if(p<part)before=__builtin_fmaxf(before,tot); }
  const int hm=bhm&7; const float cs=__builtin_amdgcn_exp2f(-2.f*(float)((hm>>1)+1))*1.4426950408889634f;
  volatile __attribute__((address_space(3))) int* T0=(volatile __attribute__((address_space(3))) int*)(lds+LDS_T0); volatile __attribute__((address_space(3))) float* UR=(volatile __attribute__((address_space(3))) float*)(lds+LDS_UREF);
  #pragma unroll
  for(int j=0;j<4;++j){ const int qb=4*part+j; const float kmx=__builtin_fmaxf(before,km[j]); const float qmx=__builtin_fmaxf(__builtin_fmaxf(qq[4*j],qq[4*j+1]),__builtin_fmaxf(qq[4*j+2],qq[4*j+3]));
    const float qk=__builtin_sqrtf(qmx*kmx), need=(ATT_SKIP+2.04f*qk)/cs;
    const float tf=((float)(256*qb-63)-need)*(1.f/64.f); int tt=tf>0.f?(int)tf:0; tt&=~1; if(tt>4*qb)tt=4*qb;
    T0[bhm*16+qb]=tt; UR[bhm*16+qb]=1.02f*qk; }
}
template<int THRL=8> __device__ __forceinline__ void attn_phase(char*lds,const AttnTensors&T,const int wid){
  volatile __attribute__((address_space(3))) int* slot=(volatile __attribute__((address_space(3))) int*)(lds+LDS_SLOT);
  const volatile __attribute__((address_space(3))) int* T0=(const volatile __attribute__((address_space(3))) int*)(lds+LDS_T0); const volatile __attribute__((address_space(3))) float* UR=(const volatile __attribute__((address_space(3))) float*)(lds+LDS_UREF);
  const bool lead=(wid==0)&&(lane_id()==0);
  if(lead) *slot=(int)__hip_atomic_fetch_add(T.queue,1u,__ATOMIC_RELAXED,__HIP_MEMORY_SCOPE_AGENT);
  attn_tables(lds,T.PN,wid*64+lane_id());
  asm volatile("s_waitcnt vmcnt(0) lgkmcnt(0)\n\ts_barrier":::"memory");
  int cur=__builtin_amdgcn_readfirstlane(*slot);
  asm volatile("s_waitcnt lgkmcnt(0)\n\ts_barrier":::"memory");
  while(cur<BATCH*16*NQB){
    int nxt=0; if(lead) nxt=(int)__hip_atomic_fetch_add(T.queue,1u,__ATOMIC_RELAXED,__HIP_MEMORY_SCOPE_AGENT);
    int b,vh,qb; unit_of(cur,b,vh,qb); const int hm=vh>>1,half=vh&1;
    const float cs=__builtin_bit_cast(float,__builtin_amdgcn_readfirstlane(__builtin_bit_cast(int,__builtin_amdgcn_exp2f(-2.f*(float)((hm>>1)+1))*1.4426950408889634f)));
    const int t0=__builtin_amdgcn_readfirstlane(T0[(b*8+hm)*16+qb]); const float uref=__builtin_bit_cast(float,__builtin_amdgcn_readfirstlane(__builtin_bit_cast(int,(float)UR[(b*8+hm)*16+qb])));
    attn_unit<THRL>(b,hm,half,qb,cs,wid,t0,uref,T.Q,T.K,T.V,T.O,lds);
    if(lead) *slot=nxt;
    asm volatile("s_waitcnt vmcnt(0) lgkmcnt(0)\n\ts_barrier":::"memory");
    cur=__builtin_amdgcn_readfirstlane(*slot);
    asm volatile("s_waitcnt lgkmcnt(0)\n\ts_barrier":::"memory");
  }
}
#undef SBAR
#undef WAIT_BAR
}
constexpr int NWAVES = 8;
constexpr int RING_OFF = 0, RING_BYTES = 131072;
constexpr int LDSCTL_OFF = RING_BYTES, MISC_OFF = LDSCTL_OFF + 320;
constexpr int LDS_BYTES = 163840;

#define XB_TMO      128
#define XB_XCNT(j)  (256  + 64 * (j))
#define XB_XSUB(j)  (1280 + 64 * (j))
#define XB_XGEN(j)  (2304 + 64 * (j))
#define XB_TOP      3328
#define XB_TOPGEN   3392
#define XCD_BAR_WORDS 3456
#define XB_SPIN_CAP (1u << 18)
__device__ __forceinline__ unsigned xb_ld(unsigned* p)              { return __hip_atomic_load(p, __ATOMIC_RELAXED, __HIP_MEMORY_SCOPE_AGENT); }
__device__ __forceinline__ unsigned xb_add(unsigned* p, unsigned v) { return __hip_atomic_fetch_add(p, v, __ATOMIC_RELAXED, __HIP_MEMORY_SCOPE_AGENT); }
__device__ __forceinline__ unsigned xb_xcc_id() { return (unsigned)__builtin_amdgcn_s_getreg((3 << 11) | 20) & 0xFu; }
#define XB_SPIN(cond, bar) do { unsigned _sp = 0; while (cond) { __builtin_amdgcn_s_sleep(1); \
    if ((++_sp & 255u) == 0u) { if (xb_ld(&(bar)[XB_TMO])) break; if (_sp > XB_SPIN_CAP) { atomicAdd(&(bar)[XB_TMO], 1u); break; } } } } while (0)
struct XcdBarrier { unsigned* bar; unsigned x; volatile LAS unsigned* st; bool wave0; };
__device__ __forceinline__ XcdBarrier xcd_barrier_post(unsigned* bar, volatile LAS unsigned* st) {
    XcdBarrier b; b.bar = bar; b.x = xb_xcc_id(); b.st = st; b.wave0 = __builtin_amdgcn_readfirstlane(threadIdx.x >> 6) == 0;
    if (threadIdx.x == 0) (void)xb_add(&bar[XB_XCNT(b.x)], 1u);
    return b;
}
__device__ __forceinline__ void xcd_barrier_complete(unsigned* bar, unsigned x, unsigned& nloc, unsigned& nx) {
    const unsigned G = gridDim.x * gridDim.y * gridDim.z;
    unsigned sum, cnt, mine, sp = 0u;
    for (;;) {
        sum = 0u; cnt = 0u; mine = 0u;
#pragma unroll
        for (unsigned j = 0; j < 16; ++j) { const unsigned c = xb_ld(&bar[XB_XCNT(j)]); sum += c; cnt += (c > 0u) ? 1u : 0u; mine = (j == x) ? c : mine; }
        if (sum == G) break;
        __builtin_amdgcn_s_sleep(1);
        if ((++sp & 255u) == 0u) { if (xb_ld(&bar[XB_TMO])) break; if (sp > XB_SPIN_CAP) { atomicAdd(&bar[XB_TMO], 1u); break; } }
    }
    nloc = mine > 0u ? mine : 1u; nx = cnt > 0u ? cnt : 1u;
}
__device__ __forceinline__ void xcd_barrier(const XcdBarrier& b) {
    asm volatile("s_waitcnt vmcnt(0)" ::: "memory");
    __syncthreads();
    if (b.wave0 && lane_id() == 0) {
        unsigned* bar = b.bar;
        __builtin_amdgcn_s_waitcnt(0);
        unsigned nloc = b.st[0], nx = b.st[1];
        if (nloc == 0u) { xcd_barrier_complete(bar, b.x, nloc, nx); b.st[0] = nloc; b.st[1] = nx; }
        const unsigned old = xb_add(&bar[XB_XSUB(b.x)], 1u);
        const unsigned gen = old / nloc;
        if (old + 1u == (gen + 1u) * nloc) {
            __builtin_amdgcn_fence(__ATOMIC_RELEASE, "agent");
            asm volatile("s_waitcnt vmcnt(0)" ::: "memory");
            const unsigned og = xb_add(&bar[XB_TOP], 1u);
            const unsigned tg = og / nx;
            if (og + 1u == (tg + 1u) * nx) xb_add(&bar[XB_TOPGEN], 1u);
            else XB_SPIN(xb_ld(&bar[XB_TOPGEN]) == tg, bar);
            __builtin_amdgcn_fence(__ATOMIC_ACQUIRE, "agent");
            xb_add(&bar[XB_XGEN(b.x)], 1u);
            asm volatile("s_waitcnt vmcnt(0)" ::: "memory");
        } else {
            XB_SPIN(xb_ld(&bar[XB_XGEN(b.x)]) == gen, bar);
            __builtin_amdgcn_fence(__ATOMIC_ACQUIRE, "agent");
            asm volatile("s_waitcnt vmcnt(0)" ::: "memory");
        }
    }
    __syncthreads();
}

struct Frame {
    LAS unsigned char* lds; volatile LAS unsigned* MISC; gu32* ctl;
    int tid, lane, wave, vcu, G;
};
__device__ __forceinline__ float bf2f_(unsigned short b) { return __builtin_bit_cast(float, (unsigned)b << 16); }
__device__ __forceinline__ float wave_sum(float v) {
#pragma unroll
    for (int o = 1; o < 64; o <<= 1) v += __shfl_xor(v, o);
    return v;
}
__device__ __forceinline__ void p0_transpose_item(const float* W, int ldw, int K, bf16* WT, int k0, int n0, int drow0, LAS float* scr, int lane) {
#pragma unroll 8
    for (int i = 0; i < 32; ++i) { const int kk = 2 * i + (lane >> 5); scr[kk * 33 + (lane & 31)] = W[(size_t)(k0 + kk) * ldw + n0 + (lane & 31)]; }
    LDS_WAIT(); asm volatile("" ::: "memory");
    const int c = lane & 7;
#pragma unroll
    for (int j = 0; j < 4; ++j) { const int n = (lane >> 3) + 8 * j; const LAS float* s = scr + (8 * c) * 33 + n;
        v4u o; o.x = pk2(s[0 * 33], s[1 * 33]); o.y = pk2(s[2 * 33], s[3 * 33]); o.z = pk2(s[4 * 33], s[5 * 33]); o.w = pk2(s[6 * 33], s[7 * 33]);
        *(GAS v4u*)(WT + (size_t)(drow0 + n) * K + k0 + 8 * c) = o; }
    LDS_WAIT(); asm volatile("" ::: "memory");
}
__device__ __forceinline__ void p0_transpose_item_f8(const float* W, int ldw, int K, unsigned char* WT, int k0, int n0, int drow0, float scale, LAS float* scr, int lane) {
#pragma unroll 8
    for (int i = 0; i < 32; ++i) { const int kk = 2 * i + (lane >> 5); scr[kk * 33 + (lane & 31)] = W[(size_t)(k0 + kk) * ldw + n0 + (lane & 31)] * scale; }
    LDS_WAIT(); asm volatile("" ::: "memory");
    const int c = lane & 3;
#pragma unroll
    for (int j = 0; j < 2; ++j) { const int n = (lane >> 2) + 16 * j; const LAS float* s = scr + (16 * c) * 33 + n;
        v4u o; o.x = pg8::pk4_fp8(s[0 * 33], s[1 * 33], s[2 * 33], s[3 * 33]); o.y = pg8::pk4_fp8(s[4 * 33], s[5 * 33], s[6 * 33], s[7 * 33]);
        o.z = pg8::pk4_fp8(s[8 * 33], s[9 * 33], s[10 * 33], s[11 * 33]); o.w = pg8::pk4_fp8(s[12 * 33], s[13 * 33], s[14 * 33], s[15 * 33]);
        *(GAS v4u*)(WT + (size_t)(drow0 + n) * K + k0 + 16 * c) = o; }
    LDS_WAIT(); asm volatile("" ::: "memory");
}
struct Ptrs {
    const float *x, *p, *w_in, *b_gate, *lq1, *lk1, *lq2, *lk2, *subln, *w_abr, *w_pmix, *pscale, *w_pbr, *w_out, *ln1g, *ln1b, *w_router, *b_router, *w_up, *b_up, *w_down, *b_down, *w_pg, *w_pp, *ln2g, *ln2b;
    float* out; unsigned char* ws;
};
__device__ __forceinline__ void ph0_prologue(Frame& F, const Ptrs& P) {
    unsigned char* ws = P.ws;
    LAS float* scr = (LAS float*)(F.lds + RING_OFF + F.wave * 16384);
    const int gw = F.vcu * NWAVES + F.wave, NGW = F.G * NWAVES;
    { const size_t n4 = (size_t)M * D / 4, st = (size_t)F.G * 512; const f32x4* src = (const f32x4*)P.x; unsigned long long* dst = (unsigned long long*)(ws + WS_XB);
      unsigned* dst8 = (unsigned*)(ws + WS_XF8);
      for (size_t i = (size_t)blockIdx.x * 512 + F.tid; i < n4; i += st) { const f32x4 v = src[i]; dst[i] = (unsigned long long)pk2(v.x, v.y) | ((unsigned long long)pk2(v.z, v.w) << 32);
          if (PROJ_F8_FROM < 16) dst8[i] = pg8::pk4_fp8(v.x, v.y, v.z, v.w); } }
    constexpr int I_IN = 16 * 128, I_A = 8 * 32, I_O = 16 * 32, I_PG = 16 * 32, I_PP = 4 * 32, I_UP1 = 16 * 64, I_DN1 = 16 * 32;
    constexpr int I_UP = NEXP * I_UP1, I_DN = NEXP * I_DN1, NITEMS = I_IN + I_A + I_O + I_PG + I_PP + I_UP + I_DN;
    for (int it = gw; it < NITEMS; it += NGW) {
        int r = it;
        if (r < I_IN) { const int nb = 128, n0 = 32 * (r % nb);
            if (n0 >= 256 * PROJ_F8_FROM) p0_transpose_item_f8(P.w_in, 4096, 1024, ws + WS_WIN8, 64 * (r / nb), n0, n0 - 256 * PROJ_F8_FROM, WUP_SCALE, scr, F.lane);
            else p0_transpose_item(P.w_in, 4096, 1024, (bf16*)(ws + WS_WIN), 64 * (r / nb), n0, n0, scr, F.lane); continue; } r -= I_IN;
        if (r < I_A) { const int nb = 32; p0_transpose_item(P.w_abr, 1024, 1024, (bf16*)(ws + WS_WCAT), 64 * (r / nb), 32 * (r % nb), 32 * (r % nb), scr, F.lane); continue; } r -= I_A;
        if (r < I_O) { const int nb = 32; p0_transpose_item(P.w_out, 1024, 1024, (bf16*)(ws + WS_WOUT), 64 * (r / nb), 32 * (r % nb), 32 * (r % nb), scr, F.lane); continue; } r -= I_O;
        if (r < I_PG) { const int nb = 32; if (MOE_FP8) p0_transpose_item_f8(P.w_pg, 1024, 1024, ws + WS_WPG, 64 * (r / nb), 32 * (r % nb), 32 * (r % nb), WUP_SCALE, scr, F.lane);
            else p0_transpose_item(P.w_pg, 1024, 1024, (bf16*)(ws + WS_WPG), 64 * (r / nb), 32 * (r % nb), 32 * (r % nb), scr, F.lane); continue; } r -= I_PG;
        if (r < I_PP) { const int nb = 32; p0_transpose_item(P.w_pp, 1024, 256, (bf16*)(ws + WS_WPP), 64 * (r / nb), 32 * (r % nb), 32 * (r % nb), scr, F.lane); continue; } r -= I_PP;
        if (r < I_UP) { const int e = r / I_UP1, q = r % I_UP1, nb = 64, n0 = 32 * (q % nb);
            const int bj = n0 >> 10, pn = (n0 & 1023) >> 7, cp = n0 & 127;
            if (MOE_FP8) p0_transpose_item_f8(P.w_up + (size_t)e * 1024 * 2048, 2048, 1024, ws + WS_WUP + (size_t)e * 2048 * 1024, 64 * (q / nb), n0, 256 * pn + 128 * bj + cp, WUP_SCALE, scr, F.lane);
            else p0_transpose_item(P.w_up + (size_t)e * 1024 * 2048, 2048, 1024, (bf16*)(ws + WS_WUP) + (size_t)e * 2048 * 1024, 64 * (q / nb), n0, 256 * pn + 128 * bj + cp, scr, F.lane);
            continue; } r -= I_UP;
        { const int e = r / I_DN1, q = r % I_DN1, nb = 32;
            if (MOE_FP8) p0_transpose_item_f8(P.w_down + (size_t)e * 1024 * 1024, 1024, 1024, ws + WS_WDN + (size_t)e * 1024 * 1024, 64 * (q / nb), 32 * (q % nb), 32 * (q % nb), WDN_SCALE, scr, F.lane);
            else p0_transpose_item(P.w_down + (size_t)e * 1024 * 1024, 1024, 1024, (bf16*)(ws + WS_WDN) + (size_t)e * 1024 * 1024, 64 * (q / nb), 32 * (q % nb), 32 * (q % nb), scr, F.lane); }
    }
    { bf16* WPC = (bf16*)(ws + WS_WCAT) + 512;
      for (int k = blockIdx.x; k < 512; k += F.G) { const int g = k >> 7;
          float a0 = 0.f, a1 = 0.f; const float* wm = P.w_pmix + (size_t)k * 128; const float* sc = P.pscale + g * 128; const float* wb = P.w_pbr + (size_t)(g * 128) * 1024;
          for (int d = 0; d < 128; ++d) { const float w = wm[d] * sc[d]; a0 += w * wb[(size_t)d * 1024 + F.tid]; a1 += w * wb[(size_t)d * 1024 + 512 + F.tid]; }
          WPC[(size_t)F.tid * 1024 + k] = (bf16)f2bf(a0); WPC[(size_t)(F.tid + 512) * 1024 + k] = (bf16)f2bf(a1); } }
}
__device__ __forceinline__ void ph_pool(Frame& F, const Ptrs& P) {
    const bf16* U = (const bf16*)(P.ws + WS_U); bf16* PO = (bf16*)(P.ws + WS_APO) + 512;
    const size_t nitem = (size_t)M * 64, st = (size_t)F.G * 512;
    for (size_t idx = (size_t)blockIdx.x * 512 + F.tid; idx < nitem; idx += st) {
        const size_t row = idx >> 6; const int cg = (int)(idx & 63), c0 = cg * 8, pos = (int)(row & (SEQ - 1)), w = 2 << (c0 >> 7), n = pos + 1 < w ? pos + 1 : w;
        float s[8] = {0.f, 0.f, 0.f, 0.f, 0.f, 0.f, 0.f, 0.f}; v4u cur = *(const v4u*)(U + row * 512 + c0);
        for (int k = 0; k < n; ++k) { const v4u v = k == 0 ? cur : *(const v4u*)(U + (row - k) * 512 + c0);
            s[0] += pg8::bflo(v.x); s[1] += pg8::bfhi(v.x); s[2] += pg8::bflo(v.y); s[3] += pg8::bfhi(v.y); s[4] += pg8::bflo(v.z); s[5] += pg8::bfhi(v.z); s[6] += pg8::bflo(v.w); s[7] += pg8::bfhi(v.w); }
        const float rn = 1.f / (float)n; v4u o;
        o.x = pk2(s[0] * rn - pg8::bflo(cur.x), s[1] * rn - pg8::bfhi(cur.x)); o.y = pk2(s[2] * rn - pg8::bflo(cur.y), s[3] * rn - pg8::bfhi(cur.y));
        o.z = pk2(s[4] * rn - pg8::bflo(cur.z), s[5] * rn - pg8::bfhi(cur.z)); o.w = pk2(s[6] * rn - pg8::bflo(cur.w), s[7] * rn - pg8::bfhi(cur.w));
        *(v4u*)(PO + row * 1024 + c0) = o;
    }
}
__device__ __forceinline__ float lam_value(const Ptrs& P) { float a = 0.f, b = 0.f; for (int d = 0; d < 64; ++d) { a += P.lq1[d] * P.lk1[d]; b += P.lq2[d] * P.lk2[d]; } return __expf(a) - __expf(b) + 0.2f; }
__device__ __forceinline__ void ph_combine(Frame& F, const Ptrs& P) {
    const bf16* O16 = (const bf16*)(P.ws + WS_O16); bf16* OA = (bf16*)(P.ws + WS_APO); const float lam = lam_value(P);
    const int gw = F.vcu * NWAVES + F.wave, NGW = F.G * NWAVES, h = F.lane >> 4, e0 = (F.lane & 15) * 8;
    float sg[8];
#pragma unroll
    for (int j = 0; j < 8; ++j) sg[j] = P.subln[e0 + j] * 0.8f;
    for (int row = gw; row < M; row += NGW) {
        const v4u a = *(const v4u*)(O16 + (size_t)row * 1024 + h * 256 + e0), b = *(const v4u*)(O16 + (size_t)row * 1024 + h * 256 + 128 + e0);
        f32x4 a0, a1, b0, b1; pg8::unpack8(a, a0, a1); pg8::unpack8(b, b0, b1); a0 -= b0 * lam; a1 -= b1 * lam;
        float ss = (a0[0] * a0[0] + a0[1] * a0[1]) + (a0[2] * a0[2] + a0[3] * a0[3]) + (a1[0] * a1[0] + a1[1] * a1[1]) + (a1[2] * a1[2] + a1[3] * a1[3]);
        ss += __shfl_xor(ss, 1); ss += __shfl_xor(ss, 2); ss += __shfl_xor(ss, 4); ss += __shfl_xor(ss, 8);
        const float r = rsqrtf(ss * (1.f / 128.f) + LN_EPS);
#pragma unroll
        for (int j = 0; j < 4; ++j) { a0[j] *= r * sg[j]; a1[j] *= r * sg[4 + j]; }
        *(v4u*)(OA + (size_t)row * 1024 + h * 128 + e0) = pg8::pack8(a0, a1);
    }
}
typedef float f32x16_ __attribute__((ext_vector_type(16)));
__device__ __forceinline__ void hilo8(const f32x4& a, const f32x4& b, bf16x8& hi, bf16x8& lo) {
    unsigned h[4], l[4];
    h[0] = pg8::cvt_pk_bf16(a[0], a[1]); h[1] = pg8::cvt_pk_bf16(a[2], a[3]); h[2] = pg8::cvt_pk_bf16(b[0], b[1]); h[3] = pg8::cvt_pk_bf16(b[2], b[3]);
    l[0] = pg8::cvt_pk_bf16(a[0] - pg8::bflo(h[0]), a[1] - pg8::bfhi(h[0])); l[1] = pg8::cvt_pk_bf16(a[2] - pg8::bflo(h[1]), a[3] - pg8::bfhi(h[1]));
    l[2] = pg8::cvt_pk_bf16(b[0] - pg8::bflo(h[2]), b[1] - pg8::bfhi(h[2])); l[3] = pg8::cvt_pk_bf16(b[2] - pg8::bflo(h[3]), b[3] - pg8::bfhi(h[3]));
    v4u hv = {h[0], h[1], h[2], h[3]}, lv = {l[0], l[1], l[2], l[3]}; hi = __builtin_bit_cast(bf16x8, hv); lo = __builtin_bit_cast(bf16x8, lv);
}
__device__ __forceinline__ void ph6_ln1_route(Frame& F, const Ptrs& P, const bool dry) {
    unsigned char* ws = P.ws;
    constexpr int XT_OFF = 0, XT_PITCH = 1028, PL_OFF = 16 * XT_PITCH * 4, LG_OFF = PL_OFF + 8 * 16 * 32 * 4, RS_OFF = LG_OFF + 256 * 33 * 4;
    static_assert(RS_OFF + 256 <= RING_BYTES, "ph6 LDS map");
    { const size_t n4 = (size_t)M * PLE / 4, st = (size_t)F.G * 512; const f32x4* src = (const f32x4*)P.p; unsigned long long* dst = (unsigned long long*)(ws + (dry ? 804 * MiB : WS_PB));
      for (size_t i = (size_t)blockIdx.x * 512 + F.tid; i < n4; i += st) { const f32x4 v = src[i]; dst[i] = (unsigned long long)pk2(v.x, v.y) | ((unsigned long long)pk2(v.z, v.w) << 32); } }
    const float* X1in = P.out; float* X1 = dry ? (float*)(ws + 356 * MiB) : P.out; bf16* X1B = (bf16*)(ws + (dry ? 612 * MiB : WS_X1B)); unsigned char* X1F8 = ws + (dry ? 740 * MiB : WS_X1F8);
    const int lane = F.lane, wave = F.wave, e = lane & 31, kh = lane >> 5;
    LAS float* XT = (LAS float*)(F.lds + XT_OFF); LAS float* PL = (LAS float*)(F.lds + PL_OFF); LAS float* LG = (LAS float*)(F.lds + LG_OFF);
    bf16x8 bh[8], bl[8];
#pragma unroll
    for (int s = 0; s < 8; ++s) { const float* wp = P.w_router + (size_t)(128 * wave + 16 * s + 8 * kh) * 32 + e;
        const f32x4 a = {wp[0], wp[32], wp[64], wp[96]}, b = {wp[128], wp[160], wp[192], wp[224]}; hilo8(a, b, bh[s], bl[s]); }
    f32x4 gam[4], bet[4];
#pragma unroll
    for (int j = 0; j < 4; ++j) { gam[j] = ((const f32x4*)P.ln1g)[lane + 64 * j]; bet[j] = ((const f32x4*)P.ln1b)[lane + 64 * j]; }
    const float brt = P.b_router[e];
    for (int chunk = blockIdx.x; chunk < M / 256; chunk += F.G) {
        f32x4 v[2][4];
#pragma unroll
        for (int i = 0; i < 2; ++i)
#pragma unroll
            for (int j = 0; j < 4; ++j) v[i][j] = ((const f32x4*)(X1in + (size_t)(chunk * 256 + 2 * wave + i) * 1024))[lane + 64 * j];
#pragma unroll 1
        for (int step = 0; step < 16; ++step) {
            f32x4 nx[2][4];
            if (step < 15) {
#pragma unroll
                for (int i = 0; i < 2; ++i)
#pragma unroll
                    for (int j = 0; j < 4; ++j) nx[i][j] = ((const f32x4*)(X1in + (size_t)(chunk * 256 + (step + 1) * 16 + 2 * wave + i) * 1024))[lane + 64 * j]; }
            float s0 = 0.f, s1 = 0.f;
#pragma unroll
            for (int j = 0; j < 4; ++j) { s0 += (v[0][j].x + v[0][j].y) + (v[0][j].z + v[0][j].w); s1 += (v[1][j].x + v[1][j].y) + (v[1][j].z + v[1][j].w); }
#pragma unroll
            for (int o = 1; o < 64; o <<= 1) { s0 += __shfl_xor(s0, o); s1 += __shfl_xor(s1, o); }
            const float m0 = s0 * (1.f / 1024.f), m1 = s1 * (1.f / 1024.f); float q0 = 0.f, q1 = 0.f;
#pragma unroll
            for (int j = 0; j < 4; ++j) { v[0][j] = v[0][j] - m0; v[1][j] = v[1][j] - m1;
                q0 += (v[0][j].x * v[0][j].x + v[0][j].y * v[0][j].y) + (v[0][j].z * v[0][j].z + v[0][j].w * v[0][j].w); q1 += (v[1][j].x * v[1][j].x + v[1][j].y * v[1][j].y) + (v[1][j].z * v[1][j].z + v[1][j].w * v[1][j].w); }
#pragma unroll
            for (int o = 1; o < 64; o <<= 1) { q0 += __shfl_xor(q0, o); q1 += __shfl_xor(q1, o); }
            const float r0 = rsqrtf(q0 * (1.f / 1024.f) + LN_EPS), r1 = rsqrtf(q1 * (1.f / 1024.f) + LN_EPS);
#pragma unroll
            for (int i = 0; i < 2; ++i) { const int rl = 2 * wave + i; const size_t row = (size_t)chunk * 256 + step * 16 + rl; const float rs = i ? r1 : r0;
#pragma unroll
                for (int j = 0; j < 4; ++j) { const f32x4 y = v[i][j] * rs * gam[j] + bet[j];
                    ((f32x4*)(X1 + row * 1024))[lane + 64 * j] = y;
                    ((unsigned long long*)(X1B + row * 1024))[lane + 64 * j] = (unsigned long long)pk2(y.x, y.y) | ((unsigned long long)pk2(y.z, y.w) << 32);
                    if (MOE_FP8) ((unsigned*)(X1F8 + row * 1024))[lane + 64 * j] = pg8::pk4_fp8(y.x, y.y, y.z, y.w);
                    *(LAS f32x4*)(XT + rl * XT_PITCH + 4 * (lane + 64 * j)) = y; } }
            __syncthreads();
            f32x16_ acc = {};
#pragma unroll
            for (int s = 0; s < 8; ++s) { const LAS float* xp = XT + (lane & 15) * XT_PITCH + 128 * wave + 16 * s + 8 * kh;
                const f32x4 a = *(const LAS f32x4*)xp, b = *(const LAS f32x4*)(xp + 4); bf16x8 ah, al; hilo8(a, b, ah, al);
                acc = __builtin_amdgcn_mfma_f32_32x32x16_bf16(ah, bh[s], acc, 0, 0, 0); acc = __builtin_amdgcn_mfma_f32_32x32x16_bf16(al, bh[s], acc, 0, 0, 0); acc = __builtin_amdgcn_mfma_f32_32x32x16_bf16(ah, bl[s], acc, 0, 0, 0); }
#pragma unroll
            for (int i = 0; i < 8; ++i) PL[(wave * 16 + (i & 3) + 8 * (i >> 2) + 4 * kh) * 32 + e] = acc[i];
            __syncthreads();
            { const int row = F.tid >> 5, ee = F.tid & 31; float sum = 0.f;
#pragma unroll
              for (int w = 0; w < 8; ++w) sum += PL[(w * 16 + row) * 32 + ee];
              LG[(step * 16 + row) * 33 + ee] = sum + __shfl(brt, ee); }
            if (step < 15) {
#pragma unroll
                for (int i = 0; i < 2; ++i)
#pragma unroll
                    for (int j = 0; j < 4; ++j) v[i][j] = nx[i][j]; }
        }
        __syncthreads();
        LAS int* cntl = (LAS int*)(F.lds + RS_OFF); LAS int* basel = cntl + 32;
        if (F.tid < 32) cntl[F.tid] = 0;
        int my_e[4] = {0, 0, 0, 0}; float my_g[4] = {0.f, 0.f, 0.f, 0.f};
        if (F.tid < 256) { float lg[32];
#pragma unroll
            for (int k = 0; k < 32; ++k) lg[k] = LG[F.tid * 33 + k];
            float tv[4];
#pragma unroll
            for (int r = 0; r < 4; ++r) { float bv = lg[0]; int bi = 0;
#pragma unroll
                for (int k = 1; k < 32; ++k) if (lg[k] > bv) { bv = lg[k]; bi = k; }
                tv[r] = bv; my_e[r] = bi;
#pragma unroll
                for (int k = 0; k < 32; ++k) if (k == bi) lg[k] = -INFINITY; }
            const float e1 = __expf(tv[1] - tv[0]), e2 = __expf(tv[2] - tv[0]), e3 = __expf(tv[3] - tv[0]), rs = 1.f / (1.f + e1 + e2 + e3);
            my_g[0] = rs; my_g[1] = e1 * rs; my_g[2] = e2 * rs; my_g[3] = e3 * rs; }
        __syncthreads();
        int rk[4] = {0, 0, 0, 0};
        if (F.tid < 256) {
#pragma unroll
            for (int k = 0; k < 4; ++k) rk[k] = __hip_atomic_fetch_add(&cntl[my_e[k]], 1, __ATOMIC_RELAXED, __HIP_MEMORY_SCOPE_WORKGROUP); }
        __syncthreads();
        if (F.tid < 32) basel[F.tid] = (int)__hip_atomic_fetch_add(F.ctl + CW_CNT + (dry ? 32 : 0) + F.tid, (unsigned)cntl[F.tid], RLX_AGENT);
        __syncthreads();
        if (F.tid < 256) { const int row = chunk * 256 + F.tid; int* LIST = (int*)(ws + (dry ? 836 * MiB : WS_LIST)); float* GATEL = (float*)(ws + (dry ? 844 * MiB : WS_GATEL)); float* GATE = (float*)(ws + (dry ? 852 * MiB : WS_GATE));
#pragma unroll
            for (int k = 0; k < 4; ++k) { const size_t o = (size_t)my_e[k] * 65536 + (size_t)(basel[my_e[k]] + rk[k]); LIST[o] = row * 4 + k; GATEL[o] = my_g[k]; GATE[row * 4 + k] = my_g[k]; } }
        __syncthreads();
    }
}
__device__ __forceinline__ void ph10_final(Frame& F, const Ptrs& P, const bool dry) {
    float* dst = dry ? (float*)(P.ws + 356 * MiB) : P.out;
    const bf16* PLEB = (const bf16*)(P.ws + WS_PLE); const unsigned char* YS0 = P.ws + WS_YS0; const unsigned char* YS1 = P.ws + WS_YS1; const unsigned char* YS2 = P.ws + WS_YS2; const unsigned char* YS3 = P.ws + WS_YS3;
    const int gw = F.vcu * NWAVES + F.wave, NGW = F.G * NWAVES, lane = F.lane;
    f32x4 gam[4], bet[4];
#pragma unroll
    for (int j = 0; j < 4; ++j) { gam[j] = ((const f32x4*)P.ln2g)[lane + 64 * j]; bet[j] = ((const f32x4*)P.ln2b)[lane + 64 * j]; }
    for (int row = gw; row < M; row += NGW) {
        f32x4 v[4]; float s = 0.f;
#pragma unroll
        for (int j = 0; j < 4; ++j) { const size_t o = (size_t)row * 256 + lane + 64 * j; v[j] = ((const f32x4*)P.out)[o] * ALPHA;
            { const unsigned long long e = ((const unsigned long long*)PLEB)[o]; const unsigned e0 = (unsigned)e, e1 = (unsigned)(e >> 32); v[j].x += pg8::bflo(e0); v[j].y += pg8::bfhi(e0); v[j].z += pg8::bflo(e1); v[j].w += pg8::bfhi(e1); }
            { const unsigned a = ((const unsigned*)YS0)[o], b = ((const unsigned*)YS1)[o], c = ((const unsigned*)YS2)[o], d = ((const unsigned*)YS3)[o]; constexpr float is = 1.f / YS_SCALE;
              typedef float f32x2_ __attribute__((ext_vector_type(2)));
              const f32x2_ a0 = __builtin_amdgcn_cvt_pk_f32_fp8(a, false), a1 = __builtin_amdgcn_cvt_pk_f32_fp8(a, true), b0 = __builtin_amdgcn_cvt_pk_f32_fp8(b, false), b1 = __builtin_amdgcn_cvt_pk_f32_fp8(b, true);
              const f32x2_ c0 = __builtin_amdgcn_cvt_pk_f32_fp8(c, false), c1 = __builtin_amdgcn_cvt_pk_f32_fp8(c, true), d0 = __builtin_amdgcn_cvt_pk_f32_fp8(d, false), d1 = __builtin_amdgcn_cvt_pk_f32_fp8(d, true);
              v[j].x += ((a0[0] + b0[0]) + (c0[0] + d0[0])) * is; v[j].y += ((a0[1] + b0[1]) + (c0[1] + d0[1])) * is; v[j].z += ((a1[0] + b1[0]) + (c1[0] + d1[0])) * is; v[j].w += ((a1[1] + b1[1]) + (c1[1] + d1[1])) * is; }
            s += (v[j].x + v[j].y) + (v[j].z + v[j].w); }
        const float mean = wave_sum(s) * (1.f / 1024.f); float s2 = 0.f;
#pragma unroll
        for (int j = 0; j < 4; ++j) { v[j] = v[j] - mean; s2 += (v[j].x * v[j].x + v[j].y * v[j].y) + (v[j].z * v[j].z + v[j].w * v[j].w); }
        const float rstd = rsqrtf(wave_sum(s2) * (1.f / 1024.f) + LN_EPS);
#pragma unroll
        for (int j = 0; j < 4; ++j) ((f32x4*)dst)[(size_t)row * 256 + lane + 64 * j] = v[j] * rstd * gam[j] + bet[j];
    }
}
__device__ __forceinline__ void moe_tables(Frame& F) {
    LAS int* cnt = (LAS int*)(F.lds + pg8::TAB_CNT); LAS int* blk0 = (LAS int*)(F.lds + pg8::TAB_BLK0); LAS int* row0 = (LAS int*)(F.lds + pg8::TAB_ROW0);
    __syncthreads();
    if (F.tid < 32) cnt[F.tid] = (int)__hip_atomic_load(F.ctl + CW_CNT + F.tid, RLX_AGENT);
    __syncthreads();
    if (F.tid == 0) { int b = 0, r = 0; for (int e = 0; e < 32; ++e) { blk0[e] = b; row0[e] = r; b += (cnt[e] + 255) >> 8; r += cnt[e]; } blk0[32] = b; row0[32] = r; }
    __syncthreads();
}

constexpr int NPHASE = 11;
struct Args { Ptrs P; int ph_lo, ph_hi; };
__global__ void __launch_bounds__(NWAVES * 64, 2) mk_fwd(Args args) {
    extern __shared__ __attribute__((aligned(16))) unsigned char lds[];
    Frame F; const Ptrs& P = args.P;
    F.lds = (LAS unsigned char*)lds; F.MISC = (volatile LAS unsigned*)(F.lds + MISC_OFF);
    F.wave = __builtin_amdgcn_readfirstlane(threadIdx.x >> 6); F.lane = lane_id(); F.tid = F.wave * 64 + F.lane;
#define REFRESH() do { F.lane = lane_id(); asm volatile("" : "+v"(F.lane)); F.tid = F.wave * 64 + F.lane; } while (0)
    F.G = gridDim.x; { const int bx = blockIdx.x; F.vcu = (F.G % 8 == 0) ? (bx % 8) * (F.G / 8) + bx / 8 : bx; }
    unsigned char* ws = P.ws; F.ctl = (gu32*)(ws + WS_CTL);
    for (int u = F.tid; u < 1024 / 4; u += NWAVES * 64) ((LAS unsigned*)(F.lds + LDSCTL_OFF))[u] = 0u;
    __syncthreads();
    const int lo = args.ph_lo, hi = args.ph_hi;
    XcdBarrier bar = xcd_barrier_post((unsigned*)(F.ctl + CW_BAR) + lo * XCD_BAR_WORDS, F.MISC + 8);
#ifndef PH_COMPILE
#define PH_COMPILE 0x7ff
#endif
#define IN(k) ((((PH_COMPILE) >> (k)) & 1) && lo <= (k) && (k) < hi)
#define SEAM(k) do { if (IN(k) && IN((k) + 1)) xcd_barrier(bar); } while (0)
#ifndef REP2_MASK
#define REP2_MASK 0
#endif
#define REPS(k) for (int rep_ = 0; rep_ < ((((REP2_MASK) >> (k)) & 1) ? 2 : 1); ++rep_)
    bf16 *XB = (bf16*)(ws + WS_XB), *Q = (bf16*)(ws + WS_Q), *K = (bf16*)(ws + WS_K), *V = (bf16*)(ws + WS_V), *U = (bf16*)(ws + WS_U), *G = (bf16*)(ws + WS_G);
    bf16 *O16 = (bf16*)(ws + WS_O16), *APO = (bf16*)(ws + WS_APO), *MIX = (bf16*)(ws + WS_MIX), *X1B = (bf16*)(ws + WS_X1B), *HB = (bf16*)(ws + WS_HB), *PB = (bf16*)(ws + WS_PB);
    bf16* T = (bf16*)(ws + WS_T);

    if (IN(0)) REPS(0) { REFRESH(); ph0_prologue(F, P); } SEAM(0);
    if (IN(1)) REPS(1) {
        { pg8::Gemm g{XB, (const bf16*)(ws + WS_WIN), 1024}; pg8::StaticOrder S; S.init(M, 256 * (PROJ_F8_FROM < 16 ? PROJ_F8_FROM : 16), F.G, (int)blockIdx.x);
          pg8::EpiProj E{Q, K, V, U, G, P.b_gate, (float*)(F.ctl + CW_PN), C2Q, 1.f, 0, 0};
          pg8::gemm_phase(F.lds, F.wave, g, S, E); }
        if (PROJ_F8_FROM < 16) {
          pg8::Gemm g{(const bf16*)(ws + WS_XF8), (const bf16*)(ws + WS_WIN8), 512}; pg8::DenseF8Order S; S.init(M, 256 * (16 - PROJ_F8_FROM), F.G, (int)blockIdx.x);
          pg8::EpiProj E{Q, K, V, U, G, P.b_gate, (float*)(F.ctl + CW_PN), C2Q, 1.f / WUP_SCALE, PROJ_F8_FROM, 0};
          pg8::gemm_phase(F.lds, F.wave, g, S, E); }
    } SEAM(1);
    if (IN(2)) REPS(2) {
        const attn_body::AttnTensors AT{(const attn_body::bf16*)Q, (const attn_body::bf16*)K, (const attn_body::bf16*)V, (attn_body::bf16*)O16, (const float*)(F.ctl + CW_PN), (unsigned*)(F.ctl + CW_AQ)};
        attn_body::attn_phase<-1>((char*)lds + RING_OFF, AT, F.wave);
#ifdef TIME_PH2
        { attn_body::AttnTensors AT2 = AT; AT2.queue = (unsigned*)(F.ctl + CW_AQ + 64); attn_body::attn_phase<-1>((char*)lds + RING_OFF, AT2, F.wave); }
#endif
#ifndef NO_POOL
        REFRESH(); ph_pool(F, P);
#endif
    } SEAM(2);
    if (IN(3)) REPS(3) { REFRESH(); ph_combine(F, P); } SEAM(3);
    if (IN(4)) REPS(4) {
        pg8::StaticOrder S; S.init(M, 1024, F.G, (int)blockIdx.x);
        pg8::Gemm g{APO, (const bf16*)(ws + WS_WCAT), 1024}; pg8::EpiMixCat E{MIX, G}; pg8::gemm_phase(F.lds, F.wave, g, S, E);
    } SEAM(4);
    if (IN(5)) REPS(5) {
        pg8::Gemm g{MIX, (const bf16*)(ws + WS_WOUT), 1024}; pg8::StaticOrder S; S.init(M, 1024, F.G, (int)blockIdx.x);
        pg8::EpiF32<0> E{P.out, P.x, ALPHA, 1.f};
        pg8::gemm_phase(F.lds, F.wave, g, S, E);
    } SEAM(5);
#ifndef DRY_MASK
#define DRY_MASK 0
#endif
    if (IN(6)) { if ((DRY_MASK >> 6) & 1) { REFRESH(); ph6_ln1_route(F, P, true); } REFRESH(); ph6_ln1_route(F, P, false); } SEAM(6);
    if (IN(7)) REPS(7) {
        pg8::StaticOrder S; S.init(M, 1024, F.G, (int)blockIdx.x);
#ifndef NO_PH7A
        { pg8::Gemm g{PB, (const bf16*)(ws + WS_WPP), 256}; pg8::EpiF32<1> E{(float*)T, nullptr, 0.f, 1.f}; pg8::gemm_phase(F.lds, F.wave, g, S, E); }
#endif
        VM_WAIT(); __syncthreads();
#ifndef NO_PH7B
        if (MOE_FP8) { pg8::DenseF8Order S8; S8.init(M, 1024, F.G, (int)blockIdx.x);
            pg8::Gemm g{(const bf16*)(ws + WS_X1F8), (const bf16*)(ws + WS_WPG), 512}; pg8::EpiF32<3> E{(float*)(ws + WS_PLE), (const float*)T, ALPHA, 1.f / WUP_SCALE}; pg8::gemm_phase(F.lds, F.wave, g, S8, E); }
        else { pg8::Gemm g{X1B, (const bf16*)(ws + WS_WPG), 1024}; pg8::EpiF32<3> E{(float*)(ws + WS_PLE), (const float*)T, ALPHA, 1.f}; pg8::gemm_phase(F.lds, F.wave, g, S, E); }
#endif
    } SEAM(7);
    if (IN(8)) REPS(8) {
        REFRESH(); moe_tables(F);
        pg8::Gemm g{MOE_FP8 ? (const bf16*)(ws + WS_X1F8) : X1B, (const bf16*)(ws + WS_WUP), MOE_FP8 ? 512 : 1024};
        pg8::MoeOrder<true, MOE_FP8> S{8, F.G, (int)blockIdx.x, (const int*)(ws + WS_LIST), (const float*)(ws + WS_GATEL), (size_t)2048 * 1024 * (MOE_FP8 ? 1 : 2)};
        pg8::EpiUp<MOE_FP8> E{HB, P.b_up, MOE_FP8 ? 1.f / WUP_SCALE : 1.f, 0};
        pg8::gemm_phase(F.lds, F.wave, g, S, E);
    } SEAM(8);
    if (IN(9)) REPS(9) {
        REFRESH(); moe_tables(F);
        pg8::Gemm g{HB, (const bf16*)(ws + WS_WDN), MOE_FP8 ? 512 : 1024};
        pg8::MoeOrder<false, MOE_FP8> S{4, F.G, (int)blockIdx.x, (const int*)(ws + WS_LIST), (const float*)(ws + WS_GATEL), (size_t)1024 * 1024 * (MOE_FP8 ? 1 : 2)};
        pg8::EpiDown E{ws + WS_YS0, ws + WS_YS1, ws + WS_YS2, ws + WS_YS3, P.b_down, MOE_FP8 ? 1.f / (WDN_SCALE) : 1.f, YS_SCALE};
        pg8::gemm_phase(F.lds, F.wave, g, S, E);
    } SEAM(9);
    if (IN(10)) { if ((DRY_MASK >> 10) & 1) { REFRESH(); ph10_final(F, P, true); } REFRESH(); ph10_final(F, P, false); }
#undef IN
#undef SEAM
}
#ifndef FAST_MASK
#define FAST_MASK 0x7ff
#endif
#ifndef MERGE_FAST
#define MERGE_FAST 1
#endif
extern "C" void kernel_launch(void* const* d_in, const int* in_sizes, int n_in, void* d_out, int out_size, void* d_ws, size_t ws_size, hipStream_t stream) {
    static int grid = 0;
    if (grid == 0) {
        if (n_in != 26 || ws_size < WS_END || out_size != M * D) { fprintf(stderr, "kernel_launch: unexpected shapes (n_in %d, ws %zu, out %d)\n", n_in, ws_size, out_size); grid = -1; return; }
        int dev = 0, cus = 0, per_cu = 0;
        if (hipGetDevice(&dev) != hipSuccess || hipDeviceGetAttribute(&cus, hipDeviceAttributeMultiprocessorCount, dev) != hipSuccess) { grid = -1; return; }
        if (hipFuncSetAttribute((const void*)mk_fwd, hipFuncAttributeMaxDynamicSharedMemorySize, LDS_BYTES) != hipSuccess) { fprintf(stderr, "kernel_launch: hipFuncSetAttribute failed\n"); grid = -1; return; }
        if (hipOccupancyMaxActiveBlocksPerMultiprocessor(&per_cu, (const void*)mk_fwd, NWAVES * 64, LDS_BYTES) != hipSuccess || per_cu < 1) fprintf(stderr, "kernel_launch: occupancy query says %d\n", per_cu);
        (void)hipGetLastError();
        grid = cus;
    }
    if (grid < 0) return;
    Ptrs P{};
    { const float** pp = (const float**)&P; for (int i = 0; i < 26; ++i) pp[i] = (const float*)d_in[i]; }
    P.out = (float*)d_out; P.ws = (unsigned char*)d_ws;
    unsigned char* ws = (unsigned char*)d_ws; float* out = (float*)d_out;
    unsigned* CTL = (unsigned*)(ws + WS_CTL); unsigned* CNT = CTL + CW_CNT; int* LIST = (int*)(ws + WS_LIST); float* GATE = (float*)(ws + WS_GATE); float* GATEL = (float*)(ws + WS_GATEL); float* WPCF = (float*)(ws + WS_WPCF);
    bf16 *XB = (bf16*)(ws + WS_XB), *PB = (bf16*)(ws + WS_PB), *Q = (bf16*)(ws + WS_Q), *K = (bf16*)(ws + WS_K), *V = (bf16*)(ws + WS_V), *U = (bf16*)(ws + WS_U), *G = (bf16*)(ws + WS_G);
    bf16 *O16 = (bf16*)(ws + WS_O16), *OA = (bf16*)(ws + WS_APO), *PO = (bf16*)(ws + WS_APO) + 512, *MIX = (bf16*)(ws + WS_MIX), *X1B = (bf16*)(ws + WS_X1B), *HB = (bf16*)(ws + WS_HB);
    bf16 *YS1 = (bf16*)(ws + WS_YS1), *YS2 = (bf16*)(ws + WS_YS2), *YS3 = (bf16*)(ws + WS_YS3); bf16* T = (bf16*)(ws + WS_T);
    (void)hipMemsetAsync(ws + WS_CTL, 0, CTL_ZERO_BYTES, stream);
    const unsigned fm = FAST_MASK;
    for (int ph = 0; ph < NPHASE;) {
        if ((fm >> ph) & 1u) {
            int hi = ph + 1; if (MERGE_FAST) while (hi < NPHASE && ((fm >> hi) & 1u)) ++hi;
            Args a{}; a.P = P; a.ph_lo = ph; a.ph_hi = hi;
            hipLaunchKernelGGL(mk_fwd, dim3(grid), dim3(NWAVES * 64), LDS_BYTES, stream, a);
            if (fm != 0x7ffu && ph == 0) { nv::k_fold_pool<<<512, 256, 0, stream>>>(P.w_pmix, P.pscale, P.w_pbr, WPCF); }
            ph = hi; continue;
        }
        switch (ph) {
        case 0: nv::k_cvt_bf16<<<2048, 256, 0, stream>>>(P.x, XB, (size_t)M * D / 4); nv::k_fold_pool<<<512, 256, 0, stream>>>(P.w_pmix, P.pscale, P.w_pbr, WPCF); break;
        case 1: nv::k_gemm<false><<<dim3(4096 / 64, M / 64, 1), 256, 0, stream>>>(nv::RowDense{XB, 1024, 0}, nv::EpiProj{Q, K, V, U, G, P.b_gate, C2Q, 0}, P.w_in, 0, 4096, 1024, 0, 0); break;
        case 2: nv::k_attn<<<dim3(SEQ / 256, 16, BATCH), 256, 0, stream>>>(Q, K, V, O16); nv::k_pool<<<(unsigned)((size_t)M * 512 / 256), 256, 0, stream>>>(U, PO); break;
        case 3: nv::k_combine<<<M / 4, 256, 0, stream>>>(O16, OA, P.lq1, P.lk1, P.lq2, P.lk2, P.subln); break;
        case 4: nv::k_gemm<false><<<dim3(1024 / 64, M / 64, 1), 256, 0, stream>>>(nv::RowDense{OA, 1024, 0}, nv::EpiMixA{MIX, G}, P.w_abr, 0, 1024, 512, 0, 0);
                nv::k_gemm<false><<<dim3(1024 / 64, M / 64, 1), 256, 0, stream>>>(nv::RowDense{PO, 1024, 0}, nv::EpiMixB{MIX, G}, WPCF, 0, 1024, 512, 0, 0); break;
        case 5: nv::k_gemm<false><<<dim3(1024 / 64, M / 64, 1), 256, 0, stream>>>(nv::RowDense{MIX, 1024, 0}, nv::EpiPre1{out, P.x, ALPHA, 0}, P.w_out, 0, 1024, 1024, 0, 0); break;
        case 6: nv::k_ln1_route<<<M, 256, 0, stream>>>(out, X1B, P.ln1g, P.ln1b, P.w_router, P.b_router, CNT, LIST, GATE, GATEL);
                nv::k_cvt_bf16<<<2048, 256, 0, stream>>>(P.p, PB, (size_t)M * PLE / 4); break;
        case 7: nv::k_gemm<false><<<dim3(1024 / 64, M / 64, 1), 256, 0, stream>>>(nv::RowDense{PB, 256, 0}, nv::EpiStoreF32{T}, P.w_pp, 0, 1024, 256, 0, 0);
                nv::k_gemm<false><<<dim3(1024 / 64, M / 64, 1), 256, 0, stream>>>(nv::RowDense{X1B, 1024, 0}, nv::EpiBase{out, T, ALPHA, 0}, P.w_pg, 0, 1024, 1024, 0, 0); break;
        case 8: nv::k_gemm<true><<<dim3(1024 / 64, M / 64, NEXP), 256, 0, stream>>>(nv::RowGather{X1B, LIST, CNT}, nv::EpiUp{HB, P.b_up, CNT}, P.w_up, (size_t)1024 * 2048, 2048, 1024, 1024, 0); break;
        case 9: nv::k_gemm<false><<<dim3(1024 / 64, M / 64, NEXP), 256, 0, stream>>>(nv::RowSlots{HB, CNT}, nv::EpiDown{out, YS1, YS2, YS3, P.b_down, LIST, GATE, CNT}, P.w_down, (size_t)1024 * 1024, 1024, 1024, 0, 0); break;
        case 10: nv::k_final<<<M, 256, 0, stream>>>(out, YS1, YS2, YS3, P.ln2g, P.ln2b); break;
        }
        ++ph;
    }
}
```

```cpp
#include <hip/hip_runtime.h>
#include <hip/hip_bf16.h>
#include <cstdio>
#include <cstdint>
#include <cmath>

#define GAS __attribute__((address_space(1)))
#define LAS __attribute__((address_space(3)))
typedef unsigned short bf16;
typedef unsigned v4u __attribute__((ext_vector_type(4)));
typedef float f32x4 __attribute__((ext_vector_type(4)));
typedef short bf16x8 __attribute__((ext_vector_type(8)));
typedef GAS unsigned gu32;
typedef GAS unsigned long long gu64;
#define RLX_AGENT __ATOMIC_RELAXED, __HIP_MEMORY_SCOPE_AGENT
#define LDS_WAIT() asm volatile("s_waitcnt lgkmcnt(0)" ::: "memory")
#define VM_WAIT() asm volatile("s_waitcnt vmcnt(0)" ::: "memory")
__device__ __forceinline__ unsigned f2bf(float f) { unsigned u = __builtin_bit_cast(unsigned, f); return (u + 0x7fffu + ((u >> 16) & 1u)) >> 16; }
__device__ __forceinline__ unsigned pk2(float lo, float hi) { return f2bf(lo) | (f2bf(hi) << 16); }

__device__ __forceinline__ int lane_id() { return (int)__builtin_amdgcn_mbcnt_hi(~0u, __builtin_amdgcn_mbcnt_lo(~0u, 0u)); }

constexpr int BATCH = 16, SEQ = 4096, D = 1024, M = BATCH * SEQ;
constexpr int NEXP = 32, TOPK = 4, NASSIGN = M * TOPK, FF = 1024, PLE = 256;
constexpr float LN_EPS = 1e-5f;
constexpr float ALPHA = 1.189207115002721f;
constexpr float C2Q = 0.125f * 1.4426950408889634f;

constexpr size_t MiB = 1u << 20;
constexpr size_t WS_CTL = 0, CTL_ZERO_BYTES = 1 * MiB;
constexpr size_t WS_LIST = 1 * MiB;
constexpr size_t WS_GATEL = 9 * MiB;
constexpr size_t WS_GATE = 17 * MiB;
constexpr size_t WS_WPCF = 18 * MiB;
constexpr size_t WS_WIN = 20 * MiB, WS_WCAT = 28 * MiB, WS_WOUT = 30 * MiB, WS_WPG = 32 * MiB, WS_WPP = 34 * MiB;
constexpr size_t WS_WDN = 36 * MiB, WS_WUP = 100 * MiB;
constexpr size_t WS_APO = 228 * MiB;
constexpr size_t WS_X1B = 228 * MiB;
constexpr size_t WS_Q = 356 * MiB, WS_K = 420 * MiB, WS_V = 484 * MiB, WS_U = 548 * MiB;
constexpr size_t WS_G = 612 * MiB;
constexpr size_t WS_O16 = 868 * MiB;
constexpr size_t WS_MIX = 356 * MiB;
constexpr size_t WS_HB = 356 * MiB;
constexpr size_t WS_YS = 100 * MiB, YS_STRIDE = 64 * MiB;
constexpr size_t WS_PRE1B = 612 * MiB;
constexpr size_t WS_STAT = 18 * MiB;
constexpr size_t WS_X1F8 = 900 * MiB;
constexpr size_t WS_PLE = 740 * MiB;
constexpr size_t WS_END = 1024 * MiB;
#ifndef MOE_FP8
#define MOE_FP8 1
#endif
constexpr float WUP_SCALE = 32.f, WDN_SCALE = 64.f;
#ifndef PROJ_F8_FROM
#define PROJ_F8_FROM 8
#endif
constexpr size_t WS_XF8 = 900 * MiB;
constexpr size_t WS_WIN8 = WS_WIN + (size_t)PROJ_F8_FROM * 256 * 1024 * 2;
#ifndef MIXG_FP8
#define MIXG_FP8 1
#endif
constexpr float APO_SCALE = 16.f;
constexpr float YS_SCALE = 16.f;
constexpr int cv_NBG = 790 + 64 + M / 256;
constexpr float ATT_SKIP = 40.f;
constexpr int CW_TMO = 0, CW_CODE = 1;
constexpr int CW_CNT = 64;
constexpr int CW_AQ = 128;
constexpr int CW_PN = 65536;
constexpr int CW_BAR = 4096;
namespace pg8 {
#define PG8_LAS __attribute__((address_space(3)))
typedef unsigned short bf16_t;
typedef unsigned u32x4 __attribute__((ext_vector_type(4)));
typedef float f32x2 __attribute__((ext_vector_type(2)));
constexpr int BM = 256, BK = 64, HALF = 128, HTB = HALF * BK * 2  , STAGE_BYTES = 8 * HTB, NXCD = 8, WGM = 8;
constexpr int TAB_OFF = 131072 + 1024;
constexpr int TAB_CNT = TAB_OFF, TAB_BLK0 = TAB_OFF + 128, TAB_ROW0 = TAB_OFF + 384, TAB_IDS = TAB_OFF + 1024, TAB_GATES = TAB_OFF + 1024 + 2048, TAB_BIAS = TAB_OFF + 1024 + 4096;

__host__ __device__ __forceinline__ int lds_byte(int r, int c) { const int st = (r >> 4) * 2 + (c >> 5), rr = r & 15, cc = c & 31, ob = rr * 64 + cc * 2; return st * 1024 + (ob ^ (((ob >> 9) & 1) << 5)); }
__host__ __device__ __forceinline__ void stage_rc(int b, int& R, int& C) { const int st = b / 1024, sb = b % 1024, swz = sb ^ (((sb >> 9) & 1) << 5); R = (st >> 1) * 16 + swz / 64; C = (st & 1) * 32 + (swz % 64) / 2; }
__host__ __device__ __forceinline__ int perm16h(int rho) { return 64 * (rho >> 5) + 16 * ((rho & 15) >> 2) + 4 * ((rho >> 4) & 1) + (rho & 3); }
__host__ __device__ __forceinline__ int perm32(int rho) { const int n = rho >> 4, i = rho & 15; return 8 * (i >> 2) + 4 * n + (i & 3); }

struct Unit { int pm, pn, e, nvalid; };
struct Gemm { const bf16_t* A; const bf16_t* Bt; int K; };

struct StaticOrder {
    static constexpr bool TABLES = false, FP8 = false;
    int nM, nN, nwg, G, c;
    __host__ __device__ void init(int M, int N, int G_, int c_) { nM = M / BM; nN = N / BM; nwg = nM * nN; G = G_; c = c_; }
    __device__ __forceinline__ bool next(int i, Unit& u, PG8_LAS unsigned char*) const {
        const long L = (long)i * G + c; if (L >= nwg) return false;
        int wgid = (int)L; { const int q = nwg / NXCD, r = nwg % NXCD, xcd = wgid % NXCD, off = wgid / NXCD; wgid = (xcd < r ? xcd * (q + 1) : r * (q + 1) + (xcd - r) * q) + off; }
        const int nig = WGM * nN, gid = wgid / nig, fm = gid * WGM, gsz = (nM - fm) < WGM ? (nM - fm) : WGM;
        u.pm = fm + ((wgid % nig) % gsz); u.pn = (wgid % nig) / gsz; u.e = 0; u.nvalid = 256; return true;
    }
    __device__ __forceinline__ const char* b_tile(const Gemm& g, const Unit& u) const { return (const char*)g.Bt + (size_t)u.pn * (size_t)(BM * 2) * g.K; }
    __device__ __forceinline__ void a_offsets(const Gemm& g, const Unit& u, PG8_LAS unsigned char*, int, const int (&R)[2], const int (&C)[2], unsigned (&off)[2][2]) const {
#pragma unroll
        for (int h = 0; h < 2; ++h)
#pragma unroll
            for (int i = 0; i < 2; ++i) off[h][i] = (unsigned)(((u.pm * BM + h * HALF + R[i]) * g.K + C[i]) * 2);
    }
    __device__ __forceinline__ void issue_tables(const Unit&, PG8_LAS unsigned char*, int, int) const {}
};

struct DenseF8Order : StaticOrder { static constexpr bool FP8 = true; };

template <bool GATHER_, bool FP8_> struct MoeOrder {
    static constexpr bool TABLES = true; static constexpr bool GATHER = GATHER_, FP8 = FP8_;
    int NT, G, c; const int* LIST; const float* GATEL; size_t bstride; const float* bias;
    __device__ __forceinline__ bool next(int i, Unit& u, PG8_LAS unsigned char* lds) const {
        const PG8_LAS int* cnt = (const PG8_LAS int*)(lds + TAB_CNT); const PG8_LAS int* blk0 = (const PG8_LAS int*)(lds + TAB_BLK0);
        int cp = c; if (G == 256) cp = NT == 8 ? (((c & 7) + 8 * (c >> 6)) * 8 + ((c >> 3) & 7)) : (((c & 7) + 8 * (c >> 5)) * 4 + ((c >> 3) & 3));
        const int L = i * G + cp; const int total = blk0[32] * NT; if (L >= total) return false;
        const int blk = L / NT;
        const int ln = (int)__builtin_amdgcn_mbcnt_hi(~0u, __builtin_amdgcn_mbcnt_lo(~0u, 0u)); const int bv = blk0[ln & 31];
        const int e = __builtin_popcountll(__builtin_amdgcn_ballot_w64(ln >= 1 && ln < 32 && blk >= bv));
        u.e = e; u.pm = __builtin_amdgcn_readfirstlane(blk - blk0[e]); u.pn = L % NT; const int left = __builtin_amdgcn_readfirstlane(cnt[e]) - 256 * u.pm; u.nvalid = left < 256 ? left : 256; return true;
    }
    __device__ __forceinline__ const char* b_tile(const Gemm& g, const Unit& u) const { return (const char*)g.Bt + (size_t)u.e * bstride + (size_t)u.pn * (size_t)(BM * 2) * g.K; }
    __device__ __forceinline__ void a_offsets(const Gemm& g, const Unit& u, PG8_LAS unsigned char* lds, int buf, const int (&R)[2], const int (&C)[2], unsigned (&off)[2][2]) const {
        const PG8_LAS int* ids = (const PG8_LAS int*)(lds + TAB_IDS) + buf * 256; const PG8_LAS int* row0 = (const PG8_LAS int*)(lds + TAB_ROW0);
#pragma unroll
        for (int h = 0; h < 2; ++h)
#pragma unroll
            for (int i = 0; i < 2; ++i) { const int r = h * HALF + R[i];
                if (GATHER) { const int tok = (r < u.nvalid) ? (ids[r] >> 2) : 0; off[h][i] = (unsigned)((tok * g.K + C[i]) * 2); }
                else off[h][i] = (unsigned)(((row0[u.e] + u.pm * BM + r) * g.K + C[i]) * 2); }
    }
    __device__ __forceinline__ void issue_tables(const Unit& u, PG8_LAS unsigned char* lds, int buf, int lane) const {
        const size_t o = (size_t)u.e * 65536 + (size_t)u.pm * 256 + lane * 4;
        __builtin_amdgcn_global_load_lds((const unsigned*)(LIST + o), (PG8_LAS unsigned*)(lds + TAB_IDS + buf * 1024), 16, 0, 0);
        if (!GATHER) __builtin_amdgcn_global_load_lds((const unsigned*)(GATEL + o), (PG8_LAS unsigned*)(lds + TAB_GATES + buf * 1024), 16, 0, 0);
        const float* bsrc = GATHER ? bias + (size_t)u.e * 2048 + (lane >> 5) * 1024 + u.pn * 128 + (lane & 31) * 4 : bias + (size_t)u.e * 1024 + u.pn * 256 + lane * 4;
        __builtin_amdgcn_global_load_lds((const unsigned*)bsrc, (PG8_LAS unsigned*)(lds + TAB_BIAS + buf * 1024), 16, 0, 0);
    }
};

__device__ __forceinline__ unsigned cvt_pk_bf16(float lo, float hi) { unsigned r; asm volatile("v_cvt_pk_bf16_f32 %0, %1, %2" : "=v"(r) : "v"(lo), "v"(hi)); return r; }
__device__ __forceinline__ float bflo(unsigned w) { return __builtin_bit_cast(float, w << 16); }
__device__ __forceinline__ float bfhi(unsigned w) { return __builtin_bit_cast(float, w & 0xffff0000u); }
__device__ __forceinline__ float sigm(float v) { return __builtin_amdgcn_rcpf(1.f + __builtin_amdgcn_exp2f(-1.4426950408889634f * v)); }
__device__ __forceinline__ u32x4 pack8(const f32x4& v0, const f32x4& v1) { u32x4 w; w.x = cvt_pk_bf16(v0[0], v0[1]); w.y = cvt_pk_bf16(v0[2], v0[3]); w.z = cvt_pk_bf16(v1[0], v1[1]); w.w = cvt_pk_bf16(v1[2], v1[3]); return w; }
__device__ __forceinline__ void unpack8(const u32x4& w, f32x4& v0, f32x4& v1) { v0 = (f32x4){bflo(w.x), bfhi(w.x), bflo(w.y), bfhi(w.y)}; v1 = (f32x4){bflo(w.z), bfhi(w.z), bflo(w.w), bfhi(w.w)}; }
typedef f32x4 Acc[2][2][4][2];
typedef int i32x4 __attribute__((ext_vector_type(4)));
typedef int i32x8 __attribute__((ext_vector_type(8)));
struct bf16x8p { bf16x8 k[2]; };
template <bool F8> struct Frag { typedef bf16x8p T; };
template <> struct Frag<true> { typedef i32x8 T; };
__device__ __forceinline__ void frag_set(i32x8& d, const i32x4& lo, const i32x4& hi) { d = __builtin_shufflevector(lo, hi, 0, 1, 2, 3, 4, 5, 6, 7); }
__device__ __forceinline__ void frag_set(bf16x8p& d, const bf16x8& lo, const bf16x8& hi) { d.k[0] = lo; d.k[1] = hi; }
__device__ __forceinline__ void frag_mma(f32x4& c, const i32x8& b, const i32x8& a) { c = __builtin_amdgcn_mfma_scale_f32_16x16x128_f8f6f4(b, a, c, 0, 0, 0, 0, 0, 0); }
__device__ __forceinline__ void frag_mma(f32x4& c, const bf16x8p& b, const bf16x8p& a) { c = __builtin_amdgcn_mfma_f32_16x16x32_bf16(b.k[0], a.k[0], c, 0, 0, 0); c = __builtin_amdgcn_mfma_f32_16x16x32_bf16(b.k[1], a.k[1], c, 0, 0, 0); }
__device__ __forceinline__ unsigned pk4_fp8(float a, float b, float c, float d) { unsigned w = __builtin_amdgcn_cvt_pk_fp8_f32(a, b, 0u, false); return __builtin_amdgcn_cvt_pk_fp8_f32(c, d, w, true); }
template <class E> struct has_p16 { template <class T> static constexpr bool f(decltype(T::PERM16)*) { return T::PERM16; } template <class T> static constexpr bool f(...) { return false; } static constexpr bool value = f<E>(nullptr); };
template <class E> struct has_mid { template <class T> static constexpr bool f(decltype(T::MID)*) { return T::MID; } template <class T> static constexpr bool f(...) { return false; } static constexpr bool value = f<E>(nullptr); };

struct EpiProj {
    static constexpr bool PERM = true; static constexpr int NSTORES = 16;
    bf16_t *Q, *K, *V, *U, *G; const float* bg; float* PN; float c2; float dsc; int pn_base; int pad;
    __device__ __forceinline__ void operator()(const Acc& acc, const Unit& u, int wr, int wc, int fr_, int fq_, PG8_LAS unsigned char* lds, int) const {
        int fr = fr_, fq = fq_; asm volatile("" : "+v"(fr), "+v"(fq));
        const int pn = u.pn + pn_base; const int row0 = u.pm * BM + wr * 64 + fr; const bool isg = pn >= 8;
        bf16_t* base; int ldc, colt, bjs; float sc = dsc;
        if (isg) { base = G; ldc = 2048; colt = (pn - 8) * HALF; bjs = 1024; } else { const int t = pn >> 1; base = t == 0 ? Q : t == 1 ? K : t == 2 ? V : U; ldc = 512; colt = (pn & 1) * BM; bjs = HALF; if (t == 0) sc = c2 * dsc; }
        const int col0 = colt + wc * 32 + 8 * fq;
        f32x4 bv[2][2];
#pragma unroll
        for (int bj = 0; bj < 2; ++bj)
#pragma unroll
            for (int n = 0; n < 2; ++n) bv[bj][n] = isg ? *(const PG8_LAS f32x4*)((const PG8_LAS float*)(lds + TAB_OFF) + col0 + bj * bjs + 4 * n) : (f32x4){0.f, 0.f, 0.f, 0.f};
#pragma unroll
        for (int ai = 0; ai < 2; ++ai)
#pragma unroll
            for (int m = 0; m < 4; ++m) { bf16_t* rowp = base + (size_t)(row0 + ai * HALF + m * 16) * ldc + col0;
                f32x4 v[2][2];
#pragma unroll
                for (int bj = 0; bj < 2; ++bj)
#pragma unroll
                    for (int n = 0; n < 2; ++n) v[bj][n] = acc[ai][bj][m][n] * sc + bv[bj][n];
                if (isg) {
#pragma unroll
                    for (int n = 0; n < 2; ++n)
#pragma unroll
                        for (int i = 0; i < 4; ++i) { const float ga = sigm(v[0][n][i]), gp = sigm(v[1][n][i]); v[0][n][i] = ga * __builtin_amdgcn_rcpf(fmaxf(gp, 8.67e-19f)); v[1][n][i] = gp; } }
#pragma unroll
                for (int bj = 0; bj < 2; ++bj) *(u32x4*)(rowp + bj * bjs) = pack8(v[bj][0], v[bj][1]); }
        if (pn < 4) {
            float* tab = PN + (pn >> 1) * 16384; const int R0 = u.pm * BM, b = R0 >> 12;
#pragma unroll
            for (int ai = 0; ai < 2; ++ai)
#pragma unroll
                for (int bj = 0; bj < 2; ++bj) { float mx = 0.f;
#pragma unroll
                    for (int m = 0; m < 4; ++m) { f32x4 v0 = acc[ai][bj][m][0] * sc, v1 = acc[ai][bj][m][1] * sc;
                        float s = (v0[0] * v0[0] + v0[1] * v0[1]) + (v0[2] * v0[2] + v0[3] * v0[3]) + (v1[0] * v1[0] + v1[1] * v1[1]) + (v1[2] * v1[2] + v1[3] * v1[3]);
                        s += __shfl_xor(s, 16); s += __shfl_xor(s, 32); mx = fmaxf(mx, s); }
                    mx = fmaxf(mx, __shfl_xor(mx, 1)); mx = fmaxf(mx, __shfl_xor(mx, 2)); mx = fmaxf(mx, __shfl_xor(mx, 4)); mx = fmaxf(mx, __shfl_xor(mx, 8));
                    const int tile = ((R0 & 4095) >> 6) + 2 * ai + wr, hm = (pn & 1) * 4 + 2 * bj + (wc >> 1);
                    if (fr == 0 && fq == 0) tab[((b * 8 + hm) * 64 + tile) * 2 + (wc & 1)] = mx; }
        }
    }
};
struct EpiMixCat {
    static constexpr bool PERM = true, MID = true; static constexpr int NSTORES = 16;
    bf16_t* MIX; const bf16_t* G; float dsc; int pad;
    __device__ __forceinline__ void mid(Acc& acc, const Unit& u, int wr, int wc, int fr_, int fq_) const {
        int fr = fr_, fq = fq_; asm volatile("" : "+v"(fr), "+v"(fq));
        const int row0 = u.pm * BM + wr * 64 + fr, col0 = u.pn * BM + wc * 32 + 8 * fq;
        u32x4 w[16];
#pragma unroll
        for (int k = 0; k < 16; ++k) w[k] = *(const u32x4*)(G + (size_t)(row0 + (k >> 3) * HALF + ((k >> 1) & 3) * 16) * 2048 + col0 + (k & 1) * HALF);
        asm volatile("" : "+v"(w[0]), "+v"(w[1]), "+v"(w[2]), "+v"(w[3]), "+v"(w[4]), "+v"(w[5]), "+v"(w[6]), "+v"(w[7]), "+v"(w[8]), "+v"(w[9]), "+v"(w[10]), "+v"(w[11]), "+v"(w[12]), "+v"(w[13]), "+v"(w[14]), "+v"(w[15]));
#pragma unroll
        for (int k = 0; k < 16; ++k) { const int ai = k >> 3, m = (k >> 1) & 3, bj = k & 1; f32x4 a0, a1; unpack8(w[k], a0, a1); acc[ai][bj][m][0] *= a0; acc[ai][bj][m][1] *= a1; }
        asm volatile("" ::: "memory");
    }
    __device__ __forceinline__ void operator()(const Acc& acc, const Unit& u, int wr, int wc, int fr_, int fq_, PG8_LAS unsigned char*, int) const {
        int fr = fr_, fq = fq_; asm volatile("" : "+v"(fr), "+v"(fq));
        const int row0 = u.pm * BM + wr * 64 + fr, col0 = u.pn * BM + wc * 32 + 8 * fq;
        u32x4 w[16];
#pragma unroll
        for (int k = 0; k < 16; ++k) w[k] = *(const u32x4*)(G + (size_t)(row0 + (k >> 3) * HALF + ((k >> 1) & 3) * 16) * 2048 + 1024 + col0 + (k & 1) * HALF);
        asm volatile("" : "+v"(w[0]), "+v"(w[1]), "+v"(w[2]), "+v"(w[3]), "+v"(w[4]), "+v"(w[5]), "+v"(w[6]), "+v"(w[7]), "+v"(w[8]), "+v"(w[9]), "+v"(w[10]), "+v"(w[11]), "+v"(w[12]), "+v"(w[13]), "+v"(w[14]), "+v"(w[15]));
#pragma unroll
        for (int k = 0; k < 16; ++k) { const int ai = k >> 3, m = (k >> 1) & 3, bj = k & 1; f32x4 p0, p1; unpack8(w[k], p0, p1);
#pragma unroll
            for (int i = 0; i < 4; ++i) { p0[i] = fmaxf(p0[i], 8.67e-19f) * dsc; p1[i] = fmaxf(p1[i], 8.67e-19f) * dsc; }
            *(u32x4*)(MIX + (size_t)(row0 + ai * HALF + m * 16) * 1024 + col0 + bj * HALF) = pack8(acc[ai][bj][m][0] * p0, acc[ai][bj][m][1] * p1); }
        asm volatile("" ::: "memory");
    }
};
struct EpiPre1 {
    static constexpr bool PERM = true; static constexpr int NSTORES = 16;
    bf16_t* out; const bf16_t* x; float alpha; int pad;
    __device__ __forceinline__ void operator()(const Acc& acc, const Unit& u, int wr, int wc, int fr_, int fq_, PG8_LAS unsigned char*, int) const {
        int fr = fr_, fq = fq_; asm volatile("" : "+v"(fr), "+v"(fq));
        const int row0 = u.pm * BM + wr * 64 + fr, col0 = u.pn * BM + wc * 32 + 8 * fq;
        u32x4 w[16];
#pragma unroll
        for (int k = 0; k < 16; ++k) w[k] = *(const u32x4*)(x + (size_t)(row0 + (k >> 3) * HALF + ((k >> 1) & 3) * 16) * 1024 + col0 + (k & 1) * HALF);
        asm volatile("" : "+v"(w[0]), "+v"(w[1]), "+v"(w[2]), "+v"(w[3]), "+v"(w[4]), "+v"(w[5]), "+v"(w[6]), "+v"(w[7]), "+v"(w[8]), "+v"(w[9]), "+v"(w[10]), "+v"(w[11]), "+v"(w[12]), "+v"(w[13]), "+v"(w[14]), "+v"(w[15]));
#pragma unroll
        for (int k = 0; k < 16; ++k) { const int ai = k >> 3, m = (k >> 1) & 3, bj = k & 1; f32x4 x0, x1; unpack8(w[k], x0, x1);
            *(u32x4*)(out + (size_t)(row0 + ai * HALF + m * 16) * 1024 + col0 + bj * HALF) = pack8(x0 * alpha + acc[ai][bj][m][0], x1 * alpha + acc[ai][bj][m][1]); }
        asm volatile("" ::: "memory");
    }
};
template <int MODE> struct EpiPle {
    static constexpr bool PERM = true; static constexpr int NSTORES = 16;
    bf16_t* out; const bf16_t* T; const bf16_t* PRE; const float* stat; const float* lng; const float* lnb; float dsc; float alpha;
    __device__ __forceinline__ void operator()(const Acc& acc, const Unit& u, int wr, int wc, int fr_, int fq_, PG8_LAS unsigned char*, int) const {
        int fr = fr_, fq = fq_; asm volatile("" : "+v"(fr), "+v"(fq));
        const int row0 = u.pm * BM + wr * 64 + fr, col0 = u.pn * BM + wc * 32 + 8 * fq;
        f32x4 ag[2][2], ab[2][2];
        if (MODE == 3) {
#pragma unroll
            for (int bj = 0; bj < 2; ++bj)
#pragma unroll
                for (int h = 0; h < 2; ++h) { ag[bj][h] = *(const f32x4*)(lng + col0 + bj * HALF + 4 * h) * alpha; ab[bj][h] = *(const f32x4*)(lnb + col0 + bj * HALF + 4 * h) * alpha; } }
#pragma unroll
        for (int ai = 0; ai < 2; ++ai)
#pragma unroll
            for (int mp = 0; mp < 2; ++mp) { u32x4 w[8]; f32x2 st[2];
                if (MODE == 3) {
#pragma unroll
                    for (int k = 0; k < 4; ++k) { const size_t o = (size_t)(row0 + ai * HALF + (2 * mp + (k >> 1)) * 16) * 1024 + col0 + (k & 1) * HALF; w[2 * k] = *(const u32x4*)(T + o); w[2 * k + 1] = *(const u32x4*)(PRE + o); }
#pragma unroll
                    for (int q = 0; q < 2; ++q) st[q] = *(const f32x2*)(stat + 2 * (size_t)(row0 + ai * HALF + (2 * mp + q) * 16));
                    asm volatile("" : "+v"(w[0]), "+v"(w[1]), "+v"(w[2]), "+v"(w[3]), "+v"(w[4]), "+v"(w[5]), "+v"(w[6]), "+v"(w[7]), "+v"(st[0]), "+v"(st[1]));
                }
#pragma unroll
                for (int k = 0; k < 4; ++k) { const int m = 2 * mp + (k >> 1), bj = k & 1; const size_t o = (size_t)(row0 + ai * HALF + m * 16) * 1024 + col0 + bj * HALF; f32x4 v0 = acc[ai][bj][m][0], v1 = acc[ai][bj][m][1];
                    if (MODE == 3) { f32x4 t0, t1, x0, x1; unpack8(w[2 * k], t0, t1); unpack8(w[2 * k + 1], x0, x1); const float s = st[k >> 1][1], ms = -st[k >> 1][0] * s;
#pragma unroll
                        for (int i = 0; i < 4; ++i) { v0[i] = sigm(v0[i] * dsc) * t0[i] + ((x0[i] * s + ms) * ag[bj][0][i] + ab[bj][0][i]); v1[i] = sigm(v1[i] * dsc) * t1[i] + ((x1[i] * s + ms) * ag[bj][1][i] + ab[bj][1][i]); } }
                    *(u32x4*)(out + o) = pack8(v0, v1); }
                if (MODE == 3) asm volatile("" ::: "memory"); }
    }
};
template <bool F8> struct EpiUp {
    static constexpr bool PERM = true; static constexpr int NSTORES = F8 ? 4 : 8;
    void* HB; const float* bup; float dsc; int pad;
    __device__ __forceinline__ void operator()(const Acc& acc, const Unit& u, int wr, int wc, int fr_, int fq_, PG8_LAS unsigned char* lds, int buf) const {
        int fr = fr_, fq = fq_; asm volatile("" : "+v"(fr), "+v"(fq));
        const PG8_LAS int* row0t = (const PG8_LAS int*)(lds + TAB_ROW0); const int srow = row0t[u.e] + u.pm * BM;
        const int c0 = u.pn * HALF + wc * 32 + 8 * fq; const PG8_LAS float* bp = (const PG8_LAS float*)(lds + TAB_BIAS + buf * 1024) + wc * 32 + 8 * fq;
        const f32x4 bg0 = *(const PG8_LAS f32x4*)(bp), bg1 = *(const PG8_LAS f32x4*)(bp + 4), bl0 = *(const PG8_LAS f32x4*)(bp + 128) + 1.f, bl1 = *(const PG8_LAS f32x4*)(bp + 132) + 1.f;
#pragma unroll
        for (int ai = 0; ai < 2; ++ai)
#pragma unroll
            for (int mp = 0; mp < 2; ++mp) { unsigned xw[2][2];
#pragma unroll
                for (int mm = 0; mm < 2; ++mm) { const int m = 2 * mp + mm, r = ai * HALF + wr * 64 + m * 16 + fr;
                    f32x4 g0 = acc[ai][0][m][0] * dsc + bg0, g1 = acc[ai][0][m][1] * dsc + bg1, l0 = acc[ai][1][m][0] * dsc + bl0, l1 = acc[ai][1][m][1] * dsc + bl1;
#pragma unroll
                    for (int h = 0; h < 4; ++h) { constexpr float CS = -1.702f * 1.4426950408889634f;
                        f32x4& gg = (h < 2) ? g0 : g1; const f32x4& ll = (h < 2) ? l0 : l1; const int i = 2 * (h & 1);
                        const f32x2 a = {fminf(gg[i], 7.f), fminf(gg[i + 1], 7.f)}, b = {fminf(fmaxf(ll[i], -6.f), 8.f), fminf(fmaxf(ll[i + 1], -6.f), 8.f)};
                        const f32x2 t = a * CS; const f32x2 e = {__builtin_amdgcn_exp2f(t[0]), __builtin_amdgcn_exp2f(t[1])}; const f32x2 d = e + 1.f;
                        const f32x2 rc = {__builtin_amdgcn_rcpf(d[0]), __builtin_amdgcn_rcpf(d[1])}; const f32x2 y = (a * rc) * b; gg[i] = y[0]; gg[i + 1] = y[1]; }
                    if (F8) { xw[mm][0] = pk4_fp8(g0[0], g0[1], g0[2], g0[3]); xw[mm][1] = pk4_fp8(g1[0], g1[1], g1[2], g1[3]); }
                    else if (r < u.nvalid) *(u32x4*)((bf16_t*)HB + (size_t)(srow + r) * 1024 + c0) = pack8(g0, g1); }
                if (F8) {
                    const auto s0 = __builtin_amdgcn_permlane16_swap(xw[0][0], xw[1][0], false, false), s1 = __builtin_amdgcn_permlane16_swap(xw[0][1], xw[1][1], false, false);
                    const int r = ai * HALF + wr * 64 + (2 * mp + (fq & 1)) * 16 + fr;
                    if (r < u.nvalid) { u32x4 w; w.x = s0[0]; w.y = s1[0]; w.z = s0[1]; w.w = s1[1]; *(u32x4*)((unsigned char*)HB + (size_t)(srow + r) * 1024 + (c0 & ~15)) = w; } } }
    }
};
struct EpiDown {
    static constexpr bool PERM = true, PERM16 = true; static constexpr int NSTORES = 8;
    unsigned char* YS; size_t rstride; const float* bdn; float dsc; float osc;
    __device__ __forceinline__ void operator()(const Acc& acc, const Unit& u, int wr, int wc, int fr_, int fq_, PG8_LAS unsigned char* lds, int buf) const {
        int fr = fr_, fq = fq_; asm volatile("" : "+v"(fr), "+v"(fq));
        const PG8_LAS int* ids = (const PG8_LAS int*)(lds + TAB_IDS) + buf * 256; const PG8_LAS float* gates = (const PG8_LAS float*)(lds + TAB_GATES) + buf * 256;
        const int col0 = u.pn * BM + wc * 64 + 16 * fq; const PG8_LAS float* bp = (const PG8_LAS float*)(lds + TAB_BIAS + buf * 1024) + wc * 64 + 16 * fq;
        f32x4 bv[2][2];
#pragma unroll
        for (int bj = 0; bj < 2; ++bj)
#pragma unroll
            for (int n = 0; n < 2; ++n) bv[bj][n] = *(const PG8_LAS f32x4*)(bp + 8 * bj + 4 * n);
#pragma unroll
        for (int ai = 0; ai < 2; ++ai)
#pragma unroll
            for (int m = 0; m < 4; ++m) { const int r = ai * HALF + wr * 64 + m * 16 + fr;
                if (r < u.nvalid) { const int a = ids[r]; const float gs = gates[r] * osc; const size_t o = (size_t)(a & 3) * rstride + (size_t)(a >> 2) * 1024 + col0;
                    u32x4 w; unsigned* wp = (unsigned*)&w;
#pragma unroll
                    for (int bj = 0; bj < 2; ++bj)
#pragma unroll
                        for (int n = 0; n < 2; ++n) { const f32x4 v = (acc[ai][bj][m][n] * dsc + bv[bj][n]) * gs; wp[2 * bj + n] = pk4_fp8(v[0], v[1], v[2], v[3]); }
                    *(u32x4*)(YS + o) = w; } }
    }
};

template <class Epi, class Sched>
__device__ __forceinline__ void gemm_phase(PG8_LAS unsigned char* lds, const int wid, const Gemm g, const Sched& S, const Epi& E) {
    int lane = lane_id(); asm volatile("" : "+v"(lane));
    const int tid = wid * 64 + lane, wr = wid >> 2, wc = wid & 3, fr = lane & 15, fq = lane >> 4;
    const int K = g.K, nt = K / BK;
    int RA[2], CA[2]; unsigned voffA[2], voffB[2];
#pragma unroll
    for (int i = 0; i < 2; ++i) { int R, C; stage_rc(tid * 16 + i * 8192, R, C); const int Rb = has_p16<Epi>::value ? perm16h(R) : Epi::PERM ? ((R & ~31) + perm32(R & 31)) : R; RA[i] = R; CA[i] = C; voffA[i] = (unsigned)(R * K + C) * 2u; voffB[i] = (unsigned)(Rb * K + C) * 2u; }
    const size_t tstep = (size_t)BM * K * 2;
    const size_t kstep = (size_t)(BK * 2);
    const size_t hstep = (size_t)HALF * K * 2;
    const size_t bstep = has_p16<Epi>::value ? (size_t)8 * K * 2 : hstep;
    const unsigned ldsw = (unsigned)wid * 1024u;
    const int aoff = lds_byte(wr * 64 + fr, fq * 8), boff = lds_byte(wc * 32 + fr, fq * 8);
#define PG8_SA(b, h) (((b) * 2 + (h)) * HTB)
#define PG8_SB(b, h) ((4 + (b) * 2 + (h)) * HTB)
#define PG8_STAGE(bufoff, gbase, voff) do { _Pragma("unroll") for (int _i = 0; _i < 2; ++_i) \
        __builtin_amdgcn_global_load_lds((const unsigned*)((const char*)(gbase) + (voff)[_i]), (PG8_LAS unsigned*)(lds + (bufoff) + ldsw + _i * 8192), 16, 0, 0); } while (0)
#define PG8_STAGE_A(bufoff, ubase, h, OFF) do { if constexpr (Sched::TABLES) PG8_STAGE(bufoff, ubase, OFF[h]); else PG8_STAGE(bufoff, (ubase) + ((h) ? hstep : 0), voffA); } while (0)
#define PG8_LDA(dst, b, h) do { _Pragma("unroll") for (int m = 0; m < 4; ++m) { if constexpr (Sched::FP8) dst##8[m] = __builtin_shufflevector(*(const PG8_LAS i32x4*)(lds + PG8_SA(b, h) + aoff + m * 2048), *(const PG8_LAS i32x4*)(lds + PG8_SA(b, h) + aoff + m * 2048 + 1024), 0, 1, 2, 3, 4, 5, 6, 7); \
        else { _Pragma("unroll") for (int k = 0; k < 2; ++k) dst[m][k] = *(const PG8_LAS bf16x8*)(lds + PG8_SA(b, h) + aoff + m * 2048 + k * 1024); } } } while (0)
#define PG8_LDB(dst, b, h) do { _Pragma("unroll") for (int n = 0; n < 2; ++n) { if constexpr (Sched::FP8) dst##8[n] = __builtin_shufflevector(*(const PG8_LAS i32x4*)(lds + PG8_SB(b, h) + boff + n * 2048), *(const PG8_LAS i32x4*)(lds + PG8_SB(b, h) + boff + n * 2048 + 1024), 0, 1, 2, 3, 4, 5, 6, 7); \
        else { _Pragma("unroll") for (int k = 0; k < 2; ++k) dst[n][k] = *(const PG8_LAS bf16x8*)(lds + PG8_SB(b, h) + boff + n * 2048 + k * 1024); } } } while (0)
#define PG8_MMA(ai, bj, At, Bt) do { __builtin_amdgcn_s_setprio(1); if constexpr (Sched::FP8) asm volatile("s_nop 1"); _Pragma("unroll") for (int m = 0; m < 4; ++m) _Pragma("unroll") for (int n = 0; n < 2; ++n) { \
        if constexpr (Sched::FP8) asm volatile("v_mfma_f32_16x16x128_f8f6f4 %0, %1, %2, %0" : "+v"(acc[ai][bj][m][n]) : "v"(Bt##8[n]), "v"(At##8[m]));   \
        else { _Pragma("unroll") for (int k = 0; k < 2; ++k) acc[ai][bj][m][n] = __builtin_amdgcn_mfma_f32_16x16x32_bf16(Bt[n][k], At[m][k], acc[ai][bj][m][n], 0, 0, 0); } } __builtin_amdgcn_s_setprio(0); } while (0)
#define PG8_WAIT_V(n) asm volatile("s_waitcnt vmcnt(" #n ")" ::: "memory")
#define PG8_WAIT_V8R(relax) do { if (relax) asm volatile("s_waitcnt vmcnt(%0)" :: "n"(8 + Epi::NSTORES) : "memory"); else asm volatile("s_waitcnt vmcnt(8)" ::: "memory"); } while (0)
#define PG8_WAIT_L(n) asm volatile("s_waitcnt lgkmcnt(" #n ")" ::: "memory")
#define PG8_BAR __builtin_amdgcn_s_barrier()
#define PG8_SCHED __builtin_amdgcn_sched_barrier(0)
    Unit cur, nxt; int ui = 0; bool prev_full = false;
    if (!S.next(0, cur, lds)) return;
    if constexpr (Sched::TABLES) {
        if (wid == 0) S.issue_tables(cur, lds, 0, lane);
        PG8_WAIT_V(0); PG8_BAR;
    }
    Acc acc;
#pragma unroll
    for (int a = 0; a < 2; ++a)
#pragma unroll
        for (int b = 0; b < 2; ++b)
#pragma unroll
            for (int m = 0; m < 4; ++m)
#pragma unroll
                for (int n = 0; n < 2; ++n) acc[a][b][m][n] = (f32x4){0.f, 0.f, 0.f, 0.f};
    bf16x8 At[4][2], B0[2][2], B1[2][2];
    i32x8 At8[4], B08[2], B18[2];
    unsigned offc[2][2], offn[2][2];
    if constexpr (Sched::TABLES) { S.a_offsets(g, cur, lds, 0, RA, CA, offc);
#pragma unroll
        for (int h = 0; h < 2; ++h)
#pragma unroll
            for (int i = 0; i < 2; ++i) offn[h][i] = offc[h][i]; }
    const char* const Ab = (const char*)g.A;
    const char* cA = Sched::TABLES ? Ab : Ab + (size_t)cur.pm * tstep;
    const char* cB = S.b_tile(g, cur);
    PG8_STAGE(PG8_SB(0, 0), cB, voffB); PG8_STAGE(PG8_SB(0, 1), cB + bstep, voffB); PG8_STAGE_A(PG8_SA(0, 0), cA, 0, offc); PG8_STAGE_A(PG8_SA(0, 1), cA, 1, offc);
    if (wr == 1) PG8_BAR;
    PG8_WAIT_V(2); PG8_BAR;
    PG8_STAGE(PG8_SB(1, 0), cB + kstep, voffB); PG8_STAGE_A(PG8_SA(1, 0), cA + kstep, 0, offc); PG8_STAGE(PG8_SB(1, 1), cB + bstep + kstep, voffB);
    PG8_WAIT_V(6); PG8_BAR;
    for (;;) {
        const bool has_next = S.next(ui + 1, nxt, lds);
        const char* nB = has_next ? S.b_tile(g, nxt) : cB;
        const char* nA = Sched::TABLES ? Ab : (has_next ? Ab + (size_t)nxt.pm * tstep : cA);
#pragma nounroll
        for (int t = 0; t < nt; t += 2) {
            const bool last = (t == nt - 2);
            const bool relax = (t == 0) && prev_full;
            const bool pre11 = (t == 0) && (ui > 0);
            if constexpr (has_mid<Epi>::value) { if (t == nt / 2) E.mid(acc, cur, wr, wc, fr, fq); }
            if constexpr (Sched::TABLES) {
                if (t == 2 && has_next && wid == 0) S.issue_tables(nxt, lds, (ui + 1) & 1, lane);
                if (t == (nt >= 16 ? nt - 6 : nt - 2) && has_next) S.a_offsets(g, nxt, lds, (ui + 1) & 1, RA, CA, offn);
            }
            unsigned o2[2][2];
            if constexpr (Sched::TABLES) {
#pragma unroll
                for (int h = 0; h < 2; ++h)
#pragma unroll
                    for (int i = 0; i < 2; ++i) o2[h][i] = last ? offn[h][i] : offc[h][i]; }
            const char* a1 = cA + (size_t)(t + 1) * kstep;
            const char* a2 = last ? nA : cA + (size_t)(t + 2) * kstep; const char* b2 = last ? nB : cB + (size_t)(t + 2) * kstep;
            const char* a3 = a2 + kstep; const char* b3 = b2 + kstep;
            PG8_LDB(B0, 0, 0); PG8_LDB(B1, 0, 1); PG8_SCHED; PG8_LDA(At, 0, 0); if (!pre11) PG8_STAGE_A(PG8_SA(1, 1), a1, 1, offc);
            PG8_WAIT_V8R(relax); PG8_WAIT_L(0); PG8_BAR; PG8_MMA(0, 0, At, B0); PG8_MMA(0, 1, At, B1); PG8_BAR; PG8_SCHED;
            PG8_LDA(At, 0, 1); PG8_STAGE(PG8_SB(0, 0), b2, voffB); PG8_STAGE(PG8_SB(0, 1), b2 + bstep, voffB); PG8_STAGE_A(PG8_SA(0, 0), a2, 0, o2);
            PG8_WAIT_V8R(relax); PG8_WAIT_L(0); PG8_BAR; PG8_MMA(1, 0, At, B0); PG8_MMA(1, 1, At, B1); PG8_BAR; PG8_SCHED;
            PG8_LDB(B0, 1, 0); PG8_LDB(B1, 1, 1); PG8_SCHED; PG8_LDA(At, 1, 0); PG8_STAGE_A(PG8_SA(0, 1), a2, 1, o2);
            PG8_WAIT_V8R(relax && pre11); PG8_WAIT_L(0); PG8_BAR; PG8_MMA(0, 0, At, B0); PG8_MMA(0, 1, At, B1); PG8_BAR; PG8_SCHED;
            PG8_LDA(At, 1, 1); PG8_STAGE(PG8_SB(1, 0), b3, voffB); PG8_STAGE(PG8_SB(1, 1), b3 + bstep, voffB); PG8_STAGE_A(PG8_SA(1, 0), a3, 0, o2);
            PG8_WAIT_V(8); PG8_WAIT_L(0); PG8_BAR; PG8_MMA(1, 0, At, B0); PG8_MMA(1, 1, At, B1); PG8_BAR; PG8_SCHED;
        }
        if (wr == 0) PG8_BAR;
        if (has_next) PG8_STAGE_A(PG8_SA(1, 1), nA + kstep, 1, offn);
        E(acc, cur, wr, wc, fr, fq, lds, ui & 1);
        if (!has_next) break;
#pragma unroll
        for (int a = 0; a < 2; ++a)
#pragma unroll
            for (int b = 0; b < 2; ++b)
#pragma unroll
                for (int m = 0; m < 4; ++m)
#pragma unroll
                    for (int n = 0; n < 2; ++n) acc[a][b][m][n] = (f32x4){0.f, 0.f, 0.f, 0.f};
        prev_full = (cur.nvalid == 256); cur = nxt; cB = nB; cA = nA; ++ui;
        if constexpr (Sched::TABLES) {
#pragma unroll
            for (int h = 0; h < 2; ++h)
#pragma unroll
                for (int i = 0; i < 2; ++i) offc[h][i] = offn[h][i]; }
        if (wr == 1) PG8_BAR;
    }
    PG8_WAIT_V(0);
    PG8_BAR;
#undef PG8_SA
#undef PG8_SB
#undef PG8_STAGE
#undef PG8_STAGE_A
#undef PG8_LDA
#undef PG8_LDB
#undef PG8_MMA
#undef PG8_WAIT_V
#undef PG8_WAIT_V8R
#undef PG8_WAIT_L
#undef PG8_BAR
#undef PG8_SCHED
}
}
namespace attn_body {
using bf16=__hip_bfloat16;
using bf16x8=__attribute__((ext_vector_type(8)))short;
using s16x4=__attribute__((ext_vector_type(4)))short;
using f32x16=__attribute__((ext_vector_type(16)))float;
using u32x4=__attribute__((ext_vector_type(4)))unsigned;
using f32x4_=__attribute__((ext_vector_type(4)))float;
constexpr int BATCH=16,SEQ=4096,D=64,DM=512,DMO=1024;
constexpr int NW=8,QBLK=32,QB=QBLK*NW,KVBLK=64,NQB=SEQ/QB;
constexpr int ATTN_UNIT_ROWS=QB;
__device__ __forceinline__ int crow(int r,int hi){return (r&3)+8*(r>>2)+4*hi;}
#define SBAR() __builtin_amdgcn_sched_barrier(0)
__device__ __forceinline__ void cmask(f32x16&p0,f32x16&p1,int jb,int qrel,int hi){
  const float NEG=-INFINITY; int kb=64*jb+4*hi; asm volatile("":"+v"(kb),"+v"(qrel));
  #pragma unroll
  for(int r=0;r<16;++r){int kv=kb+(r&3)+8*(r>>2); if(kv>qrel)p0[r]=NEG; if(kv+32>qrel)p1[r]=NEG;}
}

constexpr int NSLOT=3, SLOTB=8192, VSLOTB=16384;
constexpr int LDS_K=0, LDS_V=NSLOT*SLOTB, LDS_WS=NSLOT*SLOTB+NSLOT*VSLOTB, LDS_OST=LDS_WS+NW*64*4, LDS_BYTES=LDS_OST+NW*4096;
constexpr float C2=0.125f*1.4426950408889634f;
__device__ __forceinline__ void glds16(const void*gsrc,unsigned lds_dst){unsigned keep;
  asm volatile("s_mov_b32 %0, m0\n\ts_mov_b32 m0, %2\n\ts_nop 0\n\tglobal_load_lds_dwordx4 %1, off\n\ts_mov_b32 m0, %0":"=&s"(keep):"v"(gsrc),"s"(lds_dst):"memory");}
__device__ __forceinline__ float max3f(float a,float b,float c){float r;asm("v_max3_f32 %0, %1, %2, %3":"=v"(r):"v"(a),"v"(b),"v"(c));return r;}
__device__ __forceinline__ float max2f(float a,float b){float r;asm("v_max_f32_e32 %0, %1, %2":"=v"(r):"v"(a),"v"(b));return r;}
__device__ __forceinline__ float fadd_s(float a,float b){float r;asm("v_add_f32_e32 %0, %1, %2":"=v"(r):"v"(a),"v"(b));return r;}
__device__ __forceinline__ float fsub_s(float a,float b){float r;asm("v_sub_f32_e32 %0, %1, %2":"=v"(r):"v"(a),"v"(b));return r;}
typedef float f32x2_t __attribute__((ext_vector_type(2))); typedef __bf16 bf16x2_t __attribute__((ext_vector_type(2)));
__device__ __forceinline__ unsigned cvtpk_s(float lo,float hi){f32x2_t v={lo,hi};bf16x2_t b=__builtin_convertvector(v,bf16x2_t);return __builtin_bit_cast(unsigned,b);}
#define WAIT_BAR(N) asm volatile("s_waitcnt vmcnt(" #N ") lgkmcnt(0)\n\ts_barrier":::"memory")

__device__ __forceinline__ void qkt(f32x16&p0,f32x16&p1,const char*Kslot,const bf16x8*qr,const f32x16&i0,const f32x16&i1,int r32,int hi){
  const char*kb=Kslot+hi*1024+r32*16;
  #pragma unroll
  for(int d0=0;d0<4;++d0){
    const bf16x8 b0=*reinterpret_cast<const bf16x8*>(kb+d0*2048);
    const bf16x8 b1=*reinterpret_cast<const bf16x8*>(kb+d0*2048+512);
    if(d0==0){p0=__builtin_amdgcn_mfma_f32_32x32x16_bf16(b0,qr[0],i0,0,0,0);p1=__builtin_amdgcn_mfma_f32_32x32x16_bf16(b1,qr[0],i1,0,0,0);}
    else{p0=__builtin_amdgcn_mfma_f32_32x32x16_bf16(b0,qr[d0],p0,0,0,0);p1=__builtin_amdgcn_mfma_f32_32x32x16_bf16(b1,qr[d0],p1,0,0,0);}}
}
typedef __attribute__((address_space(3))) const char* lds_cptr;
typedef short v4i16_t __attribute__((ext_vector_type(4)));
__device__ __forceinline__ void kload8(bf16x8*kf,lds_cptr kp){
  kf[0]=*(const __attribute__((address_space(3))) bf16x8*)(kp);      kf[1]=*(const __attribute__((address_space(3))) bf16x8*)(kp+512);
  kf[2]=*(const __attribute__((address_space(3))) bf16x8*)(kp+2048); kf[3]=*(const __attribute__((address_space(3))) bf16x8*)(kp+2560);
  kf[4]=*(const __attribute__((address_space(3))) bf16x8*)(kp+4096); kf[5]=*(const __attribute__((address_space(3))) bf16x8*)(kp+4608);
  kf[6]=*(const __attribute__((address_space(3))) bf16x8*)(kp+6144); kf[7]=*(const __attribute__((address_space(3))) bf16x8*)(kp+6656);
}
__device__ __forceinline__ void kload2(bf16x8*kf,lds_cptr kp,int j){ kf[2*j]=*(const __attribute__((address_space(3))) bf16x8*)(kp+j*2048); kf[2*j+1]=*(const __attribute__((address_space(3))) bf16x8*)(kp+j*2048+512); }
__device__ __forceinline__ s16x4 vtr(lds_cptr p){ return __builtin_bit_cast(s16x4,__builtin_amdgcn_ds_read_tr16_b64_v4i16((__attribute__((address_space(3))) v4i16_t*)p)); }
__device__ __forceinline__ float rowmax(const f32x16&p0,const f32x16&p1){
  float a=max3f(p0[0],p0[1],p1[0]),b=max3f(p0[2],p0[3],p1[1]);a=max3f(a,p1[2],p1[3]);
  #pragma unroll
  for(int r=4;r<16;r+=4){a=max3f(a,p0[r],p0[r+1]);b=max3f(b,p0[r+2],p0[r+3]);a=max3f(a,p1[r],p1[r+1]);b=max3f(b,p1[r+2],p1[r+3]);}
  const float m=max2f(a,b);
  auto rr=__builtin_amdgcn_permlane32_swap(__float_as_uint(m),__float_as_uint(m),false,false);
  return max2f(__uint_as_float(rr[0]),__uint_as_float(rr[1]));
}
__device__ __forceinline__ void pv(f32x16*o,int vb,bf16x8 pa0,bf16x8 pa1,bf16x8 pa2,bf16x8 pa3){
  #pragma unroll
  for(int d0=0;d0<4;++d0){s16x4 lo[4],hi[4];
    #pragma unroll
    for(int ks=0;ks<4;++ks){
      asm volatile("ds_read_b64_tr_b16 %0,%1 offset:%c2":"=&v"(lo[ks]):"v"(vb),"i"(d0*4096+ks*1024):"memory");
      asm volatile("ds_read_b64_tr_b16 %0,%1 offset:%c2":"=&v"(hi[ks]):"v"(vb),"i"(d0*4096+ks*1024+512):"memory");}
    asm volatile("s_waitcnt lgkmcnt(0)":::"memory");SBAR();
    #define PK(k) (bf16x8){lo[k][0],lo[k][1],lo[k][2],lo[k][3],hi[k][0],hi[k][1],hi[k][2],hi[k][3]}
    o[d0]=__builtin_amdgcn_mfma_f32_32x32x16_bf16(pa0,PK(0),o[d0],0,0,0);
    o[d0]=__builtin_amdgcn_mfma_f32_32x32x16_bf16(pa1,PK(1),o[d0],0,0,0);
    o[d0]=__builtin_amdgcn_mfma_f32_32x32x16_bf16(pa2,PK(2),o[d0],0,0,0);
    o[d0]=__builtin_amdgcn_mfma_f32_32x32x16_bf16(pa3,PK(3),o[d0],0,0,0);
    #undef PK
  }
}

#ifndef ATTN_STORE16
#define ATTN_STORE16(p,v) (*(u32x4*)(p)=(v))
#endif
template<int THRL> __device__ __forceinline__ void attn_unit(int b,int hm,int qb,float cs,const int wid,const int t0,const float uref,const bf16*Q,const bf16*__restrict__ K,const bf16*__restrict__ V,bf16*O,char*shm,volatile __attribute__((address_space(3))) int*slot_,const int nxt_,const bool lead_){
  int lane=lane_id(); asm volatile("":"+v"(lane));
  const int r32=lane&31,hi=lane>>5;
  const long rowbase=(long)b*SEQ; const int q0=qb*QB;
  const int NTf=(q0+QB)/KVBLK;
  const bf16*Qw=Q+(rowbase+q0+wid*QBLK)*DM+hm*D;
  const bf16*Kh=K+(rowbase+64*t0)*DM+hm*D,*Vh=V+(rowbase+64*t0)*DM+(hm>>1)*128;
  const unsigned lds0=(unsigned)(uintptr_t)shm;
  float*wsf=(float*)(shm+LDS_WS)+wid*64;
  const bf16*ksrc=Kh+(long)lane*DM+wid*8;
  const bf16*vsrc=Vh+(long)(16*(wid&3)+(lane>>2))*DM+(wid>>2)*32+(lane&3)*8;
  const unsigned kdst=lds0+LDS_K+wid*1024, vdst=lds0+LDS_V+wid*1024;
  #define DMA_K(t,slot) glds16(ksrc+(long)(t)*KVBLK*DM,(unsigned)__builtin_amdgcn_readfirstlane(kdst+(slot)))
  #define DMA_V(t,slot) do{ glds16(vsrc+(long)(t)*KVBLK*DM,(unsigned)__builtin_amdgcn_readfirstlane(vdst+(slot))); glds16(vsrc+(long)(t)*KVBLK*DM+64,(unsigned)__builtin_amdgcn_readfirstlane(vdst+(slot)+8192)); }while(0)
  const int vb0=(int)(lds0+LDS_V)+((lane>>4)&1)*32+(lane&3)*8+(4*hi+((lane&15)>>2))*64;
  const char*Kbase=shm+LDS_K; bf16x8 kf[8];
  const lds_cptr shm3=(lds_cptr)shm; const lds_cptr kp0=shm3+LDS_K+hi*1024+r32*16; const lds_cptr vp0=shm3+LDS_V+((lane>>4)&1)*32+(lane&3)*8+(4*hi+((lane&15)>>2))*64;
  const int NT=NTf-t0;
  DMA_K(0,0);DMA_V(0,0);DMA_K(1,SLOTB);
  bf16x8 qr[4];
  #pragma unroll
  for(int d0=0;d0<4;++d0)qr[d0]=*reinterpret_cast<const bf16x8*>(&Qw[(long)r32*DM+d0*16+hi*8]);
  float mhat=0.f,l_reg=0.f;f32x16 o[4];o[0]=f32x16{};o[1]=f32x16{};o[2]=f32x16{};o[3]=f32x16{};
  const int qrel=wid*QBLK+r32;
  float nb=-uref-cs*(float)(q0+qrel-4*hi-64*t0);
  const float cs8=__builtin_bit_cast(float,__builtin_amdgcn_readfirstlane(__builtin_bit_cast(int,8.f*cs)));
  #define CINIT1(C,t,X) do{ C[0]=nb+cs*(float)(64*(t)+(X)); C[1]=C[0]+cs; C[2]=C[1]+cs; C[3]=C[2]+cs; _Pragma("unroll") for(int r=4;r<16;++r) C[r]=C[r-4]+cs8; asm volatile("":"+v"(C)); }while(0)
  #define CINIT(C0,C1,t) do{ CINIT1(C0,t,0); CINIT1(C1,t,32); }while(0)
  #define CMASK(P0,P1,t) do{int jb_=(t)-(NT-4); if(jb_>=0)cmask(P0,P1,jb_,qrel,hi);}while(0)
  bool resc=false;
  #define START(P0,P1) do{ const float rm=rowmax(P0,P1); resc=false; \
    { const float dl=0.f; (void)rm; mhat=fadd_s(mhat,dl); nb=fsub_s(nb,dl);     \
      _Pragma("unroll") for(int r=0;r<16;++r){P0[r]=fsub_s(P0[r],dl);P1[r]=fsub_s(P1[r],dl);} } \
    _Pragma("unroll") for(int r=0;r<16;++r)P0[r]=__builtin_amdgcn_exp2f(P0[r]); }while(0)
  #define RESC() do{ if(THRL>=0&&resc){ asm volatile("s_waitcnt lgkmcnt(0)":::"memory"); \
      _Pragma("unroll") for(int d_=0;d_<4;++d_) _Pragma("unroll") for(int r=0;r<16;++r)o[d_][r]*=wsf[crow(r,hi)]; } }while(0)
  f32x16 pA0,pA1,pB0,pB1;
  int sl_prev=0,sl_cur=0,sl_next=SLOTB;
  #define ROT() do{sl_prev=sl_cur;sl_cur=sl_next;sl_next=(sl_next==(NSLOT-1)*SLOTB)?0:sl_next+SLOTB;}while(0)
  DMA_K(2,2*SLOTB);
  WAIT_BAR(4);
  { f32x16 i0_,i1_; CINIT(i0_,i1_,0); qkt(pA0,pA1,Kbase,qr,i0_,i1_,r32,hi); } asm volatile("s_nop 15\n\ts_nop 7":"+v"(pA0),"+v"(pA1));CMASK(pA0,pA1,0);
  CINIT(pB0,pB1,1);
  START(pA0,pA1);
  _Pragma("unroll") for(int r=0;r<16;++r)pA1[r]=__builtin_amdgcn_exp2f(pA1[r]);
  WAIT_BAR(0);
  DMA_K(3,0);DMA_V(1,VSLOTB);
  ROT();
  kload8(kf,kp0+sl_cur);
  WAIT_BAR(3);
  s16x4 vlo[8],vhi[8]; u32x4 pw0,pw1,pw2,pw3;
  #define PKW(P,B) cvtpk_s(P[B],P[B+1])
  #define PAF(k) __builtin_bit_cast(bf16x8,pw##k)
  #define VFR(i) (bf16x8){vlo[i][0],vlo[i][1],vlo[i][2],vlo[i][3],vhi[i][0],vhi[i][1],vhi[i][2],vhi[i][3]}
  #define PIN(x) asm volatile("":"+v"(x))
  #define MX3(a,b,c) __builtin_fmaxf(__builtin_fmaxf((a),(b)),(c))
  #define GAPA(MF,A0,A1,A2,A3,W0,W1,PW) do{ MF; sacc+=A0; sacc+=A1; sacc+=A2; sacc+=A3; PIN(sacc); W0; W1; PIN(PW); SBAR(); }while(0)
  #define EX(v) __builtin_amdgcn_exp2f(v)
  #define GAPB(MF,X,B,CI) do{ MF; X[B]=EX(X[B]); X[B+1]=EX(X[B+1]); CI; PIN(X); SBAR(); }while(0)
    \
  #define CIA(P,X,t) do{ P[0]=nb+cs*(float)(64*((t)+1)+(X)); P[1]=P[0]+cs; }while(0)
  #define CIB(P) do{ P[2]=P[1]+cs; P[3]=P[2]+cs; }while(0)
  #define CIC(P,k) do{ P[2*(k)]=P[2*(k)-4]+cs8; P[2*(k)+1]=P[2*(k)-3]+cs8; }while(0)
  #define VRD2(i) do{ vlo[i]=vtr(vp_+(8192+((i)>>2)*4096+((i)&3)*1024)); vhi[i]=vtr(vp_+(8192+((i)>>2)*4096+((i)&3)*1024+512)); SBAR(); }while(0)
  #define VRD(i) do{ vlo[i]=vtr(vp_+(((i)>>2)*4096+((i)&3)*1024)); vhi[i]=vtr(vp_+(((i)>>2)*4096+((i)&3)*1024+512)); }while(0)
  #define KRD(G,j) do{ if(G){ kload2(kf,kp0+sl_next,j); SBAR(); } }while(0)
  #define STEP(C0,C1,P0,P1,t,GK,GV,GL) do{ SBAR(); \
    const lds_cptr vp_=vp0+2*sl_prev; \
    VRD(0); SBAR(); float sacc=(P0[0]+P0[1]); SBAR(); \
    GAPA(C0=__builtin_amdgcn_mfma_f32_32x32x16_bf16(kf[0],qr[0],C0,0,0,0), P0[2],P0[3],P0[4],P0[5],     pw0[0]=PKW(P0,0), pw0[1]=PKW(P0,2), pw0); \
    VRD(4); SBAR(); GAPA(C1=__builtin_amdgcn_mfma_f32_32x32x16_bf16(kf[1],qr[0],C1,0,0,0), P0[6],P0[7],P0[8],P0[9],     pw0[2]=PKW(P0,4), pw0[3]=PKW(P0,6), pw0); \
    VRD(1); SBAR(); GAPA(C0=__builtin_amdgcn_mfma_f32_32x32x16_bf16(kf[2],qr[1],C0,0,0,0),   P0[10],P0[11],P0[12],P0[13], pw1[0]=PKW(P0,8), pw1[1]=PKW(P0,10), pw1); \
    VRD(5); SBAR(); GAPA(C1=__builtin_amdgcn_mfma_f32_32x32x16_bf16(kf[3],qr[1],C1,0,0,0),   P0[14],P0[15],P1[0],P1[1],   pw1[2]=PKW(P0,12),pw1[3]=PKW(P0,14), pw1); \
    VRD(2); SBAR(); GAPA(C0=__builtin_amdgcn_mfma_f32_32x32x16_bf16(kf[4],qr[2],C0,0,0,0),   P1[2],P1[3],P1[4],P1[5],     pw2[0]=PKW(P1,0), pw2[1]=PKW(P1,2), pw2); \
    VRD(6); SBAR(); GAPA(C1=__builtin_amdgcn_mfma_f32_32x32x16_bf16(kf[5],qr[2],C1,0,0,0),   P1[6],P1[7],P1[8],P1[9],     pw2[2]=PKW(P1,4), pw2[3]=PKW(P1,6), pw2); \
    VRD(3); SBAR(); GAPA(C0=__builtin_amdgcn_mfma_f32_32x32x16_bf16(kf[6],qr[3],C0,0,0,0),   P1[10],P1[11],P1[12],P1[13], pw3[0]=PKW(P1,8), pw3[1]=PKW(P1,10), pw3); \
    VRD(7); SBAR(); GAPA(C1=__builtin_amdgcn_mfma_f32_32x32x16_bf16(kf[7],qr[3],C1,0,0,0),   P1[14],P1[15],0.f,0.f,       pw3[2]=PKW(P1,12),pw3[3]=PKW(P1,14), pw3); \
    l_reg+=sacc; \
    if(GK){DMA_K((t)+3,sl_cur);} if(GV){DMA_V((t)+1,2*sl_next);} \
    CMASK(C0,C1,t); \
    { float a=MX3(C0[0],C0[1],C1[0]),b=MX3(C0[2],C0[3],C1[1]); a=MX3(a,C1[2],C1[3]); \
      _Pragma("unroll") for(int r=4;r<16;r+=4){a=MX3(a,C0[r],C0[r+1]);b=MX3(b,C0[r+2],C0[r+3]);a=MX3(a,C1[r],C1[r+1]);b=MX3(b,C1[r+2],C1[r+3]);} \
      float rm=__builtin_fmaxf(a,b); { auto rr=__builtin_amdgcn_permlane32_swap(__float_as_uint(rm),__float_as_uint(rm),false,false); rm=__builtin_fmaxf(__uint_as_float(rr[0]),__uint_as_float(rr[1])); } \
      resc=false; \
      if(THRL>=0&&__builtin_expect(__any(rm>(float)THRL),0)){ const float dl=__builtin_fmaxf(rm,0.f); mhat+=dl; nb-=dl; \
        _Pragma("unroll") for(int r=0;r<16;++r){C0[r]-=dl;C1[r]-=dl;} \
        const float f=__builtin_amdgcn_exp2f(-dl); l_reg*=f; if(hi==0)wsf[r32]=f; resc=true; } } \
    SBAR(); \
    GAPB(o[0]=__builtin_amdgcn_mfma_f32_32x32x16_bf16(PAF(0),VFR(0),o[0],0,0,0), C0,0, CIA(P0,0,t)); \
    GAPB(o[1]=__builtin_amdgcn_mfma_f32_32x32x16_bf16(PAF(0),VFR(4),o[1],0,0,0), C0,2, CIB(P0)); VRD2(0); \
    KRD(GL,0); GAPB(o[0]=__builtin_amdgcn_mfma_f32_32x32x16_bf16(PAF(1),VFR(1),o[0],0,0,0), C0,4, CIC(P0,2)); VRD2(4); \
    KRD(GL,1); GAPB(o[1]=__builtin_amdgcn_mfma_f32_32x32x16_bf16(PAF(1),VFR(5),o[1],0,0,0), C0,6, CIC(P0,3)); VRD2(1); \
    KRD(GL,2); GAPB(o[0]=__builtin_amdgcn_mfma_f32_32x32x16_bf16(PAF(2),VFR(2),o[0],0,0,0), C0,8, CIC(P0,4)); VRD2(5); \
    KRD(GL,3); GAPB(o[1]=__builtin_amdgcn_mfma_f32_32x32x16_bf16(PAF(2),VFR(6),o[1],0,0,0), C0,10, CIC(P0,5)); VRD2(2); \
    GAPB(o[0]=__builtin_amdgcn_mfma_f32_32x32x16_bf16(PAF(3),VFR(3),o[0],0,0,0), C0,12, CIC(P0,6)); VRD2(6); \
    GAPB(o[1]=__builtin_amdgcn_mfma_f32_32x32x16_bf16(PAF(3),VFR(7),o[1],0,0,0), C0,14, CIC(P0,7)); VRD2(3); \
    GAPB(o[2]=__builtin_amdgcn_mfma_f32_32x32x16_bf16(PAF(0),VFR(0),o[2],0,0,0), C1,0, CIA(P1,32,t)); VRD2(7); \
    GAPB(o[3]=__builtin_amdgcn_mfma_f32_32x32x16_bf16(PAF(0),VFR(4),o[3],0,0,0), C1,2, CIB(P1)); \
    GAPB(o[2]=__builtin_amdgcn_mfma_f32_32x32x16_bf16(PAF(1),VFR(1),o[2],0,0,0), C1,4, CIC(P1,2)); \
    GAPB(o[3]=__builtin_amdgcn_mfma_f32_32x32x16_bf16(PAF(1),VFR(5),o[3],0,0,0), C1,6, CIC(P1,3)); \
    GAPB(o[2]=__builtin_amdgcn_mfma_f32_32x32x16_bf16(PAF(2),VFR(2),o[2],0,0,0), C1,8, CIC(P1,4)); \
    GAPB(o[3]=__builtin_amdgcn_mfma_f32_32x32x16_bf16(PAF(2),VFR(6),o[3],0,0,0), C1,10, CIC(P1,5)); \
    GAPB(o[2]=__builtin_amdgcn_mfma_f32_32x32x16_bf16(PAF(3),VFR(3),o[2],0,0,0), C1,12, CIC(P1,6)); \
    GAPB(o[3]=__builtin_amdgcn_mfma_f32_32x32x16_bf16(PAF(3),VFR(7),o[3],0,0,0), C1,14, CIC(P1,7)); \
    }while(0)
  int t=1;
  #undef CMASK
  #define CMASK(P0,P1,t) do{}while(0)
  for(;t+5<NT;t+=2){
    STEP(pB0,pB1,pA0,pA1,t,true,true,true);     WAIT_BAR(3); RESC(); ROT();
    STEP(pA0,pA1,pB0,pB1,t+1,true,true,true);   WAIT_BAR(3); RESC(); ROT();
  }
  #undef CMASK
  #define CMASK(P0,P1,t) do{int jb_=(t)-(NT-4); if(jb_>=0)cmask(P0,P1,jb_,qrel,hi);}while(0)
  #define ENDW(tt) do{ if((tt)+3<NT){WAIT_BAR(3);} else if((tt)+2<NT){WAIT_BAR(2);} else {WAIT_BAR(0);} }while(0)
  for(;t+1<NT;t+=2){
    STEP(pB0,pB1,pA0,pA1,t,(t+3<NT),(t+1<NT),(t+1<NT));       ENDW(t);   RESC(); ROT();
    STEP(pA0,pA1,pB0,pB1,t+1,(t+4<NT),(t+2<NT),(t+2<NT));     ENDW(t+1); RESC(); ROT();
  }
  STEP(pB0,pB1,pA0,pA1,NT-1,false,false,false); RESC();
  { float sacc=pB0[0]+pB0[1]; _Pragma("unroll") for(int r=2;r<16;++r)sacc+=pB0[r]; _Pragma("unroll") for(int r=0;r<16;++r)sacc+=pB1[r]; l_reg+=sacc;
    pw0=(u32x4){PKW(pB0,0),PKW(pB0,2),PKW(pB0,4),PKW(pB0,6)};pw1=(u32x4){PKW(pB0,8),PKW(pB0,10),PKW(pB0,12),PKW(pB0,14)};pw2=(u32x4){PKW(pB1,0),PKW(pB1,2),PKW(pB1,4),PKW(pB1,6)};pw3=(u32x4){PKW(pB1,8),PKW(pB1,10),PKW(pB1,12),PKW(pB1,14)};
    SBAR(); pv(o,vb0+2*sl_cur,PAF(0),PAF(1),PAF(2),PAF(3)); }
  #undef PKW
  #undef PAF
  #undef VFR
  #undef PIN
  #undef MX3
  #undef GAPA
  #undef GAPB
  #undef EX
  #undef VRD
  #undef VRD2
  #undef CIA
  #undef CIB
  #undef CIC
  #undef KRD
  #undef STEP
  #undef ENDW
  if(lead_) *slot_=nxt_;
  {auto rr=__builtin_amdgcn_permlane32_swap(__float_as_uint(l_reg),__float_as_uint(l_reg),false,false);l_reg=__uint_as_float(rr[0])+__uint_as_float(rr[1]);}
  if(hi==0)wsf[32+r32]=l_reg;asm volatile("s_waitcnt lgkmcnt(0)":::"memory");
  float rli[16];
  #pragma unroll
  for(int r=0;r<16;++r)rli[r]=__builtin_amdgcn_rcpf(wsf[32+crow(r,hi)]);
  bf16*Ow=O+(rowbase+q0+wid*QBLK)*DMO+(hm>>1)*256+(hm&1)*128;
  { bf16*stg=(bf16*)(shm+LDS_OST)+wid*2048;
    int eoff=hi*256+r32; asm volatile("":"+v"(eoff));
    #pragma unroll
    for(int hf=0;hf<2;++hf){
      #pragma unroll
      for(int r=0;r<16;++r){const int orow=(r&3)+8*(r>>2);
        #pragma unroll
        for(int d0=0;d0<2;++d0)stg[eoff+orow*64+d0*32]=__float2bfloat16(o[2*hf+d0][r]*rli[r]);}
      asm volatile("s_waitcnt lgkmcnt(0)":::"memory");
      #pragma unroll
      for(int i=0;i<4;++i){const int row=i*8+(lane>>3),ch=lane&7; const u32x4 v=*(const u32x4*)(stg+row*64+ch*8); ATTN_STORE16(Ow+(long)row*DMO+hf*64+ch*8,v);}
      asm volatile("s_waitcnt lgkmcnt(0)":::"memory"); } }
  asm volatile("s_waitcnt lgkmcnt(0)\n\ts_barrier":::"memory");
  #undef DMA_K
  #undef DMA_V
  #undef CMASK
  #undef START
  #undef RESC
  #undef ROT
  #undef CINIT
  #undef CINIT1
}
constexpr int ATTN_LDS_BYTES=LDS_BYTES;
struct AttnTensors { const bf16* Q; const bf16* K; const bf16* V; bf16* O; const float* PN; unsigned* queue; };
constexpr int LDS_SLOT=LDS_BYTES, LDS_T0=LDS_BYTES+1024, LDS_UREF=LDS_T0+8192, ATTN_LDS_TOTAL=LDS_UREF+8192;
__device__ __forceinline__ void unit_of(int u,int&b,int&hm,int&qb){ if(u<1024){qb=15-(u>>6);const int r=u&63;b=r>>2;hm=4+(r&3);} else if(u<1536){const int v=u-1024;qb=15-(v>>5);const int r=v&31;b=r>>1;hm=2+(r&1);} else {const int v=u-1536;qb=15-(v>>5);const int r=v&31;b=r>>1;hm=r&1;} }
__device__ __forceinline__ void attn_tables(char*lds,const float*PN,int tid){
  const int bhm=tid>>2,part=tid&3; const float*pq=PN+(bhm*64+16*part)*2,*pk=PN+16384+(bhm*64+16*part)*2;
  float kq[16],qq[16];
  #pragma unroll
  for(int i=0;i<8;++i){ const f32x4_ a=*(const f32x4_*)(pk+4*i),c=*(const f32x4_*)(pq+4*i); kq[2*i]=a[0]+a[1];kq[2*i+1]=a[2]+a[3];qq[2*i]=c[0]+c[1];qq[2*i+1]=c[2]+c[3]; }
  float km[4]; { float m=0.f;
    #pragma unroll
    for(int i=0;i<16;++i){ m=__builtin_fmaxf(m,kq[i]); if((i&3)==3)km[i>>2]=m; } }
  float before=0.f;
  #pragma unroll
  for(int p=0;p<3;++p){ const float tot=__shfl(km[3],(tid&~3)+p); if(p<part)before=__builtin_fmaxf(before,tot); }
  const int hm=bhm&7; const float cs=__builtin_amdgcn_exp2f(-2.f*(float)((hm>>1)+1))*1.4426950408889634f;
  volatile __attribute__((address_space(3))) int* T0=(volatile __attribute__((address_space(3))) int*)(lds+LDS_T0); volatile __attribute__((address_space(3))) float* UR=(volatile __attribute__((address_space(3))) float*)(lds+LDS_UREF);
  #pragma unroll
  for(int j=0;j<4;++j){ const int qb=4*part+j; const float kmx=__builtin_fmaxf(before,km[j]); const float qmx=__builtin_fmaxf(__builtin_fmaxf(qq[4*j],qq[4*j+1]),__builtin_fmaxf(qq[4*j+2],qq[4*j+3]));
    const float qk=__builtin_sqrtf(qmx*kmx), need=(ATT_SKIP+2.04f*qk)/cs;
    const float tf=((float)(256*qb-63)-need)*(1.f/64.f); int tt=tf>0.f?(int)tf:0; tt&=~1; if(tt>4*qb)tt=4*qb;
    T0[bhm*16+qb]=tt; UR[bhm*16+qb]=1.02f*qk; }
}
template<int THRL=8> __device__ __forceinline__ void attn_phase(char*lds,const AttnTensors&T,const int wid){
  volatile __attribute__((address_space(3))) int* slot=(volatile __attribute__((address_space(3))) int*)(lds+LDS_SLOT);
  const volatile __attribute__((address_space(3))) int* T0=(const volatile __attribute__((address_space(3))) int*)(lds+LDS_T0); const volatile __attribute__((address_space(3))) float* UR=(const volatile __attribute__((address_space(3))) float*)(lds+LDS_UREF);
  const bool lead=(wid==0)&&(lane_id()==0);
  if(lead) *slot=(int)__hip_atomic_fetch_add(T.queue,1u,__ATOMIC_RELAXED,__HIP_MEMORY_SCOPE_AGENT);
  attn_tables(lds,T.PN,wid*64+lane_id());
  asm volatile("s_waitcnt vmcnt(0) lgkmcnt(0)\n\ts_barrier":::"memory");
  int cur=__builtin_amdgcn_readfirstlane(*slot);
  asm volatile("s_waitcnt lgkmcnt(0)\n\ts_barrier":::"memory");
  while(cur<BATCH*8*NQB){
    int nxt=0; if(lead) nxt=(int)__hip_atomic_fetch_add(T.queue,1u,__ATOMIC_RELAXED,__HIP_MEMORY_SCOPE_AGENT);
    int b,hm,qb; unit_of(cur,b,hm,qb);
    const float cs=__builtin_bit_cast(float,__builtin_amdgcn_readfirstlane(__builtin_bit_cast(int,__builtin_amdgcn_exp2f(-2.f*(float)((hm>>1)+1))*1.4426950408889634f)));
    const int t0=__builtin_amdgcn_readfirstlane(T0[(b*8+hm)*16+qb]); const float uref=__builtin_bit_cast(float,__builtin_amdgcn_readfirstlane(__builtin_bit_cast(int,(float)UR[(b*8+hm)*16+qb])));
    attn_unit<THRL>(b,hm,qb,cs,wid,t0,uref,T.Q,T.K,T.V,T.O,lds,slot,nxt,lead);
    cur=__builtin_amdgcn_readfirstlane(*slot);
    asm volatile("s_waitcnt lgkmcnt(0)":::"memory");
  }
}
#undef SBAR
#undef WAIT_BAR
}
constexpr int NWAVES = 8;
constexpr int RING_OFF = 0, RING_BYTES = 131072;
constexpr int LDSCTL_OFF = RING_BYTES, MISC_OFF = LDSCTL_OFF + 320;
constexpr int LDS_BYTES = 163840;

#define XB_TMO      128
#define XB_XCNT(j)  (256  + 64 * (j))
#define XB_XSUB(j)  (1280 + 64 * (j))
#define XB_XGEN(j)  (2304 + 64 * (j))
#define XB_TOP      3328
#define XB_TOPGEN   3392
#define XCD_BAR_WORDS 3456
#define XB_SPIN_CAP (1u << 18)
__device__ __forceinline__ unsigned xb_ld(unsigned* p)              { return __hip_atomic_load(p, __ATOMIC_RELAXED, __HIP_MEMORY_SCOPE_AGENT); }
__device__ __forceinline__ unsigned xb_add(unsigned* p, unsigned v) { return __hip_atomic_fetch_add(p, v, __ATOMIC_RELAXED, __HIP_MEMORY_SCOPE_AGENT); }
__device__ __forceinline__ unsigned xb_xcc_id() { return (unsigned)__builtin_amdgcn_s_getreg((3 << 11) | 20) & 0xFu; }
#define XB_SPIN(cond, bar) do { unsigned _sp = 0; while (cond) { __builtin_amdgcn_s_sleep(1); \
    if ((++_sp & 255u) == 0u) { if (xb_ld(&(bar)[XB_TMO])) break; if (_sp > XB_SPIN_CAP) { atomicAdd(&(bar)[XB_TMO], 1u); break; } } } } while (0)
struct XcdBarrier { unsigned* bar; unsigned x; volatile LAS unsigned* st; bool wave0; };
__device__ __forceinline__ XcdBarrier xcd_barrier_post(unsigned* bar, volatile LAS unsigned* st) {
    XcdBarrier b; b.bar = bar; b.x = xb_xcc_id(); b.st = st; b.wave0 = __builtin_amdgcn_readfirstlane(threadIdx.x >> 6) == 0;
    if (threadIdx.x == 0) (void)xb_add(&bar[XB_XCNT(b.x)], 1u);
    return b;
}
__device__ __forceinline__ void xcd_barrier_complete(unsigned* bar, unsigned x, unsigned& nloc, unsigned& nx) {
    const unsigned G = gridDim.x * gridDim.y * gridDim.z;
    unsigned sum, cnt, mine, sp = 0u;
    for (;;) {
        sum = 0u; cnt = 0u; mine = 0u;
#pragma unroll
        for (unsigned j = 0; j < 16; ++j) { const unsigned c = xb_ld(&bar[XB_XCNT(j)]); sum += c; cnt += (c > 0u) ? 1u : 0u; mine = (j == x) ? c : mine; }
        if (sum == G) break;
        __builtin_amdgcn_s_sleep(1);
        if ((++sp & 255u) == 0u) { if (xb_ld(&bar[XB_TMO])) break; if (sp > XB_SPIN_CAP) { atomicAdd(&bar[XB_TMO], 1u); break; } }
    }
    nloc = mine > 0u ? mine : 1u; nx = cnt > 0u ? cnt : 1u;
}
__device__ __forceinline__ void xcd_barrier(const XcdBarrier& b) {
    asm volatile("s_waitcnt vmcnt(0)" ::: "memory");
    __syncthreads();
    if (b.wave0 && lane_id() == 0) {
        unsigned* bar = b.bar;
        __builtin_amdgcn_s_waitcnt(0);
        unsigned nloc = b.st[0], nx = b.st[1];
        if (nloc == 0u) { xcd_barrier_complete(bar, b.x, nloc, nx); b.st[0] = nloc; b.st[1] = nx; }
        const unsigned old = xb_add(&bar[XB_XSUB(b.x)], 1u);
        const unsigned gen = old / nloc;
        if (old + 1u == (gen + 1u) * nloc) {
            __builtin_amdgcn_fence(__ATOMIC_RELEASE, "agent");
            asm volatile("s_waitcnt vmcnt(0)" ::: "memory");
            const unsigned og = xb_add(&bar[XB_TOP], 1u);
            const unsigned tg = og / nx;
            if (og + 1u == (tg + 1u) * nx) xb_add(&bar[XB_TOPGEN], 1u);
            else XB_SPIN(xb_ld(&bar[XB_TOPGEN]) == tg, bar);
            __builtin_amdgcn_fence(__ATOMIC_ACQUIRE, "agent");
            xb_add(&bar[XB_XGEN(b.x)], 1u);
            asm volatile("s_waitcnt vmcnt(0)" ::: "memory");
        } else {
            XB_SPIN(xb_ld(&bar[XB_XGEN(b.x)]) == gen, bar);
            __builtin_amdgcn_fence(__ATOMIC_ACQUIRE, "agent");
            asm volatile("s_waitcnt vmcnt(0)" ::: "memory");
        }
    }
    __syncthreads();
}

struct Frame {
    LAS unsigned char* lds; volatile LAS unsigned* MISC; gu32* ctl;
    int tid, lane, wave, vcu, G;
};
__device__ __forceinline__ float bf2f_(unsigned short b) { return __builtin_bit_cast(float, (unsigned)b << 16); }
__device__ __forceinline__ float wave_sum(float v) {
#pragma unroll
    for (int o = 1; o < 64; o <<= 1) v += __shfl_xor(v, o);
    return v;
}
struct Ptrs {
    const float *x, *p, *w_in, *b_gate, *lq1, *lk1, *lq2, *lk2, *subln, *w_abr, *w_pmix, *pscale, *w_pbr, *w_out, *ln1g, *ln1b, *w_router, *b_router, *w_up, *b_up, *w_down, *b_down, *w_pg, *w_pp, *ln2g, *ln2b;
    float* out; unsigned char* ws;
};
constexpr int TI_IN = 16 * 128, TI_A = 8 * 32, TI_O = 16 * 32, TI_PG = 16 * 32, TI_PP = 4 * 32, TI_UP1 = 16 * 64, TI_DN1 = 16 * 32;
constexpr int TI_UP = NEXP * TI_UP1, TI_DN = NEXP * TI_DN1, TI_EARLY = TI_IN + TI_A + TI_O, TI_TOTAL = TI_EARLY + TI_PG + TI_PP + TI_UP + TI_DN;
#ifndef NCONV
#define NCONV 64
#endif
#ifndef NPOOL
#define NPOOL 0
#endif
struct TItem { const float* W; unsigned char* WT; int ldw, K, k0, n0, drow0, f8; float scale; };
__device__ __forceinline__ TItem p0_item(const Ptrs& P, int it) {
    unsigned char* ws = P.ws; TItem t; int r = it; t.f8 = 0; t.scale = 1.f;
    if (r < TI_IN) { const int nb = 128, n0 = 32 * (r % nb); t.W = P.w_in; t.ldw = 4096; t.K = 1024; t.k0 = 64 * (r / nb); t.n0 = n0;
        if (n0 >= 256 * PROJ_F8_FROM) { static_assert(PROJ_F8_FROM == 8 || PROJ_F8_FROM == 16, "gate-column interleave assumes the fp8 part is exactly the 2048 gate columns");
            const int gc = n0 - 2048, c = gc & 1023;
            t.WT = ws + WS_WIN8; t.drow0 = 256 * (c >> 7) + 128 * (gc >> 10) + (c & 127); t.f8 = 1; t.scale = WUP_SCALE; }
        else { t.WT = ws + WS_WIN; t.drow0 = n0; }
        return t; } r -= TI_IN;
    if (r < TI_A) { const int nb = 32; t.W = P.w_abr; t.ldw = 1024; t.K = 1024; t.WT = ws + WS_WCAT; t.k0 = 64 * (r / nb); t.n0 = t.drow0 = 32 * (r % nb); if (MIXG_FP8) { t.f8 = 1; t.scale = WUP_SCALE; } return t; } r -= TI_A;
    if (r < TI_O) { const int nb = 32; t.W = P.w_out; t.ldw = 1024; t.K = 1024; t.WT = ws + WS_WOUT; t.k0 = 64 * (r / nb); t.n0 = t.drow0 = 32 * (r % nb); return t; } r -= TI_O;
    if (r < TI_PG) { const int nb = 32; t.W = P.w_pg; t.ldw = 1024; t.K = 1024; t.WT = ws + WS_WPG; t.k0 = 64 * (r / nb); t.n0 = t.drow0 = 32 * (r % nb); if (MOE_FP8) { t.f8 = 1; t.scale = WUP_SCALE; } return t; } r -= TI_PG;
    if (r < TI_PP) { const int nb = 32; t.W = P.w_pp; t.ldw = 1024; t.K = 256; t.WT = ws + WS_WPP; t.k0 = 64 * (r / nb); t.n0 = t.drow0 = 32 * (r % nb); return t; } r -= TI_PP;
    if (r < TI_UP) { const int e = r / TI_UP1, q = r % TI_UP1, nb = 64, n0 = 32 * (q % nb);
        const int bj = n0 >> 10, pn = (n0 & 1023) >> 7, cp = n0 & 127;
        t.W = P.w_up + (size_t)e * 1024 * 2048; t.ldw = 2048; t.K = 1024; t.k0 = 64 * (q / nb); t.n0 = n0; t.drow0 = 256 * pn + 128 * bj + cp;
        if (MOE_FP8) { t.WT = ws + WS_WUP + (size_t)e * 2048 * 1024; t.f8 = 1; t.scale = WUP_SCALE; } else t.WT = ws + WS_WUP + (size_t)e * 2048 * 1024 * 2;
        return t; } r -= TI_UP;
    { const int e = r / TI_DN1, q = r % TI_DN1, nb = 32;
        t.W = P.w_down + (size_t)e * 1024 * 1024; t.ldw = 1024; t.K = 1024; t.k0 = 64 * (q / nb); t.n0 = t.drow0 = 32 * (q % nb);
        if (MOE_FP8) { t.WT = ws + WS_WDN + (size_t)e * 1024 * 1024; t.f8 = 1; t.scale = WDN_SCALE; } else t.WT = ws + WS_WDN + (size_t)e * 1024 * 1024 * 2; }
    return t;
}
__device__ __forceinline__ void p0_emit(const TItem& t, LAS float* scr, int lane) {
    if (t.f8) { const int c = lane & 3;
#pragma unroll
        for (int j = 0; j < 2; ++j) { const int n = (lane >> 2) + 16 * j; const LAS float* s = scr + (16 * c) * 33 + n;
            v4u o; o.x = pg8::pk4_fp8(s[0 * 33], s[1 * 33], s[2 * 33], s[3 * 33]); o.y = pg8::pk4_fp8(s[4 * 33], s[5 * 33], s[6 * 33], s[7 * 33]);
            o.z = pg8::pk4_fp8(s[8 * 33], s[9 * 33], s[10 * 33], s[11 * 33]); o.w = pg8::pk4_fp8(s[12 * 33], s[13 * 33], s[14 * 33], s[15 * 33]);
            *(GAS v4u*)(t.WT + (size_t)(t.drow0 + n) * t.K + t.k0 + 16 * c) = o; } }
    else { const int c = lane & 7;
#pragma unroll
        for (int j = 0; j < 4; ++j) { const int n = (lane >> 3) + 8 * j; const LAS float* s = scr + (8 * c) * 33 + n;
            v4u o; o.x = pk2(s[0 * 33], s[1 * 33]); o.y = pk2(s[2 * 33], s[3 * 33]); o.z = pk2(s[4 * 33], s[5 * 33]); o.w = pk2(s[6 * 33], s[7 * 33]);
            *(GAS v4u*)((bf16*)t.WT + (size_t)(t.drow0 + n) * t.K + t.k0 + 8 * c) = o; } }
}
#define P0_LOAD(T, V) do { const char* base_ = (const char*)(T.W + (size_t)T.k0 * T.ldw + T.n0); unsigned vo_ = (unsigned)(((lane >> 5) * T.ldw + (lane & 31)) * 4); const unsigned step_ = (unsigned)(T.ldw * 8); \
        _Pragma("unroll") for (int i = 0; i < 32; ++i) { V[i] = *(const float*)(base_ + vo_); vo_ += step_; } } while (0)
#define P0_DRAIN(T, V) do { _Pragma("unroll") for (int i = 0; i < 32; ++i) scr[(2 * i + (lane >> 5)) * 33 + (lane & 31)] = V[i] * T.scale; \
        LDS_WAIT(); asm volatile("" ::: "memory"); p0_emit(T, scr, lane); LDS_WAIT(); asm volatile("" ::: "memory"); } while (0)
__device__ __forceinline__ void conv_items(const Ptrs& P, int first, int last, int start, int stride, LAS float* scr, int lane) {
    int it = first + start; if (it >= last) return;
    TItem a = p0_item(P, it), b = p0_item(P, it + stride < last ? it + stride : it); bool two = it + stride < last;
    float va[32], vb[32], na[32], nb[32];
    P0_LOAD(a, va); if (two) P0_LOAD(b, vb);
    for (;;) {
        const int nt = it + 2 * stride; const bool more = nt < last, more2 = nt + stride < last;
        const TItem c = p0_item(P, more ? nt : it), d = p0_item(P, more2 ? nt + stride : it);
        if (more) P0_LOAD(c, na);
        if (more2) P0_LOAD(d, nb);
        P0_DRAIN(a, va); if (two) P0_DRAIN(b, vb);
        if (!more) break;
        it = nt; a = c; b = d; two = more2;
#pragma unroll
        for (int i = 0; i < 32; ++i) { va[i] = na[i]; vb[i] = nb[i]; }
    }
}
#undef P0_LOAD
#undef P0_DRAIN
__device__ __forceinline__ void ph0_prologue(Frame& F, const Ptrs& P) {
    unsigned char* ws = P.ws;
    LAS float* scr = (LAS float*)(F.lds + RING_OFF + F.wave * 16384);
    const int gw = F.vcu * NWAVES + F.wave, NGW = F.G * NWAVES;
    { const size_t n4 = (size_t)M * D / 4, st = (size_t)F.G * 512; const f32x4* src = (const f32x4*)P.x; unsigned long long* dst = (unsigned long long*)P.out;
      unsigned* dst8 = (unsigned*)(ws + WS_XF8);
      for (size_t i = (size_t)blockIdx.x * 512 + F.tid; i < n4; i += 8 * st) { f32x4 v[8];
#pragma unroll
          for (int u = 0; u < 8; ++u) v[u] = (i + u * st < n4) ? src[i + u * st] : (f32x4){0.f, 0.f, 0.f, 0.f};
#pragma unroll
          for (int u = 0; u < 8; ++u) if (i + u * st < n4) { dst[i + u * st] = (unsigned long long)pk2(v[u].x, v[u].y) | ((unsigned long long)pk2(v[u].z, v[u].w) << 32);
              if (PROJ_F8_FROM < 16) dst8[i + u * st] = pg8::pk4_fp8(v[u].x, v[u].y, v[u].z, v[u].w); } } }
    conv_items(P, 0, NCONV > 0 ? TI_EARLY : TI_TOTAL, gw, NGW, scr, F.lane);
    { bf16* WPC = (bf16*)(ws + WS_WCAT) + 512; unsigned char* WPC8 = ws + WS_WCAT + 512;
      for (int k = blockIdx.x; k < 512; k += F.G) { const int g = k >> 7;
          float a0 = 0.f, a1 = 0.f; const float* wm = P.w_pmix + (size_t)k * 128; const float* sc = P.pscale + g * 128; const float* wb = P.w_pbr + (size_t)(g * 128) * 1024;
          for (int d = 0; d < 128; ++d) { const float w = wm[d] * sc[d]; a0 += w * wb[(size_t)d * 1024 + F.tid]; a1 += w * wb[(size_t)d * 1024 + 512 + F.tid]; }
          if (MIXG_FP8) { WPC8[(size_t)F.tid * 1024 + k] = (unsigned char)(pg8::pk4_fp8(a0 * WUP_SCALE, 0.f, 0.f, 0.f) & 0xffu); WPC8[(size_t)(F.tid + 512) * 1024 + k] = (unsigned char)(pg8::pk4_fp8(a1 * WUP_SCALE, 0.f, 0.f, 0.f) & 0xffu); }
          else { WPC[(size_t)F.tid * 1024 + k] = (bf16)f2bf(a0); WPC[(size_t)(F.tid + 512) * 1024 + k] = (bf16)f2bf(a1); } } }
}
__device__ __forceinline__ void ph_pool(Frame& F, const Ptrs& P, const int wg, const int nwg) {
    const bf16* U = (const bf16*)(P.ws + WS_U); bf16* PO = (bf16*)(P.ws + WS_APO) + 512;
    constexpr int RL = 32;
    const size_t nitem = (size_t)(M / RL) * 64, st = (size_t)nwg * 512;
    for (size_t idx = (size_t)wg * 512 + F.tid; idx < nitem; idx += st) {
        const int cg = (int)(idx & 63), c0 = cg * 8, w = 2 << (c0 >> 7); const size_t r0 = (idx >> 6) * RL; const int pos0 = (int)(r0 & (SEQ - 1));
        const bf16* up = U + r0 * 512 + c0; bf16* op = PO + r0 * 1024 + c0; unsigned char* op8 = P.ws + WS_APO + 512 + r0 * 1024 + c0;
        float s[8] = {0.f, 0.f, 0.f, 0.f, 0.f, 0.f, 0.f, 0.f};
        const int nprev = pos0 < w ? pos0 : w;
        for (int k = 1; k <= nprev; ++k) { const v4u v = *(const v4u*)(up - (size_t)k * 512);
            s[0] += pg8::bflo(v.x); s[1] += pg8::bfhi(v.x); s[2] += pg8::bflo(v.y); s[3] += pg8::bfhi(v.y); s[4] += pg8::bflo(v.z); s[5] += pg8::bfhi(v.z); s[6] += pg8::bflo(v.w); s[7] += pg8::bfhi(v.w); }
        const float rw = 1.f / (float)w;
#pragma unroll 4
        for (int j = 0; j < RL; ++j) { const int pos = pos0 + j; const bool drop = pos >= w;
            const v4u cur = *(const v4u*)(up + (size_t)j * 512), old = *(const v4u*)(up + (size_t)(drop ? j - w : j) * 512);
            const float c[8] = {pg8::bflo(cur.x), pg8::bfhi(cur.x), pg8::bflo(cur.y), pg8::bfhi(cur.y), pg8::bflo(cur.z), pg8::bfhi(cur.z), pg8::bflo(cur.w), pg8::bfhi(cur.w)};
            const float o[8] = {pg8::bflo(old.x), pg8::bfhi(old.x), pg8::bflo(old.y), pg8::bfhi(old.y), pg8::bflo(old.z), pg8::bfhi(old.z), pg8::bflo(old.w), pg8::bfhi(old.w)};
            const float rn = pos + 1 < w ? 1.f / (float)(pos + 1) : rw; float r[8];
#pragma unroll
            for (int i = 0; i < 8; ++i) { s[i] += c[i]; if (drop) s[i] -= o[i]; r[i] = s[i] * rn - c[i]; }
            v4u ov; ov.x = pk2(r[0], r[1]); ov.y = pk2(r[2], r[3]); ov.z = pk2(r[4], r[5]); ov.w = pk2(r[6], r[7]);
            if (MIXG_FP8) { *(unsigned long long*)(op8 + (size_t)j * 1024) = (unsigned long long)pg8::pk4_fp8(r[0] * APO_SCALE, r[1] * APO_SCALE, r[2] * APO_SCALE, r[3] * APO_SCALE) | ((unsigned long long)pg8::pk4_fp8(r[4] * APO_SCALE, r[5] * APO_SCALE, r[6] * APO_SCALE, r[7] * APO_SCALE) << 32); }
            else *(v4u*)(op + (size_t)j * 1024) = ov; }
    }
}
__device__ __forceinline__ float lam_value(const Ptrs& P) { float a = 0.f, b = 0.f; for (int d = 0; d < 64; ++d) { a += P.lq1[d] * P.lk1[d]; b += P.lq2[d] * P.lk2[d]; } return __expf(a) - __expf(b) + 0.2f; }
__device__ __forceinline__ void ph_combine(Frame& F, const Ptrs& P) {
    const bf16* O16 = (const bf16*)(P.ws + WS_O16); bf16* OA = (bf16*)(P.ws + WS_APO); const float lam = lam_value(P);
    const int gw = F.vcu * NWAVES + F.wave, NGW = F.G * NWAVES, h = F.lane >> 4, e0 = (F.lane & 15) * 8;
    float sg[8];
#pragma unroll
    for (int j = 0; j < 8; ++j) sg[j] = P.subln[e0 + j] * 0.8f;
    v4u av[4], bv[4], nav[4], nbv[4];
#define PH3_LOAD(r0_, AV, BV) do { _Pragma("unroll") for (int u = 0; u < 4; ++u) { const int row = (r0_) + u * NGW; if (row < M) { AV[u] = *(const v4u*)(O16 + (size_t)row * 1024 + h * 256 + e0); BV[u] = *(const v4u*)(O16 + (size_t)row * 1024 + h * 256 + 128 + e0); } } } while (0)
    if (gw < M) PH3_LOAD(gw, av, bv);
    for (int row0 = gw; row0 < M; row0 += 4 * NGW) {
        if (row0 + 4 * NGW < M) PH3_LOAD(row0 + 4 * NGW, nav, nbv);
#pragma unroll
        for (int u = 0; u < 4; ++u) { const int row = row0 + u * NGW; if (row >= M) continue;
            f32x4 a0, a1, b0, b1; pg8::unpack8(av[u], a0, a1); pg8::unpack8(bv[u], b0, b1); a0 -= b0 * lam; a1 -= b1 * lam;
            float ss = (a0[0] * a0[0] + a0[1] * a0[1]) + (a0[2] * a0[2] + a0[3] * a0[3]) + (a1[0] * a1[0] + a1[1] * a1[1]) + (a1[2] * a1[2] + a1[3] * a1[3]);
            ss += __shfl_xor(ss, 1); ss += __shfl_xor(ss, 2); ss += __shfl_xor(ss, 4); ss += __shfl_xor(ss, 8);
            const float r = rsqrtf(ss * (1.f / 128.f) + LN_EPS);
#pragma unroll
            for (int j = 0; j < 4; ++j) { a0[j] *= r * sg[j]; a1[j] *= r * sg[4 + j]; }
            if (MIXG_FP8) { a0 *= APO_SCALE; a1 *= APO_SCALE; *(unsigned long long*)(P.ws + WS_APO + (size_t)row * 1024 + h * 128 + e0) = (unsigned long long)pg8::pk4_fp8(a0[0], a0[1], a0[2], a0[3]) | ((unsigned long long)pg8::pk4_fp8(a1[0], a1[1], a1[2], a1[3]) << 32); }
            else *(v4u*)(OA + (size_t)row * 1024 + h * 128 + e0) = pg8::pack8(a0, a1); }
#pragma unroll
        for (int u = 0; u < 4; ++u) { av[u] = nav[u]; bv[u] = nbv[u]; }
    }
#undef PH3_LOAD
}
__device__ __forceinline__ void conv_p(Frame& F, const Ptrs& P, const int wg, const int nwg) {
    const size_t n4 = (size_t)M * PLE / 4, st = (size_t)nwg * 512; const f32x4* src = (const f32x4*)P.p; unsigned long long* dst = (unsigned long long*)((unsigned char*)P.out + 128 * MiB);
    for (size_t i = (size_t)wg * 512 + F.tid; i < n4; i += 8 * st) { f32x4 v[8];
#pragma unroll
        for (int u = 0; u < 8; ++u) v[u] = (i + u * st < n4) ? src[i + u * st] : (f32x4){0.f, 0.f, 0.f, 0.f};
#pragma unroll
        for (int u = 0; u < 8; ++u) if (i + u * st < n4) dst[i + u * st] = (unsigned long long)pk2(v[u].x, v[u].y) | ((unsigned long long)pk2(v[u].z, v[u].w) << 32); }
}
typedef float f32x16_ __attribute__((ext_vector_type(16)));
__device__ __forceinline__ void hilo8(const f32x4& a, const f32x4& b, bf16x8& hi, bf16x8& lo) {
    unsigned h[4], l[4];
    h[0] = pg8::cvt_pk_bf16(a[0], a[1]); h[1] = pg8::cvt_pk_bf16(a[2], a[3]); h[2] = pg8::cvt_pk_bf16(b[0], b[1]); h[3] = pg8::cvt_pk_bf16(b[2], b[3]);
    l[0] = pg8::cvt_pk_bf16(a[0] - pg8::bflo(h[0]), a[1] - pg8::bfhi(h[0])); l[1] = pg8::cvt_pk_bf16(a[2] - pg8::bflo(h[1]), a[3] - pg8::bfhi(h[1]));
    l[2] = pg8::cvt_pk_bf16(b[0] - pg8::bflo(h[2]), b[1] - pg8::bfhi(h[2])); l[3] = pg8::cvt_pk_bf16(b[2] - pg8::bflo(h[3]), b[3] - pg8::bfhi(h[3]));
    v4u hv = {h[0], h[1], h[2], h[3]}, lv = {l[0], l[1], l[2], l[3]}; hi = __builtin_bit_cast(bf16x8, hv); lo = __builtin_bit_cast(bf16x8, lv);
}
__device__ __forceinline__ void ph6_ln1_route(Frame& F, const Ptrs& P, const bool dry) {
    unsigned char* ws = P.ws;
    constexpr int XT_OFF = 0, XT_PITCH = 1028, PL_OFF = 16 * XT_PITCH * 4, LG_OFF = PL_OFF + 8 * 16 * 32 * 4, RS_OFF = LG_OFF + 256 * 33 * 4;
    static_assert(RS_OFF + 256 <= RING_BYTES, "ph6 LDS map");
    if (NCONV == 0) conv_p(F, P, (int)blockIdx.x, F.G);
    const bf16* X1in = (const bf16*)(ws + WS_PRE1B); float* STAT = (float*)(ws + (dry ? 228 * MiB : WS_STAT)); unsigned char* X1F8 = ws + (dry ? 740 * MiB : WS_X1F8);
#define CI6(j) (8 * (lane + 64 * ((j) >> 1)) + 4 * ((j) & 1))
    const int lane = F.lane, wave = F.wave, e = lane & 31, kh = lane >> 5;
    LAS float* XT = (LAS float*)(F.lds + XT_OFF); LAS float* PL = (LAS float*)(F.lds + PL_OFF); LAS float* LG = (LAS float*)(F.lds + LG_OFF);
    bf16x8 bh[8], bl[8];
#pragma unroll
    for (int s = 0; s < 8; ++s) { const float* wp = P.w_router + (size_t)(128 * wave + 16 * s + 8 * kh) * 32 + e;
        const f32x4 a = {wp[0], wp[32], wp[64], wp[96]}, b = {wp[128], wp[160], wp[192], wp[224]}; hilo8(a, b, bh[s], bl[s]); }
    f32x4 gam[4], bet[4];
#pragma unroll
    for (int j = 0; j < 4; ++j) { gam[j] = *(const f32x4*)(P.ln1g + CI6(j)); bet[j] = *(const f32x4*)(P.ln1b + CI6(j)); }
    const float brt = P.b_router[e];
    for (int chunk = blockIdx.x; chunk < M / 256; chunk += F.G) {
        f32x4 v[2][4]; v4u nw[2][2];
#pragma unroll
        for (int i = 0; i < 2; ++i)
#pragma unroll
            for (int jj = 0; jj < 2; ++jj) nw[i][jj] = *(const v4u*)(X1in + (size_t)(chunk * 256 + 2 * wave + i) * 1024 + 8 * (lane + 64 * jj));
#pragma unroll 1
        for (int step = 0; step < 16; ++step) {
#pragma unroll
            for (int i = 0; i < 2; ++i)
#pragma unroll
                for (int jj = 0; jj < 2; ++jj) pg8::unpack8(nw[i][jj], v[i][2 * jj], v[i][2 * jj + 1]);
            if (step < 15) {
#pragma unroll
                for (int i = 0; i < 2; ++i)
#pragma unroll
                    for (int jj = 0; jj < 2; ++jj) nw[i][jj] = *(const v4u*)(X1in + (size_t)(chunk * 256 + (step + 1) * 16 + 2 * wave + i) * 1024 + 8 * (lane + 64 * jj)); }
            float s0 = 0.f, s1 = 0.f;
#pragma unroll
            for (int j = 0; j < 4; ++j) { s0 += (v[0][j].x + v[0][j].y) + (v[0][j].z + v[0][j].w); s1 += (v[1][j].x + v[1][j].y) + (v[1][j].z + v[1][j].w); }
#pragma unroll
            for (int o = 1; o < 64; o <<= 1) { s0 += __shfl_xor(s0, o); s1 += __shfl_xor(s1, o); }
            const float m0 = s0 * (1.f / 1024.f), m1 = s1 * (1.f / 1024.f); float q0 = 0.f, q1 = 0.f;
#pragma unroll
            for (int j = 0; j < 4; ++j) { v[0][j] = v[0][j] - m0; v[1][j] = v[1][j] - m1;
                q0 += (v[0][j].x * v[0][j].x + v[0][j].y * v[0][j].y) + (v[0][j].z * v[0][j].z + v[0][j].w * v[0][j].w); q1 += (v[1][j].x * v[1][j].x + v[1][j].y * v[1][j].y) + (v[1][j].z * v[1][j].z + v[1][j].w * v[1][j].w); }
#pragma unroll
            for (int o = 1; o < 64; o <<= 1) { q0 += __shfl_xor(q0, o); q1 += __shfl_xor(q1, o); }
            const float r0 = rsqrtf(q0 * (1.f / 1024.f) + LN_EPS), r1 = rsqrtf(q1 * (1.f / 1024.f) + LN_EPS);
#pragma unroll
            for (int i = 0; i < 2; ++i) { const int rl = 2 * wave + i; const size_t row = (size_t)chunk * 256 + step * 16 + rl; const float rs = i ? r1 : r0;
                if (lane == 0) { pg8::f32x2 sv = {i ? m1 : m0, rs}; *(pg8::f32x2*)(STAT + 2 * row) = sv; }
#pragma unroll
                for (int jj = 0; jj < 2; ++jj) { const f32x4 y0 = v[i][2 * jj] * rs * gam[2 * jj] + bet[2 * jj], y1 = v[i][2 * jj + 1] * rs * gam[2 * jj + 1] + bet[2 * jj + 1]; const int c = 8 * (lane + 64 * jj);
                    *(unsigned long long*)(X1F8 + row * 1024 + c) = (unsigned long long)pg8::pk4_fp8(y0.x, y0.y, y0.z, y0.w) | ((unsigned long long)pg8::pk4_fp8(y1.x, y1.y, y1.z, y1.w) << 32);
                    *(LAS f32x4*)(XT + rl * XT_PITCH + c) = y0; *(LAS f32x4*)(XT + rl * XT_PITCH + c + 4) = y1; } }
            __syncthreads();
            f32x16_ acc = {};
#pragma unroll
            for (int s = 0; s < 8; ++s) { const LAS float* xp = XT + (lane & 15) * XT_PITCH + 128 * wave + 16 * s + 8 * kh;
                const f32x4 a = *(const LAS f32x4*)xp, b = *(const LAS f32x4*)(xp + 4); bf16x8 ah, al; hilo8(a, b, ah, al);
                acc = __builtin_amdgcn_mfma_f32_32x32x16_bf16(ah, bh[s], acc, 0, 0, 0); acc = __builtin_amdgcn_mfma_f32_32x32x16_bf16(al, bh[s], acc, 0, 0, 0); acc = __builtin_amdgcn_mfma_f32_32x32x16_bf16(ah, bl[s], acc, 0, 0, 0); }
#pragma unroll
            for (int i = 0; i < 8; ++i) PL[(wave * 16 + (i & 3) + 8 * (i >> 2) + 4 * kh) * 32 + e] = acc[i];
            __syncthreads();
            { const int row = F.tid >> 5, ee = F.tid & 31; float sum = 0.f;
#pragma unroll
              for (int w = 0; w < 8; ++w) sum += PL[(w * 16 + row) * 32 + ee];
              LG[(step * 16 + row) * 33 + ee] = sum + __shfl(brt, ee); }
        }
        __syncthreads();
        LAS int* cntl = (LAS int*)(F.lds + RS_OFF); LAS int* basel = cntl + 32;
        if (F.tid < 32) cntl[F.tid] = 0;
        int my_e[4] = {0, 0, 0, 0}; float my_g[4] = {0.f, 0.f, 0.f, 0.f};
        if (F.tid < 256) { float lg[32];
#pragma unroll
            for (int k = 0; k < 32; ++k) lg[k] = LG[F.tid * 33 + k];
            float tv[4];
#pragma unroll
            for (int r = 0; r < 4; ++r) { float bv = lg[0]; int bi = 0;
#pragma unroll
                for (int k = 1; k < 32; ++k) if (lg[k] > bv) { bv = lg[k]; bi = k; }
                tv[r] = bv; my_e[r] = bi;
#pragma unroll
                for (int k = 0; k < 32; ++k) if (k == bi) lg[k] = -INFINITY; }
            const float e1 = __expf(tv[1] - tv[0]), e2 = __expf(tv[2] - tv[0]), e3 = __expf(tv[3] - tv[0]), rs = 1.f / (1.f + e1 + e2 + e3);
            my_g[0] = rs; my_g[1] = e1 * rs; my_g[2] = e2 * rs; my_g[3] = e3 * rs; }
        __syncthreads();
        int rk[4] = {0, 0, 0, 0};
        if (F.tid < 256) {
#pragma unroll
            for (int k = 0; k < 4; ++k) rk[k] = __hip_atomic_fetch_add(&cntl[my_e[k]], 1, __ATOMIC_RELAXED, __HIP_MEMORY_SCOPE_WORKGROUP); }
        __syncthreads();
        if (F.tid < 32) basel[F.tid] = (int)__hip_atomic_fetch_add(F.ctl + CW_CNT + (dry ? 32 : 0) + F.tid, (unsigned)cntl[F.tid], RLX_AGENT);
        __syncthreads();
        if (F.tid < 256) { const int row = chunk * 256 + F.tid; int* LIST = (int*)(ws + (dry ? 836 * MiB : WS_LIST)); float* GATEL = (float*)(ws + (dry ? 844 * MiB : WS_GATEL)); float* GATE = (float*)(ws + (dry ? 852 * MiB : WS_GATE));
#pragma unroll
            for (int k = 0; k < 4; ++k) { const size_t o = (size_t)my_e[k] * 65536 + (size_t)(basel[my_e[k]] + rk[k]); LIST[o] = row * 4 + k; GATEL[o] = my_g[k]; GATE[row * 4 + k] = my_g[k]; } }
        __syncthreads();
    }
}
__device__ __forceinline__ void ph10_final(Frame& F, const Ptrs& P, const bool dry) {
    float* dst = dry ? (float*)(P.ws + 356 * MiB) : P.out;
    const bf16* PLEB = (const bf16*)(P.ws + WS_PLE); const unsigned char* YS0 = P.ws + WS_YS; const unsigned char* YS1 = YS0 + YS_STRIDE; const unsigned char* YS2 = YS1 + YS_STRIDE; const unsigned char* YS3 = YS2 + YS_STRIDE;
    const int gw = F.vcu * NWAVES + F.wave, NGW = F.G * NWAVES, lane = F.lane;
    f32x4 gam[4], bet[4];
#pragma unroll
    for (int j = 0; j < 4; ++j) { gam[j] = *(const f32x4*)(P.ln2g + CI6(j)); bet[j] = *(const f32x4*)(P.ln2b + CI6(j)); }
    v4u pw[2], npw[2]; unsigned long long ys[2][4], nys[2][4];
#define PH10_LOAD(row_, PW, YS_) do { _Pragma("unroll") for (int jj = 0; jj < 2; ++jj) { const size_t o8 = (size_t)(row_) * 128 + lane + 64 * jj;     \
        PW[jj] = ((const v4u*)PLEB)[o8]; YS_[jj][0] = ((const unsigned long long*)YS0)[o8]; YS_[jj][1] = ((const unsigned long long*)YS1)[o8]; YS_[jj][2] = ((const unsigned long long*)YS2)[o8]; YS_[jj][3] = ((const unsigned long long*)YS3)[o8]; } } while (0)
    if (gw < M) PH10_LOAD(gw, pw, ys);
    for (int row = gw; row < M; row += NGW) {
        if (row + NGW < M) PH10_LOAD(row + NGW, npw, nys);
        f32x4 v[4]; float s = 0.f;
#pragma unroll
        for (int jj = 0; jj < 2; ++jj) { const unsigned long long ya = ys[jj][0], yb = ys[jj][1], yc = ys[jj][2], yd = ys[jj][3];
            pg8::unpack8(pw[jj], v[2 * jj], v[2 * jj + 1]);
#pragma unroll
            for (int h = 0; h < 2; ++h) { const unsigned a = (unsigned)(ya >> (32 * h)), b = (unsigned)(yb >> (32 * h)), c = (unsigned)(yc >> (32 * h)), d = (unsigned)(yd >> (32 * h)); constexpr float is = 1.f / YS_SCALE; const int j = 2 * jj + h;
              typedef float f32x2_ __attribute__((ext_vector_type(2)));
              const f32x2_ a0 = __builtin_amdgcn_cvt_pk_f32_fp8(a, false), a1 = __builtin_amdgcn_cvt_pk_f32_fp8(a, true), b0 = __builtin_amdgcn_cvt_pk_f32_fp8(b, false), b1 = __builtin_amdgcn_cvt_pk_f32_fp8(b, true);
              const f32x2_ c0 = __builtin_amdgcn_cvt_pk_f32_fp8(c, false), c1 = __builtin_amdgcn_cvt_pk_f32_fp8(c, true), d0 = __builtin_amdgcn_cvt_pk_f32_fp8(d, false), d1 = __builtin_amdgcn_cvt_pk_f32_fp8(d, true);
              v[j].x += ((a0[0] + b0[0]) + (c0[0] + d0[0])) * is; v[j].y += ((a0[1] + b0[1]) + (c0[1] + d0[1])) * is; v[j].z += ((a1[0] + b1[0]) + (c1[0] + d1[0])) * is; v[j].w += ((a1[1] + b1[1]) + (c1[1] + d1[1])) * is;
              s += (v[j].x + v[j].y) + (v[j].z + v[j].w); } }
        const float mean = wave_sum(s) * (1.f / 1024.f); float s2 = 0.f;
#pragma unroll
        for (int j = 0; j < 4; ++j) { v[j] = v[j] - mean; s2 += (v[j].x * v[j].x + v[j].y * v[j].y) + (v[j].z * v[j].z + v[j].w * v[j].w); }
        const float rstd = rsqrtf(wave_sum(s2) * (1.f / 1024.f) + LN_EPS);
#pragma unroll
        for (int j = 0; j < 4; ++j) *(f32x4*)(dst + (size_t)row * 1024 + CI6(j)) = v[j] * rstd * gam[j] + bet[j];
#pragma unroll
        for (int jj = 0; jj < 2; ++jj) { pw[jj] = npw[jj];
#pragma unroll
            for (int k = 0; k < 4; ++k) ys[jj][k] = nys[jj][k]; }
    }
#undef PH10_LOAD
}
__device__ __forceinline__ void moe_tables(Frame& F) {
    LAS int* cnt = (LAS int*)(F.lds + pg8::TAB_CNT); LAS int* blk0 = (LAS int*)(F.lds + pg8::TAB_BLK0); LAS int* row0 = (LAS int*)(F.lds + pg8::TAB_ROW0);
    __syncthreads();
    if (F.tid < 32) cnt[F.tid] = (int)__hip_atomic_load(F.ctl + CW_CNT + F.tid, RLX_AGENT);
    __syncthreads();
    if (F.tid == 0) { int b = 0, r = 0; for (int e = 0; e < 32; ++e) { blk0[e] = b; row0[e] = r; b += (cnt[e] + 255) >> 8; r += cnt[e]; } blk0[32] = b; row0[32] = r; }
    __syncthreads();
}

constexpr int NPHASE = 11;
struct Args { Ptrs P; int ph_lo, ph_hi; };
__global__ void __launch_bounds__(NWAVES * 64, 2) mk_fwd(Args args) {
    extern __shared__ __attribute__((aligned(16))) unsigned char lds[];
    Frame F; const Ptrs& P = args.P;
    F.lds = (LAS unsigned char*)lds; F.MISC = (volatile LAS unsigned*)(F.lds + MISC_OFF);
    F.wave = __builtin_amdgcn_readfirstlane(threadIdx.x >> 6); F.lane = lane_id(); F.tid = F.wave * 64 + F.lane;
#define REFRESH() do { F.lane = lane_id(); asm volatile("" : "+v"(F.lane)); F.tid = F.wave * 64 + F.lane; } while (0)
    F.G = gridDim.x; { const int bx = blockIdx.x; F.vcu = (F.G % 8 == 0) ? (bx % 8) * (F.G / 8) + bx / 8 : bx; }
    unsigned char* ws = P.ws; F.ctl = (gu32*)(ws + WS_CTL);
    for (int u = F.tid; u < 1024 / 4; u += NWAVES * 64) ((LAS unsigned*)(F.lds + LDSCTL_OFF))[u] = 0u;
    __syncthreads();
    const int lo = args.ph_lo, hi = args.ph_hi;
    XcdBarrier bar = xcd_barrier_post((unsigned*)(F.ctl + CW_BAR) + lo * XCD_BAR_WORDS, F.MISC + 8);
#define IN(k) (lo <= (k) && (k) < hi)
#define SEAM(k) do { if (IN(k) && IN((k) + 1)) xcd_barrier(bar); } while (0)
    bf16 *XB = (bf16*)P.out, *Q = (bf16*)(ws + WS_Q), *K = (bf16*)(ws + WS_K), *V = (bf16*)(ws + WS_V), *U = (bf16*)(ws + WS_U), *G = (bf16*)(ws + WS_G);
    bf16 *O16 = (bf16*)(ws + WS_O16), *APO = (bf16*)(ws + WS_APO), *MIX = (bf16*)(ws + WS_MIX), *X1B = (bf16*)(ws + WS_X1B), *HB = (bf16*)(ws + WS_HB), *PB = (bf16*)((unsigned char*)P.out + 128 * MiB);
    bf16* T = (bf16*)P.out;

    if (IN(0)) { REFRESH(); ph0_prologue(F, P); } SEAM(0);
    if (IN(1)) {
        const int flip = (PROJ_F8_FROM < 16) ? (((int)blockIdx.x >> 3) & 1) : 0;
        REFRESH(); { const f32x4 bgv = ((const f32x4*)P.b_gate)[F.tid]; ((LAS f32x4*)(F.lds + pg8::TAB_OFF))[F.tid] = bgv; } __syncthreads();
#pragma unroll 1
        for (int pass = 0; pass < 2; ++pass) {
            if ((pass ^ flip) == 0) { pg8::Gemm g{XB, (const bf16*)(ws + WS_WIN), 1024}; pg8::StaticOrder S; S.init(M, 256 * (PROJ_F8_FROM < 16 ? PROJ_F8_FROM : 16), F.G, (int)blockIdx.x);
              pg8::EpiProj E{Q, K, V, U, G, P.b_gate, (float*)(F.ctl + CW_PN), C2Q, 1.f, 0, 0};
              pg8::gemm_phase(F.lds, F.wave, g, S, E); }
            else if (PROJ_F8_FROM < 16) {
              pg8::Gemm g{(const bf16*)(ws + WS_XF8), (const bf16*)(ws + WS_WIN8), 512}; pg8::DenseF8Order S; S.init(M, 256 * (16 - PROJ_F8_FROM), F.G, (int)blockIdx.x);
              pg8::EpiProj E{Q, K, V, U, G, P.b_gate, (float*)(F.ctl + CW_PN), C2Q, 1.f / WUP_SCALE, PROJ_F8_FROM, 0};
              pg8::gemm_phase(F.lds, F.wave, g, S, E); }
        }
    } SEAM(1);
    if (IN(2)) {
        if (NCONV > 0 && (int)blockIdx.x < NCONV) {
            REFRESH(); conv_items(P, TI_EARLY, TI_TOTAL, (int)blockIdx.x * NWAVES + F.wave, NCONV * NWAVES, (LAS float*)(F.lds + RING_OFF + F.wave * 16384), F.lane); __syncthreads();
            REFRESH(); conv_p(F, P, (int)blockIdx.x, NCONV); }
        if (NPOOL > 0 && (int)blockIdx.x >= NCONV && (int)blockIdx.x < NCONV + NPOOL) { REFRESH(); ph_pool(F, P, (int)blockIdx.x - NCONV, NPOOL); }
        const attn_body::AttnTensors AT{(const attn_body::bf16*)Q, (const attn_body::bf16*)K, (const attn_body::bf16*)V, (attn_body::bf16*)O16, (const float*)(F.ctl + CW_PN), (unsigned*)(F.ctl + CW_AQ)};
        attn_body::attn_phase<-1>((char*)lds + RING_OFF, AT, F.wave);
        if (NPOOL == 0) { REFRESH(); ph_pool(F, P, (int)blockIdx.x, F.G); }
    } SEAM(2);
    if (IN(3)) { REFRESH(); ph_combine(F, P); } SEAM(3);
    if (IN(4)) {
        if (MIXG_FP8) { pg8::DenseF8Order S; S.init(M, 1024, F.G, (int)blockIdx.x);
            pg8::Gemm g{APO, (const bf16*)(ws + WS_WCAT), 512}; pg8::EpiMixCat E{MIX, G, 1.f / (APO_SCALE * WUP_SCALE), 0}; pg8::gemm_phase(F.lds, F.wave, g, S, E); }
        else { pg8::StaticOrder S; S.init(M, 1024, F.G, (int)blockIdx.x);
            pg8::Gemm g{APO, (const bf16*)(ws + WS_WCAT), 1024}; pg8::EpiMixCat E{MIX, G, 1.f, 0}; pg8::gemm_phase(F.lds, F.wave, g, S, E); }
    } SEAM(4);
    if (IN(5)) {
        pg8::Gemm g{MIX, (const bf16*)(ws + WS_WOUT), 1024}; pg8::StaticOrder S; S.init(M, 1024, F.G, (int)blockIdx.x);
        pg8::EpiPre1 E{(bf16*)(ws + WS_PRE1B), XB, ALPHA, 0};
        pg8::gemm_phase(F.lds, F.wave, g, S, E);
    } SEAM(5);
    if (IN(6)) { REFRESH(); ph6_ln1_route(F, P, false); } SEAM(6);
    if (IN(7)) {
        pg8::StaticOrder S; S.init(M, 1024, F.G, (int)blockIdx.x);
        { pg8::Gemm g{PB, (const bf16*)(ws + WS_WPP), 256}; pg8::EpiPle<1> E{T, nullptr, nullptr, nullptr, nullptr, nullptr, 1.f, 0.f}; pg8::gemm_phase(F.lds, F.wave, g, S, E); }
        VM_WAIT(); __syncthreads();
        if (MOE_FP8) { pg8::DenseF8Order S8; S8.init(M, 1024, F.G, (int)blockIdx.x);
            pg8::Gemm g{(const bf16*)(ws + WS_X1F8), (const bf16*)(ws + WS_WPG), 512}; pg8::EpiPle<3> E{(bf16*)(ws + WS_PLE), T, (const bf16*)(ws + WS_PRE1B), (const float*)(ws + WS_STAT), P.ln1g, P.ln1b, 1.f / WUP_SCALE, ALPHA}; pg8::gemm_phase(F.lds, F.wave, g, S8, E); }
        else { pg8::Gemm g{X1B, (const bf16*)(ws + WS_WPG), 1024}; pg8::EpiPle<3> E{(bf16*)(ws + WS_PLE), T, (const bf16*)(ws + WS_PRE1B), (const float*)(ws + WS_STAT), P.ln1g, P.ln1b, 1.f, ALPHA}; pg8::gemm_phase(F.lds, F.wave, g, S, E); }
    }
    if (IN(8)) {
        REFRESH(); moe_tables(F);
        pg8::Gemm g{MOE_FP8 ? (const bf16*)(ws + WS_X1F8) : X1B, (const bf16*)(ws + WS_WUP), MOE_FP8 ? 512 : 1024};
        pg8::MoeOrder<true, MOE_FP8> S{8, F.G, (int)blockIdx.x, (const int*)(ws + WS_LIST), (const float*)(ws + WS_GATEL), (size_t)2048 * 1024 * (MOE_FP8 ? 1 : 2), P.b_up};
        pg8::EpiUp<MOE_FP8> E{HB, P.b_up, MOE_FP8 ? 1.f / WUP_SCALE : 1.f, 0};
        pg8::gemm_phase(F.lds, F.wave, g, S, E);
    } SEAM(8);
    if (IN(9)) {
        REFRESH(); moe_tables(F);
        pg8::Gemm g{HB, (const bf16*)(ws + WS_WDN), MOE_FP8 ? 512 : 1024};
        pg8::MoeOrder<false, MOE_FP8> S{4, F.G, (int)blockIdx.x, (const int*)(ws + WS_LIST), (const float*)(ws + WS_GATEL), (size_t)1024 * 1024 * (MOE_FP8 ? 1 : 2), P.b_down};
        pg8::EpiDown E{ws + WS_YS, YS_STRIDE, P.b_down, MOE_FP8 ? 1.f / (WDN_SCALE) : 1.f, YS_SCALE};
        pg8::gemm_phase(F.lds, F.wave, g, S, E);
    } SEAM(9);
    if (IN(10)) { REFRESH(); ph10_final(F, P, false); }
#undef IN
#undef SEAM
}
extern "C" void kernel_launch(void* const* d_in, const int* in_sizes, int n_in, void* d_out, int out_size, void* d_ws, size_t ws_size, hipStream_t stream) {
    static int grid = 0;
    if (grid == 0) {
        if (n_in != 26 || in_sizes[0] != M * D || ws_size < WS_END || out_size != M * D) { fprintf(stderr, "kernel_launch: unexpected shapes (n_in %d, ws %zu, out %d); nothing launched\n", n_in, ws_size, out_size); grid = -1; return; }
        int dev = 0, cus = 0, per_cu = 0;
        if (hipGetDevice(&dev) != hipSuccess || hipDeviceGetAttribute(&cus, hipDeviceAttributeMultiprocessorCount, dev) != hipSuccess) { fprintf(stderr, "kernel_launch: device query failed; nothing launched\n"); grid = -1; return; }
        if (hipFuncSetAttribute((const void*)mk_fwd, hipFuncAttributeMaxDynamicSharedMemorySize, LDS_BYTES) != hipSuccess) { fprintf(stderr, "kernel_launch: hipFuncSetAttribute failed (%d bytes of dynamic LDS); nothing launched\n", LDS_BYTES); grid = -1; return; }
        if (hipOccupancyMaxActiveBlocksPerMultiprocessor(&per_cu, (const void*)mk_fwd, NWAVES * 64, LDS_BYTES) != hipSuccess || per_cu < 1) fprintf(stderr, "kernel_launch: note: occupancy query reports %d workgroups per CU\n", per_cu);
        (void)hipGetLastError();
        grid = cus;
    }
    if (grid < 0) return;
    if (hipMemsetAsync((char*)d_ws + WS_CTL, 0, CTL_ZERO_BYTES, stream) != hipSuccess) { fprintf(stderr, "kernel_launch: hipMemsetAsync failed; nothing launched\n"); return; }
    Args a{};
    { const float** pp = (const float**)&a.P; for (int i = 0; i < 26; ++i) pp[i] = (const float*)d_in[i]; }
    a.P.out = (float*)d_out; a.P.ws = (unsigned char*)d_ws; a.ph_lo = 0; a.ph_hi = NPHASE;
    hipLaunchKernelGGL(mk_fwd, dim3(grid), dim3(NWAVES * 64), LDS_BYTES, stream, a);
}
```

```cpp
#include <hip/hip_runtime.h>
#include <hip/hip_bf16.h>
#include <cstdio>
#include <cstdint>
#include <cmath>

#define GAS __attribute__((address_space(1)))
#define LAS __attribute__((address_space(3)))
typedef unsigned short bf16;
typedef unsigned v4u __attribute__((ext_vector_type(4)));
typedef float f32x4 __attribute__((ext_vector_type(4)));
typedef short bf16x8 __attribute__((ext_vector_type(8)));
typedef GAS unsigned gu32;
typedef GAS unsigned long long gu64;
#define RLX_AGENT __ATOMIC_RELAXED, __HIP_MEMORY_SCOPE_AGENT
#define LDS_WAIT() asm volatile("s_waitcnt lgkmcnt(0)" ::: "memory")
#define VM_WAIT() asm volatile("s_waitcnt vmcnt(0)" ::: "memory")
__device__ __forceinline__ unsigned f2bf(float f) { unsigned u = __builtin_bit_cast(unsigned, f); return (u + 0x7fffu + ((u >> 16) & 1u)) >> 16; }
__device__ __forceinline__ unsigned pk2(float lo, float hi) { return f2bf(lo) | (f2bf(hi) << 16); }

__device__ __forceinline__ int lane_id() { return (int)__builtin_amdgcn_mbcnt_hi(~0u, __builtin_amdgcn_mbcnt_lo(~0u, 0u)); }

constexpr int BATCH = 16, SEQ = 4096, D = 1024, M = BATCH * SEQ;
constexpr int NEXP = 32, TOPK = 4, NASSIGN = M * TOPK, FF = 1024, PLE = 256;
constexpr float LN_EPS = 1e-5f;
constexpr float ALPHA = 1.189207115002721f;
constexpr float C2Q = 0.125f * 1.4426950408889634f;

constexpr size_t MiB = 1u << 20;
constexpr size_t WS_CTL = 0, CTL_ZERO_BYTES = 1 * MiB;
constexpr size_t WS_LIST = 1 * MiB;
constexpr size_t WS_GATEL = 9 * MiB;
constexpr size_t WS_GATE = 17 * MiB;
constexpr size_t WS_WPCF = 18 * MiB;
constexpr size_t WS_WIN = 20 * MiB, WS_WCAT = 28 * MiB, WS_WOUT = 30 * MiB, WS_WPG = 32 * MiB, WS_WPP = 34 * MiB;
constexpr size_t WS_WDN = 36 * MiB, WS_WUP = 100 * MiB;
constexpr size_t WS_APO = 228 * MiB;
constexpr size_t WS_X1B = 228 * MiB;
constexpr size_t WS_Q = 356 * MiB, WS_K = 420 * MiB, WS_V = 484 * MiB, WS_U = 548 * MiB;
constexpr size_t WS_G = 612 * MiB;
constexpr size_t WS_O16 = 868 * MiB;
constexpr size_t WS_MIX = 356 * MiB;
constexpr size_t WS_HB = 356 * MiB;
constexpr size_t WS_YS = 100 * MiB, YS_STRIDE = 64 * MiB;
constexpr size_t WS_PRE1B = 612 * MiB;
constexpr size_t WS_STAT = 18 * MiB;
constexpr size_t WS_X1F8 = 900 * MiB;
constexpr size_t WS_PLE = 740 * MiB;
constexpr size_t WS_END = 1024 * MiB;
#ifndef MOE_FP8
#define MOE_FP8 1
#endif
constexpr float WUP_SCALE = 32.f, WDN_SCALE = 64.f;
#ifndef PROJ_F8_FROM
#define PROJ_F8_FROM 8
#endif
constexpr size_t WS_XF8 = 900 * MiB;
constexpr size_t WS_WIN8 = WS_WIN + (size_t)PROJ_F8_FROM * 256 * 1024 * 2;
#ifndef MIXG_FP8
#define MIXG_FP8 1
#endif
constexpr float APO_SCALE = 16.f;
constexpr float YS_SCALE = 16.f;
constexpr int cv_NBG = 790 + 64 + M / 256;
constexpr float ATT_SKIP = 40.f;
constexpr int CW_TMO = 0, CW_CODE = 1;
constexpr int CW_CNT = 64;
constexpr int CW_AQ = 128;
constexpr int CW_PN = 65536;
constexpr int CW_BAR = 4096;
namespace pg8 {
#define PG8_LAS __attribute__((address_space(3)))
typedef unsigned short bf16_t;
typedef unsigned u32x4 __attribute__((ext_vector_type(4)));
typedef float f32x2 __attribute__((ext_vector_type(2)));
constexpr int BM = 256, BK = 64, HALF = 128, HTB = HALF * BK * 2  , STAGE_BYTES = 8 * HTB, NXCD = 8, WGM = 8;
constexpr int TAB_OFF = 131072 + 1024;
constexpr int TAB_CNT = TAB_OFF, TAB_BLK0 = TAB_OFF + 128, TAB_ROW0 = TAB_OFF + 384, TAB_IDS = TAB_OFF + 1024, TAB_GATES = TAB_OFF + 1024 + 2048, TAB_BIAS = TAB_OFF + 1024 + 4096;

__host__ __device__ __forceinline__ int lds_byte(int r, int c) { const int st = (r >> 4) * 2 + (c >> 5), rr = r & 15, cc = c & 31, ob = rr * 64 + cc * 2; return st * 1024 + (ob ^ (((ob >> 9) & 1) << 5)); }
__host__ __device__ __forceinline__ void stage_rc(int b, int& R, int& C) { const int st = b / 1024, sb = b % 1024, swz = sb ^ (((sb >> 9) & 1) << 5); R = (st >> 1) * 16 + swz / 64; C = (st & 1) * 32 + (swz % 64) / 2; }
__host__ __device__ __forceinline__ int perm16h(int rho) { return 64 * (rho >> 5) + 16 * ((rho & 15) >> 2) + 4 * ((rho >> 4) & 1) + (rho & 3); }
__host__ __device__ __forceinline__ int perm32(int rho) { const int n = rho >> 4, i = rho & 15; return 8 * (i >> 2) + 4 * n + (i & 3); }

struct Unit { int pm, pn, e, nvalid; };
struct Gemm { const bf16_t* A; const bf16_t* Bt; int K; };

struct StaticOrder {
    static constexpr bool TABLES = false, FP8 = false;
    int nM, nN, nwg, G, c;
    __host__ __device__ void init(int M, int N, int G_, int c_) { nM = M / BM; nN = N / BM; nwg = nM * nN; G = G_; c = c_; }
    __device__ __forceinline__ bool next(int i, Unit& u, PG8_LAS unsigned char*) const {
        const long L = (long)i * G + c; if (L >= nwg) return false;
        int wgid = (int)L; { const int q = nwg / NXCD, r = nwg % NXCD, xcd = wgid % NXCD, off = wgid / NXCD; wgid = (xcd < r ? xcd * (q + 1) : r * (q + 1) + (xcd - r) * q) + off; }
        const int nig = WGM * nN, gid = wgid / nig, fm = gid * WGM, gsz = (nM - fm) < WGM ? (nM - fm) : WGM;
        u.pm = fm + ((wgid % nig) % gsz); u.pn = (wgid % nig) / gsz; u.e = 0; u.nvalid = 256; return true;
    }
    __device__ __forceinline__ const char* b_tile(const Gemm& g, const Unit& u) const { return (const char*)g.Bt + (size_t)u.pn * (size_t)(BM * 2) * g.K; }
    __device__ __forceinline__ void a_offsets(const Gemm& g, const Unit& u, PG8_LAS unsigned char*, int, const int (&R)[2], const int (&C)[2], unsigned (&off)[2][2]) const {
#pragma unroll
        for (int h = 0; h < 2; ++h)
#pragma unroll
            for (int i = 0; i < 2; ++i) off[h][i] = (unsigned)(((u.pm * BM + h * HALF + R[i]) * g.K + C[i]) * 2);
    }
    __device__ __forceinline__ void issue_tables(const Unit&, PG8_LAS unsigned char*, int, int) const {}
};

struct DenseF8Order : StaticOrder { static constexpr bool FP8 = true; };

template <bool GATHER_, bool FP8_> struct MoeOrder {
    static constexpr bool TABLES = true; static constexpr bool GATHER = GATHER_, FP8 = FP8_;
    int NT, G, c; const int* LIST; const float* GATEL; size_t bstride; const float* bias;
    __device__ __forceinline__ bool next(int i, Unit& u, PG8_LAS unsigned char* lds) const {
        const PG8_LAS int* cnt = (const PG8_LAS int*)(lds + TAB_CNT); const PG8_LAS int* blk0 = (const PG8_LAS int*)(lds + TAB_BLK0);
        int cp = c; if (G == 256) cp = NT == 8 ? (((c & 7) + 8 * (c >> 6)) * 8 + ((c >> 3) & 7)) : (((c & 7) + 8 * (c >> 5)) * 4 + ((c >> 3) & 3));
        const int L = i * G + cp; const int total = blk0[32] * NT; if (L >= total) return false;
        const int blk = L / NT;
        const int ln = (int)__builtin_amdgcn_mbcnt_hi(~0u, __builtin_amdgcn_mbcnt_lo(~0u, 0u)); const int bv = blk0[ln & 31];
        const int e = __builtin_popcountll(__builtin_amdgcn_ballot_w64(ln >= 1 && ln < 32 && blk >= bv));
        u.e = e; u.pm = __builtin_amdgcn_readfirstlane(blk - blk0[e]); u.pn = L % NT; const int left = __builtin_amdgcn_readfirstlane(cnt[e]) - 256 * u.pm; u.nvalid = left < 256 ? left : 256; return true;
    }
    __device__ __forceinline__ const char* b_tile(const Gemm& g, const Unit& u) const { return (const char*)g.Bt + (size_t)u.e * bstride + (size_t)u.pn * (size_t)(BM * 2) * g.K; }
    __device__ __forceinline__ void a_offsets(const Gemm& g, const Unit& u, PG8_LAS unsigned char* lds, int buf, const int (&R)[2], const int (&C)[2], unsigned (&off)[2][2]) const {
        const PG8_LAS int* ids = (const PG8_LAS int*)(lds + TAB_IDS) + buf * 256; const PG8_LAS int* row0 = (const PG8_LAS int*)(lds + TAB_ROW0);
#pragma unroll
        for (int h = 0; h < 2; ++h)
#pragma unroll
            for (int i = 0; i < 2; ++i) { const int r = h * HALF + R[i];
                if (GATHER) { const int tok = (r < u.nvalid) ? (ids[r] >> 2) : 0; off[h][i] = (unsigned)((tok * g.K + C[i]) * 2); }
                else off[h][i] = (unsigned)(((row0[u.e] + u.pm * BM + r) * g.K + C[i]) * 2); }
    }
    __device__ __forceinline__ void issue_tables(const Unit& u, PG8_LAS unsigned char* lds, int buf, int lane) const {
        const size_t o = (size_t)u.e * 65536 + (size_t)u.pm * 256 + lane * 4;
        __builtin_amdgcn_global_load_lds((const unsigned*)(LIST + o), (PG8_LAS unsigned*)(lds + TAB_IDS + buf * 1024), 16, 0, 0);
        if (!GATHER) __builtin_amdgcn_global_load_lds((const unsigned*)(GATEL + o), (PG8_LAS unsigned*)(lds + TAB_GATES + buf * 1024), 16, 0, 0);
        const float* bsrc = GATHER ? bias + (size_t)u.e * 2048 + (lane >> 5) * 1024 + u.pn * 128 + (lane & 31) * 4 : bias + (size_t)u.e * 1024 + u.pn * 256 + lane * 4;
        __builtin_amdgcn_global_load_lds((const unsigned*)bsrc, (PG8_LAS unsigned*)(lds + TAB_BIAS + buf * 1024), 16, 0, 0);
    }
};

__device__ __forceinline__ unsigned cvt_pk_bf16(float lo, float hi) { unsigned r; asm volatile("v_cvt_pk_bf16_f32 %0, %1, %2" : "=v"(r) : "v"(lo), "v"(hi)); return r; }
__device__ __forceinline__ float bflo(unsigned w) { return __builtin_bit_cast(float, w << 16); }
__device__ __forceinline__ float bfhi(unsigned w) { return __builtin_bit_cast(float, w & 0xffff0000u); }
__device__ __forceinline__ float sigm(float v) { return __builtin_amdgcn_rcpf(1.f + __builtin_amdgcn_exp2f(-1.4426950408889634f * v)); }
__device__ __forceinline__ u32x4 pack8(const f32x4& v0, const f32x4& v1) { u32x4 w; w.x = cvt_pk_bf16(v0[0], v0[1]); w.y = cvt_pk_bf16(v0[2], v0[3]); w.z = cvt_pk_bf16(v1[0], v1[1]); w.w = cvt_pk_bf16(v1[2], v1[3]); return w; }
__device__ __forceinline__ void unpack8(const u32x4& w, f32x4& v0, f32x4& v1) { v0 = (f32x4){bflo(w.x), bfhi(w.x), bflo(w.y), bfhi(w.y)}; v1 = (f32x4){bflo(w.z), bfhi(w.z), bflo(w.w), bfhi(w.w)}; }
typedef f32x4 Acc[2][2][4][2];
typedef int i32x4 __attribute__((ext_vector_type(4)));
typedef int i32x8 __attribute__((ext_vector_type(8)));
struct bf16x8p { bf16x8 k[2]; };
template <bool F8> struct Frag { typedef bf16x8p T; };
template <> struct Frag<true> { typedef i32x8 T; };
__device__ __forceinline__ void frag_set(i32x8& d, const i32x4& lo, const i32x4& hi) { d = __builtin_shufflevector(lo, hi, 0, 1, 2, 3, 4, 5, 6, 7); }
__device__ __forceinline__ void frag_set(bf16x8p& d, const bf16x8& lo, const bf16x8& hi) { d.k[0] = lo; d.k[1] = hi; }
__device__ __forceinline__ void frag_mma(f32x4& c, const i32x8& b, const i32x8& a) { c = __builtin_amdgcn_mfma_scale_f32_16x16x128_f8f6f4(b, a, c, 0, 0, 0, 0, 0, 0); }
__device__ __forceinline__ void frag_mma(f32x4& c, const bf16x8p& b, const bf16x8p& a) { c = __builtin_amdgcn_mfma_f32_16x16x32_bf16(b.k[0], a.k[0], c, 0, 0, 0); c = __builtin_amdgcn_mfma_f32_16x16x32_bf16(b.k[1], a.k[1], c, 0, 0, 0); }
__device__ __forceinline__ unsigned pk4_fp8(float a, float b, float c, float d) { unsigned w = __builtin_amdgcn_cvt_pk_fp8_f32(a, b, 0u, false); return __builtin_amdgcn_cvt_pk_fp8_f32(c, d, w, true); }
template <class E> struct has_p16 { template <class T> static constexpr bool f(decltype(T::PERM16)*) { return T::PERM16; } template <class T> static constexpr bool f(...) { return false; } static constexpr bool value = f<E>(nullptr); };
template <class E> struct has_mid { template <class T> static constexpr bool f(decltype(T::MID)*) { return T::MID; } template <class T> static constexpr bool f(...) { return false; } static constexpr bool value = f<E>(nullptr); };

struct EpiProj {
    static constexpr bool PERM = true; static constexpr int NSTORES = 16;
    bf16_t *Q, *K, *V, *U, *G; const float* bg; float* PN; float c2; float dsc; int pn_base; int pad;
    __device__ __forceinline__ void operator()(const Acc& acc, const Unit& u, int wr, int wc, int fr_, int fq_, PG8_LAS unsigned char* lds, int) const {
        int fr = fr_, fq = fq_; asm volatile("" : "+v"(fr), "+v"(fq));
        const int pn = u.pn + pn_base; const int row0 = u.pm * BM + wr * 64 + fr; const bool isg = pn >= 8;
        bf16_t* base; int ldc, colt, bjs; float sc = dsc;
        if (isg) { base = G; ldc = 2048; colt = (pn - 8) * HALF; bjs = 1024; } else { const int t = pn >> 1; base = t == 0 ? Q : t == 1 ? K : t == 2 ? V : U; ldc = 512; colt = (pn & 1) * BM; bjs = HALF; if (t == 0) sc = c2 * dsc; }
        const int col0 = colt + wc * 32 + 8 * fq;
        f32x4 bv[2][2];
#pragma unroll
        for (int bj = 0; bj < 2; ++bj)
#pragma unroll
            for (int n = 0; n < 2; ++n) bv[bj][n] = isg ? *(const PG8_LAS f32x4*)((const PG8_LAS float*)(lds + TAB_OFF) + col0 + bj * bjs + 4 * n) : (f32x4){0.f, 0.f, 0.f, 0.f};
#pragma unroll
        for (int ai = 0; ai < 2; ++ai)
#pragma unroll
            for (int m = 0; m < 4; ++m) { bf16_t* rowp = base + (size_t)(row0 + ai * HALF + m * 16) * ldc + col0;
                f32x4 v[2][2];
#pragma unroll
                for (int bj = 0; bj < 2; ++bj)
#pragma unroll
                    for (int n = 0; n < 2; ++n) v[bj][n] = acc[ai][bj][m][n] * sc + bv[bj][n];
                if (isg) {
#pragma unroll
                    for (int n = 0; n < 2; ++n)
#pragma unroll
                        for (int i = 0; i < 4; ++i) { const float ga = sigm(v[0][n][i]), gp = sigm(v[1][n][i]); v[0][n][i] = ga * __builtin_amdgcn_rcpf(fmaxf(gp, 8.67e-19f)); v[1][n][i] = gp; } }
#pragma unroll
                for (int bj = 0; bj < 2; ++bj) *(u32x4*)(rowp + bj * bjs) = pack8(v[bj][0], v[bj][1]); }
        if (pn < 4) {
            float* tab = PN + (pn >> 1) * 16384; const int R0 = u.pm * BM, b = R0 >> 12;
#pragma unroll
            for (int ai = 0; ai < 2; ++ai)
#pragma unroll
                for (int bj = 0; bj < 2; ++bj) { float mx = 0.f;
#pragma unroll
                    for (int m = 0; m < 4; ++m) { f32x4 v0 = acc[ai][bj][m][0] * sc, v1 = acc[ai][bj][m][1] * sc;
                        float s = (v0[0] * v0[0] + v0[1] * v0[1]) + (v0[2] * v0[2] + v0[3] * v0[3]) + (v1[0] * v1[0] + v1[1] * v1[1]) + (v1[2] * v1[2] + v1[3] * v1[3]);
                        s += __shfl_xor(s, 16); s += __shfl_xor(s, 32); mx = fmaxf(mx, s); }
                    mx = fmaxf(mx, __shfl_xor(mx, 1)); mx = fmaxf(mx, __shfl_xor(mx, 2)); mx = fmaxf(mx, __shfl_xor(mx, 4)); mx = fmaxf(mx, __shfl_xor(mx, 8));
                    const int tile = ((R0 & 4095) >> 6) + 2 * ai + wr, hm = (pn & 1) * 4 + 2 * bj + (wc >> 1);
                    if (fr == 0 && fq == 0) tab[((b * 8 + hm) * 64 + tile) * 2 + (wc & 1)] = mx; }
        }
    }
};
struct EpiMixCat {
    static constexpr bool PERM = true, MID = true; static constexpr int NSTORES = 16;
    bf16_t* MIX; const bf16_t* G; float dsc; int pad;
    __device__ __forceinline__ void mid(Acc& acc, const Unit& u, int wr, int wc, int fr_, int fq_) const {
        int fr = fr_, fq = fq_; asm volatile("" : "+v"(fr), "+v"(fq));
        const int row0 = u.pm * BM + wr * 64 + fr, col0 = u.pn * BM + wc * 32 + 8 * fq;
        u32x4 w[16];
#pragma unroll
        for (int k = 0; k < 16; ++k) w[k] = *(const u32x4*)(G + (size_t)(row0 + (k >> 3) * HALF + ((k >> 1) & 3) * 16) * 2048 + col0 + (k & 1) * HALF);
        asm volatile("" : "+v"(w[0]), "+v"(w[1]), "+v"(w[2]), "+v"(w[3]), "+v"(w[4]), "+v"(w[5]), "+v"(w[6]), "+v"(w[7]), "+v"(w[8]), "+v"(w[9]), "+v"(w[10]), "+v"(w[11]), "+v"(w[12]), "+v"(w[13]), "+v"(w[14]), "+v"(w[15]));
#pragma unroll
        for (int k = 0; k < 16; ++k) { const int ai = k >> 3, m = (k >> 1) & 3, bj = k & 1; f32x4 a0, a1; unpack8(w[k], a0, a1); acc[ai][bj][m][0] *= a0; acc[ai][bj][m][1] *= a1; }
        asm volatile("" ::: "memory");
    }
    __device__ __forceinline__ void operator()(const Acc& acc, const Unit& u, int wr, int wc, int fr_, int fq_, PG8_LAS unsigned char*, int) const {
        int fr = fr_, fq = fq_; asm volatile("" : "+v"(fr), "+v"(fq));
        const int row0 = u.pm * BM + wr * 64 + fr, col0 = u.pn * BM + wc * 32 + 8 * fq;
        u32x4 w[16];
#pragma unroll
        for (int k = 0; k < 16; ++k) w[k] = *(const u32x4*)(G + (size_t)(row0 + (k >> 3) * HALF + ((k >> 1) & 3) * 16) * 2048 + 1024 + col0 + (k & 1) * HALF);
        asm volatile("" : "+v"(w[0]), "+v"(w[1]), "+v"(w[2]), "+v"(w[3]), "+v"(w[4]), "+v"(w[5]), "+v"(w[6]), "+v"(w[7]), "+v"(w[8]), "+v"(w[9]), "+v"(w[10]), "+v"(w[11]), "+v"(w[12]), "+v"(w[13]), "+v"(w[14]), "+v"(w[15]));
#pragma unroll
        for (int k = 0; k < 16; ++k) { const int ai = k >> 3, m = (k >> 1) & 3, bj = k & 1; f32x4 p0, p1; unpack8(w[k], p0, p1);
#pragma unroll
            for (int i = 0; i < 4; ++i) { p0[i] = fmaxf(p0[i], 8.67e-19f) * dsc; p1[i] = fmaxf(p1[i], 8.67e-19f) * dsc; }
            *(u32x4*)(MIX + (size_t)(row0 + ai * HALF + m * 16) * 1024 + col0 + bj * HALF) = pack8(acc[ai][bj][m][0] * p0, acc[ai][bj][m][1] * p1); }
        asm volatile("" ::: "memory");
    }
};
struct EpiPre1 {
    static constexpr bool PERM = true; static constexpr int NSTORES = 16;
    bf16_t* out; const bf16_t* x; float alpha; int pad;
    __device__ __forceinline__ void operator()(const Acc& acc, const Unit& u, int wr, int wc, int fr_, int fq_, PG8_LAS unsigned char*, int) const {
        int fr = fr_, fq = fq_; asm volatile("" : "+v"(fr), "+v"(fq));
        const int row0 = u.pm * BM + wr * 64 + fr, col0 = u.pn * BM + wc * 32 + 8 * fq;
        u32x4 w[16];
#pragma unroll
        for (int k = 0; k < 16; ++k) w[k] = *(const u32x4*)(x + (size_t)(row0 + (k >> 3) * HALF + ((k >> 1) & 3) * 16) * 1024 + col0 + (k & 1) * HALF);
        asm volatile("" : "+v"(w[0]), "+v"(w[1]), "+v"(w[2]), "+v"(w[3]), "+v"(w[4]), "+v"(w[5]), "+v"(w[6]), "+v"(w[7]), "+v"(w[8]), "+v"(w[9]), "+v"(w[10]), "+v"(w[11]), "+v"(w[12]), "+v"(w[13]), "+v"(w[14]), "+v"(w[15]));
#pragma unroll
        for (int k = 0; k < 16; ++k) { const int ai = k >> 3, m = (k >> 1) & 3, bj = k & 1; f32x4 x0, x1; unpack8(w[k], x0, x1);
            *(u32x4*)(out + (size_t)(row0 + ai * HALF + m * 16) * 1024 + col0 + bj * HALF) = pack8(x0 * alpha + acc[ai][bj][m][0], x1 * alpha + acc[ai][bj][m][1]); }
        asm volatile("" ::: "memory");
    }
};
template <int MODE> struct EpiPle {
    static constexpr bool PERM = true; static constexpr int NSTORES = 16;
    bf16_t* out; const bf16_t* T; const bf16_t* PRE; const float* stat; const float* lng; const float* lnb; float dsc; float alpha;
    __device__ __forceinline__ void operator()(const Acc& acc, const Unit& u, int wr, int wc, int fr_, int fq_, PG8_LAS unsigned char*, int) const {
        int fr = fr_, fq = fq_; asm volatile("" : "+v"(fr), "+v"(fq));
        const int row0 = u.pm * BM + wr * 64 + fr, col0 = u.pn * BM + wc * 32 + 8 * fq;
        f32x4 ag[2][2], ab[2][2];
        if (MODE == 3) {
#pragma unroll
            for (int bj = 0; bj < 2; ++bj)
#pragma unroll
                for (int h = 0; h < 2; ++h) { ag[bj][h] = *(const f32x4*)(lng + col0 + bj * HALF + 4 * h) * alpha; ab[bj][h] = *(const f32x4*)(lnb + col0 + bj * HALF + 4 * h) * alpha; } }
#pragma unroll
        for (int ai = 0; ai < 2; ++ai)
#pragma unroll
            for (int mp = 0; mp < 2; ++mp) { u32x4 w[8]; f32x2 st[2];
                if (MODE == 3) {
#pragma unroll
                    for (int k = 0; k < 4; ++k) { const size_t o = (size_t)(row0 + ai * HALF + (2 * mp + (k >> 1)) * 16) * 1024 + col0 + (k & 1) * HALF; w[2 * k] = *(const u32x4*)(T + o); w[2 * k + 1] = *(const u32x4*)(PRE + o); }
#pragma unroll
                    for (int q = 0; q < 2; ++q) st[q] = *(const f32x2*)(stat + 2 * (size_t)(row0 + ai * HALF + (2 * mp + q) * 16));
                    asm volatile("" : "+v"(w[0]), "+v"(w[1]), "+v"(w[2]), "+v"(w[3]), "+v"(w[4]), "+v"(w[5]), "+v"(w[6]), "+v"(w[7]), "+v"(st[0]), "+v"(st[1]));
                }
#pragma unroll
                for (int k = 0; k < 4; ++k) { const int m = 2 * mp + (k >> 1), bj = k & 1; const size_t o = (size_t)(row0 + ai * HALF + m * 16) * 1024 + col0 + bj * HALF; f32x4 v0 = acc[ai][bj][m][0], v1 = acc[ai][bj][m][1];
                    if (MODE == 3) { f32x4 t0, t1, x0, x1; unpack8(w[2 * k], t0, t1); unpack8(w[2 * k + 1], x0, x1); const float s = st[k >> 1][1], ms = -st[k >> 1][0] * s;
#pragma unroll
                        for (int i = 0; i < 4; ++i) { v0[i] = sigm(v0[i] * dsc) * t0[i] + ((x0[i] * s + ms) * ag[bj][0][i] + ab[bj][0][i]); v1[i] = sigm(v1[i] * dsc) * t1[i] + ((x1[i] * s + ms) * ag[bj][1][i] + ab[bj][1][i]); } }
                    *(u32x4*)(out + o) = pack8(v0, v1); }
                if (MODE == 3) asm volatile("" ::: "memory"); }
    }
};
template <bool F8> struct EpiUp {
    static constexpr bool PERM = true; static constexpr int NSTORES = F8 ? 4 : 8;
    void* HB; const float* bup; float dsc; int pad;
    __device__ __forceinline__ void operator()(const Acc& acc, const Unit& u, int wr, int wc, int fr_, int fq_, PG8_LAS unsigned char* lds, int buf) const {
        int fr = fr_, fq = fq_; asm volatile("" : "+v"(fr), "+v"(fq));
        const PG8_LAS int* row0t = (const PG8_LAS int*)(lds + TAB_ROW0); const int srow = row0t[u.e] + u.pm * BM;
        const int c0 = u.pn * HALF + wc * 32 + 8 * fq; const PG8_LAS float* bp = (const PG8_LAS float*)(lds + TAB_BIAS + buf * 1024) + wc * 32 + 8 * fq;
        const f32x4 bg0 = *(const PG8_LAS f32x4*)(bp), bg1 = *(const PG8_LAS f32x4*)(bp + 4), bl0 = *(const PG8_LAS f32x4*)(bp + 128) + 1.f, bl1 = *(const PG8_LAS f32x4*)(bp + 132) + 1.f;
#pragma unroll
        for (int ai = 0; ai < 2; ++ai)
#pragma unroll
            for (int mp = 0; mp < 2; ++mp) { unsigned xw[2][2];
#pragma unroll
                for (int mm = 0; mm < 2; ++mm) { const int m = 2 * mp + mm, r = ai * HALF + wr * 64 + m * 16 + fr;
                    f32x4 g0 = acc[ai][0][m][0] * dsc + bg0, g1 = acc[ai][0][m][1] * dsc + bg1, l0 = acc[ai][1][m][0] * dsc + bl0, l1 = acc[ai][1][m][1] * dsc + bl1;
#pragma unroll
                    for (int h = 0; h < 4; ++h) { constexpr float CS = -1.702f * 1.4426950408889634f;
                        f32x4& gg = (h < 2) ? g0 : g1; const f32x4& ll = (h < 2) ? l0 : l1; const int i = 2 * (h & 1);
                        const f32x2 a = {fminf(gg[i], 7.f), fminf(gg[i + 1], 7.f)}, b = {fminf(fmaxf(ll[i], -6.f), 8.f), fminf(fmaxf(ll[i + 1], -6.f), 8.f)};
                        const f32x2 t = a * CS; const f32x2 e = {__builtin_amdgcn_exp2f(t[0]), __builtin_amdgcn_exp2f(t[1])}; const f32x2 d = e + 1.f;
                        const f32x2 rc = {__builtin_amdgcn_rcpf(d[0]), __builtin_amdgcn_rcpf(d[1])}; const f32x2 y = (a * rc) * b; gg[i] = y[0]; gg[i + 1] = y[1]; }
                    if (F8) { xw[mm][0] = pk4_fp8(g0[0], g0[1], g0[2], g0[3]); xw[mm][1] = pk4_fp8(g1[0], g1[1], g1[2], g1[3]); }
                    else if (r < u.nvalid) *(u32x4*)((bf16_t*)HB + (size_t)(srow + r) * 1024 + c0) = pack8(g0, g1); }
                if (F8) {
                    const auto s0 = __builtin_amdgcn_permlane16_swap(xw[0][0], xw[1][0], false, false), s1 = __builtin_amdgcn_permlane16_swap(xw[0][1], xw[1][1], false, false);
                    const int r = ai * HALF + wr * 64 + (2 * mp + (fq & 1)) * 16 + fr;
                    if (r < u.nvalid) { u32x4 w; w.x = s0[0]; w.y = s1[0]; w.z = s0[1]; w.w = s1[1]; *(u32x4*)((unsigned char*)HB + (size_t)(srow + r) * 1024 + (c0 & ~15)) = w; } } }
    }
};
struct EpiDown {
    static constexpr bool PERM = true, PERM16 = true; static constexpr int NSTORES = 8;
    unsigned char* YS; size_t rstride; const float* bdn; float dsc; float osc;
    __device__ __forceinline__ void operator()(const Acc& acc, const Unit& u, int wr, int wc, int fr_, int fq_, PG8_LAS unsigned char* lds, int buf) const {
        int fr = fr_, fq = fq_; asm volatile("" : "+v"(fr), "+v"(fq));
        const PG8_LAS int* ids = (const PG8_LAS int*)(lds + TAB_IDS) + buf * 256; const PG8_LAS float* gates = (const PG8_LAS float*)(lds + TAB_GATES) + buf * 256;
        const int col0 = u.pn * BM + wc * 64 + 16 * fq; const PG8_LAS float* bp = (const PG8_LAS float*)(lds + TAB_BIAS + buf * 1024) + wc * 64 + 16 * fq;
        f32x4 bv[2][2];
#pragma unroll
        for (int bj = 0; bj < 2; ++bj)
#pragma unroll
            for (int n = 0; n < 2; ++n) bv[bj][n] = *(const PG8_LAS f32x4*)(bp + 8 * bj + 4 * n);
#pragma unroll
        for (int ai = 0; ai < 2; ++ai)
#pragma unroll
            for (int m = 0; m < 4; ++m) { const int r = ai * HALF + wr * 64 + m * 16 + fr;
                if (r < u.nvalid) { const int a = ids[r]; const float gs = gates[r] * osc; const size_t o = (size_t)(a & 3) * rstride + (size_t)(a >> 2) * 1024 + col0;
                    u32x4 w; unsigned* wp = (unsigned*)&w;
#pragma unroll
                    for (int bj = 0; bj < 2; ++bj)
#pragma unroll
                        for (int n = 0; n < 2; ++n) { const f32x4 v = (acc[ai][bj][m][n] * dsc + bv[bj][n]) * gs; wp[2 * bj + n] = pk4_fp8(v[0], v[1], v[2], v[3]); }
                    *(u32x4*)(YS + o) = w; } }
    }
};

template <class Epi, class Sched>
__device__ __forceinline__ void gemm_phase(PG8_LAS unsigned char* lds, const int wid, const Gemm g, const Sched& S, const Epi& E) {
    int lane = lane_id(); asm volatile("" : "+v"(lane));
    const int tid = wid * 64 + lane, wr = wid >> 2, wc = wid & 3, fr = lane & 15, fq = lane >> 4;
    const int K = g.K, nt = K / BK;
    int RA[2], CA[2]; unsigned voffA[2], voffB[2];
#pragma unroll
    for (int i = 0; i < 2; ++i) { int R, C; stage_rc(tid * 16 + i * 8192, R, C); const int Rb = has_p16<Epi>::value ? perm16h(R) : Epi::PERM ? ((R & ~31) + perm32(R & 31)) : R; RA[i] = R; CA[i] = C; voffA[i] = (unsigned)(R * K + C) * 2u; voffB[i] = (unsigned)(Rb * K + C) * 2u; }
    const size_t tstep = (size_t)BM * K * 2;
    const size_t kstep = (size_t)(BK * 2);
    const size_t hstep = (size_t)HALF * K * 2;
    const size_t bstep = has_p16<Epi>::value ? (size_t)8 * K * 2 : hstep;
    const unsigned ldsw = (unsigned)wid * 1024u;
    const int aoff = lds_byte(wr * 64 + fr, fq * 8), boff = lds_byte(wc * 32 + fr, fq * 8);
#define PG8_SA(b, h) (((b) * 2 + (h)) * HTB)
#define PG8_SB(b, h) ((4 + (b) * 2 + (h)) * HTB)
#define PG8_STAGE(bufoff, gbase, voff) do { _Pragma("unroll") for (int _i = 0; _i < 2; ++_i) \
        __builtin_amdgcn_global_load_lds((const unsigned*)((const char*)(gbase) + (voff)[_i]), (PG8_LAS unsigned*)(lds + (bufoff) + ldsw + _i * 8192), 16, 0, 0); } while (0)
#define PG8_STAGE_A(bufoff, ubase, h, OFF) do { if constexpr (Sched::TABLES) PG8_STAGE(bufoff, ubase, OFF[h]); else PG8_STAGE(bufoff, (ubase) + ((h) ? hstep : 0), voffA); } while (0)
#define PG8_LDA(dst, b, h) do { _Pragma("unroll") for (int m = 0; m < 4; ++m) { if constexpr (Sched::FP8) dst##8[m] = __builtin_shufflevector(*(const PG8_LAS i32x4*)(lds + PG8_SA(b, h) + aoff + m * 2048), *(const PG8_LAS i32x4*)(lds + PG8_SA(b, h) + aoff + m * 2048 + 1024), 0, 1, 2, 3, 4, 5, 6, 7); \
        else { _Pragma("unroll") for (int k = 0; k < 2; ++k) dst[m][k] = *(const PG8_LAS bf16x8*)(lds + PG8_SA(b, h) + aoff + m * 2048 + k * 1024); } } } while (0)
#define PG8_LDB(dst, b, h) do { _Pragma("unroll") for (int n = 0; n < 2; ++n) { if constexpr (Sched::FP8) dst##8[n] = __builtin_shufflevector(*(const PG8_LAS i32x4*)(lds + PG8_SB(b, h) + boff + n * 2048), *(const PG8_LAS i32x4*)(lds + PG8_SB(b, h) + boff + n * 2048 + 1024), 0, 1, 2, 3, 4, 5, 6, 7); \
        else { _Pragma("unroll") for (int k = 0; k < 2; ++k) dst[n][k] = *(const PG8_LAS bf16x8*)(lds + PG8_SB(b, h) + boff + n * 2048 + k * 1024); } } } while (0)
#define PG8_MMA(ai, bj, At, Bt) do { __builtin_amdgcn_s_setprio(1); if constexpr (Sched::FP8) asm volatile("s_nop 1"); _Pragma("unroll") for (int m = 0; m < 4; ++m) _Pragma("unroll") for (int n = 0; n < 2; ++n) { \
        if constexpr (Sched::FP8) asm volatile("v_mfma_f32_16x16x128_f8f6f4 %0, %1, %2, %0" : "+v"(acc[ai][bj][m][n]) : "v"(Bt##8[n]), "v"(At##8[m]));   \
        else { _Pragma("unroll") for (int k = 0; k < 2; ++k) acc[ai][bj][m][n] = __builtin_amdgcn_mfma_f32_16x16x32_bf16(Bt[n][k], At[m][k], acc[ai][bj][m][n], 0, 0, 0); } } __builtin_amdgcn_s_setprio(0); } while (0)
#define PG8_WAIT_V(n) asm volatile("s_waitcnt vmcnt(" #n ")" ::: "memory")
#define PG8_WAIT_V8R(relax) do { if (relax) asm volatile("s_waitcnt vmcnt(%0)" :: "n"(8 + Epi::NSTORES) : "memory"); else asm volatile("s_waitcnt vmcnt(8)" ::: "memory"); } while (0)
#define PG8_WAIT_L(n) asm volatile("s_waitcnt lgkmcnt(" #n ")" ::: "memory")
#define PG8_BAR __builtin_amdgcn_s_barrier()
#define PG8_SCHED __builtin_amdgcn_sched_barrier(0)
    Unit cur, nxt; int ui = 0; bool prev_full = false;
    if (!S.next(0, cur, lds)) return;
    if constexpr (Sched::TABLES) {
        if (wid == 0) S.issue_tables(cur, lds, 0, lane);
        PG8_WAIT_V(0); PG8_BAR;
    }
    Acc acc;
#pragma unroll
    for (int a = 0; a < 2; ++a)
#pragma unroll
        for (int b = 0; b < 2; ++b)
#pragma unroll
            for (int m = 0; m < 4; ++m)
#pragma unroll
                for (int n = 0; n < 2; ++n) acc[a][b][m][n] = (f32x4){0.f, 0.f, 0.f, 0.f};
    bf16x8 At[4][2], B0[2][2], B1[2][2];
    i32x8 At8[4], B08[2], B18[2];
    unsigned offc[2][2], offn[2][2];
    if constexpr (Sched::TABLES) { S.a_offsets(g, cur, lds, 0, RA, CA, offc);
#pragma unroll
        for (int h = 0; h < 2; ++h)
#pragma unroll
            for (int i = 0; i < 2; ++i) offn[h][i] = offc[h][i]; }
    const char* const Ab = (const char*)g.A;
    const char* cA = Sched::TABLES ? Ab : Ab + (size_t)cur.pm * tstep;
    const char* cB = S.b_tile(g, cur);
    PG8_STAGE(PG8_SB(0, 0), cB, voffB); PG8_STAGE(PG8_SB(0, 1), cB + bstep, voffB); PG8_STAGE_A(PG8_SA(0, 0), cA, 0, offc); PG8_STAGE_A(PG8_SA(0, 1), cA, 1, offc);
    if (wr == 1) PG8_BAR;
    PG8_WAIT_V(2); PG8_BAR;
    PG8_STAGE(PG8_SB(1, 0), cB + kstep, voffB); PG8_STAGE_A(PG8_SA(1, 0), cA + kstep, 0, offc); PG8_STAGE(PG8_SB(1, 1), cB + bstep + kstep, voffB);
    PG8_WAIT_V(6); PG8_BAR;
    for (;;) {
        const bool has_next = S.next(ui + 1, nxt, lds);
        const char* nB = has_next ? S.b_tile(g, nxt) : cB;
        const char* nA = Sched::TABLES ? Ab : (has_next ? Ab + (size_t)nxt.pm * tstep : cA);
#pragma nounroll
        for (int t = 0; t < nt; t += 2) {
            const bool last = (t == nt - 2);
            const bool relax = (t == 0) && prev_full;
            const bool pre11 = (t == 0) && (ui > 0);
            if constexpr (has_mid<Epi>::value) { if (t == nt / 2) E.mid(acc, cur, wr, wc, fr, fq); }
            if constexpr (Sched::TABLES) {
                if (t == 2 && has_next && wid == 0) S.issue_tables(nxt, lds, (ui + 1) & 1, lane);
                if (t == (nt >= 16 ? nt - 6 : nt - 2) && has_next) S.a_offsets(g, nxt, lds, (ui + 1) & 1, RA, CA, offn);
            }
            unsigned o2[2][2];
            if constexpr (Sched::TABLES) {
#pragma unroll
                for (int h = 0; h < 2; ++h)
#pragma unroll
                    for (int i = 0; i < 2; ++i) o2[h][i] = last ? offn[h][i] : offc[h][i]; }
            const char* a1 = cA + (size_t)(t + 1) * kstep;
            const char* a2 = last ? nA : cA + (size_t)(t + 2) * kstep; const char* b2 = last ? nB : cB + (size_t)(t + 2) * kstep;
            const char* a3 = a2 + kstep; const char* b3 = b2 + kstep;
            PG8_LDB(B0, 0, 0); PG8_LDB(B1, 0, 1); PG8_SCHED; PG8_LDA(At, 0, 0); if (!pre11) PG8_STAGE_A(PG8_SA(1, 1), a1, 1, offc);
            PG8_WAIT_V8R(relax); PG8_WAIT_L(0); PG8_BAR; PG8_MMA(0, 0, At, B0); PG8_MMA(0, 1, At, B1); PG8_BAR; PG8_SCHED;
            PG8_LDA(At, 0, 1); PG8_STAGE(PG8_SB(0, 0), b2, voffB); PG8_STAGE(PG8_SB(0, 1), b2 + bstep, voffB); PG8_STAGE_A(PG8_SA(0, 0), a2, 0, o2);
            PG8_WAIT_V8R(relax); PG8_WAIT_L(0); PG8_BAR; PG8_MMA(1, 0, At, B0); PG8_MMA(1, 1, At, B1); PG8_BAR; PG8_SCHED;
            PG8_LDB(B0, 1, 0); PG8_LDB(B1, 1, 1); PG8_SCHED; PG8_LDA(At, 1, 0); PG8_STAGE_A(PG8_SA(0, 1), a2, 1, o2);
            PG8_WAIT_V8R(relax && pre11); PG8_WAIT_L(0); PG8_BAR; PG8_MMA(0, 0, At, B0); PG8_MMA(0, 1, At, B1); PG8_BAR; PG8_SCHED;
            PG8_LDA(At, 1, 1); PG8_STAGE(PG8_SB(1, 0), b3, voffB); PG8_STAGE(PG8_SB(1, 1), b3 + bstep, voffB); PG8_STAGE_A(PG8_SA(1, 0), a3, 0, o2);
            PG8_WAIT_V(8); PG8_WAIT_L(0); PG8_BAR; PG8_MMA(1, 0, At, B0); PG8_MMA(1, 1, At, B1); PG8_BAR; PG8_SCHED;
        }
        if (wr == 0) PG8_BAR;
        if (has_next) PG8_STAGE_A(PG8_SA(1, 1), nA + kstep, 1, offn);
        E(acc, cur, wr, wc, fr, fq, lds, ui & 1);
        if (!has_next) break;
#pragma unroll
        for (int a = 0; a < 2; ++a)
#pragma unroll
            for (int b = 0; b < 2; ++b)
#pragma unroll
                for (int m = 0; m < 4; ++m)
#pragma unroll
                    for (int n = 0; n < 2; ++n) acc[a][b][m][n] = (f32x4){0.f, 0.f, 0.f, 0.f};
        prev_full = (cur.nvalid == 256); cur = nxt; cB = nB; cA = nA; ++ui;
        if constexpr (Sched::TABLES) {
#pragma unroll
            for (int h = 0; h < 2; ++h)
#pragma unroll
                for (int i = 0; i < 2; ++i) offc[h][i] = offn[h][i]; }
        if (wr == 1) PG8_BAR;
    }
    PG8_WAIT_V(0);
    PG8_BAR;
#undef PG8_SA
#undef PG8_SB
#undef PG8_STAGE
#undef PG8_STAGE_A
#undef PG8_LDA
#undef PG8_LDB
#undef PG8_MMA
#undef PG8_WAIT_V
#undef PG8_WAIT_V8R
#undef PG8_WAIT_L
#undef PG8_BAR
#undef PG8_SCHED
}
}
namespace attn_body {
using bf16=__hip_bfloat16;
using bf16x8=__attribute__((ext_vector_type(8)))short;
using s16x4=__attribute__((ext_vector_type(4)))short;
using f32x16=__attribute__((ext_vector_type(16)))float;
using u32x4=__attribute__((ext_vector_type(4)))unsigned;
using f32x4_=__attribute__((ext_vector_type(4)))float;
constexpr int BATCH=16,SEQ=4096,D=64,DM=512,DMO=1024;
constexpr int NW=8,QBLK=32,QB=QBLK*NW,KVBLK=64,NQB=SEQ/QB;
constexpr int ATTN_UNIT_ROWS=QB;
__device__ __forceinline__ int crow(int r,int hi){return (r&3)+8*(r>>2)+4*hi;}
#define SBAR() __builtin_amdgcn_sched_barrier(0)
__device__ __forceinline__ void cmask(f32x16&p0,f32x16&p1,int jb,int qrel,int hi){
  const float NEG=-INFINITY; int kb=64*jb+4*hi; asm volatile("":"+v"(kb),"+v"(qrel));
  #pragma unroll
  for(int r=0;r<16;++r){int kv=kb+(r&3)+8*(r>>2); if(kv>qrel)p0[r]=NEG; if(kv+32>qrel)p1[r]=NEG;}
}

constexpr int NSLOT=3, SLOTB=8192, VSLOTB=16384;
constexpr int LDS_K=0, LDS_V=NSLOT*SLOTB, LDS_WS=NSLOT*SLOTB+NSLOT*VSLOTB, LDS_OST=LDS_WS+NW*64*4, LDS_BYTES=LDS_OST+NW*4096;
constexpr int LDS_LAM=LDS_BYTES+16, LDS_SUBLN=LDS_BYTES+256;
__device__ __forceinline__ u32x4 ld16_sc1(const void*p){u32x4 v;asm volatile("global_load_dwordx4 %0, %1, off sc1":"=v"(v):"v"(p):"memory");return v;}
constexpr float C2=0.125f*1.4426950408889634f;
__device__ __forceinline__ void glds16(const void*gsrc,unsigned lds_dst){unsigned keep;
  asm volatile("s_mov_b32 %0, m0\n\ts_mov_b32 m0, %2\n\ts_nop 0\n\tglobal_load_lds_dwordx4 %1, off\n\ts_mov_b32 m0, %0":"=&s"(keep):"v"(gsrc),"s"(lds_dst):"memory");}
__device__ __forceinline__ float max3f(float a,float b,float c){float r;asm("v_max3_f32 %0, %1, %2, %3":"=v"(r):"v"(a),"v"(b),"v"(c));return r;}
__device__ __forceinline__ float max2f(float a,float b){float r;asm("v_max_f32_e32 %0, %1, %2":"=v"(r):"v"(a),"v"(b));return r;}
__device__ __forceinline__ float fadd_s(float a,float b){float r;asm("v_add_f32_e32 %0, %1, %2":"=v"(r):"v"(a),"v"(b));return r;}
__device__ __forceinline__ float fsub_s(float a,float b){float r;asm("v_sub_f32_e32 %0, %1, %2":"=v"(r):"v"(a),"v"(b));return r;}
typedef float f32x2_t __attribute__((ext_vector_type(2))); typedef __bf16 bf16x2_t __attribute__((ext_vector_type(2)));
__device__ __forceinline__ unsigned cvtpk_s(float lo,float hi){f32x2_t v={lo,hi};bf16x2_t b=__builtin_convertvector(v,bf16x2_t);return __builtin_bit_cast(unsigned,b);}
#define WAIT_BAR(N) asm volatile("s_waitcnt vmcnt(" #N ") lgkmcnt(0)\n\ts_barrier":::"memory")

__device__ __forceinline__ void qkt(f32x16&p0,f32x16&p1,const char*Kslot,const bf16x8*qr,const f32x16&i0,const f32x16&i1,int r32,int hi){
  const char*kb=Kslot+hi*1024+r32*16;
  #pragma unroll
  for(int d0=0;d0<4;++d0){
    const bf16x8 b0=*reinterpret_cast<const bf16x8*>(kb+d0*2048);
    const bf16x8 b1=*reinterpret_cast<const bf16x8*>(kb+d0*2048+512);
    if(d0==0){p0=__builtin_amdgcn_mfma_f32_32x32x16_bf16(b0,qr[0],i0,0,0,0);p1=__builtin_amdgcn_mfma_f32_32x32x16_bf16(b1,qr[0],i1,0,0,0);}
    else{p0=__builtin_amdgcn_mfma_f32_32x32x16_bf16(b0,qr[d0],p0,0,0,0);p1=__builtin_amdgcn_mfma_f32_32x32x16_bf16(b1,qr[d0],p1,0,0,0);}}
}
typedef __attribute__((address_space(3))) const char* lds_cptr;
typedef short v4i16_t __attribute__((ext_vector_type(4)));
__device__ __forceinline__ void kload8(bf16x8*kf,lds_cptr kp){
  kf[0]=*(const __attribute__((address_space(3))) bf16x8*)(kp);      kf[1]=*(const __attribute__((address_space(3))) bf16x8*)(kp+512);
  kf[2]=*(const __attribute__((address_space(3))) bf16x8*)(kp+2048); kf[3]=*(const __attribute__((address_space(3))) bf16x8*)(kp+2560);
  kf[4]=*(const __attribute__((address_space(3))) bf16x8*)(kp+4096); kf[5]=*(const __attribute__((address_space(3))) bf16x8*)(kp+4608);
  kf[6]=*(const __attribute__((address_space(3))) bf16x8*)(kp+6144); kf[7]=*(const __attribute__((address_space(3))) bf16x8*)(kp+6656);
}
__device__ __forceinline__ void kload2(bf16x8*kf,lds_cptr kp,int j){ kf[2*j]=*(const __attribute__((address_space(3))) bf16x8*)(kp+j*2048); kf[2*j+1]=*(const __attribute__((address_space(3))) bf16x8*)(kp+j*2048+512); }
__device__ __forceinline__ s16x4 vtr(lds_cptr p){ return __builtin_bit_cast(s16x4,__builtin_amdgcn_ds_read_tr16_b64_v4i16((__attribute__((address_space(3))) v4i16_t*)p)); }
__device__ __forceinline__ float rowmax(const f32x16&p0,const f32x16&p1){
  float a=max3f(p0[0],p0[1],p1[0]),b=max3f(p0[2],p0[3],p1[1]);a=max3f(a,p1[2],p1[3]);
  #pragma unroll
  for(int r=4;r<16;r+=4){a=max3f(a,p0[r],p0[r+1]);b=max3f(b,p0[r+2],p0[r+3]);a=max3f(a,p1[r],p1[r+1]);b=max3f(b,p1[r+2],p1[r+3]);}
  const float m=max2f(a,b);
  auto rr=__builtin_amdgcn_permlane32_swap(__float_as_uint(m),__float_as_uint(m),false,false);
  return max2f(__uint_as_float(rr[0]),__uint_as_float(rr[1]));
}
__device__ __forceinline__ void pv(f32x16*o,int vb,bf16x8 pa0,bf16x8 pa1,bf16x8 pa2,bf16x8 pa3){
  #pragma unroll
  for(int d0=0;d0<4;++d0){s16x4 lo[4],hi[4];
    #pragma unroll
    for(int ks=0;ks<4;++ks){
      asm volatile("ds_read_b64_tr_b16 %0,%1 offset:%c2":"=&v"(lo[ks]):"v"(vb),"i"(d0*4096+ks*1024):"memory");
      asm volatile("ds_read_b64_tr_b16 %0,%1 offset:%c2":"=&v"(hi[ks]):"v"(vb),"i"(d0*4096+ks*1024+512):"memory");}
    asm volatile("s_waitcnt lgkmcnt(0)":::"memory");SBAR();
    #define PK(k) (bf16x8){lo[k][0],lo[k][1],lo[k][2],lo[k][3],hi[k][0],hi[k][1],hi[k][2],hi[k][3]}
    o[d0]=__builtin_amdgcn_mfma_f32_32x32x16_bf16(pa0,PK(0),o[d0],0,0,0);
    o[d0]=__builtin_amdgcn_mfma_f32_32x32x16_bf16(pa1,PK(1),o[d0],0,0,0);
    o[d0]=__builtin_amdgcn_mfma_f32_32x32x16_bf16(pa2,PK(2),o[d0],0,0,0);
    o[d0]=__builtin_amdgcn_mfma_f32_32x32x16_bf16(pa3,PK(3),o[d0],0,0,0);
    #undef PK
  }
}

#ifndef ATTN_STORE16
#define ATTN_STORE16(p,v) (*(u32x4*)(p)=(v))
#endif
template<int THRL> __device__ __forceinline__ void attn_unit(int b,int hm,int qb,float cs,const int wid,const int t0,const float uref,const bf16*Q,const bf16*__restrict__ K,const bf16*__restrict__ V,bf16*O,char*shm,volatile __attribute__((address_space(3))) int*slot_,const int nxt_,const bool lead_,const bool comb_){
  int lane=lane_id(); asm volatile("":"+v"(lane));
  const int r32=lane&31,hi=lane>>5;
  const long rowbase=(long)b*SEQ; const int q0=qb*QB;
  const int NTf=(q0+QB)/KVBLK;
  const bf16*Qw=Q+(rowbase+q0+wid*QBLK)*DM+hm*D;
  const bf16*Kh=K+(rowbase+64*t0)*DM+hm*D,*Vh=V+(rowbase+64*t0)*DM+(hm>>1)*128;
  const unsigned lds0=(unsigned)(uintptr_t)shm;
  float*wsf=(float*)(shm+LDS_WS)+wid*64;
  const bf16*ksrc=Kh+(long)lane*DM+wid*8;
  const bf16*vsrc=Vh+(long)(16*(wid&3)+(lane>>2))*DM+(wid>>2)*32+(lane&3)*8;
  const unsigned kdst=lds0+LDS_K+wid*1024, vdst=lds0+LDS_V+wid*1024;
  #define DMA_K(t,slot) glds16(ksrc+(long)(t)*KVBLK*DM,(unsigned)__builtin_amdgcn_readfirstlane(kdst+(slot)))
  #define DMA_V(t,slot) do{ glds16(vsrc+(long)(t)*KVBLK*DM,(unsigned)__builtin_amdgcn_readfirstlane(vdst+(slot))); glds16(vsrc+(long)(t)*KVBLK*DM+64,(unsigned)__builtin_amdgcn_readfirstlane(vdst+(slot)+8192)); }while(0)
  const int vb0=(int)(lds0+LDS_V)+((lane>>4)&1)*32+(lane&3)*8+(4*hi+((lane&15)>>2))*64;
  const char*Kbase=shm+LDS_K; bf16x8 kf[8];
  const lds_cptr shm3=(lds_cptr)shm; const lds_cptr kp0=shm3+LDS_K+hi*1024+r32*16; const lds_cptr vp0=shm3+LDS_V+((lane>>4)&1)*32+(lane&3)*8+(4*hi+((lane&15)>>2))*64;
  const int NT=NTf-t0;
  DMA_K(0,0);DMA_V(0,0);DMA_K(1,SLOTB);
  bf16x8 qr[4];
  #pragma unroll
  for(int d0=0;d0<4;++d0)qr[d0]=*reinterpret_cast<const bf16x8*>(&Qw[(long)r32*DM+d0*16+hi*8]);
  float mhat=0.f,l_reg=0.f;f32x16 o[4];o[0]=f32x16{};o[1]=f32x16{};o[2]=f32x16{};o[3]=f32x16{};
  const int qrel=wid*QBLK+r32;
  float nb=-uref-cs*(float)(q0+qrel-4*hi-64*t0);
  const float cs8=__builtin_bit_cast(float,__builtin_amdgcn_readfirstlane(__builtin_bit_cast(int,8.f*cs)));
  #define CINIT1(C,t,X) do{ C[0]=nb+cs*(float)(64*(t)+(X)); C[1]=C[0]+cs; C[2]=C[1]+cs; C[3]=C[2]+cs; _Pragma("unroll") for(int r=4;r<16;++r) C[r]=C[r-4]+cs8; asm volatile("":"+v"(C)); }while(0)
  #define CINIT(C0,C1,t) do{ CINIT1(C0,t,0); CINIT1(C1,t,32); }while(0)
  #define CMASK(P0,P1,t) do{int jb_=(t)-(NT-4); if(jb_>=0)cmask(P0,P1,jb_,qrel,hi);}while(0)
  bool resc=false;
  #define START(P0,P1) do{ const float rm=rowmax(P0,P1); resc=false; \
    { const float dl=0.f; (void)rm; mhat=fadd_s(mhat,dl); nb=fsub_s(nb,dl);     \
      _Pragma("unroll") for(int r=0;r<16;++r){P0[r]=fsub_s(P0[r],dl);P1[r]=fsub_s(P1[r],dl);} } \
    _Pragma("unroll") for(int r=0;r<16;++r)P0[r]=__builtin_amdgcn_exp2f(P0[r]); }while(0)
  #define RESC() do{ if(THRL>=0&&resc){ asm volatile("s_waitcnt lgkmcnt(0)":::"memory"); \
      _Pragma("unroll") for(int d_=0;d_<4;++d_) _Pragma("unroll") for(int r=0;r<16;++r)o[d_][r]*=wsf[crow(r,hi)]; } }while(0)
  f32x16 pA0,pA1,pB0,pB1;
  int sl_prev=0,sl_cur=0,sl_next=SLOTB;
  #define ROT() do{sl_prev=sl_cur;sl_cur=sl_next;sl_next=(sl_next==(NSLOT-1)*SLOTB)?0:sl_next+SLOTB;}while(0)
  DMA_K(2,2*SLOTB);
  WAIT_BAR(4);
  { f32x16 i0_,i1_; CINIT(i0_,i1_,0); qkt(pA0,pA1,Kbase,qr,i0_,i1_,r32,hi); } asm volatile("s_nop 15\n\ts_nop 7":"+v"(pA0),"+v"(pA1));CMASK(pA0,pA1,0);
  CINIT(pB0,pB1,1);
  START(pA0,pA1);
  _Pragma("unroll") for(int r=0;r<16;++r)pA1[r]=__builtin_amdgcn_exp2f(pA1[r]);
  WAIT_BAR(0);
  DMA_K(3,0);DMA_V(1,VSLOTB);
  ROT();
  kload8(kf,kp0+sl_cur);
  WAIT_BAR(3);
  s16x4 vlo[8],vhi[8]; u32x4 pw0,pw1,pw2,pw3;
  #define PKW(P,B) cvtpk_s(P[B],P[B+1])
  #define PAF(k) __builtin_bit_cast(bf16x8,pw##k)
  #define VFR(i) (bf16x8){vlo[i][0],vlo[i][1],vlo[i][2],vlo[i][3],vhi[i][0],vhi[i][1],vhi[i][2],vhi[i][3]}
  #define PIN(x) asm volatile("":"+v"(x))
  #define MX3(a,b,c) __builtin_fmaxf(__builtin_fmaxf((a),(b)),(c))
  #define GAPA(MF,A0,A1,A2,A3,W0,W1,PW) do{ MF; sacc+=A0; sacc+=A1; sacc+=A2; sacc+=A3; PIN(sacc); W0; W1; PIN(PW); SBAR(); }while(0)
  #define EX(v) __builtin_amdgcn_exp2f(v)
  #define GAPB(MF,X,B,CI) do{ MF; X[B]=EX(X[B]); X[B+1]=EX(X[B+1]); CI; PIN(X); SBAR(); }while(0)
    \
  #define CIA(P,X,t) do{ P[0]=nb+cs*(float)(64*((t)+1)+(X)); P[1]=P[0]+cs; }while(0)
  #define CIB(P) do{ P[2]=P[1]+cs; P[3]=P[2]+cs; }while(0)
  #define CIC(P,k) do{ P[2*(k)]=P[2*(k)-4]+cs8; P[2*(k)+1]=P[2*(k)-3]+cs8; }while(0)
  #define VRD2(i) do{ vlo[i]=vtr(vp_+(8192+((i)>>2)*4096+((i)&3)*1024)); vhi[i]=vtr(vp_+(8192+((i)>>2)*4096+((i)&3)*1024+512)); SBAR(); }while(0)
  #define VRD(i) do{ vlo[i]=vtr(vp_+(((i)>>2)*4096+((i)&3)*1024)); vhi[i]=vtr(vp_+(((i)>>2)*4096+((i)&3)*1024+512)); }while(0)
  #define KRD(G,j) do{ if(G){ kload2(kf,kp0+sl_next,j); SBAR(); } }while(0)
  #define STEP(C0,C1,P0,P1,t,GK,GV,GL) do{ SBAR(); \
    const lds_cptr vp_=vp0+2*sl_prev; \
    VRD(0); SBAR(); float sacc=(P0[0]+P0[1]); SBAR(); \
    GAPA(C0=__builtin_amdgcn_mfma_f32_32x32x16_bf16(kf[0],qr[0],C0,0,0,0), P0[2],P0[3],P0[4],P0[5],     pw0[0]=PKW(P0,0), pw0[1]=PKW(P0,2), pw0); \
    VRD(4); SBAR(); GAPA(C1=__builtin_amdgcn_mfma_f32_32x32x16_bf16(kf[1],qr[0],C1,0,0,0), P0[6],P0[7],P0[8],P0[9],     pw0[2]=PKW(P0,4), pw0[3]=PKW(P0,6), pw0); \
    VRD(1); SBAR(); GAPA(C0=__builtin_amdgcn_mfma_f32_32x32x16_bf16(kf[2],qr[1],C0,0,0,0),   P0[10],P0[11],P0[12],P0[13], pw1[0]=PKW(P0,8), pw1[1]=PKW(P0,10), pw1); \
    VRD(5); SBAR(); GAPA(C1=__builtin_amdgcn_mfma_f32_32x32x16_bf16(kf[3],qr[1],C1,0,0,0),   P0[14],P0[15],P1[0],P1[1],   pw1[2]=PKW(P0,12),pw1[3]=PKW(P0,14), pw1); \
    VRD(2); SBAR(); GAPA(C0=__builtin_amdgcn_mfma_f32_32x32x16_bf16(kf[4],qr[2],C0,0,0,0),   P1[2],P1[3],P1[4],P1[5],     pw2[0]=PKW(P1,0), pw2[1]=PKW(P1,2), pw2); \
    VRD(6); SBAR(); GAPA(C1=__builtin_amdgcn_mfma_f32_32x32x16_bf16(kf[5],qr[2],C1,0,0,0),   P1[6],P1[7],P1[8],P1[9],     pw2[2]=PKW(P1,4), pw2[3]=PKW(P1,6), pw2); \
    VRD(3); SBAR(); GAPA(C0=__builtin_amdgcn_mfma_f32_32x32x16_bf16(kf[6],qr[3],C0,0,0,0),   P1[10],P1[11],P1[12],P1[13], pw3[0]=PKW(P1,8), pw3[1]=PKW(P1,10), pw3); \
    VRD(7); SBAR(); GAPA(C1=__builtin_amdgcn_mfma_f32_32x32x16_bf16(kf[7],qr[3],C1,0,0,0),   P1[14],P1[15],0.f,0.f,       pw3[2]=PKW(P1,12),pw3[3]=PKW(P1,14), pw3); \
    l_reg+=sacc; \
    if(GK){DMA_K((t)+3,sl_cur);} if(GV){DMA_V((t)+1,2*sl_next);} \
    CMASK(C0,C1,t); \
    { float a=MX3(C0[0],C0[1],C1[0]),b=MX3(C0[2],C0[3],C1[1]); a=MX3(a,C1[2],C1[3]); \
      _Pragma("unroll") for(int r=4;r<16;r+=4){a=MX3(a,C0[r],C0[r+1]);b=MX3(b,C0[r+2],C0[r+3]);a=MX3(a,C1[r],C1[r+1]);b=MX3(b,C1[r+2],C1[r+3]);} \
      float rm=__builtin_fmaxf(a,b); { auto rr=__builtin_amdgcn_permlane32_swap(__float_as_uint(rm),__float_as_uint(rm),false,false); rm=__builtin_fmaxf(__uint_as_float(rr[0]),__uint_as_float(rr[1])); } \
      resc=false; \
      if(THRL>=0&&__builtin_expect(__any(rm>(float)THRL),0)){ const float dl=__builtin_fmaxf(rm,0.f); mhat+=dl; nb-=dl; \
        _Pragma("unroll") for(int r=0;r<16;++r){C0[r]-=dl;C1[r]-=dl;} \
        const float f=__builtin_amdgcn_exp2f(-dl); l_reg*=f; if(hi==0)wsf[r32]=f; resc=true; } } \
    SBAR(); \
    GAPB(o[0]=__builtin_amdgcn_mfma_f32_32x32x16_bf16(PAF(0),VFR(0),o[0],0,0,0), C0,0, CIA(P0,0,t)); \
    GAPB(o[1]=__builtin_amdgcn_mfma_f32_32x32x16_bf16(PAF(0),VFR(4),o[1],0,0,0), C0,2, CIB(P0)); VRD2(0); \
    KRD(GL,0); GAPB(o[0]=__builtin_amdgcn_mfma_f32_32x32x16_bf16(PAF(1),VFR(1),o[0],0,0,0), C0,4, CIC(P0,2)); VRD2(4); \
    KRD(GL,1); GAPB(o[1]=__builtin_amdgcn_mfma_f32_32x32x16_bf16(PAF(1),VFR(5),o[1],0,0,0), C0,6, CIC(P0,3)); VRD2(1); \
    KRD(GL,2); GAPB(o[0]=__builtin_amdgcn_mfma_f32_32x32x16_bf16(PAF(2),VFR(2),o[0],0,0,0), C0,8, CIC(P0,4)); VRD2(5); \
    KRD(GL,3); GAPB(o[1]=__builtin_amdgcn_mfma_f32_32x32x16_bf16(PAF(2),VFR(6),o[1],0,0,0), C0,10, CIC(P0,5)); VRD2(2); \
    GAPB(o[0]=__builtin_amdgcn_mfma_f32_32x32x16_bf16(PAF(3),VFR(3),o[0],0,0,0), C0,12, CIC(P0,6)); VRD2(6); \
    GAPB(o[1]=__builtin_amdgcn_mfma_f32_32x32x16_bf16(PAF(3),VFR(7),o[1],0,0,0), C0,14, CIC(P0,7)); VRD2(3); \
    GAPB(o[2]=__builtin_amdgcn_mfma_f32_32x32x16_bf16(PAF(0),VFR(0),o[2],0,0,0), C1,0, CIA(P1,32,t)); VRD2(7); \
    GAPB(o[3]=__builtin_amdgcn_mfma_f32_32x32x16_bf16(PAF(0),VFR(4),o[3],0,0,0), C1,2, CIB(P1)); \
    GAPB(o[2]=__builtin_amdgcn_mfma_f32_32x32x16_bf16(PAF(1),VFR(1),o[2],0,0,0), C1,4, CIC(P1,2)); \
    GAPB(o[3]=__builtin_amdgcn_mfma_f32_32x32x16_bf16(PAF(1),VFR(5),o[3],0,0,0), C1,6, CIC(P1,3)); \
    GAPB(o[2]=__builtin_amdgcn_mfma_f32_32x32x16_bf16(PAF(2),VFR(2),o[2],0,0,0), C1,8, CIC(P1,4)); \
    GAPB(o[3]=__builtin_amdgcn_mfma_f32_32x32x16_bf16(PAF(2),VFR(6),o[3],0,0,0), C1,10, CIC(P1,5)); \
    GAPB(o[2]=__builtin_amdgcn_mfma_f32_32x32x16_bf16(PAF(3),VFR(3),o[2],0,0,0), C1,12, CIC(P1,6)); \
    GAPB(o[3]=__builtin_amdgcn_mfma_f32_32x32x16_bf16(PAF(3),VFR(7),o[3],0,0,0), C1,14, CIC(P1,7)); \
    }while(0)
  int t=1;
  #undef CMASK
  #define CMASK(P0,P1,t) do{}while(0)
  for(;t+5<NT;t+=2){
    STEP(pB0,pB1,pA0,pA1,t,true,true,true);     WAIT_BAR(3); RESC(); ROT();
    STEP(pA0,pA1,pB0,pB1,t+1,true,true,true);   WAIT_BAR(3); RESC(); ROT();
  }
  #undef CMASK
  #define CMASK(P0,P1,t) do{int jb_=(t)-(NT-4); if(jb_>=0)cmask(P0,P1,jb_,qrel,hi);}while(0)
  #define ENDW(tt) do{ if((tt)+3<NT){WAIT_BAR(3);} else if((tt)+2<NT){WAIT_BAR(2);} else {WAIT_BAR(0);} }while(0)
  for(;t+1<NT;t+=2){
    STEP(pB0,pB1,pA0,pA1,t,(t+3<NT),(t+1<NT),(t+1<NT));       ENDW(t);   RESC(); ROT();
    STEP(pA0,pA1,pB0,pB1,t+1,(t+4<NT),(t+2<NT),(t+2<NT));     ENDW(t+1); RESC(); ROT();
  }
  STEP(pB0,pB1,pA0,pA1,NT-1,false,false,false); RESC();
  { float sacc=pB0[0]+pB0[1]; _Pragma("unroll") for(int r=2;r<16;++r)sacc+=pB0[r]; _Pragma("unroll") for(int r=0;r<16;++r)sacc+=pB1[r]; l_reg+=sacc;
    pw0=(u32x4){PKW(pB0,0),PKW(pB0,2),PKW(pB0,4),PKW(pB0,6)};pw1=(u32x4){PKW(pB0,8),PKW(pB0,10),PKW(pB0,12),PKW(pB0,14)};pw2=(u32x4){PKW(pB1,0),PKW(pB1,2),PKW(pB1,4),PKW(pB1,6)};pw3=(u32x4){PKW(pB1,8),PKW(pB1,10),PKW(pB1,12),PKW(pB1,14)};
    SBAR(); pv(o,vb0+2*sl_cur,PAF(0),PAF(1),PAF(2),PAF(3)); }
  #undef PKW
  #undef PAF
  #undef VFR
  #undef PIN
  #undef MX3
  #undef GAPA
  #undef GAPB
  #undef EX
  #undef VRD
  #undef VRD2
  #undef CIA
  #undef CIB
  #undef CIC
  #undef KRD
  #undef STEP
  #undef ENDW
  if(lead_) *slot_=nxt_;
  {auto rr=__builtin_amdgcn_permlane32_swap(__float_as_uint(l_reg),__float_as_uint(l_reg),false,false);l_reg=__uint_as_float(rr[0])+__uint_as_float(rr[1]);}
  if(hi==0)wsf[32+r32]=l_reg;asm volatile("s_waitcnt lgkmcnt(0)":::"memory");
  float rli[16];
  #pragma unroll
  for(int r=0;r<16;++r)rli[r]=__builtin_amdgcn_rcpf(wsf[32+crow(r,hi)]);
  bf16*Ow=O+(rowbase+q0+wid*QBLK)*DMO+(hm>>1)*256;
  { bf16*stg=(bf16*)(shm+LDS_OST)+wid*2048;
    int eoff=hi*256+r32; asm volatile("":"+v"(eoff));
    const int row_l=lane>>3,ch=lane&7;
    if(!comb_){
      #pragma unroll
      for(int hf=0;hf<2;++hf){
        #pragma unroll
        for(int r=0;r<16;++r){const int orow=(r&3)+8*(r>>2);
          #pragma unroll
          for(int d0=0;d0<2;++d0)stg[eoff+orow*64+d0*32]=__float2bfloat16(o[2*hf+d0][r]*rli[r]);}
        asm volatile("s_waitcnt lgkmcnt(0)":::"memory");
        #pragma unroll
        for(int i=0;i<4;++i){const int row=i*8+row_l; const u32x4 v=*(const u32x4*)(stg+row*64+ch*8); ATTN_STORE16(Ow+(long)row*DMO+hf*64+ch*8,v);}
        asm volatile("s_waitcnt lgkmcnt(0)":::"memory"); }
    } else {
      static_assert(MIXG_FP8, "fused combine writes the fp8 APO layout");
      u32x4 A[2][4];
      #pragma unroll
      for(int hf=0;hf<2;++hf)
        #pragma unroll
        for(int i=0;i<4;++i)A[hf][i]=ld16_sc1(Ow+(long)(i*8+row_l)*DMO+hf*64+ch*8);
      const float lam=*(const volatile __attribute__((address_space(3))) float*)((lds_cptr)shm+LDS_LAM);
      ::f32x4 dd[2][4][2]; float ss[4]={0.f,0.f,0.f,0.f};
      #pragma unroll
      for(int hf=0;hf<2;++hf){
        #pragma unroll
        for(int r=0;r<16;++r){const int orow=(r&3)+8*(r>>2);
          #pragma unroll
          for(int d0=0;d0<2;++d0)stg[eoff+orow*64+d0*32]=__float2bfloat16(o[2*hf+d0][r]*rli[r]);}
        asm volatile("s_waitcnt lgkmcnt(0)":::"memory");
        if(hf==0){ asm volatile("s_waitcnt vmcnt(0)":"+v"(A[0][0]),"+v"(A[0][1]),"+v"(A[0][2]),"+v"(A[0][3]),"+v"(A[1][0]),"+v"(A[1][1]),"+v"(A[1][2]),"+v"(A[1][3])::"memory"); }
        #pragma unroll
        for(int i=0;i<4;++i){const int row=i*8+row_l; const u32x4 v=*(const u32x4*)(stg+row*64+ch*8);
          ::f32x4 a0,a1,b0,b1; pg8::unpack8(A[hf][i],a0,a1); pg8::unpack8(v,b0,b1); a0-=b0*lam; a1-=b1*lam; dd[hf][i][0]=a0; dd[hf][i][1]=a1;
          ss[i]+=(a0[0]*a0[0]+a0[1]*a0[1])+(a0[2]*a0[2]+a0[3]*a0[3])+(a1[0]*a1[0]+a1[1]*a1[1])+(a1[2]*a1[2]+a1[3]*a1[3]); }
        asm volatile("s_waitcnt lgkmcnt(0)":::"memory"); }
      unsigned char*ap=(unsigned char*)O+((long)WS_APO-(long)WS_O16)+(size_t)(rowbase+q0+wid*QBLK+row_l)*1024+(hm>>1)*128+ch*8;
      #pragma unroll
      for(int i=0;i<4;++i){ float s=ss[i];
        #define SWZ_ADD(k) s+=__builtin_bit_cast(float,__builtin_amdgcn_ds_swizzle(__builtin_bit_cast(int,s),((k)<<10)|0x1f))
        SWZ_ADD(1);SWZ_ADD(2);SWZ_ADD(4);
        #undef SWZ_ADD
        const float rs=rsqrtf(s*(1.f/128.f)+LN_EPS)*(0.8f*APO_SCALE);
        #pragma unroll
        for(int hf=0;hf<2;++hf){ const __attribute__((address_space(3))) f32x4_* gp=(const __attribute__((address_space(3))) f32x4_*)((lds_cptr)shm+LDS_SUBLN+(hf*64+ch*8)*4); const f32x4_ g0=gp[0],g1=gp[1];
          ::f32x4 a0=dd[hf][i][0],a1=dd[hf][i][1];
          #pragma unroll
          for(int j=0;j<4;++j){a0[j]*=rs*g0[j];a1[j]*=rs*g1[j];}
          *(unsigned long long*)(ap+(size_t)(i*8)*1024+hf*64)=(unsigned long long)pg8::pk4_fp8(a0[0],a0[1],a0[2],a0[3])|((unsigned long long)pg8::pk4_fp8(a1[0],a1[1],a1[2],a1[3])<<32); } }
    } }
  asm volatile("s_waitcnt lgkmcnt(0)\n\ts_barrier":::"memory");
  #undef DMA_K
  #undef DMA_V
  #undef CMASK
  #undef START
  #undef RESC
  #undef ROT
  #undef CINIT
  #undef CINIT1
}
constexpr int ATTN_LDS_BYTES=LDS_BYTES;
struct AttnTensors { const bf16* Q; const bf16* K; const bf16* V; bf16* O; const float* PN; unsigned* queue; float lam; const float* subln; unsigned char* APO; };
constexpr int LDS_SLOT=LDS_BYTES, LDS_T0=LDS_BYTES+1024, LDS_UREF=LDS_T0+8192, ATTN_LDS_TOTAL=LDS_UREF+8192;
__device__ __forceinline__ void unit_of(int u,int&b,int&h,int&qb){ if(u<512){qb=15-(u>>5);const int r=u&31;b=r>>1;h=2+(r&1);} else if(u<768){const int v=u-512;qb=15-(v>>4);b=v&15;h=1;} else {const int v=u-768;qb=15-(v>>4);b=v&15;h=0;} }
__device__ __forceinline__ void attn_tables(char*lds,const float*PN,int tid){
  const int bhm=tid>>2,part=tid&3; const float*pq=PN+(bhm*64+16*part)*2,*pk=PN+16384+(bhm*64+16*part)*2;
  float kq[16],qq[16];
  #pragma unroll
  for(int i=0;i<8;++i){ const f32x4_ a=*(const f32x4_*)(pk+4*i),c=*(const f32x4_*)(pq+4*i); kq[2*i]=a[0]+a[1];kq[2*i+1]=a[2]+a[3];qq[2*i]=c[0]+c[1];qq[2*i+1]=c[2]+c[3]; }
  float km[4]; { float m=0.f;
    #pragma unroll
    for(int i=0;i<16;++i){ m=__builtin_fmaxf(m,kq[i]); if((i&3)==3)km[i>>2]=m; } }
  float before=0.f;
  #pragma unroll
  for(int p=0;p<3;++p){ const float tot=__shfl(km[3],(tid&~3)+p); if(p<part)before=__builtin_fmaxf(before,tot); }
  const int hm=bhm&7; const float cs=__builtin_amdgcn_exp2f(-2.f*(float)((hm>>1)+1))*1.4426950408889634f;
  volatile __attribute__((address_space(3))) int* T0=(volatile __attribute__((address_space(3))) int*)(lds+LDS_T0); volatile __attribute__((address_space(3))) float* UR=(volatile __attribute__((address_space(3))) float*)(lds+LDS_UREF);
  #pragma unroll
  for(int j=0;j<4;++j){ const int qb=4*part+j; const float kmx=__builtin_fmaxf(before,km[j]); const float qmx=__builtin_fmaxf(__builtin_fmaxf(qq[4*j],qq[4*j+1]),__builtin_fmaxf(qq[4*j+2],qq[4*j+3]));
    const float qk=__builtin_sqrtf(qmx*kmx), need=(ATT_SKIP+2.04f*qk)/cs;
    const float tf=((float)(256*qb-63)-need)*(1.f/64.f); int tt=tf>0.f?(int)tf:0; tt&=~1; if(tt>4*qb)tt=4*qb;
    T0[bhm*16+qb]=tt; UR[bhm*16+qb]=1.02f*qk; }
}
template<int THRL=8> __device__ __forceinline__ void attn_phase(char*lds,const AttnTensors&T,const int wid){
  volatile __attribute__((address_space(3))) int* slot=(volatile __attribute__((address_space(3))) int*)(lds+LDS_SLOT);
  const volatile __attribute__((address_space(3))) int* T0=(const volatile __attribute__((address_space(3))) int*)(lds+LDS_T0); const volatile __attribute__((address_space(3))) float* UR=(const volatile __attribute__((address_space(3))) float*)(lds+LDS_UREF);
  const bool lead=(wid==0)&&(lane_id()==0);
  if(lead) *slot=(int)__hip_atomic_fetch_add(T.queue,1u,__ATOMIC_RELAXED,__HIP_MEMORY_SCOPE_AGENT);
  { const int tid_=wid*64+lane_id(); if(tid_<128)((volatile __attribute__((address_space(3))) float*)(lds+LDS_SUBLN))[tid_]=T.subln[tid_]; if(tid_==0)*(volatile __attribute__((address_space(3))) float*)(lds+LDS_LAM)=T.lam; }
  attn_tables(lds,T.PN,wid*64+lane_id());
  asm volatile("s_waitcnt vmcnt(0) lgkmcnt(0)\n\ts_barrier":::"memory");
  int cur=__builtin_amdgcn_readfirstlane(*slot);
  asm volatile("s_waitcnt lgkmcnt(0)\n\ts_barrier":::"memory");
  while(cur<BATCH*4*NQB){
    int nxt=0; if(lead) nxt=(int)__hip_atomic_fetch_add(T.queue,1u,__ATOMIC_RELAXED,__HIP_MEMORY_SCOPE_AGENT);
    int b,h,qb; unit_of(cur,b,h,qb);
    const float cs=__builtin_bit_cast(float,__builtin_amdgcn_readfirstlane(__builtin_bit_cast(int,__builtin_amdgcn_exp2f(-2.f*(float)(h+1))*1.4426950408889634f)));
    #pragma unroll 1
    for(int m=0;m<2;++m){ const int hm=2*h+m;
      const int t0=__builtin_amdgcn_readfirstlane(T0[(b*8+hm)*16+qb]); const float uref=__builtin_bit_cast(float,__builtin_amdgcn_readfirstlane(__builtin_bit_cast(int,(float)UR[(b*8+hm)*16+qb])));
      attn_unit<THRL>(b,hm,qb,cs,wid,t0,uref,T.Q,T.K,T.V,T.O,lds,slot,nxt,lead&&(m==1),m==1); }
    cur=__builtin_amdgcn_readfirstlane(*slot);
    asm volatile("s_waitcnt lgkmcnt(0)":::"memory");
  }
}
#undef SBAR
#undef WAIT_BAR
}
constexpr int NWAVES = 8;
constexpr int RING_OFF = 0, RING_BYTES = 131072;
constexpr int LDSCTL_OFF = RING_BYTES, MISC_OFF = LDSCTL_OFF + 320;
constexpr int LDS_BYTES = 163840;

#define XB_TMO      128
#define XB_XCNT(j)  (256  + 64 * (j))
#define XB_XSUB(j)  (1280 + 64 * (j))
#define XB_XGEN(j)  (2304 + 64 * (j))
#define XB_TOP      3328
#define XB_TOPGEN   3392
#define XCD_BAR_WORDS 3456
#define XB_SPIN_CAP (1u << 18)
__device__ __forceinline__ unsigned xb_ld(unsigned* p)              { return __hip_atomic_load(p, __ATOMIC_RELAXED, __HIP_MEMORY_SCOPE_AGENT); }
__device__ __forceinline__ unsigned xb_add(unsigned* p, unsigned v) { return __hip_atomic_fetch_add(p, v, __ATOMIC_RELAXED, __HIP_MEMORY_SCOPE_AGENT); }
__device__ __forceinline__ unsigned xb_xcc_id() { return (unsigned)__builtin_amdgcn_s_getreg((3 << 11) | 20) & 0xFu; }
#define XB_SPIN(cond, bar) do { unsigned _sp = 0; while (cond) { __builtin_amdgcn_s_sleep(1); \
    if ((++_sp & 255u) == 0u) { if (xb_ld(&(bar)[XB_TMO])) break; if (_sp > XB_SPIN_CAP) { atomicAdd(&(bar)[XB_TMO], 1u); break; } } } } while (0)
struct XcdBarrier { unsigned* bar; unsigned x; volatile LAS unsigned* st; bool wave0; };
__device__ __forceinline__ XcdBarrier xcd_barrier_post(unsigned* bar, volatile LAS unsigned* st) {
    XcdBarrier b; b.bar = bar; b.x = xb_xcc_id(); b.st = st; b.wave0 = __builtin_amdgcn_readfirstlane(threadIdx.x >> 6) == 0;
    if (threadIdx.x == 0) (void)xb_add(&bar[XB_XCNT(b.x)], 1u);
    return b;
}
__device__ __forceinline__ void xcd_barrier_complete(unsigned* bar, unsigned x, unsigned& nloc, unsigned& nx) {
    const unsigned G = gridDim.x * gridDim.y * gridDim.z;
    unsigned sum, cnt, mine, sp = 0u;
    for (;;) {
        sum = 0u; cnt = 0u; mine = 0u;
#pragma unroll
        for (unsigned j = 0; j < 16; ++j) { const unsigned c = xb_ld(&bar[XB_XCNT(j)]); sum += c; cnt += (c > 0u) ? 1u : 0u; mine = (j == x) ? c : mine; }
        if (sum == G) break;
        __builtin_amdgcn_s_sleep(1);
        if ((++sp & 255u) == 0u) { if (xb_ld(&bar[XB_TMO])) break; if (sp > XB_SPIN_CAP) { atomicAdd(&bar[XB_TMO], 1u); break; } }
    }
    nloc = mine > 0u ? mine : 1u; nx = cnt > 0u ? cnt : 1u;
}
__device__ __forceinline__ void xcd_barrier(const XcdBarrier& b) {
    asm volatile("s_waitcnt vmcnt(0)" ::: "memory");
    __syncthreads();
    if (b.wave0 && lane_id() == 0) {
        unsigned* bar = b.bar;
        __builtin_amdgcn_s_waitcnt(0);
        unsigned nloc = b.st[0], nx = b.st[1];
        if (nloc == 0u) { xcd_barrier_complete(bar, b.x, nloc, nx); b.st[0] = nloc; b.st[1] = nx; }
        const unsigned old = xb_add(&bar[XB_XSUB(b.x)], 1u);
        const unsigned gen = old / nloc;
        if (old + 1u == (gen + 1u) * nloc) {
            __builtin_amdgcn_fence(__ATOMIC_RELEASE, "agent");
            asm volatile("s_waitcnt vmcnt(0)" ::: "memory");
            const unsigned og = xb_add(&bar[XB_TOP], 1u);
            const unsigned tg = og / nx;
            if (og + 1u == (tg + 1u) * nx) xb_add(&bar[XB_TOPGEN], 1u);
            else XB_SPIN(xb_ld(&bar[XB_TOPGEN]) == tg, bar);
            __builtin_amdgcn_fence(__ATOMIC_ACQUIRE, "agent");
            xb_add(&bar[XB_XGEN(b.x)], 1u);
            asm volatile("s_waitcnt vmcnt(0)" ::: "memory");
        } else {
            XB_SPIN(xb_ld(&bar[XB_XGEN(b.x)]) == gen, bar);
            __builtin_amdgcn_fence(__ATOMIC_ACQUIRE, "agent");
            asm volatile("s_waitcnt vmcnt(0)" ::: "memory");
        }
    }
    __syncthreads();
}

struct Frame {
    LAS unsigned char* lds; volatile LAS unsigned* MISC; gu32* ctl;
    int tid, lane, wave, vcu, G;
};
__device__ __forceinline__ float bf2f_(unsigned short b) { return __builtin_bit_cast(float, (unsigned)b << 16); }
__device__ __forceinline__ float wave_sum(float v) {
#pragma unroll
    for (int o = 1; o < 64; o <<= 1) v += __shfl_xor(v, o);
    return v;
}
struct Ptrs {
    const float *x, *p, *w_in, *b_gate, *lq1, *lk1, *lq2, *lk2, *subln, *w_abr, *w_pmix, *pscale, *w_pbr, *w_out, *ln1g, *ln1b, *w_router, *b_router, *w_up, *b_up, *w_down, *b_down, *w_pg, *w_pp, *ln2g, *ln2b;
    float* out; unsigned char* ws;
};
constexpr int TI_IN = 16 * 128, TI_A = 8 * 32, TI_O = 16 * 32, TI_PG = 16 * 32, TI_PP = 4 * 32, TI_UP1 = 16 * 64, TI_DN1 = 16 * 32;
constexpr int TI_UP = NEXP * TI_UP1, TI_DN = NEXP * TI_DN1, TI_EARLY = TI_IN + TI_A + TI_O, TI_TOTAL = TI_EARLY + TI_PG + TI_PP + TI_UP + TI_DN;
#ifndef NCONV
#define NCONV 64
#endif
#ifndef NPOOL
#define NPOOL 0
#endif
struct TItem { const float* W; unsigned char* WT; int ldw, K, k0, n0, drow0, f8; float scale; };
__device__ __forceinline__ TItem p0_item(const Ptrs& P, int it) {
    unsigned char* ws = P.ws; TItem t; int r = it; t.f8 = 0; t.scale = 1.f;
    if (r < TI_IN) { const int nb = 128, n0 = 32 * (r % nb); t.W = P.w_in; t.ldw = 4096; t.K = 1024; t.k0 = 64 * (r / nb); t.n0 = n0;
        if (n0 >= 256 * PROJ_F8_FROM) { static_assert(PROJ_F8_FROM == 8 || PROJ_F8_FROM == 16, "gate-column interleave assumes the fp8 part is exactly the 2048 gate columns");
            const int gc = n0 - 2048, c = gc & 1023;
            t.WT = ws + WS_WIN8; t.drow0 = 256 * (c >> 7) + 128 * (gc >> 10) + (c & 127); t.f8 = 1; t.scale = WUP_SCALE; }
        else { t.WT = ws + WS_WIN; t.drow0 = n0; }
        return t; } r -= TI_IN;
    if (r < TI_A) { const int nb = 32; t.W = P.w_abr; t.ldw = 1024; t.K = 1024; t.WT = ws + WS_WCAT; t.k0 = 64 * (r / nb); t.n0 = t.drow0 = 32 * (r % nb); if (MIXG_FP8) { t.f8 = 1; t.scale = WUP_SCALE; } return t; } r -= TI_A;
    if (r < TI_O) { const int nb = 32; t.W = P.w_out; t.ldw = 1024; t.K = 1024; t.WT = ws + WS_WOUT; t.k0 = 64 * (r / nb); t.n0 = t.drow0 = 32 * (r % nb); return t; } r -= TI_O;
    if (r < TI_PG) { const int nb = 32; t.W = P.w_pg; t.ldw = 1024; t.K = 1024; t.WT = ws + WS_WPG; t.k0 = 64 * (r / nb); t.n0 = t.drow0 = 32 * (r % nb); if (MOE_FP8) { t.f8 = 1; t.scale = WUP_SCALE; } return t; } r -= TI_PG;
    if (r < TI_PP) { const int nb = 32; t.W = P.w_pp; t.ldw = 1024; t.K = 256; t.WT = ws + WS_WPP; t.k0 = 64 * (r / nb); t.n0 = t.drow0 = 32 * (r % nb); return t; } r -= TI_PP;
    if (r < TI_UP) { const int e = r / TI_UP1, q = r % TI_UP1, nb = 64, n0 = 32 * (q % nb);
        const int bj = n0 >> 10, pn = (n0 & 1023) >> 7, cp = n0 & 127;
        t.W = P.w_up + (size_t)e * 1024 * 2048; t.ldw = 2048; t.K = 1024; t.k0 = 64 * (q / nb); t.n0 = n0; t.drow0 = 256 * pn + 128 * bj + cp;
        if (MOE_FP8) { t.WT = ws + WS_WUP + (size_t)e * 2048 * 1024; t.f8 = 1; t.scale = WUP_SCALE; } else t.WT = ws + WS_WUP + (size_t)e * 2048 * 1024 * 2;
        return t; } r -= TI_UP;
    { const int e = r / TI_DN1, q = r % TI_DN1, nb = 32;
        t.W = P.w_down + (size_t)e * 1024 * 1024; t.ldw = 1024; t.K = 1024; t.k0 = 64 * (q / nb); t.n0 = t.drow0 = 32 * (q % nb);
        if (MOE_FP8) { t.WT = ws + WS_WDN + (size_t)e * 1024 * 1024; t.f8 = 1; t.scale = WDN_SCALE; } else t.WT = ws + WS_WDN + (size_t)e * 1024 * 1024 * 2; }
    return t;
}
__device__ __forceinline__ void p0_emit(const TItem& t, LAS float* scr, int lane) {
    if (t.f8) { const int c = lane & 3;
#pragma unroll
        for (int j = 0; j < 2; ++j) { const int n = (lane >> 2) + 16 * j; const LAS float* s = scr + (16 * c) * 33 + n;
            v4u o; o.x = pg8::pk4_fp8(s[0 * 33], s[1 * 33], s[2 * 33], s[3 * 33]); o.y = pg8::pk4_fp8(s[4 * 33], s[5 * 33], s[6 * 33], s[7 * 33]);
            o.z = pg8::pk4_fp8(s[8 * 33], s[9 * 33], s[10 * 33], s[11 * 33]); o.w = pg8::pk4_fp8(s[12 * 33], s[13 * 33], s[14 * 33], s[15 * 33]);
            *(GAS v4u*)(t.WT + (size_t)(t.drow0 + n) * t.K + t.k0 + 16 * c) = o; } }
    else { const int c = lane & 7;
#pragma unroll
        for (int j = 0; j < 4; ++j) { const int n = (lane >> 3) + 8 * j; const LAS float* s = scr + (8 * c) * 33 + n;
            v4u o; o.x = pk2(s[0 * 33], s[1 * 33]); o.y = pk2(s[2 * 33], s[3 * 33]); o.z = pk2(s[4 * 33], s[5 * 33]); o.w = pk2(s[6 * 33], s[7 * 33]);
            *(GAS v4u*)((bf16*)t.WT + (size_t)(t.drow0 + n) * t.K + t.k0 + 8 * c) = o; } }
}
#define P0_LOAD(T, V) do { const char* base_ = (const char*)(T.W + (size_t)T.k0 * T.ldw + T.n0); unsigned vo_ = (unsigned)(((lane >> 5) * T.ldw + (lane & 31)) * 4); const unsigned step_ = (unsigned)(T.ldw * 8); \
        _Pragma("unroll") for (int i = 0; i < 32; ++i) { V[i] = *(const float*)(base_ + vo_); vo_ += step_; } } while (0)
#define P0_DRAIN(T, V) do { _Pragma("unroll") for (int i = 0; i < 32; ++i) scr[(2 * i + (lane >> 5)) * 33 + (lane & 31)] = V[i] * T.scale; \
        LDS_WAIT(); asm volatile("" ::: "memory"); p0_emit(T, scr, lane); LDS_WAIT(); asm volatile("" ::: "memory"); } while (0)
__device__ __forceinline__ void conv_items(const Ptrs& P, int first, int last, int start, int stride, LAS float* scr, int lane) {
    int it = first + start; if (it >= last) return;
    TItem a = p0_item(P, it), b = p0_item(P, it + stride < last ? it + stride : it); bool two = it + stride < last;
    float va[32], vb[32], na[32], nb[32];
    P0_LOAD(a, va); if (two) P0_LOAD(b, vb);
    for (;;) {
        const int nt = it + 2 * stride; const bool more = nt < last, more2 = nt + stride < last;
        const TItem c = p0_item(P, more ? nt : it), d = p0_item(P, more2 ? nt + stride : it);
        if (more) P0_LOAD(c, na);
        if (more2) P0_LOAD(d, nb);
        P0_DRAIN(a, va); if (two) P0_DRAIN(b, vb);
        if (!more) break;
        it = nt; a = c; b = d; two = more2;
#pragma unroll
        for (int i = 0; i < 32; ++i) { va[i] = na[i]; vb[i] = nb[i]; }
    }
}
#undef P0_LOAD
#undef P0_DRAIN
__device__ __forceinline__ void ph0_prologue(Frame& F, const Ptrs& P) {
    unsigned char* ws = P.ws;
    LAS float* scr = (LAS float*)(F.lds + RING_OFF + F.wave * 16384);
    const int gw = F.vcu * NWAVES + F.wave, NGW = F.G * NWAVES;
    { const size_t n4 = (size_t)M * D / 4, st = (size_t)F.G * 512; const f32x4* src = (const f32x4*)P.x; unsigned long long* dst = (unsigned long long*)P.out;
      unsigned* dst8 = (unsigned*)(ws + WS_XF8);
      for (size_t i = (size_t)blockIdx.x * 512 + F.tid; i < n4; i += 8 * st) { f32x4 v[8];
#pragma unroll
          for (int u = 0; u < 8; ++u) v[u] = (i + u * st < n4) ? src[i + u * st] : (f32x4){0.f, 0.f, 0.f, 0.f};
#pragma unroll
          for (int u = 0; u < 8; ++u) if (i + u * st < n4) { dst[i + u * st] = (unsigned long long)pk2(v[u].x, v[u].y) | ((unsigned long long)pk2(v[u].z, v[u].w) << 32);
              if (PROJ_F8_FROM < 16) dst8[i + u * st] = pg8::pk4_fp8(v[u].x, v[u].y, v[u].z, v[u].w); } } }
    conv_items(P, 0, NCONV > 0 ? TI_EARLY : TI_TOTAL, gw, NGW, scr, F.lane);
    { bf16* WPC = (bf16*)(ws + WS_WCAT) + 512; unsigned char* WPC8 = ws + WS_WCAT + 512;
      for (int k = blockIdx.x; k < 512; k += F.G) { const int g = k >> 7;
          float a0 = 0.f, a1 = 0.f; const float* wm = P.w_pmix + (size_t)k * 128; const float* sc = P.pscale + g * 128; const float* wb = P.w_pbr + (size_t)(g * 128) * 1024;
          for (int d = 0; d < 128; ++d) { const float w = wm[d] * sc[d]; a0 += w * wb[(size_t)d * 1024 + F.tid]; a1 += w * wb[(size_t)d * 1024 + 512 + F.tid]; }
          if (MIXG_FP8) { WPC8[(size_t)F.tid * 1024 + k] = (unsigned char)(pg8::pk4_fp8(a0 * WUP_SCALE, 0.f, 0.f, 0.f) & 0xffu); WPC8[(size_t)(F.tid + 512) * 1024 + k] = (unsigned char)(pg8::pk4_fp8(a1 * WUP_SCALE, 0.f, 0.f, 0.f) & 0xffu); }
          else { WPC[(size_t)F.tid * 1024 + k] = (bf16)f2bf(a0); WPC[(size_t)(F.tid + 512) * 1024 + k] = (bf16)f2bf(a1); } } }
}
__device__ __forceinline__ void ph_pool(Frame& F, const Ptrs& P, const int wg, const int nwg) {
    const bf16* U = (const bf16*)(P.ws + WS_U); bf16* PO = (bf16*)(P.ws + WS_APO) + 512;
    constexpr int RL = 32;
    const size_t nitem = (size_t)(M / RL) * 64, st = (size_t)nwg * 512;
    for (size_t idx = (size_t)wg * 512 + F.tid; idx < nitem; idx += st) {
        const int cg = (int)(idx & 63), c0 = cg * 8, w = 2 << (c0 >> 7); const size_t r0 = (idx >> 6) * RL; const int pos0 = (int)(r0 & (SEQ - 1));
        const bf16* up = U + r0 * 512 + c0; bf16* op = PO + r0 * 1024 + c0; unsigned char* op8 = P.ws + WS_APO + 512 + r0 * 1024 + c0;
        float s[8] = {0.f, 0.f, 0.f, 0.f, 0.f, 0.f, 0.f, 0.f};
        const int nprev = pos0 < w ? pos0 : w;
        for (int k = 1; k <= nprev; ++k) { const v4u v = *(const v4u*)(up - (size_t)k * 512);
            s[0] += pg8::bflo(v.x); s[1] += pg8::bfhi(v.x); s[2] += pg8::bflo(v.y); s[3] += pg8::bfhi(v.y); s[4] += pg8::bflo(v.z); s[5] += pg8::bfhi(v.z); s[6] += pg8::bflo(v.w); s[7] += pg8::bfhi(v.w); }
        const float rw = 1.f / (float)w;
#pragma unroll 4
        for (int j = 0; j < RL; ++j) { const int pos = pos0 + j; const bool drop = pos >= w;
            const v4u cur = *(const v4u*)(up + (size_t)j * 512), old = *(const v4u*)(up + (size_t)(drop ? j - w : j) * 512);
            const float c[8] = {pg8::bflo(cur.x), pg8::bfhi(cur.x), pg8::bflo(cur.y), pg8::bfhi(cur.y), pg8::bflo(cur.z), pg8::bfhi(cur.z), pg8::bflo(cur.w), pg8::bfhi(cur.w)};
            const float o[8] = {pg8::bflo(old.x), pg8::bfhi(old.x), pg8::bflo(old.y), pg8::bfhi(old.y), pg8::bflo(old.z), pg8::bfhi(old.z), pg8::bflo(old.w), pg8::bfhi(old.w)};
            const float rn = pos + 1 < w ? 1.f / (float)(pos + 1) : rw; float r[8];
#pragma unroll
            for (int i = 0; i < 8; ++i) { s[i] += c[i]; if (drop) s[i] -= o[i]; r[i] = s[i] * rn - c[i]; }
            v4u ov; ov.x = pk2(r[0], r[1]); ov.y = pk2(r[2], r[3]); ov.z = pk2(r[4], r[5]); ov.w = pk2(r[6], r[7]);
            if (MIXG_FP8) { *(unsigned long long*)(op8 + (size_t)j * 1024) = (unsigned long long)pg8::pk4_fp8(r[0] * APO_SCALE, r[1] * APO_SCALE, r[2] * APO_SCALE, r[3] * APO_SCALE) | ((unsigned long long)pg8::pk4_fp8(r[4] * APO_SCALE, r[5] * APO_SCALE, r[6] * APO_SCALE, r[7] * APO_SCALE) << 32); }
            else *(v4u*)(op + (size_t)j * 1024) = ov; }
    }
}
__device__ __forceinline__ float lam_value(const Ptrs& P) { float a = 0.f, b = 0.f; for (int d = 0; d < 64; ++d) { a += P.lq1[d] * P.lk1[d]; b += P.lq2[d] * P.lk2[d]; } return __expf(a) - __expf(b) + 0.2f; }
__device__ __forceinline__ void ph_combine(Frame& F, const Ptrs& P) {
    const bf16* O16 = (const bf16*)(P.ws + WS_O16); bf16* OA = (bf16*)(P.ws + WS_APO); const float lam = lam_value(P);
    const int gw = F.vcu * NWAVES + F.wave, NGW = F.G * NWAVES, h = F.lane >> 4, e0 = (F.lane & 15) * 8;
    float sg[8];
#pragma unroll
    for (int j = 0; j < 8; ++j) sg[j] = P.subln[e0 + j] * 0.8f;
    v4u av[4], bv[4], nav[4], nbv[4];
#define PH3_LOAD(r0_, AV, BV) do { _Pragma("unroll") for (int u = 0; u < 4; ++u) { const int row = (r0_) + u * NGW; if (row < M) { AV[u] = *(const v4u*)(O16 + (size_t)row * 1024 + h * 256 + e0); BV[u] = *(const v4u*)(O16 + (size_t)row * 1024 + h * 256 + 128 + e0); } } } while (0)
    if (gw < M) PH3_LOAD(gw, av, bv);
    for (int row0 = gw; row0 < M; row0 += 4 * NGW) {
        if (row0 + 4 * NGW < M) PH3_LOAD(row0 + 4 * NGW, nav, nbv);
#pragma unroll
        for (int u = 0; u < 4; ++u) { const int row = row0 + u * NGW; if (row >= M) continue;
            f32x4 a0, a1, b0, b1; pg8::unpack8(av[u], a0, a1); pg8::unpack8(bv[u], b0, b1); a0 -= b0 * lam; a1 -= b1 * lam;
            float ss = (a0[0] * a0[0] + a0[1] * a0[1]) + (a0[2] * a0[2] + a0[3] * a0[3]) + (a1[0] * a1[0] + a1[1] * a1[1]) + (a1[2] * a1[2] + a1[3] * a1[3]);
            ss += __shfl_xor(ss, 1); ss += __shfl_xor(ss, 2); ss += __shfl_xor(ss, 4); ss += __shfl_xor(ss, 8);
            const float r = rsqrtf(ss * (1.f / 128.f) + LN_EPS);
#pragma unroll
            for (int j = 0; j < 4; ++j) { a0[j] *= r * sg[j]; a1[j] *= r * sg[4 + j]; }
            if (MIXG_FP8) { a0 *= APO_SCALE; a1 *= APO_SCALE; *(unsigned long long*)(P.ws + WS_APO + (size_t)row * 1024 + h * 128 + e0) = (unsigned long long)pg8::pk4_fp8(a0[0], a0[1], a0[2], a0[3]) | ((unsigned long long)pg8::pk4_fp8(a1[0], a1[1], a1[2], a1[3]) << 32); }
            else *(v4u*)(OA + (size_t)row * 1024 + h * 128 + e0) = pg8::pack8(a0, a1); }
#pragma unroll
        for (int u = 0; u < 4; ++u) { av[u] = nav[u]; bv[u] = nbv[u]; }
    }
#undef PH3_LOAD
}
__device__ __forceinline__ void conv_p(Frame& F, const Ptrs& P, const int wg, const int nwg) {
    const size_t n4 = (size_t)M * PLE / 4, st = (size_t)nwg * 512; const f32x4* src = (const f32x4*)P.p; unsigned long long* dst = (unsigned long long*)((unsigned char*)P.out + 128 * MiB);
    for (size_t i = (size_t)wg * 512 + F.tid; i < n4; i += 8 * st) { f32x4 v[8];
#pragma unroll
        for (int u = 0; u < 8; ++u) v[u] = (i + u * st < n4) ? src[i + u * st] : (f32x4){0.f, 0.f, 0.f, 0.f};
#pragma unroll
        for (int u = 0; u < 8; ++u) if (i + u * st < n4) dst[i + u * st] = (unsigned long long)pk2(v[u].x, v[u].y) | ((unsigned long long)pk2(v[u].z, v[u].w) << 32); }
}
typedef float f32x16_ __attribute__((ext_vector_type(16)));
__device__ __forceinline__ void hilo8(const f32x4& a, const f32x4& b, bf16x8& hi, bf16x8& lo) {
    unsigned h[4], l[4];
    h[0] = pg8::cvt_pk_bf16(a[0], a[1]); h[1] = pg8::cvt_pk_bf16(a[2], a[3]); h[2] = pg8::cvt_pk_bf16(b[0], b[1]); h[3] = pg8::cvt_pk_bf16(b[2], b[3]);
    l[0] = pg8::cvt_pk_bf16(a[0] - pg8::bflo(h[0]), a[1] - pg8::bfhi(h[0])); l[1] = pg8::cvt_pk_bf16(a[2] - pg8::bflo(h[1]), a[3] - pg8::bfhi(h[1]));
    l[2] = pg8::cvt_pk_bf16(b[0] - pg8::bflo(h[2]), b[1] - pg8::bfhi(h[2])); l[3] = pg8::cvt_pk_bf16(b[2] - pg8::bflo(h[3]), b[3] - pg8::bfhi(h[3]));
    v4u hv = {h[0], h[1], h[2], h[3]}, lv = {l[0], l[1], l[2], l[3]}; hi = __builtin_bit_cast(bf16x8, hv); lo = __builtin_bit_cast(bf16x8, lv);
}
__device__ __forceinline__ void ph6_ln1_route(Frame& F, const Ptrs& P, const bool dry) {
    unsigned char* ws = P.ws;
    constexpr int XT_OFF = 0, XT_PITCH = 1028, PL_OFF = 16 * XT_PITCH * 4, LG_OFF = PL_OFF + 8 * 16 * 32 * 4, RS_OFF = LG_OFF + 256 * 33 * 4;
    static_assert(RS_OFF + 256 <= RING_BYTES, "ph6 LDS map");
    if (NCONV == 0) conv_p(F, P, (int)blockIdx.x, F.G);
    const bf16* X1in = (const bf16*)(ws + WS_PRE1B); float* STAT = (float*)(ws + (dry ? 228 * MiB : WS_STAT)); unsigned char* X1F8 = ws + (dry ? 740 * MiB : WS_X1F8);
#define CI6(j) (8 * (lane + 64 * ((j) >> 1)) + 4 * ((j) & 1))
    const int lane = F.lane, wave = F.wave, e = lane & 31, kh = lane >> 5;
    LAS float* XT = (LAS float*)(F.lds + XT_OFF); LAS float* PL = (LAS float*)(F.lds + PL_OFF); LAS float* LG = (LAS float*)(F.lds + LG_OFF);
    bf16x8 bh[8], bl[8];
#pragma unroll
    for (int s = 0; s < 8; ++s) { const float* wp = P.w_router + (size_t)(128 * wave + 16 * s + 8 * kh) * 32 + e;
        const f32x4 a = {wp[0], wp[32], wp[64], wp[96]}, b = {wp[128], wp[160], wp[192], wp[224]}; hilo8(a, b, bh[s], bl[s]); }
    f32x4 gam[4], bet[4];
#pragma unroll
    for (int j = 0; j < 4; ++j) { gam[j] = *(const f32x4*)(P.ln1g + CI6(j)); bet[j] = *(const f32x4*)(P.ln1b + CI6(j)); }
    const float brt = P.b_router[e];
    for (int chunk = blockIdx.x; chunk < M / 256; chunk += F.G) {
        f32x4 v[2][4]; v4u nw[2][2];
#pragma unroll
        for (int i = 0; i < 2; ++i)
#pragma unroll
            for (int jj = 0; jj < 2; ++jj) nw[i][jj] = *(const v4u*)(X1in + (size_t)(chunk * 256 + 2 * wave + i) * 1024 + 8 * (lane + 64 * jj));
#pragma unroll 1
        for (int step = 0; step < 16; ++step) {
#pragma unroll
            for (int i = 0; i < 2; ++i)
#pragma unroll
                for (int jj = 0; jj < 2; ++jj) pg8::unpack8(nw[i][jj], v[i][2 * jj], v[i][2 * jj + 1]);
            if (step < 15) {
#pragma unroll
                for (int i = 0; i < 2; ++i)
#pragma unroll
                    for (int jj = 0; jj < 2; ++jj) nw[i][jj] = *(const v4u*)(X1in + (size_t)(chunk * 256 + (step + 1) * 16 + 2 * wave + i) * 1024 + 8 * (lane + 64 * jj)); }
            float s0 = 0.f, s1 = 0.f;
#pragma unroll
            for (int j = 0; j < 4; ++j) { s0 += (v[0][j].x + v[0][j].y) + (v[0][j].z + v[0][j].w); s1 += (v[1][j].x + v[1][j].y) + (v[1][j].z + v[1][j].w); }
#pragma unroll
            for (int o = 1; o < 64; o <<= 1) { s0 += __shfl_xor(s0, o); s1 += __shfl_xor(s1, o); }
            const float m0 = s0 * (1.f / 1024.f), m1 = s1 * (1.f / 1024.f); float q0 = 0.f, q1 = 0.f;
#pragma unroll
            for (int j = 0; j < 4; ++j) { v[0][j] = v[0][j] - m0; v[1][j] = v[1][j] - m1;
                q0 += (v[0][j].x * v[0][j].x + v[0][j].y * v[0][j].y) + (v[0][j].z * v[0][j].z + v[0][j].w * v[0][j].w); q1 += (v[1][j].x * v[1][j].x + v[1][j].y * v[1][j].y) + (v[1][j].z * v[1][j].z + v[1][j].w * v[1][j].w); }
#pragma unroll
            for (int o = 1; o < 64; o <<= 1) { q0 += __shfl_xor(q0, o); q1 += __shfl_xor(q1, o); }
            const float r0 = rsqrtf(q0 * (1.f / 1024.f) + LN_EPS), r1 = rsqrtf(q1 * (1.f / 1024.f) + LN_EPS);
#pragma unroll
            for (int i = 0; i < 2; ++i) { const int rl = 2 * wave + i; const size_t row = (size_t)chunk * 256 + step * 16 + rl; const float rs = i ? r1 : r0;
                if (lane == 0) { pg8::f32x2 sv = {i ? m1 : m0, rs}; *(pg8::f32x2*)(STAT + 2 * row) = sv; }
#pragma unroll
                for (int jj = 0; jj < 2; ++jj) { const f32x4 y0 = v[i][2 * jj] * rs * gam[2 * jj] + bet[2 * jj], y1 = v[i][2 * jj + 1] * rs * gam[2 * jj + 1] + bet[2 * jj + 1]; const int c = 8 * (lane + 64 * jj);
                    *(unsigned long long*)(X1F8 + row * 1024 + c) = (unsigned long long)pg8::pk4_fp8(y0.x, y0.y, y0.z, y0.w) | ((unsigned long long)pg8::pk4_fp8(y1.x, y1.y, y1.z, y1.w) << 32);
                    *(LAS f32x4*)(XT + rl * XT_PITCH + c) = y0; *(LAS f32x4*)(XT + rl * XT_PITCH + c + 4) = y1; } }
            __syncthreads();
            f32x16_ acc = {};
#pragma unroll
            for (int s = 0; s < 8; ++s) { const LAS float* xp = XT + (lane & 15) * XT_PITCH + 128 * wave + 16 * s + 8 * kh;
                const f32x4 a = *(const LAS f32x4*)xp, b = *(const LAS f32x4*)(xp + 4); bf16x8 ah, al; hilo8(a, b, ah, al);
                acc = __builtin_amdgcn_mfma_f32_32x32x16_bf16(ah, bh[s], acc, 0, 0, 0); acc = __builtin_amdgcn_mfma_f32_32x32x16_bf16(al, bh[s], acc, 0, 0, 0); acc = __builtin_amdgcn_mfma_f32_32x32x16_bf16(ah, bl[s], acc, 0, 0, 0); }
#pragma unroll
            for (int i = 0; i < 8; ++i) PL[(wave * 16 + (i & 3) + 8 * (i >> 2) + 4 * kh) * 32 + e] = acc[i];
            __syncthreads();
            { const int row = F.tid >> 5, ee = F.tid & 31; float sum = 0.f;
#pragma unroll
              for (int w = 0; w < 8; ++w) sum += PL[(w * 16 + row) * 32 + ee];
              LG[(step * 16 + row) * 33 + ee] = sum + __shfl(brt, ee); }
        }
        __syncthreads();
        LAS int* cntl = (LAS int*)(F.lds + RS_OFF); LAS int* basel = cntl + 32;
        if (F.tid < 32) cntl[F.tid] = 0;
        int my_e[4] = {0, 0, 0, 0}; float my_g[4] = {0.f, 0.f, 0.f, 0.f};
        if (F.tid < 256) { float lg[32];
#pragma unroll
            for (int k = 0; k < 32; ++k) lg[k] = LG[F.tid * 33 + k];
            float tv[4];
#pragma unroll
            for (int r = 0; r < 4; ++r) { float bv = lg[0]; int bi = 0;
#pragma unroll
                for (int k = 1; k < 32; ++k) if (lg[k] > bv) { bv = lg[k]; bi = k; }
                tv[r] = bv; my_e[r] = bi;
#pragma unroll
                for (int k = 0; k < 32; ++k) if (k == bi) lg[k] = -INFINITY; }
            const float e1 = __expf(tv[1] - tv[0]), e2 = __expf(tv[2] - tv[0]), e3 = __expf(tv[3] - tv[0]), rs = 1.f / (1.f + e1 + e2 + e3);
            my_g[0] = rs; my_g[1] = e1 * rs; my_g[2] = e2 * rs; my_g[3] = e3 * rs; }
        __syncthreads();
        int rk[4] = {0, 0, 0, 0};
        if (F.tid < 256) {
#pragma unroll
            for (int k = 0; k < 4; ++k) rk[k] = __hip_atomic_fetch_add(&cntl[my_e[k]], 1, __ATOMIC_RELAXED, __HIP_MEMORY_SCOPE_WORKGROUP); }
        __syncthreads();
        if (F.tid < 32) basel[F.tid] = (int)__hip_atomic_fetch_add(F.ctl + CW_CNT + (dry ? 32 : 0) + F.tid, (unsigned)cntl[F.tid], RLX_AGENT);
        __syncthreads();
        if (F.tid < 256) { const int row = chunk * 256 + F.tid; int* LIST = (int*)(ws + (dry ? 836 * MiB : WS_LIST)); float* GATEL = (float*)(ws + (dry ? 844 * MiB : WS_GATEL)); float* GATE = (float*)(ws + (dry ? 852 * MiB : WS_GATE));
#pragma unroll
            for (int k = 0; k < 4; ++k) { const size_t o = (size_t)my_e[k] * 65536 + (size_t)(basel[my_e[k]] + rk[k]); LIST[o] = row * 4 + k; GATEL[o] = my_g[k]; GATE[row * 4 + k] = my_g[k]; } }
        __syncthreads();
    }
}
__device__ __forceinline__ void ph10_final(Frame& F, const Ptrs& P, const bool dry) {
    float* dst = dry ? (float*)(P.ws + 356 * MiB) : P.out;
    const bf16* PLEB = (const bf16*)(P.ws + WS_PLE); const unsigned char* YS0 = P.ws + WS_YS; const unsigned char* YS1 = YS0 + YS_STRIDE; const unsigned char* YS2 = YS1 + YS_STRIDE; const unsigned char* YS3 = YS2 + YS_STRIDE;
    const int gw = F.vcu * NWAVES + F.wave, NGW = F.G * NWAVES, lane = F.lane;
    f32x4 gam[4], bet[4];
#pragma unroll
    for (int j = 0; j < 4; ++j) { gam[j] = *(const f32x4*)(P.ln2g + CI6(j)); bet[j] = *(const f32x4*)(P.ln2b + CI6(j)); }
    v4u pw[2], npw[2]; unsigned long long ys[2][4], nys[2][4];
#define PH10_LOAD(row_, PW, YS_) do { _Pragma("unroll") for (int jj = 0; jj < 2; ++jj) { const size_t o8 = (size_t)(row_) * 128 + lane + 64 * jj;     \
        PW[jj] = ((const v4u*)PLEB)[o8]; YS_[jj][0] = ((const unsigned long long*)YS0)[o8]; YS_[jj][1] = ((const unsigned long long*)YS1)[o8]; YS_[jj][2] = ((const unsigned long long*)YS2)[o8]; YS_[jj][3] = ((const unsigned long long*)YS3)[o8]; } } while (0)
    if (gw < M) PH10_LOAD(gw, pw, ys);
    for (int row = gw; row < M; row += NGW) {
        if (row + NGW < M) PH10_LOAD(row + NGW, npw, nys);
        f32x4 v[4]; float s = 0.f;
#pragma unroll
        for (int jj = 0; jj < 2; ++jj) { const unsigned long long ya = ys[jj][0], yb = ys[jj][1], yc = ys[jj][2], yd = ys[jj][3];
            pg8::unpack8(pw[jj], v[2 * jj], v[2 * jj + 1]);
#pragma unroll
            for (int h = 0; h < 2; ++h) { const unsigned a = (unsigned)(ya >> (32 * h)), b = (unsigned)(yb >> (32 * h)), c = (unsigned)(yc >> (32 * h)), d = (unsigned)(yd >> (32 * h)); constexpr float is = 1.f / YS_SCALE; const int j = 2 * jj + h;
              typedef float f32x2_ __attribute__((ext_vector_type(2)));
              const f32x2_ a0 = __builtin_amdgcn_cvt_pk_f32_fp8(a, false), a1 = __builtin_amdgcn_cvt_pk_f32_fp8(a, true), b0 = __builtin_amdgcn_cvt_pk_f32_fp8(b, false), b1 = __builtin_amdgcn_cvt_pk_f32_fp8(b, true);
              const f32x2_ c0 = __builtin_amdgcn_cvt_pk_f32_fp8(c, false), c1 = __builtin_amdgcn_cvt_pk_f32_fp8(c, true), d0 = __builtin_amdgcn_cvt_pk_f32_fp8(d, false), d1 = __builtin_amdgcn_cvt_pk_f32_fp8(d, true);
              v[j].x += ((a0[0] + b0[0]) + (c0[0] + d0[0])) * is; v[j].y += ((a0[1] + b0[1]) + (c0[1] + d0[1])) * is; v[j].z += ((a1[0] + b1[0]) + (c1[0] + d1[0])) * is; v[j].w += ((a1[1] + b1[1]) + (c1[1] + d1[1])) * is;
              s += (v[j].x + v[j].y) + (v[j].z + v[j].w); } }
        const float mean = wave_sum(s) * (1.f / 1024.f); float s2 = 0.f;
#pragma unroll
        for (int j = 0; j < 4; ++j) { v[j] = v[j] - mean; s2 += (v[j].x * v[j].x + v[j].y * v[j].y) + (v[j].z * v[j].z + v[j].w * v[j].w); }
        const float rstd = rsqrtf(wave_sum(s2) * (1.f / 1024.f) + LN_EPS);
#pragma unroll
        for (int j = 0; j < 4; ++j) *(f32x4*)(dst + (size_t)row * 1024 + CI6(j)) = v[j] * rstd * gam[j] + bet[j];
#pragma unroll
        for (int jj = 0; jj < 2; ++jj) { pw[jj] = npw[jj];
#pragma unroll
            for (int k = 0; k < 4; ++k) ys[jj][k] = nys[jj][k]; }
    }
#undef PH10_LOAD
}
__device__ __forceinline__ void moe_tables(Frame& F) {
    LAS int* cnt = (LAS int*)(F.lds + pg8::TAB_CNT); LAS int* blk0 = (LAS int*)(F.lds + pg8::TAB_BLK0); LAS int* row0 = (LAS int*)(F.lds + pg8::TAB_ROW0);
    __syncthreads();
    if (F.tid < 32) cnt[F.tid] = (int)__hip_atomic_load(F.ctl + CW_CNT + F.tid, RLX_AGENT);
    __syncthreads();
    if (F.tid == 0) { int b = 0, r = 0; for (int e = 0; e < 32; ++e) { blk0[e] = b; row0[e] = r; b += (cnt[e] + 255) >> 8; r += cnt[e]; } blk0[32] = b; row0[32] = r; }
    __syncthreads();
}

constexpr int NPHASE = 11;
struct Args { Ptrs P; int ph_lo, ph_hi; };
__global__ void __launch_bounds__(NWAVES * 64, 2) mk_fwd(Args args) {
    extern __shared__ __attribute__((aligned(16))) unsigned char lds[];
    Frame F; const Ptrs& P = args.P;
    F.lds = (LAS unsigned char*)lds; F.MISC = (volatile LAS unsigned*)(F.lds + MISC_OFF);
    F.wave = __builtin_amdgcn_readfirstlane(threadIdx.x >> 6); F.lane = lane_id(); F.tid = F.wave * 64 + F.lane;
#define REFRESH() do { F.lane = lane_id(); asm volatile("" : "+v"(F.lane)); F.tid = F.wave * 64 + F.lane; } while (0)
    F.G = gridDim.x; { const int bx = blockIdx.x; F.vcu = (F.G % 8 == 0) ? (bx % 8) * (F.G / 8) + bx / 8 : bx; }
    unsigned char* ws = P.ws; F.ctl = (gu32*)(ws + WS_CTL);
    for (int u = F.tid; u < 1024 / 4; u += NWAVES * 64) ((LAS unsigned*)(F.lds + LDSCTL_OFF))[u] = 0u;
    __syncthreads();
    const int lo = args.ph_lo, hi = args.ph_hi;
    XcdBarrier bar = xcd_barrier_post((unsigned*)(F.ctl + CW_BAR) + lo * XCD_BAR_WORDS, F.MISC + 8);
#define IN(k) (lo <= (k) && (k) < hi)
#define SEAM(k) do { if (IN(k) && IN((k) + 1)) xcd_barrier(bar); } while (0)
    bf16 *XB = (bf16*)P.out, *Q = (bf16*)(ws + WS_Q), *K = (bf16*)(ws + WS_K), *V = (bf16*)(ws + WS_V), *U = (bf16*)(ws + WS_U), *G = (bf16*)(ws + WS_G);
    bf16 *O16 = (bf16*)(ws + WS_O16), *APO = (bf16*)(ws + WS_APO), *MIX = (bf16*)(ws + WS_MIX), *X1B = (bf16*)(ws + WS_X1B), *HB = (bf16*)(ws + WS_HB), *PB = (bf16*)((unsigned char*)P.out + 128 * MiB);
    bf16* T = (bf16*)P.out;

    if (IN(0)) { REFRESH(); ph0_prologue(F, P); } SEAM(0);
    if (IN(1)) {
        const int flip = (PROJ_F8_FROM < 16) ? (((int)blockIdx.x >> 3) & 1) : 0;
        REFRESH(); { const f32x4 bgv = ((const f32x4*)P.b_gate)[F.tid]; ((LAS f32x4*)(F.lds + pg8::TAB_OFF))[F.tid] = bgv; } __syncthreads();
#pragma unroll 1
        for (int pass = 0; pass < 2; ++pass) {
            if ((pass ^ flip) == 0) { pg8::Gemm g{XB, (const bf16*)(ws + WS_WIN), 1024}; pg8::StaticOrder S; S.init(M, 256 * (PROJ_F8_FROM < 16 ? PROJ_F8_FROM : 16), F.G, (int)blockIdx.x);
              pg8::EpiProj E{Q, K, V, U, G, P.b_gate, (float*)(F.ctl + CW_PN), C2Q, 1.f, 0, 0};
              pg8::gemm_phase(F.lds, F.wave, g, S, E); }
            else if (PROJ_F8_FROM < 16) {
              pg8::Gemm g{(const bf16*)(ws + WS_XF8), (const bf16*)(ws + WS_WIN8), 512}; pg8::DenseF8Order S; S.init(M, 256 * (16 - PROJ_F8_FROM), F.G, (int)blockIdx.x);
              pg8::EpiProj E{Q, K, V, U, G, P.b_gate, (float*)(F.ctl + CW_PN), C2Q, 1.f / WUP_SCALE, PROJ_F8_FROM, 0};
              pg8::gemm_phase(F.lds, F.wave, g, S, E); }
        }
    } SEAM(1);
    if (IN(2)) {
        if (NCONV > 0 && (int)blockIdx.x < NCONV) {
            REFRESH(); conv_items(P, TI_EARLY, TI_TOTAL, (int)blockIdx.x * NWAVES + F.wave, NCONV * NWAVES, (LAS float*)(F.lds + RING_OFF + F.wave * 16384), F.lane); __syncthreads();
            REFRESH(); conv_p(F, P, (int)blockIdx.x, NCONV); }
        if (NPOOL > 0 && (int)blockIdx.x >= NCONV && (int)blockIdx.x < NCONV + NPOOL) { REFRESH(); ph_pool(F, P, (int)blockIdx.x - NCONV, NPOOL); }
        const attn_body::AttnTensors AT{(const attn_body::bf16*)Q, (const attn_body::bf16*)K, (const attn_body::bf16*)V, (attn_body::bf16*)O16, (const float*)(F.ctl + CW_PN), (unsigned*)(F.ctl + CW_AQ), lam_value(P), P.subln, ws + WS_APO};
        attn_body::attn_phase<-1>((char*)lds + RING_OFF, AT, F.wave);
        if (NPOOL == 0) { REFRESH(); ph_pool(F, P, (int)blockIdx.x, F.G); }
    }
    SEAM(3);
    if (IN(4)) {
        if (MIXG_FP8) { pg8::DenseF8Order S; S.init(M, 1024, F.G, (int)blockIdx.x);
            pg8::Gemm g{APO, (const bf16*)(ws + WS_WCAT), 512}; pg8::EpiMixCat E{MIX, G, 1.f / (APO_SCALE * WUP_SCALE), 0}; pg8::gemm_phase(F.lds, F.wave, g, S, E); }
        else { pg8::StaticOrder S; S.init(M, 1024, F.G, (int)blockIdx.x);
            pg8::Gemm g{APO, (const bf16*)(ws + WS_WCAT), 1024}; pg8::EpiMixCat E{MIX, G, 1.f, 0}; pg8::gemm_phase(F.lds, F.wave, g, S, E); }
    } SEAM(4);
    if (IN(5)) {
        pg8::Gemm g{MIX, (const bf16*)(ws + WS_WOUT), 1024}; pg8::StaticOrder S; S.init(M, 1024, F.G, (int)blockIdx.x);
        pg8::EpiPre1 E{(bf16*)(ws + WS_PRE1B), XB, ALPHA, 0};
        pg8::gemm_phase(F.lds, F.wave, g, S, E);
    } SEAM(5);
    if (IN(6)) { REFRESH(); ph6_ln1_route(F, P, false); } SEAM(6);
    if (IN(7)) {
        pg8::StaticOrder S; S.init(M, 1024, F.G, (int)blockIdx.x);
        { pg8::Gemm g{PB, (const bf16*)(ws + WS_WPP), 256}; pg8::EpiPle<1> E{T, nullptr, nullptr, nullptr, nullptr, nullptr, 1.f, 0.f}; pg8::gemm_phase(F.lds, F.wave, g, S, E); }
        VM_WAIT(); __syncthreads();
        if (MOE_FP8) { pg8::DenseF8Order S8; S8.init(M, 1024, F.G, (int)blockIdx.x);
            pg8::Gemm g{(const bf16*)(ws + WS_X1F8), (const bf16*)(ws + WS_WPG), 512}; pg8::EpiPle<3> E{(bf16*)(ws + WS_PLE), T, (const bf16*)(ws + WS_PRE1B), (const float*)(ws + WS_STAT), P.ln1g, P.ln1b, 1.f / WUP_SCALE, ALPHA}; pg8::gemm_phase(F.lds, F.wave, g, S8, E); }
        else { pg8::Gemm g{X1B, (const bf16*)(ws + WS_WPG), 1024}; pg8::EpiPle<3> E{(bf16*)(ws + WS_PLE), T, (const bf16*)(ws + WS_PRE1B), (const float*)(ws + WS_STAT), P.ln1g, P.ln1b, 1.f, ALPHA}; pg8::gemm_phase(F.lds, F.wave, g, S, E); }
    }
    if (IN(8)) {
        REFRESH(); moe_tables(F);
        pg8::Gemm g{MOE_FP8 ? (const bf16*)(ws + WS_X1F8) : X1B, (const bf16*)(ws + WS_WUP), MOE_FP8 ? 512 : 1024};
        pg8::MoeOrder<true, MOE_FP8> S{8, F.G, (int)blockIdx.x, (const int*)(ws + WS_LIST), (const float*)(ws + WS_GATEL), (size_t)2048 * 1024 * (MOE_FP8 ? 1 : 2), P.b_up};
        pg8::EpiUp<MOE_FP8> E{HB, P.b_up, MOE_FP8 ? 1.f / WUP_SCALE : 1.f, 0};
        pg8::gemm_phase(F.lds, F.wave, g, S, E);
    } SEAM(8);
    if (IN(9)) {
        REFRESH(); moe_tables(F);
        pg8::Gemm g{HB, (const bf16*)(ws + WS_WDN), MOE_FP8 ? 512 : 1024};
        pg8::MoeOrder<false, MOE_FP8> S{4, F.G, (int)blockIdx.x, (const int*)(ws + WS_LIST), (const float*)(ws + WS_GATEL), (size_t)1024 * 1024 * (MOE_FP8 ? 1 : 2), P.b_down};
        pg8::EpiDown E{ws + WS_YS, YS_STRIDE, P.b_down, MOE_FP8 ? 1.f / (WDN_SCALE) : 1.f, YS_SCALE};
        pg8::gemm_phase(F.lds, F.wave, g, S, E);
    } SEAM(9);
    if (IN(10)) { REFRESH(); ph10_final(F, P, false); }
#undef IN
#undef SEAM
}
extern "C" void kernel_launch(void* const* d_in, const int* in_sizes, int n_in, void* d_out, int out_size, void* d_ws, size_t ws_size, hipStream_t stream) {
    static int grid = 0;
    if (grid == 0) {
        if (n_in != 26 || in_sizes[0] != M * D || ws_size < WS_END || out_size != M * D) { fprintf(stderr, "kernel_launch: unexpected shapes (n_in %d, ws %zu, out %d); nothing launched\n", n_in, ws_size, out_size); grid = -1; return; }
        int dev = 0, cus = 0, per_cu = 0;
        if (hipGetDevice(&dev) != hipSuccess || hipDeviceGetAttribute(&cus, hipDeviceAttributeMultiprocessorCount, dev) != hipSuccess) { fprintf(stderr, "kernel_launch: device query failed; nothing launched\n"); grid = -1; return; }
        if (hipFuncSetAttribute((const void*)mk_fwd, hipFuncAttributeMaxDynamicSharedMemorySize, LDS_BYTES) != hipSuccess) { fprintf(stderr, "kernel_launch: hipFuncSetAttribute failed (%d bytes of dynamic LDS); nothing launched\n", LDS_BYTES); grid = -1; return; }
        if (hipOccupancyMaxActiveBlocksPerMultiprocessor(&per_cu, (const void*)mk_fwd, NWAVES * 64, LDS_BYTES) != hipSuccess || per_cu < 1) fprintf(stderr, "kernel_launch: note: occupancy query reports %d workgroups per CU\n", per_cu);
        (void)hipGetLastError();
        grid = cus;
    }
    if (grid < 0) return;
    if (hipMemsetAsync((char*)d_ws + WS_CTL, 0, CTL_ZERO_BYTES, stream) != hipSuccess) { fprintf(stderr, "kernel_launch: hipMemsetAsync failed; nothing launched\n"); return; }
    Args a{};
    { const float** pp = (const float**)&a.P; for (int i = 0; i < 26; ++i) pp[i] = (const float*)d_in[i]; }
    a.P.out = (float*)d_out; a.P.ws = (unsigned char*)d_ws; a.ph_lo = 0; a.ph_hi = NPHASE;
    hipLaunchKernelGGL(mk_fwd, dim3(grid), dim3(NWAVES * 64), LDS_BYTES, stream, a);
}
```

```cpp
#include <hip/hip_runtime.h>
#include <hip/hip_bf16.h>
#include <cstdio>
#include <cstdint>
#include <cmath>

#define GAS __attribute__((address_space(1)))
#define LAS __attribute__((address_space(3)))
typedef unsigned short bf16;
typedef unsigned v4u __attribute__((ext_vector_type(4)));
typedef float f32x4 __attribute__((ext_vector_type(4)));
typedef short bf16x8 __attribute__((ext_vector_type(8)));
typedef GAS unsigned gu32;
typedef GAS unsigned long long gu64;
#define RLX_AGENT __ATOMIC_RELAXED, __HIP_MEMORY_SCOPE_AGENT
#define LDS_WAIT() asm volatile("s_waitcnt lgkmcnt(0)" ::: "memory")
#define VM_WAIT() asm volatile("s_waitcnt vmcnt(0)" ::: "memory")
__device__ __forceinline__ unsigned f2bf(float f) { unsigned u = __builtin_bit_cast(unsigned, f); return (u + 0x7fffu + ((u >> 16) & 1u)) >> 16; }
__device__ __forceinline__ unsigned pk2(float lo, float hi) { return f2bf(lo) | (f2bf(hi) << 16); }

__device__ __forceinline__ int lane_id() { return (int)__builtin_amdgcn_mbcnt_hi(~0u, __builtin_amdgcn_mbcnt_lo(~0u, 0u)); }

constexpr int BATCH = 16, SEQ = 4096, D = 1024, M = BATCH * SEQ;
constexpr int NEXP = 32, TOPK = 4, NASSIGN = M * TOPK, FF = 1024, PLE = 256;
constexpr float LN_EPS = 1e-5f;
constexpr float ALPHA = 1.189207115002721f;
constexpr float C2Q = 0.125f * 1.4426950408889634f;

constexpr size_t MiB = 1u << 20;
constexpr size_t WS_CTL = 0, CTL_ZERO_BYTES = 1 * MiB;
constexpr size_t WS_LIST = 1 * MiB;
constexpr size_t WS_GATEL = 9 * MiB;
constexpr size_t WS_GATE = 17 * MiB;
constexpr size_t WS_WPCF = 18 * MiB;
constexpr size_t WS_WIN = 20 * MiB, WS_WCAT = 28 * MiB, WS_WOUT = 30 * MiB, WS_WPG = 32 * MiB, WS_WPP = 34 * MiB;
constexpr size_t WS_WDN = 36 * MiB, WS_WUP = 100 * MiB;
constexpr size_t WS_APO = 228 * MiB;
constexpr size_t WS_X1B = 228 * MiB;
constexpr size_t WS_Q = 356 * MiB, WS_K = 420 * MiB, WS_V = 484 * MiB, WS_U = 548 * MiB;
constexpr size_t WS_G = 612 * MiB;
constexpr size_t WS_O16 = 868 * MiB;
constexpr size_t WS_MIX = 356 * MiB;
constexpr size_t WS_HB = 356 * MiB;
constexpr size_t WS_YS = 100 * MiB, YS_STRIDE = 64 * MiB;
constexpr size_t WS_PRE1B = 612 * MiB;
constexpr size_t WS_STAT = 18 * MiB;
constexpr size_t WS_X1F8 = 900 * MiB;
constexpr size_t WS_PLE = 740 * MiB;
constexpr size_t WS_END = 1024 * MiB;
#ifndef MOE_FP8
#define MOE_FP8 1
#endif
constexpr float WUP_SCALE = 32.f, WDN_SCALE = 64.f;
#ifndef PROJ_F8_FROM
#define PROJ_F8_FROM 8
#endif
constexpr size_t WS_XF8 = 900 * MiB;
constexpr size_t WS_WIN8 = WS_WIN + (size_t)PROJ_F8_FROM * 256 * 1024 * 2;
#ifndef MIXG_FP8
#define MIXG_FP8 1
#endif
constexpr float APO_SCALE = 16.f;
constexpr float YS_SCALE = 16.f;
constexpr int cv_NBG = 790 + 64 + M / 256;
constexpr float ATT_SKIP = 40.f;
constexpr int CW_TMO = 0, CW_CODE = 1;
constexpr int CW_CNT = 64;
constexpr int CW_AQ = 128;
constexpr int CW_PN = 65536;
constexpr int CW_BAR = 4096;
namespace pg8 {
#define PG8_LAS __attribute__((address_space(3)))
typedef unsigned short bf16_t;
typedef unsigned u32x4 __attribute__((ext_vector_type(4)));
typedef float f32x2 __attribute__((ext_vector_type(2)));
constexpr int BM = 256, BK = 64, HALF = 128, HTB = HALF * BK * 2  , STAGE_BYTES = 8 * HTB, NXCD = 8, WGM = 8;
constexpr int TAB_OFF = 131072 + 1024;
constexpr int TAB_CNT = TAB_OFF, TAB_BLK0 = TAB_OFF + 128, TAB_ROW0 = TAB_OFF + 384, TAB_IDS = TAB_OFF + 1024, TAB_GATES = TAB_OFF + 1024 + 2048, TAB_BIAS = TAB_OFF + 1024 + 4096;

__host__ __device__ __forceinline__ int lds_byte(int r, int c) { const int st = (r >> 4) * 2 + (c >> 5), rr = r & 15, cc = c & 31, ob = rr * 64 + cc * 2; return st * 1024 + (ob ^ (((ob >> 9) & 1) << 5)); }
__host__ __device__ __forceinline__ void stage_rc(int b, int& R, int& C) { const int st = b / 1024, sb = b % 1024, swz = sb ^ (((sb >> 9) & 1) << 5); R = (st >> 1) * 16 + swz / 64; C = (st & 1) * 32 + (swz % 64) / 2; }
__host__ __device__ __forceinline__ int perm16h(int rho) { return 64 * (rho >> 5) + 16 * ((rho & 15) >> 2) + 4 * ((rho >> 4) & 1) + (rho & 3); }
__host__ __device__ __forceinline__ int perm32(int rho) { const int n = rho >> 4, i = rho & 15; return 8 * (i >> 2) + 4 * n + (i & 3); }

struct Unit { int pm, pn, e, nvalid; };
struct Gemm { const bf16_t* A; const bf16_t* Bt; int K; };

struct StaticOrder {
    static constexpr bool TABLES = false, FP8 = false;
    int nM, nN, nwg, G, c;
    __host__ __device__ void init(int M, int N, int G_, int c_) { nM = M / BM; nN = N / BM; nwg = nM * nN; G = G_; c = c_; }
    __device__ __forceinline__ bool next(int i, Unit& u, PG8_LAS unsigned char*) const {
        const long L = (long)i * G + c; if (L >= nwg) return false;
        int wgid = (int)L; { const int q = nwg / NXCD, r = nwg % NXCD, xcd = wgid % NXCD, off = wgid / NXCD; wgid = (xcd < r ? xcd * (q + 1) : r * (q + 1) + (xcd - r) * q) + off; }
        const int nig = WGM * nN, gid = wgid / nig, fm = gid * WGM, gsz = (nM - fm) < WGM ? (nM - fm) : WGM;
        u.pm = fm + ((wgid % nig) % gsz); u.pn = (wgid % nig) / gsz; u.e = 0; u.nvalid = 256; return true;
    }
    __device__ __forceinline__ const char* b_tile(const Gemm& g, const Unit& u) const { return (const char*)g.Bt + (size_t)u.pn * (size_t)(BM * 2) * g.K; }
    __device__ __forceinline__ void a_offsets(const Gemm& g, const Unit& u, PG8_LAS unsigned char*, int, const int (&R)[2], const int (&C)[2], unsigned (&off)[2][2]) const {
#pragma unroll
        for (int h = 0; h < 2; ++h)
#pragma unroll
            for (int i = 0; i < 2; ++i) off[h][i] = (unsigned)(((u.pm * BM + h * HALF + R[i]) * g.K + C[i]) * 2);
    }
    __device__ __forceinline__ void issue_tables(const Unit&, PG8_LAS unsigned char*, int, int) const {}
};

struct DenseF8Order : StaticOrder { static constexpr bool FP8 = true; };

template <bool GATHER_, bool FP8_> struct MoeOrder {
    static constexpr bool TABLES = true; static constexpr bool GATHER = GATHER_, FP8 = FP8_;
    int NT, G, c; const int* LIST; const float* GATEL; size_t bstride; const float* bias;
    __device__ __forceinline__ bool next(int i, Unit& u, PG8_LAS unsigned char* lds) const {
        const PG8_LAS int* cnt = (const PG8_LAS int*)(lds + TAB_CNT); const PG8_LAS int* blk0 = (const PG8_LAS int*)(lds + TAB_BLK0);
        int cp = c; if (G == 256) cp = NT == 8 ? (((c & 7) + 8 * (c >> 6)) * 8 + ((c >> 3) & 7)) : (((c & 7) + 8 * (c >> 5)) * 4 + ((c >> 3) & 3));
        const int L = i * G + cp; const int total = blk0[32] * NT; if (L >= total) return false;
        const int blk = L / NT;
        const int ln = (int)__builtin_amdgcn_mbcnt_hi(~0u, __builtin_amdgcn_mbcnt_lo(~0u, 0u)); const int bv = blk0[ln & 31];
        const int e = __builtin_popcountll(__builtin_amdgcn_ballot_w64(ln >= 1 && ln < 32 && blk >= bv));
        u.e = e; u.pm = __builtin_amdgcn_readfirstlane(blk - blk0[e]); u.pn = L % NT; const int left = __builtin_amdgcn_readfirstlane(cnt[e]) - 256 * u.pm; u.nvalid = left < 256 ? left : 256; return true;
    }
    __device__ __forceinline__ const char* b_tile(const Gemm& g, const Unit& u) const { return (const char*)g.Bt + (size_t)u.e * bstride + (size_t)u.pn * (size_t)(BM * 2) * g.K; }
    __device__ __forceinline__ void a_offsets(const Gemm& g, const Unit& u, PG8_LAS unsigned char* lds, int buf, const int (&R)[2], const int (&C)[2], unsigned (&off)[2][2]) const {
        const PG8_LAS int* ids = (const PG8_LAS int*)(lds + TAB_IDS) + buf * 256; const PG8_LAS int* row0 = (const PG8_LAS int*)(lds + TAB_ROW0);
#pragma unroll
        for (int h = 0; h < 2; ++h)
#pragma unroll
            for (int i = 0; i < 2; ++i) { const int r = h * HALF + R[i];
                if (GATHER) { const int tok = (r < u.nvalid) ? (ids[r] >> 2) : 0; off[h][i] = (unsigned)((tok * g.K + C[i]) * 2); }
                else off[h][i] = (unsigned)(((row0[u.e] + u.pm * BM + r) * g.K + C[i]) * 2); }
    }
    __device__ __forceinline__ void issue_tables(const Unit& u, PG8_LAS unsigned char* lds, int buf, int lane) const {
        const size_t o = (size_t)u.e * 65536 + (size_t)u.pm * 256 + lane * 4;
        __builtin_amdgcn_global_load_lds((const unsigned*)(LIST + o), (PG8_LAS unsigned*)(lds + TAB_IDS + buf * 1024), 16, 0, 0);
        if (!GATHER) __builtin_amdgcn_global_load_lds((const unsigned*)(GATEL + o), (PG8_LAS unsigned*)(lds + TAB_GATES + buf * 1024), 16, 0, 0);
        const float* bsrc = GATHER ? bias + (size_t)u.e * 2048 + (lane >> 5) * 1024 + u.pn * 128 + (lane & 31) * 4 : bias + (size_t)u.e * 1024 + u.pn * 256 + lane * 4;
        __builtin_amdgcn_global_load_lds((const unsigned*)bsrc, (PG8_LAS unsigned*)(lds + TAB_BIAS + buf * 1024), 16, 0, 0);
    }
};

__device__ __forceinline__ unsigned cvt_pk_bf16(float lo, float hi) { unsigned r; asm volatile("v_cvt_pk_bf16_f32 %0, %1, %2" : "=v"(r) : "v"(lo), "v"(hi)); return r; }
__device__ __forceinline__ float bflo(unsigned w) { return __builtin_bit_cast(float, w << 16); }
__device__ __forceinline__ float bfhi(unsigned w) { return __builtin_bit_cast(float, w & 0xffff0000u); }
__device__ __forceinline__ float sigm(float v) { return __builtin_amdgcn_rcpf(1.f + __builtin_amdgcn_exp2f(-1.4426950408889634f * v)); }
__device__ __forceinline__ u32x4 pack8(const f32x4& v0, const f32x4& v1) { u32x4 w; w.x = cvt_pk_bf16(v0[0], v0[1]); w.y = cvt_pk_bf16(v0[2], v0[3]); w.z = cvt_pk_bf16(v1[0], v1[1]); w.w = cvt_pk_bf16(v1[2], v1[3]); return w; }
__device__ __forceinline__ void unpack8(const u32x4& w, f32x4& v0, f32x4& v1) { v0 = (f32x4){bflo(w.x), bfhi(w.x), bflo(w.y), bfhi(w.y)}; v1 = (f32x4){bflo(w.z), bfhi(w.z), bflo(w.w), bfhi(w.w)}; }
typedef f32x4 Acc[2][2][4][2];
typedef int i32x4 __attribute__((ext_vector_type(4)));
typedef int i32x8 __attribute__((ext_vector_type(8)));
struct bf16x8p { bf16x8 k[2]; };
template <bool F8> struct Frag { typedef bf16x8p T; };
template <> struct Frag<true> { typedef i32x8 T; };
__device__ __forceinline__ void frag_set(i32x8& d, const i32x4& lo, const i32x4& hi) { d = __builtin_shufflevector(lo, hi, 0, 1, 2, 3, 4, 5, 6, 7); }
__device__ __forceinline__ void frag_set(bf16x8p& d, const bf16x8& lo, const bf16x8& hi) { d.k[0] = lo; d.k[1] = hi; }
__device__ __forceinline__ void frag_mma(f32x4& c, const i32x8& b, const i32x8& a) { c = __builtin_amdgcn_mfma_scale_f32_16x16x128_f8f6f4(b, a, c, 0, 0, 0, 0, 0, 0); }
__device__ __forceinline__ void frag_mma(f32x4& c, const bf16x8p& b, const bf16x8p& a) { c = __builtin_amdgcn_mfma_f32_16x16x32_bf16(b.k[0], a.k[0], c, 0, 0, 0); c = __builtin_amdgcn_mfma_f32_16x16x32_bf16(b.k[1], a.k[1], c, 0, 0, 0); }
__device__ __forceinline__ unsigned pk4_fp8(float a, float b, float c, float d) { unsigned w = __builtin_amdgcn_cvt_pk_fp8_f32(a, b, 0u, false); return __builtin_amdgcn_cvt_pk_fp8_f32(c, d, w, true); }
template <class E> struct has_p16 { template <class T> static constexpr bool f(decltype(T::PERM16)*) { return T::PERM16; } template <class T> static constexpr bool f(...) { return false; } static constexpr bool value = f<E>(nullptr); };
template <class E> struct has_mid { template <class T> static constexpr bool f(decltype(T::MID)*) { return T::MID; } template <class T> static constexpr bool f(...) { return false; } static constexpr bool value = f<E>(nullptr); };

struct EpiProj {
    static constexpr bool PERM = true; static constexpr int NSTORES = 16;
    bf16_t *Q, *K, *V, *U, *G; const float* bg; float* PN; float c2; float dsc; int pn_base; int pad;
    __device__ __forceinline__ void operator()(const Acc& acc, const Unit& u, int wr, int wc, int fr_, int fq_, PG8_LAS unsigned char* lds, int) const {
        int fr = fr_, fq = fq_; asm volatile("" : "+v"(fr), "+v"(fq));
        const int pn = u.pn + pn_base; const int row0 = u.pm * BM + wr * 64 + fr; const bool isg = pn >= 8;
        bf16_t* base; int ldc, colt, bjs; float sc = dsc;
        if (isg) { base = G; ldc = 2048; colt = (pn - 8) * HALF; bjs = 1024; } else { const int t = pn >> 1; base = t == 0 ? Q : t == 1 ? K : t == 2 ? V : U; ldc = 512; colt = (pn & 1) * BM; bjs = HALF; if (t == 0) sc = c2 * dsc; }
        const int col0 = colt + wc * 32 + 8 * fq;
        f32x4 bv[2][2];
#pragma unroll
        for (int bj = 0; bj < 2; ++bj)
#pragma unroll
            for (int n = 0; n < 2; ++n) bv[bj][n] = isg ? *(const PG8_LAS f32x4*)((const PG8_LAS float*)(lds + TAB_OFF) + col0 + bj * bjs + 4 * n) : (f32x4){0.f, 0.f, 0.f, 0.f};
#pragma unroll
        for (int ai = 0; ai < 2; ++ai)
#pragma unroll
            for (int m = 0; m < 4; ++m) { bf16_t* rowp = base + (size_t)(row0 + ai * HALF + m * 16) * ldc + col0;
                f32x4 v[2][2];
#pragma unroll
                for (int bj = 0; bj < 2; ++bj)
#pragma unroll
                    for (int n = 0; n < 2; ++n) v[bj][n] = acc[ai][bj][m][n] * sc + bv[bj][n];
                if (isg) {
#pragma unroll
                    for (int n = 0; n < 2; ++n)
#pragma unroll
                        for (int i = 0; i < 4; ++i) { const float ga = sigm(v[0][n][i]), gp = sigm(v[1][n][i]); v[0][n][i] = ga * __builtin_amdgcn_rcpf(fmaxf(gp, 8.67e-19f)); v[1][n][i] = gp; } }
#pragma unroll
                for (int bj = 0; bj < 2; ++bj) *(u32x4*)(rowp + bj * bjs) = pack8(v[bj][0], v[bj][1]); }
        if (pn < 4) {
            float* tab = PN + (pn >> 1) * 16384; const int R0 = u.pm * BM, b = R0 >> 12;
#pragma unroll
            for (int ai = 0; ai < 2; ++ai)
#pragma unroll
                for (int bj = 0; bj < 2; ++bj) { float mx = 0.f;
#pragma unroll
                    for (int m = 0; m < 4; ++m) { f32x4 v0 = acc[ai][bj][m][0] * sc, v1 = acc[ai][bj][m][1] * sc;
                        float s = (v0[0] * v0[0] + v0[1] * v0[1]) + (v0[2] * v0[2] + v0[3] * v0[3]) + (v1[0] * v1[0] + v1[1] * v1[1]) + (v1[2] * v1[2] + v1[3] * v1[3]);
                        s += __shfl_xor(s, 16); s += __shfl_xor(s, 32); mx = fmaxf(mx, s); }
                    mx = fmaxf(mx, __shfl_xor(mx, 1)); mx = fmaxf(mx, __shfl_xor(mx, 2)); mx = fmaxf(mx, __shfl_xor(mx, 4)); mx = fmaxf(mx, __shfl_xor(mx, 8));
                    const int tile = ((R0 & 4095) >> 6) + 2 * ai + wr, hm = (pn & 1) * 4 + 2 * bj + (wc >> 1);
                    if (fr == 0 && fq == 0) tab[((b * 8 + hm) * 64 + tile) * 2 + (wc & 1)] = mx; }
        }
    }
};
struct EpiMixCat {
    static constexpr bool PERM = true, MID = true; static constexpr int NSTORES = 16;
    bf16_t* MIX; const bf16_t* G; float dsc; int pad;
    __device__ __forceinline__ void mid(Acc& acc, const Unit& u, int wr, int wc, int fr_, int fq_) const {
        int fr = fr_, fq = fq_; asm volatile("" : "+v"(fr), "+v"(fq));
        const int row0 = u.pm * BM + wr * 64 + fr, col0 = u.pn * BM + wc * 32 + 8 * fq;
        u32x4 w[16];
#pragma unroll
        for (int k = 0; k < 16; ++k) w[k] = *(const u32x4*)(G + (size_t)(row0 + (k >> 3) * HALF + ((k >> 1) & 3) * 16) * 2048 + col0 + (k & 1) * HALF);
        asm volatile("" : "+v"(w[0]), "+v"(w[1]), "+v"(w[2]), "+v"(w[3]), "+v"(w[4]), "+v"(w[5]), "+v"(w[6]), "+v"(w[7]), "+v"(w[8]), "+v"(w[9]), "+v"(w[10]), "+v"(w[11]), "+v"(w[12]), "+v"(w[13]), "+v"(w[14]), "+v"(w[15]));
#pragma unroll
        for (int k = 0; k < 16; ++k) { const int ai = k >> 3, m = (k >> 1) & 3, bj = k & 1; f32x4 a0, a1; unpack8(w[k], a0, a1); acc[ai][bj][m][0] *= a0; acc[ai][bj][m][1] *= a1; }
        asm volatile("" ::: "memory");
    }
    __device__ __forceinline__ void operator()(const Acc& acc, const Unit& u, int wr, int wc, int fr_, int fq_, PG8_LAS unsigned char*, int) const {
        int fr = fr_, fq = fq_; asm volatile("" : "+v"(fr), "+v"(fq));
        const int row0 = u.pm * BM + wr * 64 + fr, col0 = u.pn * BM + wc * 32 + 8 * fq;
        u32x4 w[16];
#pragma unroll
        for (int k = 0; k < 16; ++k) w[k] = *(const u32x4*)(G + (size_t)(row0 + (k >> 3) * HALF + ((k >> 1) & 3) * 16) * 2048 + 1024 + col0 + (k & 1) * HALF);
        asm volatile("" : "+v"(w[0]), "+v"(w[1]), "+v"(w[2]), "+v"(w[3]), "+v"(w[4]), "+v"(w[5]), "+v"(w[6]), "+v"(w[7]), "+v"(w[8]), "+v"(w[9]), "+v"(w[10]), "+v"(w[11]), "+v"(w[12]), "+v"(w[13]), "+v"(w[14]), "+v"(w[15]));
#pragma unroll
        for (int k = 0; k < 16; ++k) { const int ai = k >> 3, m = (k >> 1) & 3, bj = k & 1; f32x4 p0, p1; unpack8(w[k], p0, p1);
#pragma unroll
            for (int i = 0; i < 4; ++i) { p0[i] = fmaxf(p0[i], 8.67e-19f) * dsc; p1[i] = fmaxf(p1[i], 8.67e-19f) * dsc; }
            *(u32x4*)(MIX + (size_t)(row0 + ai * HALF + m * 16) * 1024 + col0 + bj * HALF) = pack8(acc[ai][bj][m][0] * p0, acc[ai][bj][m][1] * p1); }
        asm volatile("" ::: "memory");
    }
};
struct EpiPre1 {
    static constexpr bool PERM = true; static constexpr int NSTORES = 16;
    bf16_t* out; const bf16_t* x; float alpha; int pad;
    __device__ __forceinline__ void operator()(const Acc& acc, const Unit& u, int wr, int wc, int fr_, int fq_, PG8_LAS unsigned char*, int) const {
        int fr = fr_, fq = fq_; asm volatile("" : "+v"(fr), "+v"(fq));
        const int row0 = u.pm * BM + wr * 64 + fr, col0 = u.pn * BM + wc * 32 + 8 * fq;
        u32x4 w[16];
#pragma unroll
        for (int k = 0; k < 16; ++k) w[k] = *(const u32x4*)(x + (size_t)(row0 + (k >> 3) * HALF + ((k >> 1) & 3) * 16) * 1024 + col0 + (k & 1) * HALF);
        asm volatile("" : "+v"(w[0]), "+v"(w[1]), "+v"(w[2]), "+v"(w[3]), "+v"(w[4]), "+v"(w[5]), "+v"(w[6]), "+v"(w[7]), "+v"(w[8]), "+v"(w[9]), "+v"(w[10]), "+v"(w[11]), "+v"(w[12]), "+v"(w[13]), "+v"(w[14]), "+v"(w[15]));
#pragma unroll
        for (int k = 0; k < 16; ++k) { const int ai = k >> 3, m = (k >> 1) & 3, bj = k & 1; f32x4 x0, x1; unpack8(w[k], x0, x1);
            *(u32x4*)(out + (size_t)(row0 + ai * HALF + m * 16) * 1024 + col0 + bj * HALF) = pack8(x0 * alpha + acc[ai][bj][m][0], x1 * alpha + acc[ai][bj][m][1]); }
        asm volatile("" ::: "memory");
    }
};
template <int MODE> struct EpiPle {
    static constexpr bool PERM = true; static constexpr int NSTORES = 16;
    bf16_t* out; const bf16_t* T; const bf16_t* PRE; const float* stat; const float* lng; const float* lnb; float dsc; float alpha;
    __device__ __forceinline__ void operator()(const Acc& acc, const Unit& u, int wr, int wc, int fr_, int fq_, PG8_LAS unsigned char*, int) const {
        int fr = fr_, fq = fq_; asm volatile("" : "+v"(fr), "+v"(fq));
        const int row0 = u.pm * BM + wr * 64 + fr, col0 = u.pn * BM + wc * 32 + 8 * fq;
        f32x4 ag[2][2], ab[2][2];
        if (MODE == 3) {
#pragma unroll
            for (int bj = 0; bj < 2; ++bj)
#pragma unroll
                for (int h = 0; h < 2; ++h) { ag[bj][h] = *(const f32x4*)(lng + col0 + bj * HALF + 4 * h) * alpha; ab[bj][h] = *(const f32x4*)(lnb + col0 + bj * HALF + 4 * h) * alpha; } }
#pragma unroll
        for (int ai = 0; ai < 2; ++ai)
#pragma unroll
            for (int mp = 0; mp < 2; ++mp) { u32x4 w[8]; f32x2 st[2];
                if (MODE == 3) {
#pragma unroll
                    for (int k = 0; k < 4; ++k) { const size_t o = (size_t)(row0 + ai * HALF + (2 * mp + (k >> 1)) * 16) * 1024 + col0 + (k & 1) * HALF; w[2 * k] = *(const u32x4*)(T + o); w[2 * k + 1] = *(const u32x4*)(PRE + o); }
#pragma unroll
                    for (int q = 0; q < 2; ++q) st[q] = *(const f32x2*)(stat + 2 * (size_t)(row0 + ai * HALF + (2 * mp + q) * 16));
                    asm volatile("" : "+v"(w[0]), "+v"(w[1]), "+v"(w[2]), "+v"(w[3]), "+v"(w[4]), "+v"(w[5]), "+v"(w[6]), "+v"(w[7]), "+v"(st[0]), "+v"(st[1]));
                }
#pragma unroll
                for (int k = 0; k < 4; ++k) { const int m = 2 * mp + (k >> 1), bj = k & 1; const size_t o = (size_t)(row0 + ai * HALF + m * 16) * 1024 + col0 + bj * HALF; f32x4 v0 = acc[ai][bj][m][0], v1 = acc[ai][bj][m][1];
                    if (MODE == 3) { f32x4 t0, t1, x0, x1; unpack8(w[2 * k], t0, t1); unpack8(w[2 * k + 1], x0, x1); const float s = st[k >> 1][1], ms = -st[k >> 1][0] * s;
#pragma unroll
                        for (int i = 0; i < 4; ++i) { v0[i] = sigm(v0[i] * dsc) * t0[i] + ((x0[i] * s + ms) * ag[bj][0][i] + ab[bj][0][i]); v1[i] = sigm(v1[i] * dsc) * t1[i] + ((x1[i] * s + ms) * ag[bj][1][i] + ab[bj][1][i]); } }
                    *(u32x4*)(out + o) = pack8(v0, v1); }
                if (MODE == 3) asm volatile("" ::: "memory"); }
    }
};
template <bool F8> struct EpiUp {
    static constexpr bool PERM = true; static constexpr int NSTORES = F8 ? 4 : 8;
    void* HB; const float* bup; float dsc; int pad;
    __device__ __forceinline__ void operator()(const Acc& acc, const Unit& u, int wr, int wc, int fr_, int fq_, PG8_LAS unsigned char* lds, int buf) const {
        int fr = fr_, fq = fq_; asm volatile("" : "+v"(fr), "+v"(fq));
        const PG8_LAS int* row0t = (const PG8_LAS int*)(lds + TAB_ROW0); const int srow = row0t[u.e] + u.pm * BM;
        const int c0 = u.pn * HALF + wc * 32 + 8 * fq; const PG8_LAS float* bp = (const PG8_LAS float*)(lds + TAB_BIAS + buf * 1024) + wc * 32 + 8 * fq;
        const f32x4 bg0 = *(const PG8_LAS f32x4*)(bp), bg1 = *(const PG8_LAS f32x4*)(bp + 4), bl0 = *(const PG8_LAS f32x4*)(bp + 128) + 1.f, bl1 = *(const PG8_LAS f32x4*)(bp + 132) + 1.f;
#pragma unroll
        for (int ai = 0; ai < 2; ++ai)
#pragma unroll
            for (int mp = 0; mp < 2; ++mp) { unsigned xw[2][2];
#pragma unroll
                for (int mm = 0; mm < 2; ++mm) { const int m = 2 * mp + mm, r = ai * HALF + wr * 64 + m * 16 + fr;
                    f32x4 g0 = acc[ai][0][m][0] * dsc + bg0, g1 = acc[ai][0][m][1] * dsc + bg1, l0 = acc[ai][1][m][0] * dsc + bl0, l1 = acc[ai][1][m][1] * dsc + bl1;
#pragma unroll
                    for (int h = 0; h < 4; ++h) { constexpr float CS = -1.702f * 1.4426950408889634f;
                        f32x4& gg = (h < 2) ? g0 : g1; const f32x4& ll = (h < 2) ? l0 : l1; const int i = 2 * (h & 1);
                        const f32x2 a = {fminf(gg[i], 7.f), fminf(gg[i + 1], 7.f)}, b = {fminf(fmaxf(ll[i], -6.f), 8.f), fminf(fmaxf(ll[i + 1], -6.f), 8.f)};
                        const f32x2 t = a * CS; const f32x2 e = {__builtin_amdgcn_exp2f(t[0]), __builtin_amdgcn_exp2f(t[1])}; const f32x2 d = e + 1.f;
                        const f32x2 rc = {__builtin_amdgcn_rcpf(d[0]), __builtin_amdgcn_rcpf(d[1])}; const f32x2 y = (a * rc) * b; gg[i] = y[0]; gg[i + 1] = y[1]; }
                    if (F8) { xw[mm][0] = pk4_fp8(g0[0], g0[1], g0[2], g0[3]); xw[mm][1] = pk4_fp8(g1[0], g1[1], g1[2], g1[3]); }
                    else if (r < u.nvalid) *(u32x4*)((bf16_t*)HB + (size_t)(srow + r) * 1024 + c0) = pack8(g0, g1); }
                if (F8) {
                    const auto s0 = __builtin_amdgcn_permlane16_swap(xw[0][0], xw[1][0], false, false), s1 = __builtin_amdgcn_permlane16_swap(xw[0][1], xw[1][1], false, false);
                    const int r = ai * HALF + wr * 64 + (2 * mp + (fq & 1)) * 16 + fr;
                    if (r < u.nvalid) { u32x4 w; w.x = s0[0]; w.y = s1[0]; w.z = s0[1]; w.w = s1[1]; *(u32x4*)((unsigned char*)HB + (size_t)(srow + r) * 1024 + (c0 & ~15)) = w; } } }
    }
};
struct EpiDown {
    static constexpr bool PERM = true, PERM16 = true; static constexpr int NSTORES = 8;
    unsigned char* YS; size_t rstride; const float* bdn; float dsc; float osc;
    __device__ __forceinline__ void operator()(const Acc& acc, const Unit& u, int wr, int wc, int fr_, int fq_, PG8_LAS unsigned char* lds, int buf) const {
        int fr = fr_, fq = fq_; asm volatile("" : "+v"(fr), "+v"(fq));
        const PG8_LAS int* ids = (const PG8_LAS int*)(lds + TAB_IDS) + buf * 256; const PG8_LAS float* gates = (const PG8_LAS float*)(lds + TAB_GATES) + buf * 256;
        const int col0 = u.pn * BM + wc * 64 + 16 * fq; const PG8_LAS float* bp = (const PG8_LAS float*)(lds + TAB_BIAS + buf * 1024) + wc * 64 + 16 * fq;
        f32x4 bv[2][2];
#pragma unroll
        for (int bj = 0; bj < 2; ++bj)
#pragma unroll
            for (int n = 0; n < 2; ++n) bv[bj][n] = *(const PG8_LAS f32x4*)(bp + 8 * bj + 4 * n);
#pragma unroll
        for (int ai = 0; ai < 2; ++ai)
#pragma unroll
            for (int m = 0; m < 4; ++m) { const int r = ai * HALF + wr * 64 + m * 16 + fr;
                if (r < u.nvalid) { const int a = ids[r]; const float gs = gates[r] * osc; const size_t o = (size_t)(a & 3) * rstride + (size_t)(a >> 2) * 1024 + col0;
                    u32x4 w; unsigned* wp = (unsigned*)&w;
#pragma unroll
                    for (int bj = 0; bj < 2; ++bj)
#pragma unroll
                        for (int n = 0; n < 2; ++n) { const f32x4 v = (acc[ai][bj][m][n] * dsc + bv[bj][n]) * gs; wp[2 * bj + n] = pk4_fp8(v[0], v[1], v[2], v[3]); }
                    *(u32x4*)(YS + o) = w; } }
    }
};

template <class Epi, class Sched>
__device__ __forceinline__ void gemm_phase(PG8_LAS unsigned char* lds, const int wid, const Gemm g, const Sched& S, const Epi& E) {
    int lane = lane_id(); asm volatile("" : "+v"(lane));
    const int tid = wid * 64 + lane, wr = wid >> 2, wc = wid & 3, fr = lane & 15, fq = lane >> 4;
    const int K = g.K, nt = K / BK;
    int RA[2], CA[2]; unsigned voffA[2], voffB[2];
#pragma unroll
    for (int i = 0; i < 2; ++i) { int R, C; stage_rc(tid * 16 + i * 8192, R, C); const int Rb = has_p16<Epi>::value ? perm16h(R) : Epi::PERM ? ((R & ~31) + perm32(R & 31)) : R; RA[i] = R; CA[i] = C; voffA[i] = (unsigned)(R * K + C) * 2u; voffB[i] = (unsigned)(Rb * K + C) * 2u; }
    const size_t tstep = (size_t)BM * K * 2;
    const size_t kstep = (size_t)(BK * 2);
    const size_t hstep = (size_t)HALF * K * 2;
    const size_t bstep = has_p16<Epi>::value ? (size_t)8 * K * 2 : hstep;
    const unsigned ldsw = (unsigned)wid * 1024u;
    const int aoff = lds_byte(wr * 64 + fr, fq * 8), boff = lds_byte(wc * 32 + fr, fq * 8);
#define PG8_SA(b, h) (((b) * 2 + (h)) * HTB)
#define PG8_SB(b, h) ((4 + (b) * 2 + (h)) * HTB)
#define PG8_STAGE(bufoff, gbase, voff) do { _Pragma("unroll") for (int _i = 0; _i < 2; ++_i) \
        __builtin_amdgcn_global_load_lds((const unsigned*)((const char*)(gbase) + (voff)[_i]), (PG8_LAS unsigned*)(lds + (bufoff) + ldsw + _i * 8192), 16, 0, 0); } while (0)
#define PG8_STAGE_A(bufoff, ubase, h, OFF) do { if constexpr (Sched::TABLES) PG8_STAGE(bufoff, ubase, OFF[h]); else PG8_STAGE(bufoff, (ubase) + ((h) ? hstep : 0), voffA); } while (0)
#define PG8_LDA(dst, b, h) do { _Pragma("unroll") for (int m = 0; m < 4; ++m) { if constexpr (Sched::FP8) dst##8[m] = __builtin_shufflevector(*(const PG8_LAS i32x4*)(lds + PG8_SA(b, h) + aoff + m * 2048), *(const PG8_LAS i32x4*)(lds + PG8_SA(b, h) + aoff + m * 2048 + 1024), 0, 1, 2, 3, 4, 5, 6, 7); \
        else { _Pragma("unroll") for (int k = 0; k < 2; ++k) dst[m][k] = *(const PG8_LAS bf16x8*)(lds + PG8_SA(b, h) + aoff + m * 2048 + k * 1024); } } } while (0)
#define PG8_LDB(dst, b, h) do { _Pragma("unroll") for (int n = 0; n < 2; ++n) { if constexpr (Sched::FP8) dst##8[n] = __builtin_shufflevector(*(const PG8_LAS i32x4*)(lds + PG8_SB(b, h) + boff + n * 2048), *(const PG8_LAS i32x4*)(lds + PG8_SB(b, h) + boff + n * 2048 + 1024), 0, 1, 2, 3, 4, 5, 6, 7); \
        else { _Pragma("unroll") for (int k = 0; k < 2; ++k) dst[n][k] = *(const PG8_LAS bf16x8*)(lds + PG8_SB(b, h) + boff + n * 2048 + k * 1024); } } } while (0)
#define PG8_MMA(ai, bj, At, Bt) do { __builtin_amdgcn_s_setprio(1); if constexpr (Sched::FP8) asm volatile("s_nop 1"); _Pragma("unroll") for (int m = 0; m < 4; ++m) _Pragma("unroll") for (int n = 0; n < 2; ++n) { \
        if constexpr (Sched::FP8) asm volatile("v_mfma_f32_16x16x128_f8f6f4 %0, %1, %2, %0" : "+v"(acc[ai][bj][m][n]) : "v"(Bt##8[n]), "v"(At##8[m]));   \
        else { _Pragma("unroll") for (int k = 0; k < 2; ++k) acc[ai][bj][m][n] = __builtin_amdgcn_mfma_f32_16x16x32_bf16(Bt[n][k], At[m][k], acc[ai][bj][m][n], 0, 0, 0); } } __builtin_amdgcn_s_setprio(0); } while (0)
#define PG8_WAIT_V(n) asm volatile("s_waitcnt vmcnt(" #n ")" ::: "memory")
#define PG8_WAIT_V8R(relax) do { if (relax) asm volatile("s_waitcnt vmcnt(%0)" :: "n"(8 + Epi::NSTORES) : "memory"); else asm volatile("s_waitcnt vmcnt(8)" ::: "memory"); } while (0)
#define PG8_WAIT_L(n) asm volatile("s_waitcnt lgkmcnt(" #n ")" ::: "memory")
#define PG8_BAR __builtin_amdgcn_s_barrier()
#define PG8_SCHED __builtin_amdgcn_sched_barrier(0)
    Unit cur, nxt; int ui = 0; bool prev_full = false;
    if (!S.next(0, cur, lds)) return;
    if constexpr (Sched::TABLES) {
        if (wid == 0) S.issue_tables(cur, lds, 0, lane);
        PG8_WAIT_V(0); PG8_BAR;
    }
    Acc acc;
#pragma unroll
    for (int a = 0; a < 2; ++a)
#pragma unroll
        for (int b = 0; b < 2; ++b)
#pragma unroll
            for (int m = 0; m < 4; ++m)
#pragma unroll
                for (int n = 0; n < 2; ++n) acc[a][b][m][n] = (f32x4){0.f, 0.f, 0.f, 0.f};
    bf16x8 At[4][2], B0[2][2], B1[2][2];
    i32x8 At8[4], B08[2], B18[2];
    unsigned offc[2][2], offn[2][2];
    if constexpr (Sched::TABLES) { S.a_offsets(g, cur, lds, 0, RA, CA, offc);
#pragma unroll
        for (int h = 0; h < 2; ++h)
#pragma unroll
            for (int i = 0; i < 2; ++i) offn[h][i] = offc[h][i]; }
    const char* const Ab = (const char*)g.A;
    const char* cA = Sched::TABLES ? Ab : Ab + (size_t)cur.pm * tstep;
    const char* cB = S.b_tile(g, cur);
    PG8_STAGE(PG8_SB(0, 0), cB, voffB); PG8_STAGE(PG8_SB(0, 1), cB + bstep, voffB); PG8_STAGE_A(PG8_SA(0, 0), cA, 0, offc); PG8_STAGE_A(PG8_SA(0, 1), cA, 1, offc);
    if (wr == 1) PG8_BAR;
    PG8_WAIT_V(2); PG8_BAR;
    PG8_STAGE(PG8_SB(1, 0), cB + kstep, voffB); PG8_STAGE_A(PG8_SA(1, 0), cA + kstep, 0, offc); PG8_STAGE(PG8_SB(1, 1), cB + bstep + kstep, voffB);
    PG8_WAIT_V(6); PG8_BAR;
    for (;;) {
        const bool has_next = S.next(ui + 1, nxt, lds);
        const char* nB = has_next ? S.b_tile(g, nxt) : cB;
        const char* nA = Sched::TABLES ? Ab : (has_next ? Ab + (size_t)nxt.pm * tstep : cA);
#pragma nounroll
        for (int t = 0; t < nt; t += 2) {
            const bool last = (t == nt - 2);
            const bool relax = (t == 0) && prev_full;
            const bool pre11 = (t == 0) && (ui > 0);
            if constexpr (has_mid<Epi>::value) { if (t == nt / 2) E.mid(acc, cur, wr, wc, fr, fq); }
            if constexpr (Sched::TABLES) {
                if (t == 2 && has_next && wid == 0) S.issue_tables(nxt, lds, (ui + 1) & 1, lane);
                if (t == (nt >= 16 ? nt - 6 : nt - 2) && has_next) S.a_offsets(g, nxt, lds, (ui + 1) & 1, RA, CA, offn);
            }
            unsigned o2[2][2];
            if constexpr (Sched::TABLES) {
#pragma unroll
                for (int h = 0; h < 2; ++h)
#pragma unroll
                    for (int i = 0; i < 2; ++i) o2[h][i] = last ? offn[h][i] : offc[h][i]; }
            const char* a1 = cA + (size_t)(t + 1) * kstep;
            const char* a2 = last ? nA : cA + (size_t)(t + 2) * kstep; const char* b2 = last ? nB : cB + (size_t)(t + 2) * kstep;
            const char* a3 = a2 + kstep; const char* b3 = b2 + kstep;
            PG8_LDB(B0, 0, 0); PG8_LDB(B1, 0, 1); PG8_SCHED; PG8_LDA(At, 0, 0); if (!pre11) PG8_STAGE_A(PG8_SA(1, 1), a1, 1, offc);
            PG8_WAIT_V8R(relax); PG8_WAIT_L(0); PG8_BAR; PG8_MMA(0, 0, At, B0); PG8_MMA(0, 1, At, B1); PG8_BAR; PG8_SCHED;
            PG8_LDA(At, 0, 1); PG8_STAGE(PG8_SB(0, 0), b2, voffB); PG8_STAGE(PG8_SB(0, 1), b2 + bstep, voffB); PG8_STAGE_A(PG8_SA(0, 0), a2, 0, o2);
            PG8_WAIT_V8R(relax); PG8_WAIT_L(0); PG8_BAR; PG8_MMA(1, 0, At, B0); PG8_MMA(1, 1, At, B1); PG8_BAR; PG8_SCHED;
            PG8_LDB(B0, 1, 0); PG8_LDB(B1, 1, 1); PG8_SCHED; PG8_LDA(At, 1, 0); PG8_STAGE_A(PG8_SA(0, 1), a2, 1, o2);
            PG8_WAIT_V8R(relax && pre11); PG8_WAIT_L(0); PG8_BAR; PG8_MMA(0, 0, At, B0); PG8_MMA(0, 1, At, B1); PG8_BAR; PG8_SCHED;
            PG8_LDA(At, 1, 1); PG8_STAGE(PG8_SB(1, 0), b3, voffB); PG8_STAGE(PG8_SB(1, 1), b3 + bstep, voffB); PG8_STAGE_A(PG8_SA(1, 0), a3, 0, o2);
            PG8_WAIT_V(8); PG8_WAIT_L(0); PG8_BAR; PG8_MMA(1, 0, At, B0); PG8_MMA(1, 1, At, B1); PG8_BAR; PG8_SCHED;
        }
        if (wr == 0) PG8_BAR;
        if (has_next) PG8_STAGE_A(PG8_SA(1, 1), nA + kstep, 1, offn);
        E(acc, cur, wr, wc, fr, fq, lds, ui & 1);
        if (!has_next) break;
#pragma unroll
        for (int a = 0; a < 2; ++a)
#pragma unroll
            for (int b = 0; b < 2; ++b)
#pragma unroll
                for (int m = 0; m < 4; ++m)
#pragma unroll
                    for (int n = 0; n < 2; ++n) acc[a][b][m][n] = (f32x4){0.f, 0.f, 0.f, 0.f};
        prev_full = (cur.nvalid == 256); cur = nxt; cB = nB; cA = nA; ++ui;
        if constexpr (Sched::TABLES) {
#pragma unroll
            for (int h = 0; h < 2; ++h)
#pragma unroll
                for (int i = 0; i < 2; ++i) offc[h][i] = offn[h][i]; }
        if (wr == 1) PG8_BAR;
    }
    PG8_WAIT_V(0);
    PG8_BAR;
#undef PG8_SA
#undef PG8_SB
#undef PG8_STAGE
#undef PG8_STAGE_A
#undef PG8_LDA
#undef PG8_LDB
#undef PG8_MMA
#undef PG8_WAIT_V
#undef PG8_WAIT_V8R
#undef PG8_WAIT_L
#undef PG8_BAR
#undef PG8_SCHED
}
}
namespace attn_body {
using bf16=__hip_bfloat16;
using bf16x8=__attribute__((ext_vector_type(8)))short;
using s16x4=__attribute__((ext_vector_type(4)))short;
using f32x16=__attribute__((ext_vector_type(16)))float;
using u32x4=__attribute__((ext_vector_type(4)))unsigned;
using f32x4_=__attribute__((ext_vector_type(4)))float;
constexpr int BATCH=16,SEQ=4096,D=64,DM=512,DMO=1024;
constexpr int NW=8,QBLK=32,QB=QBLK*NW,KVBLK=64,NQB=SEQ/QB;
constexpr int ATTN_UNIT_ROWS=QB;
__device__ __forceinline__ int crow(int r,int hi){return (r&3)+8*(r>>2)+4*hi;}
#define SBAR() __builtin_amdgcn_sched_barrier(0)
__device__ __forceinline__ void cmask(f32x16&p0,f32x16&p1,int jb,int qrel,int hi){
  const float NEG=-INFINITY; int kb=64*jb+4*hi; asm volatile("":"+v"(kb),"+v"(qrel));
  #pragma unroll
  for(int r=0;r<16;++r){int kv=kb+(r&3)+8*(r>>2); if(kv>qrel)p0[r]=NEG; if(kv+32>qrel)p1[r]=NEG;}
}

constexpr int NSLOT=3, SLOTB=8192, VSLOTB=16384;
constexpr int LDS_K=0, LDS_V=NSLOT*SLOTB, LDS_WS=NSLOT*SLOTB+NSLOT*VSLOTB, LDS_OST=LDS_WS+NW*64*4, LDS_BYTES=LDS_OST+NW*4096;
constexpr int LDS_LAM=LDS_BYTES+16, LDS_SUBLN=LDS_BYTES+256;
__device__ __forceinline__ u32x4 ld16_sc1(const void*p){u32x4 v;asm volatile("global_load_dwordx4 %0, %1, off sc1":"=v"(v):"v"(p):"memory");return v;}
constexpr float C2=0.125f*1.4426950408889634f;
__device__ __forceinline__ void glds16(const void*gsrc,unsigned lds_dst){unsigned keep;
  asm volatile("s_mov_b32 %0, m0\n\ts_mov_b32 m0, %2\n\ts_nop 0\n\tglobal_load_lds_dwordx4 %1, off\n\ts_mov_b32 m0, %0":"=&s"(keep):"v"(gsrc),"s"(lds_dst):"memory");}
__device__ __forceinline__ float max3f(float a,float b,float c){float r;asm("v_max3_f32 %0, %1, %2, %3":"=v"(r):"v"(a),"v"(b),"v"(c));return r;}
__device__ __forceinline__ float max2f(float a,float b){float r;asm("v_max_f32_e32 %0, %1, %2":"=v"(r):"v"(a),"v"(b));return r;}
__device__ __forceinline__ float fadd_s(float a,float b){float r;asm("v_add_f32_e32 %0, %1, %2":"=v"(r):"v"(a),"v"(b));return r;}
__device__ __forceinline__ float fsub_s(float a,float b){float r;asm("v_sub_f32_e32 %0, %1, %2":"=v"(r):"v"(a),"v"(b));return r;}
typedef float f32x2_t __attribute__((ext_vector_type(2))); typedef __bf16 bf16x2_t __attribute__((ext_vector_type(2)));
__device__ __forceinline__ unsigned cvtpk_s(float lo,float hi){f32x2_t v={lo,hi};bf16x2_t b=__builtin_convertvector(v,bf16x2_t);return __builtin_bit_cast(unsigned,b);}
#define WAIT_BAR(N) asm volatile("s_waitcnt vmcnt(" #N ") lgkmcnt(0)\n\ts_barrier":::"memory")

__device__ __forceinline__ void qkt(f32x16&p0,f32x16&p1,const char*Kslot,const bf16x8*qr,const f32x16&i0,const f32x16&i1,int r32,int hi){
  const char*kb=Kslot+hi*1024+r32*16;
  #pragma unroll
  for(int d0=0;d0<4;++d0){
    const bf16x8 b0=*reinterpret_cast<const bf16x8*>(kb+d0*2048);
    const bf16x8 b1=*reinterpret_cast<const bf16x8*>(kb+d0*2048+512);
    if(d0==0){p0=__builtin_amdgcn_mfma_f32_32x32x16_bf16(b0,qr[0],i0,0,0,0);p1=__builtin_amdgcn_mfma_f32_32x32x16_bf16(b1,qr[0],i1,0,0,0);}
    else{p0=__builtin_amdgcn_mfma_f32_32x32x16_bf16(b0,qr[d0],p0,0,0,0);p1=__builtin_amdgcn_mfma_f32_32x32x16_bf16(b1,qr[d0],p1,0,0,0);}}
}
typedef __attribute__((address_space(3))) const char* lds_cptr;
typedef short v4i16_t __attribute__((ext_vector_type(4)));
__device__ __forceinline__ void kload8(bf16x8*kf,lds_cptr kp){
  kf[0]=*(const __attribute__((address_space(3))) bf16x8*)(kp);      kf[1]=*(const __attribute__((address_space(3))) bf16x8*)(kp+512);
  kf[2]=*(const __attribute__((address_space(3))) bf16x8*)(kp+2048); kf[3]=*(const __attribute__((address_space(3))) bf16x8*)(kp+2560);
  kf[4]=*(const __attribute__((address_space(3))) bf16x8*)(kp+4096); kf[5]=*(const __attribute__((address_space(3))) bf16x8*)(kp+4608);
  kf[6]=*(const __attribute__((address_space(3))) bf16x8*)(kp+6144); kf[7]=*(const __attribute__((address_space(3))) bf16x8*)(kp+6656);
}
__device__ __forceinline__ void kload2(bf16x8*kf,lds_cptr kp,int j){ kf[2*j]=*(const __attribute__((address_space(3))) bf16x8*)(kp+j*2048); kf[2*j+1]=*(const __attribute__((address_space(3))) bf16x8*)(kp+j*2048+512); }
__device__ __forceinline__ s16x4 vtr(lds_cptr p){ return __builtin_bit_cast(s16x4,__builtin_amdgcn_ds_read_tr16_b64_v4i16((__attribute__((address_space(3))) v4i16_t*)p)); }
__device__ __forceinline__ float rowmax(const f32x16&p0,const f32x16&p1){
  float a=max3f(p0[0],p0[1],p1[0]),b=max3f(p0[2],p0[3],p1[1]);a=max3f(a,p1[2],p1[3]);
  #pragma unroll
  for(int r=4;r<16;r+=4){a=max3f(a,p0[r],p0[r+1]);b=max3f(b,p0[r+2],p0[r+3]);a=max3f(a,p1[r],p1[r+1]);b=max3f(b,p1[r+2],p1[r+3]);}
  const float m=max2f(a,b);
  auto rr=__builtin_amdgcn_permlane32_swap(__float_as_uint(m),__float_as_uint(m),false,false);
  return max2f(__uint_as_float(rr[0]),__uint_as_float(rr[1]));
}
__device__ __forceinline__ void pv(f32x16*o,int vb,bf16x8 pa0,bf16x8 pa1,bf16x8 pa2,bf16x8 pa3){
  #pragma unroll
  for(int d0=0;d0<4;++d0){s16x4 lo[4],hi[4];
    #pragma unroll
    for(int ks=0;ks<4;++ks){
      asm volatile("ds_read_b64_tr_b16 %0,%1 offset:%c2":"=&v"(lo[ks]):"v"(vb),"i"(d0*4096+ks*1024):"memory");
      asm volatile("ds_read_b64_tr_b16 %0,%1 offset:%c2":"=&v"(hi[ks]):"v"(vb),"i"(d0*4096+ks*1024+512):"memory");}
    asm volatile("s_waitcnt lgkmcnt(0)":::"memory");SBAR();
    #define PK(k) (bf16x8){lo[k][0],lo[k][1],lo[k][2],lo[k][3],hi[k][0],hi[k][1],hi[k][2],hi[k][3]}
    o[d0]=__builtin_amdgcn_mfma_f32_32x32x16_bf16(pa0,PK(0),o[d0],0,0,0);
    o[d0]=__builtin_amdgcn_mfma_f32_32x32x16_bf16(pa1,PK(1),o[d0],0,0,0);
    o[d0]=__builtin_amdgcn_mfma_f32_32x32x16_bf16(pa2,PK(2),o[d0],0,0,0);
    o[d0]=__builtin_amdgcn_mfma_f32_32x32x16_bf16(pa3,PK(3),o[d0],0,0,0);
    #undef PK
  }
}

#ifndef ATTN_STORE16
#define ATTN_STORE16(p,v) (*(u32x4*)(p)=(v))
#endif
template<int THRL> __device__ __forceinline__ void attn_unit(int b,int hm,int qb,float cs,const int wid,const int t0,const float uref,const bf16*Q,const bf16*__restrict__ K,const bf16*__restrict__ V,bf16*O,char*shm,volatile __attribute__((address_space(3))) int*slot_,const int nxt_,const bool lead_,const bool comb_){
  int lane=lane_id(); asm volatile("":"+v"(lane));
  const int r32=lane&31,hi=lane>>5;
  const long rowbase=(long)b*SEQ; const int q0=qb*QB;
  const int NTf=(q0+QB)/KVBLK;
  const bf16*Qw=Q+(rowbase+q0+wid*QBLK)*DM+hm*D;
  const bf16*Kh=K+(rowbase+64*t0)*DM+hm*D,*Vh=V+(rowbase+64*t0)*DM+(hm>>1)*128;
  const unsigned lds0=(unsigned)(uintptr_t)shm;
  float*wsf=(float*)(shm+LDS_WS)+wid*64;
  const bf16*ksrc=Kh+(long)lane*DM+wid*8;
  const bf16*vsrc=Vh+(long)(16*(wid&3)+(lane>>2))*DM+(wid>>2)*32+(lane&3)*8;
  const unsigned kdst=lds0+LDS_K+wid*1024, vdst=lds0+LDS_V+wid*1024;
  #define DMA_K(t,slot) glds16(ksrc+(long)(t)*KVBLK*DM,(unsigned)__builtin_amdgcn_readfirstlane(kdst+(slot)))
  #define DMA_V(t,slot) do{ glds16(vsrc+(long)(t)*KVBLK*DM,(unsigned)__builtin_amdgcn_readfirstlane(vdst+(slot))); glds16(vsrc+(long)(t)*KVBLK*DM+64,(unsigned)__builtin_amdgcn_readfirstlane(vdst+(slot)+8192)); }while(0)
  const int vb0=(int)(lds0+LDS_V)+((lane>>4)&1)*32+(lane&3)*8+(4*hi+((lane&15)>>2))*64;
  const char*Kbase=shm+LDS_K; bf16x8 kf[8];
  const lds_cptr shm3=(lds_cptr)shm; const lds_cptr kp0=shm3+LDS_K+hi*1024+r32*16; const lds_cptr vp0=shm3+LDS_V+((lane>>4)&1)*32+(lane&3)*8+(4*hi+((lane&15)>>2))*64;
  const int NT=NTf-t0;
  DMA_K(0,0);DMA_V(0,0);DMA_K(1,SLOTB);
  bf16x8 qr[4];
  #pragma unroll
  for(int d0=0;d0<4;++d0)qr[d0]=*reinterpret_cast<const bf16x8*>(&Qw[(long)r32*DM+d0*16+hi*8]);
  float mhat=0.f,l_reg=0.f;f32x16 o[4];o[0]=f32x16{};o[1]=f32x16{};o[2]=f32x16{};o[3]=f32x16{};
  const int qrel=wid*QBLK+r32;
  float nb=-uref-cs*(float)(q0+qrel-4*hi-64*t0);
  const float cs8=__builtin_bit_cast(float,__builtin_amdgcn_readfirstlane(__builtin_bit_cast(int,8.f*cs)));
  #define CINIT1(C,t,X) do{ C[0]=nb+cs*(float)(64*(t)+(X)); C[1]=C[0]+cs; C[2]=C[1]+cs; C[3]=C[2]+cs; _Pragma("unroll") for(int r=4;r<16;++r) C[r]=C[r-4]+cs8; asm volatile("":"+v"(C)); }while(0)
  #define CINIT(C0,C1,t) do{ CINIT1(C0,t,0); CINIT1(C1,t,32); }while(0)
  #define CMASK(P0,P1,t) do{int jb_=(t)-(NT-4); if(jb_>=0)cmask(P0,P1,jb_,qrel,hi);}while(0)
  bool resc=false;
  #define START(P0,P1) do{ const float rm=rowmax(P0,P1); resc=false; \
    { const float dl=0.f; (void)rm; mhat=fadd_s(mhat,dl); nb=fsub_s(nb,dl);     \
      _Pragma("unroll") for(int r=0;r<16;++r){P0[r]=fsub_s(P0[r],dl);P1[r]=fsub_s(P1[r],dl);} } \
    _Pragma("unroll") for(int r=0;r<16;++r)P0[r]=__builtin_amdgcn_exp2f(P0[r]); }while(0)
  #define RESC() do{ if(THRL>=0&&resc){ asm volatile("s_waitcnt lgkmcnt(0)":::"memory"); \
      _Pragma("unroll") for(int d_=0;d_<4;++d_) _Pragma("unroll") for(int r=0;r<16;++r)o[d_][r]*=wsf[crow(r,hi)]; } }while(0)
  f32x16 pA0,pA1,pB0,pB1;
  int sl_prev=0,sl_cur=0,sl_next=SLOTB;
  #define ROT() do{sl_prev=sl_cur;sl_cur=sl_next;sl_next=(sl_next==(NSLOT-1)*SLOTB)?0:sl_next+SLOTB;}while(0)
  DMA_K(2,2*SLOTB);
  WAIT_BAR(4);
  { f32x16 i0_,i1_; CINIT(i0_,i1_,0); qkt(pA0,pA1,Kbase,qr,i0_,i1_,r32,hi); } asm volatile("s_nop 15\n\ts_nop 7":"+v"(pA0),"+v"(pA1));CMASK(pA0,pA1,0);
  CINIT(pB0,pB1,1);
  START(pA0,pA1);
  _Pragma("unroll") for(int r=0;r<16;++r)pA1[r]=__builtin_amdgcn_exp2f(pA1[r]);
  WAIT_BAR(0);
  DMA_K(3,0);DMA_V(1,VSLOTB);
  ROT();
  kload8(kf,kp0+sl_cur);
  WAIT_BAR(3);
  s16x4 vlo[8],vhi[8]; u32x4 pw0,pw1,pw2,pw3;
  #define PKW(P,B) cvtpk_s(P[B],P[B+1])
  #define PAF(k) __builtin_bit_cast(bf16x8,pw##k)
  #define VFR(i) (bf16x8){vlo[i][0],vlo[i][1],vlo[i][2],vlo[i][3],vhi[i][0],vhi[i][1],vhi[i][2],vhi[i][3]}
  #define PIN(x) asm volatile("":"+v"(x))
  #define MX3(a,b,c) __builtin_fmaxf(__builtin_fmaxf((a),(b)),(c))
  #define GAPA(MF,A0,A1,A2,A3,W0,W1,PW) do{ MF; sacc+=A0; sacc+=A1; sacc+=A2; sacc+=A3; PIN(sacc); W0; W1; PIN(PW); SBAR(); }while(0)
  #define EX(v) __builtin_amdgcn_exp2f(v)
  #define GAPB(MF,X,B,CI) do{ MF; X[B]=EX(X[B]); X[B+1]=EX(X[B+1]); CI; PIN(X); SBAR(); }while(0)
    \
  #define CIA(P,X,t) do{ P[0]=nb+cs*(float)(64*((t)+1)+(X)); P[1]=P[0]+cs; }while(0)
  #define CIB(P) do{ P[2]=P[1]+cs; P[3]=P[2]+cs; }while(0)
  #define CIC(P,k) do{ P[2*(k)]=P[2*(k)-4]+cs8; P[2*(k)+1]=P[2*(k)-3]+cs8; }while(0)
  #define VRD2(i) do{ vlo[i]=vtr(vp_+(8192+((i)>>2)*4096+((i)&3)*1024)); vhi[i]=vtr(vp_+(8192+((i)>>2)*4096+((i)&3)*1024+512)); SBAR(); }while(0)
  #define VRD(i) do{ vlo[i]=vtr(vp_+(((i)>>2)*4096+((i)&3)*1024)); vhi[i]=vtr(vp_+(((i)>>2)*4096+((i)&3)*1024+512)); }while(0)
  #define KRD(G,j) do{ if(G){ kload2(kf,kp0+sl_next,j); SBAR(); } }while(0)
  #define STEP(C0,C1,P0,P1,t,GK,GV,GL) do{ SBAR(); \
    const lds_cptr vp_=vp0+2*sl_prev; \
    VRD(0); SBAR(); float sacc=(P0[0]+P0[1]); SBAR(); \
    GAPA(C0=__builtin_amdgcn_mfma_f32_32x32x16_bf16(kf[0],qr[0],C0,0,0,0), P0[2],P0[3],P0[4],P0[5],     pw0[0]=PKW(P0,0), pw0[1]=PKW(P0,2), pw0); \
    VRD(4); SBAR(); GAPA(C1=__builtin_amdgcn_mfma_f32_32x32x16_bf16(kf[1],qr[0],C1,0,0,0), P0[6],P0[7],P0[8],P0[9],     pw0[2]=PKW(P0,4), pw0[3]=PKW(P0,6), pw0); \
    VRD(1); SBAR(); GAPA(C0=__builtin_amdgcn_mfma_f32_32x32x16_bf16(kf[2],qr[1],C0,0,0,0),   P0[10],P0[11],P0[12],P0[13], pw1[0]=PKW(P0,8), pw1[1]=PKW(P0,10), pw1); \
    VRD(5); SBAR(); GAPA(C1=__builtin_amdgcn_mfma_f32_32x32x16_bf16(kf[3],qr[1],C1,0,0,0),   P0[14],P0[15],P1[0],P1[1],   pw1[2]=PKW(P0,12),pw1[3]=PKW(P0,14), pw1); \
    VRD(2); SBAR(); GAPA(C0=__builtin_amdgcn_mfma_f32_32x32x16_bf16(kf[4],qr[2],C0,0,0,0),   P1[2],P1[3],P1[4],P1[5],     pw2[0]=PKW(P1,0), pw2[1]=PKW(P1,2), pw2); \
    VRD(6); SBAR(); GAPA(C1=__builtin_amdgcn_mfma_f32_32x32x16_bf16(kf[5],qr[2],C1,0,0,0),   P1[6],P1[7],P1[8],P1[9],     pw2[2]=PKW(P1,4), pw2[3]=PKW(P1,6), pw2); \
    VRD(3); SBAR(); GAPA(C0=__builtin_amdgcn_mfma_f32_32x32x16_bf16(kf[6],qr[3],C0,0,0,0),   P1[10],P1[11],P1[12],P1[13], pw3[0]=PKW(P1,8), pw3[1]=PKW(P1,10), pw3); \
    VRD(7); SBAR(); GAPA(C1=__builtin_amdgcn_mfma_f32_32x32x16_bf16(kf[7],qr[3],C1,0,0,0),   P1[14],P1[15],0.f,0.f,       pw3[2]=PKW(P1,12),pw3[3]=PKW(P1,14), pw3); \
    l_reg+=sacc; \
    if(GK){DMA_K((t)+3,sl_cur);} if(GV){DMA_V((t)+1,2*sl_next);} \
    CMASK(C0,C1,t); \
    { float a=MX3(C0[0],C0[1],C1[0]),b=MX3(C0[2],C0[3],C1[1]); a=MX3(a,C1[2],C1[3]); \
      _Pragma("unroll") for(int r=4;r<16;r+=4){a=MX3(a,C0[r],C0[r+1]);b=MX3(b,C0[r+2],C0[r+3]);a=MX3(a,C1[r],C1[r+1]);b=MX3(b,C1[r+2],C1[r+3]);} \
      float rm=__builtin_fmaxf(a,b); { auto rr=__builtin_amdgcn_permlane32_swap(__float_as_uint(rm),__float_as_uint(rm),false,false); rm=__builtin_fmaxf(__uint_as_float(rr[0]),__uint_as_float(rr[1])); } \
      resc=false; \
      if(THRL>=0&&__builtin_expect(__any(rm>(float)THRL),0)){ const float dl=__builtin_fmaxf(rm,0.f); mhat+=dl; nb-=dl; \
        _Pragma("unroll") for(int r=0;r<16;++r){C0[r]-=dl;C1[r]-=dl;} \
        const float f=__builtin_amdgcn_exp2f(-dl); l_reg*=f; if(hi==0)wsf[r32]=f; resc=true; } } \
    SBAR(); \
    GAPB(o[0]=__builtin_amdgcn_mfma_f32_32x32x16_bf16(PAF(0),VFR(0),o[0],0,0,0), C0,0, CIA(P0,0,t)); \
    GAPB(o[1]=__builtin_amdgcn_mfma_f32_32x32x16_bf16(PAF(0),VFR(4),o[1],0,0,0), C0,2, CIB(P0)); VRD2(0); \
    KRD(GL,0); GAPB(o[0]=__builtin_amdgcn_mfma_f32_32x32x16_bf16(PAF(1),VFR(1),o[0],0,0,0), C0,4, CIC(P0,2)); VRD2(4); \
    KRD(GL,1); GAPB(o[1]=__builtin_amdgcn_mfma_f32_32x32x16_bf16(PAF(1),VFR(5),o[1],0,0,0), C0,6, CIC(P0,3)); VRD2(1); \
    KRD(GL,2); GAPB(o[0]=__builtin_amdgcn_mfma_f32_32x32x16_bf16(PAF(2),VFR(2),o[0],0,0,0), C0,8, CIC(P0,4)); VRD2(5); \
    KRD(GL,3); GAPB(o[1]=__builtin_amdgcn_mfma_f32_32x32x16_bf16(PAF(2),VFR(6),o[1],0,0,0), C0,10, CIC(P0,5)); VRD2(2); \
    GAPB(o[0]=__builtin_amdgcn_mfma_f32_32x32x16_bf16(PAF(3),VFR(3),o[0],0,0,0), C0,12, CIC(P0,6)); VRD2(6); \
    GAPB(o[1]=__builtin_amdgcn_mfma_f32_32x32x16_bf16(PAF(3),VFR(7),o[1],0,0,0), C0,14, CIC(P0,7)); VRD2(3); \
    GAPB(o[2]=__builtin_amdgcn_mfma_f32_32x32x16_bf16(PAF(0),VFR(0),o[2],0,0,0), C1,0, CIA(P1,32,t)); VRD2(7); \
    GAPB(o[3]=__builtin_amdgcn_mfma_f32_32x32x16_bf16(PAF(0),VFR(4),o[3],0,0,0), C1,2, CIB(P1)); \
    GAPB(o[2]=__builtin_amdgcn_mfma_f32_32x32x16_bf16(PAF(1),VFR(1),o[2],0,0,0), C1,4, CIC(P1,2)); \
    GAPB(o[3]=__builtin_amdgcn_mfma_f32_32x32x16_bf16(PAF(1),VFR(5),o[3],0,0,0), C1,6, CIC(P1,3)); \
    GAPB(o[2]=__builtin_amdgcn_mfma_f32_32x32x16_bf16(PAF(2),VFR(2),o[2],0,0,0), C1,8, CIC(P1,4)); \
    GAPB(o[3]=__builtin_amdgcn_mfma_f32_32x32x16_bf16(PAF(2),VFR(6),o[3],0,0,0), C1,10, CIC(P1,5)); \
    GAPB(o[2]=__builtin_amdgcn_mfma_f32_32x32x16_bf16(PAF(3),VFR(3),o[2],0,0,0), C1,12, CIC(P1,6)); \
    GAPB(o[3]=__builtin_amdgcn_mfma_f32_32x32x16_bf16(PAF(3),VFR(7),o[3],0,0,0), C1,14, CIC(P1,7)); \
    }while(0)
  int t=1;
  #undef CMASK
  #define CMASK(P0,P1,t) do{}while(0)
  for(;t+5<NT;t+=2){
    STEP(pB0,pB1,pA0,pA1,t,true,true,true);     WAIT_BAR(3); RESC(); ROT();
    STEP(pA0,pA1,pB0,pB1,t+1,true,true,true);   WAIT_BAR(3); RESC(); ROT();
  }
  #undef CMASK
  #define CMASK(P0,P1,t) do{int jb_=(t)-(NT-4); if(jb_>=0)cmask(P0,P1,jb_,qrel,hi);}while(0)
  #define ENDW(tt) do{ if((tt)+3<NT){WAIT_BAR(3);} else if((tt)+2<NT){WAIT_BAR(2);} else {WAIT_BAR(0);} }while(0)
  for(;t+1<NT;t+=2){
    STEP(pB0,pB1,pA0,pA1,t,(t+3<NT),(t+1<NT),(t+1<NT));       ENDW(t);   RESC(); ROT();
    STEP(pA0,pA1,pB0,pB1,t+1,(t+4<NT),(t+2<NT),(t+2<NT));     ENDW(t+1); RESC(); ROT();
  }
  STEP(pB0,pB1,pA0,pA1,NT-1,false,false,false); RESC();
  u32x4 A[2][4];
  if(comb_){ const bf16*o0=O+(rowbase+q0+wid*QBLK+(lane>>3))*DMO+(hm>>1)*256+(lane&7)*8;
    #pragma unroll
    for(int hf=0;hf<2;++hf)
      #pragma unroll
      for(int i=0;i<4;++i)A[hf][i]=ld16_sc1(o0+(long)(i*8)*DMO+hf*64); }
  { float sacc=pB0[0]+pB0[1]; _Pragma("unroll") for(int r=2;r<16;++r)sacc+=pB0[r]; _Pragma("unroll") for(int r=0;r<16;++r)sacc+=pB1[r]; l_reg+=sacc;
    pw0=(u32x4){PKW(pB0,0),PKW(pB0,2),PKW(pB0,4),PKW(pB0,6)};pw1=(u32x4){PKW(pB0,8),PKW(pB0,10),PKW(pB0,12),PKW(pB0,14)};pw2=(u32x4){PKW(pB1,0),PKW(pB1,2),PKW(pB1,4),PKW(pB1,6)};pw3=(u32x4){PKW(pB1,8),PKW(pB1,10),PKW(pB1,12),PKW(pB1,14)};
    SBAR(); pv(o,vb0+2*sl_cur,PAF(0),PAF(1),PAF(2),PAF(3)); }
  #undef PKW
  #undef PAF
  #undef VFR
  #undef PIN
  #undef MX3
  #undef GAPA
  #undef GAPB
  #undef EX
  #undef VRD
  #undef VRD2
  #undef CIA
  #undef CIB
  #undef CIC
  #undef KRD
  #undef STEP
  #undef ENDW
  if(lead_) *slot_=nxt_;
  {auto rr=__builtin_amdgcn_permlane32_swap(__float_as_uint(l_reg),__float_as_uint(l_reg),false,false);l_reg=__uint_as_float(rr[0])+__uint_as_float(rr[1]);}
  if(hi==0)wsf[32+r32]=l_reg;asm volatile("s_waitcnt lgkmcnt(0)":::"memory");
  float rli[16];
  #pragma unroll
  for(int r=0;r<16;++r)rli[r]=__builtin_amdgcn_rcpf(wsf[32+crow(r,hi)]);
  bf16*Ow=O+(rowbase+q0+wid*QBLK)*DMO+(hm>>1)*256;
  { bf16*stg=(bf16*)(shm+LDS_OST)+wid*2048;
    int eoff=hi*256+r32; asm volatile("":"+v"(eoff));
    const int row_l=lane>>3,ch=lane&7;
    if(!comb_){
      #pragma unroll
      for(int hf=0;hf<2;++hf){
        #pragma unroll
        for(int r=0;r<16;++r){const int orow=(r&3)+8*(r>>2);
          #pragma unroll
          for(int d0=0;d0<2;++d0)stg[eoff+orow*64+d0*32]=__float2bfloat16(o[2*hf+d0][r]*rli[r]);}
        asm volatile("s_waitcnt lgkmcnt(0)":::"memory");
        #pragma unroll
        for(int i=0;i<4;++i){const int row=i*8+row_l; const u32x4 v=*(const u32x4*)(stg+row*64+ch*8); ATTN_STORE16(Ow+(long)row*DMO+hf*64+ch*8,v);}
        asm volatile("s_waitcnt lgkmcnt(0)":::"memory"); }
    } else {
      static_assert(MIXG_FP8, "fused combine writes the fp8 APO layout");
      const float lam=*(const volatile __attribute__((address_space(3))) float*)((lds_cptr)shm+LDS_LAM);
      ::f32x4 dd[2][4][2]; float ss[4]={0.f,0.f,0.f,0.f};
      #pragma unroll
      for(int hf=0;hf<2;++hf){
        #pragma unroll
        for(int r=0;r<16;++r){const int orow=(r&3)+8*(r>>2);
          #pragma unroll
          for(int d0=0;d0<2;++d0)stg[eoff+orow*64+d0*32]=__float2bfloat16(o[2*hf+d0][r]*rli[r]);}
        asm volatile("s_waitcnt lgkmcnt(0)":::"memory");
        if(hf==0){ asm volatile("s_waitcnt vmcnt(0)":"+v"(A[0][0]),"+v"(A[0][1]),"+v"(A[0][2]),"+v"(A[0][3]),"+v"(A[1][0]),"+v"(A[1][1]),"+v"(A[1][2]),"+v"(A[1][3])::"memory"); }
        #pragma unroll
        for(int i=0;i<4;++i){const int row=i*8+row_l; const u32x4 v=*(const u32x4*)(stg+row*64+ch*8);
          ::f32x4 a0,a1,b0,b1; pg8::unpack8(A[hf][i],a0,a1); pg8::unpack8(v,b0,b1); a0-=b0*lam; a1-=b1*lam; dd[hf][i][0]=a0; dd[hf][i][1]=a1;
          ss[i]+=(a0[0]*a0[0]+a0[1]*a0[1])+(a0[2]*a0[2]+a0[3]*a0[3])+(a1[0]*a1[0]+a1[1]*a1[1])+(a1[2]*a1[2]+a1[3]*a1[3]); }
        asm volatile("s_waitcnt lgkmcnt(0)":::"memory"); }
      unsigned char*ap=(unsigned char*)O+((long)WS_APO-(long)WS_O16)+(size_t)(rowbase+q0+wid*QBLK+row_l)*1024+(hm>>1)*128+ch*8;
      #pragma unroll
      for(int i=0;i<4;++i){ float s=ss[i];
        #define SWZ_ADD(k) s+=__builtin_bit_cast(float,__builtin_amdgcn_ds_swizzle(__builtin_bit_cast(int,s),((k)<<10)|0x1f))
        SWZ_ADD(1);SWZ_ADD(2);SWZ_ADD(4);
        #undef SWZ_ADD
        const float rs=rsqrtf(s*(1.f/128.f)+LN_EPS)*(0.8f*APO_SCALE);
        #pragma unroll
        for(int hf=0;hf<2;++hf){ const __attribute__((address_space(3))) f32x4_* gp=(const __attribute__((address_space(3))) f32x4_*)((lds_cptr)shm+LDS_SUBLN+(hf*64+ch*8)*4); const f32x4_ g0=gp[0],g1=gp[1];
          ::f32x4 a0=dd[hf][i][0],a1=dd[hf][i][1];
          #pragma unroll
          for(int j=0;j<4;++j){a0[j]*=rs*g0[j];a1[j]*=rs*g1[j];}
          *(unsigned long long*)(ap+(size_t)(i*8)*1024+hf*64)=(unsigned long long)pg8::pk4_fp8(a0[0],a0[1],a0[2],a0[3])|((unsigned long long)pg8::pk4_fp8(a1[0],a1[1],a1[2],a1[3])<<32); } }
    } }
  asm volatile("s_waitcnt lgkmcnt(0)\n\ts_barrier":::"memory");
  #undef DMA_K
  #undef DMA_V
  #undef CMASK
  #undef START
  #undef RESC
  #undef ROT
  #undef CINIT
  #undef CINIT1
}
constexpr int ATTN_LDS_BYTES=LDS_BYTES;
struct AttnTensors { const bf16* Q; const bf16* K; const bf16* V; bf16* O; const float* PN; unsigned* queue; float lam; const float* subln; unsigned char* APO; };
constexpr int LDS_SLOT=LDS_BYTES, LDS_T0=LDS_BYTES+1024, LDS_UREF=LDS_T0+8192, ATTN_LDS_TOTAL=LDS_UREF+8192;
__device__ __forceinline__ void unit_of(int u,int&b,int&h,int&qb){ if(u<512){qb=15-(u>>5);const int r=u&31;b=r>>1;h=2+(r&1);} else if(u<768){const int v=u-512;qb=15-(v>>4);b=v&15;h=1;} else {const int v=u-768;qb=15-(v>>4);b=v&15;h=0;} }
__device__ __forceinline__ void attn_tables(char*lds,const float*PN,int tid){
  const int bhm=tid>>2,part=tid&3; const float*pq=PN+(bhm*64+16*part)*2,*pk=PN+16384+(bhm*64+16*part)*2;
  float kq[16],qq[16];
  #pragma unroll
  for(int i=0;i<8;++i){ const f32x4_ a=*(const f32x4_*)(pk+4*i),c=*(const f32x4_*)(pq+4*i); kq[2*i]=a[0]+a[1];kq[2*i+1]=a[2]+a[3];qq[2*i]=c[0]+c[1];qq[2*i+1]=c[2]+c[3]; }
  float km[4]; { float m=0.f;
    #pragma unroll
    for(int i=0;i<16;++i){ m=__builtin_fmaxf(m,kq[i]); if((i&3)==3)km[i>>2]=m; } }
  float before=0.f;
  #pragma unroll
  for(int p=0;p<3;++p){ const float tot=__shfl(km[3],(tid&~3)+p); if(p<part)before=__builtin_fmaxf(before,tot); }
  const int hm=bhm&7; const float cs=__builtin_amdgcn_exp2f(-2.f*(float)((hm>>1)+1))*1.4426950408889634f;
  volatile __attribute__((address_space(3))) int* T0=(volatile __attribute__((address_space(3))) int*)(lds+LDS_T0); volatile __attribute__((address_space(3))) float* UR=(volatile __attribute__((address_space(3))) float*)(lds+LDS_UREF);
  #pragma unroll
  for(int j=0;j<4;++j){ const int qb=4*part+j; const float kmx=__builtin_fmaxf(before,km[j]); const float qmx=__builtin_fmaxf(__builtin_fmaxf(qq[4*j],qq[4*j+1]),__builtin_fmaxf(qq[4*j+2],qq[4*j+3]));
    const float qk=__builtin_sqrtf(qmx*kmx), need=(ATT_SKIP+2.04f*qk)/cs;
    const float tf=((float)(256*qb-63)-need)*(1.f/64.f); int tt=tf>0.f?(int)tf:0; tt&=~1; if(tt>4*qb)tt=4*qb;
    T0[bhm*16+qb]=tt; UR[bhm*16+qb]=1.02f*qk; }
}
template<int THRL=8> __device__ __forceinline__ void attn_phase(char*lds,const AttnTensors&T,const int wid){
  volatile __attribute__((address_space(3))) int* slot=(volatile __attribute__((address_space(3))) int*)(lds+LDS_SLOT);
  const volatile __attribute__((address_space(3))) int* T0=(const volatile __attribute__((address_space(3))) int*)(lds+LDS_T0); const volatile __attribute__((address_space(3))) float* UR=(const volatile __attribute__((address_space(3))) float*)(lds+LDS_UREF);
  const bool lead=(wid==0)&&(lane_id()==0);
  if(lead) *slot=(int)__hip_atomic_fetch_add(T.queue,1u,__ATOMIC_RELAXED,__HIP_MEMORY_SCOPE_AGENT);
  { const int tid_=wid*64+lane_id(); if(tid_<128)((volatile __attribute__((address_space(3))) float*)(lds+LDS_SUBLN))[tid_]=T.subln[tid_]; if(tid_==0)*(volatile __attribute__((address_space(3))) float*)(lds+LDS_LAM)=T.lam; }
  attn_tables(lds,T.PN,wid*64+lane_id());
  asm volatile("s_waitcnt vmcnt(0) lgkmcnt(0)\n\ts_barrier":::"memory");
  int cur=__builtin_amdgcn_readfirstlane(*slot);
  asm volatile("s_waitcnt lgkmcnt(0)\n\ts_barrier":::"memory");
  while(cur<BATCH*4*NQB){
    int nxt=0; if(lead) nxt=(int)__hip_atomic_fetch_add(T.queue,1u,__ATOMIC_RELAXED,__HIP_MEMORY_SCOPE_AGENT);
    int b,h,qb; unit_of(cur,b,h,qb);
    const float cs=__builtin_bit_cast(float,__builtin_amdgcn_readfirstlane(__builtin_bit_cast(int,__builtin_amdgcn_exp2f(-2.f*(float)(h+1))*1.4426950408889634f)));
    #pragma unroll 1
    for(int m=0;m<2;++m){ const int hm=2*h+m;
      const int t0=__builtin_amdgcn_readfirstlane(T0[(b*8+hm)*16+qb]); const float uref=__builtin_bit_cast(float,__builtin_amdgcn_readfirstlane(__builtin_bit_cast(int,(float)UR[(b*8+hm)*16+qb])));
      attn_unit<THRL>(b,hm,qb,cs,wid,t0,uref,T.Q,T.K,T.V,T.O,lds,slot,nxt,lead&&(m==1),m==1); }
    cur=__builtin_amdgcn_readfirstlane(*slot);
    asm volatile("s_waitcnt lgkmcnt(0)":::"memory");
  }
}
#undef SBAR
#undef WAIT_BAR
}
constexpr int NWAVES = 8;
constexpr int RING_OFF = 0, RING_BYTES = 131072;
constexpr int LDSCTL_OFF = RING_BYTES, MISC_OFF = LDSCTL_OFF + 320;
constexpr int LDS_BYTES = 163840;

#define XB_TMO      128
#define XB_XCNT(j)  (256  + 64 * (j))
#define XB_XSUB(j)  (1280 + 64 * (j))
#define XB_XGEN(j)  (2304 + 64 * (j))
#define XB_TOP      3328
#define XB_TOPGEN   3392
#define XCD_BAR_WORDS 3456
#define XB_SPIN_CAP (1u << 18)
__device__ __forceinline__ unsigned xb_ld(unsigned* p)              { return __hip_atomic_load(p, __ATOMIC_RELAXED, __HIP_MEMORY_SCOPE_AGENT); }
__device__ __forceinline__ unsigned xb_add(unsigned* p, unsigned v) { return __hip_atomic_fetch_add(p, v, __ATOMIC_RELAXED, __HIP_MEMORY_SCOPE_AGENT); }
__device__ __forceinline__ unsigned xb_xcc_id() { return (unsigned)__builtin_amdgcn_s_getreg((3 << 11) | 20) & 0xFu; }
#define XB_SPIN(cond, bar) do { unsigned _sp = 0; while (cond) { __builtin_amdgcn_s_sleep(1); \
    if ((++_sp & 255u) == 0u) { if (xb_ld(&(bar)[XB_TMO])) break; if (_sp > XB_SPIN_CAP) { atomicAdd(&(bar)[XB_TMO], 1u); break; } } } } while (0)
struct XcdBarrier { unsigned* bar; unsigned x; volatile LAS unsigned* st; bool wave0; };
__device__ __forceinline__ XcdBarrier xcd_barrier_post(unsigned* bar, volatile LAS unsigned* st) {
    XcdBarrier b; b.bar = bar; b.x = xb_xcc_id(); b.st = st; b.wave0 = __builtin_amdgcn_readfirstlane(threadIdx.x >> 6) == 0;
    if (threadIdx.x == 0) (void)xb_add(&bar[XB_XCNT(b.x)], 1u);
    return b;
}
__device__ __forceinline__ void xcd_barrier_complete(unsigned* bar, unsigned x, unsigned& nloc, unsigned& nx) {
    const unsigned G = gridDim.x * gridDim.y * gridDim.z;
    unsigned sum, cnt, mine, sp = 0u;
    for (;;) {
        sum = 0u; cnt = 0u; mine = 0u;
#pragma unroll
        for (unsigned j = 0; j < 16; ++j) { const unsigned c = xb_ld(&bar[XB_XCNT(j)]); sum += c; cnt += (c > 0u) ? 1u : 0u; mine = (j == x) ? c : mine; }
        if (sum == G) break;
        __builtin_amdgcn_s_sleep(1);
        if ((++sp & 255u) == 0u) { if (xb_ld(&bar[XB_TMO])) break; if (sp > XB_SPIN_CAP) { atomicAdd(&bar[XB_TMO], 1u); break; } }
    }
    nloc = mine > 0u ? mine : 1u; nx = cnt > 0u ? cnt : 1u;
}
__device__ __forceinline__ void xcd_barrier(const XcdBarrier& b) {
    asm volatile("s_waitcnt vmcnt(0)" ::: "memory");
    __syncthreads();
    if (b.wave0 && lane_id() == 0) {
        unsigned* bar = b.bar;
        __builtin_amdgcn_s_waitcnt(0);
        unsigned nloc = b.st[0], nx = b.st[1];
        if (nloc == 0u) { xcd_barrier_complete(bar, b.x, nloc, nx); b.st[0] = nloc; b.st[1] = nx; }
        const unsigned old = xb_add(&bar[XB_XSUB(b.x)], 1u);
        const unsigned gen = old / nloc;
        if (old + 1u == (gen + 1u) * nloc) {
            __builtin_amdgcn_fence(__ATOMIC_RELEASE, "agent");
            asm volatile("s_waitcnt vmcnt(0)" ::: "memory");
            const unsigned og = xb_add(&bar[XB_TOP], 1u);
            const unsigned tg = og / nx;
            if (og + 1u == (tg + 1u) * nx) xb_add(&bar[XB_TOPGEN], 1u);
            else XB_SPIN(xb_ld(&bar[XB_TOPGEN]) == tg, bar);
            __builtin_amdgcn_fence(__ATOMIC_ACQUIRE, "agent");
            xb_add(&bar[XB_XGEN(b.x)], 1u);
            asm volatile("s_waitcnt vmcnt(0)" ::: "memory");
        } else {
            XB_SPIN(xb_ld(&bar[XB_XGEN(b.x)]) == gen, bar);
            __builtin_amdgcn_fence(__ATOMIC_ACQUIRE, "agent");
            asm volatile("s_waitcnt vmcnt(0)" ::: "memory");
        }
    }
    __syncthreads();
}

struct Frame {
    LAS unsigned char* lds; volatile LAS unsigned* MISC; gu32* ctl;
    int tid, lane, wave, vcu, G;
};
__device__ __forceinline__ float bf2f_(unsigned short b) { return __builtin_bit_cast(float, (unsigned)b << 16); }
__device__ __forceinline__ float wave_sum(float v) {
#pragma unroll
    for (int o = 1; o < 64; o <<= 1) v += __shfl_xor(v, o);
    return v;
}
struct Ptrs {
    const float *x, *p, *w_in, *b_gate, *lq1, *lk1, *lq2, *lk2, *subln, *w_abr, *w_pmix, *pscale, *w_pbr, *w_out, *ln1g, *ln1b, *w_router, *b_router, *w_up, *b_up, *w_down, *b_down, *w_pg, *w_pp, *ln2g, *ln2b;
    float* out; unsigned char* ws;
};
constexpr int TI_IN = 16 * 128, TI_A = 8 * 32, TI_O = 16 * 32, TI_PG = 16 * 32, TI_PP = 4 * 32, TI_UP1 = 16 * 64, TI_DN1 = 16 * 32;
constexpr int TI_UP = NEXP * TI_UP1, TI_DN = NEXP * TI_DN1, TI_EARLY = TI_IN + TI_A + TI_O, TI_TOTAL = TI_EARLY + TI_PG + TI_PP + TI_UP + TI_DN;
#ifndef NCONV
#define NCONV 64
#endif
#ifndef NPOOL
#define NPOOL 0
#endif
struct TItem { const float* W; unsigned char* WT; int ldw, K, k0, n0, drow0, f8; float scale; };
__device__ __forceinline__ TItem p0_item(const Ptrs& P, int it) {
    unsigned char* ws = P.ws; TItem t; int r = it; t.f8 = 0; t.scale = 1.f;
    if (r < TI_IN) { const int nb = 128, n0 = 32 * (r % nb); t.W = P.w_in; t.ldw = 4096; t.K = 1024; t.k0 = 64 * (r / nb); t.n0 = n0;
        if (n0 >= 256 * PROJ_F8_FROM) { static_assert(PROJ_F8_FROM == 8 || PROJ_F8_FROM == 16, "gate-column interleave assumes the fp8 part is exactly the 2048 gate columns");
            const int gc = n0 - 2048, c = gc & 1023;
            t.WT = ws + WS_WIN8; t.drow0 = 256 * (c >> 7) + 128 * (gc >> 10) + (c & 127); t.f8 = 1; t.scale = WUP_SCALE; }
        else { t.WT = ws + WS_WIN; t.drow0 = n0; }
        return t; } r -= TI_IN;
    if (r < TI_A) { const int nb = 32; t.W = P.w_abr; t.ldw = 1024; t.K = 1024; t.WT = ws + WS_WCAT; t.k0 = 64 * (r / nb); t.n0 = t.drow0 = 32 * (r % nb); if (MIXG_FP8) { t.f8 = 1; t.scale = WUP_SCALE; } return t; } r -= TI_A;
    if (r < TI_O) { const int nb = 32; t.W = P.w_out; t.ldw = 1024; t.K = 1024; t.WT = ws + WS_WOUT; t.k0 = 64 * (r / nb); t.n0 = t.drow0 = 32 * (r % nb); return t; } r -= TI_O;
    if (r < TI_PG) { const int nb = 32; t.W = P.w_pg; t.ldw = 1024; t.K = 1024; t.WT = ws + WS_WPG; t.k0 = 64 * (r / nb); t.n0 = t.drow0 = 32 * (r % nb); if (MOE_FP8) { t.f8 = 1; t.scale = WUP_SCALE; } return t; } r -= TI_PG;
    if (r < TI_PP) { const int nb = 32; t.W = P.w_pp; t.ldw = 1024; t.K = 256; t.WT = ws + WS_WPP; t.k0 = 64 * (r / nb); t.n0 = t.drow0 = 32 * (r % nb); return t; } r -= TI_PP;
    if (r < TI_UP) { const int e = r / TI_UP1, q = r % TI_UP1, nb = 64, n0 = 32 * (q % nb);
        const int bj = n0 >> 10, pn = (n0 & 1023) >> 7, cp = n0 & 127;
        t.W = P.w_up + (size_t)e * 1024 * 2048; t.ldw = 2048; t.K = 1024; t.k0 = 64 * (q / nb); t.n0 = n0; t.drow0 = 256 * pn + 128 * bj + cp;
        if (MOE_FP8) { t.WT = ws + WS_WUP + (size_t)e * 2048 * 1024; t.f8 = 1; t.scale = WUP_SCALE; } else t.WT = ws + WS_WUP + (size_t)e * 2048 * 1024 * 2;
        return t; } r -= TI_UP;
    { const int e = r / TI_DN1, q = r % TI_DN1, nb = 32;
        t.W = P.w_down + (size_t)e * 1024 * 1024; t.ldw = 1024; t.K = 1024; t.k0 = 64 * (q / nb); t.n0 = t.drow0 = 32 * (q % nb);
        if (MOE_FP8) { t.WT = ws + WS_WDN + (size_t)e * 1024 * 1024; t.f8 = 1; t.scale = WDN_SCALE; } else t.WT = ws + WS_WDN + (size_t)e * 1024 * 1024 * 2; }
    return t;
}
__device__ __forceinline__ void p0_emit(const TItem& t, LAS float* scr, int lane) {
    if (t.f8) { const int c = lane & 3;
#pragma unroll
        for (int j = 0; j < 2; ++j) { const int n = (lane >> 2) + 16 * j; const LAS float* s = scr + (16 * c) * 33 + n;
            v4u o; o.x = pg8::pk4_fp8(s[0 * 33], s[1 * 33], s[2 * 33], s[3 * 33]); o.y = pg8::pk4_fp8(s[4 * 33], s[5 * 33], s[6 * 33], s[7 * 33]);
            o.z = pg8::pk4_fp8(s[8 * 33], s[9 * 33], s[10 * 33], s[11 * 33]); o.w = pg8::pk4_fp8(s[12 * 33], s[13 * 33], s[14 * 33], s[15 * 33]);
            *(GAS v4u*)(t.WT + (size_t)(t.drow0 + n) * t.K + t.k0 + 16 * c) = o; } }
    else { const int c = lane & 7;
#pragma unroll
        for (int j = 0; j < 4; ++j) { const int n = (lane >> 3) + 8 * j; const LAS float* s = scr + (8 * c) * 33 + n;
            v4u o; o.x = pk2(s[0 * 33], s[1 * 33]); o.y = pk2(s[2 * 33], s[3 * 33]); o.z = pk2(s[4 * 33], s[5 * 33]); o.w = pk2(s[6 * 33], s[7 * 33]);
            *(GAS v4u*)((bf16*)t.WT + (size_t)(t.drow0 + n) * t.K + t.k0 + 8 * c) = o; } }
}
#define P0_LOAD(T, V) do { const char* base_ = (const char*)(T.W + (size_t)T.k0 * T.ldw + T.n0); unsigned vo_ = (unsigned)(((lane >> 5) * T.ldw + (lane & 31)) * 4); const unsigned step_ = (unsigned)(T.ldw * 8); \
        _Pragma("unroll") for (int i = 0; i < 32; ++i) { V[i] = *(const float*)(base_ + vo_); vo_ += step_; } } while (0)
#define P0_DRAIN(T, V) do { _Pragma("unroll") for (int i = 0; i < 32; ++i) scr[(2 * i + (lane >> 5)) * 33 + (lane & 31)] = V[i] * T.scale; \
        LDS_WAIT(); asm volatile("" ::: "memory"); p0_emit(T, scr, lane); LDS_WAIT(); asm volatile("" ::: "memory"); } while (0)
__device__ __forceinline__ void conv_items(const Ptrs& P, int first, int last, int start, int stride, LAS float* scr, int lane) {
    int it = first + start; if (it >= last) return;
    TItem a = p0_item(P, it), b = p0_item(P, it + stride < last ? it + stride : it); bool two = it + stride < last;
    float va[32], vb[32], na[32], nb[32];
    P0_LOAD(a, va); if (two) P0_LOAD(b, vb);
    for (;;) {
        const int nt = it + 2 * stride; const bool more = nt < last, more2 = nt + stride < last;
        const TItem c = p0_item(P, more ? nt : it), d = p0_item(P, more2 ? nt + stride : it);
        if (more) P0_LOAD(c, na);
        if (more2) P0_LOAD(d, nb);
        P0_DRAIN(a, va); if (two) P0_DRAIN(b, vb);
        if (!more) break;
        it = nt; a = c; b = d; two = more2;
#pragma unroll
        for (int i = 0; i < 32; ++i) { va[i] = na[i]; vb[i] = nb[i]; }
    }
}
#undef P0_LOAD
#undef P0_DRAIN
__device__ __forceinline__ void ph0_prologue(Frame& F, const Ptrs& P) {
    unsigned char* ws = P.ws;
    LAS float* scr = (LAS float*)(F.lds + RING_OFF + F.wave * 16384);
    const int gw = F.vcu * NWAVES + F.wave, NGW = F.G * NWAVES;
    { const size_t n4 = (size_t)M * D / 4, st = (size_t)F.G * 512; const f32x4* src = (const f32x4*)P.x; unsigned long long* dst = (unsigned long long*)P.out;
      unsigned* dst8 = (unsigned*)(ws + WS_XF8);
      for (size_t i = (size_t)blockIdx.x * 512 + F.tid; i < n4; i += 8 * st) { f32x4 v[8];
#pragma unroll
          for (int u = 0; u < 8; ++u) v[u] = (i + u * st < n4) ? src[i + u * st] : (f32x4){0.f, 0.f, 0.f, 0.f};
#pragma unroll
          for (int u = 0; u < 8; ++u) if (i + u * st < n4) { dst[i + u * st] = (unsigned long long)pk2(v[u].x, v[u].y) | ((unsigned long long)pk2(v[u].z, v[u].w) << 32);
              if (PROJ_F8_FROM < 16) dst8[i + u * st] = pg8::pk4_fp8(v[u].x, v[u].y, v[u].z, v[u].w); } } }
    conv_items(P, 0, NCONV > 0 ? TI_EARLY : TI_TOTAL, gw, NGW, scr, F.lane);
    { bf16* WPC = (bf16*)(ws + WS_WCAT) + 512; unsigned char* WPC8 = ws + WS_WCAT + 512;
      for (int k = blockIdx.x; k < 512; k += F.G) { const int g = k >> 7;
          float a0 = 0.f, a1 = 0.f; const float* wm = P.w_pmix + (size_t)k * 128; const float* sc = P.pscale + g * 128; const float* wb = P.w_pbr + (size_t)(g * 128) * 1024;
          for (int d = 0; d < 128; ++d) { const float w = wm[d] * sc[d]; a0 += w * wb[(size_t)d * 1024 + F.tid]; a1 += w * wb[(size_t)d * 1024 + 512 + F.tid]; }
          if (MIXG_FP8) { WPC8[(size_t)F.tid * 1024 + k] = (unsigned char)(pg8::pk4_fp8(a0 * WUP_SCALE, 0.f, 0.f, 0.f) & 0xffu); WPC8[(size_t)(F.tid + 512) * 1024 + k] = (unsigned char)(pg8::pk4_fp8(a1 * WUP_SCALE, 0.f, 0.f, 0.f) & 0xffu); }
          else { WPC[(size_t)F.tid * 1024 + k] = (bf16)f2bf(a0); WPC[(size_t)(F.tid + 512) * 1024 + k] = (bf16)f2bf(a1); } } }
}
__device__ __forceinline__ void ph_pool(Frame& F, const Ptrs& P, const int wg, const int nwg) {
    const bf16* U = (const bf16*)(P.ws + WS_U); bf16* PO = (bf16*)(P.ws + WS_APO) + 512;
    constexpr int RL = 32;
    const size_t nitem = (size_t)(M / RL) * 64, st = (size_t)nwg * 512;
    for (size_t idx = (size_t)wg * 512 + F.tid; idx < nitem; idx += st) {
        const int cg = (int)(idx & 63), c0 = cg * 8, w = 2 << (c0 >> 7); const size_t r0 = (idx >> 6) * RL; const int pos0 = (int)(r0 & (SEQ - 1));
        const bf16* up = U + r0 * 512 + c0; bf16* op = PO + r0 * 1024 + c0; unsigned char* op8 = P.ws + WS_APO + 512 + r0 * 1024 + c0;
        float s[8] = {0.f, 0.f, 0.f, 0.f, 0.f, 0.f, 0.f, 0.f};
        const int nprev = pos0 < w ? pos0 : w;
        for (int k = 1; k <= nprev; ++k) { const v4u v = *(const v4u*)(up - (size_t)k * 512);
            s[0] += pg8::bflo(v.x); s[1] += pg8::bfhi(v.x); s[2] += pg8::bflo(v.y); s[3] += pg8::bfhi(v.y); s[4] += pg8::bflo(v.z); s[5] += pg8::bfhi(v.z); s[6] += pg8::bflo(v.w); s[7] += pg8::bfhi(v.w); }
        const float rw = 1.f / (float)w;
#pragma unroll 4
        for (int j = 0; j < RL; ++j) { const int pos = pos0 + j; const bool drop = pos >= w;
            const v4u cur = *(const v4u*)(up + (size_t)j * 512), old = *(const v4u*)(up + (size_t)(drop ? j - w : j) * 512);
            const float c[8] = {pg8::bflo(cur.x), pg8::bfhi(cur.x), pg8::bflo(cur.y), pg8::bfhi(cur.y), pg8::bflo(cur.z), pg8::bfhi(cur.z), pg8::bflo(cur.w), pg8::bfhi(cur.w)};
            const float o[8] = {pg8::bflo(old.x), pg8::bfhi(old.x), pg8::bflo(old.y), pg8::bfhi(old.y), pg8::bflo(old.z), pg8::bfhi(old.z), pg8::bflo(old.w), pg8::bfhi(old.w)};
            const float rn = pos + 1 < w ? 1.f / (float)(pos + 1) : rw; float r[8];
#pragma unroll
            for (int i = 0; i < 8; ++i) { s[i] += c[i]; if (drop) s[i] -= o[i]; r[i] = s[i] * rn - c[i]; }
            v4u ov; ov.x = pk2(r[0], r[1]); ov.y = pk2(r[2], r[3]); ov.z = pk2(r[4], r[5]); ov.w = pk2(r[6], r[7]);
            if (MIXG_FP8) { *(unsigned long long*)(op8 + (size_t)j * 1024) = (unsigned long long)pg8::pk4_fp8(r[0] * APO_SCALE, r[1] * APO_SCALE, r[2] * APO_SCALE, r[3] * APO_SCALE) | ((unsigned long long)pg8::pk4_fp8(r[4] * APO_SCALE, r[5] * APO_SCALE, r[6] * APO_SCALE, r[7] * APO_SCALE) << 32); }
            else *(v4u*)(op + (size_t)j * 1024) = ov; }
    }
}
__device__ __forceinline__ float lam_value(const Ptrs& P) { float a = 0.f, b = 0.f; for (int d = 0; d < 64; ++d) { a += P.lq1[d] * P.lk1[d]; b += P.lq2[d] * P.lk2[d]; } return __expf(a) - __expf(b) + 0.2f; }
__device__ __forceinline__ void ph_combine(Frame& F, const Ptrs& P) {
    const bf16* O16 = (const bf16*)(P.ws + WS_O16); bf16* OA = (bf16*)(P.ws + WS_APO); const float lam = lam_value(P);
    const int gw = F.vcu * NWAVES + F.wave, NGW = F.G * NWAVES, h = F.lane >> 4, e0 = (F.lane & 15) * 8;
    float sg[8];
#pragma unroll
    for (int j = 0; j < 8; ++j) sg[j] = P.subln[e0 + j] * 0.8f;
    v4u av[4], bv[4], nav[4], nbv[4];
#define PH3_LOAD(r0_, AV, BV) do { _Pragma("unroll") for (int u = 0; u < 4; ++u) { const int row = (r0_) + u * NGW; if (row < M) { AV[u] = *(const v4u*)(O16 + (size_t)row * 1024 + h * 256 + e0); BV[u] = *(const v4u*)(O16 + (size_t)row * 1024 + h * 256 + 128 + e0); } } } while (0)
    if (gw < M) PH3_LOAD(gw, av, bv);
    for (int row0 = gw; row0 < M; row0 += 4 * NGW) {
        if (row0 + 4 * NGW < M) PH3_LOAD(row0 + 4 * NGW, nav, nbv);
#pragma unroll
        for (int u = 0; u < 4; ++u) { const int row = row0 + u * NGW; if (row >= M) continue;
            f32x4 a0, a1, b0, b1; pg8::unpack8(av[u], a0, a1); pg8::unpack8(bv[u], b0, b1); a0 -= b0 * lam; a1 -= b1 * lam;
            float ss = (a0[0] * a0[0] + a0[1] * a0[1]) + (a0[2] * a0[2] + a0[3] * a0[3]) + (a1[0] * a1[0] + a1[1] * a1[1]) + (a1[2] * a1[2] + a1[3] * a1[3]);
            ss += __shfl_xor(ss, 1); ss += __shfl_xor(ss, 2); ss += __shfl_xor(ss, 4); ss += __shfl_xor(ss, 8);
            const float r = rsqrtf(ss * (1.f / 128.f) + LN_EPS);
#pragma unroll
            for (int j = 0; j < 4; ++j) { a0[j] *= r * sg[j]; a1[j] *= r * sg[4 + j]; }
            if (MIXG_FP8) { a0 *= APO_SCALE; a1 *= APO_SCALE; *(unsigned long long*)(P.ws + WS_APO + (size_t)row * 1024 + h * 128 + e0) = (unsigned long long)pg8::pk4_fp8(a0[0], a0[1], a0[2], a0[3]) | ((unsigned long long)pg8::pk4_fp8(a1[0], a1[1], a1[2], a1[3]) << 32); }
            else *(v4u*)(OA + (size_t)row * 1024 + h * 128 + e0) = pg8::pack8(a0, a1); }
#pragma unroll
        for (int u = 0; u < 4; ++u) { av[u] = nav[u]; bv[u] = nbv[u]; }
    }
#undef PH3_LOAD
}
__device__ __forceinline__ void conv_p(Frame& F, const Ptrs& P, const int wg, const int nwg) {
    const size_t n4 = (size_t)M * PLE / 4, st = (size_t)nwg * 512; const f32x4* src = (const f32x4*)P.p; unsigned long long* dst = (unsigned long long*)((unsigned char*)P.out + 128 * MiB);
    for (size_t i = (size_t)wg * 512 + F.tid; i < n4; i += 8 * st) { f32x4 v[8];
#pragma unroll
        for (int u = 0; u < 8; ++u) v[u] = (i + u * st < n4) ? src[i + u * st] : (f32x4){0.f, 0.f, 0.f, 0.f};
#pragma unroll
        for (int u = 0; u < 8; ++u) if (i + u * st < n4) dst[i + u * st] = (unsigned long long)pk2(v[u].x, v[u].y) | ((unsigned long long)pk2(v[u].z, v[u].w) << 32); }
}
typedef float f32x16_ __attribute__((ext_vector_type(16)));
__device__ __forceinline__ void hilo8(const f32x4& a, const f32x4& b, bf16x8& hi, bf16x8& lo) {
    unsigned h[4], l[4];
    h[0] = pg8::cvt_pk_bf16(a[0], a[1]); h[1] = pg8::cvt_pk_bf16(a[2], a[3]); h[2] = pg8::cvt_pk_bf16(b[0], b[1]); h[3] = pg8::cvt_pk_bf16(b[2], b[3]);
    l[0] = pg8::cvt_pk_bf16(a[0] - pg8::bflo(h[0]), a[1] - pg8::bfhi(h[0])); l[1] = pg8::cvt_pk_bf16(a[2] - pg8::bflo(h[1]), a[3] - pg8::bfhi(h[1]));
    l[2] = pg8::cvt_pk_bf16(b[0] - pg8::bflo(h[2]), b[1] - pg8::bfhi(h[2])); l[3] = pg8::cvt_pk_bf16(b[2] - pg8::bflo(h[3]), b[3] - pg8::bfhi(h[3]));
    v4u hv = {h[0], h[1], h[2], h[3]}, lv = {l[0], l[1], l[2], l[3]}; hi = __builtin_bit_cast(bf16x8, hv); lo = __builtin_bit_cast(bf16x8, lv);
}
__device__ __forceinline__ void ph6_ln1_route(Frame& F, const Ptrs& P, const bool dry) {
    unsigned char* ws = P.ws;
    constexpr int XT_OFF = 0, XT_PITCH = 1028, PL_OFF = 16 * XT_PITCH * 4, LG_OFF = PL_OFF + 8 * 16 * 32 * 4, RS_OFF = LG_OFF + 256 * 33 * 4;
    static_assert(RS_OFF + 256 <= RING_BYTES, "ph6 LDS map");
    if (NCONV == 0) conv_p(F, P, (int)blockIdx.x, F.G);
    const bf16* X1in = (const bf16*)(ws + WS_PRE1B); float* STAT = (float*)(ws + (dry ? 228 * MiB : WS_STAT)); unsigned char* X1F8 = ws + (dry ? 740 * MiB : WS_X1F8);
#define CI6(j) (8 * (lane + 64 * ((j) >> 1)) + 4 * ((j) & 1))
    const int lane = F.lane, wave = F.wave, e = lane & 31, kh = lane >> 5;
    LAS float* XT = (LAS float*)(F.lds + XT_OFF); LAS float* PL = (LAS float*)(F.lds + PL_OFF); LAS float* LG = (LAS float*)(F.lds + LG_OFF);
    bf16x8 bh[8], bl[8];
#pragma unroll
    for (int s = 0; s < 8; ++s) { const float* wp = P.w_router + (size_t)(128 * wave + 16 * s + 8 * kh) * 32 + e;
        const f32x4 a = {wp[0], wp[32], wp[64], wp[96]}, b = {wp[128], wp[160], wp[192], wp[224]}; hilo8(a, b, bh[s], bl[s]); }
    f32x4 gam[4], bet[4];
#pragma unroll
    for (int j = 0; j < 4; ++j) { gam[j] = *(const f32x4*)(P.ln1g + CI6(j)); bet[j] = *(const f32x4*)(P.ln1b + CI6(j)); }
    const float brt = P.b_router[e];
    for (int chunk = blockIdx.x; chunk < M / 256; chunk += F.G) {
        f32x4 v[2][4]; v4u nw[2][2];
#pragma unroll
        for (int i = 0; i < 2; ++i)
#pragma unroll
            for (int jj = 0; jj < 2; ++jj) nw[i][jj] = *(const v4u*)(X1in + (size_t)(chunk * 256 + 2 * wave + i) * 1024 + 8 * (lane + 64 * jj));
#pragma unroll 1
        for (int step = 0; step < 16; ++step) {
#pragma unroll
            for (int i = 0; i < 2; ++i)
#pragma unroll
                for (int jj = 0; jj < 2; ++jj) pg8::unpack8(nw[i][jj], v[i][2 * jj], v[i][2 * jj + 1]);
            if (step < 15) {
#pragma unroll
                for (int i = 0; i < 2; ++i)
#pragma unroll
                    for (int jj = 0; jj < 2; ++jj) nw[i][jj] = *(const v4u*)(X1in + (size_t)(chunk * 256 + (step + 1) * 16 + 2 * wave + i) * 1024 + 8 * (lane + 64 * jj)); }
            float s0 = 0.f, s1 = 0.f;
#pragma unroll
            for (int j = 0; j < 4; ++j) { s0 += (v[0][j].x + v[0][j].y) + (v[0][j].z + v[0][j].w); s1 += (v[1][j].x + v[1][j].y) + (v[1][j].z + v[1][j].w); }
#pragma unroll
            for (int o = 1; o < 64; o <<= 1) { s0 += __shfl_xor(s0, o); s1 += __shfl_xor(s1, o); }
            const float m0 = s0 * (1.f / 1024.f), m1 = s1 * (1.f / 1024.f); float q0 = 0.f, q1 = 0.f;
#pragma unroll
            for (int j = 0; j < 4; ++j) { v[0][j] = v[0][j] - m0; v[1][j] = v[1][j] - m1;
                q0 += (v[0][j].x * v[0][j].x + v[0][j].y * v[0][j].y) + (v[0][j].z * v[0][j].z + v[0][j].w * v[0][j].w); q1 += (v[1][j].x * v[1][j].x + v[1][j].y * v[1][j].y) + (v[1][j].z * v[1][j].z + v[1][j].w * v[1][j].w); }
#pragma unroll
            for (int o = 1; o < 64; o <<= 1) { q0 += __shfl_xor(q0, o); q1 += __shfl_xor(q1, o); }
            const float r0 = rsqrtf(q0 * (1.f / 1024.f) + LN_EPS), r1 = rsqrtf(q1 * (1.f / 1024.f) + LN_EPS);
#pragma unroll
            for (int i = 0; i < 2; ++i) { const int rl = 2 * wave + i; const size_t row = (size_t)chunk * 256 + step * 16 + rl; const float rs = i ? r1 : r0;
                if (lane == 0) { pg8::f32x2 sv = {i ? m1 : m0, rs}; *(pg8::f32x2*)(STAT + 2 * row) = sv; }
#pragma unroll
                for (int jj = 0; jj < 2; ++jj) { const f32x4 y0 = v[i][2 * jj] * rs * gam[2 * jj] + bet[2 * jj], y1 = v[i][2 * jj + 1] * rs * gam[2 * jj + 1] + bet[2 * jj + 1]; const int c = 8 * (lane + 64 * jj);
                    *(unsigned long long*)(X1F8 + row * 1024 + c) = (unsigned long long)pg8::pk4_fp8(y0.x, y0.y, y0.z, y0.w) | ((unsigned long long)pg8::pk4_fp8(y1.x, y1.y, y1.z, y1.w) << 32);
                    *(LAS f32x4*)(XT + rl * XT_PITCH + c) = y0; *(LAS f32x4*)(XT + rl * XT_PITCH + c + 4) = y1; } }
            __syncthreads();
            f32x16_ acc = {};
#pragma unroll
            for (int s = 0; s < 8; ++s) { const LAS float* xp = XT + (lane & 15) * XT_PITCH + 128 * wave + 16 * s + 8 * kh;
                const f32x4 a = *(const LAS f32x4*)xp, b = *(const LAS f32x4*)(xp + 4); bf16x8 ah, al; hilo8(a, b, ah, al);
                acc = __builtin_amdgcn_mfma_f32_32x32x16_bf16(ah, bh[s], acc, 0, 0, 0); acc = __builtin_amdgcn_mfma_f32_32x32x16_bf16(al, bh[s], acc, 0, 0, 0); acc = __builtin_amdgcn_mfma_f32_32x32x16_bf16(ah, bl[s], acc, 0, 0, 0); }
#pragma unroll
            for (int i = 0; i < 8; ++i) PL[(wave * 16 + (i & 3) + 8 * (i >> 2) + 4 * kh) * 32 + e] = acc[i];
            __syncthreads();
            { const int row = F.tid >> 5, ee = F.tid & 31; float sum = 0.f;
#pragma unroll
              for (int w = 0; w < 8; ++w) sum += PL[(w * 16 + row) * 32 + ee];
              LG[(step * 16 + row) * 33 + ee] = sum + __shfl(brt, ee); }
        }
        __syncthreads();
        LAS int* cntl = (LAS int*)(F.lds + RS_OFF); LAS int* basel = cntl + 32;
        if (F.tid < 32) cntl[F.tid] = 0;
        int my_e[4] = {0, 0, 0, 0}; float my_g[4] = {0.f, 0.f, 0.f, 0.f};
        if (F.tid < 256) { float lg[32];
#pragma unroll
            for (int k = 0; k < 32; ++k) lg[k] = LG[F.tid * 33 + k];
            float tv[4];
#pragma unroll
            for (int r = 0; r < 4; ++r) { float bv = lg[0]; int bi = 0;
#pragma unroll
                for (int k = 1; k < 32; ++k) if (lg[k] > bv) { bv = lg[k]; bi = k; }
                tv[r] = bv; my_e[r] = bi;
#pragma unroll
                for (int k = 0; k < 32; ++k) if (k == bi) lg[k] = -INFINITY; }
            const float e1 = __expf(tv[1] - tv[0]), e2 = __expf(tv[2] - tv[0]), e3 = __expf(tv[3] - tv[0]), rs = 1.f / (1.f + e1 + e2 + e3);
            my_g[0] = rs; my_g[1] = e1 * rs; my_g[2] = e2 * rs; my_g[3] = e3 * rs; }
        __syncthreads();
        int rk[4] = {0, 0, 0, 0};
        if (F.tid < 256) {
#pragma unroll
            for (int k = 0; k < 4; ++k) rk[k] = __hip_atomic_fetch_add(&cntl[my_e[k]], 1, __ATOMIC_RELAXED, __HIP_MEMORY_SCOPE_WORKGROUP); }
        __syncthreads();
        if (F.tid < 32) basel[F.tid] = (int)__hip_atomic_fetch_add(F.ctl + CW_CNT + (dry ? 32 : 0) + F.tid, (unsigned)cntl[F.tid], RLX_AGENT);
        __syncthreads();
        if (F.tid < 256) { const int row = chunk * 256 + F.tid; int* LIST = (int*)(ws + (dry ? 836 * MiB : WS_LIST)); float* GATEL = (float*)(ws + (dry ? 844 * MiB : WS_GATEL)); float* GATE = (float*)(ws + (dry ? 852 * MiB : WS_GATE));
#pragma unroll
            for (int k = 0; k < 4; ++k) { const size_t o = (size_t)my_e[k] * 65536 + (size_t)(basel[my_e[k]] + rk[k]); LIST[o] = row * 4 + k; GATEL[o] = my_g[k]; GATE[row * 4 + k] = my_g[k]; } }
        __syncthreads();
    }
}
__device__ __forceinline__ void ph10_final(Frame& F, const Ptrs& P, const bool dry) {
    float* dst = dry ? (float*)(P.ws + 356 * MiB) : P.out;
    const bf16* PLEB = (const bf16*)(P.ws + WS_PLE); const unsigned char* YS0 = P.ws + WS_YS; const unsigned char* YS1 = YS0 + YS_STRIDE; const unsigned char* YS2 = YS1 + YS_STRIDE; const unsigned char* YS3 = YS2 + YS_STRIDE;
    const int gw = F.vcu * NWAVES + F.wave, NGW = F.G * NWAVES, lane = F.lane;
    f32x4 gam[4], bet[4];
#pragma unroll
    for (int j = 0; j < 4; ++j) { gam[j] = *(const f32x4*)(P.ln2g + CI6(j)); bet[j] = *(const f32x4*)(P.ln2b + CI6(j)); }
    v4u pw[2], npw[2]; unsigned long long ys[2][4], nys[2][4];
#define PH10_LOAD(row_, PW, YS_) do { _Pragma("unroll") for (int jj = 0; jj < 2; ++jj) { const size_t o8 = (size_t)(row_) * 128 + lane + 64 * jj;     \
        PW[jj] = ((const v4u*)PLEB)[o8]; YS_[jj][0] = ((const unsigned long long*)YS0)[o8]; YS_[jj][1] = ((const unsigned long long*)YS1)[o8]; YS_[jj][2] = ((const unsigned long long*)YS2)[o8]; YS_[jj][3] = ((const unsigned long long*)YS3)[o8]; } } while (0)
    if (gw < M) PH10_LOAD(gw, pw, ys);
    for (int row = gw; row < M; row += NGW) {
        if (row + NGW < M) PH10_LOAD(row + NGW, npw, nys);
        f32x4 v[4]; float s = 0.f;
#pragma unroll
        for (int jj = 0; jj < 2; ++jj) { const unsigned long long ya = ys[jj][0], yb = ys[jj][1], yc = ys[jj][2], yd = ys[jj][3];
            pg8::unpack8(pw[jj], v[2 * jj], v[2 * jj + 1]);
#pragma unroll
            for (int h = 0; h < 2; ++h) { const unsigned a = (unsigned)(ya >> (32 * h)), b = (unsigned)(yb >> (32 * h)), c = (unsigned)(yc >> (32 * h)), d = (unsigned)(yd >> (32 * h)); constexpr float is = 1.f / YS_SCALE; const int j = 2 * jj + h;
              typedef float f32x2_ __attribute__((ext_vector_type(2)));
              const f32x2_ a0 = __builtin_amdgcn_cvt_pk_f32_fp8(a, false), a1 = __builtin_amdgcn_cvt_pk_f32_fp8(a, true), b0 = __builtin_amdgcn_cvt_pk_f32_fp8(b, false), b1 = __builtin_amdgcn_cvt_pk_f32_fp8(b, true);
              const f32x2_ c0 = __builtin_amdgcn_cvt_pk_f32_fp8(c, false), c1 = __builtin_amdgcn_cvt_pk_f32_fp8(c, true), d0 = __builtin_amdgcn_cvt_pk_f32_fp8(d, false), d1 = __builtin_amdgcn_cvt_pk_f32_fp8(d, true);
              v[j].x += ((a0[0] + b0[0]) + (c0[0] + d0[0])) * is; v[j].y += ((a0[1] + b0[1]) + (c0[1] + d0[1])) * is; v[j].z += ((a1[0] + b1[0]) + (c1[0] + d1[0])) * is; v[j].w += ((a1[1] + b1[1]) + (c1[1] + d1[1])) * is;
              s += (v[j].x + v[j].y) + (v[j].z + v[j].w); } }
        const float mean = wave_sum(s) * (1.f / 1024.f); float s2 = 0.f;
#pragma unroll
        for (int j = 0; j < 4; ++j) { v[j] = v[j] - mean; s2 += (v[j].x * v[j].x + v[j].y * v[j].y) + (v[j].z * v[j].z + v[j].w * v[j].w); }
        const float rstd = rsqrtf(wave_sum(s2) * (1.f / 1024.f) + LN_EPS);
#pragma unroll
        for (int j = 0; j < 4; ++j) *(f32x4*)(dst + (size_t)row * 1024 + CI6(j)) = v[j] * rstd * gam[j] + bet[j];
#pragma unroll
        for (int jj = 0; jj < 2; ++jj) { pw[jj] = npw[jj];
#pragma unroll
            for (int k = 0; k < 4; ++k) ys[jj][k] = nys[jj][k]; }
    }
#undef PH10_LOAD
}
__device__ __forceinline__ void moe_tables(Frame& F) {
    LAS int* cnt = (LAS int*)(F.lds + pg8::TAB_CNT); LAS int* blk0 = (LAS int*)(F.lds + pg8::TAB_BLK0); LAS int* row0 = (LAS int*)(F.lds + pg8::TAB_ROW0);
    __syncthreads();
    if (F.tid < 32) cnt[F.tid] = (int)__hip_atomic_load(F.ctl + CW_CNT + F.tid, RLX_AGENT);
    __syncthreads();
    if (F.tid == 0) { int b = 0, r = 0; for (int e = 0; e < 32; ++e) { blk0[e] = b; row0[e] = r; b += (cnt[e] + 255) >> 8; r += cnt[e]; } blk0[32] = b; row0[32] = r; }
    __syncthreads();
}

constexpr int NPHASE = 11;
struct Args { Ptrs P; int ph_lo, ph_hi; };
__global__ void __launch_bounds__(NWAVES * 64, 2) mk_fwd(Args args) {
    extern __shared__ __attribute__((aligned(16))) unsigned char lds[];
    Frame F; const Ptrs& P = args.P;
    F.lds = (LAS unsigned char*)lds; F.MISC = (volatile LAS unsigned*)(F.lds + MISC_OFF);
    F.wave = __builtin_amdgcn_readfirstlane(threadIdx.x >> 6); F.lane = lane_id(); F.tid = F.wave * 64 + F.lane;
#define REFRESH() do { F.lane = lane_id(); asm volatile("" : "+v"(F.lane)); F.tid = F.wave * 64 + F.lane; } while (0)
    F.G = gridDim.x; { const int bx = blockIdx.x; F.vcu = (F.G % 8 == 0) ? (bx % 8) * (F.G / 8) + bx / 8 : bx; }
    unsigned char* ws = P.ws; F.ctl = (gu32*)(ws + WS_CTL);
    for (int u = F.tid; u < 1024 / 4; u += NWAVES * 64) ((LAS unsigned*)(F.lds + LDSCTL_OFF))[u] = 0u;
    __syncthreads();
    const int lo = args.ph_lo, hi = args.ph_hi;
    XcdBarrier bar = xcd_barrier_post((unsigned*)(F.ctl + CW_BAR) + lo * XCD_BAR_WORDS, F.MISC + 8);
#define IN(k) (lo <= (k) && (k) < hi)
#define SEAM(k) do { if (IN(k) && IN((k) + 1)) xcd_barrier(bar); } while (0)
    bf16 *XB = (bf16*)P.out, *Q = (bf16*)(ws + WS_Q), *K = (bf16*)(ws + WS_K), *V = (bf16*)(ws + WS_V), *U = (bf16*)(ws + WS_U), *G = (bf16*)(ws + WS_G);
    bf16 *O16 = (bf16*)(ws + WS_O16), *APO = (bf16*)(ws + WS_APO), *MIX = (bf16*)(ws + WS_MIX), *X1B = (bf16*)(ws + WS_X1B), *HB = (bf16*)(ws + WS_HB), *PB = (bf16*)((unsigned char*)P.out + 128 * MiB);
    bf16* T = (bf16*)P.out;

    if (IN(0)) { REFRESH(); ph0_prologue(F, P); } SEAM(0);
    if (IN(1)) {
        const int flip = (PROJ_F8_FROM < 16) ? (((int)blockIdx.x >> 3) & 1) : 0;
        REFRESH(); { const f32x4 bgv = ((const f32x4*)P.b_gate)[F.tid]; ((LAS f32x4*)(F.lds + pg8::TAB_OFF))[F.tid] = bgv; } __syncthreads();
#pragma unroll 1
        for (int pass = 0; pass < 2; ++pass) {
            if ((pass ^ flip) == 0) { pg8::Gemm g{XB, (const bf16*)(ws + WS_WIN), 1024}; pg8::StaticOrder S; S.init(M, 256 * (PROJ_F8_FROM < 16 ? PROJ_F8_FROM : 16), F.G, (int)blockIdx.x);
              pg8::EpiProj E{Q, K, V, U, G, P.b_gate, (float*)(F.ctl + CW_PN), C2Q, 1.f, 0, 0};
              pg8::gemm_phase(F.lds, F.wave, g, S, E); }
            else if (PROJ_F8_FROM < 16) {
              pg8::Gemm g{(const bf16*)(ws + WS_XF8), (const bf16*)(ws + WS_WIN8), 512}; pg8::DenseF8Order S; S.init(M, 256 * (16 - PROJ_F8_FROM), F.G, (int)blockIdx.x);
              pg8::EpiProj E{Q, K, V, U, G, P.b_gate, (float*)(F.ctl + CW_PN), C2Q, 1.f / WUP_SCALE, PROJ_F8_FROM, 0};
              pg8::gemm_phase(F.lds, F.wave, g, S, E); }
        }
    } SEAM(1);
    if (IN(2)) {
        if (NCONV > 0 && (int)blockIdx.x < NCONV) {
            REFRESH(); conv_items(P, TI_EARLY, TI_TOTAL, (int)blockIdx.x * NWAVES + F.wave, NCONV * NWAVES, (LAS float*)(F.lds + RING_OFF + F.wave * 16384), F.lane); __syncthreads();
            REFRESH(); conv_p(F, P, (int)blockIdx.x, NCONV); }
        if (NPOOL > 0 && (int)blockIdx.x >= NCONV && (int)blockIdx.x < NCONV + NPOOL) { REFRESH(); ph_pool(F, P, (int)blockIdx.x - NCONV, NPOOL); }
        const attn_body::AttnTensors AT{(const attn_body::bf16*)Q, (const attn_body::bf16*)K, (const attn_body::bf16*)V, (attn_body::bf16*)O16, (const float*)(F.ctl + CW_PN), (unsigned*)(F.ctl + CW_AQ), lam_value(P), P.subln, ws + WS_APO};
        attn_body::attn_phase<-1>((char*)lds + RING_OFF, AT, F.wave);
        if (NPOOL == 0) { REFRESH(); ph_pool(F, P, (int)blockIdx.x, F.G); }
    }
    SEAM(3);
    if (IN(4)) {
        if (MIXG_FP8) { pg8::DenseF8Order S; S.init(M, 1024, F.G, (int)blockIdx.x);
            pg8::Gemm g{APO, (const bf16*)(ws + WS_WCAT), 512}; pg8::EpiMixCat E{MIX, G, 1.f / (APO_SCALE * WUP_SCALE), 0}; pg8::gemm_phase(F.lds, F.wave, g, S, E); }
        else { pg8::StaticOrder S; S.init(M, 1024, F.G, (int)blockIdx.x);
            pg8::Gemm g{APO, (const bf16*)(ws + WS_WCAT), 1024}; pg8::EpiMixCat E{MIX, G, 1.f, 0}; pg8::gemm_phase(F.lds, F.wave, g, S, E); }
    } SEAM(4);
    if (IN(5)) {
        pg8::Gemm g{MIX, (const bf16*)(ws + WS_WOUT), 1024}; pg8::StaticOrder S; S.init(M, 1024, F.G, (int)blockIdx.x);
        pg8::EpiPre1 E{(bf16*)(ws + WS_PRE1B), XB, ALPHA, 0};
        pg8::gemm_phase(F.lds, F.wave, g, S, E);
    } SEAM(5);
    if (IN(6)) { REFRESH(); ph6_ln1_route(F, P, false); } SEAM(6);
    if (IN(7)) {
        pg8::StaticOrder S; S.init(M, 1024, F.G, (int)blockIdx.x);
        { pg8::Gemm g{PB, (const bf16*)(ws + WS_WPP), 256}; pg8::EpiPle<1> E{T, nullptr, nullptr, nullptr, nullptr, nullptr, 1.f, 0.f}; pg8::gemm_phase(F.lds, F.wave, g, S, E); }
        VM_WAIT(); __syncthreads();
        if (MOE_FP8) { pg8::DenseF8Order S8; S8.init(M, 1024, F.G, (int)blockIdx.x);
            pg8::Gemm g{(const bf16*)(ws + WS_X1F8), (const bf16*)(ws + WS_WPG), 512}; pg8::EpiPle<3> E{(bf16*)(ws + WS_PLE), T, (const bf16*)(ws + WS_PRE1B), (const float*)(ws + WS_STAT), P.ln1g, P.ln1b, 1.f / WUP_SCALE, ALPHA}; pg8::gemm_phase(F.lds, F.wave, g, S8, E); }
        else { pg8::Gemm g{X1B, (const bf16*)(ws + WS_WPG), 1024}; pg8::EpiPle<3> E{(bf16*)(ws + WS_PLE), T, (const bf16*)(ws + WS_PRE1B), (const float*)(ws + WS_STAT), P.ln1g, P.ln1b, 1.f, ALPHA}; pg8::gemm_phase(F.lds, F.wave, g, S, E); }
    }
    if (IN(8)) {
        REFRESH(); moe_tables(F);
        pg8::Gemm g{MOE_FP8 ? (const bf16*)(ws + WS_X1F8) : X1B, (const bf16*)(ws + WS_WUP), MOE_FP8 ? 512 : 1024};
        pg8::MoeOrder<true, MOE_FP8> S{8, F.G, (int)blockIdx.x, (const int*)(ws + WS_LIST), (const float*)(ws + WS_GATEL), (size_t)2048 * 1024 * (MOE_FP8 ? 1 : 2), P.b_up};
        pg8::EpiUp<MOE_FP8> E{HB, P.b_up, MOE_FP8 ? 1.f / WUP_SCALE : 1.f, 0};
        pg8::gemm_phase(F.lds, F.wave, g, S, E);
    } SEAM(8);
    if (IN(9)) {
        REFRESH(); moe_tables(F);
        pg8::Gemm g{HB, (const bf16*)(ws + WS_WDN), MOE_FP8 ? 512 : 1024};
        pg8::MoeOrder<false, MOE_FP8> S{4, F.G, (int)blockIdx.x, (const int*)(ws + WS_LIST), (const float*)(ws + WS_GATEL), (size_t)1024 * 1024 * (MOE_FP8 ? 1 : 2), P.b_down};
        pg8::EpiDown E{ws + WS_YS, YS_STRIDE, P.b_down, MOE_FP8 ? 1.f / (WDN_SCALE) : 1.f, YS_SCALE};
        pg8::gemm_phase(F.lds, F.wave, g, S, E);
    } SEAM(9);
    if (IN(10)) { REFRESH(); ph10_final(F, P, false); }
#undef IN
#undef SEAM
}
extern "C" void kernel_launch(void* const* d_in, const int* in_sizes, int n_in, void* d_out, int out_size, void* d_ws, size_t ws_size, hipStream_t stream) {
    static int grid = 0;
    if (grid == 0) {
        if (n_in != 26 || in_sizes[0] != M * D || ws_size < WS_END || out_size != M * D) { fprintf(stderr, "kernel_launch: unexpected shapes (n_in %d, ws %zu, out %d); nothing launched\n", n_in, ws_size, out_size); grid = -1; return; }
        int dev = 0, cus = 0, per_cu = 0;
        if (hipGetDevice(&dev) != hipSuccess || hipDeviceGetAttribute(&cus, hipDeviceAttributeMultiprocessorCount, dev) != hipSuccess) { fprintf(stderr, "kernel_launch: device query failed; nothing launched\n"); grid = -1; return; }
        if (hipFuncSetAttribute((const void*)mk_fwd, hipFuncAttributeMaxDynamicSharedMemorySize, LDS_BYTES) != hipSuccess) { fprintf(stderr, "kernel_launch: hipFuncSetAttribute failed (%d bytes of dynamic LDS); nothing launched\n", LDS_BYTES); grid = -1; return; }
        if (hipOccupancyMaxActiveBlocksPerMultiprocessor(&per_cu, (const void*)mk_fwd, NWAVES * 64, LDS_BYTES) != hipSuccess || per_cu < 1) fprintf(stderr, "kernel_launch: note: occupancy query reports %d workgroups per CU\n", per_cu);
        (void)hipGetLastError();
        grid = cus;
    }
    if (grid < 0) return;
    if (hipMemsetAsync((char*)d_ws + WS_CTL, 0, CTL_ZERO_BYTES, stream) != hipSuccess) { fprintf(stderr, "kernel_launch: hipMemsetAsync failed; nothing launched\n"); return; }
    Args a{};
    { const float** pp = (const float**)&a.P; for (int i = 0; i < 26; ++i) pp[i] = (const float*)d_in[i]; }
    a.P.out = (float*)d_out; a.P.ws = (unsigned char*)d_ws; a.ph_lo = 0; a.ph_hi = NPHASE;
    hipLaunchKernelGGL(mk_fwd, dim3(grid), dim3(NWAVES * 64), LDS_BYTES, stream, a);
}
```

```cpp
#include <hip/hip_runtime.h>
#include <hip/hip_bf16.h>
#include <cstdio>
#include <cstdint>
#include <cmath>

#define GAS __attribute__((address_space(1)))
#define LAS __attribute__((address_space(3)))
typedef unsigned short bf16;
typedef unsigned v4u __attribute__((ext_vector_type(4)));
typedef float f32x4 __attribute__((ext_vector_type(4)));
typedef short bf16x8 __attribute__((ext_vector_type(8)));
typedef GAS unsigned gu32;
typedef GAS unsigned long long gu64;
#define RLX_AGENT __ATOMIC_RELAXED, __HIP_MEMORY_SCOPE_AGENT
#define LDS_WAIT() asm volatile("s_waitcnt lgkmcnt(0)" ::: "memory")
#define VM_WAIT() asm volatile("s_waitcnt vmcnt(0)" ::: "memory")
__device__ __forceinline__ unsigned f2bf(float f) { unsigned u = __builtin_bit_cast(unsigned, f); return (u + 0x7fffu + ((u >> 16) & 1u)) >> 16; }
__device__ __forceinline__ unsigned pk2(float lo, float hi) { return f2bf(lo) | (f2bf(hi) << 16); }

__device__ __forceinline__ int lane_id() { return (int)__builtin_amdgcn_mbcnt_hi(~0u, __builtin_amdgcn_mbcnt_lo(~0u, 0u)); }

constexpr int BATCH = 16, SEQ = 4096, D = 1024, M = BATCH * SEQ;
constexpr int NEXP = 32, TOPK = 4, NASSIGN = M * TOPK, FF = 1024, PLE = 256;
constexpr float LN_EPS = 1e-5f;
constexpr float ALPHA = 1.189207115002721f;
constexpr float C2Q = 0.125f * 1.4426950408889634f;

constexpr size_t MiB = 1u << 20;
constexpr size_t WS_CTL = 0, CTL_ZERO_BYTES = 1 * MiB;
constexpr size_t WS_LIST = 1 * MiB;
constexpr size_t WS_GATEL = 9 * MiB;
constexpr size_t WS_GATE = 17 * MiB;
constexpr size_t WS_WPCF = 18 * MiB;
constexpr size_t WS_WIN = 20 * MiB, WS_WCAT = 28 * MiB, WS_WOUT = 30 * MiB, WS_WPG = 32 * MiB, WS_WPP = 34 * MiB;
constexpr size_t WS_WDN = 36 * MiB, WS_WUP = 100 * MiB;
constexpr size_t WS_APO = 228 * MiB;
constexpr size_t WS_X1B = 228 * MiB;
constexpr size_t WS_Q = 356 * MiB, WS_K = 420 * MiB, WS_V = 484 * MiB, WS_U = 548 * MiB;
constexpr size_t WS_G = 612 * MiB;
constexpr size_t WS_O16 = 868 * MiB;
constexpr size_t WS_MIX = 356 * MiB;
constexpr size_t WS_HB = 356 * MiB;
constexpr size_t WS_YS = 100 * MiB, YS_STRIDE = 64 * MiB;
constexpr size_t WS_PRE1B = 612 * MiB;
constexpr size_t WS_STAT = 18 * MiB;
constexpr size_t WS_X1F8 = 900 * MiB;
constexpr size_t WS_PLE = 740 * MiB;
constexpr size_t WS_END = 1024 * MiB;
#ifndef MOE_FP8
#define MOE_FP8 1
#endif
constexpr float WUP_SCALE = 32.f, WDN_SCALE = 64.f;
#ifndef PROJ_F8_FROM
#define PROJ_F8_FROM 8
#endif
constexpr size_t WS_XF8 = 900 * MiB;
constexpr size_t WS_WIN8 = WS_WIN + (size_t)PROJ_F8_FROM * 256 * 1024 * 2;
#ifndef MIXG_FP8
#define MIXG_FP8 1
#endif
constexpr float APO_SCALE = 16.f;
constexpr float YS_SCALE = 16.f;
constexpr int cv_NBG = 790 + 64 + M / 256;
constexpr float ATT_SKIP = 40.f;
constexpr int CW_TMO = 0, CW_CODE = 1;
constexpr int CW_CNT = 64;
constexpr int CW_AQ = 128;
constexpr int CW_PQ = 130;
constexpr int CW_PN = 65536;
constexpr int CW_BAR = 4096;
namespace pg8 {
#define PG8_LAS __attribute__((address_space(3)))
typedef unsigned short bf16_t;
typedef unsigned u32x4 __attribute__((ext_vector_type(4)));
typedef float f32x2 __attribute__((ext_vector_type(2)));
constexpr int BM = 256, BK = 64, HALF = 128, HTB = HALF * BK * 2  , STAGE_BYTES = 8 * HTB, NXCD = 8, WGM = 8;
constexpr int TAB_OFF = 131072 + 1024;
constexpr int TAB_CNT = TAB_OFF, TAB_BLK0 = TAB_OFF + 128, TAB_ROW0 = TAB_OFF + 384, TAB_IDS = TAB_OFF + 1024, TAB_GATES = TAB_OFF + 1024 + 2048, TAB_BIAS = TAB_OFF + 1024 + 4096;

__host__ __device__ __forceinline__ int lds_byte(int r, int c) { const int st = (r >> 4) * 2 + (c >> 5), rr = r & 15, cc = c & 31, ob = rr * 64 + cc * 2; return st * 1024 + (ob ^ (((ob >> 9) & 1) << 5)); }
__host__ __device__ __forceinline__ void stage_rc(int b, int& R, int& C) { const int st = b / 1024, sb = b % 1024, swz = sb ^ (((sb >> 9) & 1) << 5); R = (st >> 1) * 16 + swz / 64; C = (st & 1) * 32 + (swz % 64) / 2; }
__host__ __device__ __forceinline__ int perm16h(int rho) { return 64 * (rho >> 5) + 16 * ((rho & 15) >> 2) + 4 * ((rho >> 4) & 1) + (rho & 3); }
__host__ __device__ __forceinline__ int perm32(int rho) { const int n = rho >> 4, i = rho & 15; return 8 * (i >> 2) + 4 * n + (i & 3); }

struct Unit { int pm, pn, e, nvalid; };
struct Gemm { const bf16_t* A; const bf16_t* Bt; int K; };

struct StaticOrder {
    static constexpr bool TABLES = false, FP8 = false;
    int nM, nN, nwg, G, c;
    __host__ __device__ void init(int M, int N, int G_, int c_) { nM = M / BM; nN = N / BM; nwg = nM * nN; G = G_; c = c_; }
    __device__ __forceinline__ bool next(int i, Unit& u, PG8_LAS unsigned char*) const {
        const long L = (long)i * G + c; if (L >= nwg) return false;
        int wgid = (int)L; { const int q = nwg / NXCD, r = nwg % NXCD, xcd = wgid % NXCD, off = wgid / NXCD; wgid = (xcd < r ? xcd * (q + 1) : r * (q + 1) + (xcd - r) * q) + off; }
        const int nig = WGM * nN, gid = wgid / nig, fm = gid * WGM, gsz = (nM - fm) < WGM ? (nM - fm) : WGM;
        u.pm = fm + ((wgid % nig) % gsz); u.pn = (wgid % nig) / gsz; u.e = 0; u.nvalid = 256; return true;
    }
    __device__ __forceinline__ const char* b_tile(const Gemm& g, const Unit& u) const { return (const char*)g.Bt + (size_t)u.pn * (size_t)(BM * 2) * g.K; }
    __device__ __forceinline__ void a_offsets(const Gemm& g, const Unit& u, PG8_LAS unsigned char*, int, const int (&R)[2], const int (&C)[2], unsigned (&off)[2][2]) const {
#pragma unroll
        for (int h = 0; h < 2; ++h)
#pragma unroll
            for (int i = 0; i < 2; ++i) off[h][i] = (unsigned)(((u.pm * BM + h * HALF + R[i]) * g.K + C[i]) * 2);
    }
    __device__ __forceinline__ void issue_tables(const Unit&, PG8_LAS unsigned char*, int, int) const {}
};

struct DenseF8Order : StaticOrder { static constexpr bool FP8 = true; };

template <bool GATHER_, bool FP8_> struct MoeOrder {
    static constexpr bool TABLES = true; static constexpr bool GATHER = GATHER_, FP8 = FP8_;
    int NT, G, c; const int* LIST; const float* GATEL; size_t bstride; const float* bias;
    __device__ __forceinline__ bool next(int i, Unit& u, PG8_LAS unsigned char* lds) const {
        const PG8_LAS int* cnt = (const PG8_LAS int*)(lds + TAB_CNT); const PG8_LAS int* blk0 = (const PG8_LAS int*)(lds + TAB_BLK0);
        int cp = c; if (G == 256) cp = NT == 8 ? (((c & 7) + 8 * (c >> 6)) * 8 + ((c >> 3) & 7)) : (((c & 7) + 8 * (c >> 5)) * 4 + ((c >> 3) & 3));
        const int L = i * G + cp; const int total = blk0[32] * NT; if (L >= total) return false;
        const int blk = L / NT;
        const int ln = (int)__builtin_amdgcn_mbcnt_hi(~0u, __builtin_amdgcn_mbcnt_lo(~0u, 0u)); const int bv = blk0[ln & 31];
        const int e = __builtin_popcountll(__builtin_amdgcn_ballot_w64(ln >= 1 && ln < 32 && blk >= bv));
        u.e = e; u.pm = __builtin_amdgcn_readfirstlane(blk - blk0[e]); u.pn = L % NT; const int left = __builtin_amdgcn_readfirstlane(cnt[e]) - 256 * u.pm; u.nvalid = left < 256 ? left : 256; return true;
    }
    __device__ __forceinline__ const char* b_tile(const Gemm& g, const Unit& u) const { return (const char*)g.Bt + (size_t)u.e * bstride + (size_t)u.pn * (size_t)(BM * 2) * g.K; }
    __device__ __forceinline__ void a_offsets(const Gemm& g, const Unit& u, PG8_LAS unsigned char* lds, int buf, const int (&R)[2], const int (&C)[2], unsigned (&off)[2][2]) const {
        const PG8_LAS int* ids = (const PG8_LAS int*)(lds + TAB_IDS) + buf * 256; const PG8_LAS int* row0 = (const PG8_LAS int*)(lds + TAB_ROW0);
#pragma unroll
        for (int h = 0; h < 2; ++h)
#pragma unroll
            for (int i = 0; i < 2; ++i) { const int r = h * HALF + R[i];
                if (GATHER) { const int tok = (r < u.nvalid) ? (ids[r] >> 2) : 0; off[h][i] = (unsigned)((tok * g.K + C[i]) * 2); }
                else off[h][i] = (unsigned)(((row0[u.e] + u.pm * BM + r) * g.K + C[i]) * 2); }
    }
    __device__ __forceinline__ void issue_tables(const Unit& u, PG8_LAS unsigned char* lds, int buf, int lane) const {
        const size_t o = (size_t)u.e * 65536 + (size_t)u.pm * 256 + lane * 4;
        __builtin_amdgcn_global_load_lds((const unsigned*)(LIST + o), (PG8_LAS unsigned*)(lds + TAB_IDS + buf * 1024), 16, 0, 0);
        if (!GATHER) __builtin_amdgcn_global_load_lds((const unsigned*)(GATEL + o), (PG8_LAS unsigned*)(lds + TAB_GATES + buf * 1024), 16, 0, 0);
        const float* bsrc = GATHER ? bias + (size_t)u.e * 2048 + (lane >> 5) * 1024 + u.pn * 128 + (lane & 31) * 4 : bias + (size_t)u.e * 1024 + u.pn * 256 + lane * 4;
        __builtin_amdgcn_global_load_lds((const unsigned*)bsrc, (PG8_LAS unsigned*)(lds + TAB_BIAS + buf * 1024), 16, 0, 0);
    }
};

__device__ __forceinline__ unsigned cvt_pk_bf16(float lo, float hi) { unsigned r; asm volatile("v_cvt_pk_bf16_f32 %0, %1, %2" : "=v"(r) : "v"(lo), "v"(hi)); return r; }
__device__ __forceinline__ float bflo(unsigned w) { return __builtin_bit_cast(float, w << 16); }
__device__ __forceinline__ float bfhi(unsigned w) { return __builtin_bit_cast(float, w & 0xffff0000u); }
__device__ __forceinline__ float sigm(float v) { return __builtin_amdgcn_rcpf(1.f + __builtin_amdgcn_exp2f(-1.4426950408889634f * v)); }
__device__ __forceinline__ u32x4 pack8(const f32x4& v0, const f32x4& v1) { u32x4 w; w.x = cvt_pk_bf16(v0[0], v0[1]); w.y = cvt_pk_bf16(v0[2], v0[3]); w.z = cvt_pk_bf16(v1[0], v1[1]); w.w = cvt_pk_bf16(v1[2], v1[3]); return w; }
__device__ __forceinline__ void unpack8(const u32x4& w, f32x4& v0, f32x4& v1) { v0 = (f32x4){bflo(w.x), bfhi(w.x), bflo(w.y), bfhi(w.y)}; v1 = (f32x4){bflo(w.z), bfhi(w.z), bflo(w.w), bfhi(w.w)}; }
typedef f32x4 Acc[2][2][4][2];
typedef int i32x4 __attribute__((ext_vector_type(4)));
typedef int i32x8 __attribute__((ext_vector_type(8)));
struct bf16x8p { bf16x8 k[2]; };
template <bool F8> struct Frag { typedef bf16x8p T; };
template <> struct Frag<true> { typedef i32x8 T; };
__device__ __forceinline__ void frag_set(i32x8& d, const i32x4& lo, const i32x4& hi) { d = __builtin_shufflevector(lo, hi, 0, 1, 2, 3, 4, 5, 6, 7); }
__device__ __forceinline__ void frag_set(bf16x8p& d, const bf16x8& lo, const bf16x8& hi) { d.k[0] = lo; d.k[1] = hi; }
__device__ __forceinline__ void frag_mma(f32x4& c, const i32x8& b, const i32x8& a) { c = __builtin_amdgcn_mfma_scale_f32_16x16x128_f8f6f4(b, a, c, 0, 0, 0, 0, 0, 0); }
__device__ __forceinline__ void frag_mma(f32x4& c, const bf16x8p& b, const bf16x8p& a) { c = __builtin_amdgcn_mfma_f32_16x16x32_bf16(b.k[0], a.k[0], c, 0, 0, 0); c = __builtin_amdgcn_mfma_f32_16x16x32_bf16(b.k[1], a.k[1], c, 0, 0, 0); }
__device__ __forceinline__ unsigned pk4_fp8(float a, float b, float c, float d) { unsigned w = __builtin_amdgcn_cvt_pk_fp8_f32(a, b, 0u, false); return __builtin_amdgcn_cvt_pk_fp8_f32(c, d, w, true); }
template <class E> struct has_p16 { template <class T> static constexpr bool f(decltype(T::PERM16)*) { return T::PERM16; } template <class T> static constexpr bool f(...) { return false; } static constexpr bool value = f<E>(nullptr); };
template <class E> struct has_mid { template <class T> static constexpr bool f(decltype(T::MID)*) { return T::MID; } template <class T> static constexpr bool f(...) { return false; } static constexpr bool value = f<E>(nullptr); };

struct EpiProj {
    static constexpr bool PERM = true; static constexpr int NSTORES = 16;
    bf16_t *Q, *K, *V, *U, *G; const float* bg; float* PN; float c2; float dsc; int pn_base; int pad;
    __device__ __forceinline__ void operator()(const Acc& acc, const Unit& u, int wr, int wc, int fr_, int fq_, PG8_LAS unsigned char* lds, int) const {
        int fr = fr_, fq = fq_; asm volatile("" : "+v"(fr), "+v"(fq));
        const int pn = u.pn + pn_base; const int row0 = u.pm * BM + wr * 64 + fr; const bool isg = pn >= 8;
        bf16_t* base; int ldc, colt, bjs; float sc = dsc;
        if (isg) { base = G; ldc = 2048; colt = (pn - 8) * HALF; bjs = 1024; } else { const int t = pn >> 1; base = t == 0 ? Q : t == 1 ? K : t == 2 ? V : U; ldc = 512; colt = (pn & 1) * BM; bjs = HALF; if (t == 0) sc = c2 * dsc; }
        const int col0 = colt + wc * 32 + 8 * fq;
        f32x4 bv[2][2];
#pragma unroll
        for (int bj = 0; bj < 2; ++bj)
#pragma unroll
            for (int n = 0; n < 2; ++n) bv[bj][n] = isg ? *(const PG8_LAS f32x4*)((const PG8_LAS float*)(lds + TAB_OFF) + col0 + bj * bjs + 4 * n) : (f32x4){0.f, 0.f, 0.f, 0.f};
#pragma unroll
        for (int ai = 0; ai < 2; ++ai)
#pragma unroll
            for (int m = 0; m < 4; ++m) { bf16_t* rowp = base + (size_t)(row0 + ai * HALF + m * 16) * ldc + col0;
                f32x4 v[2][2];
#pragma unroll
                for (int bj = 0; bj < 2; ++bj)
#pragma unroll
                    for (int n = 0; n < 2; ++n) v[bj][n] = acc[ai][bj][m][n] * sc + bv[bj][n];
                if (isg) {
#pragma unroll
                    for (int n = 0; n < 2; ++n)
#pragma unroll
                        for (int i = 0; i < 4; ++i) { const float ga = sigm(v[0][n][i]), gp = sigm(v[1][n][i]); v[0][n][i] = ga * __builtin_amdgcn_rcpf(fmaxf(gp, 8.67e-19f)); v[1][n][i] = gp; } }
#pragma unroll
                for (int bj = 0; bj < 2; ++bj) *(u32x4*)(rowp + bj * bjs) = pack8(v[bj][0], v[bj][1]); }
        if (pn < 4) {
            float* tab = PN + (pn >> 1) * 16384; const int R0 = u.pm * BM, b = R0 >> 12;
#pragma unroll
            for (int ai = 0; ai < 2; ++ai)
#pragma unroll
                for (int bj = 0; bj < 2; ++bj) { float mx = 0.f;
#pragma unroll
                    for (int m = 0; m < 4; ++m) { f32x4 v0 = acc[ai][bj][m][0] * sc, v1 = acc[ai][bj][m][1] * sc;
                        float s = (v0[0] * v0[0] + v0[1] * v0[1]) + (v0[2] * v0[2] + v0[3] * v0[3]) + (v1[0] * v1[0] + v1[1] * v1[1]) + (v1[2] * v1[2] + v1[3] * v1[3]);
                        s += __shfl_xor(s, 16); s += __shfl_xor(s, 32); mx = fmaxf(mx, s); }
                    mx = fmaxf(mx, __shfl_xor(mx, 1)); mx = fmaxf(mx, __shfl_xor(mx, 2)); mx = fmaxf(mx, __shfl_xor(mx, 4)); mx = fmaxf(mx, __shfl_xor(mx, 8));
                    const int tile = ((R0 & 4095) >> 6) + 2 * ai + wr, hm = (pn & 1) * 4 + 2 * bj + (wc >> 1);
                    if (fr == 0 && fq == 0) tab[((b * 8 + hm) * 64 + tile) * 2 + (wc & 1)] = mx; }
        }
    }
};
struct EpiMixCat {
    static constexpr bool PERM = true, MID = true; static constexpr int NSTORES = 16;
    bf16_t* MIX; const bf16_t* G; float dsc; int pad;
    __device__ __forceinline__ void mid(Acc& acc, const Unit& u, int wr, int wc, int fr_, int fq_) const {
        int fr = fr_, fq = fq_; asm volatile("" : "+v"(fr), "+v"(fq));
        const int row0 = u.pm * BM + wr * 64 + fr, col0 = u.pn * BM + wc * 32 + 8 * fq;
        u32x4 w[16];
#pragma unroll
        for (int k = 0; k < 16; ++k) w[k] = *(const u32x4*)(G + (size_t)(row0 + (k >> 3) * HALF + ((k >> 1) & 3) * 16) * 2048 + col0 + (k & 1) * HALF);
        asm volatile("" : "+v"(w[0]), "+v"(w[1]), "+v"(w[2]), "+v"(w[3]), "+v"(w[4]), "+v"(w[5]), "+v"(w[6]), "+v"(w[7]), "+v"(w[8]), "+v"(w[9]), "+v"(w[10]), "+v"(w[11]), "+v"(w[12]), "+v"(w[13]), "+v"(w[14]), "+v"(w[15]));
#pragma unroll
        for (int k = 0; k < 16; ++k) { const int ai = k >> 3, m = (k >> 1) & 3, bj = k & 1; f32x4 a0, a1; unpack8(w[k], a0, a1); acc[ai][bj][m][0] *= a0; acc[ai][bj][m][1] *= a1; }
        asm volatile("" ::: "memory");
    }
    __device__ __forceinline__ void operator()(const Acc& acc, const Unit& u, int wr, int wc, int fr_, int fq_, PG8_LAS unsigned char*, int) const {
        int fr = fr_, fq = fq_; asm volatile("" : "+v"(fr), "+v"(fq));
        const int row0 = u.pm * BM + wr * 64 + fr, col0 = u.pn * BM + wc * 32 + 8 * fq;
        u32x4 w[16];
#pragma unroll
        for (int k = 0; k < 16; ++k) w[k] = *(const u32x4*)(G + (size_t)(row0 + (k >> 3) * HALF + ((k >> 1) & 3) * 16) * 2048 + 1024 + col0 + (k & 1) * HALF);
        asm volatile("" : "+v"(w[0]), "+v"(w[1]), "+v"(w[2]), "+v"(w[3]), "+v"(w[4]), "+v"(w[5]), "+v"(w[6]), "+v"(w[7]), "+v"(w[8]), "+v"(w[9]), "+v"(w[10]), "+v"(w[11]), "+v"(w[12]), "+v"(w[13]), "+v"(w[14]), "+v"(w[15]));
#pragma unroll
        for (int k = 0; k < 16; ++k) { const int ai = k >> 3, m = (k >> 1) & 3, bj = k & 1; f32x4 p0, p1; unpack8(w[k], p0, p1);
#pragma unroll
            for (int i = 0; i < 4; ++i) { p0[i] = fmaxf(p0[i], 8.67e-19f) * dsc; p1[i] = fmaxf(p1[i], 8.67e-19f) * dsc; }
            *(u32x4*)(MIX + (size_t)(row0 + ai * HALF + m * 16) * 1024 + col0 + bj * HALF) = pack8(acc[ai][bj][m][0] * p0, acc[ai][bj][m][1] * p1); }
        asm volatile("" ::: "memory");
    }
};
struct EpiPre1 {
    static constexpr bool PERM = true; static constexpr int NSTORES = 16;
    bf16_t* out; const bf16_t* x; float alpha; int pad;
    __device__ __forceinline__ void operator()(const Acc& acc, const Unit& u, int wr, int wc, int fr_, int fq_, PG8_LAS unsigned char*, int) const {
        int fr = fr_, fq = fq_; asm volatile("" : "+v"(fr), "+v"(fq));
        const int row0 = u.pm * BM + wr * 64 + fr, col0 = u.pn * BM + wc * 32 + 8 * fq;
        u32x4 w[16];
#pragma unroll
        for (int k = 0; k < 16; ++k) w[k] = *(const u32x4*)(x + (size_t)(row0 + (k >> 3) * HALF + ((k >> 1) & 3) * 16) * 1024 + col0 + (k & 1) * HALF);
        asm volatile("" : "+v"(w[0]), "+v"(w[1]), "+v"(w[2]), "+v"(w[3]), "+v"(w[4]), "+v"(w[5]), "+v"(w[6]), "+v"(w[7]), "+v"(w[8]), "+v"(w[9]), "+v"(w[10]), "+v"(w[11]), "+v"(w[12]), "+v"(w[13]), "+v"(w[14]), "+v"(w[15]));
#pragma unroll
        for (int k = 0; k < 16; ++k) { const int ai = k >> 3, m = (k >> 1) & 3, bj = k & 1; f32x4 x0, x1; unpack8(w[k], x0, x1);
            *(u32x4*)(out + (size_t)(row0 + ai * HALF + m * 16) * 1024 + col0 + bj * HALF) = pack8(x0 * alpha + acc[ai][bj][m][0], x1 * alpha + acc[ai][bj][m][1]); }
        asm volatile("" ::: "memory");
    }
};
template <int MODE> struct EpiPle {
    static constexpr bool PERM = true; static constexpr int NSTORES = 16;
    bf16_t* out; const bf16_t* T; const bf16_t* PRE; const float* stat; const float* lng; const float* lnb; float dsc; float alpha;
    __device__ __forceinline__ void operator()(const Acc& acc, const Unit& u, int wr, int wc, int fr_, int fq_, PG8_LAS unsigned char*, int) const {
        int fr = fr_, fq = fq_; asm volatile("" : "+v"(fr), "+v"(fq));
        const int row0 = u.pm * BM + wr * 64 + fr, col0 = u.pn * BM + wc * 32 + 8 * fq;
        f32x4 ag[2][2], ab[2][2];
        if (MODE == 3) {
#pragma unroll
            for (int bj = 0; bj < 2; ++bj)
#pragma unroll
                for (int h = 0; h < 2; ++h) { ag[bj][h] = *(const f32x4*)(lng + col0 + bj * HALF + 4 * h) * alpha; ab[bj][h] = *(const f32x4*)(lnb + col0 + bj * HALF + 4 * h) * alpha; } }
#pragma unroll
        for (int ai = 0; ai < 2; ++ai)
#pragma unroll
            for (int mp = 0; mp < 2; ++mp) { u32x4 w[8]; f32x2 st[2];
                if (MODE == 3) {
#pragma unroll
                    for (int k = 0; k < 4; ++k) { const size_t o = (size_t)(row0 + ai * HALF + (2 * mp + (k >> 1)) * 16) * 1024 + col0 + (k & 1) * HALF; w[2 * k] = *(const u32x4*)(T + o); w[2 * k + 1] = *(const u32x4*)(PRE + o); }
#pragma unroll
                    for (int q = 0; q < 2; ++q) st[q] = *(const f32x2*)(stat + 2 * (size_t)(row0 + ai * HALF + (2 * mp + q) * 16));
                    asm volatile("" : "+v"(w[0]), "+v"(w[1]), "+v"(w[2]), "+v"(w[3]), "+v"(w[4]), "+v"(w[5]), "+v"(w[6]), "+v"(w[7]), "+v"(st[0]), "+v"(st[1]));
                }
#pragma unroll
                for (int k = 0; k < 4; ++k) { const int m = 2 * mp + (k >> 1), bj = k & 1; const size_t o = (size_t)(row0 + ai * HALF + m * 16) * 1024 + col0 + bj * HALF; f32x4 v0 = acc[ai][bj][m][0], v1 = acc[ai][bj][m][1];
                    if (MODE == 3) { f32x4 t0, t1, x0, x1; unpack8(w[2 * k], t0, t1); unpack8(w[2 * k + 1], x0, x1); const float s = st[k >> 1][1], ms = -st[k >> 1][0] * s;
#pragma unroll
                        for (int i = 0; i < 4; ++i) { v0[i] = sigm(v0[i] * dsc) * t0[i] + ((x0[i] * s + ms) * ag[bj][0][i] + ab[bj][0][i]); v1[i] = sigm(v1[i] * dsc) * t1[i] + ((x1[i] * s + ms) * ag[bj][1][i] + ab[bj][1][i]); } }
                    *(u32x4*)(out + o) = pack8(v0, v1); }
                if (MODE == 3) asm volatile("" ::: "memory"); }
    }
};
template <bool F8> struct EpiUp {
    static constexpr bool PERM = true; static constexpr int NSTORES = F8 ? 4 : 8;
    void* HB; const float* bup; float dsc; int pad;
    __device__ __forceinline__ void operator()(const Acc& acc, const Unit& u, int wr, int wc, int fr_, int fq_, PG8_LAS unsigned char* lds, int buf) const {
        int fr = fr_, fq = fq_; asm volatile("" : "+v"(fr), "+v"(fq));
        const PG8_LAS int* row0t = (const PG8_LAS int*)(lds + TAB_ROW0); const int srow = row0t[u.e] + u.pm * BM;
        const int c0 = u.pn * HALF + wc * 32 + 8 * fq; const PG8_LAS float* bp = (const PG8_LAS float*)(lds + TAB_BIAS + buf * 1024) + wc * 32 + 8 * fq;
        const f32x4 bg0 = *(const PG8_LAS f32x4*)(bp), bg1 = *(const PG8_LAS f32x4*)(bp + 4), bl0 = *(const PG8_LAS f32x4*)(bp + 128) + 1.f, bl1 = *(const PG8_LAS f32x4*)(bp + 132) + 1.f;
#pragma unroll
        for (int ai = 0; ai < 2; ++ai)
#pragma unroll
            for (int mp = 0; mp < 2; ++mp) { unsigned xw[2][2];
#pragma unroll
                for (int mm = 0; mm < 2; ++mm) { const int m = 2 * mp + mm, r = ai * HALF + wr * 64 + m * 16 + fr;
                    f32x4 g0 = acc[ai][0][m][0] * dsc + bg0, g1 = acc[ai][0][m][1] * dsc + bg1, l0 = acc[ai][1][m][0] * dsc + bl0, l1 = acc[ai][1][m][1] * dsc + bl1;
#pragma unroll
                    for (int h = 0; h < 4; ++h) { constexpr float CS = -1.702f * 1.4426950408889634f;
                        f32x4& gg = (h < 2) ? g0 : g1; const f32x4& ll = (h < 2) ? l0 : l1; const int i = 2 * (h & 1);
                        const f32x2 a = {fminf(gg[i], 7.f), fminf(gg[i + 1], 7.f)}, b = {fminf(fmaxf(ll[i], -6.f), 8.f), fminf(fmaxf(ll[i + 1], -6.f), 8.f)};
                        const f32x2 t = a * CS; const f32x2 e = {__builtin_amdgcn_exp2f(t[0]), __builtin_amdgcn_exp2f(t[1])}; const f32x2 d = e + 1.f;
                        const f32x2 rc = {__builtin_amdgcn_rcpf(d[0]), __builtin_amdgcn_rcpf(d[1])}; const f32x2 y = (a * rc) * b; gg[i] = y[0]; gg[i + 1] = y[1]; }
                    if (F8) { xw[mm][0] = pk4_fp8(g0[0], g0[1], g0[2], g0[3]); xw[mm][1] = pk4_fp8(g1[0], g1[1], g1[2], g1[3]); }
                    else if (r < u.nvalid) *(u32x4*)((bf16_t*)HB + (size_t)(srow + r) * 1024 + c0) = pack8(g0, g1); }
                if (F8) {
                    const auto s0 = __builtin_amdgcn_permlane16_swap(xw[0][0], xw[1][0], false, false), s1 = __builtin_amdgcn_permlane16_swap(xw[0][1], xw[1][1], false, false);
                    const int r = ai * HALF + wr * 64 + (2 * mp + (fq & 1)) * 16 + fr;
                    if (r < u.nvalid) { u32x4 w; w.x = s0[0]; w.y = s1[0]; w.z = s0[1]; w.w = s1[1]; *(u32x4*)((unsigned char*)HB + (size_t)(srow + r) * 1024 + (c0 & ~15)) = w; } } }
    }
};
struct EpiDown {
    static constexpr bool PERM = true, PERM16 = true; static constexpr int NSTORES = 8;
    unsigned char* YS; size_t rstride; const float* bdn; float dsc; float osc;
    __device__ __forceinline__ void operator()(const Acc& acc, const Unit& u, int wr, int wc, int fr_, int fq_, PG8_LAS unsigned char* lds, int buf) const {
        int fr = fr_, fq = fq_; asm volatile("" : "+v"(fr), "+v"(fq));
        const PG8_LAS int* ids = (const PG8_LAS int*)(lds + TAB_IDS) + buf * 256; const PG8_LAS float* gates = (const PG8_LAS float*)(lds + TAB_GATES) + buf * 256;
        const int col0 = u.pn * BM + wc * 64 + 16 * fq; const PG8_LAS float* bp = (const PG8_LAS float*)(lds + TAB_BIAS + buf * 1024) + wc * 64 + 16 * fq;
        f32x4 bv[2][2];
#pragma unroll
        for (int bj = 0; bj < 2; ++bj)
#pragma unroll
            for (int n = 0; n < 2; ++n) bv[bj][n] = *(const PG8_LAS f32x4*)(bp + 8 * bj + 4 * n);
#pragma unroll
        for (int ai = 0; ai < 2; ++ai)
#pragma unroll
            for (int m = 0; m < 4; ++m) { const int r = ai * HALF + wr * 64 + m * 16 + fr;
                if (r < u.nvalid) { const int a = ids[r]; const float gs = gates[r] * osc; const size_t o = (size_t)(a & 3) * rstride + (size_t)(a >> 2) * 1024 + col0;
                    u32x4 w; unsigned* wp = (unsigned*)&w;
#pragma unroll
                    for (int bj = 0; bj < 2; ++bj)
#pragma unroll
                        for (int n = 0; n < 2; ++n) { const f32x4 v = (acc[ai][bj][m][n] * dsc + bv[bj][n]) * gs; wp[2 * bj + n] = pk4_fp8(v[0], v[1], v[2], v[3]); }
                    *(u32x4*)(YS + o) = w; } }
    }
};

template <class Epi, class Sched>
__device__ __forceinline__ void gemm_phase(PG8_LAS unsigned char* lds, const int wid, const Gemm g, const Sched& S, const Epi& E) {
    int lane = lane_id(); asm volatile("" : "+v"(lane));
    const int tid = wid * 64 + lane, wr = wid >> 2, wc = wid & 3, fr = lane & 15, fq = lane >> 4;
    const int K = g.K, nt = K / BK;
    int RA[2], CA[2]; unsigned voffA[2], voffB[2];
#pragma unroll
    for (int i = 0; i < 2; ++i) { int R, C; stage_rc(tid * 16 + i * 8192, R, C); const int Rb = has_p16<Epi>::value ? perm16h(R) : Epi::PERM ? ((R & ~31) + perm32(R & 31)) : R; RA[i] = R; CA[i] = C; voffA[i] = (unsigned)(R * K + C) * 2u; voffB[i] = (unsigned)(Rb * K + C) * 2u; }
    const size_t tstep = (size_t)BM * K * 2;
    const size_t kstep = (size_t)(BK * 2);
    const size_t hstep = (size_t)HALF * K * 2;
    const size_t bstep = has_p16<Epi>::value ? (size_t)8 * K * 2 : hstep;
    const unsigned ldsw = (unsigned)wid * 1024u;
    const int aoff = lds_byte(wr * 64 + fr, fq * 8), boff = lds_byte(wc * 32 + fr, fq * 8);
#define PG8_SA(b, h) (((b) * 2 + (h)) * HTB)
#define PG8_SB(b, h) ((4 + (b) * 2 + (h)) * HTB)
#define PG8_STAGE(bufoff, gbase, voff) do { _Pragma("unroll") for (int _i = 0; _i < 2; ++_i) \
        __builtin_amdgcn_global_load_lds((const unsigned*)((const char*)(gbase) + (voff)[_i]), (PG8_LAS unsigned*)(lds + (bufoff) + ldsw + _i * 8192), 16, 0, 0); } while (0)
#define PG8_STAGE_A(bufoff, ubase, h, OFF) do { if constexpr (Sched::TABLES) PG8_STAGE(bufoff, ubase, OFF[h]); else PG8_STAGE(bufoff, (ubase) + ((h) ? hstep : 0), voffA); } while (0)
#define PG8_LDA(dst, b, h) do { _Pragma("unroll") for (int m = 0; m < 4; ++m) { if constexpr (Sched::FP8) dst##8[m] = __builtin_shufflevector(*(const PG8_LAS i32x4*)(lds + PG8_SA(b, h) + aoff + m * 2048), *(const PG8_LAS i32x4*)(lds + PG8_SA(b, h) + aoff + m * 2048 + 1024), 0, 1, 2, 3, 4, 5, 6, 7); \
        else { _Pragma("unroll") for (int k = 0; k < 2; ++k) dst[m][k] = *(const PG8_LAS bf16x8*)(lds + PG8_SA(b, h) + aoff + m * 2048 + k * 1024); } } } while (0)
#define PG8_LDB(dst, b, h) do { _Pragma("unroll") for (int n = 0; n < 2; ++n) { if constexpr (Sched::FP8) dst##8[n] = __builtin_shufflevector(*(const PG8_LAS i32x4*)(lds + PG8_SB(b, h) + boff + n * 2048), *(const PG8_LAS i32x4*)(lds + PG8_SB(b, h) + boff + n * 2048 + 1024), 0, 1, 2, 3, 4, 5, 6, 7); \
        else { _Pragma("unroll") for (int k = 0; k < 2; ++k) dst[n][k] = *(const PG8_LAS bf16x8*)(lds + PG8_SB(b, h) + boff + n * 2048 + k * 1024); } } } while (0)
#define PG8_MMA(ai, bj, At, Bt) do { __builtin_amdgcn_s_setprio(1); if constexpr (Sched::FP8) asm volatile("s_nop 1"); _Pragma("unroll") for (int m = 0; m < 4; ++m) _Pragma("unroll") for (int n = 0; n < 2; ++n) { \
        if constexpr (Sched::FP8) asm volatile("v_mfma_f32_16x16x128_f8f6f4 %0, %1, %2, %0" : "+v"(acc[ai][bj][m][n]) : "v"(Bt##8[n]), "v"(At##8[m]));   \
        else { _Pragma("unroll") for (int k = 0; k < 2; ++k) acc[ai][bj][m][n] = __builtin_amdgcn_mfma_f32_16x16x32_bf16(Bt[n][k], At[m][k], acc[ai][bj][m][n], 0, 0, 0); } } __builtin_amdgcn_s_setprio(0); } while (0)
#define PG8_WAIT_V(n) asm volatile("s_waitcnt vmcnt(" #n ")" ::: "memory")
#define PG8_WAIT_V8R(relax) do { if (relax) asm volatile("s_waitcnt vmcnt(%0)" :: "n"(8 + Epi::NSTORES) : "memory"); else asm volatile("s_waitcnt vmcnt(8)" ::: "memory"); } while (0)
#define PG8_WAIT_L(n) asm volatile("s_waitcnt lgkmcnt(" #n ")" ::: "memory")
#define PG8_BAR __builtin_amdgcn_s_barrier()
#define PG8_SCHED __builtin_amdgcn_sched_barrier(0)
    Unit cur, nxt; int ui = 0; bool prev_full = false;
    if (!S.next(0, cur, lds)) return;
    if constexpr (Sched::TABLES) {
        if (wid == 0) S.issue_tables(cur, lds, 0, lane);
        PG8_WAIT_V(0); PG8_BAR;
    }
    Acc acc;
#pragma unroll
    for (int a = 0; a < 2; ++a)
#pragma unroll
        for (int b = 0; b < 2; ++b)
#pragma unroll
            for (int m = 0; m < 4; ++m)
#pragma unroll
                for (int n = 0; n < 2; ++n) acc[a][b][m][n] = (f32x4){0.f, 0.f, 0.f, 0.f};
    bf16x8 At[4][2], B0[2][2], B1[2][2];
    i32x8 At8[4], B08[2], B18[2];
    unsigned offc[2][2], offn[2][2];
    if constexpr (Sched::TABLES) { S.a_offsets(g, cur, lds, 0, RA, CA, offc);
#pragma unroll
        for (int h = 0; h < 2; ++h)
#pragma unroll
            for (int i = 0; i < 2; ++i) offn[h][i] = offc[h][i]; }
    const char* const Ab = (const char*)g.A;
    const char* cA = Sched::TABLES ? Ab : Ab + (size_t)cur.pm * tstep;
    const char* cB = S.b_tile(g, cur);
    PG8_STAGE(PG8_SB(0, 0), cB, voffB); PG8_STAGE(PG8_SB(0, 1), cB + bstep, voffB); PG8_STAGE_A(PG8_SA(0, 0), cA, 0, offc); PG8_STAGE_A(PG8_SA(0, 1), cA, 1, offc);
    if (wr == 1) PG8_BAR;
    PG8_WAIT_V(2); PG8_BAR;
    PG8_STAGE(PG8_SB(1, 0), cB + kstep, voffB); PG8_STAGE_A(PG8_SA(1, 0), cA + kstep, 0, offc); PG8_STAGE(PG8_SB(1, 1), cB + bstep + kstep, voffB);
    PG8_WAIT_V(6); PG8_BAR;
    for (;;) {
        const bool has_next = S.next(ui + 1, nxt, lds);
        const char* nB = has_next ? S.b_tile(g, nxt) : cB;
        const char* nA = Sched::TABLES ? Ab : (has_next ? Ab + (size_t)nxt.pm * tstep : cA);
#pragma nounroll
        for (int t = 0; t < nt; t += 2) {
            const bool last = (t == nt - 2);
            const bool relax = (t == 0) && prev_full;
            const bool pre11 = (t == 0) && (ui > 0);
            if constexpr (has_mid<Epi>::value) { if (t == nt / 2) E.mid(acc, cur, wr, wc, fr, fq); }
            if constexpr (Sched::TABLES) {
                if (t == 2 && has_next && wid == 0) S.issue_tables(nxt, lds, (ui + 1) & 1, lane);
                if (t == (nt >= 16 ? nt - 6 : nt - 2) && has_next) S.a_offsets(g, nxt, lds, (ui + 1) & 1, RA, CA, offn);
            }
            unsigned o2[2][2];
            if constexpr (Sched::TABLES) {
#pragma unroll
                for (int h = 0; h < 2; ++h)
#pragma unroll
                    for (int i = 0; i < 2; ++i) o2[h][i] = last ? offn[h][i] : offc[h][i]; }
            const char* a1 = cA + (size_t)(t + 1) * kstep;
            const char* a2 = last ? nA : cA + (size_t)(t + 2) * kstep; const char* b2 = last ? nB : cB + (size_t)(t + 2) * kstep;
            const char* a3 = a2 + kstep; const char* b3 = b2 + kstep;
            PG8_LDB(B0, 0, 0); PG8_LDB(B1, 0, 1); PG8_SCHED; PG8_LDA(At, 0, 0); if (!pre11) PG8_STAGE_A(PG8_SA(1, 1), a1, 1, offc);
            PG8_WAIT_V8R(relax); PG8_WAIT_L(0); PG8_BAR; PG8_MMA(0, 0, At, B0); PG8_MMA(0, 1, At, B1); PG8_BAR; PG8_SCHED;
            PG8_LDA(At, 0, 1); PG8_STAGE(PG8_SB(0, 0), b2, voffB); PG8_STAGE(PG8_SB(0, 1), b2 + bstep, voffB); PG8_STAGE_A(PG8_SA(0, 0), a2, 0, o2);
            PG8_WAIT_V8R(relax); PG8_WAIT_L(0); PG8_BAR; PG8_MMA(1, 0, At, B0); PG8_MMA(1, 1, At, B1); PG8_BAR; PG8_SCHED;
            PG8_LDB(B0, 1, 0); PG8_LDB(B1, 1, 1); PG8_SCHED; PG8_LDA(At, 1, 0); PG8_STAGE_A(PG8_SA(0, 1), a2, 1, o2);
            PG8_WAIT_V8R(relax && pre11); PG8_WAIT_L(0); PG8_BAR; PG8_MMA(0, 0, At, B0); PG8_MMA(0, 1, At, B1); PG8_BAR; PG8_SCHED;
            PG8_LDA(At, 1, 1); PG8_STAGE(PG8_SB(1, 0), b3, voffB); PG8_STAGE(PG8_SB(1, 1), b3 + bstep, voffB); PG8_STAGE_A(PG8_SA(1, 0), a3, 0, o2);
            PG8_WAIT_V(8); PG8_WAIT_L(0); PG8_BAR; PG8_MMA(1, 0, At, B0); PG8_MMA(1, 1, At, B1); PG8_BAR; PG8_SCHED;
        }
        if (wr == 0) PG8_BAR;
        if (has_next) PG8_STAGE_A(PG8_SA(1, 1), nA + kstep, 1, offn);
        E(acc, cur, wr, wc, fr, fq, lds, ui & 1);
        if (!has_next) break;
#pragma unroll
        for (int a = 0; a < 2; ++a)
#pragma unroll
            for (int b = 0; b < 2; ++b)
#pragma unroll
                for (int m = 0; m < 4; ++m)
#pragma unroll
                    for (int n = 0; n < 2; ++n) acc[a][b][m][n] = (f32x4){0.f, 0.f, 0.f, 0.f};
        prev_full = (cur.nvalid == 256); cur = nxt; cB = nB; cA = nA; ++ui;
        if constexpr (Sched::TABLES) {
#pragma unroll
            for (int h = 0; h < 2; ++h)
#pragma unroll
                for (int i = 0; i < 2; ++i) offc[h][i] = offn[h][i]; }
        if (wr == 1) PG8_BAR;
    }
    PG8_WAIT_V(0);
    PG8_BAR;
#undef PG8_SA
#undef PG8_SB
#undef PG8_STAGE
#undef PG8_STAGE_A
#undef PG8_LDA
#undef PG8_LDB
#undef PG8_MMA
#undef PG8_WAIT_V
#undef PG8_WAIT_V8R
#undef PG8_WAIT_L
#undef PG8_BAR
#undef PG8_SCHED
}
}
namespace attn_body {
using bf16=__hip_bfloat16;
using bf16x8=__attribute__((ext_vector_type(8)))short;
using s16x4=__attribute__((ext_vector_type(4)))short;
using f32x16=__attribute__((ext_vector_type(16)))float;
using u32x4=__attribute__((ext_vector_type(4)))unsigned;
using f32x4_=__attribute__((ext_vector_type(4)))float;
constexpr int BATCH=16,SEQ=4096,D=64,DM=512,DMO=1024;
constexpr int NW=8,QBLK=32,QB=QBLK*NW,KVBLK=64,NQB=SEQ/QB;
constexpr int ATTN_UNIT_ROWS=QB;
__device__ __forceinline__ int crow(int r,int hi){return (r&3)+8*(r>>2)+4*hi;}
#define SBAR() __builtin_amdgcn_sched_barrier(0)
__device__ __forceinline__ void cmask(f32x16&p0,f32x16&p1,int jb,int qrel,int hi){
  const float NEG=-INFINITY; int kb=64*jb+4*hi; asm volatile("":"+v"(kb),"+v"(qrel));
  #pragma unroll
  for(int r=0;r<16;++r){int kv=kb+(r&3)+8*(r>>2); if(kv>qrel)p0[r]=NEG; if(kv+32>qrel)p1[r]=NEG;}
}

constexpr int NSLOT=3, SLOTB=8192, VSLOTB=16384;
constexpr int LDS_K=0, LDS_V=NSLOT*SLOTB, LDS_WS=NSLOT*SLOTB+NSLOT*VSLOTB, LDS_OST=LDS_WS+NW*64*4, LDS_BYTES=LDS_OST+NW*4096;
constexpr int LDS_LAM=LDS_BYTES+16, LDS_SUBLN=LDS_BYTES+256;
__device__ __forceinline__ u32x4 ld16_sc1(const void*p){u32x4 v;asm volatile("global_load_dwordx4 %0, %1, off sc1":"=v"(v):"v"(p):"memory");return v;}
constexpr float C2=0.125f*1.4426950408889634f;
__device__ __forceinline__ void glds16(const void*gsrc,unsigned lds_dst){unsigned keep;
  asm volatile("s_mov_b32 %0, m0\n\ts_mov_b32 m0, %2\n\ts_nop 0\n\tglobal_load_lds_dwordx4 %1, off\n\ts_mov_b32 m0, %0":"=&s"(keep):"v"(gsrc),"s"(lds_dst):"memory");}
__device__ __forceinline__ float max3f(float a,float b,float c){float r;asm("v_max3_f32 %0, %1, %2, %3":"=v"(r):"v"(a),"v"(b),"v"(c));return r;}
__device__ __forceinline__ float max2f(float a,float b){float r;asm("v_max_f32_e32 %0, %1, %2":"=v"(r):"v"(a),"v"(b));return r;}
__device__ __forceinline__ float fadd_s(float a,float b){float r;asm("v_add_f32_e32 %0, %1, %2":"=v"(r):"v"(a),"v"(b));return r;}
__device__ __forceinline__ float fsub_s(float a,float b){float r;asm("v_sub_f32_e32 %0, %1, %2":"=v"(r):"v"(a),"v"(b));return r;}
typedef float f32x2_t __attribute__((ext_vector_type(2))); typedef __bf16 bf16x2_t __attribute__((ext_vector_type(2)));
__device__ __forceinline__ unsigned cvtpk_s(float lo,float hi){f32x2_t v={lo,hi};bf16x2_t b=__builtin_convertvector(v,bf16x2_t);return __builtin_bit_cast(unsigned,b);}
#define WAIT_BAR(N) asm volatile("s_waitcnt vmcnt(" #N ") lgkmcnt(0)\n\ts_barrier":::"memory")

__device__ __forceinline__ void qkt(f32x16&p0,f32x16&p1,const char*Kslot,const bf16x8*qr,const f32x16&i0,const f32x16&i1,int r32,int hi){
  const char*kb=Kslot+hi*1024+r32*16;
  #pragma unroll
  for(int d0=0;d0<4;++d0){
    const bf16x8 b0=*reinterpret_cast<const bf16x8*>(kb+d0*2048);
    const bf16x8 b1=*reinterpret_cast<const bf16x8*>(kb+d0*2048+512);
    if(d0==0){p0=__builtin_amdgcn_mfma_f32_32x32x16_bf16(b0,qr[0],i0,0,0,0);p1=__builtin_amdgcn_mfma_f32_32x32x16_bf16(b1,qr[0],i1,0,0,0);}
    else{p0=__builtin_amdgcn_mfma_f32_32x32x16_bf16(b0,qr[d0],p0,0,0,0);p1=__builtin_amdgcn_mfma_f32_32x32x16_bf16(b1,qr[d0],p1,0,0,0);}}
}
typedef __attribute__((address_space(3))) const char* lds_cptr;
typedef short v4i16_t __attribute__((ext_vector_type(4)));
__device__ __forceinline__ void kload8(bf16x8*kf,lds_cptr kp){
  kf[0]=*(const __attribute__((address_space(3))) bf16x8*)(kp);      kf[1]=*(const __attribute__((address_space(3))) bf16x8*)(kp+512);
  kf[2]=*(const __attribute__((address_space(3))) bf16x8*)(kp+2048); kf[3]=*(const __attribute__((address_space(3))) bf16x8*)(kp+2560);
  kf[4]=*(const __attribute__((address_space(3))) bf16x8*)(kp+4096); kf[5]=*(const __attribute__((address_space(3))) bf16x8*)(kp+4608);
  kf[6]=*(const __attribute__((address_space(3))) bf16x8*)(kp+6144); kf[7]=*(const __attribute__((address_space(3))) bf16x8*)(kp+6656);
}
__device__ __forceinline__ void kload2(bf16x8*kf,lds_cptr kp,int j){ kf[2*j]=*(const __attribute__((address_space(3))) bf16x8*)(kp+j*2048); kf[2*j+1]=*(const __attribute__((address_space(3))) bf16x8*)(kp+j*2048+512); }
__device__ __forceinline__ s16x4 vtr(lds_cptr p){ return __builtin_bit_cast(s16x4,__builtin_amdgcn_ds_read_tr16_b64_v4i16((__attribute__((address_space(3))) v4i16_t*)p)); }
__device__ __forceinline__ float rowmax(const f32x16&p0,const f32x16&p1){
  float a=max3f(p0[0],p0[1],p1[0]),b=max3f(p0[2],p0[3],p1[1]);a=max3f(a,p1[2],p1[3]);
  #pragma unroll
  for(int r=4;r<16;r+=4){a=max3f(a,p0[r],p0[r+1]);b=max3f(b,p0[r+2],p0[r+3]);a=max3f(a,p1[r],p1[r+1]);b=max3f(b,p1[r+2],p1[r+3]);}
  const float m=max2f(a,b);
  auto rr=__builtin_amdgcn_permlane32_swap(__float_as_uint(m),__float_as_uint(m),false,false);
  return max2f(__uint_as_float(rr[0]),__uint_as_float(rr[1]));
}
__device__ __forceinline__ void pv(f32x16*o,int vb,bf16x8 pa0,bf16x8 pa1,bf16x8 pa2,bf16x8 pa3){
  #pragma unroll
  for(int d0=0;d0<4;++d0){s16x4 lo[4],hi[4];
    #pragma unroll
    for(int ks=0;ks<4;++ks){
      asm volatile("ds_read_b64_tr_b16 %0,%1 offset:%c2":"=&v"(lo[ks]):"v"(vb),"i"(d0*4096+ks*1024):"memory");
      asm volatile("ds_read_b64_tr_b16 %0,%1 offset:%c2":"=&v"(hi[ks]):"v"(vb),"i"(d0*4096+ks*1024+512):"memory");}
    asm volatile("s_waitcnt lgkmcnt(0)":::"memory");SBAR();
    #define PK(k) (bf16x8){lo[k][0],lo[k][1],lo[k][2],lo[k][3],hi[k][0],hi[k][1],hi[k][2],hi[k][3]}
    o[d0]=__builtin_amdgcn_mfma_f32_32x32x16_bf16(pa0,PK(0),o[d0],0,0,0);
    o[d0]=__builtin_amdgcn_mfma_f32_32x32x16_bf16(pa1,PK(1),o[d0],0,0,0);
    o[d0]=__builtin_amdgcn_mfma_f32_32x32x16_bf16(pa2,PK(2),o[d0],0,0,0);
    o[d0]=__builtin_amdgcn_mfma_f32_32x32x16_bf16(pa3,PK(3),o[d0],0,0,0);
    #undef PK
  }
}

#ifndef ATTN_STORE16
#define ATTN_STORE16(p,v) (*(u32x4*)(p)=(v))
#endif
template<int THRL> __device__ __forceinline__ void attn_unit(int b,int hm,int qb,float cs,const int wid,const int t0,const float uref,const bf16*Q,const bf16*__restrict__ K,const bf16*__restrict__ V,bf16*O,char*shm,volatile __attribute__((address_space(3))) int*slot_,const int nxt_,const bool lead_,const bool comb_){
  int lane=lane_id(); asm volatile("":"+v"(lane));
  const int r32=lane&31,hi=lane>>5;
  const long rowbase=(long)b*SEQ; const int q0=qb*QB;
  const int NTf=(q0+QB)/KVBLK;
  const bf16*Qw=Q+(rowbase+q0+wid*QBLK)*DM+hm*D;
  const bf16*Kh=K+(rowbase+64*t0)*DM+hm*D,*Vh=V+(rowbase+64*t0)*DM+(hm>>1)*128;
  const unsigned lds0=(unsigned)(uintptr_t)shm;
  float*wsf=(float*)(shm+LDS_WS)+wid*64;
  const bf16*ksrc=Kh+(long)lane*DM+wid*8;
  const bf16*vsrc=Vh+(long)(16*(wid&3)+(lane>>2))*DM+(wid>>2)*32+(lane&3)*8;
  const unsigned kdst=lds0+LDS_K+wid*1024, vdst=lds0+LDS_V+wid*1024;
  #define DMA_K(t,slot) glds16(ksrc+(long)(t)*KVBLK*DM,(unsigned)__builtin_amdgcn_readfirstlane(kdst+(slot)))
  #define DMA_V(t,slot) do{ glds16(vsrc+(long)(t)*KVBLK*DM,(unsigned)__builtin_amdgcn_readfirstlane(vdst+(slot))); glds16(vsrc+(long)(t)*KVBLK*DM+64,(unsigned)__builtin_amdgcn_readfirstlane(vdst+(slot)+8192)); }while(0)
  const int vb0=(int)(lds0+LDS_V)+((lane>>4)&1)*32+(lane&3)*8+(4*hi+((lane&15)>>2))*64;
  const char*Kbase=shm+LDS_K; bf16x8 kf[8];
  const lds_cptr shm3=(lds_cptr)shm; const lds_cptr kp0=shm3+LDS_K+hi*1024+r32*16; const lds_cptr vp0=shm3+LDS_V+((lane>>4)&1)*32+(lane&3)*8+(4*hi+((lane&15)>>2))*64;
  const int NT=NTf-t0;
  DMA_K(0,0);DMA_V(0,0);DMA_K(1,SLOTB);
  bf16x8 qr[4];
  #pragma unroll
  for(int d0=0;d0<4;++d0)qr[d0]=*reinterpret_cast<const bf16x8*>(&Qw[(long)r32*DM+d0*16+hi*8]);
  float mhat=0.f,l_reg=0.f;f32x16 o[4];o[0]=f32x16{};o[1]=f32x16{};o[2]=f32x16{};o[3]=f32x16{};
  const int qrel=wid*QBLK+r32;
  float nb=-uref-cs*(float)(q0+qrel-4*hi-64*t0);
  const float cs8=__builtin_bit_cast(float,__builtin_amdgcn_readfirstlane(__builtin_bit_cast(int,8.f*cs)));
  #define CINIT1(C,t,X) do{ C[0]=nb+cs*(float)(64*(t)+(X)); C[1]=C[0]+cs; C[2]=C[1]+cs; C[3]=C[2]+cs; _Pragma("unroll") for(int r=4;r<16;++r) C[r]=C[r-4]+cs8; asm volatile("":"+v"(C)); }while(0)
  #define CINIT(C0,C1,t) do{ CINIT1(C0,t,0); CINIT1(C1,t,32); }while(0)
  #define CMASK(P0,P1,t) do{int jb_=(t)-(NT-4); if(jb_>=0)cmask(P0,P1,jb_,qrel,hi);}while(0)
  bool resc=false;
  #define START(P0,P1) do{ const float rm=rowmax(P0,P1); resc=false; \
    { const float dl=0.f; (void)rm; mhat=fadd_s(mhat,dl); nb=fsub_s(nb,dl);     \
      _Pragma("unroll") for(int r=0;r<16;++r){P0[r]=fsub_s(P0[r],dl);P1[r]=fsub_s(P1[r],dl);} } \
    _Pragma("unroll") for(int r=0;r<16;++r)P0[r]=__builtin_amdgcn_exp2f(P0[r]); }while(0)
  #define RESC() do{ if(THRL>=0&&resc){ asm volatile("s_waitcnt lgkmcnt(0)":::"memory"); \
      _Pragma("unroll") for(int d_=0;d_<4;++d_) _Pragma("unroll") for(int r=0;r<16;++r)o[d_][r]*=wsf[crow(r,hi)]; } }while(0)
  f32x16 pA0,pA1,pB0,pB1;
  int sl_prev=0,sl_cur=0,sl_next=SLOTB;
  #define ROT() do{sl_prev=sl_cur;sl_cur=sl_next;sl_next=(sl_next==(NSLOT-1)*SLOTB)?0:sl_next+SLOTB;}while(0)
  DMA_K(2,2*SLOTB);
  WAIT_BAR(4);
  { f32x16 i0_,i1_; CINIT(i0_,i1_,0); qkt(pA0,pA1,Kbase,qr,i0_,i1_,r32,hi); } asm volatile("s_nop 15\n\ts_nop 7":"+v"(pA0),"+v"(pA1));CMASK(pA0,pA1,0);
  CINIT(pB0,pB1,1);
  START(pA0,pA1);
  _Pragma("unroll") for(int r=0;r<16;++r)pA1[r]=__builtin_amdgcn_exp2f(pA1[r]);
  WAIT_BAR(0);
  DMA_K(3,0);DMA_V(1,VSLOTB);
  ROT();
  kload8(kf,kp0+sl_cur);
  WAIT_BAR(3);
  s16x4 vlo[8],vhi[8]; u32x4 pw0,pw1,pw2,pw3;
  #define PKW(P,B) cvtpk_s(P[B],P[B+1])
  #define PAF(k) __builtin_bit_cast(bf16x8,pw##k)
  #define VFR(i) (bf16x8){vlo[i][0],vlo[i][1],vlo[i][2],vlo[i][3],vhi[i][0],vhi[i][1],vhi[i][2],vhi[i][3]}
  #define PIN(x) asm volatile("":"+v"(x))
  #define MX3(a,b,c) __builtin_fmaxf(__builtin_fmaxf((a),(b)),(c))
  #define GAPA(MF,A0,A1,A2,A3,W0,W1,PW) do{ MF; sacc+=A0; sacc+=A1; sacc+=A2; sacc+=A3; PIN(sacc); W0; W1; PIN(PW); SBAR(); }while(0)
  #define EX(v) __builtin_amdgcn_exp2f(v)
  #define GAPB(MF,X,B,CI) do{ MF; X[B]=EX(X[B]); X[B+1]=EX(X[B+1]); CI; PIN(X); SBAR(); }while(0)
    \
  #define CIA(P,X,t) do{ P[0]=nb+cs*(float)(64*((t)+1)+(X)); P[1]=fadd_s(P[0],cs); }while(0)
  #define CIB(P) do{ P[2]=fadd_s(P[1],cs); P[3]=fadd_s(P[2],cs); }while(0)
  #define CIC(P,k) do{ P[2*(k)]=fadd_s(P[2*(k)-4],cs8); P[2*(k)+1]=fadd_s(P[2*(k)-3],cs8); }while(0)
  #define VRD2(i) do{ vlo[i]=vtr(vp_+(8192+((i)>>2)*4096+((i)&3)*1024)); vhi[i]=vtr(vp_+(8192+((i)>>2)*4096+((i)&3)*1024+512)); SBAR(); }while(0)
  #define VRD(i) do{ vlo[i]=vtr(vp_+(((i)>>2)*4096+((i)&3)*1024)); vhi[i]=vtr(vp_+(((i)>>2)*4096+((i)&3)*1024+512)); }while(0)
  #define KRD(G,j) do{ if(G){ kload2(kf,kp0+sl_next,j); SBAR(); } }while(0)
  #define STEP(C0,C1,P0,P1,t,GK,GV,GL) do{ SBAR(); \
    const lds_cptr vp_=vp0+2*sl_prev; \
    VRD(0); SBAR(); float sacc=(P0[0]+P0[1]); SBAR(); \
    GAPA(C0=__builtin_amdgcn_mfma_f32_32x32x16_bf16(kf[0],qr[0],C0,0,0,0), P0[2],P0[3],P0[4],P0[5],     pw0[0]=PKW(P0,0), pw0[1]=PKW(P0,2), pw0); \
    VRD(4); SBAR(); GAPA(C1=__builtin_amdgcn_mfma_f32_32x32x16_bf16(kf[1],qr[0],C1,0,0,0), P0[6],P0[7],P0[8],P0[9],     pw0[2]=PKW(P0,4), pw0[3]=PKW(P0,6), pw0); \
    VRD(1); SBAR(); GAPA(C0=__builtin_amdgcn_mfma_f32_32x32x16_bf16(kf[2],qr[1],C0,0,0,0),   P0[10],P0[11],P0[12],P0[13], pw1[0]=PKW(P0,8), pw1[1]=PKW(P0,10), pw1); \
    VRD(5); SBAR(); GAPA(C1=__builtin_amdgcn_mfma_f32_32x32x16_bf16(kf[3],qr[1],C1,0,0,0),   P0[14],P0[15],P1[0],P1[1],   pw1[2]=PKW(P0,12),pw1[3]=PKW(P0,14), pw1); \
    VRD(2); SBAR(); GAPA(C0=__builtin_amdgcn_mfma_f32_32x32x16_bf16(kf[4],qr[2],C0,0,0,0),   P1[2],P1[3],P1[4],P1[5],     pw2[0]=PKW(P1,0), pw2[1]=PKW(P1,2), pw2); \
    VRD(6); SBAR(); GAPA(C1=__builtin_amdgcn_mfma_f32_32x32x16_bf16(kf[5],qr[2],C1,0,0,0),   P1[6],P1[7],P1[8],P1[9],     pw2[2]=PKW(P1,4), pw2[3]=PKW(P1,6), pw2); \
    VRD(3); SBAR(); GAPA(C0=__builtin_amdgcn_mfma_f32_32x32x16_bf16(kf[6],qr[3],C0,0,0,0),   P1[10],P1[11],P1[12],P1[13], pw3[0]=PKW(P1,8), pw3[1]=PKW(P1,10), pw3); \
    VRD(7); SBAR(); GAPA(C1=__builtin_amdgcn_mfma_f32_32x32x16_bf16(kf[7],qr[3],C1,0,0,0),   P1[14],P1[15],0.f,0.f,       pw3[2]=PKW(P1,12),pw3[3]=PKW(P1,14), pw3); \
    l_reg+=sacc; \
    if(GK){DMA_K((t)+3,sl_cur);} if(GV){DMA_V((t)+1,2*sl_next);} \
    CMASK(C0,C1,t); \
    { float a=MX3(C0[0],C0[1],C1[0]),b=MX3(C0[2],C0[3],C1[1]); a=MX3(a,C1[2],C1[3]); \
      _Pragma("unroll") for(int r=4;r<16;r+=4){a=MX3(a,C0[r],C0[r+1]);b=MX3(b,C0[r+2],C0[r+3]);a=MX3(a,C1[r],C1[r+1]);b=MX3(b,C1[r+2],C1[r+3]);} \
      float rm=__builtin_fmaxf(a,b); { auto rr=__builtin_amdgcn_permlane32_swap(__float_as_uint(rm),__float_as_uint(rm),false,false); rm=__builtin_fmaxf(__uint_as_float(rr[0]),__uint_as_float(rr[1])); } \
      resc=false; \
      if(THRL>=0&&__builtin_expect(__any(rm>(float)THRL),0)){ const float dl=__builtin_fmaxf(rm,0.f); mhat+=dl; nb-=dl; \
        _Pragma("unroll") for(int r=0;r<16;++r){C0[r]-=dl;C1[r]-=dl;} \
        const float f=__builtin_amdgcn_exp2f(-dl); l_reg*=f; if(hi==0)wsf[r32]=f; resc=true; } } \
    SBAR(); \
    GAPB(o[0]=__builtin_amdgcn_mfma_f32_32x32x16_bf16(PAF(0),VFR(0),o[0],0,0,0), C0,0, CIA(P0,0,t)); \
    GAPB(o[1]=__builtin_amdgcn_mfma_f32_32x32x16_bf16(PAF(0),VFR(4),o[1],0,0,0), C0,2, CIB(P0)); VRD2(0); \
    KRD(GL,0); GAPB(o[0]=__builtin_amdgcn_mfma_f32_32x32x16_bf16(PAF(1),VFR(1),o[0],0,0,0), C0,4, CIC(P0,2)); VRD2(4); \
    KRD(GL,1); GAPB(o[1]=__builtin_amdgcn_mfma_f32_32x32x16_bf16(PAF(1),VFR(5),o[1],0,0,0), C0,6, CIC(P0,3)); VRD2(1); \
    KRD(GL,2); GAPB(o[0]=__builtin_amdgcn_mfma_f32_32x32x16_bf16(PAF(2),VFR(2),o[0],0,0,0), C0,8, CIC(P0,4)); VRD2(5); \
    KRD(GL,3); GAPB(o[1]=__builtin_amdgcn_mfma_f32_32x32x16_bf16(PAF(2),VFR(6),o[1],0,0,0), C0,10, CIC(P0,5)); VRD2(2); \
    GAPB(o[0]=__builtin_amdgcn_mfma_f32_32x32x16_bf16(PAF(3),VFR(3),o[0],0,0,0), C0,12, CIC(P0,6)); VRD2(6); \
    GAPB(o[1]=__builtin_amdgcn_mfma_f32_32x32x16_bf16(PAF(3),VFR(7),o[1],0,0,0), C0,14, CIC(P0,7)); VRD2(3); \
    GAPB(o[2]=__builtin_amdgcn_mfma_f32_32x32x16_bf16(PAF(0),VFR(0),o[2],0,0,0), C1,0, CIA(P1,32,t)); VRD2(7); \
    GAPB(o[3]=__builtin_amdgcn_mfma_f32_32x32x16_bf16(PAF(0),VFR(4),o[3],0,0,0), C1,2, CIB(P1)); \
    GAPB(o[2]=__builtin_amdgcn_mfma_f32_32x32x16_bf16(PAF(1),VFR(1),o[2],0,0,0), C1,4, CIC(P1,2)); \
    GAPB(o[3]=__builtin_amdgcn_mfma_f32_32x32x16_bf16(PAF(1),VFR(5),o[3],0,0,0), C1,6, CIC(P1,3)); \
    GAPB(o[2]=__builtin_amdgcn_mfma_f32_32x32x16_bf16(PAF(2),VFR(2),o[2],0,0,0), C1,8, CIC(P1,4)); \
    GAPB(o[3]=__builtin_amdgcn_mfma_f32_32x32x16_bf16(PAF(2),VFR(6),o[3],0,0,0), C1,10, CIC(P1,5)); \
    GAPB(o[2]=__builtin_amdgcn_mfma_f32_32x32x16_bf16(PAF(3),VFR(3),o[2],0,0,0), C1,12, CIC(P1,6)); \
    GAPB(o[3]=__builtin_amdgcn_mfma_f32_32x32x16_bf16(PAF(3),VFR(7),o[3],0,0,0), C1,14, CIC(P1,7)); \
    }while(0)
  int t=1;
  #undef CMASK
  #define CMASK(P0,P1,t) do{}while(0)
  for(;t+5<NT;t+=2){
    STEP(pB0,pB1,pA0,pA1,t,true,true,true);     WAIT_BAR(3); RESC(); ROT();
    STEP(pA0,pA1,pB0,pB1,t+1,true,true,true);   WAIT_BAR(3); RESC(); ROT();
  }
  #undef CMASK
  #define CMASK(P0,P1,t) do{int jb_=(t)-(NT-4); if(jb_>=0)cmask(P0,P1,jb_,qrel,hi);}while(0)
  #define ENDW(tt) do{ if((tt)+3<NT){WAIT_BAR(3);} else if((tt)+2<NT){WAIT_BAR(2);} else {WAIT_BAR(0);} }while(0)
  for(;t+1<NT;t+=2){
    STEP(pB0,pB1,pA0,pA1,t,(t+3<NT),(t+1<NT),(t+1<NT));       ENDW(t);   RESC(); ROT();
    STEP(pA0,pA1,pB0,pB1,t+1,(t+4<NT),(t+2<NT),(t+2<NT));     ENDW(t+1); RESC(); ROT();
  }
  STEP(pB0,pB1,pA0,pA1,NT-1,false,false,false); RESC();
  u32x4 A[2][4];
  if(comb_){ const bf16*o0=O+(rowbase+q0+wid*QBLK+(lane>>3))*DMO+(hm>>1)*256+(lane&7)*8;
    #pragma unroll
    for(int hf=0;hf<2;++hf)
      #pragma unroll
      for(int i=0;i<4;++i)A[hf][i]=ld16_sc1(o0+(long)(i*8)*DMO+hf*64); }
  { float sacc=pB0[0]+pB0[1]; _Pragma("unroll") for(int r=2;r<16;++r)sacc+=pB0[r]; _Pragma("unroll") for(int r=0;r<16;++r)sacc+=pB1[r]; l_reg+=sacc;
    pw0=(u32x4){PKW(pB0,0),PKW(pB0,2),PKW(pB0,4),PKW(pB0,6)};pw1=(u32x4){PKW(pB0,8),PKW(pB0,10),PKW(pB0,12),PKW(pB0,14)};pw2=(u32x4){PKW(pB1,0),PKW(pB1,2),PKW(pB1,4),PKW(pB1,6)};pw3=(u32x4){PKW(pB1,8),PKW(pB1,10),PKW(pB1,12),PKW(pB1,14)};
    SBAR(); pv(o,vb0+2*sl_cur,PAF(0),PAF(1),PAF(2),PAF(3)); }
  #undef PKW
  #undef PAF
  #undef VFR
  #undef PIN
  #undef MX3
  #undef GAPA
  #undef GAPB
  #undef EX
  #undef VRD
  #undef VRD2
  #undef CIA
  #undef CIB
  #undef CIC
  #undef KRD
  #undef STEP
  #undef ENDW
  if(lead_) *slot_=nxt_;
  {auto rr=__builtin_amdgcn_permlane32_swap(__float_as_uint(l_reg),__float_as_uint(l_reg),false,false);l_reg=__uint_as_float(rr[0])+__uint_as_float(rr[1]);}
  if(hi==0)wsf[32+r32]=l_reg;asm volatile("s_waitcnt lgkmcnt(0)":::"memory");
  float rli[16];
  #pragma unroll
  for(int r=0;r<16;++r)rli[r]=__builtin_amdgcn_rcpf(wsf[32+crow(r,hi)]);
  bf16*Ow=O+(rowbase+q0+wid*QBLK)*DMO+(hm>>1)*256;
  { bf16*stg=(bf16*)(shm+LDS_OST)+wid*2048;
    int eoff=hi*256+r32; asm volatile("":"+v"(eoff));
    const int row_l=lane>>3,ch=lane&7;
    if(!comb_){
      #pragma unroll
      for(int hf=0;hf<2;++hf){
        #pragma unroll
        for(int r=0;r<16;++r){const int orow=(r&3)+8*(r>>2);
          #pragma unroll
          for(int d0=0;d0<2;++d0)stg[eoff+orow*64+d0*32]=__float2bfloat16(o[2*hf+d0][r]*rli[r]);}
        asm volatile("s_waitcnt lgkmcnt(0)":::"memory");
        #pragma unroll
        for(int i=0;i<4;++i){const int row=i*8+row_l; const u32x4 v=*(const u32x4*)(stg+row*64+ch*8); ATTN_STORE16(Ow+(long)row*DMO+hf*64+ch*8,v);}
        asm volatile("s_waitcnt lgkmcnt(0)":::"memory"); }
    } else {
      static_assert(MIXG_FP8, "fused combine writes the fp8 APO layout");
      const float lam=*(const volatile __attribute__((address_space(3))) float*)((lds_cptr)shm+LDS_LAM);
      ::f32x4 dd[2][4][2]; float ss[4]={0.f,0.f,0.f,0.f};
      #pragma unroll
      for(int hf=0;hf<2;++hf){
        #pragma unroll
        for(int r=0;r<16;++r){const int orow=(r&3)+8*(r>>2);
          #pragma unroll
          for(int d0=0;d0<2;++d0)stg[eoff+orow*64+d0*32]=__float2bfloat16(o[2*hf+d0][r]*rli[r]);}
        asm volatile("s_waitcnt lgkmcnt(0)":::"memory");
        if(hf==0){ asm volatile("s_waitcnt vmcnt(0)":"+v"(A[0][0]),"+v"(A[0][1]),"+v"(A[0][2]),"+v"(A[0][3]),"+v"(A[1][0]),"+v"(A[1][1]),"+v"(A[1][2]),"+v"(A[1][3])::"memory"); }
        #pragma unroll
        for(int i=0;i<4;++i){const int row=i*8+row_l; const u32x4 v=*(const u32x4*)(stg+row*64+ch*8);
          ::f32x4 a0,a1,b0,b1; pg8::unpack8(A[hf][i],a0,a1); pg8::unpack8(v,b0,b1); a0-=b0*lam; a1-=b1*lam; dd[hf][i][0]=a0; dd[hf][i][1]=a1;
          ss[i]+=(a0[0]*a0[0]+a0[1]*a0[1])+(a0[2]*a0[2]+a0[3]*a0[3])+(a1[0]*a1[0]+a1[1]*a1[1])+(a1[2]*a1[2]+a1[3]*a1[3]); }
        asm volatile("s_waitcnt lgkmcnt(0)":::"memory"); }
      unsigned char*ap=(unsigned char*)O+((long)WS_APO-(long)WS_O16)+(size_t)(rowbase+q0+wid*QBLK+row_l)*1024+(hm>>1)*128+ch*8;
      #pragma unroll
      for(int i=0;i<4;++i){ float s=ss[i];
        #define SWZ_ADD(k) s+=__builtin_bit_cast(float,__builtin_amdgcn_ds_swizzle(__builtin_bit_cast(int,s),((k)<<10)|0x1f))
        SWZ_ADD(1);SWZ_ADD(2);SWZ_ADD(4);
        #undef SWZ_ADD
        const float rs=rsqrtf(s*(1.f/128.f)+LN_EPS)*(0.8f*APO_SCALE);
        #pragma unroll
        for(int hf=0;hf<2;++hf){ const __attribute__((address_space(3))) f32x4_* gp=(const __attribute__((address_space(3))) f32x4_*)((lds_cptr)shm+LDS_SUBLN+(hf*64+ch*8)*4); const f32x4_ g0=gp[0],g1=gp[1];
          ::f32x4 a0=dd[hf][i][0],a1=dd[hf][i][1];
          #pragma unroll
          for(int j=0;j<4;++j){a0[j]*=rs*g0[j];a1[j]*=rs*g1[j];}
          *(unsigned long long*)(ap+(size_t)(i*8)*1024+hf*64)=(unsigned long long)pg8::pk4_fp8(a0[0],a0[1],a0[2],a0[3])|((unsigned long long)pg8::pk4_fp8(a1[0],a1[1],a1[2],a1[3])<<32); } }
    } }
  asm volatile("s_waitcnt lgkmcnt(0)\n\ts_barrier":::"memory");
  #undef DMA_K
  #undef DMA_V
  #undef CMASK
  #undef START
  #undef RESC
  #undef ROT
  #undef CINIT
  #undef CINIT1
}
constexpr int ATTN_LDS_BYTES=LDS_BYTES;
struct AttnTensors { const bf16* Q; const bf16* K; const bf16* V; bf16* O; const float* PN; unsigned* queue; float lam; const float* subln; unsigned char* APO; };
constexpr int LDS_SLOT=LDS_BYTES, LDS_T0=LDS_BYTES+1024, LDS_UREF=LDS_T0+8192, ATTN_LDS_TOTAL=LDS_UREF+8192;
__device__ __forceinline__ void unit_of(int u,int&b,int&h,int&qb){ if(u<512){qb=15-(u>>5);const int r=u&31;b=r>>1;h=2+(r&1);} else if(u<768){const int v=u-512;qb=15-(v>>4);b=v&15;h=1;} else {const int v=u-768;qb=15-(v>>4);b=v&15;h=0;} }
__device__ __forceinline__ void attn_tables(char*lds,const float*PN,int tid){
  const int bhm=tid>>2,part=tid&3; const float*pq=PN+(bhm*64+16*part)*2,*pk=PN+16384+(bhm*64+16*part)*2;
  float kq[16],qq[16];
  #pragma unroll
  for(int i=0;i<8;++i){ const f32x4_ a=*(const f32x4_*)(pk+4*i),c=*(const f32x4_*)(pq+4*i); kq[2*i]=a[0]+a[1];kq[2*i+1]=a[2]+a[3];qq[2*i]=c[0]+c[1];qq[2*i+1]=c[2]+c[3]; }
  float km[4]; { float m=0.f;
    #pragma unroll
    for(int i=0;i<16;++i){ m=__builtin_fmaxf(m,kq[i]); if((i&3)==3)km[i>>2]=m; } }
  float before=0.f;
  #pragma unroll
  for(int p=0;p<3;++p){ const float tot=__shfl(km[3],(tid&~3)+p); if(p<part)before=__builtin_fmaxf(before,tot); }
  const int hm=bhm&7; const float cs=__builtin_amdgcn_exp2f(-2.f*(float)((hm>>1)+1))*1.4426950408889634f;
  volatile __attribute__((address_space(3))) int* T0=(volatile __attribute__((address_space(3))) int*)(lds+LDS_T0); volatile __attribute__((address_space(3))) float* UR=(volatile __attribute__((address_space(3))) float*)(lds+LDS_UREF);
  #pragma unroll
  for(int j=0;j<4;++j){ const int qb=4*part+j; const float kmx=__builtin_fmaxf(before,km[j]); const float qmx=__builtin_fmaxf(__builtin_fmaxf(qq[4*j],qq[4*j+1]),__builtin_fmaxf(qq[4*j+2],qq[4*j+3]));
    const float qk=__builtin_sqrtf(qmx*kmx), need=(ATT_SKIP+2.04f*qk)/cs;
    const float tf=((float)(256*qb-63)-need)*(1.f/64.f); int tt=tf>0.f?(int)tf:0; tt&=~1; if(tt>4*qb)tt=4*qb;
    T0[bhm*16+qb]=tt; UR[bhm*16+qb]=1.02f*qk; }
}
template<int THRL=8> __device__ __forceinline__ void attn_phase(char*lds,const AttnTensors&T,const int wid){
  volatile __attribute__((address_space(3))) int* slot=(volatile __attribute__((address_space(3))) int*)(lds+LDS_SLOT);
  const volatile __attribute__((address_space(3))) int* T0=(const volatile __attribute__((address_space(3))) int*)(lds+LDS_T0); const volatile __attribute__((address_space(3))) float* UR=(const volatile __attribute__((address_space(3))) float*)(lds+LDS_UREF);
  const bool lead=(wid==0)&&(lane_id()==0);
  if(lead) *slot=(int)__hip_atomic_fetch_add(T.queue,1u,__ATOMIC_RELAXED,__HIP_MEMORY_SCOPE_AGENT);
  { const int tid_=wid*64+lane_id(); if(tid_<128)((volatile __attribute__((address_space(3))) float*)(lds+LDS_SUBLN))[tid_]=T.subln[tid_]; if(tid_==0)*(volatile __attribute__((address_space(3))) float*)(lds+LDS_LAM)=T.lam; }
  attn_tables(lds,T.PN,wid*64+lane_id());
  asm volatile("s_waitcnt vmcnt(0) lgkmcnt(0)\n\ts_barrier":::"memory");
  int cur=__builtin_amdgcn_readfirstlane(*slot);
  asm volatile("s_waitcnt lgkmcnt(0)\n\ts_barrier":::"memory");
  while(cur<BATCH*4*NQB){
    int nxt=0; if(lead) nxt=(int)__hip_atomic_fetch_add(T.queue,1u,__ATOMIC_RELAXED,__HIP_MEMORY_SCOPE_AGENT);
    int b,h,qb; unit_of(cur,b,h,qb);
    const float cs=__builtin_bit_cast(float,__builtin_amdgcn_readfirstlane(__builtin_bit_cast(int,__builtin_amdgcn_exp2f(-2.f*(float)(h+1))*1.4426950408889634f)));
    #pragma unroll 1
    for(int m=0;m<2;++m){ const int hm=2*h+m;
      const int t0=__builtin_amdgcn_readfirstlane(T0[(b*8+hm)*16+qb]); const float uref=__builtin_bit_cast(float,__builtin_amdgcn_readfirstlane(__builtin_bit_cast(int,(float)UR[(b*8+hm)*16+qb])));
      attn_unit<THRL>(b,hm,qb,cs,wid,t0,uref,T.Q,T.K,T.V,T.O,lds,slot,nxt,lead&&(m==1),m==1); }
    cur=__builtin_amdgcn_readfirstlane(*slot);
    asm volatile("s_waitcnt lgkmcnt(0)":::"memory");
  }
}
#undef SBAR
#undef WAIT_BAR
}
constexpr int NWAVES = 8;
constexpr int RING_OFF = 0, RING_BYTES = 131072;
constexpr int LDSCTL_OFF = RING_BYTES, MISC_OFF = LDSCTL_OFF + 320;
constexpr int LDS_BYTES = 163840;

#define XB_TMO      128
#define XB_XCNT(j)  (256  + 64 * (j))
#define XB_XSUB(j)  (1280 + 64 * (j))
#define XB_XGEN(j)  (2304 + 64 * (j))
#define XB_TOP      3328
#define XB_TOPGEN   3392
#define XCD_BAR_WORDS 3456
#define XB_SPIN_CAP (1u << 18)
__device__ __forceinline__ unsigned xb_ld(unsigned* p)              { return __hip_atomic_load(p, __ATOMIC_RELAXED, __HIP_MEMORY_SCOPE_AGENT); }
__device__ __forceinline__ unsigned xb_add(unsigned* p, unsigned v) { return __hip_atomic_fetch_add(p, v, __ATOMIC_RELAXED, __HIP_MEMORY_SCOPE_AGENT); }
__device__ __forceinline__ unsigned xb_xcc_id() { return (unsigned)__builtin_amdgcn_s_getreg((3 << 11) | 20) & 0xFu; }
#define XB_SPIN(cond, bar) do { unsigned _sp = 0; while (cond) { __builtin_amdgcn_s_sleep(1); \
    if ((++_sp & 255u) == 0u) { if (xb_ld(&(bar)[XB_TMO])) break; if (_sp > XB_SPIN_CAP) { atomicAdd(&(bar)[XB_TMO], 1u); break; } } } } while (0)
struct XcdBarrier { unsigned* bar; unsigned x; volatile LAS unsigned* st; bool wave0; };
__device__ __forceinline__ XcdBarrier xcd_barrier_post(unsigned* bar, volatile LAS unsigned* st) {
    XcdBarrier b; b.bar = bar; b.x = xb_xcc_id(); b.st = st; b.wave0 = __builtin_amdgcn_readfirstlane(threadIdx.x >> 6) == 0;
    if (threadIdx.x == 0) (void)xb_add(&bar[XB_XCNT(b.x)], 1u);
    return b;
}
__device__ __forceinline__ void xcd_barrier_complete(unsigned* bar, unsigned x, unsigned& nloc, unsigned& nx) {
    const unsigned G = gridDim.x * gridDim.y * gridDim.z;
    unsigned sum, cnt, mine, sp = 0u;
    for (;;) {
        sum = 0u; cnt = 0u; mine = 0u;
#pragma unroll
        for (unsigned j = 0; j < 16; ++j) { const unsigned c = xb_ld(&bar[XB_XCNT(j)]); sum += c; cnt += (c > 0u) ? 1u : 0u; mine = (j == x) ? c : mine; }
        if (sum == G) break;
        __builtin_amdgcn_s_sleep(1);
        if ((++sp & 255u) == 0u) { if (xb_ld(&bar[XB_TMO])) break; if (sp > XB_SPIN_CAP) { atomicAdd(&bar[XB_TMO], 1u); break; } }
    }
    nloc = mine > 0u ? mine : 1u; nx = cnt > 0u ? cnt : 1u;
}
__device__ __forceinline__ void xcd_barrier(const XcdBarrier& b) {
    asm volatile("s_waitcnt vmcnt(0)" ::: "memory");
    __syncthreads();
    if (b.wave0 && lane_id() == 0) {
        unsigned* bar = b.bar;
        __builtin_amdgcn_s_waitcnt(0);
        unsigned nloc = b.st[0], nx = b.st[1];
        if (nloc == 0u) { xcd_barrier_complete(bar, b.x, nloc, nx); b.st[0] = nloc; b.st[1] = nx; }
        const unsigned old = xb_add(&bar[XB_XSUB(b.x)], 1u);
        const unsigned gen = old / nloc;
        if (old + 1u == (gen + 1u) * nloc) {
            __builtin_amdgcn_fence(__ATOMIC_RELEASE, "agent");
            asm volatile("s_waitcnt vmcnt(0)" ::: "memory");
            const unsigned og = xb_add(&bar[XB_TOP], 1u);
            const unsigned tg = og / nx;
            if (og + 1u == (tg + 1u) * nx) xb_add(&bar[XB_TOPGEN], 1u);
            else XB_SPIN(xb_ld(&bar[XB_TOPGEN]) == tg, bar);
            __builtin_amdgcn_fence(__ATOMIC_ACQUIRE, "agent");
            xb_add(&bar[XB_XGEN(b.x)], 1u);
            asm volatile("s_waitcnt vmcnt(0)" ::: "memory");
        } else {
            XB_SPIN(xb_ld(&bar[XB_XGEN(b.x)]) == gen, bar);
            __builtin_amdgcn_fence(__ATOMIC_ACQUIRE, "agent");
            asm volatile("s_waitcnt vmcnt(0)" ::: "memory");
        }
    }
    __syncthreads();
}

struct Frame {
    LAS unsigned char* lds; volatile LAS unsigned* MISC; gu32* ctl;
    int tid, lane, wave, vcu, G;
};
__device__ __forceinline__ float bf2f_(unsigned short b) { return __builtin_bit_cast(float, (unsigned)b << 16); }
__device__ __forceinline__ float wave_sum(float v) {
#pragma unroll
    for (int o = 1; o < 64; o <<= 1) v += __shfl_xor(v, o);
    return v;
}
struct Ptrs {
    const float *x, *p, *w_in, *b_gate, *lq1, *lk1, *lq2, *lk2, *subln, *w_abr, *w_pmix, *pscale, *w_pbr, *w_out, *ln1g, *ln1b, *w_router, *b_router, *w_up, *b_up, *w_down, *b_down, *w_pg, *w_pp, *ln2g, *ln2b;
    float* out; unsigned char* ws;
};
constexpr int TI_IN = 16 * 128, TI_A = 8 * 32, TI_O = 16 * 32, TI_PG = 16 * 32, TI_PP = 4 * 32, TI_UP1 = 16 * 64, TI_DN1 = 16 * 32;
constexpr int TI_UP = NEXP * TI_UP1, TI_DN = NEXP * TI_DN1, TI_EARLY = TI_IN + TI_A + TI_O, TI_TOTAL = TI_EARLY + TI_PG + TI_PP + TI_UP + TI_DN;
#ifndef NCONV
#define NCONV 80
#endif
#ifndef NPOOL
#define NPOOL 0
#endif
struct TItem { const float* W; unsigned char* WT; int ldw, K, k0, n0, drow0, f8; float scale; };
__device__ __forceinline__ TItem p0_item(const Ptrs& P, int it) {
    unsigned char* ws = P.ws; TItem t; int r = it; t.f8 = 0; t.scale = 1.f;
    if (r < TI_IN) { const int nb = 128, n0 = 32 * (r % nb); t.W = P.w_in; t.ldw = 4096; t.K = 1024; t.k0 = 64 * (r / nb); t.n0 = n0;
        if (n0 >= 256 * PROJ_F8_FROM) { static_assert(PROJ_F8_FROM == 8 || PROJ_F8_FROM == 16, "gate-column interleave assumes the fp8 part is exactly the 2048 gate columns");
            const int gc = n0 - 2048, c = gc & 1023;
            t.WT = ws + WS_WIN8; t.drow0 = 256 * (c >> 7) + 128 * (gc >> 10) + (c & 127); t.f8 = 1; t.scale = WUP_SCALE; }
        else { t.WT = ws + WS_WIN; t.drow0 = n0; }
        return t; } r -= TI_IN;
    if (r < TI_A) { const int nb = 32; t.W = P.w_abr; t.ldw = 1024; t.K = 1024; t.WT = ws + WS_WCAT; t.k0 = 64 * (r / nb); t.n0 = t.drow0 = 32 * (r % nb); if (MIXG_FP8) { t.f8 = 1; t.scale = WUP_SCALE; } return t; } r -= TI_A;
    if (r < TI_O) { const int nb = 32; t.W = P.w_out; t.ldw = 1024; t.K = 1024; t.WT = ws + WS_WOUT; t.k0 = 64 * (r / nb); t.n0 = t.drow0 = 32 * (r % nb); return t; } r -= TI_O;
    if (r < TI_PG) { const int nb = 32; t.W = P.w_pg; t.ldw = 1024; t.K = 1024; t.WT = ws + WS_WPG; t.k0 = 64 * (r / nb); t.n0 = t.drow0 = 32 * (r % nb); if (MOE_FP8) { t.f8 = 1; t.scale = WUP_SCALE; } return t; } r -= TI_PG;
    if (r < TI_PP) { const int nb = 32; t.W = P.w_pp; t.ldw = 1024; t.K = 256; t.WT = ws + WS_WPP; t.k0 = 64 * (r / nb); t.n0 = t.drow0 = 32 * (r % nb); return t; } r -= TI_PP;
    if (r < TI_UP) { const int e = r / TI_UP1, q = r % TI_UP1, nb = 64, n0 = 32 * (q % nb);
        const int bj = n0 >> 10, pn = (n0 & 1023) >> 7, cp = n0 & 127;
        t.W = P.w_up + (size_t)e * 1024 * 2048; t.ldw = 2048; t.K = 1024; t.k0 = 64 * (q / nb); t.n0 = n0; t.drow0 = 256 * pn + 128 * bj + cp;
        if (MOE_FP8) { t.WT = ws + WS_WUP + (size_t)e * 2048 * 1024; t.f8 = 1; t.scale = WUP_SCALE; } else t.WT = ws + WS_WUP + (size_t)e * 2048 * 1024 * 2;
        return t; } r -= TI_UP;
    { const int e = r / TI_DN1, q = r % TI_DN1, nb = 32;
        t.W = P.w_down + (size_t)e * 1024 * 1024; t.ldw = 1024; t.K = 1024; t.k0 = 64 * (q / nb); t.n0 = t.drow0 = 32 * (q % nb);
        if (MOE_FP8) { t.WT = ws + WS_WDN + (size_t)e * 1024 * 1024; t.f8 = 1; t.scale = WDN_SCALE; } else t.WT = ws + WS_WDN + (size_t)e * 1024 * 1024 * 2; }
    return t;
}
__device__ __forceinline__ void p0_emit(const TItem& t, LAS float* scr, int lane) {
    if (t.f8) { const int c = lane & 3;
#pragma unroll
        for (int j = 0; j < 2; ++j) { const int n = (lane >> 2) + 16 * j; const LAS float* s = scr + (16 * c) * 33 + n;
            v4u o; o.x = pg8::pk4_fp8(s[0 * 33], s[1 * 33], s[2 * 33], s[3 * 33]); o.y = pg8::pk4_fp8(s[4 * 33], s[5 * 33], s[6 * 33], s[7 * 33]);
            o.z = pg8::pk4_fp8(s[8 * 33], s[9 * 33], s[10 * 33], s[11 * 33]); o.w = pg8::pk4_fp8(s[12 * 33], s[13 * 33], s[14 * 33], s[15 * 33]);
            *(GAS v4u*)(t.WT + (size_t)(t.drow0 + n) * t.K + t.k0 + 16 * c) = o; } }
    else { const int c = lane & 7;
#pragma unroll
        for (int j = 0; j < 4; ++j) { const int n = (lane >> 3) + 8 * j; const LAS float* s = scr + (8 * c) * 33 + n;
            v4u o; o.x = pk2(s[0 * 33], s[1 * 33]); o.y = pk2(s[2 * 33], s[3 * 33]); o.z = pk2(s[4 * 33], s[5 * 33]); o.w = pk2(s[6 * 33], s[7 * 33]);
            *(GAS v4u*)((bf16*)t.WT + (size_t)(t.drow0 + n) * t.K + t.k0 + 8 * c) = o; } }
}
#define P0_LOAD(T, V) do { const char* base_ = (const char*)(T.W + (size_t)T.k0 * T.ldw + T.n0); unsigned vo_ = (unsigned)(((lane >> 5) * T.ldw + (lane & 31)) * 4); const unsigned step_ = (unsigned)(T.ldw * 8); \
        _Pragma("unroll") for (int i = 0; i < 32; ++i) { V[i] = *(const float*)(base_ + vo_); vo_ += step_; } } while (0)
#define P0_DRAIN(T, V) do { _Pragma("unroll") for (int i = 0; i < 32; ++i) scr[(2 * i + (lane >> 5)) * 33 + (lane & 31)] = V[i] * T.scale; \
        LDS_WAIT(); asm volatile("" ::: "memory"); p0_emit(T, scr, lane); LDS_WAIT(); asm volatile("" ::: "memory"); } while (0)
__device__ __forceinline__ void conv_items(const Ptrs& P, int first, int last, int start, int stride, LAS float* scr, int lane) {
    int it = first + start; if (it >= last) return;
    TItem a = p0_item(P, it), b = p0_item(P, it + stride < last ? it + stride : it); bool two = it + stride < last;
    float va[32], vb[32], na[32], nb[32];
    P0_LOAD(a, va); if (two) P0_LOAD(b, vb);
    for (;;) {
        const int nt = it + 2 * stride; const bool more = nt < last, more2 = nt + stride < last;
        const TItem c = p0_item(P, more ? nt : it), d = p0_item(P, more2 ? nt + stride : it);
        if (more) P0_LOAD(c, na);
        if (more2) P0_LOAD(d, nb);
        P0_DRAIN(a, va); if (two) P0_DRAIN(b, vb);
        if (!more) break;
        it = nt; a = c; b = d; two = more2;
#pragma unroll
        for (int i = 0; i < 32; ++i) { va[i] = na[i]; vb[i] = nb[i]; }
    }
}
#undef P0_LOAD
#undef P0_DRAIN
__device__ __forceinline__ void ph0_prologue(Frame& F, const Ptrs& P) {
    unsigned char* ws = P.ws;
    LAS float* scr = (LAS float*)(F.lds + RING_OFF + F.wave * 16384);
    const int gw = F.vcu * NWAVES + F.wave, NGW = F.G * NWAVES;
    { const size_t n4 = (size_t)M * D / 4, st = (size_t)F.G * 512; const f32x4* src = (const f32x4*)P.x; unsigned long long* dst = (unsigned long long*)P.out;
      unsigned* dst8 = (unsigned*)(ws + WS_XF8);
      for (size_t i = (size_t)blockIdx.x * 512 + F.tid; i < n4; i += 8 * st) { f32x4 v[8];
#pragma unroll
          for (int u = 0; u < 8; ++u) v[u] = (i + u * st < n4) ? src[i + u * st] : (f32x4){0.f, 0.f, 0.f, 0.f};
#pragma unroll
          for (int u = 0; u < 8; ++u) if (i + u * st < n4) { dst[i + u * st] = (unsigned long long)pk2(v[u].x, v[u].y) | ((unsigned long long)pk2(v[u].z, v[u].w) << 32);
              if (PROJ_F8_FROM < 16) dst8[i + u * st] = pg8::pk4_fp8(v[u].x, v[u].y, v[u].z, v[u].w); } } }
    conv_items(P, 0, NCONV > 0 ? TI_EARLY : TI_TOTAL, gw, NGW, scr, F.lane);
    { bf16* WPC = (bf16*)(ws + WS_WCAT) + 512; unsigned char* WPC8 = ws + WS_WCAT + 512;
      for (int k = blockIdx.x; k < 512; k += F.G) { const int g = k >> 7;
          float a0 = 0.f, a1 = 0.f; const float* wm = P.w_pmix + (size_t)k * 128; const float* sc = P.pscale + g * 128; const float* wb = P.w_pbr + (size_t)(g * 128) * 1024;
          for (int d = 0; d < 128; ++d) { const float w = wm[d] * sc[d]; a0 += w * wb[(size_t)d * 1024 + F.tid]; a1 += w * wb[(size_t)d * 1024 + 512 + F.tid]; }
          if (MIXG_FP8) { WPC8[(size_t)F.tid * 1024 + k] = (unsigned char)(pg8::pk4_fp8(a0 * WUP_SCALE, 0.f, 0.f, 0.f) & 0xffu); WPC8[(size_t)(F.tid + 512) * 1024 + k] = (unsigned char)(pg8::pk4_fp8(a1 * WUP_SCALE, 0.f, 0.f, 0.f) & 0xffu); }
          else { WPC[(size_t)F.tid * 1024 + k] = (bf16)f2bf(a0); WPC[(size_t)(F.tid + 512) * 1024 + k] = (bf16)f2bf(a1); } } }
}
__device__ __forceinline__ void ph_pool(Frame& F, const Ptrs& P, const int wg, const int nwg) {
    const bf16* U = (const bf16*)(P.ws + WS_U); bf16* PO = (bf16*)(P.ws + WS_APO) + 512;
    constexpr int RL = 32;
    const size_t nitem = (size_t)(M / RL) * 64, st = (size_t)nwg * 512;
    for (size_t idx = (size_t)wg * 512 + F.tid; idx < nitem; idx += st) {
        const int cg = (int)(idx & 63), c0 = cg * 8, w = 2 << (c0 >> 7); const size_t r0 = (idx >> 6) * RL; const int pos0 = (int)(r0 & (SEQ - 1));
        const bf16* up = U + r0 * 512 + c0; bf16* op = PO + r0 * 1024 + c0; unsigned char* op8 = P.ws + WS_APO + 512 + r0 * 1024 + c0;
        float s[8] = {0.f, 0.f, 0.f, 0.f, 0.f, 0.f, 0.f, 0.f};
        const int nprev = pos0 < w ? pos0 : w;
        { v4u pvv[16];
#pragma unroll
          for (int k = 1; k <= 16; ++k) pvv[k - 1] = (k <= nprev) ? *(const v4u*)(up - (size_t)k * 512) : (v4u){0u, 0u, 0u, 0u};
#pragma unroll
          for (int k = 0; k < 16; ++k) { const v4u v = pvv[k];
            s[0] += pg8::bflo(v.x); s[1] += pg8::bfhi(v.x); s[2] += pg8::bflo(v.y); s[3] += pg8::bfhi(v.y); s[4] += pg8::bflo(v.z); s[5] += pg8::bfhi(v.z); s[6] += pg8::bflo(v.w); s[7] += pg8::bfhi(v.w); } }
        const float rw = 1.f / (float)w;
#pragma unroll 4
        for (int j = 0; j < RL; ++j) { const int pos = pos0 + j; const bool drop = pos >= w;
            const v4u cur = *(const v4u*)(up + (size_t)j * 512), old = *(const v4u*)(up + (size_t)(drop ? j - w : j) * 512);
            const float c[8] = {pg8::bflo(cur.x), pg8::bfhi(cur.x), pg8::bflo(cur.y), pg8::bfhi(cur.y), pg8::bflo(cur.z), pg8::bfhi(cur.z), pg8::bflo(cur.w), pg8::bfhi(cur.w)};
            const float o[8] = {pg8::bflo(old.x), pg8::bfhi(old.x), pg8::bflo(old.y), pg8::bfhi(old.y), pg8::bflo(old.z), pg8::bfhi(old.z), pg8::bflo(old.w), pg8::bfhi(old.w)};
            const float rn = pos + 1 < w ? 1.f / (float)(pos + 1) : rw; float r[8];
#pragma unroll
            for (int i = 0; i < 8; ++i) { s[i] += c[i]; if (drop) s[i] -= o[i]; r[i] = s[i] * rn - c[i]; }
            v4u ov; ov.x = pk2(r[0], r[1]); ov.y = pk2(r[2], r[3]); ov.z = pk2(r[4], r[5]); ov.w = pk2(r[6], r[7]);
            if (MIXG_FP8) { *(unsigned long long*)(op8 + (size_t)j * 1024) = (unsigned long long)pg8::pk4_fp8(r[0] * APO_SCALE, r[1] * APO_SCALE, r[2] * APO_SCALE, r[3] * APO_SCALE) | ((unsigned long long)pg8::pk4_fp8(r[4] * APO_SCALE, r[5] * APO_SCALE, r[6] * APO_SCALE, r[7] * APO_SCALE) << 32); }
            else *(v4u*)(op + (size_t)j * 1024) = ov; }
    }
}
__device__ __forceinline__ float lam_value(const Ptrs& P) { float a = 0.f, b = 0.f; for (int d = 0; d < 64; ++d) { a += P.lq1[d] * P.lk1[d]; b += P.lq2[d] * P.lk2[d]; } return __expf(a) - __expf(b) + 0.2f; }
__device__ __forceinline__ void ph_combine(Frame& F, const Ptrs& P) {
    const bf16* O16 = (const bf16*)(P.ws + WS_O16); bf16* OA = (bf16*)(P.ws + WS_APO); const float lam = lam_value(P);
    const int gw = F.vcu * NWAVES + F.wave, NGW = F.G * NWAVES, h = F.lane >> 4, e0 = (F.lane & 15) * 8;
    float sg[8];
#pragma unroll
    for (int j = 0; j < 8; ++j) sg[j] = P.subln[e0 + j] * 0.8f;
    v4u av[4], bv[4], nav[4], nbv[4];
#define PH3_LOAD(r0_, AV, BV) do { _Pragma("unroll") for (int u = 0; u < 4; ++u) { const int row = (r0_) + u * NGW; if (row < M) { AV[u] = *(const v4u*)(O16 + (size_t)row * 1024 + h * 256 + e0); BV[u] = *(const v4u*)(O16 + (size_t)row * 1024 + h * 256 + 128 + e0); } } } while (0)
    if (gw < M) PH3_LOAD(gw, av, bv);
    for (int row0 = gw; row0 < M; row0 += 4 * NGW) {
        if (row0 + 4 * NGW < M) PH3_LOAD(row0 + 4 * NGW, nav, nbv);
#pragma unroll
        for (int u = 0; u < 4; ++u) { const int row = row0 + u * NGW; if (row >= M) continue;
            f32x4 a0, a1, b0, b1; pg8::unpack8(av[u], a0, a1); pg8::unpack8(bv[u], b0, b1); a0 -= b0 * lam; a1 -= b1 * lam;
            float ss = (a0[0] * a0[0] + a0[1] * a0[1]) + (a0[2] * a0[2] + a0[3] * a0[3]) + (a1[0] * a1[0] + a1[1] * a1[1]) + (a1[2] * a1[2] + a1[3] * a1[3]);
            ss += __shfl_xor(ss, 1); ss += __shfl_xor(ss, 2); ss += __shfl_xor(ss, 4); ss += __shfl_xor(ss, 8);
            const float r = rsqrtf(ss * (1.f / 128.f) + LN_EPS);
#pragma unroll
            for (int j = 0; j < 4; ++j) { a0[j] *= r * sg[j]; a1[j] *= r * sg[4 + j]; }
            if (MIXG_FP8) { a0 *= APO_SCALE; a1 *= APO_SCALE; *(unsigned long long*)(P.ws + WS_APO + (size_t)row * 1024 + h * 128 + e0) = (unsigned long long)pg8::pk4_fp8(a0[0], a0[1], a0[2], a0[3]) | ((unsigned long long)pg8::pk4_fp8(a1[0], a1[1], a1[2], a1[3]) << 32); }
            else *(v4u*)(OA + (size_t)row * 1024 + h * 128 + e0) = pg8::pack8(a0, a1); }
#pragma unroll
        for (int u = 0; u < 4; ++u) { av[u] = nav[u]; bv[u] = nbv[u]; }
    }
#undef PH3_LOAD
}
__device__ __forceinline__ void conv_p(Frame& F, const Ptrs& P, const int wg, const int nwg) {
    const size_t n4 = (size_t)M * PLE / 4, st = (size_t)nwg * 512; const f32x4* src = (const f32x4*)P.p; unsigned long long* dst = (unsigned long long*)((unsigned char*)P.out + 128 * MiB);
    for (size_t i = (size_t)wg * 512 + F.tid; i < n4; i += 8 * st) { f32x4 v[8];
#pragma unroll
        for (int u = 0; u < 8; ++u) v[u] = (i + u * st < n4) ? src[i + u * st] : (f32x4){0.f, 0.f, 0.f, 0.f};
#pragma unroll
        for (int u = 0; u < 8; ++u) if (i + u * st < n4) dst[i + u * st] = (unsigned long long)pk2(v[u].x, v[u].y) | ((unsigned long long)pk2(v[u].z, v[u].w) << 32); }
}
typedef float f32x16_ __attribute__((ext_vector_type(16)));
__device__ __forceinline__ void hilo8(const f32x4& a, const f32x4& b, bf16x8& hi, bf16x8& lo) {
    unsigned h[4], l[4];
    h[0] = pg8::cvt_pk_bf16(a[0], a[1]); h[1] = pg8::cvt_pk_bf16(a[2], a[3]); h[2] = pg8::cvt_pk_bf16(b[0], b[1]); h[3] = pg8::cvt_pk_bf16(b[2], b[3]);
    l[0] = pg8::cvt_pk_bf16(a[0] - pg8::bflo(h[0]), a[1] - pg8::bfhi(h[0])); l[1] = pg8::cvt_pk_bf16(a[2] - pg8::bflo(h[1]), a[3] - pg8::bfhi(h[1]));
    l[2] = pg8::cvt_pk_bf16(b[0] - pg8::bflo(h[2]), b[1] - pg8::bfhi(h[2])); l[3] = pg8::cvt_pk_bf16(b[2] - pg8::bflo(h[3]), b[3] - pg8::bfhi(h[3]));
    v4u hv = {h[0], h[1], h[2], h[3]}, lv = {l[0], l[1], l[2], l[3]}; hi = __builtin_bit_cast(bf16x8, hv); lo = __builtin_bit_cast(bf16x8, lv);
}
__device__ __forceinline__ void ph6_ln1_route(Frame& F, const Ptrs& P, const bool dry) {
    unsigned char* ws = P.ws;
    constexpr int XT_OFF = 0, XT_PITCH = 1028, PL_OFF = 16 * XT_PITCH * 4, LG_OFF = PL_OFF + 8 * 16 * 32 * 4, RS_OFF = LG_OFF + 256 * 33 * 4;
    static_assert(RS_OFF + 256 <= RING_BYTES, "ph6 LDS map");
    if (NCONV == 0) conv_p(F, P, (int)blockIdx.x, F.G);
    const bf16* X1in = (const bf16*)(ws + WS_PRE1B); float* STAT = (float*)(ws + (dry ? 228 * MiB : WS_STAT)); unsigned char* X1F8 = ws + (dry ? 740 * MiB : WS_X1F8);
#define CI6(j) (8 * (lane + 64 * ((j) >> 1)) + 4 * ((j) & 1))
    const int lane = F.lane, wave = F.wave, e = lane & 31, kh = lane >> 5;
    LAS float* XT = (LAS float*)(F.lds + XT_OFF); LAS float* PL = (LAS float*)(F.lds + PL_OFF); LAS float* LG = (LAS float*)(F.lds + LG_OFF);
    bf16x8 bh[8], bl[8];
#pragma unroll
    for (int s = 0; s < 8; ++s) { const float* wp = P.w_router + (size_t)(128 * wave + 16 * s + 8 * kh) * 32 + e;
        const f32x4 a = {wp[0], wp[32], wp[64], wp[96]}, b = {wp[128], wp[160], wp[192], wp[224]}; hilo8(a, b, bh[s], bl[s]); }
    f32x4 gam[4], bet[4];
#pragma unroll
    for (int j = 0; j < 4; ++j) { gam[j] = *(const f32x4*)(P.ln1g + CI6(j)); bet[j] = *(const f32x4*)(P.ln1b + CI6(j)); }
    const float brt = P.b_router[e];
    for (int chunk = blockIdx.x; chunk < M / 256; chunk += F.G) {
        f32x4 v[2][4]; v4u nw[2][2];
#pragma unroll
        for (int i = 0; i < 2; ++i)
#pragma unroll
            for (int jj = 0; jj < 2; ++jj) nw[i][jj] = *(const v4u*)(X1in + (size_t)(chunk * 256 + 2 * wave + i) * 1024 + 8 * (lane + 64 * jj));
#pragma unroll 1
        for (int step = 0; step < 16; ++step) {
#pragma unroll
            for (int i = 0; i < 2; ++i)
#pragma unroll
                for (int jj = 0; jj < 2; ++jj) pg8::unpack8(nw[i][jj], v[i][2 * jj], v[i][2 * jj + 1]);
            if (step < 15) {
#pragma unroll
                for (int i = 0; i < 2; ++i)
#pragma unroll
                    for (int jj = 0; jj < 2; ++jj) nw[i][jj] = *(const v4u*)(X1in + (size_t)(chunk * 256 + (step + 1) * 16 + 2 * wave + i) * 1024 + 8 * (lane + 64 * jj)); }
            float s0 = 0.f, s1 = 0.f;
#pragma unroll
            for (int j = 0; j < 4; ++j) { s0 += (v[0][j].x + v[0][j].y) + (v[0][j].z + v[0][j].w); s1 += (v[1][j].x + v[1][j].y) + (v[1][j].z + v[1][j].w); }
#pragma unroll
            for (int o = 1; o < 64; o <<= 1) { s0 += __shfl_xor(s0, o); s1 += __shfl_xor(s1, o); }
            const float m0 = s0 * (1.f / 1024.f), m1 = s1 * (1.f / 1024.f); float q0 = 0.f, q1 = 0.f;
#pragma unroll
            for (int j = 0; j < 4; ++j) { v[0][j] = v[0][j] - m0; v[1][j] = v[1][j] - m1;
                q0 += (v[0][j].x * v[0][j].x + v[0][j].y * v[0][j].y) + (v[0][j].z * v[0][j].z + v[0][j].w * v[0][j].w); q1 += (v[1][j].x * v[1][j].x + v[1][j].y * v[1][j].y) + (v[1][j].z * v[1][j].z + v[1][j].w * v[1][j].w); }
#pragma unroll
            for (int o = 1; o < 64; o <<= 1) { q0 += __shfl_xor(q0, o); q1 += __shfl_xor(q1, o); }
            const float r0 = rsqrtf(q0 * (1.f / 1024.f) + LN_EPS), r1 = rsqrtf(q1 * (1.f / 1024.f) + LN_EPS);
#pragma unroll
            for (int i = 0; i < 2; ++i) { const int rl = 2 * wave + i; const size_t row = (size_t)chunk * 256 + step * 16 + rl; const float rs = i ? r1 : r0;
                if (lane == 0) { pg8::f32x2 sv = {i ? m1 : m0, rs}; *(pg8::f32x2*)(STAT + 2 * row) = sv; }
#pragma unroll
                for (int jj = 0; jj < 2; ++jj) { const f32x4 y0 = v[i][2 * jj] * rs * gam[2 * jj] + bet[2 * jj], y1 = v[i][2 * jj + 1] * rs * gam[2 * jj + 1] + bet[2 * jj + 1]; const int c = 8 * (lane + 64 * jj);
                    *(unsigned long long*)(X1F8 + row * 1024 + c) = (unsigned long long)pg8::pk4_fp8(y0.x, y0.y, y0.z, y0.w) | ((unsigned long long)pg8::pk4_fp8(y1.x, y1.y, y1.z, y1.w) << 32);
                    *(LAS f32x4*)(XT + rl * XT_PITCH + c) = y0; *(LAS f32x4*)(XT + rl * XT_PITCH + c + 4) = y1; } }
            __syncthreads();
            f32x16_ acc = {};
#pragma unroll
            for (int s = 0; s < 8; ++s) { const LAS float* xp = XT + (lane & 15) * XT_PITCH + 128 * wave + 16 * s + 8 * kh;
                const f32x4 a = *(const LAS f32x4*)xp, b = *(const LAS f32x4*)(xp + 4); bf16x8 ah, al; hilo8(a, b, ah, al);
                acc = __builtin_amdgcn_mfma_f32_32x32x16_bf16(ah, bh[s], acc, 0, 0, 0); acc = __builtin_amdgcn_mfma_f32_32x32x16_bf16(al, bh[s], acc, 0, 0, 0); acc = __builtin_amdgcn_mfma_f32_32x32x16_bf16(ah, bl[s], acc, 0, 0, 0); }
#pragma unroll
            for (int i = 0; i < 8; ++i) PL[(wave * 16 + (i & 3) + 8 * (i >> 2) + 4 * kh) * 32 + e] = acc[i];
            __syncthreads();
            { const int row = F.tid >> 5, ee = F.tid & 31; float sum = 0.f;
#pragma unroll
              for (int w = 0; w < 8; ++w) sum += PL[(w * 16 + row) * 32 + ee];
              LG[(step * 16 + row) * 33 + ee] = sum + __shfl(brt, ee); }
        }
        __syncthreads();
        LAS int* cntl = (LAS int*)(F.lds + RS_OFF); LAS int* basel = cntl + 32;
        if (F.tid < 32) cntl[F.tid] = 0;
        int my_e[4] = {0, 0, 0, 0}; float my_g[4] = {0.f, 0.f, 0.f, 0.f};
        if (F.tid < 256) { float lg[32];
#pragma unroll
            for (int k = 0; k < 32; ++k) lg[k] = LG[F.tid * 33 + k];
            float tv[4];
#pragma unroll
            for (int r = 0; r < 4; ++r) { float bv = lg[0]; int bi = 0;
#pragma unroll
                for (int k = 1; k < 32; ++k) if (lg[k] > bv) { bv = lg[k]; bi = k; }
                tv[r] = bv; my_e[r] = bi;
#pragma unroll
                for (int k = 0; k < 32; ++k) if (k == bi) lg[k] = -INFINITY; }
            const float e1 = __expf(tv[1] - tv[0]), e2 = __expf(tv[2] - tv[0]), e3 = __expf(tv[3] - tv[0]), rs = 1.f / (1.f + e1 + e2 + e3);
            my_g[0] = rs; my_g[1] = e1 * rs; my_g[2] = e2 * rs; my_g[3] = e3 * rs; }
        __syncthreads();
        int rk[4] = {0, 0, 0, 0};
        if (F.tid < 256) {
#pragma unroll
            for (int k = 0; k < 4; ++k) rk[k] = __hip_atomic_fetch_add(&cntl[my_e[k]], 1, __ATOMIC_RELAXED, __HIP_MEMORY_SCOPE_WORKGROUP); }
        __syncthreads();
        if (F.tid < 32) basel[F.tid] = (int)__hip_atomic_fetch_add(F.ctl + CW_CNT + (dry ? 32 : 0) + F.tid, (unsigned)cntl[F.tid], RLX_AGENT);
        __syncthreads();
        if (F.tid < 256) { const int row = chunk * 256 + F.tid; int* LIST = (int*)(ws + (dry ? 836 * MiB : WS_LIST)); float* GATEL = (float*)(ws + (dry ? 844 * MiB : WS_GATEL)); float* GATE = (float*)(ws + (dry ? 852 * MiB : WS_GATE));
#pragma unroll
            for (int k = 0; k < 4; ++k) { const size_t o = (size_t)my_e[k] * 65536 + (size_t)(basel[my_e[k]] + rk[k]); LIST[o] = row * 4 + k; GATEL[o] = my_g[k]; GATE[row * 4 + k] = my_g[k]; } }
        __syncthreads();
    }
}
__device__ __forceinline__ void ph10_final(Frame& F, const Ptrs& P, const bool dry) {
    float* dst = dry ? (float*)(P.ws + 356 * MiB) : P.out;
    const bf16* PLEB = (const bf16*)(P.ws + WS_PLE); const unsigned char* YS0 = P.ws + WS_YS; const unsigned char* YS1 = YS0 + YS_STRIDE; const unsigned char* YS2 = YS1 + YS_STRIDE; const unsigned char* YS3 = YS2 + YS_STRIDE;
    const int gw = F.vcu * NWAVES + F.wave, NGW = F.G * NWAVES, lane = F.lane;
    f32x4 gam[4], bet[4];
#pragma unroll
    for (int j = 0; j < 4; ++j) { gam[j] = *(const f32x4*)(P.ln2g + CI6(j)); bet[j] = *(const f32x4*)(P.ln2b + CI6(j)); }
    v4u pw[2], npw[2]; unsigned long long ys[2][4], nys[2][4];
#define PH10_LOAD(row_, PW, YS_) do { _Pragma("unroll") for (int jj = 0; jj < 2; ++jj) { const size_t o8 = (size_t)(row_) * 128 + lane + 64 * jj;     \
        PW[jj] = ((const v4u*)PLEB)[o8]; YS_[jj][0] = ((const unsigned long long*)YS0)[o8]; YS_[jj][1] = ((const unsigned long long*)YS1)[o8]; YS_[jj][2] = ((const unsigned long long*)YS2)[o8]; YS_[jj][3] = ((const unsigned long long*)YS3)[o8]; } } while (0)
    if (gw < M) PH10_LOAD(gw, pw, ys);
    for (int row = gw; row < M; row += NGW) {
        if (row + NGW < M) PH10_LOAD(row + NGW, npw, nys);
        f32x4 v[4]; float s = 0.f;
#pragma unroll
        for (int jj = 0; jj < 2; ++jj) { const unsigned long long ya = ys[jj][0], yb = ys[jj][1], yc = ys[jj][2], yd = ys[jj][3];
            pg8::unpack8(pw[jj], v[2 * jj], v[2 * jj + 1]);
#pragma unroll
            for (int h = 0; h < 2; ++h) { const unsigned a = (unsigned)(ya >> (32 * h)), b = (unsigned)(yb >> (32 * h)), c = (unsigned)(yc >> (32 * h)), d = (unsigned)(yd >> (32 * h)); constexpr float is = 1.f / YS_SCALE; const int j = 2 * jj + h;
              typedef float f32x2_ __attribute__((ext_vector_type(2)));
              const f32x2_ a0 = __builtin_amdgcn_cvt_pk_f32_fp8(a, false), a1 = __builtin_amdgcn_cvt_pk_f32_fp8(a, true), b0 = __builtin_amdgcn_cvt_pk_f32_fp8(b, false), b1 = __builtin_amdgcn_cvt_pk_f32_fp8(b, true);
              const f32x2_ c0 = __builtin_amdgcn_cvt_pk_f32_fp8(c, false), c1 = __builtin_amdgcn_cvt_pk_f32_fp8(c, true), d0 = __builtin_amdgcn_cvt_pk_f32_fp8(d, false), d1 = __builtin_amdgcn_cvt_pk_f32_fp8(d, true);
              v[j].x += ((a0[0] + b0[0]) + (c0[0] + d0[0])) * is; v[j].y += ((a0[1] + b0[1]) + (c0[1] + d0[1])) * is; v[j].z += ((a1[0] + b1[0]) + (c1[0] + d1[0])) * is; v[j].w += ((a1[1] + b1[1]) + (c1[1] + d1[1])) * is;
              s += (v[j].x + v[j].y) + (v[j].z + v[j].w); } }
        const float mean = wave_sum(s) * (1.f / 1024.f); float s2 = 0.f;
#pragma unroll
        for (int j = 0; j < 4; ++j) { v[j] = v[j] - mean; s2 += (v[j].x * v[j].x + v[j].y * v[j].y) + (v[j].z * v[j].z + v[j].w * v[j].w); }
        const float rstd = rsqrtf(wave_sum(s2) * (1.f / 1024.f) + LN_EPS);
#pragma unroll
        for (int j = 0; j < 4; ++j) *(f32x4*)(dst + (size_t)row * 1024 + CI6(j)) = v[j] * rstd * gam[j] + bet[j];
#pragma unroll
        for (int jj = 0; jj < 2; ++jj) { pw[jj] = npw[jj];
#pragma unroll
            for (int k = 0; k < 4; ++k) ys[jj][k] = nys[jj][k]; }
    }
#undef PH10_LOAD
}
__device__ __forceinline__ void moe_tables(Frame& F) {
    LAS int* cnt = (LAS int*)(F.lds + pg8::TAB_CNT); LAS int* blk0 = (LAS int*)(F.lds + pg8::TAB_BLK0); LAS int* row0 = (LAS int*)(F.lds + pg8::TAB_ROW0);
    __syncthreads();
    if (F.tid < 32) cnt[F.tid] = (int)__hip_atomic_load(F.ctl + CW_CNT + F.tid, RLX_AGENT);
    __syncthreads();
    if (F.tid == 0) { int b = 0, r = 0; for (int e = 0; e < 32; ++e) { blk0[e] = b; row0[e] = r; b += (cnt[e] + 255) >> 8; r += cnt[e]; } blk0[32] = b; row0[32] = r; }
    __syncthreads();
}

constexpr int NPHASE = 11;
struct Args { Ptrs P; int ph_lo, ph_hi; };
__global__ void __launch_bounds__(NWAVES * 64, 2) mk_fwd(Args args) {
    extern __shared__ __attribute__((aligned(16))) unsigned char lds[];
    Frame F; const Ptrs& P = args.P;
    F.lds = (LAS unsigned char*)lds; F.MISC = (volatile LAS unsigned*)(F.lds + MISC_OFF);
    F.wave = __builtin_amdgcn_readfirstlane(threadIdx.x >> 6); F.lane = lane_id(); F.tid = F.wave * 64 + F.lane;
#define REFRESH() do { F.lane = lane_id(); asm volatile("" : "+v"(F.lane)); F.tid = F.wave * 64 + F.lane; } while (0)
    F.G = gridDim.x; { const int bx = blockIdx.x; F.vcu = (F.G % 8 == 0) ? (bx % 8) * (F.G / 8) + bx / 8 : bx; }
    unsigned char* ws = P.ws; F.ctl = (gu32*)(ws + WS_CTL);
    for (int u = F.tid; u < 1024 / 4; u += NWAVES * 64) ((LAS unsigned*)(F.lds + LDSCTL_OFF))[u] = 0u;
    __syncthreads();
    const int lo = args.ph_lo, hi = args.ph_hi;
    XcdBarrier bar = xcd_barrier_post((unsigned*)(F.ctl + CW_BAR) + lo * XCD_BAR_WORDS, F.MISC + 8);
#define IN(k) (lo <= (k) && (k) < hi)
#define SEAM(k) do { if (IN(k) && IN((k) + 1)) xcd_barrier(bar); } while (0)
    bf16 *XB = (bf16*)P.out, *Q = (bf16*)(ws + WS_Q), *K = (bf16*)(ws + WS_K), *V = (bf16*)(ws + WS_V), *U = (bf16*)(ws + WS_U), *G = (bf16*)(ws + WS_G);
    bf16 *O16 = (bf16*)(ws + WS_O16), *APO = (bf16*)(ws + WS_APO), *MIX = (bf16*)(ws + WS_MIX), *X1B = (bf16*)(ws + WS_X1B), *HB = (bf16*)(ws + WS_HB), *PB = (bf16*)((unsigned char*)P.out + 128 * MiB);
    bf16* T = (bf16*)P.out;

    if (IN(0)) { REFRESH(); ph0_prologue(F, P); } SEAM(0);
    if (IN(1)) {
        const int flip = (PROJ_F8_FROM < 16) ? (((int)blockIdx.x >> 3) & 1) : 0;
        REFRESH(); { const f32x4 bgv = ((const f32x4*)P.b_gate)[F.tid]; ((LAS f32x4*)(F.lds + pg8::TAB_OFF))[F.tid] = bgv; } __syncthreads();
#pragma unroll 1
        for (int pass = 0; pass < 2; ++pass) {
            if ((pass ^ flip) == 0) { pg8::Gemm g{XB, (const bf16*)(ws + WS_WIN), 1024}; pg8::StaticOrder S; S.init(M, 256 * (PROJ_F8_FROM < 16 ? PROJ_F8_FROM : 16), F.G, (int)blockIdx.x);
              pg8::EpiProj E{Q, K, V, U, G, P.b_gate, (float*)(F.ctl + CW_PN), C2Q, 1.f, 0, 0};
              pg8::gemm_phase(F.lds, F.wave, g, S, E); }
            else if (PROJ_F8_FROM < 16) {
              pg8::Gemm g{(const bf16*)(ws + WS_XF8), (const bf16*)(ws + WS_WIN8), 512}; pg8::DenseF8Order S; S.init(M, 256 * (16 - PROJ_F8_FROM), F.G, (int)blockIdx.x);
              pg8::EpiProj E{Q, K, V, U, G, P.b_gate, (float*)(F.ctl + CW_PN), C2Q, 1.f / WUP_SCALE, PROJ_F8_FROM, 0};
              pg8::gemm_phase(F.lds, F.wave, g, S, E); }
        }
    } SEAM(1);
    if (IN(2)) {
        if (NCONV > 0 && (int)blockIdx.x < NCONV) {
            REFRESH(); conv_items(P, TI_EARLY, TI_TOTAL, (int)blockIdx.x * NWAVES + F.wave, NCONV * NWAVES, (LAS float*)(F.lds + RING_OFF + F.wave * 16384), F.lane); __syncthreads();
            REFRESH(); conv_p(F, P, (int)blockIdx.x, NCONV); }
        if (NPOOL > 0 && (int)blockIdx.x >= NCONV && (int)blockIdx.x < NCONV + NPOOL) { REFRESH(); ph_pool(F, P, (int)blockIdx.x - NCONV, NPOOL); }
        const attn_body::AttnTensors AT{(const attn_body::bf16*)Q, (const attn_body::bf16*)K, (const attn_body::bf16*)V, (attn_body::bf16*)O16, (const float*)(F.ctl + CW_PN), (unsigned*)(F.ctl + CW_AQ), lam_value(P), P.subln, ws + WS_APO};
        attn_body::attn_phase<-1>((char*)lds + RING_OFF, AT, F.wave);
        if (NPOOL == 0) {
            volatile LAS unsigned* pslot = (volatile LAS unsigned*)(F.lds + RING_OFF + 64);
            for (;;) { __syncthreads(); REFRESH(); if (F.tid == 0) *pslot = __hip_atomic_fetch_add((unsigned*)(F.ctl + CW_PQ), 1u, RLX_AGENT); __syncthreads();
                const unsigned blk = *pslot; if (blk >= (unsigned)((M / 32) * 64 / 512)) break; ph_pool(F, P, (int)blk, (M / 32) * 64 / 512); } }
    }
    SEAM(3);
    if (IN(4)) {
        if (MIXG_FP8) { pg8::DenseF8Order S; S.init(M, 1024, F.G, (int)blockIdx.x);
            pg8::Gemm g{APO, (const bf16*)(ws + WS_WCAT), 512}; pg8::EpiMixCat E{MIX, G, 1.f / (APO_SCALE * WUP_SCALE), 0}; pg8::gemm_phase(F.lds, F.wave, g, S, E); }
        else { pg8::StaticOrder S; S.init(M, 1024, F.G, (int)blockIdx.x);
            pg8::Gemm g{APO, (const bf16*)(ws + WS_WCAT), 1024}; pg8::EpiMixCat E{MIX, G, 1.f, 0}; pg8::gemm_phase(F.lds, F.wave, g, S, E); }
    } SEAM(4);
    if (IN(5)) {
        pg8::Gemm g{MIX, (const bf16*)(ws + WS_WOUT), 1024}; pg8::StaticOrder S; S.init(M, 1024, F.G, (int)blockIdx.x);
        pg8::EpiPre1 E{(bf16*)(ws + WS_PRE1B), XB, ALPHA, 0};
        pg8::gemm_phase(F.lds, F.wave, g, S, E);
    } SEAM(5);
    if (IN(6)) { REFRESH(); ph6_ln1_route(F, P, false); } SEAM(6);
    if (IN(7)) {
        pg8::StaticOrder S; S.init(M, 1024, F.G, (int)blockIdx.x);
        { pg8::Gemm g{PB, (const bf16*)(ws + WS_WPP), 256}; pg8::EpiPle<1> E{T, nullptr, nullptr, nullptr, nullptr, nullptr, 1.f, 0.f}; pg8::gemm_phase(F.lds, F.wave, g, S, E); }
        VM_WAIT(); __syncthreads();
        if (MOE_FP8) { pg8::DenseF8Order S8; S8.init(M, 1024, F.G, (int)blockIdx.x);
            pg8::Gemm g{(const bf16*)(ws + WS_X1F8), (const bf16*)(ws + WS_WPG), 512}; pg8::EpiPle<3> E{(bf16*)(ws + WS_PLE), T, (const bf16*)(ws + WS_PRE1B), (const float*)(ws + WS_STAT), P.ln1g, P.ln1b, 1.f / WUP_SCALE, ALPHA}; pg8::gemm_phase(F.lds, F.wave, g, S8, E); }
        else { pg8::Gemm g{X1B, (const bf16*)(ws + WS_WPG), 1024}; pg8::EpiPle<3> E{(bf16*)(ws + WS_PLE), T, (const bf16*)(ws + WS_PRE1B), (const float*)(ws + WS_STAT), P.ln1g, P.ln1b, 1.f, ALPHA}; pg8::gemm_phase(F.lds, F.wave, g, S, E); }
    }
    if (IN(8)) {
        REFRESH(); moe_tables(F);
        pg8::Gemm g{MOE_FP8 ? (const bf16*)(ws + WS_X1F8) : X1B, (const bf16*)(ws + WS_WUP), MOE_FP8 ? 512 : 1024};
        pg8::MoeOrder<true, MOE_FP8> S{8, F.G, (int)blockIdx.x, (const int*)(ws + WS_LIST), (const float*)(ws + WS_GATEL), (size_t)2048 * 1024 * (MOE_FP8 ? 1 : 2), P.b_up};
        pg8::EpiUp<MOE_FP8> E{HB, P.b_up, MOE_FP8 ? 1.f / WUP_SCALE : 1.f, 0};
        pg8::gemm_phase(F.lds, F.wave, g, S, E);
    } SEAM(8);
    if (IN(9)) {
        REFRESH(); moe_tables(F);
        pg8::Gemm g{HB, (const bf16*)(ws + WS_WDN), MOE_FP8 ? 512 : 1024};
        pg8::MoeOrder<false, MOE_FP8> S{4, F.G, (int)blockIdx.x, (const int*)(ws + WS_LIST), (const float*)(ws + WS_GATEL), (size_t)1024 * 1024 * (MOE_FP8 ? 1 : 2), P.b_down};
        pg8::EpiDown E{ws + WS_YS, YS_STRIDE, P.b_down, MOE_FP8 ? 1.f / (WDN_SCALE) : 1.f, YS_SCALE};
        pg8::gemm_phase(F.lds, F.wave, g, S, E);
    } SEAM(9);
    if (IN(10)) { REFRESH(); ph10_final(F, P, false); }
#undef IN
#undef SEAM
}
extern "C" void kernel_launch(void* const* d_in, const int* in_sizes, int n_in, void* d_out, int out_size, void* d_ws, size_t ws_size, hipStream_t stream) {
    static int grid = 0;
    if (grid == 0) {
        if (n_in != 26 || in_sizes[0] != M * D || ws_size < WS_END || out_size != M * D) { fprintf(stderr, "kernel_launch: unexpected shapes (n_in %d, ws %zu, out %d); nothing launched\n", n_in, ws_size, out_size); grid = -1; return; }
        int dev = 0, cus = 0, per_cu = 0;
        if (hipGetDevice(&dev) != hipSuccess || hipDeviceGetAttribute(&cus, hipDeviceAttributeMultiprocessorCount, dev) != hipSuccess) { fprintf(stderr, "kernel_launch: device query failed; nothing launched\n"); grid = -1; return; }
        if (hipFuncSetAttribute((const void*)mk_fwd, hipFuncAttributeMaxDynamicSharedMemorySize, LDS_BYTES) != hipSuccess) { fprintf(stderr, "kernel_launch: hipFuncSetAttribute failed (%d bytes of dynamic LDS); nothing launched\n", LDS_BYTES); grid = -1; return; }
        if (hipOccupancyMaxActiveBlocksPerMultiprocessor(&per_cu, (const void*)mk_fwd, NWAVES * 64, LDS_BYTES) != hipSuccess || per_cu < 1) fprintf(stderr, "kernel_launch: note: occupancy query reports %d workgroups per CU\n", per_cu);
        (void)hipGetLastError();
        grid = cus;
    }
    if (grid < 0) return;
    if (hipMemsetAsync((char*)d_ws + WS_CTL, 0, CTL_ZERO_BYTES, stream) != hipSuccess) { fprintf(stderr, "kernel_launch: hipMemsetAsync failed; nothing launched\n"); return; }
    Args a{};
    { const float** pp = (const float**)&a.P; for (int i = 0; i < 26; ++i) pp[i] = (const float*)d_in[i]; }
    a.P.out = (float*)d_out; a.P.ws = (unsigned char*)d_ws; a.ph_lo = 0; a.ph_hi = NPHASE;
    hipLaunchKernelGGL(mk_fwd, dim3(grid), dim3(NWAVES * 64), LDS_BYTES, stream, a);
}
```
